# Optimizing an MI355X kernel written in HIP

```python
import math
import jax, jax.numpy as jnp
from jax import lax
import numpy as np

D_MODEL = 1024
BATCH = 8
SEQ = 4096
DEPTH = 4

A_CHUNK = 128
A_GROUPS = 4
A_WIDTH = D_MODEL
A_GROUP_DIM = A_WIDTH // A_GROUPS
HEAD_DIM = 64
B_HEADS = 8
DILATED_PATTERNS = ((128, 1), (512, 4), (2048, 16))
N_DIL = len(DILATED_PATTERNS)
B_GROUP_WIDTH = B_HEADS * HEAD_DIM
B_QKV_WIDTH = N_DIL * B_GROUP_WIDTH
B_BLOCK = 128
ROPE_DIM = HEAD_DIM // 4
ROPE_THETA = 500000.0
N_BRANCH = 2
IN_WIDTH = 2 * A_WIDTH + 3 * B_QKV_WIDTH + N_BRANCH * D_MODEL
N_EXPERTS = 32
TOP_K = 4
D_FF_EXPERT = D_MODEL
SWIGLU_LIMIT = 7.0
SWIGLU_ALPHA = 1.702
DN_ALPHA = (2 * DEPTH) ** 0.25
DN_BETA = (8 * DEPTH) ** -0.25
LN_EPS = 1e-5
ADA_SCALE = 0.1

kernel_name = "hybrid_gmlp_dilated_attn_moe_deepnorm"


def layer_norm(x, g, b):
    xf = x.astype(jnp.float32)
    mu = jnp.mean(xf, -1, keepdims=True)
    var = jnp.mean(jnp.square(xf - mu), -1, keepdims=True)
    y = (xf - mu) * lax.rsqrt(var + LN_EPS)
    return (y * g.astype(jnp.float32) + b.astype(jnp.float32)).astype(x.dtype)


def plain_norm(x):
    xf = x.astype(jnp.float32)
    mu = jnp.mean(xf, -1, keepdims=True)
    var = jnp.mean(jnp.square(xf - mu), -1, keepdims=True)
    return ((xf - mu) * lax.rsqrt(var + LN_EPS)).astype(x.dtype)


def rope_partial(x, pos):
    half = ROPE_DIM // 2
    inv = ROPE_THETA ** (-jnp.arange(half, dtype=jnp.float32) / half)
    ang = pos.astype(jnp.float32)[:, None] * inv[None, :]
    cos = jnp.cos(ang)[None, :, None, :]
    sin = jnp.sin(ang)[None, :, None, :]
    xr = x[..., :ROPE_DIM].astype(jnp.float32)
    x1, x2 = xr[..., :half], xr[..., half:]
    rot = jnp.concatenate([x1 * cos - x2 * sin, x2 * cos + x1 * sin], -1)
    return jnp.concatenate([rot.astype(x.dtype), x[..., ROPE_DIM:]], -1)


def dilated_window_group(q, k, v, window, dilation):
    B, S, H, Dh = q.shape
    span = window // dilation
    L = S // dilation
    nb = -(-L // B_BLOCK)
    Lp = nb * B_BLOCK

    def sub(a):
        a = a.reshape(B, L, dilation, H, Dh)
        a = jnp.pad(a, ((0, 0), (0, Lp - L), (0, 0), (0, 0), (0, 0)))
        return a.reshape(B, nb, B_BLOCK, dilation, H, Dh)

    def with_prev(a):
        prev = jnp.pad(a[:, :-1], ((0, 0), (1, 0), (0, 0), (0, 0), (0, 0), (0, 0)))
        return jnp.concatenate([prev, a], axis=2)

    qb = sub(q)
    kc = with_prev(sub(k))
    vc = with_prev(sub(v))
    s = jnp.einsum('bnqrhc,bnkrhc->bnrhqk', qb, kc,
                   preferred_element_type=jnp.float32) * (HEAD_DIM ** -0.5)
    i = jnp.arange(B_BLOCK)[:, None]
    j = jnp.arange(2 * B_BLOCK)[None, :]
    diff = B_BLOCK + i - j
    band = (diff >= 0) & (diff <= span)
    kblk = jnp.arange(nb)[:, None] - 1 + (jnp.arange(2 * B_BLOCK)[None, :] >= B_BLOCK)
    valid = (kblk >= 0)[:, None, :]
    mask = band[None] & valid
    s = jnp.where(mask[None, :, None, None], s, -jnp.inf)
    m = jnp.max(s, -1)
    p = jnp.exp(s - m[..., None])
    den = jnp.sum(p, -1)
    o = jnp.einsum('bnrhqk,bnkrhc->bnqrhc', p, vc.astype(jnp.float32))

    def unsub(a):
        a = a.reshape((B, Lp, dilation) + a.shape[4:])[:, :L]
        return a.reshape((B, S) + a.shape[3:])

    m = unsub(jnp.transpose(m, (0, 1, 4, 2, 3)))
    den = unsub(jnp.transpose(den, (0, 1, 4, 2, 3)))
    return unsub(o), m, den


def token_mixer(h, w_in, sp_w, sp_b, w_ba, w_bb, w_out):
    B, S, D = h.shape
    pos = jnp.arange(S)
    z = h @ w_in
    i1 = A_WIDTH
    i2 = 2 * A_WIDTH
    i3 = i2 + B_QKV_WIDTH
    i4 = i3 + B_QKV_WIDTH
    i5 = i4 + B_QKV_WIDTH
    u, v, q, k, vv, gates = jnp.split(z, [i1, i2, i3, i4, i5], axis=-1)

    nc = S // A_CHUNK
    u = jax.nn.gelu(u).reshape(B, nc, A_CHUNK, A_GROUPS, A_GROUP_DIM)
    v = plain_norm(jax.nn.gelu(v).reshape(B, nc, A_CHUNK, A_GROUPS, A_GROUP_DIM))
    causal = jnp.tril(jnp.ones((A_CHUNK, A_CHUNK), dtype=bool))
    ws = jnp.where(causal[None], sp_w, jnp.zeros_like(sp_w))
    sv = jnp.einsum('gij,bnjgc->bnigc', ws, v) + sp_b.T[None, None, :, :, None]
    ya = (u * sv).reshape(B, S, A_WIDTH) @ w_ba

    q = rope_partial(q.reshape(B, S, N_DIL * B_HEADS, HEAD_DIM), pos).reshape(B, S, N_DIL, B_HEADS, HEAD_DIM)
    k = rope_partial(k.reshape(B, S, N_DIL * B_HEADS, HEAD_DIM), pos).reshape(B, S, N_DIL, B_HEADS, HEAD_DIM)
    vv = vv.reshape(B, S, N_DIL, B_HEADS, HEAD_DIM)
    outs, maxes, dens = [], [], []
    for g, (window, dilation) in enumerate(DILATED_PATTERNS):
        o_g, m_g, d_g = dilated_window_group(q[:, :, g], k[:, :, g], vv[:, :, g], window, dilation)
        outs.append(o_g)
        maxes.append(m_g)
        dens.append(d_g)
    m_all = jnp.stack(maxes, 0)
    m_ref = jnp.max(m_all, 0)
    wgt = jnp.exp(m_all - m_ref[None])
    num = sum(wgt[g][..., None] * outs[g] for g in range(N_DIL))
    den = jnp.sum(wgt * jnp.stack(dens, 0), 0)
    ob = (num / den[..., None]).astype(h.dtype).reshape(B, S, B_GROUP_WIDTH)
    yb = ob @ w_bb

    gts = jax.nn.sigmoid(gates.astype(jnp.float32)).astype(h.dtype).reshape(B, S, N_BRANCH, D)
    merged = gts[:, :, 0] * ya + gts[:, :, 1] * yb
    return merged @ w_out


def routed_experts(h, w_r, b_r, w_up, b_up, w_down, b_down):
    B, S, D = h.shape
    t = h.reshape(B * S, D)
    logits = (t @ w_r + b_r).astype(jnp.float32)
    vals, idx = lax.top_k(logits, TOP_K)
    wts = jax.nn.softmax(vals, axis=-1)
    combine = jnp.einsum('tk,tke->te', wts, jax.nn.one_hot(idx, N_EXPERTS, dtype=jnp.float32)).astype(t.dtype)
    out = jnp.zeros_like(t)
    for e in range(N_EXPERTS):
        hh = t @ w_up[e] + b_up[e]
        glu = jnp.minimum(hh[:, ::2], SWIGLU_LIMIT)
        lin = jnp.clip(hh[:, 1::2], -SWIGLU_LIMIT, SWIGLU_LIMIT)
        act = glu * jax.nn.sigmoid(SWIGLU_ALPHA * glu) * (lin + 1)
        out = out + combine[:, e:e + 1] * (act @ w_down[e] + b_down[e])
    return out.reshape(B, S, D)


def setup_inputs(seed: int = 0) -> dict:
    key = jax.random.key(seed)
    ks = jax.random.split(key, 22)
    n = jax.random.normal
    D = D_MODEL
    F = D_FF_EXPERT
    return {
        "x": n(ks[0], (BATCH, SEQ, D), jnp.float32),
        "c": n(ks[1], (BATCH, D), jnp.float32),
        "w_ada": n(ks[2], (DEPTH, D, 6 * D), jnp.float32) * (D ** -0.5) * ADA_SCALE,
        "b_ada": 0.01 * n(ks[3], (DEPTH, 6 * D), jnp.float32),
        "w_in": n(ks[4], (DEPTH, D, IN_WIDTH), jnp.float32) * (D ** -0.5),
        "spatial_w": n(ks[5], (DEPTH, A_GROUPS, A_CHUNK, A_CHUNK), jnp.float32) * (A_CHUNK ** -0.5),
        "spatial_b": 1.0 + 0.02 * n(ks[6], (DEPTH, A_GROUPS, A_CHUNK), jnp.float32),
        "w_branch_a": n(ks[7], (DEPTH, A_WIDTH, D), jnp.float32) * (A_WIDTH ** -0.5),
        "w_branch_b": n(ks[8], (DEPTH, B_GROUP_WIDTH, D), jnp.float32) * (B_GROUP_WIDTH ** -0.5),
        "w_out": n(ks[9], (DEPTH, D, D), jnp.float32) * (D ** -0.5) * DN_BETA,
        "ln1_g": 1.0 + 0.02 * n(ks[10], (DEPTH, D), jnp.float32),
        "ln1_b": 0.02 * n(ks[11], (DEPTH, D), jnp.float32),
        "w_router": n(ks[12], (DEPTH, D, N_EXPERTS), jnp.float32) * (D ** -0.5),
        "b_router": 0.01 * n(ks[13], (DEPTH, N_EXPERTS), jnp.float32),
        "w_up": n(ks[14], (DEPTH, N_EXPERTS, D, 2 * F), jnp.float32) * (D ** -0.5),
        "b_up": 0.01 * n(ks[15], (DEPTH, N_EXPERTS, 2 * F), jnp.float32),
        "w_down": n(ks[16], (DEPTH, N_EXPERTS, F, D), jnp.float32) * (F ** -0.5) * DN_BETA,
        "b_down": 0.01 * n(ks[17], (DEPTH, N_EXPERTS, D), jnp.float32),
        "ln2_g": 1.0 + 0.02 * n(ks[18], (DEPTH, D), jnp.float32),
        "ln2_b": 0.02 * n(ks[19], (DEPTH, D), jnp.float32),
    }


def reference(x, c, w_ada, b_ada, w_in, spatial_w, spatial_b, w_branch_a, w_branch_b, w_out,
              ln1_g, ln1_b, w_router, b_router, w_up, b_up, w_down, b_down, ln2_g, ln2_b):
    for l in range(DEPTH):
        mod = (c @ w_ada[l] + b_ada[l])[:, None, :]
        sh1, sc1, g1, sh2, sc2, g2 = jnp.split(mod, 6, axis=-1)
        h = x * (1 + sc1) + sh1
        y = token_mixer(h, w_in[l], spatial_w[l], spatial_b[l], w_branch_a[l], w_branch_b[l], w_out[l])
        x = layer_norm(DN_ALPHA * x + (1 + g1) * y, ln1_g[l], ln1_b[l])
        h = x * (1 + sc2) + sh2
        y = routed_experts(h, w_router[l], b_router[l], w_up[l], b_up[l], w_down[l], b_down[l])
        x = layer_norm(DN_ALPHA * x + (1 + g2) * y, ln2_g[l], ln2_b[l])
    return x
```

```cpp
#include <hip/hip_runtime.h>
#include <cstdio>
#include <cstdint>
#ifndef MK_PER_PHASE
#define MK_PER_PHASE 0
#endif
namespace pg8 {
#define PG8_LAS __attribute__((address_space(3)))
typedef unsigned short bf16_t;
typedef short bf16x8 __attribute__((ext_vector_type(8)));
typedef float f32x4 __attribute__((ext_vector_type(4)));
typedef unsigned u32x4 __attribute__((ext_vector_type(4)));
constexpr int BM = 256, BK = 64, HALF = 128, HTB = HALF * BK * 2  , STAGE_BYTES = 8 * HTB, NXCD = 8, WGM = 8;

__host__ __device__ __forceinline__ int lds_byte(int r, int c) { const int st = (r >> 4) * 2 + (c >> 5), rr = r & 15, cc = c & 31, ob = rr * 64 + cc * 2; return st * 1024 + (ob ^ (((ob >> 9) & 1) << 5)); }
__host__ __device__ __forceinline__ void stage_rc(int b, int& R, int& C) { const int st = b / 1024, sb = b % 1024, swz = sb ^ (((sb >> 9) & 1) << 5); R = (st >> 1) * 16 + swz / 64; C = (st & 1) * 32 + (swz % 64) / 2; }
__host__ __device__ __forceinline__ int perm32(int rho) { const int n = rho >> 4, i = rho & 15; return 8 * (i >> 2) + 4 * n + (i & 3); }

struct Unit { int pm, pn; };
struct Gemm { const bf16_t* A; const bf16_t* Bt; int M, N, K; };

struct StaticOrder {
    int nM, nN, nwg, G, c;
    __host__ __device__ void init(int M, int N, int G_, int c_) { nM = M / BM; nN = N / BM; nwg = nM * nN; G = G_; c = c_; }
    __host__ __device__ bool next(int i, Unit& u) const {
        const long L = (long)i * G + c; if (L >= nwg) return false;
        int wgid = (int)L; { const int q = nwg / NXCD, r = nwg % NXCD, xcd = wgid % NXCD, off = wgid / NXCD; wgid = (xcd < r ? xcd * (q + 1) : r * (q + 1) + (xcd - r) * q) + off; }
        const int nig = WGM * nN, gid = wgid / nig, fm = gid * WGM, gsz = (nM - fm) < WGM ? (nM - fm) : WGM;
        u.pm = fm + ((wgid % nig) % gsz); u.pn = (wgid % nig) / gsz; return true;
    }
    __device__ __forceinline__ void a_ready(const Unit&) const {}
    __device__ __forceinline__ void done(const Unit&) const {}
};

__device__ __forceinline__ unsigned cvt_pk_bf16(float lo, float hi) { unsigned r; asm volatile("v_cvt_pk_bf16_f32 %0, %1, %2" : "=v"(r) : "v"(lo), "v"(hi)); return r; }
typedef float f32x2 __attribute__((ext_vector_type(2)));

template <class Epi, class Sched, bool ALIGN_EPI = false, bool SP2 = false>
__device__ __forceinline__ void gemm_phase(PG8_LAS unsigned char* lds, const Gemm g, const Sched& S, const Epi& E, const int tid_in) {
    const int tid = tid_in, wid = __builtin_amdgcn_readfirstlane(tid >> 6), lane = tid & 63, wr = wid >> 2, wc = wid & 3, fr = lane & 15, fq = lane >> 4;
    const int K = g.K, nt = K / BK;
    unsigned voffA[2], voffB[2];
#pragma unroll
    for (int i = 0; i < 2; ++i) { int R, C; stage_rc(tid * 16 + i * 8192, R, C); const int Rb = Epi::PERM ? ((R & ~31) + perm32(R & 31)) : R;
        voffA[i] = (unsigned)(R * K + C) * 2u; voffB[i] = (unsigned)(Rb * K + C) * 2u; }
    const size_t kstep = (size_t)(BK * 2);
    const size_t hstep = (size_t)HALF * K * 2;
    const size_t tstep = 2 * hstep;
    const unsigned ldsw = (unsigned)wid * 1024u;
    const int aoff = lds_byte(wr * 64 + fr, fq * 8), boff = lds_byte(wc * 32 + fr, fq * 8);
#define PG8_SA(b, h) (((b) * 2 + (h)) * HTB)
#define PG8_SB(b, h) ((4 + (b) * 2 + (h)) * HTB)
#define PG8_STAGE(bufoff, gbase, voff) do { _Pragma("unroll") for (int _i = 0; _i < 2; ++_i) \
        __builtin_amdgcn_global_load_lds((const unsigned*)((const char*)(gbase) + (voff)[_i]), (PG8_LAS unsigned*)(lds + (bufoff) + ldsw + _i * 8192), 16, 0, 0); } while (0)
#define PG8_LDA(dst, b, h) do { _Pragma("unroll") for (int m = 0; m < 4; ++m) _Pragma("unroll") for (int k = 0; k < 2; ++k) dst[m][k] = *(const PG8_LAS bf16x8*)(lds + PG8_SA(b, h) + aoff + m * 2048 + k * 1024); } while (0)
#define PG8_LDB(dst, b, h) do { _Pragma("unroll") for (int n = 0; n < 2; ++n) _Pragma("unroll") for (int k = 0; k < 2; ++k) dst[n][k] = *(const PG8_LAS bf16x8*)(lds + PG8_SB(b, h) + boff + n * 2048 + k * 1024); } while (0)
#define PG8_MMA(ai, bj, At, Bt) do { __builtin_amdgcn_s_setprio(1); _Pragma("unroll") for (int m = 0; m < 4; ++m) _Pragma("unroll") for (int n = 0; n < 2; ++n) _Pragma("unroll") for (int k = 0; k < 2; ++k) \
        acc[ai][bj][m][n] = __builtin_amdgcn_mfma_f32_16x16x32_bf16(Bt[n][k], At[m][k], acc[ai][bj][m][n], 0, 0, 0); __builtin_amdgcn_s_setprio(0); } while (0)
#define PG8_WAIT_V(n) asm volatile("s_waitcnt vmcnt(" #n ")" ::: "memory")
#define PG8_WAIT_L(n) asm volatile("s_waitcnt lgkmcnt(" #n ")" ::: "memory")
#define PG8_BAR __builtin_amdgcn_s_barrier()
#define PG8_SCHED __builtin_amdgcn_sched_barrier(0)
    Unit cur, nxt; int ui = 0;
    if (!S.next(0, cur)) return;
    f32x4 acc[2][2][4][2];
#pragma unroll
    for (int a = 0; a < 2; ++a)
#pragma unroll
        for (int b = 0; b < 2; ++b)
#pragma unroll
            for (int m = 0; m < 4; ++m)
#pragma unroll
                for (int n = 0; n < 2; ++n) acc[a][b][m][n] = (f32x4){0.f, 0.f, 0.f, 0.f};
    bf16x8 At[4][2], B0[2][2], B1[2][2];
    const char* cA = (const char*)g.A + (size_t)cur.pm * tstep; const char* cB = (const char*)g.Bt + (size_t)cur.pn * tstep;
    S.a_ready(cur);
    if constexpr (SP2) {
        PG8_STAGE(PG8_SB(0, 0), cB, voffB); PG8_STAGE(PG8_SB(0, 1), cB + hstep, voffB); PG8_STAGE(PG8_SA(0, 0), cA, voffA); PG8_STAGE(PG8_SA(0, 1), cA + hstep, voffA);
        if (wr == 1) PG8_BAR;
        PG8_WAIT_V(2); PG8_BAR;
        PG8_STAGE(PG8_SB(1, 0), cB + kstep, voffB); PG8_STAGE(PG8_SA(1, 0), cA + kstep, voffA); PG8_STAGE(PG8_SB(1, 1), cB + hstep + kstep, voffB);
        PG8_WAIT_V(6); PG8_BAR;
    } else {
        PG8_STAGE(PG8_SB(0, 0), cB, voffB); PG8_STAGE(PG8_SA(0, 0), cA, voffA); PG8_STAGE(PG8_SB(0, 1), cB + hstep, voffB); PG8_STAGE(PG8_SA(0, 1), cA + hstep, voffA);
        if (wr == 1) PG8_BAR;
        PG8_WAIT_V(4); PG8_BAR;
        PG8_STAGE(PG8_SB(1, 0), cB + kstep, voffB); PG8_STAGE(PG8_SA(1, 0), cA + kstep, voffA); PG8_STAGE(PG8_SB(1, 1), cB + hstep + kstep, voffB);
        PG8_WAIT_V(6); PG8_BAR;
    }
    for (;;) {
        const bool has_next = S.next(ui + 1, nxt);
        const char* nA = has_next ? (const char*)g.A + (size_t)nxt.pm * tstep : cA; const char* nB = has_next ? (const char*)g.Bt + (size_t)nxt.pn * tstep : cB;
        for (int t = 0; t < nt; t += 2) {
            const bool last = (t == nt - 2);
            const char* a1 = cA + (size_t)(t + 1) * kstep;
            const char* a2 = last ? nA : cA + (size_t)(t + 2) * kstep; const char* b2 = last ? nB : cB + (size_t)(t + 2) * kstep;
            const char* a3 = a2 + kstep; const char* b3 = b2 + kstep;
            if (last && has_next) S.a_ready(nxt);
            if constexpr (SP2) {
            PG8_LDB(B0, 0, 0); PG8_LDB(B1, 0, 1); PG8_SCHED; PG8_LDA(At, 0, 0); PG8_STAGE(PG8_SA(1, 1), a1 + hstep, voffA);
            PG8_WAIT_V(8); PG8_WAIT_L(0); PG8_BAR; PG8_MMA(0, 0, At, B0); PG8_MMA(0, 1, At, B1); PG8_BAR; PG8_SCHED;
            PG8_LDA(At, 0, 1); PG8_STAGE(PG8_SB(0, 0), b2, voffB); PG8_STAGE(PG8_SB(0, 1), b2 + hstep, voffB); PG8_STAGE(PG8_SA(0, 0), a2, voffA);
            PG8_WAIT_V(8); PG8_WAIT_L(0); PG8_BAR; PG8_MMA(1, 0, At, B0); PG8_MMA(1, 1, At, B1); PG8_BAR; PG8_SCHED;
            PG8_LDB(B0, 1, 0); PG8_LDB(B1, 1, 1); PG8_SCHED; PG8_LDA(At, 1, 0); PG8_STAGE(PG8_SA(0, 1), a2 + hstep, voffA);
            PG8_WAIT_V(8); PG8_WAIT_L(0); PG8_BAR; PG8_MMA(0, 0, At, B0); PG8_MMA(0, 1, At, B1); PG8_BAR; PG8_SCHED;
            PG8_LDA(At, 1, 1); PG8_STAGE(PG8_SB(1, 0), b3, voffB); PG8_STAGE(PG8_SB(1, 1), b3 + hstep, voffB); PG8_STAGE(PG8_SA(1, 0), a3, voffA);
            PG8_WAIT_V(8); PG8_WAIT_L(0); PG8_BAR; PG8_MMA(1, 0, At, B0); PG8_MMA(1, 1, At, B1); PG8_BAR; PG8_SCHED;
            } else {
            PG8_LDB(B0, 0, 0); PG8_SCHED; PG8_LDA(At, 0, 0); PG8_STAGE(PG8_SA(1, 1), a1 + hstep, voffA);
            PG8_WAIT_L(8); PG8_BAR; PG8_WAIT_L(0); PG8_MMA(0, 0, At, B0); PG8_BAR; PG8_SCHED;
            PG8_LDB(B1, 0, 1); PG8_STAGE(PG8_SB(0, 0), b2, voffB);
            PG8_BAR; PG8_WAIT_L(0); PG8_MMA(0, 1, At, B1); PG8_BAR;
            PG8_LDA(At, 0, 1); PG8_STAGE(PG8_SA(0, 0), a2, voffA);
            PG8_BAR; PG8_WAIT_L(0); PG8_MMA(1, 0, At, B0); PG8_BAR; PG8_SCHED;
            PG8_STAGE(PG8_SB(0, 1), b2 + hstep, voffB);
            PG8_WAIT_V(6); PG8_BAR; PG8_MMA(1, 1, At, B1); PG8_BAR;
            PG8_LDB(B0, 1, 0); PG8_SCHED; PG8_LDA(At, 1, 0); PG8_STAGE(PG8_SA(0, 1), a2 + hstep, voffA);
            PG8_WAIT_L(8); PG8_BAR; PG8_WAIT_L(0); PG8_MMA(0, 0, At, B0); PG8_BAR; PG8_SCHED;
            PG8_LDB(B1, 1, 1); PG8_STAGE(PG8_SB(1, 0), b3, voffB);
            PG8_BAR; PG8_WAIT_L(0); PG8_MMA(0, 1, At, B1); PG8_BAR;
            PG8_LDA(At, 1, 1); PG8_STAGE(PG8_SA(1, 0), a3, voffA);
            PG8_BAR; PG8_WAIT_L(0); PG8_MMA(1, 0, At, B0); PG8_BAR; PG8_SCHED;
            PG8_STAGE(PG8_SB(1, 1), b3 + hstep, voffB);
            PG8_WAIT_V(6); PG8_BAR; PG8_MMA(1, 1, At, B1); PG8_BAR;
            }
        }
        if constexpr (ALIGN_EPI) { if (wr == 0) PG8_BAR; }
        if constexpr (!Epi::AFTER_DRAIN) { E(acc, cur, wr, wc, fr, fq); S.done(cur); }
        if (!has_next) break;
#pragma unroll
        for (int a = 0; a < 2; ++a)
#pragma unroll
            for (int b = 0; b < 2; ++b)
#pragma unroll
                for (int m = 0; m < 4; ++m)
#pragma unroll
                    for (int n = 0; n < 2; ++n) acc[a][b][m][n] = (f32x4){0.f, 0.f, 0.f, 0.f};
        cur = nxt; cA = nA; cB = nB; ++ui;
        if constexpr (ALIGN_EPI) { if (wr == 1) PG8_BAR; }
    }
    PG8_WAIT_V(0);
    if constexpr (!ALIGN_EPI) { if (wr == 0) PG8_BAR; }
    PG8_BAR;
    if constexpr (Epi::AFTER_DRAIN) { E.fused(acc, cur, wr, wc, fr, fq, lds, wid, lane); S.done(cur); }
#undef PG8_SA
#undef PG8_SB
#undef PG8_STAGE
#undef PG8_LDA
#undef PG8_LDB
#undef PG8_MMA
#undef PG8_WAIT_V
#undef PG8_WAIT_L
#undef PG8_BAR
#undef PG8_SCHED
}
}
#define LAS __attribute__((address_space(3)))
#define XB_TMO      128
#define XB_XCNT(j)  (256  + 64 * (j))
#define XB_XSUB(j)  (1280 + 64 * (j))
#define XB_XGEN(j)  (2304 + 64 * (j))
#define XB_TOP      3328
#define XB_TOPGEN   3392
#define XCD_BAR_WORDS 3456
#define XB_SPIN_CAP (1u << 18)

__device__ __forceinline__ unsigned xb_ld(unsigned* p)              { return __hip_atomic_load(p, __ATOMIC_RELAXED, __HIP_MEMORY_SCOPE_AGENT); }
__device__ __forceinline__ unsigned xb_add(unsigned* p, unsigned v) { return __hip_atomic_fetch_add(p, v, __ATOMIC_RELAXED, __HIP_MEMORY_SCOPE_AGENT); }
__device__ __forceinline__ unsigned xb_xcc_id() { return (unsigned)__builtin_amdgcn_s_getreg((3 << 11) | 20) & 0xFu; }
#define XB_SPIN(cond, bar) do { unsigned _sp = 0; while (cond) { __builtin_amdgcn_s_sleep(1); \
    if ((++_sp & 255u) == 0u) { if (xb_ld(&(bar)[XB_TMO])) break; if (_sp > XB_SPIN_CAP) { atomicAdd(&(bar)[XB_TMO], 1u); break; } } } } while (0)

struct XcdBarrier {
    unsigned* bar; unsigned x;
    volatile LAS unsigned* st;
};

__device__ __forceinline__ XcdBarrier xcd_barrier_post(unsigned* bar, volatile LAS unsigned* st) {
    XcdBarrier b; b.bar = bar; b.x = xb_xcc_id(); b.st = st;
    if (threadIdx.x == 0) (void)xb_add(&bar[XB_XCNT(b.x)], 1u);
    return b;
}
__device__ __forceinline__ void xcd_barrier_complete(unsigned* bar, unsigned x, unsigned& nloc, unsigned& nx) {
    const unsigned G = gridDim.x * gridDim.y * gridDim.z;
    unsigned sum, cnt, mine, sp = 0u;
    for (;;) {
        sum = 0u; cnt = 0u; mine = 0u;
#pragma unroll
        for (unsigned j = 0; j < 16; ++j) { const unsigned c = xb_ld(&bar[XB_XCNT(j)]); sum += c; cnt += (c > 0u) ? 1u : 0u; mine = (j == x) ? c : mine; }
        if (sum == G) break;
        __builtin_amdgcn_s_sleep(1);
        if ((++sp & 255u) == 0u) { if (xb_ld(&bar[XB_TMO])) break; if (sp > XB_SPIN_CAP) { atomicAdd(&bar[XB_TMO], 1u); break; } }
    }
    nloc = mine > 0u ? mine : 1u; nx = cnt > 0u ? cnt : 1u;
}

__device__ __forceinline__ void xcd_barrier(const XcdBarrier& b) {
    asm volatile("s_waitcnt vmcnt(0)" ::: "memory");
    __syncthreads();
    if (threadIdx.x == 0) {
        unsigned* bar = b.bar;
        __builtin_amdgcn_s_waitcnt(0);
        unsigned nloc = b.st[0], nx = b.st[1];
        if (nloc == 0u) { xcd_barrier_complete(bar, b.x, nloc, nx); b.st[0] = nloc; b.st[1] = nx; }
        const unsigned old = xb_add(&bar[XB_XSUB(b.x)], 1u);
        const unsigned gen = old / nloc;
        if (old + 1u == (gen + 1u) * nloc) {
            __builtin_amdgcn_fence(__ATOMIC_RELEASE, "agent");
            asm volatile("s_waitcnt vmcnt(0)" ::: "memory");
            const unsigned og = xb_add(&bar[XB_TOP], 1u);
            const unsigned tg = og / nx;
            if (og + 1u == (tg + 1u) * nx) xb_add(&bar[XB_TOPGEN], 1u);
            else XB_SPIN(xb_ld(&bar[XB_TOPGEN]) == tg, bar);
            __builtin_amdgcn_fence(__ATOMIC_ACQUIRE, "agent");
            xb_add(&bar[XB_XGEN(b.x)], 1u);
            asm volatile("s_waitcnt vmcnt(0)" ::: "memory");
        } else {
            XB_SPIN(xb_ld(&bar[XB_XGEN(b.x)]) == gen, bar);
            __builtin_amdgcn_fence(__ATOMIC_ACQUIRE, "agent");
            asm volatile("s_waitcnt vmcnt(0)" ::: "memory");
        }
    }
    __syncthreads();
}


constexpr int D = 1024, NB = 8, SEQ = 4096, T = NB * SEQ, NL = 4;
constexpr int NIN = 8704, NE = 32, FF = 1024;
constexpr int RMAX = 139264;
constexpr float LN_EPS = 1e-5f, DN_ALPHA = 1.681792830507429f;
constexpr float QSCALE = 0.18033688011112042f;
constexpr float LOG2E = 1.4426950408889634f;

constexpr size_t MiB = 1u << 20;
constexpr size_t WS_CTL = 0, CTL_ZERO_BYTES = 1 * MiB;
constexpr size_t WS_MOD = 1 * MiB;
constexpr size_t WS_ROPE = 2 * MiB;
constexpr size_t WS_WSP = 3 * MiB;
constexpr size_t WS_WRT = 4 * MiB;
constexpr size_t WS_TOKINFO = 5 * MiB;
constexpr size_t WS_TOKW = 5 * MiB + 512 * 1024;
constexpr size_t WS_ROWTOK = 6 * MiB;
constexpr size_t WS_ROWW = 7 * MiB;
constexpr size_t WS_LSE = 8 * MiB;
constexpr size_t WS_WGCNT = 12 * MiB;
constexpr size_t WS_WIN = 16 * MiB;
constexpr size_t WS_WBA = 84 * MiB;
constexpr size_t WS_WBB = 92 * MiB;
constexpr size_t WS_WOUT = 96 * MiB;
constexpr size_t WS_WUP = 104 * MiB;
constexpr size_t WS_WDN = 616 * MiB;
constexpr size_t WS_H = 872 * MiB;
constexpr size_t WS_X1 = 936 * MiB;
constexpr size_t WS_X2 = 1064 * MiB;
constexpr size_t WS_YPRE = 1192 * MiB;
constexpr size_t WS_U = 1320 * MiB, WS_V = 1384 * MiB;
constexpr size_t WS_Q = 1448 * MiB, WS_K = 1544 * MiB, WS_VV = 1640 * MiB;
constexpr size_t WS_G = 1736 * MiB;
constexpr size_t WS_OG = 1864 * MiB;
constexpr size_t WS_TT = 1960 * MiB;
constexpr size_t WS_OB = 2024 * MiB;
constexpr size_t WS_YA = 2056 * MiB;
constexpr size_t WS_MG = 2120 * MiB;
constexpr size_t WS_XG = 2184 * MiB;
constexpr size_t WS_ACT = 2456 * MiB;
constexpr size_t WS_YK = 2728 * MiB;
constexpr size_t WS_END = 2984 * MiB;
constexpr int CW_BAR = 4096;
constexpr int CW_CNT = 16384;

constexpr int RING_BYTES = 131072;
constexpr int XOFF = RING_BYTES;
constexpr int X_MISC = XOFF;
constexpr int X_SELE = XOFF + 256;
constexpr int X_SELR = XOFF + 2304;
constexpr int X_CNTL = XOFF + 4352;
constexpr int X_BASE = XOFF + 4480;
constexpr int X_TILEE = XOFF + 4608;
constexpr int X_CNTS = XOFF + 5632;
constexpr int X_OFFS = XOFF + 5760;
constexpr int LDS_BYTES = 147456;

#define GAS __attribute__((address_space(1)))
typedef unsigned short bf16;
typedef unsigned v4u __attribute__((ext_vector_type(4)));
typedef unsigned v2u __attribute__((ext_vector_type(2)));
typedef float f32x4 __attribute__((ext_vector_type(4)));
typedef short bf16x8 __attribute__((ext_vector_type(8)));
typedef short s16x4 __attribute__((ext_vector_type(4)));
#define RLX_AGENT __ATOMIC_RELAXED, __HIP_MEMORY_SCOPE_AGENT
#define LDS_WAIT() asm volatile("s_waitcnt lgkmcnt(0)" ::: "memory")
#define VM_WAIT() asm volatile("s_waitcnt vmcnt(0)" ::: "memory")

typedef __bf16 bf16x2_t __attribute__((ext_vector_type(2))); typedef float f32x2_t __attribute__((ext_vector_type(2)));
__device__ __forceinline__ unsigned pk2(float lo, float hi) { return __builtin_bit_cast(unsigned, __builtin_convertvector((f32x2_t){lo, hi}, bf16x2_t)); }
__device__ __forceinline__ float bflo(unsigned w) { return __uint_as_float(w << 16); }
__device__ __forceinline__ float bfhi(unsigned w) { return __uint_as_float(w & 0xffff0000u); }
__device__ __forceinline__ float fexp2(float x) { return __builtin_amdgcn_exp2f(x); }
__device__ __forceinline__ float frcp(float x) { return __builtin_amdgcn_rcpf(x); }
__device__ __forceinline__ float gelu_tanh(float x) { const float u = x + 0.044715f * x * x * x; return x * frcp(1.0f + fexp2(-2.302208198144325f * u)); }
__device__ __forceinline__ float sigmoidf_(float x) { return frcp(1.0f + fexp2(-LOG2E * x)); }
__device__ __forceinline__ float wave_sum(float v) {
#pragma unroll
    for (int o = 1; o < 64; o <<= 1) v += __shfl_xor(v, o);
    return v;
}
__device__ __forceinline__ float wave_max(float v) {
#pragma unroll
    for (int o = 1; o < 64; o <<= 1) v = fmaxf(v, __shfl_xor(v, o));
    return v;
}
__device__ __forceinline__ s16x4 tr16(const LAS unsigned char* p) { return __builtin_bit_cast(s16x4, __builtin_amdgcn_ds_read_tr16_b64_v4i16((LAS s16x4*)p)); }
__device__ __forceinline__ bf16x8 cat8(s16x4 lo, s16x4 hi) { return (bf16x8){lo[0], lo[1], lo[2], lo[3], hi[0], hi[1], hi[2], hi[3]}; }
__device__ __forceinline__ f32x4 mfma16(bf16x8 a, bf16x8 b, f32x4 c) { return __builtin_amdgcn_mfma_f32_16x16x32_bf16(a, b, c, 0, 0, 0); }

struct Frame {
    LAS unsigned char* lds;
    int tid, lane, wave, G, vcu, bx;
    unsigned char* ws;
    const float* const* in;
    float* out;
};
enum { I_X = 0, I_C, I_WADA, I_BADA, I_WIN, I_SPW, I_SPB, I_WBA, I_WBB, I_WOUT, I_LN1G, I_LN1B, I_WR, I_BR, I_WUP, I_BUP, I_WDN, I_BDN, I_LN2G, I_LN2B };
template <class Tp> __device__ __forceinline__ Tp* wsp(const Frame& F, size_t off) { return (Tp*)(F.ws + off); }

template <class P> __device__ __forceinline__ P launder(P p) { unsigned lo = (unsigned)(uintptr_t)p, hi = (unsigned)((uintptr_t)p >> 32); asm volatile("" : "+v"(lo), "+v"(hi));
    lo = (unsigned)__builtin_amdgcn_readfirstlane((int)lo); hi = (unsigned)__builtin_amdgcn_readfirstlane((int)hi); return (P)(((uintptr_t)hi << 32) | (uintptr_t)lo); }
struct EpiIn {
    static constexpr bool PERM = true, AFTER_DRAIN = false;
    bf16 *U, *V, *Q, *K, *VV, *Gt; const float* rope;
    __device__ __forceinline__ void operator()(const f32x4 (&acc)[2][2][4][2], const pg8::Unit& u, int wr, int wc, int fr, int fq) const {
        const int pn = u.pn; int type, ld, colt; bf16* base;
        if (pn < 4) { type = 0; base = U; ld = 1024; colt = pn * 256; }
        else if (pn < 8) { type = 0; base = V; ld = 1024; colt = (pn - 4) * 256; }
        else if (pn < 14) { type = 1; base = Q; ld = 1536; colt = (pn - 8) * 256; }
        else if (pn < 20) { type = 2; base = K; ld = 1536; colt = (pn - 14) * 256; }
        else if (pn < 26) { type = 3; base = VV; ld = 1536; colt = (pn - 20) * 256; }
        else { type = 4; base = Gt; ld = 2048; colt = (pn - 26) * 256; }
        const int row0 = u.pm * 256 + wr * 64 + fr, col0 = colt + wc * 32 + 8 * fq;
        if (type == 0) {
#pragma unroll
            for (int ai = 0; ai < 2; ++ai)
#pragma unroll
                for (int m = 0; m < 4; ++m) { bf16* rowp = base + (size_t)(row0 + ai * 128 + m * 16) * ld + col0;
#pragma unroll
                    for (int bj = 0; bj < 2; ++bj) { const f32x4 v0 = acc[ai][bj][m][0], v1 = acc[ai][bj][m][1]; v4u w;
                        w.x = pk2(gelu_tanh(v0[0]), gelu_tanh(v0[1])); w.y = pk2(gelu_tanh(v0[2]), gelu_tanh(v0[3]));
                        w.z = pk2(gelu_tanh(v1[0]), gelu_tanh(v1[1])); w.w = pk2(gelu_tanh(v1[2]), gelu_tanh(v1[3]));
                        *(v4u*)(rowp + bj * 128) = w; } }
        } else if (type == 4) {
#pragma unroll
            for (int ai = 0; ai < 2; ++ai)
#pragma unroll
                for (int m = 0; m < 4; ++m) { bf16* rowp = base + (size_t)(row0 + ai * 128 + m * 16) * ld + col0;
#pragma unroll
                    for (int bj = 0; bj < 2; ++bj) { const f32x4 v0 = acc[ai][bj][m][0], v1 = acc[ai][bj][m][1]; v4u w;
                        w.x = pk2(sigmoidf_(v0[0]), sigmoidf_(v0[1])); w.y = pk2(sigmoidf_(v0[2]), sigmoidf_(v0[3]));
                        w.z = pk2(sigmoidf_(v1[0]), sigmoidf_(v1[1])); w.w = pk2(sigmoidf_(v1[2]), sigmoidf_(v1[3]));
                        *(v4u*)(rowp + bj * 128) = w; } }
        } else if (type == 3) {
#pragma unroll
            for (int ai = 0; ai < 2; ++ai)
#pragma unroll
                for (int m = 0; m < 4; ++m) { bf16* rowp = base + (size_t)(row0 + ai * 128 + m * 16) * ld + col0;
#pragma unroll
                    for (int bj = 0; bj < 2; ++bj) { const f32x4 v0 = acc[ai][bj][m][0], v1 = acc[ai][bj][m][1]; v4u w;
                        w.x = pk2(v0[0], v0[1]); w.y = pk2(v0[2], v0[3]); w.z = pk2(v1[0], v1[1]); w.w = pk2(v1[2], v1[3]);
                        *(v4u*)(rowp + bj * 128) = w; } }
        } else {
            const float sc = (type == 1) ? QSCALE : 1.0f;
            const bool ropew = (wc & 1) == 0;
#pragma unroll
            for (int ai = 0; ai < 2; ++ai)
#pragma unroll
                for (int m = 0; m < 4; ++m) { const int row = row0 + ai * 128 + m * 16; bf16* rowp = base + (size_t)row * ld + col0;
                    float cs[8], sn[8];
                    if (ropew) { const f32x4* rp = (const f32x4*)(rope + (size_t)(row & (SEQ - 1)) * 16); const f32x4 c0 = rp[0], c1 = rp[1], s0 = rp[2], s1 = rp[3];
#pragma unroll
                        for (int e = 0; e < 4; ++e) { cs[e] = c0[e]; cs[4 + e] = c1[e]; sn[e] = s0[e]; sn[4 + e] = s1[e]; } }
#pragma unroll
                    for (int bj = 0; bj < 2; ++bj) { f32x4 v0 = acc[ai][bj][m][0], v1 = acc[ai][bj][m][1];
                        if (ropew) {
#pragma unroll
                            for (int e = 0; e < 8; ++e) { const float x = (e < 4) ? v0[e & 3] : v1[e & 3]; const float p = __shfl_xor(x, 16);
                                float y = x;
                                if (fq == 0) y = x * cs[e] - p * sn[e];
                                if (fq == 1) y = x * cs[e] + p * sn[e];
                                if (e < 4) v0[e & 3] = y; else v1[e & 3] = y; } }
                        v4u w; w.x = pk2(v0[0] * sc, v0[1] * sc); w.y = pk2(v0[2] * sc, v0[3] * sc); w.z = pk2(v1[0] * sc, v1[1] * sc); w.w = pk2(v1[2] * sc, v1[3] * sc);
                        *(v4u*)(rowp + bj * 128) = w; } }
        }
    }
};
struct EpiYA {
    static constexpr bool PERM = true, AFTER_DRAIN = false;
    const bf16* Gt; bf16* YA;
    __device__ __forceinline__ void operator()(const f32x4 (&acc)[2][2][4][2], const pg8::Unit& u, int wr, int wc, int fr, int fq) const {
        const int row0 = u.pm * 256 + wr * 64 + fr, col0 = u.pn * 256 + wc * 32 + 8 * fq;
#pragma unroll
        for (int ai = 0; ai < 2; ++ai)
#pragma unroll
            for (int m = 0; m < 4; ++m) { const size_t row = (size_t)(row0 + ai * 128 + m * 16);
#pragma unroll
                for (int bj = 0; bj < 2; ++bj) { const f32x4 v0 = acc[ai][bj][m][0], v1 = acc[ai][bj][m][1];
                    const v4u g = *(const v4u*)(Gt + row * 2048 + col0 + bj * 128); v4u w;
                    w.x = pk2(v0[0] * bflo(g.x), v0[1] * bfhi(g.x)); w.y = pk2(v0[2] * bflo(g.y), v0[3] * bfhi(g.y));
                    w.z = pk2(v1[0] * bflo(g.z), v1[1] * bfhi(g.z)); w.w = pk2(v1[2] * bflo(g.w), v1[3] * bfhi(g.w));
                    *(v4u*)(YA + row * 1024 + col0 + bj * 128) = w; }
                asm volatile("" ::: "memory"); }
    }
};
struct EpiMg {
    static constexpr bool PERM = true, AFTER_DRAIN = false;
    const bf16* Gt; const bf16* YA; bf16* MG;
    __device__ __forceinline__ void operator()(const f32x4 (&acc)[2][2][4][2], const pg8::Unit& u, int wr, int wc, int fr, int fq) const {
        const int row0 = u.pm * 256 + wr * 64 + fr, col0 = u.pn * 256 + wc * 32 + 8 * fq;
#pragma unroll
        for (int ai = 0; ai < 2; ++ai)
#pragma unroll
            for (int m = 0; m < 4; ++m) { const size_t row = (size_t)(row0 + ai * 128 + m * 16);
#pragma unroll
                for (int bj = 0; bj < 2; ++bj) { const f32x4 v0 = acc[ai][bj][m][0], v1 = acc[ai][bj][m][1];
                    const v4u g = *(const v4u*)(Gt + row * 2048 + 1024 + col0 + bj * 128); const v4u y = *(const v4u*)(YA + row * 1024 + col0 + bj * 128); v4u w;
                    w.x = pk2(bflo(y.x) + v0[0] * bflo(g.x), bfhi(y.x) + v0[1] * bfhi(g.x)); w.y = pk2(bflo(y.y) + v0[2] * bflo(g.y), bfhi(y.y) + v0[3] * bfhi(g.y));
                    w.z = pk2(bflo(y.z) + v1[0] * bflo(g.z), bfhi(y.z) + v1[1] * bfhi(g.z)); w.w = pk2(bflo(y.w) + v1[2] * bflo(g.w), bfhi(y.w) + v1[3] * bfhi(g.w));
                    *(v4u*)(MG + row * 1024 + col0 + bj * 128) = w; }
                asm volatile("" ::: "memory"); }
    }
};
struct EpiOut {
    static constexpr bool PERM = false, AFTER_DRAIN = false;
    const float* xres; const float* modl  ; float* YPRE;
    __device__ __forceinline__ void operator()(const f32x4 (&acc)[2][2][4][2], const pg8::Unit& u, int wr, int wc, int fr, int fq) const {
        const int row0 = u.pm * 256 + wr * 64 + fr, col0 = u.pn * 256 + wc * 32 + 4 * fq; const int b = (u.pm * 256) >> 12;
        f32x4 gg[2][2];
#pragma unroll
        for (int bj = 0; bj < 2; ++bj)
#pragma unroll
            for (int n = 0; n < 2; ++n) gg[bj][n] = *(const f32x4*)(modl + (size_t)b * 6144 + 2048 + col0 + bj * 128 + n * 16) + 1.0f;
#pragma unroll
        for (int ai = 0; ai < 2; ++ai)
#pragma unroll
            for (int m = 0; m < 4; ++m) { const size_t off = (size_t)(row0 + ai * 128 + m * 16) * 1024 + col0;
#pragma unroll
                for (int bj = 0; bj < 2; ++bj)
#pragma unroll
                    for (int n = 0; n < 2; ++n) { const f32x4 xr = *(const f32x4*)(xres + off + bj * 128 + n * 16);
                        *(f32x4*)(YPRE + off + bj * 128 + n * 16) = xr * DN_ALPHA + gg[bj][n] * acc[ai][bj][m][n]; }
                asm volatile("" ::: "memory"); }
    }
};
struct EpiUp {
    static constexpr bool PERM = true, AFTER_DRAIN = false;
    const float* bup  ; bf16* ACT;
    __device__ __forceinline__ void operator()(const f32x4 (&acc)[2][2][4][2], const pg8::Unit& u, int wr, int wc, int fr, int fq) const {
        const int e = u.pn >> 3, pnl = u.pn & 7; const int row0 = u.pm * 256 + wr * 64 + fr, ac0 = pnl * 128 + wc * 32 + 8 * fq;
        const f32x4* bp = (const f32x4*)(bup + (size_t)e * 2048 + 2 * ac0); const f32x4 b0 = bp[0], b1 = bp[1], b2 = bp[2], b3 = bp[3];
        const float bg[8] = {b0[0], b0[2], b1[0], b1[2], b2[0], b2[2], b3[0], b3[2]}, bl[8] = {b0[1], b0[3], b1[1], b1[3], b2[1], b2[3], b3[1], b3[3]};
#pragma unroll
        for (int ai = 0; ai < 2; ++ai)
#pragma unroll
            for (int m = 0; m < 4; ++m) { float a[8];
#pragma unroll
                for (int j = 0; j < 8; ++j) { const float hg = acc[ai][0][m][j >> 2][j & 3] + bg[j], hl = acc[ai][1][m][j >> 2][j & 3] + bl[j];
                    const float glu = fminf(hg, 7.0f), lin = fminf(fmaxf(hl, -7.0f), 7.0f);
                    a[j] = glu * frcp(1.0f + fexp2(-2.4554669595930156f * glu)) * (lin + 1.0f); }
                v4u w; w.x = pk2(a[0], a[1]); w.y = pk2(a[2], a[3]); w.z = pk2(a[4], a[5]); w.w = pk2(a[6], a[7]);
                *(v4u*)(ACT + (size_t)(row0 + ai * 128 + m * 16) * 1024 + ac0) = w; }
    }
};
struct EpiDn {
    static constexpr bool PERM = true, AFTER_DRAIN = false;
    const float* bdn  ; const int* rowtok; const float* roww; bf16* YK; const LAS int* cnt_s; const LAS int* off_s;
    __device__ __forceinline__ void operator()(const f32x4 (&acc)[2][2][4][2], const pg8::Unit& u, int wr, int wc, int fr, int fq) const {
        const int e = u.pn >> 2, pnl = u.pn & 3; const int row0 = u.pm * 256 + wr * 64 + fr, col0 = pnl * 256 + wc * 32 + 8 * fq;
        const int rend = off_s[e] + cnt_s[e];
        f32x4 bv[2][2];
#pragma unroll
        for (int bj = 0; bj < 2; ++bj)
#pragma unroll
            for (int n = 0; n < 2; ++n) bv[bj][n] = *(const f32x4*)(bdn + (size_t)e * 1024 + col0 + bj * 128 + 4 * n);
#pragma unroll
        for (int ai = 0; ai < 2; ++ai)
#pragma unroll
            for (int m = 0; m < 4; ++m) { const int row = row0 + ai * 128 + m * 16;
                if (row < rend) { const int tk = rowtok[row]; const float wt = roww[row]; bf16* op = YK + (size_t)tk * 1024 + col0;
#pragma unroll
                    for (int bj = 0; bj < 2; ++bj) { const f32x4 v0 = (acc[ai][bj][m][0] + bv[bj][0]) * wt, v1 = (acc[ai][bj][m][1] + bv[bj][1]) * wt; v4u w;
                        w.x = pk2(v0[0], v0[1]); w.y = pk2(v0[2], v0[3]); w.z = pk2(v1[0], v1[1]); w.w = pk2(v1[2], v1[3]);
                        *(v4u*)(op + bj * 128) = w; } }
                asm volatile("" ::: "memory"); }
    }
};
struct MoeOrder {
    int nM, nN, nwg, G, c; const LAS unsigned char* tile_e;
    __device__ void init(int RT, int NN, int G_, int c_, const LAS unsigned char* te) { nM = RT; nN = NN; nwg = RT * NN; G = G_; c = c_; tile_e = te; }
    __device__ bool next(int i, pg8::Unit& u) const {
        const long L = (long)i * G + c; if (L >= nwg) return false;
        int wgid = (int)L; { const int q = nwg / pg8::NXCD, r = nwg % pg8::NXCD, xcd = wgid % pg8::NXCD, off = wgid / pg8::NXCD; wgid = (xcd < r ? xcd * (q + 1) : r * (q + 1) + (xcd - r) * q) + off; }
        const int nig = pg8::WGM * nN, gid = wgid / nig, fm = gid * pg8::WGM, gsz = (nM - fm) < pg8::WGM ? (nM - fm) : pg8::WGM;
        const int pm = fm + ((wgid % nig) % gsz), pnl = (wgid % nig) / gsz;
        u.pm = pm; u.pn = (int)tile_e[pm] * nN + pnl; return true;
    }
    __device__ __forceinline__ void a_ready(const pg8::Unit&) const {}
    __device__ __forceinline__ void done(const pg8::Unit&) const {}
};

__device__ __forceinline__ void tr_item(const float* W, int N, int K, bf16* WT, LAS float* scr, int kb, int nb, int lane) {
    const int k0 = 64 * kb, n0 = 32 * nb;
#pragma unroll 8
    for (int i = 0; i < 32; ++i) { const int kk = 2 * i + (lane >> 5); scr[kk * 33 + (lane & 31)] = W[(size_t)(k0 + kk) * N + n0 + (lane & 31)]; }
    LDS_WAIT(); asm volatile("" ::: "memory");
    const int c = lane & 7;
#pragma unroll
    for (int j = 0; j < 4; ++j) { const int n = (lane >> 3) + 8 * j; const LAS float* s = scr + (8 * c) * 33 + n;
        v4u o; o.x = pk2(s[0 * 33], s[1 * 33]); o.y = pk2(s[2 * 33], s[3 * 33]); o.z = pk2(s[4 * 33], s[5 * 33]); o.w = pk2(s[6 * 33], s[7 * 33]);
        *(v4u*)(WT + (size_t)(n0 + n) * K + k0 + 8 * c) = o; }
    LDS_WAIT(); asm volatile("" ::: "memory");
}
__device__ __forceinline__ void tr_item_up(const float* W, bf16* WT, LAS float* scr, int kb, int cb, int lane) {
    const int k0 = 32 * kb, c0 = 64 * cb, p = cb >> 2, x0 = 32 * (cb & 3);
#pragma unroll 8
    for (int i = 0; i < 32; ++i) scr[i * 65 + lane] = W[(size_t)(k0 + i) * 2048 + c0 + lane];
    LDS_WAIT(); asm volatile("" ::: "memory");
    const int c = lane & 3;
#pragma unroll
    for (int j = 0; j < 4; ++j) { const int rr = (lane >> 2) + 16 * j, bj = rr >> 5, x = rr & 31; const LAS float* s = scr + (8 * c) * 65 + 2 * x + bj;
        v4u o; o.x = pk2(s[0 * 65], s[1 * 65]); o.y = pk2(s[2 * 65], s[3 * 65]); o.z = pk2(s[4 * 65], s[5 * 65]); o.w = pk2(s[6 * 65], s[7 * 65]);
        *(v4u*)(WT + (size_t)(256 * p + 128 * bj + x0 + x) * 1024 + k0 + 8 * c) = o; }
    LDS_WAIT(); asm volatile("" ::: "memory");
}
__device__ __forceinline__ void sincos_d(double a, double& s, double& c) {
    const double k = rint(a * 0.63661977236758134308);
    const double y = fma(-k, 6.12323399573676603587e-17, fma(-k, 1.57079632679489655800, a));
    const double y2 = y * y;
    double sp = -7.6471637318198164759e-13; sp = fma(sp, y2, 1.6059043836821614599e-10); sp = fma(sp, y2, -2.5052108385441718775e-8); sp = fma(sp, y2, 2.7557319223985890653e-6);
    sp = fma(sp, y2, -1.9841269841269841270e-4); sp = fma(sp, y2, 8.3333333333333333333e-3); sp = fma(sp, y2, -1.6666666666666666667e-1); const double sy = fma(sp * y2, y, y);
    double cp = 4.7794773323873852974e-14; cp = fma(cp, y2, -1.1470745597729724714e-11); cp = fma(cp, y2, 2.0876756987868098979e-9); cp = fma(cp, y2, -2.7557319223985890653e-7);
    cp = fma(cp, y2, 2.4801587301587301587e-5); cp = fma(cp, y2, -1.3888888888888888889e-3); cp = fma(cp, y2, 4.1666666666666666667e-2); cp = fma(cp, y2, -0.5); const double cy = fma(cp, y2, 1.0);
    const int q = ((int)k) & 3;
    s = (q == 0) ? sy : (q == 1) ? cy : (q == 2) ? -sy : -cy;
    c = (q == 0) ? cy : (q == 1) ? -sy : (q == 2) ? -cy : sy;
}
__device__ __forceinline__ void phase_pro_a(Frame& F) {
    LAS float* scr = (LAS float*)(F.lds + F.wave * 16384);
    const int gw = F.vcu * 8 + F.wave, NGW = F.G * 8;
    constexpr int I_IN = 16 * 272, I_SQ = 16 * 32, I_BB = 8 * 32, I_UP = 32 * 32;
    constexpr int S0 = NL * I_IN, S1 = S0 + NL * I_SQ, S2 = S1 + NL * I_BB, S3 = S2 + NL * I_SQ, S4 = S3 + NL * NE * I_SQ, S5 = S4 + NL * NE * I_UP;
    for (int it = gw; it < S5; it += NGW) {
        if (it < S0) { const int l = it / I_IN, r = it % I_IN; tr_item(F.in[I_WIN] + (size_t)l * D * NIN, NIN, D, wsp<bf16>(F, WS_WIN) + (size_t)l * NIN * D, scr, r / 272, r % 272, F.lane); }
        else if (it < S1) { const int q = it - S0, l = q / I_SQ, r = q % I_SQ; tr_item(F.in[I_WBA] + (size_t)l * D * D, D, D, wsp<bf16>(F, WS_WBA) + (size_t)l * D * D, scr, r / 32, r % 32, F.lane); }
        else if (it < S2) { const int q = it - S1, l = q / I_BB, r = q % I_BB; tr_item(F.in[I_WBB] + (size_t)l * 512 * D, D, 512, wsp<bf16>(F, WS_WBB) + (size_t)l * D * 512, scr, r / 32, r % 32, F.lane); }
        else if (it < S3) { const int q = it - S2, l = q / I_SQ, r = q % I_SQ; tr_item(F.in[I_WOUT] + (size_t)l * D * D, D, D, wsp<bf16>(F, WS_WOUT) + (size_t)l * D * D, scr, r / 32, r % 32, F.lane); }
        else if (it < S4) { const int q = it - S3, le = q / I_SQ, r = q % I_SQ; tr_item(F.in[I_WDN] + (size_t)le * FF * D, D, FF, wsp<bf16>(F, WS_WDN) + (size_t)le * D * FF, scr, r / 32, r % 32, F.lane); }
        else { const int q = it - S4, le = q / I_UP, r = q % I_UP; tr_item_up(F.in[I_WUP] + (size_t)le * D * 2048, wsp<bf16>(F, WS_WUP) + (size_t)le * 2048 * D, scr, r / 32, r % 32, F.lane); }
    }
    __syncthreads();
    {
        LAS float* red = (LAS float*)F.lds;
        const float* cv = F.in[I_C];
        for (int u = F.vcu; u < NL * 96; u += F.G) {
            const int l = u / 96, n0 = 64 * (u % 96);
            float a[8];
#pragma unroll
            for (int b = 0; b < 8; ++b) a[b] = 0.f;
            const float* wp = F.in[I_WADA] + (size_t)l * D * 6144 + (size_t)(F.wave * 128) * 6144 + n0 + F.lane;
#pragma unroll 4
            for (int kk = 0; kk < 128; ++kk) { const float w = wp[(size_t)kk * 6144]; const int k = F.wave * 128 + kk;
#pragma unroll
                for (int b = 0; b < 8; ++b) a[b] += cv[b * 1024 + k] * w; }
#pragma unroll
            for (int b = 0; b < 8; ++b) red[(F.wave * 8 + b) * 64 + F.lane] = a[b];
            __syncthreads();
            { const int b = F.tid >> 6, ln = F.tid & 63; float s = F.in[I_BADA][l * 6144 + n0 + ln];
#pragma unroll
              for (int w = 0; w < 8; ++w) s += red[(w * 8 + b) * 64 + ln];
              wsp<float>(F, WS_MOD)[(size_t)(l * 8 + b) * 6144 + n0 + ln] = s; }
            __syncthreads();
        }
    }
    const int gt = F.vcu * 512 + F.tid, NT = F.G * 512;
    for (int i = gt; i < SEQ * 8; i += NT) { const int pos = i >> 3, f = i & 7;
        const double inv = (f == 0) ? 1.0 : (f == 1) ? 0.19392274474868576 : (f == 2) ? 0.03760603093086393 : (f == 3) ? 0.007292664737217109 : (f == 4) ? 0.001414213562373095 : (f == 5) ? 0.0002742481756762073 : (f == 6) ? 5.318295896944988e-05 : 1.031338537721246e-05;
        double s, c; sincos_d((double)pos * inv, s, c);
        float* rp = wsp<float>(F, WS_ROPE) + (size_t)pos * 16; rp[f] = (float)c; rp[8 + f] = (float)s; }
    for (int i = gt; i < NL * 4 * 128 * 128; i += NT) { const int j = i & 127, ii = (i >> 7) & 127; const float w = F.in[I_SPW][i];
        wsp<bf16>(F, WS_WSP)[i] = (bf16)(pk2((j <= ii) ? w : 0.f, 0.f) & 0xffffu); }
    for (int i = gt; i < NL * NE * D; i += NT) { const int k = i & 1023, e = (i >> 10) & 31, l = i >> 15; wsp<float>(F, WS_WRT)[i] = F.in[I_WR][((size_t)l * D + k) * NE + e]; }
}
__device__ __forceinline__ void phase_pro_b(Frame& F) {
    const int gw = F.vcu * 8 + F.wave, NGW = F.G * 8;
    const float* mod = wsp<float>(F, WS_MOD);
    for (int m = gw; m < T; m += NGW) { const int b = m >> 12; const float* mb = mod + (size_t)b * 6144;
        const f32x4* xr = (const f32x4*)(F.in[I_X] + (size_t)m * D) + F.lane; v2u* hp = (v2u*)(wsp<bf16>(F, WS_H) + (size_t)m * D) + F.lane;
#pragma unroll
        for (int j = 0; j < 4; ++j) { const f32x4 x = xr[64 * j]; const f32x4 sh = *((const f32x4*)mb + F.lane + 64 * j), sc = *((const f32x4*)(mb + 1024) + F.lane + 64 * j);
            const f32x4 h = x * (sc + 1.0f) + sh; v2u o; o.x = pk2(h[0], h[1]); o.y = pk2(h[2], h[3]); hp[64 * j] = o; } }
}

constexpr int AT_RS = 144;
constexpr int AT_ROWS = 272, AT_VOFF = AT_ROWS * AT_RS;
__device__ __forceinline__ void phase_attn(Frame& F) {
    const bf16* Qb = wsp<bf16>(F, WS_Q); const bf16* Kb = wsp<bf16>(F, WS_K); const bf16* Vb = wsp<bf16>(F, WS_VV);
    bf16* OG = wsp<bf16>(F, WS_OG); float* LSE = wsp<float>(F, WS_LSE);
    LAS unsigned char* Ks = F.lds; LAS unsigned char* Vs = F.lds + AT_VOFF;
    const int qi = F.lane & 15, g4 = F.lane >> 4;
    if (F.tid < 144) { *(LAS v4u*)(Ks + 256 * AT_RS + F.tid * 16) = (v4u){0u, 0u, 0u, 0u}; *(LAS v4u*)(Vs + 256 * AT_RS + F.tid * 16) = (v4u){0u, 0u, 0u, 0u}; }
    for (int u = F.vcu; u < 3 * 2048; u += F.G) {
        const int g = u >> 11, rem = u & 2047, b = rem >> 8, h = (rem >> 5) & 7, rn = rem & 31;
        const int dsh = 2 * g, d = 1 << dsh, nbs = 5 - dsh;
        const int r = rn >> nbs, n = rn & ((1 << nbs) - 1);
        const size_t hoff = (size_t)g * 512 + h * 64;
        { const int piece = F.tid & 7, jr = F.tid >> 3;
#pragma unroll
          for (int ps = 0; ps < 4; ++ps) { const int j = ps * 64 + jr; const int lp = 128 * (n - 1) + j; v4u kv = (v4u){0u, 0u, 0u, 0u}, vv = kv;
              if (lp >= 0) { const size_t off = ((size_t)b * SEQ + (size_t)lp * d + r) * 1536 + hoff + piece * 8; kv = *(const v4u*)(Kb + off); vv = *(const v4u*)(Vb + off); }
              *(LAS v4u*)(Ks + j * AT_RS + piece * 16) = kv; *(LAS v4u*)(Vs + j * AT_RS + piece * 16) = vv; } }
        __syncthreads();
        {
            const int iq = 16 * F.wave + qi; const size_t qrow = (size_t)b * SEQ + (size_t)(128 * n + iq) * d + r;
            const bf16* qp = Qb + qrow * 1536 + hoff + 8 * g4;
            const bf16x8 qf0 = *(const bf16x8*)qp, qf1 = *(const bf16x8*)(qp + 32);
            f32x4 s[10]; float mx = -1e30f;
#pragma unroll
            for (int st = 0; st < 10; ++st) {
                const LAS unsigned char* kp = Ks + (16 * F.wave + 16 * st + qi) * AT_RS + g4 * 16;
                const bf16x8 k0 = *(const LAS bf16x8*)kp, k1 = *(const LAS bf16x8*)(kp + 64);
                f32x4 a = (f32x4){0.f, 0.f, 0.f, 0.f};
                a = mfma16(k0, qf0, a); a = mfma16(k1, qf1, a);
#pragma unroll
                for (int i = 0; i < 4; ++i) { const int j = 16 * F.wave + 16 * st + 4 * g4 + i, diff = 128 + iq - j;
                    const bool ok = (diff >= 0) && (diff <= 128) && (n > 0 || j >= 128);
                    a[i] = ok ? a[i] : -1e30f; mx = fmaxf(mx, a[i]); }
                s[st] = a;
            }
            mx = fmaxf(mx, __shfl_xor(mx, 16)); mx = fmaxf(mx, __shfl_xor(mx, 32));
            float sum = 0.f;
#pragma unroll
            for (int st = 0; st < 10; ++st)
#pragma unroll
                for (int i = 0; i < 4; ++i) { const float p = fexp2(s[st][i] - mx); s[st][i] = p; sum += p; }
            sum += __shfl_xor(sum, 16); sum += __shfl_xor(sum, 32);
            f32x4 o[4];
#pragma unroll
            for (int dt = 0; dt < 4; ++dt) o[dt] = (f32x4){0.f, 0.f, 0.f, 0.f};
#pragma unroll
            for (int c = 0; c < 5; ++c) {
                v4u pw; pw.x = pk2(s[2 * c][0], s[2 * c][1]); pw.y = pk2(s[2 * c][2], s[2 * c][3]); pw.z = pk2(s[2 * c + 1][0], s[2 * c + 1][1]); pw.w = pk2(s[2 * c + 1][2], s[2 * c + 1][3]);
                const bf16x8 pf = __builtin_bit_cast(bf16x8, pw);
                const LAS unsigned char* vp = Vs + (16 * F.wave + 32 * c + 4 * g4 + (qi >> 2)) * AT_RS + 8 * (qi & 3);
#pragma unroll
                for (int dt = 0; dt < 4; ++dt) { const s16x4 lo = tr16(vp + 32 * dt), hi = tr16(vp + 32 * dt + 16 * AT_RS);
                    o[dt] = mfma16(cat8(lo, hi), pf, o[dt]); }
            }
            const float inv = 1.0f / sum;
            bf16* op = OG + ((size_t)g * T + qrow) * 512 + h * 64 + 4 * g4;
#pragma unroll
            for (int dt = 0; dt < 4; ++dt) { v2u w; w.x = pk2(o[dt][0] * inv, o[dt][1] * inv); w.y = pk2(o[dt][2] * inv, o[dt][3] * inv); *(v2u*)(op + 16 * dt) = w; }
            if (g4 == 0) LSE[((size_t)g * T + qrow) * 8 + h] = mx + __log2f(sum);
        }
        __syncthreads();
    }
}

constexpr int SG_RS = 528;
__device__ __forceinline__ void phase_sg(Frame& F, int l) {
    const bf16* Ub = wsp<bf16>(F, WS_U); const bf16* Vb = wsp<bf16>(F, WS_V); bf16* TT = wsp<bf16>(F, WS_TT);
    const bf16* OG = wsp<bf16>(F, WS_OG); const float* LSE = wsp<float>(F, WS_LSE); bf16* OB = wsp<bf16>(F, WS_OB);
    const bf16* Wsp = wsp<bf16>(F, WS_WSP); const float* spb = F.in[I_SPB];
    LAS unsigned char* Vn = F.lds;
    const int qi = F.lane & 15, g4 = F.lane >> 4;
    for (int u = F.vcu; u < 1024; u += F.G) {
        const int gi = u & 3, m0 = (u >> 2) * 128;
        { const int l32 = F.lane & 31;
#pragma unroll
          for (int ps = 0; ps < 8; ++ps) { const int j = 16 * ps + 2 * F.wave + (F.lane >> 5);
              const v4u raw = *(const v4u*)(Vb + (size_t)(m0 + j) * 1024 + gi * 256 + 8 * l32);
              float x[8] = {bflo(raw.x), bfhi(raw.x), bflo(raw.y), bfhi(raw.y), bflo(raw.z), bfhi(raw.z), bflo(raw.w), bfhi(raw.w)};
              float sm = 0.f;
#pragma unroll
              for (int e = 0; e < 8; ++e) sm += x[e];
#pragma unroll
              for (int o = 1; o < 32; o <<= 1) sm += __shfl_xor(sm, o);
              const float mean = sm * (1.0f / 256.0f); float q = 0.f;
#pragma unroll
              for (int e = 0; e < 8; ++e) { x[e] -= mean; q += x[e] * x[e]; }
#pragma unroll
              for (int o = 1; o < 32; o <<= 1) q += __shfl_xor(q, o);
              const float rstd = 1.0f / sqrtf(q * (1.0f / 256.0f) + LN_EPS);
              v4u w; w.x = pk2(x[0] * rstd, x[1] * rstd); w.y = pk2(x[2] * rstd, x[3] * rstd); w.z = pk2(x[4] * rstd, x[5] * rstd); w.w = pk2(x[6] * rstd, x[7] * rstd);
              *(LAS v4u*)(Vn + j * SG_RS + l32 * 16) = w; } }
        __syncthreads();
        {
            f32x4 acc[2][8];
#pragma unroll
            for (int ct = 0; ct < 2; ++ct)
#pragma unroll
                for (int it = 0; it < 8; ++it) acc[ct][it] = (f32x4){0.f, 0.f, 0.f, 0.f};
            const bf16* wbase = Wsp + (size_t)(l * 4 + gi) * 128 * 128 + (size_t)qi * 128 + 4 * g4;
#pragma unroll
            for (int kc = 0; kc < 4; ++kc) {
                bf16x8 af[2];
#pragma unroll
                for (int ct = 0; ct < 2; ++ct) { const LAS unsigned char* p = Vn + (32 * kc + 4 * g4 + (qi >> 2)) * SG_RS + (32 * F.wave + 16 * ct + 4 * (qi & 3)) * 2;
                    af[ct] = cat8(tr16(p), tr16(p + 16 * SG_RS)); }
#pragma unroll
                for (int it = 0; it < 8; ++it) if (it >= 2 * kc) {
                    const bf16* wp = wbase + (size_t)(16 * it) * 128 + 32 * kc;
                    const v2u b0 = *(const v2u*)wp, b1 = *(const v2u*)(wp + 16);
                    const bf16x8 bfr = __builtin_bit_cast(bf16x8, (v4u){b0.x, b0.y, b1.x, b1.y});
                    acc[0][it] = mfma16(af[0], bfr, acc[0][it]); acc[1][it] = mfma16(af[1], bfr, acc[1][it]); }
            }
#pragma unroll
            for (int it = 0; it < 8; ++it) { const int i = 16 * it + qi; const float bias = spb[(l * 4 + gi) * 128 + i]; const size_t rowo = (size_t)(m0 + i) * 1024 + gi * 256 + 32 * F.wave + 4 * g4;
#pragma unroll
                for (int ct = 0; ct < 2; ++ct) { const v2u uu = *(const v2u*)(Ub + rowo + 16 * ct); const f32x4 a = acc[ct][it]; v2u w;
                    w.x = pk2(bflo(uu.x) * (a[0] + bias), bfhi(uu.x) * (a[1] + bias)); w.y = pk2(bflo(uu.y) * (a[2] + bias), bfhi(uu.y) * (a[3] + bias));
                    *(v2u*)(TT + rowo + 16 * ct) = w; } }
        }
        { const int sub = F.tid & 7;
#pragma unroll
          for (int ps = 0; ps < 4; ++ps) { const int p = (F.tid >> 3) + 64 * ps; const size_t tok = (size_t)m0 + (p >> 1); const int hd = 2 * gi + (p & 1);
              const float l0 = LSE[(0 * (size_t)T + tok) * 8 + hd], l1 = LSE[(1 * (size_t)T + tok) * 8 + hd], l2 = LSE[(2 * (size_t)T + tok) * 8 + hd];
              const float mxx = fmaxf(l0, fmaxf(l1, l2)); float w0 = fexp2(l0 - mxx), w1 = fexp2(l1 - mxx), w2 = fexp2(l2 - mxx); const float inv = 1.0f / (w0 + w1 + w2); w0 *= inv; w1 *= inv; w2 *= inv;
              const size_t off = tok * 512 + hd * 64 + 8 * sub;
              const v4u a = *(const v4u*)(OG + off), bq = *(const v4u*)(OG + (size_t)T * 512 + off), cq = *(const v4u*)(OG + 2 * (size_t)T * 512 + off); v4u w;
              w.x = pk2(w0 * bflo(a.x) + w1 * bflo(bq.x) + w2 * bflo(cq.x), w0 * bfhi(a.x) + w1 * bfhi(bq.x) + w2 * bfhi(cq.x));
              w.y = pk2(w0 * bflo(a.y) + w1 * bflo(bq.y) + w2 * bflo(cq.y), w0 * bfhi(a.y) + w1 * bfhi(bq.y) + w2 * bfhi(cq.y));
              w.z = pk2(w0 * bflo(a.z) + w1 * bflo(bq.z) + w2 * bflo(cq.z), w0 * bfhi(a.z) + w1 * bfhi(bq.z) + w2 * bfhi(cq.z));
              w.w = pk2(w0 * bflo(a.w) + w1 * bflo(bq.w) + w2 * bflo(cq.w), w0 * bfhi(a.w) + w1 * bfhi(bq.w) + w2 * bfhi(cq.w));
              *(v4u*)(OB + off) = w; } }
        __syncthreads();
    }
}

__device__ __forceinline__ void phase_ln1(Frame& F, int l) {
    const float* YPRE = wsp<float>(F, WS_YPRE); float* X1 = wsp<float>(F, WS_X1); bf16* H = wsp<bf16>(F, WS_H);
    const float* modl = wsp<float>(F, WS_MOD) + (size_t)l * 8 * 6144;
    const float* lg = F.in[I_LN1G] + l * D; const float* lb = F.in[I_LN1B] + l * D; const float* br = F.in[I_BR] + l * NE;
    int* TOKINFO = wsp<int>(F, WS_TOKINFO); float* TOKW = wsp<float>(F, WS_TOKW);
    unsigned* cntg = wsp<unsigned>(F, WS_CTL) + CW_CNT + (size_t)l * NE * 64;
    LAS float* wl = (LAS float*)F.lds;
    LAS int* sel_e = (LAS int*)(F.lds + X_SELE); LAS int* sel_r = (LAS int*)(F.lds + X_SELR); LAS int* cnt_l = (LAS int*)(F.lds + X_CNTL); LAS int* base_l = (LAS int*)(F.lds + X_BASE);
    { const v4u* src = (const v4u*)(wsp<float>(F, WS_WRT) + (size_t)l * NE * D);
#pragma unroll 4
      for (int i = F.tid; i < NE * D / 4; i += 512) *((LAS v4u*)wl + i) = src[i]; }
    const int lane = F.lane;
    const float brv = br[lane >> 1];
    for (int tb = F.vcu; tb < T / 128; tb += F.G) {
        const int m0 = tb * 128; const int b = m0 >> 12; const float* mb = modl + (size_t)b * 6144;
        if (F.tid < 32) cnt_l[F.tid] = 0;
        __syncthreads();
        for (int rp = 0; rp < 8; ++rp) {
            asm volatile("" ::: "memory");
            f32x4 hh[2][4]; float mean[2], rstd[2];
            const int mrow = m0 + 16 * F.wave + 2 * rp;
#pragma unroll
            for (int r = 0; r < 2; ++r) { const f32x4* yr = (const f32x4*)(YPRE + (size_t)(mrow + r) * D) + lane; float s = 0.f;
#pragma unroll
                for (int j = 0; j < 4; ++j) { hh[r][j] = yr[64 * j]; s += (hh[r][j][0] + hh[r][j][1]) + (hh[r][j][2] + hh[r][j][3]); }
                mean[r] = wave_sum(s) * (1.0f / D); float s2 = 0.f;
#pragma unroll
                for (int j = 0; j < 4; ++j) { const f32x4 dv = hh[r][j] - mean[r]; s2 += (dv[0] * dv[0] + dv[1] * dv[1]) + (dv[2] * dv[2] + dv[3] * dv[3]); }
                rstd[r] = 1.0f / sqrtf(wave_sum(s2) * (1.0f / D) + LN_EPS); }
#pragma unroll
            for (int j = 0; j < 4; ++j) { const f32x4 gq = *((const f32x4*)lg + lane + 64 * j), bq = *((const f32x4*)lb + lane + 64 * j);
                const f32x4 shq = *((const f32x4*)(mb + 3072) + lane + 64 * j), scq = *((const f32x4*)(mb + 4096) + lane + 64 * j) + 1.0f;
#pragma unroll
                for (int r = 0; r < 2; ++r) { const f32x4 x1 = (hh[r][j] - mean[r]) * rstd[r] * gq + bq; *((f32x4*)(X1 + (size_t)(mrow + r) * D) + lane + 64 * j) = x1;
                    const f32x4 h2 = x1 * scq + shq; hh[r][j] = h2; v2u o; o.x = pk2(h2[0], h2[1]); o.y = pk2(h2[2], h2[3]); *((v2u*)(H + (size_t)(mrow + r) * D) + lane + 64 * j) = o; } }
            float p0[32], p1[32];
#pragma unroll
            for (int e = 0; e < 32; ++e) { float a0 = 0.f, a1 = 0.f;
#pragma unroll
                for (int j = 0; j < 4; ++j) { const f32x4 w = *((const LAS f32x4*)(wl + e * 1024) + lane + 64 * j);
                    a0 += hh[0][j][0] * w[0] + hh[0][j][1] * w[1] + hh[0][j][2] * w[2] + hh[0][j][3] * w[3];
                    a1 += hh[1][j][0] * w[0] + hh[1][j][1] * w[1] + hh[1][j][2] * w[2] + hh[1][j][3] * w[3]; }
                asm volatile("" : "+v"(a0), "+v"(a1));
                p0[e] = a0; p1[e] = a1; }
#pragma unroll
            for (int r = 0; r < 2; ++r) {
                float a16[16], a8[8], a4[4], a2[2];
                const bool h5 = lane & 32, h4 = lane & 16, h3 = lane & 8, h2b = lane & 4, h1 = lane & 2;
#pragma unroll
                for (int i = 0; i < 16; ++i) { const float lo = r ? p1[i] : p0[i], hi = r ? p1[i + 16] : p0[i + 16]; a16[i] = (h5 ? hi : lo) + __shfl_xor(h5 ? lo : hi, 32); }
#pragma unroll
                for (int i = 0; i < 8; ++i) a8[i] = (h4 ? a16[i + 8] : a16[i]) + __shfl_xor(h4 ? a16[i] : a16[i + 8], 16);
#pragma unroll
                for (int i = 0; i < 4; ++i) a4[i] = (h3 ? a8[i + 4] : a8[i]) + __shfl_xor(h3 ? a8[i] : a8[i + 4], 8);
#pragma unroll
                for (int i = 0; i < 2; ++i) a2[i] = (h2b ? a4[i + 2] : a4[i]) + __shfl_xor(h2b ? a4[i] : a4[i + 2], 4);
                float val = (h1 ? a2[1] : a2[0]) + __shfl_xor(h1 ? a2[0] : a2[1], 2);
                val += __shfl_xor(val, 1);
                val += brv;
                int ek[4]; float vk[4];
#pragma unroll
                for (int k = 0; k < 4; ++k) { const float mxv = wave_max(val); const unsigned long long bal = __ballot(val == mxv); const int win = __ffsll((long long)bal) - 1;
                    ek[k] = win >> 1; vk[k] = mxv; if ((lane >> 1) == ek[k]) val = -INFINITY; }
                const float e1 = __expf(vk[1] - vk[0]), e2 = __expf(vk[2] - vk[0]), e3 = __expf(vk[3] - vk[0]); const float inv = 1.0f / (1.0f + e1 + e2 + e3);
                const int tl = 16 * F.wave + 2 * rp + r;
                if (lane < 4) { const int e = (lane == 0) ? ek[0] : (lane == 1) ? ek[1] : (lane == 2) ? ek[2] : ek[3]; const float w = ((lane == 0) ? 1.0f : (lane == 1) ? e1 : (lane == 2) ? e2 : e3) * inv;
                    sel_e[tl * 4 + lane] = e; TOKW[(size_t)(m0 + tl) * 4 + lane] = w; }
            }
        }
        __syncthreads();
        { const int myE = sel_e[F.tid]; int rk = 0, tot = 0;
#pragma unroll 8
          for (int j = 0; j < 512; ++j) { const int ej = sel_e[j]; rk += (ej == myE && j < F.tid) ? 1 : 0; tot += (ej == F.tid) ? 1 : 0; }
          TOKINFO[(size_t)m0 * 4 + F.tid] = myE | (rk << 8);
          if (F.tid < 32) { wsp<int>(F, WS_WGCNT)[((size_t)l * 256 + tb) * 32 + F.tid] = tot; if (tot) (void)__hip_atomic_fetch_add(cntg + F.tid * 64, (unsigned)tot, RLX_AGENT); } }
        (void)sel_r; (void)cnt_l; (void)base_l;
        __syncthreads();
    }
}

__device__ __forceinline__ int moe_tables(Frame& F, int l) {
    const unsigned* cntg = wsp<unsigned>(F, WS_CTL) + CW_CNT + (size_t)l * NE * 64;
    LAS int* cnt_s = (LAS int*)(F.lds + X_CNTS); LAS int* off_s = (LAS int*)(F.lds + X_OFFS); LAS unsigned char* tile_e = (LAS unsigned char*)(F.lds + X_TILEE);
    if (F.tid < 32) cnt_s[F.tid] = (int)__hip_atomic_load(cntg + F.tid * 64, RLX_AGENT);
    __syncthreads();
    if (F.tid == 0) { int acc = 0;
#pragma unroll 1
        for (int e = 0; e < 32; ++e) { off_s[e] = acc * 256; const int nt = (cnt_s[e] + 255) >> 8; for (int t = 0; t < nt; ++t) tile_e[acc + t] = (unsigned char)e; acc += nt; } off_s[32] = acc * 256; }
    __syncthreads();
    return off_s[32] >> 8;
}
__device__ __forceinline__ void phase_scat(Frame& F, int l) {
    (void)moe_tables(F, l);
    const LAS int* off_s = (const LAS int*)(F.lds + X_OFFS); LAS int* base_s = (LAS int*)(F.lds + X_BASE);
    const bf16* H = wsp<bf16>(F, WS_H); bf16* XG = wsp<bf16>(F, WS_XG); const int* TOKINFO = wsp<int>(F, WS_TOKINFO); const float* TOKW = wsp<float>(F, WS_TOKW);
    int* ROWTOK = wsp<int>(F, WS_ROWTOK); float* ROWW = wsp<float>(F, WS_ROWW); const int* WGC = wsp<int>(F, WS_WGCNT) + (size_t)l * 256 * 32;
    for (int tb = F.vcu; tb < T / 128; tb += F.G) {
        if (F.tid < 32) base_s[F.tid] = 0;
        __syncthreads();
        { const int e = F.tid & 31, part = F.tid >> 5; int sacc = 0;
          for (int t2 = part * 16; t2 < part * 16 + 16; ++t2) if (t2 < tb) sacc += WGC[t2 * 32 + e];
          if (sacc) atomicAdd((int*)&base_s[e], sacc); }
        __syncthreads();
        for (int i = 0; i < 16; ++i) { const int m = tb * 128 + 16 * F.wave + i;
            const v4u* hp = (const v4u*)(H + (size_t)m * D) + 2 * F.lane; const v4u a = hp[0], bq = hp[1];
#pragma unroll
            for (int k = 0; k < 4; ++k) { const int info = TOKINFO[(size_t)m * 4 + k]; const int e = info & 255, row = off_s[e] + base_s[e] + (info >> 8);
                v4u* xp = (v4u*)(XG + (size_t)row * D) + 2 * F.lane; xp[0] = a; xp[1] = bq;
                if (F.lane == 0) { ROWTOK[row] = m * 4 + k; ROWW[row] = TOKW[(size_t)m * 4 + k]; } } }
        __syncthreads();
    }
}
__device__ __forceinline__ void phase_ln2(Frame& F, int l) {
    const float* X1 = wsp<float>(F, WS_X1); const bf16* YK = wsp<bf16>(F, WS_YK); bf16* H = wsp<bf16>(F, WS_H);
    float* XO = (l == NL - 1) ? F.out : wsp<float>(F, WS_X2);
    const float* modl = wsp<float>(F, WS_MOD) + (size_t)l * 8 * 6144; const float* modn = wsp<float>(F, WS_MOD) + (size_t)((l + 1) & 3) * 8 * 6144;
    const float* lg = F.in[I_LN2G] + l * D; const float* lb = F.in[I_LN2B] + l * D;
    const int lane = F.lane; const int gw = F.vcu * 8 + F.wave, NGW = F.G * 8;
    f32x4 gv[4], bv[4];
#pragma unroll
    for (int j = 0; j < 4; ++j) { gv[j] = *((const f32x4*)lg + lane + 64 * j); bv[j] = *((const f32x4*)lb + lane + 64 * j); }
    for (int m = gw; m < T; m += NGW) { const int b = m >> 12; const float* mb = modl + (size_t)b * 6144; const float* mn = modn + (size_t)b * 6144;
        const f32x4* xr = (const f32x4*)(X1 + (size_t)m * D) + lane; f32x4 v[4]; float s = 0.f;
#pragma unroll
        for (int j = 0; j < 4; ++j) { f32x4 y = (f32x4){0.f, 0.f, 0.f, 0.f};
#pragma unroll
            for (int k = 0; k < 4; ++k) { const v2u w = *((const v2u*)(YK + ((size_t)m * 4 + k) * D) + lane + 64 * j); y[0] += bflo(w.x); y[1] += bfhi(w.x); y[2] += bflo(w.y); y[3] += bfhi(w.y); }
            const f32x4 g2 = *((const f32x4*)(mb + 5120) + lane + 64 * j) + 1.0f;
            v[j] = xr[64 * j] * DN_ALPHA + g2 * y; s += (v[j][0] + v[j][1]) + (v[j][2] + v[j][3]); }
        const float mean = wave_sum(s) * (1.0f / D); float s2 = 0.f;
#pragma unroll
        for (int j = 0; j < 4; ++j) { v[j] = v[j] - mean; s2 += (v[j][0] * v[j][0] + v[j][1] * v[j][1]) + (v[j][2] * v[j][2] + v[j][3] * v[j][3]); }
        const float rstd = 1.0f / sqrtf(wave_sum(s2) * (1.0f / D) + LN_EPS);
        f32x4* xo = (f32x4*)(XO + (size_t)m * D) + lane; v2u* ho = (v2u*)(H + (size_t)m * D) + lane;
#pragma unroll
        for (int j = 0; j < 4; ++j) { const f32x4 x2 = v[j] * rstd * gv[j] + bv[j]; xo[64 * j] = x2;
            if (l < NL - 1) { const f32x4 sh = *((const f32x4*)mn + lane + 64 * j), sc = *((const f32x4*)(mn + 1024) + lane + 64 * j) + 1.0f; const f32x4 h = x2 * sc + sh;
                v2u o; o.x = pk2(h[0], h[1]); o.y = pk2(h[2], h[3]); ho[64 * j] = o; } } }
}

#ifndef PH_MASK
#define PH_MASK 0xFFFF
#endif
#define PHM(b) ((PH_MASK >> (b)) & 1)
constexpr int NPH_L = 10, NPHASE = 2 + NL * NPH_L;
struct Args { const float* in[20]; float* out; unsigned char* ws; int ph_lo, ph_hi; };
__global__ void __launch_bounds__(512, 2) fwd(Args args) {
    extern __shared__ __attribute__((aligned(16))) unsigned char lds[];
    Frame F;
    F.lds = (LAS unsigned char*)lds;
#define FRESH() do { int zv_ = 0; asm volatile("" : "+v"(zv_)); const int z_ = __builtin_amdgcn_readfirstlane(zv_); \
        F.tid = (int)threadIdx.x + zv_; F.lane = F.tid & 63; F.wave = __builtin_amdgcn_readfirstlane(F.tid >> 6); \
        F.G = (int)gridDim.x + z_; F.bx = (int)blockIdx.x + z_; F.vcu = (F.G % 8 == 0) ? (F.bx % 8) * (F.G / 8) + F.bx / 8 : F.bx; \
        F.ws = args.ws + z_; F.in = args.in + z_; F.out = args.out + z_; F.lds = (LAS unsigned char*)lds + z_; } while (0)
    FRESH();
    for (int u = F.tid; u < (LDS_BYTES - XOFF) / 4; u += 512) ((LAS unsigned*)(F.lds + XOFF))[u] = 0u;
    __syncthreads();
    unsigned* ctl = wsp<unsigned>(F, WS_CTL);
    XcdBarrier bar; bar.bar = ctl + CW_BAR; bar.x = 0; bar.st = nullptr;
    if (!MK_PER_PHASE) bar = xcd_barrier_post(ctl + CW_BAR, (volatile LAS unsigned*)(F.lds + X_MISC) + 8);
    const int lo = args.ph_lo, hi = args.ph_hi;
#define IN(k) (lo <= (k) && (k) < hi)
#define SEAM(k) do { if (!MK_PER_PHASE && IN(k) && IN((k) + 1)) xcd_barrier(bar); } while (0)

    if (PHM(0) && IN(0)) { FRESH(); phase_pro_a(F); } SEAM(0);
    if (PHM(1) && IN(1)) { FRESH(); phase_pro_b(F); } SEAM(1);
    for (int l = 0; l < NL; ++l) {
        const int pb = 2 + l * NPH_L;
        if (PHM(2) && IN(pb + 0)) { FRESH();
            pg8::Gemm g{wsp<bf16>(F, WS_H), wsp<bf16>(F, WS_WIN) + (size_t)l * NIN * D, T, NIN, D}; pg8::StaticOrder S; S.init(T, NIN, F.G, F.bx);
            EpiIn E{wsp<bf16>(F, WS_U), wsp<bf16>(F, WS_V), wsp<bf16>(F, WS_Q), wsp<bf16>(F, WS_K), wsp<bf16>(F, WS_VV), wsp<bf16>(F, WS_G), wsp<float>(F, WS_ROPE)};
            pg8::gemm_phase<EpiIn, pg8::StaticOrder, true, true>(F.lds, g, S, E, F.tid);
        } SEAM(pb + 0);
        if (PHM(3) && IN(pb + 1)) { FRESH(); phase_attn(F); } SEAM(pb + 1);
        if (PHM(4) && IN(pb + 2)) { FRESH(); phase_sg(F, l); } SEAM(pb + 2);
        if (PHM(5) && IN(pb + 3)) { FRESH();
#ifndef T_NO_YA
            { pg8::Gemm g{wsp<bf16>(F, WS_TT), wsp<bf16>(F, WS_WBA) + (size_t)l * D * D, T, D, D}; pg8::StaticOrder S; S.init(T, D, F.G, F.bx);
              EpiYA E{wsp<bf16>(F, WS_G), wsp<bf16>(F, WS_YA)}; pg8::gemm_phase<EpiYA, pg8::StaticOrder, true, true>(F.lds, g, S, E, F.tid); }
#endif
#ifndef T_NO_MG
            FRESH();
            { pg8::Gemm g{wsp<bf16>(F, WS_OB), wsp<bf16>(F, WS_WBB) + (size_t)l * D * 512, T, D, 512}; pg8::StaticOrder S; S.init(T, D, F.G, F.bx);
              EpiMg E{wsp<bf16>(F, WS_G), wsp<bf16>(F, WS_YA), wsp<bf16>(F, WS_MG)}; pg8::gemm_phase<EpiMg, pg8::StaticOrder, true, true>(F.lds, g, S, E, F.tid); }
#endif
        } SEAM(pb + 3);
        if (PHM(6) && IN(pb + 4)) { FRESH();
            pg8::Gemm g{wsp<bf16>(F, WS_MG), wsp<bf16>(F, WS_WOUT) + (size_t)l * D * D, T, D, D}; pg8::StaticOrder S; S.init(T, D, F.G, F.bx);
            EpiOut E{(l == 0) ? F.in[I_X] : wsp<float>(F, WS_X2), wsp<float>(F, WS_MOD) + (size_t)l * 8 * 6144, wsp<float>(F, WS_YPRE)};
            pg8::gemm_phase<EpiOut, pg8::StaticOrder, true, true>(F.lds, g, S, E, F.tid);
        } SEAM(pb + 4);
        if (PHM(7) && IN(pb + 5)) { FRESH(); phase_ln1(F, l); } SEAM(pb + 5);
        if (PHM(8) && IN(pb + 6)) { FRESH(); phase_scat(F, l); } SEAM(pb + 6);
        if (PHM(9) && IN(pb + 7)) { FRESH();
            const int RT = moe_tables(F, l);
            pg8::Gemm g{wsp<bf16>(F, WS_XG), wsp<bf16>(F, WS_WUP) + (size_t)l * NE * 2048 * D, RT * 256, NE * 2048, D};
            MoeOrder S; S.init(RT, 8, F.G, F.bx, (const LAS unsigned char*)(F.lds + X_TILEE));
            EpiUp E{F.in[I_BUP] + (size_t)l * NE * 2048, wsp<bf16>(F, WS_ACT)};
            pg8::gemm_phase<EpiUp, MoeOrder, true, true>(F.lds, g, S, E, F.tid);
        } SEAM(pb + 7);
        if (PHM(10) && IN(pb + 8)) { FRESH();
            const int RT = moe_tables(F, l);
            pg8::Gemm g{wsp<bf16>(F, WS_ACT), wsp<bf16>(F, WS_WDN) + (size_t)l * NE * D * FF, RT * 256, NE * D, FF};
            MoeOrder S; S.init(RT, 4, F.G, F.bx, (const LAS unsigned char*)(F.lds + X_TILEE));
            EpiDn E{F.in[I_BDN] + (size_t)l * NE * D, wsp<int>(F, WS_ROWTOK), wsp<float>(F, WS_ROWW), wsp<bf16>(F, WS_YK), (const LAS int*)(F.lds + X_CNTS), (const LAS int*)(F.lds + X_OFFS)};
            pg8::gemm_phase<EpiDn, MoeOrder, true, true>(F.lds, g, S, E, F.tid);
        } SEAM(pb + 8);
        if (PHM(11) && IN(pb + 9)) { FRESH(); phase_ln2(F, l); } SEAM(pb + 9);
    }
#undef IN
#undef SEAM
#undef FRESH
}

extern "C" void kernel_launch(void* const* d_in, const int* in_sizes, int n_in, void* d_out, int out_size, void* d_ws, size_t ws_size, hipStream_t stream) {
    static int grid = 0;
    if (grid == 0) {
        if (n_in != 20 || out_size != T * D || ws_size < WS_END) { fprintf(stderr, "kernel_launch: unexpected shapes (n_in %d, out %d, ws %zu < %zu)\n", n_in, out_size, ws_size, (size_t)WS_END); grid = -1; return; }
        int dev = 0, cus = 0;
        if (hipGetDevice(&dev) != hipSuccess || hipDeviceGetAttribute(&cus, hipDeviceAttributeMultiprocessorCount, dev) != hipSuccess) { grid = -1; return; }
        if (hipFuncSetAttribute((const void*)fwd, hipFuncAttributeMaxDynamicSharedMemorySize, LDS_BYTES) != hipSuccess) { fprintf(stderr, "kernel_launch: hipFuncSetAttribute failed\n"); grid = -1; return; }
        int per_cu = 0;
        if (hipOccupancyMaxActiveBlocksPerMultiprocessor(&per_cu, (const void*)fwd, 512, LDS_BYTES) != hipSuccess || per_cu < 1) fprintf(stderr, "kernel_launch: occupancy query says %d blocks per CU\n", per_cu);
        (void)hipGetLastError();
        grid = cus;
    }
    if (grid < 0) return;
    (void)in_sizes;
    if (hipMemsetAsync((char*)d_ws + WS_CTL, 0, CTL_ZERO_BYTES, stream) != hipSuccess) return;
    Args a{};
    for (int i = 0; i < 20; ++i) a.in[i] = (const float*)d_in[i];
    a.out = (float*)d_out; a.ws = (unsigned char*)d_ws;
#if MK_PER_PHASE
    for (int p = 0; p < NPHASE; ++p) { a.ph_lo = p; a.ph_hi = p + 1; hipLaunchKernelGGL(fwd, dim3(grid), dim3(512), LDS_BYTES, stream, a); }
#else
    a.ph_lo = 0; a.ph_hi = NPHASE;
    hipLaunchKernelGGL(fwd, dim3(grid), dim3(512), LDS_BYTES, stream, a);
#endif
    const hipError_t le = hipPeekAtLastError();
    if (le != hipSuccess) fprintf(stderr, "kernel_launch: launch failed: %s\n", hipGetErrorName(le));
}
```

```cpp
#include <hip/hip_runtime.h>
#include <cstdio>
#include <cstdint>
#ifndef MK_PER_PHASE
#define MK_PER_PHASE 0
#endif
namespace pg8 {
#define PG8_LAS __attribute__((address_space(3)))
typedef unsigned short bf16_t;
typedef short bf16x8 __attribute__((ext_vector_type(8)));
typedef float f32x4 __attribute__((ext_vector_type(4)));
typedef unsigned u32x4 __attribute__((ext_vector_type(4)));
constexpr int BM = 256, BK = 64, HALF = 128, HTB = HALF * BK * 2  , STAGE_BYTES = 8 * HTB, NXCD = 8;
#ifndef PG8_WGM
#define PG8_WGM 8
#endif
constexpr int WGM = PG8_WGM;

__host__ __device__ __forceinline__ int lds_byte(int r, int c) { const int st = (r >> 4) * 2 + (c >> 5), rr = r & 15, cc = c & 31, ob = rr * 64 + cc * 2; return st * 1024 + (ob ^ (((ob >> 9) & 1) << 5)); }
__host__ __device__ __forceinline__ void stage_rc(int b, int& R, int& C) { const int st = b / 1024, sb = b % 1024, swz = sb ^ (((sb >> 9) & 1) << 5); R = (st >> 1) * 16 + swz / 64; C = (st & 1) * 32 + (swz % 64) / 2; }
__host__ __device__ __forceinline__ int perm32(int rho) { const int n = rho >> 4, i = rho & 15; return 8 * (i >> 2) + 4 * n + (i & 3); }

struct Unit { int pm, pn; };
struct Gemm { const bf16_t* A; const bf16_t* Bt; int M, N, K; };

struct StaticOrder {
    static constexpr bool GATHER = false; __device__ __forceinline__ int arow(int, int r) const { return r; }
    int nM, nN, nwg, G, c;
    __host__ __device__ void init(int M, int N, int G_, int c_) { nM = M / BM; nN = N / BM; nwg = nM * nN; G = G_; c = c_; }
    __host__ __device__ bool next(int i, Unit& u) const {
        const long L = (long)i * G + c; if (L >= nwg) return false;
        int wgid = (int)L; { const int q = nwg / NXCD, r = nwg % NXCD, xcd = wgid % NXCD, off = wgid / NXCD; wgid = (xcd < r ? xcd * (q + 1) : r * (q + 1) + (xcd - r) * q) + off; }
        const int nig = WGM * nN, gid = wgid / nig, fm = gid * WGM, gsz = (nM - fm) < WGM ? (nM - fm) : WGM;
        u.pm = fm + ((wgid % nig) % gsz); u.pn = (wgid % nig) / gsz; return true;
    }
    __device__ __forceinline__ void a_ready(const Unit&) const {}
    __device__ __forceinline__ void done(const Unit&) const {}
};

__device__ __forceinline__ unsigned cvt_pk_bf16(float lo, float hi) { unsigned r; asm volatile("v_cvt_pk_bf16_f32 %0, %1, %2" : "=v"(r) : "v"(lo), "v"(hi)); return r; }
typedef float f32x2 __attribute__((ext_vector_type(2)));

template <class Epi, class Sched, bool ALIGN_EPI = false, bool SP2 = false>
__device__ __forceinline__ void gemm_phase(PG8_LAS unsigned char* lds, const Gemm g, const Sched& S, const Epi& E, const int tid_in) {
    const int tid = tid_in, wid = __builtin_amdgcn_readfirstlane(tid >> 6), lane = tid & 63, wr = wid >> 2, wc = wid & 3, fr = lane & 15, fq = lane >> 4;
    const int K = g.K, nt = K / BK;
    unsigned voffA[2], voffB[2];
#pragma unroll
    for (int i = 0; i < 2; ++i) { int R, C; stage_rc(tid * 16 + i * 8192, R, C); const int Rb = Epi::PERM ? ((R & ~31) + perm32(R & 31)) : R;
        voffA[i] = (unsigned)(R * K + C) * 2u; voffB[i] = (unsigned)(Rb * K + C) * 2u; }
    const size_t kstep = (size_t)(BK * 2);
    const size_t hstep = (size_t)HALF * K * 2;
    const size_t tstep = 2 * hstep;
    const unsigned ldsw = (unsigned)wid * 1024u;
    const int aoff = lds_byte(wr * 64 + fr, fq * 8), boff = lds_byte(wc * 32 + fr, fq * 8);
#define PG8_SA(b, h) (((b) * 2 + (h)) * HTB)
#define PG8_SB(b, h) ((4 + (b) * 2 + (h)) * HTB)
    unsigned gc[2][2], gn[2][2];
#define PG8_GOFF(dst, pmv, ordv) do { if constexpr (Sched::GATHER) { _Pragma("unroll") for (int _h = 0; _h < 2; ++_h) _Pragma("unroll") for (int _i = 0; _i < 2; ++_i) { int _R, _C; stage_rc(tid * 16 + _i * 8192, _R, _C); \
        dst[_h][_i] = (unsigned)S.arow((ordv), (pmv) * 256 + _h * 128 + _R) * (unsigned)(K * 2) + (unsigned)(_C * 2); } } } while (0)
#define PG8_STAGE_A(bufoff, origptr, nextf, hh, kbytes) do { if constexpr (Sched::GATHER) { _Pragma("unroll") for (int _i = 0; _i < 2; ++_i) { const unsigned _o = (nextf) ? gn[hh][_i] : gc[hh][_i]; \
        __builtin_amdgcn_global_load_lds((const unsigned*)((const char*)g.A + (kbytes) + _o), (PG8_LAS unsigned*)(lds + (bufoff) + ldsw + _i * 8192), 16, 0, 0); } } else { PG8_STAGE(bufoff, origptr, voffA); } } while (0)
#define PG8_STAGE(bufoff, gbase, voff) do { _Pragma("unroll") for (int _i = 0; _i < 2; ++_i) \
        __builtin_amdgcn_global_load_lds((const unsigned*)((const char*)(gbase) + (voff)[_i]), (PG8_LAS unsigned*)(lds + (bufoff) + ldsw + _i * 8192), 16, 0, 0); } while (0)
#define PG8_LDA(dst, b, h) do { _Pragma("unroll") for (int m = 0; m < 4; ++m) _Pragma("unroll") for (int k = 0; k < 2; ++k) dst[m][k] = *(const PG8_LAS bf16x8*)(lds + PG8_SA(b, h) + aoff + m * 2048 + k * 1024); } while (0)
#define PG8_LDB(dst, b, h) do { _Pragma("unroll") for (int n = 0; n < 2; ++n) _Pragma("unroll") for (int k = 0; k < 2; ++k) dst[n][k] = *(const PG8_LAS bf16x8*)(lds + PG8_SB(b, h) + boff + n * 2048 + k * 1024); } while (0)
#define PG8_MMA(ai, bj, At, Bt) do { __builtin_amdgcn_s_setprio(1); _Pragma("unroll") for (int m = 0; m < 4; ++m) _Pragma("unroll") for (int n = 0; n < 2; ++n) _Pragma("unroll") for (int k = 0; k < 2; ++k) \
        acc[ai][bj][m][n] = __builtin_amdgcn_mfma_f32_16x16x32_bf16(Bt[n][k], At[m][k], acc[ai][bj][m][n], 0, 0, 0); __builtin_amdgcn_s_setprio(0); } while (0)
#define PG8_WAIT_V(n) asm volatile("s_waitcnt vmcnt(" #n ")" ::: "memory")
#define PG8_WAIT_L(n) asm volatile("s_waitcnt lgkmcnt(" #n ")" ::: "memory")
#define PG8_BAR __builtin_amdgcn_s_barrier()
#define PG8_SCHED __builtin_amdgcn_sched_barrier(0)
    Unit cur, nxt; int ui = 0;
    if (!S.next(0, cur)) return;
    f32x4 acc[2][2][4][2];
#pragma unroll
    for (int a = 0; a < 2; ++a)
#pragma unroll
        for (int b = 0; b < 2; ++b)
#pragma unroll
            for (int m = 0; m < 4; ++m)
#pragma unroll
                for (int n = 0; n < 2; ++n) acc[a][b][m][n] = (f32x4){0.f, 0.f, 0.f, 0.f};
    bf16x8 At[4][2], B0[2][2], B1[2][2];
    const char* cA = (const char*)g.A + (size_t)cur.pm * tstep; const char* cB = (const char*)g.Bt + (size_t)cur.pn * tstep;
    S.a_ready(cur);
    PG8_GOFF(gc, cur.pm, 0);
    if constexpr (SP2) {
        PG8_STAGE(PG8_SB(0, 0), cB, voffB); PG8_STAGE(PG8_SB(0, 1), cB + hstep, voffB); PG8_STAGE_A(PG8_SA(0, 0), cA, false, 0, 0); PG8_STAGE_A(PG8_SA(0, 1), cA + hstep, false, 1, 0);
        if (wr == 1) PG8_BAR;
        PG8_WAIT_V(2); PG8_BAR;
        PG8_STAGE(PG8_SB(1, 0), cB + kstep, voffB); PG8_STAGE_A(PG8_SA(1, 0), cA + kstep, false, 0, kstep); PG8_STAGE(PG8_SB(1, 1), cB + hstep + kstep, voffB);
        PG8_WAIT_V(6); PG8_BAR;
    } else {
        PG8_STAGE(PG8_SB(0, 0), cB, voffB); PG8_STAGE(PG8_SA(0, 0), cA, voffA); PG8_STAGE(PG8_SB(0, 1), cB + hstep, voffB); PG8_STAGE(PG8_SA(0, 1), cA + hstep, voffA);
        if (wr == 1) PG8_BAR;
        PG8_WAIT_V(4); PG8_BAR;
        PG8_STAGE(PG8_SB(1, 0), cB + kstep, voffB); PG8_STAGE(PG8_SA(1, 0), cA + kstep, voffA); PG8_STAGE(PG8_SB(1, 1), cB + hstep + kstep, voffB);
        PG8_WAIT_V(6); PG8_BAR;
    }
    for (;;) {
        const bool has_next = S.next(ui + 1, nxt);
        if constexpr (Sched::GATHER) { if (has_next) { PG8_GOFF(gn, nxt.pm, ui + 1); } else { gn[0][0] = gc[0][0]; gn[0][1] = gc[0][1]; gn[1][0] = gc[1][0]; gn[1][1] = gc[1][1]; } }
        const char* nA = has_next ? (const char*)g.A + (size_t)nxt.pm * tstep : cA; const char* nB = has_next ? (const char*)g.Bt + (size_t)nxt.pn * tstep : cB;
#pragma unroll
        for (int seg = 0; seg < (Epi::MID_T > 0 ? 2 : 1); ++seg) {
        if constexpr (Epi::MID_T > 0) { if (seg == 1) { PG8_SCHED; E.mid(acc, cur, wr, wc, fr, fq); PG8_SCHED; } }
        const int t_lo = seg ? Epi::MID_T : 0, t_hi = (Epi::MID_T > 0 && seg == 0) ? Epi::MID_T : nt;
        for (int t = t_lo; t < t_hi; t += 2) {
            const bool last = (t == nt - 2);
            const char* a1 = cA + (size_t)(t + 1) * kstep;
            const char* a2 = last ? nA : cA + (size_t)(t + 2) * kstep; const char* b2 = last ? nB : cB + (size_t)(t + 2) * kstep;
            const char* a3 = a2 + kstep; const char* b3 = b2 + kstep; const size_t k2b = last ? (size_t)0 : (size_t)(t + 2) * kstep;
            if (last && has_next) S.a_ready(nxt);
            if constexpr (SP2) {
            PG8_LDB(B0, 0, 0); PG8_LDB(B1, 0, 1); PG8_SCHED; PG8_LDA(At, 0, 0); PG8_STAGE_A(PG8_SA(1, 1), a1 + hstep, false, 1, (size_t)(t + 1) * kstep);
            PG8_WAIT_V(8); PG8_WAIT_L(0); PG8_BAR; PG8_MMA(0, 0, At, B0); PG8_MMA(0, 1, At, B1); PG8_BAR; PG8_SCHED;
            PG8_LDA(At, 0, 1); PG8_STAGE(PG8_SB(0, 0), b2, voffB); PG8_STAGE(PG8_SB(0, 1), b2 + hstep, voffB); PG8_STAGE_A(PG8_SA(0, 0), a2, last, 0, k2b);
            PG8_WAIT_V(8); PG8_WAIT_L(0); PG8_BAR; PG8_MMA(1, 0, At, B0); PG8_MMA(1, 1, At, B1); PG8_BAR; PG8_SCHED;
            PG8_LDB(B0, 1, 0); PG8_LDB(B1, 1, 1); PG8_SCHED; PG8_LDA(At, 1, 0); PG8_STAGE_A(PG8_SA(0, 1), a2 + hstep, last, 1, k2b);
            PG8_WAIT_V(8); PG8_WAIT_L(0); PG8_BAR; PG8_MMA(0, 0, At, B0); PG8_MMA(0, 1, At, B1); PG8_BAR; PG8_SCHED;
            PG8_LDA(At, 1, 1); PG8_STAGE(PG8_SB(1, 0), b3, voffB); PG8_STAGE(PG8_SB(1, 1), b3 + hstep, voffB); PG8_STAGE_A(PG8_SA(1, 0), a3, last, 0, k2b + kstep);
            PG8_WAIT_V(8); PG8_WAIT_L(0); PG8_BAR; PG8_MMA(1, 0, At, B0); PG8_MMA(1, 1, At, B1); PG8_BAR; PG8_SCHED;
            } else {
            PG8_LDB(B0, 0, 0); PG8_SCHED; PG8_LDA(At, 0, 0); PG8_STAGE(PG8_SA(1, 1), a1 + hstep, voffA);
            PG8_WAIT_L(8); PG8_BAR; PG8_WAIT_L(0); PG8_MMA(0, 0, At, B0); PG8_BAR; PG8_SCHED;
            PG8_LDB(B1, 0, 1); PG8_STAGE(PG8_SB(0, 0), b2, voffB);
            PG8_BAR; PG8_WAIT_L(0); PG8_MMA(0, 1, At, B1); PG8_BAR;
            PG8_LDA(At, 0, 1); PG8_STAGE(PG8_SA(0, 0), a2, voffA);
            PG8_BAR; PG8_WAIT_L(0); PG8_MMA(1, 0, At, B0); PG8_BAR; PG8_SCHED;
            PG8_STAGE(PG8_SB(0, 1), b2 + hstep, voffB);
            PG8_WAIT_V(6); PG8_BAR; PG8_MMA(1, 1, At, B1); PG8_BAR;
            PG8_LDB(B0, 1, 0); PG8_SCHED; PG8_LDA(At, 1, 0); PG8_STAGE(PG8_SA(0, 1), a2 + hstep, voffA);
            PG8_WAIT_L(8); PG8_BAR; PG8_WAIT_L(0); PG8_MMA(0, 0, At, B0); PG8_BAR; PG8_SCHED;
            PG8_LDB(B1, 1, 1); PG8_STAGE(PG8_SB(1, 0), b3, voffB);
            PG8_BAR; PG8_WAIT_L(0); PG8_MMA(0, 1, At, B1); PG8_BAR;
            PG8_LDA(At, 1, 1); PG8_STAGE(PG8_SA(1, 0), a3, voffA);
            PG8_BAR; PG8_WAIT_L(0); PG8_MMA(1, 0, At, B0); PG8_BAR; PG8_SCHED;
            PG8_STAGE(PG8_SB(1, 1), b3 + hstep, voffB);
            PG8_WAIT_V(6); PG8_BAR; PG8_MMA(1, 1, At, B1); PG8_BAR;
            }
        }
        }
        if constexpr (ALIGN_EPI) { if (wr == 0) PG8_BAR; }
        if constexpr (!Epi::AFTER_DRAIN) { E(acc, cur, wr, wc, fr, fq); S.done(cur); }
        if (!has_next) break;
#pragma unroll
        for (int a = 0; a < 2; ++a)
#pragma unroll
            for (int b = 0; b < 2; ++b)
#pragma unroll
                for (int m = 0; m < 4; ++m)
#pragma unroll
                    for (int n = 0; n < 2; ++n) acc[a][b][m][n] = (f32x4){0.f, 0.f, 0.f, 0.f};
        cur = nxt; cA = nA; cB = nB; ++ui;
        if constexpr (Sched::GATHER) { gc[0][0] = gn[0][0]; gc[0][1] = gn[0][1]; gc[1][0] = gn[1][0]; gc[1][1] = gn[1][1]; }
        if constexpr (ALIGN_EPI) { if (wr == 1) PG8_BAR; }
    }
    PG8_WAIT_V(0);
    if constexpr (!ALIGN_EPI) { if (wr == 0) PG8_BAR; }
    PG8_BAR;
    if constexpr (Epi::AFTER_DRAIN) { E.fused(acc, cur, wr, wc, fr, fq, lds, wid, lane); S.done(cur); }
#undef PG8_SA
#undef PG8_SB
#undef PG8_STAGE
#undef PG8_STAGE_A
#undef PG8_GOFF
#undef PG8_LDA
#undef PG8_LDB
#undef PG8_MMA
#undef PG8_WAIT_V
#undef PG8_WAIT_L
#undef PG8_BAR
#undef PG8_SCHED
}
}
#define LAS __attribute__((address_space(3)))
#define XB_TMO      128
#define XB_XCNT(j)  (256  + 64 * (j))
#define XB_XSUB(j)  (1280 + 64 * (j))
#define XB_XGEN(j)  (2304 + 64 * (j))
#define XB_TOP      3328
#define XB_TOPGEN   3392
#define XCD_BAR_WORDS 3456
#define XB_SPIN_CAP (1u << 18)

__device__ __forceinline__ unsigned xb_ld(unsigned* p)              { return __hip_atomic_load(p, __ATOMIC_RELAXED, __HIP_MEMORY_SCOPE_AGENT); }
__device__ __forceinline__ unsigned xb_add(unsigned* p, unsigned v) { return __hip_atomic_fetch_add(p, v, __ATOMIC_RELAXED, __HIP_MEMORY_SCOPE_AGENT); }
__device__ __forceinline__ unsigned xb_xcc_id() { return (unsigned)__builtin_amdgcn_s_getreg((3 << 11) | 20) & 0xFu; }
#define XB_SPIN(cond, bar) do { unsigned _sp = 0; while (cond) { __builtin_amdgcn_s_sleep(1); \
    if ((++_sp & 255u) == 0u) { if (xb_ld(&(bar)[XB_TMO])) break; if (_sp > XB_SPIN_CAP) { atomicAdd(&(bar)[XB_TMO], 1u); break; } } } } while (0)

struct XcdBarrier {
    unsigned* bar; unsigned x;
    volatile LAS unsigned* st;
};

__device__ __forceinline__ XcdBarrier xcd_barrier_post(unsigned* bar, volatile LAS unsigned* st) {
    XcdBarrier b; b.bar = bar; b.x = xb_xcc_id(); b.st = st;
    if (threadIdx.x == 0) (void)xb_add(&bar[XB_XCNT(b.x)], 1u);
    return b;
}
__device__ __forceinline__ void xcd_barrier_complete(unsigned* bar, unsigned x, unsigned& nloc, unsigned& nx) {
    const unsigned G = gridDim.x * gridDim.y * gridDim.z;
    unsigned sum, cnt, mine, sp = 0u;
    for (;;) {
        sum = 0u; cnt = 0u; mine = 0u;
#pragma unroll
        for (unsigned j = 0; j < 16; ++j) { const unsigned c = xb_ld(&bar[XB_XCNT(j)]); sum += c; cnt += (c > 0u) ? 1u : 0u; mine = (j == x) ? c : mine; }
        if (sum == G) break;
        __builtin_amdgcn_s_sleep(1);
        if ((++sp & 255u) == 0u) { if (xb_ld(&bar[XB_TMO])) break; if (sp > XB_SPIN_CAP) { atomicAdd(&bar[XB_TMO], 1u); break; } }
    }
    nloc = mine > 0u ? mine : 1u; nx = cnt > 0u ? cnt : 1u;
}

__device__ __forceinline__ void xcd_barrier(const XcdBarrier& b) {
    asm volatile("s_waitcnt vmcnt(0)" ::: "memory");
    __syncthreads();
    if (threadIdx.x == 0) {
        unsigned* bar = b.bar;
        __builtin_amdgcn_s_waitcnt(0);
        unsigned nloc = b.st[0], nx = b.st[1];
        if (nloc == 0u) { xcd_barrier_complete(bar, b.x, nloc, nx); b.st[0] = nloc; b.st[1] = nx; }
        const unsigned old = xb_add(&bar[XB_XSUB(b.x)], 1u);
        const unsigned gen = old / nloc;
        if (old + 1u == (gen + 1u) * nloc) {
            __builtin_amdgcn_fence(__ATOMIC_RELEASE, "agent");
            asm volatile("s_waitcnt vmcnt(0)" ::: "memory");
            const unsigned og = xb_add(&bar[XB_TOP], 1u);
            const unsigned tg = og / nx;
            if (og + 1u == (tg + 1u) * nx) xb_add(&bar[XB_TOPGEN], 1u);
            else XB_SPIN(xb_ld(&bar[XB_TOPGEN]) == tg, bar);
            __builtin_amdgcn_fence(__ATOMIC_ACQUIRE, "agent");
            xb_add(&bar[XB_XGEN(b.x)], 1u);
            asm volatile("s_waitcnt vmcnt(0)" ::: "memory");
        } else {
            XB_SPIN(xb_ld(&bar[XB_XGEN(b.x)]) == gen, bar);
            __builtin_amdgcn_fence(__ATOMIC_ACQUIRE, "agent");
            asm volatile("s_waitcnt vmcnt(0)" ::: "memory");
        }
    }
    __syncthreads();
}


#ifndef PG8_SP2
#define PG8_SP2 true
#endif
#ifndef PG8_ALIGN
#define PG8_ALIGN true
#endif
constexpr int D = 1024, NB = 8, SEQ = 4096, T = NB * SEQ, NL = 4;
constexpr int NIN = 8704, NE = 32, FF = 1024;
constexpr int RMAX = 139264;
constexpr float LN_EPS = 1e-5f, DN_ALPHA = 1.681792830507429f;
constexpr float QSCALE = 0.18033688011112042f;
constexpr float LOG2E = 1.4426950408889634f;

constexpr size_t MiB = 1u << 20;
constexpr size_t WS_CTL = 0, CTL_ZERO_BYTES = 1 * MiB;
constexpr size_t WS_MOD = 1 * MiB;
constexpr size_t WS_ROPE = 2 * MiB;
constexpr size_t WS_WSP = 3 * MiB;
constexpr size_t WS_WRT = 4 * MiB;
constexpr size_t WS_TOKINFO = 5 * MiB;
constexpr size_t WS_TOKW = 5 * MiB + 512 * 1024;
constexpr size_t WS_ROWTOK = 6 * MiB;
constexpr size_t WS_ROWW = 7 * MiB;
constexpr size_t WS_LSE = 8 * MiB;
constexpr size_t WS_TOKROW = 14 * MiB;
constexpr size_t WS_STAT = 13 * MiB;
constexpr size_t WS_WGCNT = 12 * MiB;
constexpr size_t WS_WIN = 16 * MiB;
constexpr size_t WS_WBA = 84 * MiB;
constexpr size_t WS_WBB = 92 * MiB;
constexpr size_t WS_WOUT = 96 * MiB;
constexpr size_t WS_WUP = 104 * MiB;
constexpr size_t WS_WDN = 616 * MiB;
constexpr size_t WS_H = 872 * MiB;
constexpr size_t WS_X1 = 936 * MiB;
constexpr size_t WS_X2 = 1064 * MiB;
constexpr size_t WS_YPRE = 1192 * MiB;
constexpr size_t WS_U = 1320 * MiB, WS_V = 1384 * MiB;
constexpr size_t WS_Q = 1448 * MiB, WS_K = 1544 * MiB, WS_VV = 1640 * MiB;
constexpr size_t WS_G = 1736 * MiB;
constexpr size_t WS_OG = 1864 * MiB;
constexpr size_t WS_TT = 1960 * MiB;
constexpr size_t WS_OB = 2024 * MiB;
constexpr size_t WS_YA = 2056 * MiB;
constexpr size_t WS_MG = 2120 * MiB;
constexpr size_t WS_XG = 2184 * MiB;
constexpr size_t WS_ACT = 2456 * MiB;
constexpr size_t WS_YK = 2728 * MiB;
constexpr size_t WS_END = 2984 * MiB;
constexpr int CW_BAR = 4096;
constexpr int CW_CNT = 16384;

constexpr int RING_BYTES = 131072;
constexpr int XOFF = RING_BYTES;
constexpr int X_MISC = XOFF;
constexpr int X_SELE = XOFF + 256;
constexpr int X_SELR = XOFF + 2304;
constexpr int X_CNTL = XOFF + 4352;
constexpr int X_BASE = XOFF + 4480;
constexpr int X_TILEE = XOFF + 4608;
constexpr int X_CNTS = XOFF + 5632;
constexpr int X_OFFS = XOFF + 5760;
constexpr int LDS_BYTES = 147456;

#define GAS __attribute__((address_space(1)))
typedef unsigned short bf16;
typedef unsigned v4u __attribute__((ext_vector_type(4)));
typedef unsigned v2u __attribute__((ext_vector_type(2)));
typedef float f32x4 __attribute__((ext_vector_type(4)));
typedef short bf16x8 __attribute__((ext_vector_type(8)));
typedef short s16x4 __attribute__((ext_vector_type(4)));
#define RLX_AGENT __ATOMIC_RELAXED, __HIP_MEMORY_SCOPE_AGENT
#define LDS_WAIT() asm volatile("s_waitcnt lgkmcnt(0)" ::: "memory")
#define VM_WAIT() asm volatile("s_waitcnt vmcnt(0)" ::: "memory")

typedef __bf16 bf16x2_t __attribute__((ext_vector_type(2))); typedef float f32x2_t __attribute__((ext_vector_type(2)));
__device__ __forceinline__ unsigned pk2(float lo, float hi) { return __builtin_bit_cast(unsigned, __builtin_convertvector((f32x2_t){lo, hi}, bf16x2_t)); }
__device__ __forceinline__ float bflo(unsigned w) { return __uint_as_float(w << 16); }
__device__ __forceinline__ float bfhi(unsigned w) { return __uint_as_float(w & 0xffff0000u); }
__device__ __forceinline__ float fexp2(float x) { return __builtin_amdgcn_exp2f(x); }
__device__ __forceinline__ float frcp(float x) { return __builtin_amdgcn_rcpf(x); }
__device__ __forceinline__ float gelu_tanh(float x) { const float u = x + 0.044715f * x * x * x; return x * frcp(1.0f + fexp2(-2.302208198144325f * u)); }
__device__ __forceinline__ float sigmoidf_(float x) { return frcp(1.0f + fexp2(-LOG2E * x)); }
__device__ __forceinline__ float wave_sum(float v) {
#pragma unroll
    for (int o = 1; o < 64; o <<= 1) v += __shfl_xor(v, o);
    return v;
}
__device__ __forceinline__ float wave_max(float v) {
#pragma unroll
    for (int o = 1; o < 64; o <<= 1) v = fmaxf(v, __shfl_xor(v, o));
    return v;
}
__device__ __forceinline__ s16x4 tr16(const LAS unsigned char* p) { return __builtin_bit_cast(s16x4, __builtin_amdgcn_ds_read_tr16_b64_v4i16((LAS s16x4*)p)); }
__device__ __forceinline__ bf16x8 cat8(s16x4 lo, s16x4 hi) { return (bf16x8){lo[0], lo[1], lo[2], lo[3], hi[0], hi[1], hi[2], hi[3]}; }
__device__ __forceinline__ f32x4 mfma16(bf16x8 a, bf16x8 b, f32x4 c) { return __builtin_amdgcn_mfma_f32_16x16x32_bf16(a, b, c, 0, 0, 0); }

struct Frame {
    LAS unsigned char* lds;
    int tid, lane, wave, G, vcu, bx;
    unsigned char* ws;
    const float* const* in;
    float* out;
};
enum { I_X = 0, I_C, I_WADA, I_BADA, I_WIN, I_SPW, I_SPB, I_WBA, I_WBB, I_WOUT, I_LN1G, I_LN1B, I_WR, I_BR, I_WUP, I_BUP, I_WDN, I_BDN, I_LN2G, I_LN2B };
template <class Tp> __device__ __forceinline__ Tp* wsp(const Frame& F, size_t off) { return (Tp*)(F.ws + off); }

template <class P> __device__ __forceinline__ P launder(P p) { unsigned lo = (unsigned)(uintptr_t)p, hi = (unsigned)((uintptr_t)p >> 32); asm volatile("" : "+v"(lo), "+v"(hi));
    lo = (unsigned)__builtin_amdgcn_readfirstlane((int)lo); hi = (unsigned)__builtin_amdgcn_readfirstlane((int)hi); return (P)(((uintptr_t)hi << 32) | (uintptr_t)lo); }
struct EpiIn {
    static constexpr int MID_T = 0; static constexpr bool PERM = true, AFTER_DRAIN = false;
    bf16 *U, *V, *Q, *K, *VV, *Gt; const float* rope;
    __device__ __forceinline__ void operator()(const f32x4 (&acc)[2][2][4][2], const pg8::Unit& u, int wr, int wc, int fr, int fq) const {
        const int pn = u.pn; int type, ld, colt; bf16* base;
        if (pn < 4) { type = 0; base = U; ld = 1024; colt = pn * 256; }
        else if (pn < 8) { type = 0; base = V; ld = 1024; colt = (pn - 4) * 256; }
        else if (pn < 14) { type = 1; base = Q; ld = 1536; colt = (pn - 8) * 256; }
        else if (pn < 20) { type = 2; base = K; ld = 1536; colt = (pn - 14) * 256; }
        else if (pn < 26) { type = 3; base = VV; ld = 1536; colt = (pn - 20) * 256; }
        else { type = 4; base = Gt; ld = 2048; colt = (pn - 26) * 256; }
        const int row0 = u.pm * 256 + wr * 64 + fr, col0 = colt + wc * 32 + 8 * fq;
        if (type == 0) {
#pragma unroll
            for (int ai = 0; ai < 2; ++ai)
#pragma unroll
                for (int m = 0; m < 4; ++m) { bf16* rowp = base + (size_t)(row0 + ai * 128 + m * 16) * ld + col0;
#pragma unroll
                    for (int bj = 0; bj < 2; ++bj) { const f32x4 v0 = acc[ai][bj][m][0], v1 = acc[ai][bj][m][1]; v4u w;
                        w.x = pk2(gelu_tanh(v0[0]), gelu_tanh(v0[1])); w.y = pk2(gelu_tanh(v0[2]), gelu_tanh(v0[3]));
                        w.z = pk2(gelu_tanh(v1[0]), gelu_tanh(v1[1])); w.w = pk2(gelu_tanh(v1[2]), gelu_tanh(v1[3]));
                        __builtin_nontemporal_store(w, (v4u*)(rowp + bj * 128)); } }
        } else if (type == 4) {
#pragma unroll
            for (int ai = 0; ai < 2; ++ai)
#pragma unroll
                for (int m = 0; m < 4; ++m) { bf16* rowp = base + (size_t)(row0 + ai * 128 + m * 16) * ld + col0;
#pragma unroll
                    for (int bj = 0; bj < 2; ++bj) { const f32x4 v0 = acc[ai][bj][m][0], v1 = acc[ai][bj][m][1]; v4u w;
                        w.x = pk2(sigmoidf_(v0[0]), sigmoidf_(v0[1])); w.y = pk2(sigmoidf_(v0[2]), sigmoidf_(v0[3]));
                        w.z = pk2(sigmoidf_(v1[0]), sigmoidf_(v1[1])); w.w = pk2(sigmoidf_(v1[2]), sigmoidf_(v1[3]));
                        __builtin_nontemporal_store(w, (v4u*)(rowp + bj * 128)); } }
        } else if (type == 3) {
#pragma unroll
            for (int ai = 0; ai < 2; ++ai)
#pragma unroll
                for (int m = 0; m < 4; ++m) { bf16* rowp = base + (size_t)(row0 + ai * 128 + m * 16) * ld + col0;
#pragma unroll
                    for (int bj = 0; bj < 2; ++bj) { const f32x4 v0 = acc[ai][bj][m][0], v1 = acc[ai][bj][m][1]; v4u w;
                        w.x = pk2(v0[0], v0[1]); w.y = pk2(v0[2], v0[3]); w.z = pk2(v1[0], v1[1]); w.w = pk2(v1[2], v1[3]);
                        __builtin_nontemporal_store(w, (v4u*)(rowp + bj * 128)); } }
        } else {
            const float sc = (type == 1) ? QSCALE : 1.0f;
            const bool ropew = (wc & 1) == 0;
#pragma unroll
            for (int ai = 0; ai < 2; ++ai)
#pragma unroll
                for (int m = 0; m < 4; ++m) { const int row = row0 + ai * 128 + m * 16; bf16* rowp = base + (size_t)row * ld + col0;
                    float cs[8], sn[8];
                    if (ropew) { const f32x4* rp = (const f32x4*)(rope + (size_t)(row & (SEQ - 1)) * 16); const f32x4 c0 = rp[0], c1 = rp[1], s0 = rp[2], s1 = rp[3];
#pragma unroll
                        for (int e = 0; e < 4; ++e) { cs[e] = c0[e]; cs[4 + e] = c1[e]; sn[e] = s0[e]; sn[4 + e] = s1[e]; } }
#pragma unroll
                    for (int bj = 0; bj < 2; ++bj) { f32x4 v0 = acc[ai][bj][m][0], v1 = acc[ai][bj][m][1];
                        if (ropew) {
#pragma unroll
                            for (int e = 0; e < 8; ++e) { const float x = (e < 4) ? v0[e & 3] : v1[e & 3]; const float p = __shfl_xor(x, 16);
                                float y = x;
                                if (fq == 0) y = x * cs[e] - p * sn[e];
                                if (fq == 1) y = x * cs[e] + p * sn[e];
                                if (e < 4) v0[e & 3] = y; else v1[e & 3] = y; } }
                        v4u w; w.x = pk2(v0[0] * sc, v0[1] * sc); w.y = pk2(v0[2] * sc, v0[3] * sc); w.z = pk2(v1[0] * sc, v1[1] * sc); w.w = pk2(v1[2] * sc, v1[3] * sc);
                        __builtin_nontemporal_store(w, (v4u*)(rowp + bj * 128)); } }
        }
    }
};
struct EpiProbe {
    static constexpr int MID_T = 0; static constexpr bool PERM = true, AFTER_DRAIN = false;
    bf16* O; int ld; int on;
    __device__ __forceinline__ void operator()(const f32x4 (&acc)[2][2][4][2], const pg8::Unit& u, int wr, int wc, int fr, int fq) const {
        if (!on) return;
        const int row0 = u.pm * 256 + wr * 64 + fr, col0 = ((on == 3) ? u.pn : (u.pn & 3)) * 256 + wc * 32 + 8 * fq;
#pragma unroll
        for (int ai = 0; ai < 2; ++ai)
#pragma unroll
            for (int m = 0; m < 4; ++m) { bf16* rowp = O + (size_t)(row0 + ai * 128 + m * 16) * ld + col0;
#pragma unroll
                for (int bj = 0; bj < 2; ++bj) { const f32x4 v0 = acc[ai][bj][m][0], v1 = acc[ai][bj][m][1]; v4u w;
                    w.x = pk2(v0[0], v0[1]); w.y = pk2(v0[2], v0[3]); w.z = pk2(v1[0], v1[1]); w.w = pk2(v1[2], v1[3]);
                    *(v4u*)(rowp + bj * 128) = w; } }
    }
};
struct EpiYA {
    static constexpr int MID_T = 0; static constexpr bool PERM = true, AFTER_DRAIN = false;
    const bf16* Gt; bf16* YA;
    __device__ __forceinline__ void operator()(const f32x4 (&acc)[2][2][4][2], const pg8::Unit& u, int wr, int wc, int fr, int fq) const {
        const int row0 = u.pm * 256 + wr * 64 + fr, col0 = u.pn * 256 + wc * 32 + 8 * fq;
#pragma unroll
        for (int ai = 0; ai < 2; ++ai)
#pragma unroll
            for (int m = 0; m < 4; ++m) { const size_t row = (size_t)(row0 + ai * 128 + m * 16);
#pragma unroll
                for (int bj = 0; bj < 2; ++bj) { const f32x4 v0 = acc[ai][bj][m][0], v1 = acc[ai][bj][m][1];
                    const v4u g = *(const v4u*)(Gt + row * 2048 + col0 + bj * 128); v4u w;
                    w.x = pk2(v0[0] * bflo(g.x), v0[1] * bfhi(g.x)); w.y = pk2(v0[2] * bflo(g.y), v0[3] * bfhi(g.y));
                    w.z = pk2(v1[0] * bflo(g.z), v1[1] * bfhi(g.z)); w.w = pk2(v1[2] * bflo(g.w), v1[3] * bfhi(g.w));
                    *(v4u*)(YA + row * 1024 + col0 + bj * 128) = w; } }
    }
};
struct EpiMg {
    static constexpr int MID_T = 0; static constexpr bool PERM = true, AFTER_DRAIN = false;
    const bf16* Gt; const bf16* YA; bf16* MG;
    __device__ __forceinline__ void operator()(const f32x4 (&acc)[2][2][4][2], const pg8::Unit& u, int wr, int wc, int fr, int fq) const {
        const int row0 = u.pm * 256 + wr * 64 + fr, col0 = u.pn * 256 + wc * 32 + 8 * fq;
#pragma unroll
        for (int ai = 0; ai < 2; ++ai)
#pragma unroll
            for (int m = 0; m < 4; ++m) { const size_t row = (size_t)(row0 + ai * 128 + m * 16);
#pragma unroll
                for (int bj = 0; bj < 2; ++bj) { const f32x4 v0 = acc[ai][bj][m][0], v1 = acc[ai][bj][m][1];
                    const v4u g = *(const v4u*)(Gt + row * 2048 + 1024 + col0 + bj * 128); const v4u y = *(const v4u*)(YA + row * 1024 + col0 + bj * 128); v4u w;
                    w.x = pk2(bflo(y.x) + v0[0] * bflo(g.x), bfhi(y.x) + v0[1] * bfhi(g.x)); w.y = pk2(bflo(y.y) + v0[2] * bflo(g.y), bfhi(y.y) + v0[3] * bfhi(g.y));
                    w.z = pk2(bflo(y.z) + v1[0] * bflo(g.z), bfhi(y.z) + v1[1] * bfhi(g.z)); w.w = pk2(bflo(y.w) + v1[2] * bflo(g.w), bfhi(y.w) + v1[3] * bfhi(g.w));
                    *(v4u*)(MG + row * 1024 + col0 + bj * 128) = w; } }
    }
};
struct EpiMg2 {
    static constexpr int MID_T = 16; static constexpr bool PERM = true, AFTER_DRAIN = false;
    const bf16* Gt; bf16* MG;
    __device__ __forceinline__ void mid(f32x4 (&acc)[2][2][4][2], const pg8::Unit& u, int wr, int wc, int fr, int fq) const {
        int row0 = u.pm * 256 + wr * 64 + fr; const int col0 = u.pn * 256 + wc * 32 + 8 * fq;
        asm volatile("" : "+v"(row0));
#pragma unroll
        for (int ai = 0; ai < 2; ++ai)
#pragma unroll
            for (int m = 0; m < 4; ++m) { const size_t row = (size_t)(row0 + ai * 128 + m * 16);
#pragma unroll
                for (int bj = 0; bj < 2; ++bj) { const v4u g0 = *(const v4u*)(Gt + row * 2048 + col0 + bj * 128), g1 = *(const v4u*)(Gt + row * 2048 + 1024 + col0 + bj * 128);
                    const unsigned a0[4] = {g0.x, g0.y, g0.z, g0.w}, a1[4] = {g1.x, g1.y, g1.z, g1.w};
#pragma unroll
                    for (int q = 0; q < 4; ++q) { const float r0 = bflo(a0[q]) * frcp(fmaxf(bflo(a1[q]), 1e-20f)), r1 = bfhi(a0[q]) * frcp(fmaxf(bfhi(a1[q]), 1e-20f));
                        acc[ai][bj][m][q >> 1][(q & 1) * 2] *= r0; acc[ai][bj][m][q >> 1][(q & 1) * 2 + 1] *= r1; } }
                if (m == 3) asm volatile("" ::: "memory"); }
    }
    __device__ __forceinline__ void operator()(const f32x4 (&acc)[2][2][4][2], const pg8::Unit& u, int wr, int wc, int fr, int fq) const {
        const int row0 = u.pm * 256 + wr * 64 + fr, col0 = u.pn * 256 + wc * 32 + 8 * fq;
#pragma unroll
        for (int ai = 0; ai < 2; ++ai)
#pragma unroll
            for (int m = 0; m < 4; ++m) { const size_t row = (size_t)(row0 + ai * 128 + m * 16);
#pragma unroll
                for (int bj = 0; bj < 2; ++bj) { const f32x4 v0 = acc[ai][bj][m][0], v1 = acc[ai][bj][m][1];
                    const v4u g = *(const v4u*)(Gt + row * 2048 + 1024 + col0 + bj * 128); v4u w;
                    w.x = pk2(v0[0] * fmaxf(bflo(g.x), 1e-20f), v0[1] * fmaxf(bfhi(g.x), 1e-20f)); w.y = pk2(v0[2] * fmaxf(bflo(g.y), 1e-20f), v0[3] * fmaxf(bfhi(g.y), 1e-20f));
                    w.z = pk2(v1[0] * fmaxf(bflo(g.z), 1e-20f), v1[1] * fmaxf(bfhi(g.z), 1e-20f)); w.w = pk2(v1[2] * fmaxf(bflo(g.w), 1e-20f), v1[3] * fmaxf(bfhi(g.w), 1e-20f));
                    *(v4u*)(MG + row * 1024 + col0 + bj * 128) = w; } }
    }
};
template <bool XF32> struct EpiOut {
    static constexpr int MID_T = 0; static constexpr bool PERM = true, AFTER_DRAIN = false;
    const void* xres; const float* modl  ; bf16* YPRE;
    __device__ __forceinline__ void operator()(const f32x4 (&acc)[2][2][4][2], const pg8::Unit& u, int wr, int wc, int fr, int fq) const {
        const int row0 = u.pm * 256 + wr * 64 + fr, col0 = u.pn * 256 + wc * 32 + 8 * fq; const int b = (u.pm * 256) >> 12;
        f32x4 gg[2][2];
#pragma unroll
        for (int bj = 0; bj < 2; ++bj)
#pragma unroll
            for (int n = 0; n < 2; ++n) gg[bj][n] = *(const f32x4*)(modl + (size_t)b * 6144 + 2048 + col0 + bj * 128 + 4 * n) + 1.0f;
#pragma unroll
        for (int ai = 0; ai < 2; ++ai)
#pragma unroll
            for (int m = 0; m < 4; ++m) { const size_t off = (size_t)(row0 + ai * 128 + m * 16) * 1024 + col0;
#pragma unroll
                for (int bj = 0; bj < 2; ++bj) { f32x4 x0, x1;
                    if (XF32) { x0 = *(const f32x4*)((const float*)xres + off + bj * 128); x1 = *(const f32x4*)((const float*)xres + off + bj * 128 + 4); }
                    else { const v4u xr = *(const v4u*)((const bf16*)xres + off + bj * 128); x0 = (f32x4){bflo(xr.x), bfhi(xr.x), bflo(xr.y), bfhi(xr.y)}; x1 = (f32x4){bflo(xr.z), bfhi(xr.z), bflo(xr.w), bfhi(xr.w)}; }
                    const f32x4 o0 = x0 * DN_ALPHA + gg[bj][0] * acc[ai][bj][m][0], o1 = x1 * DN_ALPHA + gg[bj][1] * acc[ai][bj][m][1];
                    v4u w; w.x = pk2(o0[0], o0[1]); w.y = pk2(o0[2], o0[3]); w.z = pk2(o1[0], o1[1]); w.w = pk2(o1[2], o1[3]);
                    *(v4u*)(YPRE + off + bj * 128) = w; }
                if (m == 3) asm volatile("" ::: "memory"); }
    }
};
struct EpiUp {
    static constexpr int MID_T = 0; static constexpr bool PERM = true, AFTER_DRAIN = false;
    const float* bup  ; bf16* ACT;
    __device__ __forceinline__ void operator()(const f32x4 (&acc)[2][2][4][2], const pg8::Unit& u, int wr, int wc, int fr, int fq) const {
        const int e = u.pn >> 3, pnl = u.pn & 7; const int row0 = u.pm * 256 + wr * 64 + fr, ac0 = pnl * 128 + wc * 32 + 8 * fq;
        const f32x4* bp = (const f32x4*)(bup + (size_t)e * 2048 + 2 * ac0); const f32x4 b0 = bp[0], b1 = bp[1], b2 = bp[2], b3 = bp[3];
        const float bg[8] = {b0[0], b0[2], b1[0], b1[2], b2[0], b2[2], b3[0], b3[2]}, bl[8] = {b0[1], b0[3], b1[1], b1[3], b2[1], b2[3], b3[1], b3[3]};
#pragma unroll
        for (int ai = 0; ai < 2; ++ai)
#pragma unroll
            for (int m = 0; m < 4; ++m) { float a[8];
#pragma unroll
                for (int j = 0; j < 8; ++j) { const float hg = acc[ai][0][m][j >> 2][j & 3] + bg[j], hl = acc[ai][1][m][j >> 2][j & 3] + bl[j];
                    const float glu = fminf(hg, 7.0f), lin = fminf(fmaxf(hl, -7.0f), 7.0f);
                    a[j] = glu * frcp(1.0f + fexp2(-2.4554669595930156f * glu)) * (lin + 1.0f); }
                v4u w; w.x = pk2(a[0], a[1]); w.y = pk2(a[2], a[3]); w.z = pk2(a[4], a[5]); w.w = pk2(a[6], a[7]);
                *(v4u*)(ACT + (size_t)(row0 + ai * 128 + m * 16) * 1024 + ac0) = w; }
    }
};
struct EpiDn {
    static constexpr int MID_T = 0; static constexpr bool PERM = true, AFTER_DRAIN = false;
    const float* bdn  ; bf16* YKS;
    __device__ __forceinline__ void operator()(const f32x4 (&acc)[2][2][4][2], const pg8::Unit& u, int wr, int wc, int fr, int fq) const {
        const int e = u.pn >> 2, pnl = u.pn & 3; const int row0 = u.pm * 256 + wr * 64 + fr, col0 = pnl * 256 + wc * 32 + 8 * fq;
        f32x4 bv[2][2];
#pragma unroll
        for (int bj = 0; bj < 2; ++bj)
#pragma unroll
            for (int n = 0; n < 2; ++n) bv[bj][n] = *(const f32x4*)(bdn + (size_t)e * 1024 + col0 + bj * 128 + 4 * n);
#pragma unroll
        for (int ai = 0; ai < 2; ++ai)
#pragma unroll
            for (int m = 0; m < 4; ++m) { bf16* op = YKS + (size_t)(row0 + ai * 128 + m * 16) * 1024 + col0;
#pragma unroll
                for (int bj = 0; bj < 2; ++bj) { const f32x4 v0 = acc[ai][bj][m][0] + bv[bj][0], v1 = acc[ai][bj][m][1] + bv[bj][1]; v4u w;
                    w.x = pk2(v0[0], v0[1]); w.y = pk2(v0[2], v0[3]); w.z = pk2(v1[0], v1[1]); w.w = pk2(v1[2], v1[3]);
                    *(v4u*)(op + bj * 128) = w; } }
    }
};
struct MoeOrder {
    static constexpr bool GATHER = false; __device__ __forceinline__ int arow(int, int r) const { return r; }
    int nM, nN, nwg, G, c, rev; const LAS unsigned char* tile_e;
    __device__ void init(int RT, int NN, int G_, int c_, const LAS unsigned char* te, int rev_ = 0) { nM = RT; nN = NN; nwg = RT * NN; G = G_; c = c_; tile_e = te; rev = rev_; }
    __device__ bool next(int i, pg8::Unit& u) const {
        const long L = (long)i * G + c; if (L >= nwg) return false;
        int wgid = (int)L; { const int q = nwg / pg8::NXCD, r = nwg % pg8::NXCD, xcd = wgid % pg8::NXCD, off = wgid / pg8::NXCD; wgid = (xcd < r ? xcd * (q + 1) : r * (q + 1) + (xcd - r) * q) + off; }
        const int nig = pg8::WGM * nN, gid = wgid / nig, fm = gid * pg8::WGM, gsz = (nM - fm) < pg8::WGM ? (nM - fm) : pg8::WGM;
        int pm = fm + ((wgid % nig) % gsz); const int pnl = (wgid % nig) / gsz; if (rev) pm = nM - 1 - pm;
        u.pm = pm; u.pn = (int)tile_e[pm] * nN + pnl; return true;
    }
    __device__ __forceinline__ void a_ready(const pg8::Unit&) const {}
    __device__ __forceinline__ void done(const pg8::Unit&) const {}
};

#ifndef STAG_N
#define STAG_N 1
#endif
#ifndef STAG_US
#define STAG_US 24
#endif
__device__ __forceinline__ void stagger(int slot, int us) {
    if (STAG_N <= 1) return;
    const unsigned long long t0 = __builtin_amdgcn_s_memrealtime(); const unsigned long long ticks = (unsigned long long)(slot % STAG_N) * (unsigned)us * 100ull / STAG_N;
    while (__builtin_amdgcn_s_memrealtime() - t0 < ticks) __builtin_amdgcn_s_sleep(16);
}
struct MoeGatherOrder : MoeOrder {
    static constexpr bool GATHER = true; const LAS unsigned short* tokl;
    __device__ __forceinline__ int arow(int ord, int r) const { return (int)tokl[ord * 256 + (r & 255)]; }
};
constexpr int X_TOKL = XOFF + 6144, TOKL_UNITS = 20;
struct TrItem { const float* src; bf16* dst; int ld, K, kind, k0, c0, koff; };
__device__ __forceinline__ void tr_load(const TrItem& t, int lane, f32x4 (&r)[8]) {
    if (t.kind == 0) { const int kk = lane >> 3, cc = lane & 7;
#pragma unroll
        for (int i = 0; i < 8; ++i) r[i] = *(const f32x4*)(t.src + (size_t)(t.k0 + kk + 8 * i) * t.ld + t.c0 + 4 * cc); }
    else { const int kk = lane >> 4, cc = lane & 15;
#pragma unroll
        for (int i = 0; i < 8; ++i) r[i] = *(const f32x4*)(t.src + (size_t)(t.k0 + kk + 4 * i) * t.ld + t.c0 + 4 * cc); }
}
__device__ __forceinline__ void tr_store(const TrItem& t, int lane, LAS float* scr, const f32x4 (&r)[8]) {
    if (t.kind == 0) { const int kk = lane >> 3, cc = lane & 7;
#pragma unroll
        for (int i = 0; i < 8; ++i) { LAS float* p = scr + (kk + 8 * i) * 33 + 4 * cc; p[0] = r[i][0]; p[1] = r[i][1]; p[2] = r[i][2]; p[3] = r[i][3]; }
        LDS_WAIT(); asm volatile("" ::: "memory");
        const int c = lane & 7;
#pragma unroll
        for (int j = 0; j < 4; ++j) { const int n = (lane >> 3) + 8 * j; const LAS float* sp = scr + (8 * c) * 33 + n;
            v4u o; o.x = pk2(sp[0 * 33], sp[1 * 33]); o.y = pk2(sp[2 * 33], sp[3 * 33]); o.z = pk2(sp[4 * 33], sp[5 * 33]); o.w = pk2(sp[6 * 33], sp[7 * 33]);
            __builtin_nontemporal_store(o, (v4u*)(t.dst + (size_t)(t.c0 + n) * t.K + t.koff + t.k0 + 8 * c)); }
    } else { const int kk = lane >> 4, cc = lane & 15; const int p = t.c0 >> 8, x0 = (t.c0 & 255) >> 1;
#pragma unroll
        for (int i = 0; i < 8; ++i) { LAS float* q = scr + (kk + 4 * i) * 65 + 4 * cc; q[0] = r[i][0]; q[1] = r[i][1]; q[2] = r[i][2]; q[3] = r[i][3]; }
        LDS_WAIT(); asm volatile("" ::: "memory");
        const int c = lane & 3;
#pragma unroll
        for (int j = 0; j < 4; ++j) { const int rr = (lane >> 2) + 16 * j, bj = rr >> 5, x = rr & 31; const LAS float* sp = scr + (8 * c) * 65 + 2 * x + bj;
            v4u o; o.x = pk2(sp[0 * 65], sp[1 * 65]); o.y = pk2(sp[2 * 65], sp[3 * 65]); o.z = pk2(sp[4 * 65], sp[5 * 65]); o.w = pk2(sp[6 * 65], sp[7 * 65]);
            __builtin_nontemporal_store(o, (v4u*)(t.dst + (size_t)(256 * p + 128 * bj + x0 + x) * 1024 + t.k0 + 8 * c)); }
    }
    LDS_WAIT(); asm volatile("" ::: "memory");
}
__device__ __forceinline__ void sincos_d(double a, double& s, double& c) {
    const double k = rint(a * 0.63661977236758134308);
    const double y = fma(-k, 6.12323399573676603587e-17, fma(-k, 1.57079632679489655800, a));
    const double y2 = y * y;
    double sp = -7.6471637318198164759e-13; sp = fma(sp, y2, 1.6059043836821614599e-10); sp = fma(sp, y2, -2.5052108385441718775e-8); sp = fma(sp, y2, 2.7557319223985890653e-6);
    sp = fma(sp, y2, -1.9841269841269841270e-4); sp = fma(sp, y2, 8.3333333333333333333e-3); sp = fma(sp, y2, -1.6666666666666666667e-1); const double sy = fma(sp * y2, y, y);
    double cp = 4.7794773323873852974e-14; cp = fma(cp, y2, -1.1470745597729724714e-11); cp = fma(cp, y2, 2.0876756987868098979e-9); cp = fma(cp, y2, -2.7557319223985890653e-7);
    cp = fma(cp, y2, 2.4801587301587301587e-5); cp = fma(cp, y2, -1.3888888888888888889e-3); cp = fma(cp, y2, 4.1666666666666666667e-2); cp = fma(cp, y2, -0.5); const double cy = fma(cp, y2, 1.0);
    const int q = ((int)k) & 3;
    s = (q == 0) ? sy : (q == 1) ? cy : (q == 2) ? -sy : -cy;
    c = (q == 0) ? cy : (q == 1) ? -sy : (q == 2) ? -cy : sy;
}
__device__ __forceinline__ void phase_pro_a(Frame& F) {
    LAS float* scr = (LAS float*)(F.lds + F.wave * 16384);
    const int gw = F.vcu * 8 + F.wave, NGW = F.G * 8;
    constexpr int I_IN = 16 * 272, I_SQ = 16 * 32, I_BB = 8 * 32, I_UP = 32 * 32;
    constexpr int S0 = NL * I_IN, S1 = S0 + NL * I_SQ, S2 = S1 + NL * I_BB, S3 = S2 + NL * I_SQ, S4 = S3 + NL * NE * I_SQ, S5 = S4 + NL * NE * I_UP;
    auto decode = [&](int it) -> TrItem { TrItem t; t.koff = 0;
        if (it < S0) { const int l = it / I_IN, r = it % I_IN; t.src = F.in[I_WIN] + (size_t)l * D * NIN; t.dst = wsp<bf16>(F, WS_WIN) + (size_t)l * NIN * D; t.ld = NIN; t.K = D; t.kind = 0; t.k0 = 64 * (r / 272); t.c0 = 32 * (r % 272); }
        else if (it < S1) { const int q = it - S0, l = q / I_SQ, r = q % I_SQ; t.src = F.in[I_WBA] + (size_t)l * D * D; t.dst = wsp<bf16>(F, WS_WBA) + (size_t)l * D * 1536; t.ld = D; t.K = 1536; t.kind = 0; t.k0 = 64 * (r / 32); t.c0 = 32 * (r % 32); }
        else if (it < S2) { const int q = it - S1, l = q / I_BB, r = q % I_BB; t.src = F.in[I_WBB] + (size_t)l * 512 * D; t.dst = wsp<bf16>(F, WS_WBA) + (size_t)l * D * 1536; t.ld = D; t.K = 1536; t.koff = 1024; t.kind = 0; t.k0 = 64 * (r / 32); t.c0 = 32 * (r % 32); }
        else if (it < S3) { const int q = it - S2, l = q / I_SQ, r = q % I_SQ; t.src = F.in[I_WOUT] + (size_t)l * D * D; t.dst = wsp<bf16>(F, WS_WOUT) + (size_t)l * D * D; t.ld = D; t.K = D; t.kind = 0; t.k0 = 64 * (r / 32); t.c0 = 32 * (r % 32); }
        else if (it < S4) { const int q = it - S3, le = q / I_SQ, r = q % I_SQ; t.src = F.in[I_WDN] + (size_t)le * FF * D; t.dst = wsp<bf16>(F, WS_WDN) + (size_t)le * D * FF; t.ld = D; t.K = FF; t.kind = 0; t.k0 = 64 * (r / 32); t.c0 = 32 * (r % 32); }
        else { const int q = it - S4, le = q / I_UP, r = q % I_UP; t.src = F.in[I_WUP] + (size_t)le * D * 2048; t.dst = wsp<bf16>(F, WS_WUP) + (size_t)le * 2048 * D; t.ld = 2048; t.K = D; t.kind = 1; t.k0 = 32 * (r / 32); t.c0 = 64 * (r % 32); }
        return t; };
    {
        f32x4 rn[8]; TrItem tn; int it = gw;
        if (it < S5) { tn = decode(it); tr_load(tn, F.lane, rn); }
#pragma unroll 1
        for (; it < S5; it += NGW) {
            const TrItem tc = tn; f32x4 rc[8];
#pragma unroll
            for (int i = 0; i < 8; ++i) rc[i] = rn[i];
            if (it + NGW < S5) { tn = decode(it + NGW); tr_load(tn, F.lane, rn); }
            tr_store(tc, F.lane, scr, rc);
        }
    }
    __syncthreads();
    {
        LAS float* red = (LAS float*)F.lds;
        const float* cv = F.in[I_C];
        for (int u = F.vcu; u < NL * 96; u += F.G) {
            const int l = u / 96, n0 = 64 * (u % 96);
            float a[8];
#pragma unroll
            for (int b = 0; b < 8; ++b) a[b] = 0.f;
            const float* wp = F.in[I_WADA] + (size_t)l * D * 6144 + (size_t)(F.wave * 128) * 6144 + n0 + F.lane;
#pragma unroll 4
            for (int kk = 0; kk < 128; ++kk) { const float w = wp[(size_t)kk * 6144]; const int k = F.wave * 128 + kk;
#pragma unroll
                for (int b = 0; b < 8; ++b) a[b] += cv[b * 1024 + k] * w; }
#pragma unroll
            for (int b = 0; b < 8; ++b) red[(F.wave * 8 + b) * 64 + F.lane] = a[b];
            __syncthreads();
            { const int b = F.tid >> 6, ln = F.tid & 63; float s = F.in[I_BADA][l * 6144 + n0 + ln];
#pragma unroll
              for (int w = 0; w < 8; ++w) s += red[(w * 8 + b) * 64 + ln];
              wsp<float>(F, WS_MOD)[(size_t)(l * 8 + b) * 6144 + n0 + ln] = s; }
            __syncthreads();
        }
    }
    const int gt = F.vcu * 512 + F.tid, NT = F.G * 512;
    for (int i = gt; i < SEQ * 8; i += NT) { const int pos = i >> 3, f = i & 7;
        const double inv = (f == 0) ? 1.0 : (f == 1) ? 0.19392274474868576 : (f == 2) ? 0.03760603093086393 : (f == 3) ? 0.007292664737217109 : (f == 4) ? 0.001414213562373095 : (f == 5) ? 0.0002742481756762073 : (f == 6) ? 5.318295896944988e-05 : 1.031338537721246e-05;
        double s, c; sincos_d((double)pos * inv, s, c);
        float* rp = wsp<float>(F, WS_ROPE) + (size_t)pos * 16; rp[f] = (float)c; rp[8 + f] = (float)s; }
    for (int i = gt; i < NL * 4 * 128 * 128; i += NT) { const int j = i & 127, ii = (i >> 7) & 127; const float w = F.in[I_SPW][i];
        wsp<bf16>(F, WS_WSP)[i] = (bf16)(pk2((j <= ii) ? w : 0.f, 0.f) & 0xffffu); }
    for (int i = gt; i < NL * NE * D; i += NT) { const int k = i & 1023, e = (i >> 10) & 31, l = i >> 15; const float w = F.in[I_WR][((size_t)l * D + k) * NE + e];
        const unsigned hi = pk2(w, 0.f) & 0xffffu; const float lo = w - __uint_as_float(hi << 16);
        wsp<bf16>(F, WS_WRT)[i] = (bf16)hi; wsp<bf16>(F, WS_WRT)[NL * NE * D + i] = (bf16)(pk2(lo, 0.f) & 0xffffu); }
}
__device__ __forceinline__ void phase_pro_b(Frame& F) {
    const int gw = F.vcu * 8 + F.wave, NGW = F.G * 8;
    const float* mod = wsp<float>(F, WS_MOD);
    for (int m = gw; m < T; m += NGW) { const int b = m >> 12; const float* mb = mod + (size_t)b * 6144;
        const f32x4* xr = (const f32x4*)(F.in[I_X] + (size_t)m * D) + F.lane; v2u* hp = (v2u*)(wsp<bf16>(F, WS_H) + (size_t)m * D) + F.lane;
#pragma unroll
        for (int j = 0; j < 4; ++j) { const f32x4 x = xr[64 * j]; const f32x4 sh = *((const f32x4*)mb + F.lane + 64 * j), sc = *((const f32x4*)(mb + 1024) + F.lane + 64 * j);
            const f32x4 h = x * (sc + 1.0f) + sh; v2u o; o.x = pk2(h[0], h[1]); o.y = pk2(h[2], h[3]); hp[64 * j] = o; } }
}

constexpr int AT_RS = 144;
constexpr int AT_ROWS = 400, AT_VOFF = AT_ROWS * AT_RS;
#define LDS_BARRIER() do { asm volatile("s_waitcnt lgkmcnt(0)" ::: "memory"); __builtin_amdgcn_s_barrier(); asm volatile("" ::: "memory"); } while (0)
struct AtUnit { int g, b, h, r, n, d; size_t hoff; };
__device__ __forceinline__ AtUnit at_decode(int u) { AtUnit a; a.g = u >> 10; const int rem = u & 1023; a.b = rem >> 7; a.h = (rem >> 4) & 7; const int rn = rem & 15;
    const int dsh = 2 * a.g, nbs = 4 - dsh; a.d = 1 << dsh; a.r = rn >> nbs; a.n = 2 * (rn & ((1 << nbs) - 1)); a.hoff = (size_t)a.g * 512 + a.h * 64; return a; }
constexpr int AT_NU = 3 * 1024;
struct AtSlot { v4u k[6], v[6]; bf16x8 q0, q1, q2, q3; };
struct AtCtx { const bf16 *Qb, *Kb, *Vb; bf16* OG; float* LSE; LAS unsigned char *Ks, *Vs; int qi, g4, piece, jr; };
__device__ __forceinline__ void at_load(AtSlot& sl, int uu, const AtCtx& C, const Frame& F) {
    const AtUnit a_ = at_decode(uu);
#pragma unroll
    for (int ps = 0; ps < 6; ++ps) { const int lp = 128 * (a_.n - 1) + ps * 64 + C.jr; sl.k[ps] = (v4u){0u, 0u, 0u, 0u}; sl.v[ps] = sl.k[ps];
        if (lp >= 0) { const size_t off = ((size_t)a_.b * SEQ + (size_t)lp * a_.d + a_.r) * 1536 + a_.hoff + C.piece * 8; sl.k[ps] = *(const v4u*)(C.Kb + off); sl.v[ps] = *(const v4u*)(C.Vb + off); } }
    const size_t qrow_ = (size_t)a_.b * SEQ + (size_t)(128 * a_.n + 16 * F.wave + C.qi) * a_.d + a_.r; const bf16* qp = C.Qb + qrow_ * 1536 + a_.hoff + 8 * C.g4;
    sl.q0 = *(const bf16x8*)qp; sl.q1 = *(const bf16x8*)(qp + 32);
    const bf16* qp2 = qp + (size_t)128 * a_.d * 1536; sl.q2 = *(const bf16x8*)qp2; sl.q3 = *(const bf16x8*)(qp2 + 32);
}
__device__ __forceinline__ void at_unit(AtSlot& sl, int u, int unext, const AtCtx& C, const Frame& F) {
    bf16* OG = C.OG; float* LSE = C.LSE; LAS unsigned char* Ks = C.Ks; LAS unsigned char* Vs = C.Vs; const int qi = C.qi, g4 = C.g4;
    const AtUnit au = at_decode(u); const int g = au.g, b = au.b, h = au.h, r = au.r, n = au.n, d = au.d;
#pragma unroll
    for (int ps = 0; ps < 6; ++ps) { const int j = ps * 64 + C.jr; *(LAS v4u*)(Ks + j * AT_RS + C.piece * 16) = sl.k[ps]; *(LAS v4u*)(Vs + j * AT_RS + C.piece * 16) = sl.v[ps]; }
    const bf16x8 sl_q0 = sl.q0, sl_q1 = sl.q1, sl_q2 = sl.q2, sl_q3 = sl.q3;
    LDS_BARRIER();
    if (unext < AT_NU) at_load(sl, unext, C, F);
#pragma unroll
    for (int tq = 0; tq < 2; ++tq)
        {
            const int iq = 128 * tq + 16 * F.wave + qi; const int rb = 128 * tq + 16 * F.wave; const bf16x8 qf0 = tq ? sl_q2 : sl_q0, qf1 = tq ? sl_q3 : sl_q1; const size_t qrow = (size_t)b * SEQ + (size_t)(128 * n + iq) * d + r;
            f32x4 s[10]; float mx = -1e30f; const int dq = qi - 4 * g4; const bool first = (n == 0) && (tq == 0);
#pragma unroll
            for (int st = 0; st < 9; ++st) {
                const LAS unsigned char* kp = Ks + (rb + 16 * st + qi) * AT_RS + g4 * 16;
                const bf16x8 k0 = *(const LAS bf16x8*)kp, k1 = *(const LAS bf16x8*)(kp + 64);
                f32x4 a = (f32x4){0.f, 0.f, 0.f, 0.f};
                a = mfma16(k0, qf0, a); a = mfma16(k1, qf1, a);
                if (st == 0) {
#pragma unroll
                    for (int i = 0; i < 4; ++i) a[i] = (i >= dq) ? a[i] : -1e30f; }
                if (st == 8) {
#pragma unroll
                    for (int i = 0; i < 4; ++i) a[i] = (i <= dq) ? a[i] : -1e30f; }
                if (first) {
#pragma unroll
                    for (int i = 0; i < 4; ++i) a[i] = (rb + 16 * st + 4 * g4 + i >= 128) ? a[i] : -1e30f; }
#pragma unroll
                for (int i = 0; i < 4; ++i) mx = fmaxf(mx, a[i]);
                s[st] = a;
            }
            mx = fmaxf(mx, __shfl_xor(mx, 16)); mx = fmaxf(mx, __shfl_xor(mx, 32));
            float sum = 0.f;
#pragma unroll
            for (int st = 0; st < 9; ++st)
#pragma unroll
                for (int i = 0; i < 4; ++i) { const float p = fexp2(s[st][i] - mx); s[st][i] = p; sum += p; }
            s[9] = (f32x4){0.f, 0.f, 0.f, 0.f};
            sum += __shfl_xor(sum, 16); sum += __shfl_xor(sum, 32);
            f32x4 o[4];
#pragma unroll
            for (int dt = 0; dt < 4; ++dt) o[dt] = (f32x4){0.f, 0.f, 0.f, 0.f};
#pragma unroll
            for (int c = 0; c < 5; ++c) {
                v4u pw; pw.x = pk2(s[2 * c][0], s[2 * c][1]); pw.y = pk2(s[2 * c][2], s[2 * c][3]); pw.z = pk2(s[2 * c + 1][0], s[2 * c + 1][1]); pw.w = pk2(s[2 * c + 1][2], s[2 * c + 1][3]);
                const bf16x8 pf = __builtin_bit_cast(bf16x8, pw);
                const LAS unsigned char* vp = Vs + (rb + 32 * c + 4 * g4 + (qi >> 2)) * AT_RS + 8 * (qi & 3);
#pragma unroll
                for (int dt = 0; dt < 4; ++dt) { const s16x4 lo = tr16(vp + 32 * dt), hi = tr16(vp + 32 * dt + 16 * AT_RS);
                    o[dt] = mfma16(cat8(lo, hi), pf, o[dt]); }
            }
            const float inv = 1.0f / sum;
            bf16* op = OG + ((size_t)g * T + qrow) * 512 + h * 64 + 4 * g4;
#pragma unroll
            for (int dt = 0; dt < 4; ++dt) { v2u w; w.x = pk2(o[dt][0] * inv, o[dt][1] * inv); w.y = pk2(o[dt][2] * inv, o[dt][3] * inv); *(v2u*)(op + 16 * dt) = w; }
            if (g4 == 0) LSE[((size_t)g * T + qrow) * 8 + h] = mx + __log2f(sum);
        }
    LDS_BARRIER();
}
__device__ __forceinline__ void phase_attn(Frame& F) {
    AtCtx C; C.Qb = wsp<bf16>(F, WS_Q); C.Kb = wsp<bf16>(F, WS_K); C.Vb = wsp<bf16>(F, WS_VV); C.OG = wsp<bf16>(F, WS_OG); C.LSE = wsp<float>(F, WS_LSE);
    C.Ks = F.lds; C.Vs = F.lds + AT_VOFF; C.qi = F.lane & 15; C.g4 = F.lane >> 4; C.piece = F.tid & 7; C.jr = F.tid >> 3;
    if (F.tid < 144) { *(LAS v4u*)(C.Ks + 384 * AT_RS + F.tid * 16) = (v4u){0u, 0u, 0u, 0u}; *(LAS v4u*)(C.Vs + 384 * AT_RS + F.tid * 16) = (v4u){0u, 0u, 0u, 0u}; }
    AtSlot sa; const int u0 = F.vcu, G = F.G;
    if (u0 < AT_NU) at_load(sa, u0, C, F);
#pragma unroll 1
    for (int u = u0; u < AT_NU; u += G) at_unit(sa, u, u + G, C, F);
}

constexpr int SG_WOFF = 69632, SG_WRS = 264;
constexpr int SG_RS = 528;
__device__ __forceinline__ void phase_sg(Frame& F, int l) {
    const bf16* Ub = wsp<bf16>(F, WS_U); const bf16* Vb = wsp<bf16>(F, WS_V); bf16* TT = wsp<bf16>(F, WS_TT);
    const bf16* OG = wsp<bf16>(F, WS_OG); const float* LSE = wsp<float>(F, WS_LSE); bf16* OB = wsp<bf16>(F, WS_OB);
    const bf16* Wsp = wsp<bf16>(F, WS_WSP); const float* spb = F.in[I_SPB];
    LAS unsigned char* Vn = F.lds;
    const int qi = F.lane & 15, g4 = F.lane >> 4;
    const int l32 = F.lane & 31;
    v4u vraw[8];
#define SG_LOAD(uu) do { const int gi_ = (uu) & 3, m0_ = ((uu) >> 2) * 128; \
        _Pragma("unroll") for (int ps = 0; ps < 8; ++ps) vraw[ps] = *(const v4u*)(Vb + (size_t)(m0_ + 16 * ps + 2 * F.wave + (F.lane >> 5)) * 1024 + gi_ * 256 + 8 * l32); } while (0)
    if (F.vcu < 1024) SG_LOAD(F.vcu);
    const bool wlds = (F.G & 3) == 0; LAS unsigned char* Wl = F.lds + SG_WOFF;
    if (wlds) { const bf16* wsrc = Wsp + (size_t)(l * 4 + (F.vcu & 3)) * 128 * 128;
        for (int i = F.tid; i < 128 * 16; i += 512) { const int row = i >> 4, ch = i & 15; const v4u wv = *(const v4u*)(wsrc + row * 128 + ch * 8);
            *(LAS v2u*)(Wl + row * SG_WRS + ch * 16) = (v2u){wv.x, wv.y}; *(LAS v2u*)(Wl + row * SG_WRS + ch * 16 + 8) = (v2u){wv.z, wv.w}; } }
    for (int u = F.vcu; u < 1024; u += F.G) {
        const int gi = u & 3, m0 = (u >> 2) * 128;
        float ml[4][3]; v4u mo[4][3]; const int sub = F.tid & 7;
#pragma unroll
        for (int ps = 0; ps < 4; ++ps) { const int p = (F.tid >> 3) + 64 * ps; const size_t tok = (size_t)m0 + (p >> 1); const int hd = 2 * gi + (p & 1); const size_t off = tok * 512 + hd * 64 + 8 * sub;
#pragma unroll
            for (int gq = 0; gq < 3; ++gq) { ml[ps][gq] = LSE[((size_t)gq * T + tok) * 8 + hd]; mo[ps][gq] = *(const v4u*)(OG + (size_t)gq * T * 512 + off); } }
        {
            float sm[8], mean[8], rs[8];
#pragma unroll
            for (int ps = 0; ps < 8; ++ps) { const v4u raw = vraw[ps]; sm[ps] = ((bflo(raw.x) + bfhi(raw.x)) + (bflo(raw.y) + bfhi(raw.y))) + ((bflo(raw.z) + bfhi(raw.z)) + (bflo(raw.w) + bfhi(raw.w))); }
#pragma unroll
            for (int o = 1; o < 32; o <<= 1) {
#pragma unroll
                for (int ps = 0; ps < 8; ++ps) sm[ps] += __shfl_xor(sm[ps], o); }
#pragma unroll
            for (int ps = 0; ps < 8; ++ps) { const v4u raw = vraw[ps]; mean[ps] = sm[ps] * (1.0f / 256.0f); float q = 0.f;
                const float x[8] = {bflo(raw.x), bfhi(raw.x), bflo(raw.y), bfhi(raw.y), bflo(raw.z), bfhi(raw.z), bflo(raw.w), bfhi(raw.w)};
#pragma unroll
                for (int e = 0; e < 8; ++e) { const float dx = x[e] - mean[ps]; q += dx * dx; }
                sm[ps] = q; }
#pragma unroll
            for (int o = 1; o < 32; o <<= 1) {
#pragma unroll
                for (int ps = 0; ps < 8; ++ps) sm[ps] += __shfl_xor(sm[ps], o); }
#pragma unroll
            for (int ps = 0; ps < 8; ++ps) { rs[ps] = 1.0f / sqrtf(sm[ps] * (1.0f / 256.0f) + LN_EPS); const v4u raw = vraw[ps]; const int j = 16 * ps + 2 * F.wave + (F.lane >> 5);
                const float x[8] = {bflo(raw.x), bfhi(raw.x), bflo(raw.y), bfhi(raw.y), bflo(raw.z), bfhi(raw.z), bflo(raw.w), bfhi(raw.w)};
                v4u w; w.x = pk2((x[0] - mean[ps]) * rs[ps], (x[1] - mean[ps]) * rs[ps]); w.y = pk2((x[2] - mean[ps]) * rs[ps], (x[3] - mean[ps]) * rs[ps]);
                w.z = pk2((x[4] - mean[ps]) * rs[ps], (x[5] - mean[ps]) * rs[ps]); w.w = pk2((x[6] - mean[ps]) * rs[ps], (x[7] - mean[ps]) * rs[ps]);
                *(LAS v4u*)(Vn + j * SG_RS + l32 * 16) = w; }
        }
        LDS_BARRIER();
        if (u + F.G < 1024) SG_LOAD(u + F.G);
        {
#pragma unroll
          for (int ps = 0; ps < 4; ++ps) { const int p = (F.tid >> 3) + 64 * ps; const size_t tok = (size_t)m0 + (p >> 1); const int hd = 2 * gi + (p & 1);
              const float l0 = ml[ps][0], l1 = ml[ps][1], l2 = ml[ps][2];
              const float mxx = fmaxf(l0, fmaxf(l1, l2)); float w0 = fexp2(l0 - mxx), w1 = fexp2(l1 - mxx), w2 = fexp2(l2 - mxx); const float inv = 1.0f / (w0 + w1 + w2); w0 *= inv; w1 *= inv; w2 *= inv;
              const size_t off = tok * 512 + hd * 64 + 8 * sub;
              const v4u a = mo[ps][0], bq = mo[ps][1], cq = mo[ps][2]; v4u w;
              w.x = pk2(w0 * bflo(a.x) + w1 * bflo(bq.x) + w2 * bflo(cq.x), w0 * bfhi(a.x) + w1 * bfhi(bq.x) + w2 * bfhi(cq.x));
              w.y = pk2(w0 * bflo(a.y) + w1 * bflo(bq.y) + w2 * bflo(cq.y), w0 * bfhi(a.y) + w1 * bfhi(bq.y) + w2 * bfhi(cq.y));
              w.z = pk2(w0 * bflo(a.z) + w1 * bflo(bq.z) + w2 * bflo(cq.z), w0 * bfhi(a.z) + w1 * bfhi(bq.z) + w2 * bfhi(cq.z));
              w.w = pk2(w0 * bflo(a.w) + w1 * bflo(bq.w) + w2 * bflo(cq.w), w0 * bfhi(a.w) + w1 * bfhi(bq.w) + w2 * bfhi(cq.w));
              *(v4u*)(TT + tok * 1536 + 1024 + hd * 64 + 8 * sub) = w; } }
        v2u uq[8][2]; float ubias[8];
#pragma unroll
        for (int it = 0; it < 8; ++it) { const int i = 16 * it + qi; ubias[it] = spb[(l * 4 + gi) * 128 + i]; const size_t rowo = (size_t)(m0 + i) * 1024 + gi * 256 + 32 * F.wave + 4 * g4;
            uq[it][0] = *(const v2u*)(Ub + rowo); uq[it][1] = *(const v2u*)(Ub + rowo + 16); }
        {
            f32x4 acc[2][8];
#pragma unroll
            for (int ct = 0; ct < 2; ++ct)
#pragma unroll
                for (int it = 0; it < 8; ++it) acc[ct][it] = (f32x4){0.f, 0.f, 0.f, 0.f};
            const bf16* wbase = Wsp + (size_t)(l * 4 + gi) * 128 * 128 + (size_t)qi * 128 + 4 * g4;
#pragma unroll
            for (int kc = 0; kc < 4; ++kc) {
                bf16x8 af[2];
#pragma unroll
                for (int ct = 0; ct < 2; ++ct) { const LAS unsigned char* p = Vn + (32 * kc + 4 * g4 + (qi >> 2)) * SG_RS + (32 * F.wave + 16 * ct + 4 * (qi & 3)) * 2;
                    af[ct] = cat8(tr16(p), tr16(p + 16 * SG_RS)); }
#pragma unroll
                for (int it = 0; it < 8; ++it) if (it >= 2 * kc) {
                    const bf16* wp = wbase + (size_t)(16 * it) * 128 + 32 * kc; const LAS unsigned char* wq = Wl + (16 * it + qi) * SG_WRS + (32 * kc + 4 * g4) * 2;
                    const v2u b0 = wlds ? *(const LAS v2u*)wq : *(const v2u*)wp, b1 = wlds ? *(const LAS v2u*)(wq + 32) : *(const v2u*)(wp + 16);
                    const bf16x8 bfr = __builtin_bit_cast(bf16x8, (v4u){b0.x, b0.y, b1.x, b1.y});
                    acc[0][it] = mfma16(af[0], bfr, acc[0][it]); acc[1][it] = mfma16(af[1], bfr, acc[1][it]); }
            }
#pragma unroll
            for (int it = 0; it < 8; ++it) { const int i = 16 * it + qi; const float bias = ubias[it]; const size_t rowo = (size_t)(m0 + i) * 1536 + gi * 256 + 32 * F.wave + 4 * g4;
#pragma unroll
                for (int ct = 0; ct < 2; ++ct) { const v2u uu = uq[it][ct]; const f32x4 a = acc[ct][it]; v2u w;
                    w.x = pk2(bflo(uu.x) * (a[0] + bias), bfhi(uu.x) * (a[1] + bias)); w.y = pk2(bflo(uu.y) * (a[2] + bias), bfhi(uu.y) * (a[3] + bias));
                    *(v2u*)(TT + rowo + 16 * ct) = w; } }
        }
        LDS_BARRIER();
    }
#undef SG_LOAD
}

__device__ __forceinline__ void phase_ln1(Frame& F, int l, bool commit) {
    const bf16* YPRE = wsp<bf16>(F, WS_YPRE); bf16* H = wsp<bf16>(F, WS_H);
    const float* modl = wsp<float>(F, WS_MOD) + (size_t)l * 8 * 6144;
    const float* lg = F.in[I_LN1G] + l * D; const float* lb = F.in[I_LN1B] + l * D; const float* br = F.in[I_BR] + l * NE;
    const bf16* WH = wsp<bf16>(F, WS_WRT) + (size_t)l * NE * D; const bf16* WL = WH + (size_t)NL * NE * D;
    int* TOKINFO = wsp<int>(F, WS_TOKINFO); float* TOKW = wsp<float>(F, WS_TOKW);
    unsigned* cntg = wsp<unsigned>(F, WS_CTL) + CW_CNT + (size_t)l * NE * 64;
    LAS int* sel_e = (LAS int*)(F.lds + X_SELE);
    const int lane = F.lane, qi = lane & 15, g4 = lane >> 4;
    { const v4u* srcw = (const v4u*)WH;
#pragma unroll 4
      for (int i = F.tid; i < 2 * NE * 128; i += 512) { const int hl = i >> 12, e = (i >> 7) & 31, c = i & 127;
          *(LAS v4u*)(F.lds + hl * 65536 + e * 2048 + ((c ^ (e & 15)) << 4)) = srcw[(size_t)hl * (NL * NE * 128) + e * 128 + c]; } }
    __syncthreads();
    for (int tb = F.vcu; tb < T / 128; tb += F.G) {
        const int m0 = tb * 128; const int b = m0 >> 12; const float* mb = modl + (size_t)b * 6144; const int mw = m0 + 16 * F.wave;
        v2u pre[4][4];
#pragma unroll
        for (int r = 0; r < 4; ++r)
#pragma unroll
            for (int j = 0; j < 4; ++j) pre[r][j] = *((const v2u*)(YPRE + (size_t)(mw + r) * D) + lane + 64 * j);
#pragma unroll 1
        for (int rp = 0; rp < 4; ++rp) {
            f32x4 hh[4][4]; float mean[4], rstd[4];
            const int mrow = mw + 4 * rp;
#pragma unroll
            for (int r = 0; r < 4; ++r)
#pragma unroll
                for (int j = 0; j < 4; ++j) hh[r][j] = (f32x4){bflo(pre[r][j].x), bfhi(pre[r][j].x), bflo(pre[r][j].y), bfhi(pre[r][j].y)};
            if (rp < 3) {
#pragma unroll
                for (int r = 0; r < 4; ++r)
#pragma unroll
                    for (int j = 0; j < 4; ++j) pre[r][j] = *((const v2u*)(YPRE + (size_t)(mrow + 4 + r) * D) + lane + 64 * j); }
            { float sm[4], sq[4];
#pragma unroll
              for (int r = 0; r < 4; ++r) { sm[r] = 0.f; sq[r] = 0.f;
#pragma unroll
                  for (int j = 0; j < 4; ++j) { sm[r] += (hh[r][j][0] + hh[r][j][1]) + (hh[r][j][2] + hh[r][j][3]);
                      sq[r] += (hh[r][j][0] * hh[r][j][0] + hh[r][j][1] * hh[r][j][1]) + (hh[r][j][2] * hh[r][j][2] + hh[r][j][3] * hh[r][j][3]); } }
#pragma unroll
              for (int o = 1; o < 64; o <<= 1) {
#pragma unroll
                  for (int r = 0; r < 4; ++r) { sm[r] += __shfl_xor(sm[r], o); sq[r] += __shfl_xor(sq[r], o); } }
#pragma unroll
              for (int r = 0; r < 4; ++r) { mean[r] = sm[r] * (1.0f / D); rstd[r] = 1.0f / sqrtf(fmaxf(sq[r] * (1.0f / D) - mean[r] * mean[r], 0.f) + LN_EPS); } }
            if (lane < 4) { const float mq = (lane == 0) ? mean[0] : (lane == 1) ? mean[1] : (lane == 2) ? mean[2] : mean[3], rq = (lane == 0) ? rstd[0] : (lane == 1) ? rstd[1] : (lane == 2) ? rstd[2] : rstd[3];
                float* st = wsp<float>(F, WS_STAT) + (size_t)(mrow + lane) * 2; st[0] = mq; st[1] = rq; }
#pragma unroll
            for (int j = 0; j < 4; ++j) { const f32x4 gq = *((const f32x4*)lg + lane + 64 * j), bq = *((const f32x4*)lb + lane + 64 * j);
                const f32x4 shq = *((const f32x4*)(mb + 3072) + lane + 64 * j), scq = *((const f32x4*)(mb + 4096) + lane + 64 * j) + 1.0f;
#pragma unroll
                for (int r = 0; r < 4; ++r) { const f32x4 x1 = (hh[r][j] - mean[r]) * rstd[r] * gq + bq;
                    const f32x4 h2 = x1 * scq + shq; v2u o; o.x = pk2(h2[0], h2[1]); o.y = pk2(h2[2], h2[3]); *((v2u*)(H + (size_t)(mrow + r) * D) + lane + 64 * j) = o;
 } }
        }
        VM_WAIT(); asm volatile("" ::: "memory");
        f32x4 c0 = (f32x4){0.f, 0.f, 0.f, 0.f}, c1 = c0;
        { const bf16* hp = H + (size_t)(mw + qi) * D + 8 * g4;
          const LAS unsigned char* w0 = F.lds + qi * 2048; const LAS unsigned char* w1 = F.lds + (16 + qi) * 2048;
#pragma unroll 8
          for (int ks = 0; ks < 32; ++ks) {
              const bf16x8 hhi = *(const bf16x8*)(hp + 32 * ks);
              const int co = ((4 * ks + g4) ^ qi) << 4;
              const bf16x8 a0h = *(const LAS bf16x8*)(w0 + co), a0l = *(const LAS bf16x8*)(w0 + 65536 + co);
              const bf16x8 a1h = *(const LAS bf16x8*)(w1 + co), a1l = *(const LAS bf16x8*)(w1 + 65536 + co);
              c0 = mfma16(a0h, hhi, c0); c0 = mfma16(a0l, hhi, c0);
              c1 = mfma16(a1h, hhi, c1); c1 = mfma16(a1l, hhi, c1); } }
        {
            float v[8]; int id[8];
#pragma unroll
            for (int i = 0; i < 4; ++i) { id[i] = 4 * g4 + i; id[4 + i] = 16 + 4 * g4 + i; v[i] = c0[i] + br[4 * g4 + i]; v[4 + i] = c1[i] + br[16 + 4 * g4 + i]; }
            int ek[4]; float vk[4];
#pragma unroll
            for (int k = 0; k < 4; ++k) { float lm = v[0]; int li = id[0];
#pragma unroll
                for (int j = 1; j < 8; ++j) if (v[j] > lm) { lm = v[j]; li = id[j]; }
#pragma unroll
                for (int o = 16; o <= 32; o <<= 1) { const float om = __shfl_xor(lm, o); const int oi = __shfl_xor(li, o); if (om > lm || (om == lm && oi < li)) { lm = om; li = oi; } }
                ek[k] = li; vk[k] = lm;
#pragma unroll
                for (int j = 0; j < 8; ++j) if (id[j] == li) v[j] = -INFINITY; }
            const float e1 = __expf(vk[1] - vk[0]), e2 = __expf(vk[2] - vk[0]), e3 = __expf(vk[3] - vk[0]); const float inv = 1.0f / (1.0f + e1 + e2 + e3);
            if (g4 == 0) { const int tl = 16 * F.wave + qi;
                sel_e[tl * 4 + 0] = ek[0]; sel_e[tl * 4 + 1] = ek[1]; sel_e[tl * 4 + 2] = ek[2]; sel_e[tl * 4 + 3] = ek[3];
                *(f32x4*)(TOKW + (size_t)(m0 + tl) * 4) = (f32x4){inv, e1 * inv, e2 * inv, e3 * inv}; }
        }
        __syncthreads();
        { const int myE = sel_e[F.tid]; LAS unsigned long long* bm = (LAS unsigned long long*)(F.lds + X_SELR); unsigned long long mine = 0ull;
#pragma unroll
          for (int e = 0; e < 32; ++e) { const unsigned long long m = __ballot(myE == e); if (lane == e) mine = m; }
          if (lane < 32) bm[F.wave * 32 + lane] = mine;
          __syncthreads();
          int rk = __popcll(bm[F.wave * 32 + myE] & ((1ull << lane) - 1ull));
#pragma unroll
          for (int w = 0; w < 8; ++w) if (w < F.wave) rk += __popcll(bm[w * 32 + myE]);
          TOKINFO[(size_t)m0 * 4 + F.tid] = myE | (rk << 8);
          if (F.tid < 32) { int tot = 0;
#pragma unroll
              for (int w = 0; w < 8; ++w) tot += __popcll(bm[w * 32 + F.tid]);
              wsp<int>(F, WS_WGCNT)[((size_t)l * 256 + tb) * 32 + F.tid] = tot; if (tot && commit) (void)__hip_atomic_fetch_add(cntg + F.tid * 64, (unsigned)tot, RLX_AGENT); } }
        __syncthreads();
    }
}

__device__ __forceinline__ int moe_tables(Frame& F, int l) {
    const unsigned* cntg = wsp<unsigned>(F, WS_CTL) + CW_CNT + (size_t)l * NE * 64;
    LAS int* cnt_s = (LAS int*)(F.lds + X_CNTS); LAS int* off_s = (LAS int*)(F.lds + X_OFFS); LAS unsigned char* tile_e = (LAS unsigned char*)(F.lds + X_TILEE);
    if (F.tid < 32) cnt_s[F.tid] = (int)__hip_atomic_load(cntg + F.tid * 64, RLX_AGENT);
    __syncthreads();
    if (F.tid < 64) {
        const int e = F.tid & 31; const int c = (F.tid < 32) ? cnt_s[e] : 0; const int nt = (c + 255) >> 8; int incl = nt;
#pragma unroll
        for (int o = 1; o < 32; o <<= 1) { const int v = __shfl_up(incl, o); if ((F.tid & 63) >= o) incl += v; }
        if (F.tid < 32) { const int excl = incl - nt; off_s[e] = excl * 256; for (int t = 0; t < nt; ++t) tile_e[excl + t] = (unsigned char)e; if (e == 31) off_s[32] = incl * 256; }
    }
    __syncthreads();
    return off_s[32] >> 8;
}
__device__ __forceinline__ void phase_scat(Frame& F, int l) {
    (void)moe_tables(F, l);
    const LAS int* off_s = (const LAS int*)(F.lds + X_OFFS); const LAS int* cnt_s = (const LAS int*)(F.lds + X_CNTS); LAS int* base_s = (LAS int*)(F.lds + X_BASE);
    const int* TOKINFO = wsp<int>(F, WS_TOKINFO); const float* TOKW = wsp<float>(F, WS_TOKW);
    int* ROWTOK = wsp<int>(F, WS_ROWTOK); float* ROWW = wsp<float>(F, WS_ROWW); const int* WGC = wsp<int>(F, WS_WGCNT) + (size_t)l * 256 * 32; int* TOKINFO2 = wsp<int>(F, WS_TOKROW);
    for (int tb = F.vcu; tb < T / 128; tb += F.G) {
        if (F.tid < 32) base_s[F.tid] = 0;
        __syncthreads();
        { const int e = F.tid & 31, part = F.tid >> 5; int sacc = 0;
          for (int t2 = part * 16; t2 < part * 16 + 16; ++t2) if (t2 < tb) sacc += WGC[t2 * 32 + e];
          if (sacc) atomicAdd((int*)&base_s[e], sacc); }
        __syncthreads();
        { const size_t ent = (size_t)tb * 512 + F.tid; const int info = TOKINFO[ent]; const int e = info & 255, row = off_s[e] + base_s[e] + (info >> 8);
          ROWTOK[row] = (int)ent; ROWW[row] = TOKW[ent]; TOKINFO2[ent] = row; }
        __syncthreads();
    }
    if (F.vcu == 0) for (int e = 0; e < NE; ++e) for (int r = off_s[e] + cnt_s[e] + F.tid; r < off_s[e + 1]; r += 512) { ROWTOK[r] = 0; ROWW[r] = 0.f; }
}
__device__ __forceinline__ void phase_ln2(Frame& F, int l) {
    const bf16* X1 = wsp<bf16>(F, WS_YPRE); const bf16* YK = wsp<bf16>(F, WS_XG); bf16* H = wsp<bf16>(F, WS_H); const int* TOKROW = wsp<int>(F, WS_TOKROW); const float* TOKW = wsp<float>(F, WS_TOKW);
    const float* STAT = wsp<float>(F, WS_STAT); const float* l1g = F.in[I_LN1G] + l * D; const float* l1b = F.in[I_LN1B] + l * D;
    float* XO = F.out; bf16* XB = wsp<bf16>(F, WS_X2);
    const float* modl = wsp<float>(F, WS_MOD) + (size_t)l * 8 * 6144; const float* modn = wsp<float>(F, WS_MOD) + (size_t)((l + 1) & 3) * 8 * 6144;
    const float* lg = F.in[I_LN2G] + l * D; const float* lb = F.in[I_LN2B] + l * D;
    const int lane = F.lane; const int gw = F.vcu * 8 + F.wave, NGW = F.G * 8;
    v2u px[4]; v2u py[4][4]; float pst[2], nst[2]; f32x4 pw4, nw4;
#define LN2_LOAD(mm) do { nst[0] = STAT[(size_t)(mm) * 2]; nst[1] = STAT[(size_t)(mm) * 2 + 1]; nw4 = *(const f32x4*)(TOKW + (size_t)(mm) * 4); \
        int rw_[4]; _Pragma("unroll") for (int k = 0; k < 4; ++k) rw_[k] = TOKROW[(size_t)(mm) * 4 + k]; \
        _Pragma("unroll") for (int j = 0; j < 4; ++j) { px[j] = __builtin_nontemporal_load((const v2u*)(X1 + (size_t)(mm) * D) + lane + 64 * j); \
        _Pragma("unroll") for (int k = 0; k < 4; ++k) py[j][k] = __builtin_nontemporal_load((const v2u*)(YK + (size_t)rw_[k] * D) + lane + 64 * j); } } while (0)
    if (gw < T) LN2_LOAD(gw);
#pragma unroll 1
    for (int m = gw; m < T; m += NGW) { const int b = m >> 12; const float* mb = modl + (size_t)b * 6144; const float* mn = modn + (size_t)b * 6144;
        f32x4 v[4]; float s = 0.f; pst[0] = nst[0]; pst[1] = nst[1]; pw4 = nw4;
#pragma unroll
        for (int j = 0; j < 4; ++j) { f32x4 y = (f32x4){0.f, 0.f, 0.f, 0.f};
#pragma unroll
            for (int k = 0; k < 4; ++k) { const v2u w = py[j][k]; const float cw = pw4[k]; y[0] += cw * bflo(w.x); y[1] += cw * bfhi(w.x); y[2] += cw * bflo(w.y); y[3] += cw * bfhi(w.y); }
            const f32x4 g2 = *((const f32x4*)(mb + 5120) + lane + 64 * j) + 1.0f;
            const f32x4 pxf = (f32x4){bflo(px[j].x), bfhi(px[j].x), bflo(px[j].y), bfhi(px[j].y)};
            const f32x4 x1 = (pxf - pst[0]) * pst[1] * *((const f32x4*)l1g + lane + 64 * j) + *((const f32x4*)l1b + lane + 64 * j);
            v[j] = x1 * DN_ALPHA + g2 * y; s += (v[j][0] + v[j][1]) + (v[j][2] + v[j][3]); }
        if (m + NGW < T) LN2_LOAD(m + NGW);
        float s2 = 0.f;
#pragma unroll
        for (int j = 0; j < 4; ++j) s2 += (v[j][0] * v[j][0] + v[j][1] * v[j][1]) + (v[j][2] * v[j][2] + v[j][3] * v[j][3]);
#pragma unroll
        for (int o = 1; o < 64; o <<= 1) { s += __shfl_xor(s, o); s2 += __shfl_xor(s2, o); }
        const float mean = s * (1.0f / D); const float rstd = 1.0f / sqrtf(fmaxf(s2 * (1.0f / D) - mean * mean, 0.f) + LN_EPS);
#pragma unroll
        for (int j = 0; j < 4; ++j) v[j] = v[j] - mean;
        f32x4* xo = (f32x4*)(XO + (size_t)m * D) + lane; v2u* xb = (v2u*)(XB + (size_t)m * D) + lane; v2u* ho = (v2u*)(H + (size_t)m * D) + lane;
#pragma unroll
        for (int j = 0; j < 4; ++j) { const f32x4 gvj = *((const f32x4*)lg + lane + 64 * j), bvj = *((const f32x4*)lb + lane + 64 * j); const f32x4 x2 = v[j] * rstd * gvj + bvj;
            if (l == NL - 1) __builtin_nontemporal_store(x2, xo + 64 * j); else { v2u xq; xq.x = pk2(x2[0], x2[1]); xq.y = pk2(x2[2], x2[3]); __builtin_nontemporal_store(xq, xb + 64 * j); }
            if (l < NL - 1) { const f32x4 sh = *((const f32x4*)mn + lane + 64 * j), sc = *((const f32x4*)(mn + 1024) + lane + 64 * j) + 1.0f; const f32x4 h = x2 * sc + sh;
                v2u o; o.x = pk2(h[0], h[1]); o.y = pk2(h[2], h[3]); ho[64 * j] = o; } } }
#undef LN2_LOAD
}

#ifndef PH_MASK
#define PH_MASK 0xFFFF
#endif
#define PHM(b) ((PH_MASK >> (b)) & 1)
#ifndef DUP_MASK
#define DUP_MASK 0
#endif
#define REPS(b) (((DUP_MASK >> (b)) & 1) ? 2 : 1)
constexpr int NPH_L = 10, NPHASE = 2 + NL * NPH_L;
struct Args { const float* in[20]; float* out; unsigned char* ws; int ph_lo, ph_hi; };
__global__ void __launch_bounds__(512, 2) fwd(Args args) {
    extern __shared__ __attribute__((aligned(16))) unsigned char lds[];
    Frame F;
    F.lds = (LAS unsigned char*)lds;
#define FRESH() do { int zv_ = 0; asm volatile("" : "+v"(zv_)); const int z_ = __builtin_amdgcn_readfirstlane(zv_); \
        F.tid = (int)threadIdx.x + zv_; F.lane = F.tid & 63; F.wave = __builtin_amdgcn_readfirstlane(F.tid >> 6); \
        F.G = (int)gridDim.x + z_; F.bx = (int)blockIdx.x + z_; F.vcu = (F.G % 8 == 0) ? (F.bx % 8) * (F.G / 8) + F.bx / 8 : F.bx; \
        F.ws = args.ws + z_; F.in = args.in + z_; F.out = args.out + z_; F.lds = (LAS unsigned char*)lds + z_; } while (0)
    FRESH();
    for (int u = F.tid; u < (LDS_BYTES - XOFF) / 4; u += 512) ((LAS unsigned*)(F.lds + XOFF))[u] = 0u;
    __syncthreads();
    unsigned* ctl = wsp<unsigned>(F, WS_CTL);
    XcdBarrier bar; bar.bar = ctl + CW_BAR; bar.x = 0; bar.st = nullptr;
    if (!MK_PER_PHASE) bar = xcd_barrier_post(ctl + CW_BAR, (volatile LAS unsigned*)(F.lds + X_MISC) + 8);
    const int lo = args.ph_lo, hi = args.ph_hi;
#define IN(k) (lo <= (k) && (k) < hi)
#ifndef BAR_REPS
#define BAR_REPS 1
#endif
#define SEAM(k) do { if (!MK_PER_PHASE && IN(k) && IN((k) + 1)) for (int br_ = 0; br_ < BAR_REPS; ++br_) xcd_barrier(bar); } while (0)

    if (PHM(0) && IN(0)) for (int rep = 0; rep < REPS(0); ++rep) { FRESH(); phase_pro_a(F); } SEAM(0);
    if (PHM(1) && IN(1)) for (int rep = 0; rep < REPS(1); ++rep) { FRESH(); phase_pro_b(F); } SEAM(1);
    for (int l = 0; l < NL; ++l) {
        const int pb = 2 + l * NPH_L;
        if (PHM(2) && IN(pb + 0)) for (int rep = 0; rep < REPS(2); ++rep) { FRESH();
            pg8::Gemm g{wsp<bf16>(F, WS_H), wsp<bf16>(F, WS_WIN) + (size_t)l * NIN * D, T, NIN, D}; pg8::StaticOrder S; S.init(T, NIN, F.G, F.bx);
            EpiIn E{wsp<bf16>(F, WS_U), wsp<bf16>(F, WS_V), wsp<bf16>(F, WS_Q), wsp<bf16>(F, WS_K), wsp<bf16>(F, WS_VV), wsp<bf16>(F, WS_G), wsp<float>(F, WS_ROPE)};
            stagger(F.bx >> 3, STAG_US);
            pg8::gemm_phase<EpiIn, pg8::StaticOrder, PG8_ALIGN, PG8_SP2>(F.lds, g, S, E, F.tid);
#if defined(XPROBE)
            { FRESH(); pg8::Gemm g2{wsp<bf16>(F, WS_H), wsp<bf16>(F, WS_WIN) + (size_t)l * NIN * D, T, NIN, D}; pg8::StaticOrder S2; S2.init(T, NIN, F.G, F.bx);
              EpiProbe E2{wsp<bf16>(F, WS_XG), (XPROBE == 3) ? NIN : 1024, (XPROBE >= 2) ? (XPROBE == 3 ? 3 : 1) : (F.G == 0x7ffffff0 ? 1 : 0)};
              pg8::gemm_phase<EpiProbe, pg8::StaticOrder, PG8_ALIGN, PG8_SP2>(F.lds, g2, S2, E2, F.tid); }
#endif
        } SEAM(pb + 0);
        if (PHM(3) && IN(pb + 1)) for (int rep = 0; rep < REPS(3); ++rep) { FRESH(); phase_attn(F); } SEAM(pb + 1);
        if (PHM(4) && IN(pb + 2)) for (int rep = 0; rep < REPS(4); ++rep) { FRESH(); phase_sg(F, l); } SEAM(pb + 2);
        if (PHM(5) && IN(pb + 3)) for (int rep = 0; rep < REPS(5); ++rep) { FRESH();
            pg8::Gemm g{wsp<bf16>(F, WS_TT), wsp<bf16>(F, WS_WBA) + (size_t)l * D * 1536, T, D, 1536}; pg8::StaticOrder S; S.init(T, D, F.G, F.bx);
            EpiMg2 E{wsp<bf16>(F, WS_G), wsp<bf16>(F, WS_MG)}; pg8::gemm_phase<EpiMg2, pg8::StaticOrder, PG8_ALIGN, PG8_SP2>(F.lds, g, S, E, F.tid);
        } SEAM(pb + 3);
        if (PHM(6) && IN(pb + 4)) for (int rep = 0; rep < REPS(6); ++rep) { FRESH();
            pg8::Gemm g{wsp<bf16>(F, WS_MG), wsp<bf16>(F, WS_WOUT) + (size_t)l * D * D, T, D, D}; pg8::StaticOrder S; S.init(T, D, F.G, F.bx);
            if (l == 0) { EpiOut<true> E{(const void*)F.in[I_X], wsp<float>(F, WS_MOD) + (size_t)l * 8 * 6144, wsp<bf16>(F, WS_YPRE)}; pg8::gemm_phase<EpiOut<true>, pg8::StaticOrder, PG8_ALIGN, PG8_SP2>(F.lds, g, S, E, F.tid); }
            else { EpiOut<false> E{(const void*)wsp<bf16>(F, WS_X2), wsp<float>(F, WS_MOD) + (size_t)l * 8 * 6144, wsp<bf16>(F, WS_YPRE)}; pg8::gemm_phase<EpiOut<false>, pg8::StaticOrder, PG8_ALIGN, PG8_SP2>(F.lds, g, S, E, F.tid); }
        } SEAM(pb + 4);
        if (PHM(7) && IN(pb + 5)) for (int rep = 0; rep < REPS(7); ++rep) { FRESH(); phase_ln1(F, l, rep == 0); } SEAM(pb + 5);
        if (PHM(8) && IN(pb + 6)) for (int rep = 0; rep < REPS(8); ++rep) { FRESH(); phase_scat(F, l); } SEAM(pb + 6);
        if (PHM(9) && IN(pb + 7)) for (int rep = 0; rep < REPS(9); ++rep) { FRESH();
            const int RT = moe_tables(F, l);
            pg8::Gemm g{wsp<bf16>(F, WS_H), wsp<bf16>(F, WS_WUP) + (size_t)l * NE * 2048 * D, RT * 256, NE * 2048, D};
            MoeGatherOrder S; S.init(RT, 8, F.G, F.bx, (const LAS unsigned char*)(F.lds + X_TILEE)); S.tokl = (const LAS unsigned short*)(F.lds + X_TOKL);
            { const int* rowtok = wsp<int>(F, WS_ROWTOK); LAS unsigned short* tl = (LAS unsigned short*)(F.lds + X_TOKL); pg8::Unit uu;
              for (int i = 0; i < TOKL_UNITS && S.next(i, uu); ++i) if (F.tid < 256) tl[i * 256 + F.tid] = (unsigned short)(rowtok[uu.pm * 256 + F.tid] >> 2);
              __syncthreads(); }
            EpiUp E{F.in[I_BUP] + (size_t)l * NE * 2048, wsp<bf16>(F, WS_ACT)};
            stagger(F.bx >> 3, STAG_US);
            pg8::gemm_phase<EpiUp, MoeGatherOrder, PG8_ALIGN, true>(F.lds, g, S, E, F.tid);
        } SEAM(pb + 7);
        if (PHM(10) && IN(pb + 8)) for (int rep = 0; rep < REPS(10); ++rep) { FRESH();
            const int RT = moe_tables(F, l);
            pg8::Gemm g{wsp<bf16>(F, WS_ACT), wsp<bf16>(F, WS_WDN) + (size_t)l * NE * D * FF, RT * 256, NE * D, FF};
            MoeOrder S; S.init(RT, 4, F.G, F.bx, (const LAS unsigned char*)(F.lds + X_TILEE), 1);
            EpiDn E{F.in[I_BDN] + (size_t)l * NE * D, wsp<bf16>(F, WS_XG)};
            stagger(F.bx >> 3, STAG_US);
            pg8::gemm_phase<EpiDn, MoeOrder, PG8_ALIGN, PG8_SP2>(F.lds, g, S, E, F.tid);
        } SEAM(pb + 8);
        if (PHM(11) && IN(pb + 9)) for (int rep = 0; rep < REPS(11); ++rep) { FRESH(); phase_ln2(F, l); } SEAM(pb + 9);
    }
#undef IN
#undef SEAM
#undef FRESH
}

extern "C" void kernel_launch(void* const* d_in, const int* in_sizes, int n_in, void* d_out, int out_size, void* d_ws, size_t ws_size, hipStream_t stream) {
    static int grid = 0;
    if (grid == 0) {
        if (n_in != 20 || out_size != T * D || ws_size < WS_END) { fprintf(stderr, "kernel_launch: unexpected shapes (n_in %d, out %d, ws %zu < %zu)\n", n_in, out_size, ws_size, (size_t)WS_END); grid = -1; return; }
        int dev = 0, cus = 0;
        if (hipGetDevice(&dev) != hipSuccess || hipDeviceGetAttribute(&cus, hipDeviceAttributeMultiprocessorCount, dev) != hipSuccess) { grid = -1; return; }
        if (hipFuncSetAttribute((const void*)fwd, hipFuncAttributeMaxDynamicSharedMemorySize, LDS_BYTES) != hipSuccess) { fprintf(stderr, "kernel_launch: hipFuncSetAttribute failed\n"); grid = -1; return; }
        int per_cu = 0;
        if (hipOccupancyMaxActiveBlocksPerMultiprocessor(&per_cu, (const void*)fwd, 512, LDS_BYTES) != hipSuccess || per_cu < 1) fprintf(stderr, "kernel_launch: occupancy query says %d blocks per CU\n", per_cu);
        (void)hipGetLastError();
        grid = cus;
    }
    if (grid < 0) return;
    (void)in_sizes;
    if (hipMemsetAsync((char*)d_ws + WS_CTL, 0, CTL_ZERO_BYTES, stream) != hipSuccess) return;
    Args a{};
    for (int i = 0; i < 20; ++i) a.in[i] = (const float*)d_in[i];
    a.out = (float*)d_out; a.ws = (unsigned char*)d_ws;
#if MK_PER_PHASE
    for (int p = 0; p < NPHASE; ++p) { a.ph_lo = p; a.ph_hi = p + 1; hipLaunchKernelGGL(fwd, dim3(grid), dim3(512), LDS_BYTES, stream, a); }
#else
    a.ph_lo = 0; a.ph_hi = NPHASE;
    hipLaunchKernelGGL(fwd, dim3(grid), dim3(512), LDS_BYTES, stream, a);
#endif
    const hipError_t le = hipPeekAtLastError();
    if (le != hipSuccess) fprintf(stderr, "kernel_launch: launch failed: %s\n", hipGetErrorName(le));
}
```

```cpp
#include <hip/hip_runtime.h>
#include <cstdio>
#include <cstdint>
#ifndef MK_PER_PHASE
#define MK_PER_PHASE 0
#endif
namespace pg8 {
#define PG8_LAS __attribute__((address_space(3)))
typedef unsigned short bf16_t;
typedef short bf16x8 __attribute__((ext_vector_type(8)));
typedef float f32x4 __attribute__((ext_vector_type(4)));
typedef unsigned u32x4 __attribute__((ext_vector_type(4)));
constexpr int BM = 256, BK = 64, HALF = 128, HTB = HALF * BK * 2  , STAGE_BYTES = 8 * HTB, NXCD = 8;
#ifndef PG8_WGM
#define PG8_WGM 8
#endif
constexpr int WGM = PG8_WGM;

__host__ __device__ __forceinline__ int lds_byte(int r, int c) { const int st = (r >> 4) * 2 + (c >> 5), rr = r & 15, cc = c & 31, ob = rr * 64 + cc * 2; return st * 1024 + (ob ^ (((ob >> 9) & 1) << 5)); }
__host__ __device__ __forceinline__ void stage_rc(int b, int& R, int& C) { const int st = b / 1024, sb = b % 1024, swz = sb ^ (((sb >> 9) & 1) << 5); R = (st >> 1) * 16 + swz / 64; C = (st & 1) * 32 + (swz % 64) / 2; }
__host__ __device__ __forceinline__ int perm32(int rho) { const int n = rho >> 4, i = rho & 15; return 8 * (i >> 2) + 4 * n + (i & 3); }

struct Unit { int pm, pn; };
struct Gemm { const bf16_t* A; const bf16_t* Bt; int M, N, K; };

struct StaticOrder {
    static constexpr bool GATHER = false; __device__ __forceinline__ int arow(int, int r) const { return r; }
    int nM, nN, nwg, G, c;
    __host__ __device__ void init(int M, int N, int G_, int c_) { nM = M / BM; nN = N / BM; nwg = nM * nN; G = G_; c = c_; }
    __host__ __device__ bool next(int i, Unit& u) const {
        const long L = (long)i * G + c; if (L >= nwg) return false;
        int wgid = (int)L; { const int q = nwg / NXCD, r = nwg % NXCD, xcd = wgid % NXCD, off = wgid / NXCD; wgid = (xcd < r ? xcd * (q + 1) : r * (q + 1) + (xcd - r) * q) + off; }
        const int nig = WGM * nN, gid = wgid / nig, fm = gid * WGM, gsz = (nM - fm) < WGM ? (nM - fm) : WGM;
        u.pm = fm + ((wgid % nig) % gsz); u.pn = (wgid % nig) / gsz; return true;
    }
    __device__ __forceinline__ void a_ready(const Unit&) const {}
    __device__ __forceinline__ void done(const Unit&) const {}
};

__device__ __forceinline__ unsigned cvt_pk_bf16(float lo, float hi) { unsigned r; asm volatile("v_cvt_pk_bf16_f32 %0, %1, %2" : "=v"(r) : "v"(lo), "v"(hi)); return r; }
typedef float f32x2 __attribute__((ext_vector_type(2)));

template <class Epi, class Sched, bool ALIGN_EPI = false, bool SP2 = false>
__device__ __forceinline__ void gemm_phase(PG8_LAS unsigned char* lds, const Gemm g, const Sched& S, const Epi& E, const int tid_in) {
    const int tid = tid_in, wid = __builtin_amdgcn_readfirstlane(tid >> 6), lane = tid & 63, wr = wid >> 2, wc = wid & 3, fr = lane & 15, fq = lane >> 4;
    const int K = g.K, nt = K / BK;
    unsigned voffA[2], voffB[2];
#pragma unroll
    for (int i = 0; i < 2; ++i) { int R, C; stage_rc(tid * 16 + i * 8192, R, C); const int Rb = Epi::PERM ? ((R & ~31) + perm32(R & 31)) : R;
        voffA[i] = (unsigned)(R * K + C) * 2u; voffB[i] = (unsigned)(Rb * K + C) * 2u; }
    const size_t kstep = (size_t)(BK * 2);
    const size_t hstep = (size_t)HALF * K * 2;
    const size_t tstep = 2 * hstep;
    const unsigned ldsw = (unsigned)wid * 1024u;
    const int aoff = lds_byte(wr * 64 + fr, fq * 8), boff = lds_byte(wc * 32 + fr, fq * 8);
#define PG8_SA(b, h) (((b) * 2 + (h)) * HTB)
#define PG8_SB(b, h) ((4 + (b) * 2 + (h)) * HTB)
    unsigned gc[2][2], gn[2][2];
#define PG8_GOFF(dst, pmv, ordv) do { if constexpr (Sched::GATHER) { _Pragma("unroll") for (int _h = 0; _h < 2; ++_h) _Pragma("unroll") for (int _i = 0; _i < 2; ++_i) { int _R, _C; stage_rc(tid * 16 + _i * 8192, _R, _C); \
        dst[_h][_i] = (unsigned)S.arow((ordv), (pmv) * 256 + _h * 128 + _R) * (unsigned)(K * 2) + (unsigned)(_C * 2); } } } while (0)
#define PG8_STAGE_A(bufoff, origptr, nextf, hh, kbytes) do { if constexpr (Sched::GATHER) { _Pragma("unroll") for (int _i = 0; _i < 2; ++_i) { const unsigned _o = (nextf) ? gn[hh][_i] : gc[hh][_i]; \
        __builtin_amdgcn_global_load_lds((const unsigned*)((const char*)g.A + (kbytes) + _o), (PG8_LAS unsigned*)(lds + (bufoff) + ldsw + _i * 8192), 16, 0, 0); } } else { PG8_STAGE(bufoff, origptr, voffA); } } while (0)
#define PG8_STAGE(bufoff, gbase, voff) do { _Pragma("unroll") for (int _i = 0; _i < 2; ++_i) \
        __builtin_amdgcn_global_load_lds((const unsigned*)((const char*)(gbase) + (voff)[_i]), (PG8_LAS unsigned*)(lds + (bufoff) + ldsw + _i * 8192), 16, 0, 0); } while (0)
#define PG8_LDA(dst, b, h) do { _Pragma("unroll") for (int m = 0; m < 4; ++m) _Pragma("unroll") for (int k = 0; k < 2; ++k) dst[m][k] = *(const PG8_LAS bf16x8*)(lds + PG8_SA(b, h) + aoff + m * 2048 + k * 1024); } while (0)
#define PG8_LDB(dst, b, h) do { _Pragma("unroll") for (int n = 0; n < 2; ++n) _Pragma("unroll") for (int k = 0; k < 2; ++k) dst[n][k] = *(const PG8_LAS bf16x8*)(lds + PG8_SB(b, h) + boff + n * 2048 + k * 1024); } while (0)
#define PG8_MMA(ai, bj, At, Bt) do { __builtin_amdgcn_s_setprio(1); _Pragma("unroll") for (int m = 0; m < 4; ++m) _Pragma("unroll") for (int n = 0; n < 2; ++n) _Pragma("unroll") for (int k = 0; k < 2; ++k) \
        acc[ai][bj][m][n] = __builtin_amdgcn_mfma_f32_16x16x32_bf16(Bt[n][k], At[m][k], acc[ai][bj][m][n], 0, 0, 0); __builtin_amdgcn_s_setprio(0); } while (0)
#define PG8_WAIT_V(n) asm volatile("s_waitcnt vmcnt(" #n ")" ::: "memory")
#define PG8_WAIT_L(n) asm volatile("s_waitcnt lgkmcnt(" #n ")" ::: "memory")
#define PG8_BAR __builtin_amdgcn_s_barrier()
#define PG8_SCHED __builtin_amdgcn_sched_barrier(0)
    Unit cur, nxt; int ui = 0;
    if (!S.next(0, cur)) return;
    f32x4 acc[2][2][4][2];
#pragma unroll
    for (int a = 0; a < 2; ++a)
#pragma unroll
        for (int b = 0; b < 2; ++b)
#pragma unroll
            for (int m = 0; m < 4; ++m)
#pragma unroll
                for (int n = 0; n < 2; ++n) acc[a][b][m][n] = (f32x4){0.f, 0.f, 0.f, 0.f};
    bf16x8 At[4][2], B0[2][2], B1[2][2];
    const char* cA = (const char*)g.A + (size_t)cur.pm * tstep; const char* cB = (const char*)g.Bt + (size_t)cur.pn * tstep;
    S.a_ready(cur);
    PG8_GOFF(gc, cur.pm, 0);
    if constexpr (SP2) {
        PG8_STAGE(PG8_SB(0, 0), cB, voffB); PG8_STAGE(PG8_SB(0, 1), cB + hstep, voffB); PG8_STAGE_A(PG8_SA(0, 0), cA, false, 0, 0); PG8_STAGE_A(PG8_SA(0, 1), cA + hstep, false, 1, 0);
        if (wr == 1) PG8_BAR;
        PG8_WAIT_V(2); PG8_BAR;
        PG8_STAGE(PG8_SB(1, 0), cB + kstep, voffB); PG8_STAGE_A(PG8_SA(1, 0), cA + kstep, false, 0, kstep); PG8_STAGE(PG8_SB(1, 1), cB + hstep + kstep, voffB);
        PG8_WAIT_V(6); PG8_BAR;
    } else {
        PG8_STAGE(PG8_SB(0, 0), cB, voffB); PG8_STAGE(PG8_SA(0, 0), cA, voffA); PG8_STAGE(PG8_SB(0, 1), cB + hstep, voffB); PG8_STAGE(PG8_SA(0, 1), cA + hstep, voffA);
        if (wr == 1) PG8_BAR;
        PG8_WAIT_V(4); PG8_BAR;
        PG8_STAGE(PG8_SB(1, 0), cB + kstep, voffB); PG8_STAGE(PG8_SA(1, 0), cA + kstep, voffA); PG8_STAGE(PG8_SB(1, 1), cB + hstep + kstep, voffB);
        PG8_WAIT_V(6); PG8_BAR;
    }
    for (;;) {
        const bool has_next = S.next(ui + 1, nxt);
        if constexpr (Sched::GATHER) { if (has_next) { PG8_GOFF(gn, nxt.pm, ui + 1); } else { gn[0][0] = gc[0][0]; gn[0][1] = gc[0][1]; gn[1][0] = gc[1][0]; gn[1][1] = gc[1][1]; } }
        const char* nA = has_next ? (const char*)g.A + (size_t)nxt.pm * tstep : cA; const char* nB = has_next ? (const char*)g.Bt + (size_t)nxt.pn * tstep : cB;
#pragma unroll
        for (int seg = 0; seg < (Epi::MID_T > 0 ? 2 : 1); ++seg) {
        if constexpr (Epi::MID_T > 0) { if (seg == 1) { PG8_SCHED; E.mid(acc, cur, wr, wc, fr, fq); PG8_SCHED; } }
        const int t_lo = seg ? Epi::MID_T : 0, t_hi = (Epi::MID_T > 0 && seg == 0) ? Epi::MID_T : nt;
        for (int t = t_lo; t < t_hi; t += 2) {
            const bool last = (t == nt - 2);
            const char* a1 = cA + (size_t)(t + 1) * kstep;
            const char* a2 = last ? nA : cA + (size_t)(t + 2) * kstep; const char* b2 = last ? nB : cB + (size_t)(t + 2) * kstep;
            const char* a3 = a2 + kstep; const char* b3 = b2 + kstep; const size_t k2b = last ? (size_t)0 : (size_t)(t + 2) * kstep;
            if (last && has_next) S.a_ready(nxt);
            if constexpr (SP2) {
            PG8_LDB(B0, 0, 0); PG8_LDB(B1, 0, 1); PG8_SCHED; PG8_LDA(At, 0, 0); PG8_STAGE_A(PG8_SA(1, 1), a1 + hstep, false, 1, (size_t)(t + 1) * kstep);
            PG8_WAIT_V(8); PG8_WAIT_L(0); PG8_BAR; PG8_MMA(0, 0, At, B0); PG8_MMA(0, 1, At, B1); PG8_BAR; PG8_SCHED;
            PG8_LDA(At, 0, 1); PG8_STAGE(PG8_SB(0, 0), b2, voffB); PG8_STAGE(PG8_SB(0, 1), b2 + hstep, voffB); PG8_STAGE_A(PG8_SA(0, 0), a2, last, 0, k2b);
            PG8_WAIT_V(8); PG8_WAIT_L(0); PG8_BAR; PG8_MMA(1, 0, At, B0); PG8_MMA(1, 1, At, B1); PG8_BAR; PG8_SCHED;
            PG8_LDB(B0, 1, 0); PG8_LDB(B1, 1, 1); PG8_SCHED; PG8_LDA(At, 1, 0); PG8_STAGE_A(PG8_SA(0, 1), a2 + hstep, last, 1, k2b);
            PG8_WAIT_V(8); PG8_WAIT_L(0); PG8_BAR; PG8_MMA(0, 0, At, B0); PG8_MMA(0, 1, At, B1); PG8_BAR; PG8_SCHED;
            PG8_LDA(At, 1, 1); PG8_STAGE(PG8_SB(1, 0), b3, voffB); PG8_STAGE(PG8_SB(1, 1), b3 + hstep, voffB); PG8_STAGE_A(PG8_SA(1, 0), a3, last, 0, k2b + kstep);
            PG8_WAIT_V(8); PG8_WAIT_L(0); PG8_BAR; PG8_MMA(1, 0, At, B0); PG8_MMA(1, 1, At, B1); PG8_BAR; PG8_SCHED;
            } else {
            PG8_LDB(B0, 0, 0); PG8_SCHED; PG8_LDA(At, 0, 0); PG8_STAGE(PG8_SA(1, 1), a1 + hstep, voffA);
            PG8_WAIT_L(8); PG8_BAR; PG8_WAIT_L(0); PG8_MMA(0, 0, At, B0); PG8_BAR; PG8_SCHED;
            PG8_LDB(B1, 0, 1); PG8_STAGE(PG8_SB(0, 0), b2, voffB);
            PG8_BAR; PG8_WAIT_L(0); PG8_MMA(0, 1, At, B1); PG8_BAR;
            PG8_LDA(At, 0, 1); PG8_STAGE(PG8_SA(0, 0), a2, voffA);
            PG8_BAR; PG8_WAIT_L(0); PG8_MMA(1, 0, At, B0); PG8_BAR; PG8_SCHED;
            PG8_STAGE(PG8_SB(0, 1), b2 + hstep, voffB);
            PG8_WAIT_V(6); PG8_BAR; PG8_MMA(1, 1, At, B1); PG8_BAR;
            PG8_LDB(B0, 1, 0); PG8_SCHED; PG8_LDA(At, 1, 0); PG8_STAGE(PG8_SA(0, 1), a2 + hstep, voffA);
            PG8_WAIT_L(8); PG8_BAR; PG8_WAIT_L(0); PG8_MMA(0, 0, At, B0); PG8_BAR; PG8_SCHED;
            PG8_LDB(B1, 1, 1); PG8_STAGE(PG8_SB(1, 0), b3, voffB);
            PG8_BAR; PG8_WAIT_L(0); PG8_MMA(0, 1, At, B1); PG8_BAR;
            PG8_LDA(At, 1, 1); PG8_STAGE(PG8_SA(1, 0), a3, voffA);
            PG8_BAR; PG8_WAIT_L(0); PG8_MMA(1, 0, At, B0); PG8_BAR; PG8_SCHED;
            PG8_STAGE(PG8_SB(1, 1), b3 + hstep, voffB);
            PG8_WAIT_V(6); PG8_BAR; PG8_MMA(1, 1, At, B1); PG8_BAR;
            }
        }
        }
        if constexpr (ALIGN_EPI) { if (wr == 0) PG8_BAR; }
        if constexpr (!Epi::AFTER_DRAIN) { E(acc, cur, wr, wc, fr, fq); S.done(cur); }
        if (!has_next) break;
#pragma unroll
        for (int a = 0; a < 2; ++a)
#pragma unroll
            for (int b = 0; b < 2; ++b)
#pragma unroll
                for (int m = 0; m < 4; ++m)
#pragma unroll
                    for (int n = 0; n < 2; ++n) acc[a][b][m][n] = (f32x4){0.f, 0.f, 0.f, 0.f};
        cur = nxt; cA = nA; cB = nB; ++ui;
        if constexpr (Sched::GATHER) { gc[0][0] = gn[0][0]; gc[0][1] = gn[0][1]; gc[1][0] = gn[1][0]; gc[1][1] = gn[1][1]; }
        if constexpr (ALIGN_EPI) { if (wr == 1) PG8_BAR; }
    }
    PG8_WAIT_V(0);
    if constexpr (!ALIGN_EPI) { if (wr == 0) PG8_BAR; }
    PG8_BAR;
    if constexpr (Epi::AFTER_DRAIN) { E.fused(acc, cur, wr, wc, fr, fq, lds, wid, lane); S.done(cur); }
#undef PG8_SA
#undef PG8_SB
#undef PG8_STAGE
#undef PG8_STAGE_A
#undef PG8_GOFF
#undef PG8_LDA
#undef PG8_LDB
#undef PG8_MMA
#undef PG8_WAIT_V
#undef PG8_WAIT_L
#undef PG8_BAR
#undef PG8_SCHED
}
}
#define LAS __attribute__((address_space(3)))
#define XB_TMO      128
#define XB_XCNT(j)  (256  + 64 * (j))
#define XB_XSUB(j)  (1280 + 64 * (j))
#define XB_XGEN(j)  (2304 + 64 * (j))
#define XB_TOP      3328
#define XB_TOPGEN   3392
#define XCD_BAR_WORDS 3456
#define XB_SPIN_CAP (1u << 18)

__device__ __forceinline__ unsigned xb_ld(unsigned* p)              { return __hip_atomic_load(p, __ATOMIC_RELAXED, __HIP_MEMORY_SCOPE_AGENT); }
__device__ __forceinline__ unsigned xb_add(unsigned* p, unsigned v) { return __hip_atomic_fetch_add(p, v, __ATOMIC_RELAXED, __HIP_MEMORY_SCOPE_AGENT); }
__device__ __forceinline__ unsigned xb_xcc_id() { return (unsigned)__builtin_amdgcn_s_getreg((3 << 11) | 20) & 0xFu; }
#define XB_SPIN(cond, bar) do { unsigned _sp = 0; while (cond) { __builtin_amdgcn_s_sleep(1); \
    if ((++_sp & 255u) == 0u) { if (xb_ld(&(bar)[XB_TMO])) break; if (_sp > XB_SPIN_CAP) { atomicAdd(&(bar)[XB_TMO], 1u); break; } } } } while (0)

struct XcdBarrier {
    unsigned* bar; unsigned x;
    volatile LAS unsigned* st;
};

__device__ __forceinline__ XcdBarrier xcd_barrier_post(unsigned* bar, volatile LAS unsigned* st) {
    XcdBarrier b; b.bar = bar; b.x = xb_xcc_id(); b.st = st;
    if (threadIdx.x == 0) (void)xb_add(&bar[XB_XCNT(b.x)], 1u);
    return b;
}
__device__ __forceinline__ void xcd_barrier_complete(unsigned* bar, unsigned x, unsigned& nloc, unsigned& nx) {
    const unsigned G = gridDim.x * gridDim.y * gridDim.z;
    unsigned sum, cnt, mine, sp = 0u;
    for (;;) {
        sum = 0u; cnt = 0u; mine = 0u;
#pragma unroll
        for (unsigned j = 0; j < 16; ++j) { const unsigned c = xb_ld(&bar[XB_XCNT(j)]); sum += c; cnt += (c > 0u) ? 1u : 0u; mine = (j == x) ? c : mine; }
        if (sum == G) break;
        __builtin_amdgcn_s_sleep(1);
        if ((++sp & 255u) == 0u) { if (xb_ld(&bar[XB_TMO])) break; if (sp > XB_SPIN_CAP) { atomicAdd(&bar[XB_TMO], 1u); break; } }
    }
    nloc = mine > 0u ? mine : 1u; nx = cnt > 0u ? cnt : 1u;
}

__device__ __forceinline__ void xcd_barrier(const XcdBarrier& b) {
    asm volatile("s_waitcnt vmcnt(0)" ::: "memory");
    __syncthreads();
    if (threadIdx.x == 0) {
        unsigned* bar = b.bar;
        __builtin_amdgcn_s_waitcnt(0);
        unsigned nloc = b.st[0], nx = b.st[1];
        if (nloc == 0u) { xcd_barrier_complete(bar, b.x, nloc, nx); b.st[0] = nloc; b.st[1] = nx; }
        const unsigned old = xb_add(&bar[XB_XSUB(b.x)], 1u);
        const unsigned gen = old / nloc;
        if (old + 1u == (gen + 1u) * nloc) {
            __builtin_amdgcn_fence(__ATOMIC_RELEASE, "agent");
            asm volatile("s_waitcnt vmcnt(0)" ::: "memory");
            const unsigned og = xb_add(&bar[XB_TOP], 1u);
            const unsigned tg = og / nx;
            if (og + 1u == (tg + 1u) * nx) xb_add(&bar[XB_TOPGEN], 1u);
            else XB_SPIN(xb_ld(&bar[XB_TOPGEN]) == tg, bar);
            __builtin_amdgcn_fence(__ATOMIC_ACQUIRE, "agent");
            xb_add(&bar[XB_XGEN(b.x)], 1u);
            asm volatile("s_waitcnt vmcnt(0)" ::: "memory");
        } else {
            XB_SPIN(xb_ld(&bar[XB_XGEN(b.x)]) == gen, bar);
            __builtin_amdgcn_fence(__ATOMIC_ACQUIRE, "agent");
            asm volatile("s_waitcnt vmcnt(0)" ::: "memory");
        }
    }
    __syncthreads();
}


#ifndef PG8_SP2
#define PG8_SP2 true
#endif
#ifndef PG8_ALIGN
#define PG8_ALIGN true
#endif
constexpr int D = 1024, NB = 8, SEQ = 4096, T = NB * SEQ, NL = 4;
constexpr int NIN = 8704, NE = 32, FF = 1024;
constexpr int RMAX = 139264;
constexpr float LN_EPS = 1e-5f, DN_ALPHA = 1.681792830507429f;
constexpr float QSCALE = 0.18033688011112042f;
constexpr float LOG2E = 1.4426950408889634f;

constexpr size_t MiB = 1u << 20;
constexpr size_t WS_CTL = 0, CTL_ZERO_BYTES = 1 * MiB;
constexpr size_t WS_MOD = 1 * MiB;
constexpr size_t WS_ROPE = 2 * MiB;
constexpr size_t WS_WSP = 3 * MiB;
constexpr size_t WS_WRT = 4 * MiB;
constexpr size_t WS_TOKINFO = 5 * MiB;
constexpr size_t WS_TOKW = 5 * MiB + 512 * 1024;
constexpr size_t WS_ROWTOK = 6 * MiB;
constexpr size_t WS_ROWW = 7 * MiB;
constexpr size_t WS_LSE = 8 * MiB;
constexpr size_t WS_TOKROW = 14 * MiB;
constexpr size_t WS_STAT = 13 * MiB;
constexpr size_t WS_WGCNT = 12 * MiB;
constexpr size_t WS_WIN = 16 * MiB;
constexpr size_t WS_WBA = 84 * MiB;
constexpr size_t WS_WBB = 92 * MiB;
constexpr size_t WS_WOUT = 96 * MiB;
constexpr size_t WS_WUP = 104 * MiB;
constexpr size_t WS_WDN = 616 * MiB;
constexpr size_t WS_H = 872 * MiB;
constexpr size_t WS_X1 = 936 * MiB;
constexpr size_t WS_X2 = 1064 * MiB;
constexpr size_t WS_YPRE = 1192 * MiB;
constexpr size_t WS_U = 1320 * MiB, WS_V = 1384 * MiB;
constexpr size_t WS_Q = 1448 * MiB, WS_K = 1544 * MiB, WS_VV = 1640 * MiB;
constexpr size_t WS_G = 1736 * MiB;
constexpr size_t WS_OG = 1864 * MiB;
constexpr size_t WS_TT = 1960 * MiB;
constexpr size_t WS_OB = 2024 * MiB;
constexpr size_t WS_YA = 2056 * MiB;
constexpr size_t WS_MG = 2120 * MiB;
constexpr size_t WS_XG = 2184 * MiB;
constexpr size_t WS_ACT = 2456 * MiB;
constexpr size_t WS_YK = 2728 * MiB;
constexpr size_t WS_END = 2984 * MiB;
constexpr int CW_BAR = 4096;
constexpr int CW_CNT = 16384;

constexpr int RING_BYTES = 131072;
constexpr int XOFF = RING_BYTES;
constexpr int X_MISC = XOFF;
constexpr int X_SELE = XOFF + 256;
constexpr int X_SELR = XOFF + 2304;
constexpr int X_CNTL = XOFF + 4352;
constexpr int X_BASE = XOFF + 4480;
constexpr int X_TILEE = XOFF + 4608;
constexpr int X_CNTS = XOFF + 5632;
constexpr int X_OFFS = XOFF + 5760;
constexpr int LDS_BYTES = 147456;

#define GAS __attribute__((address_space(1)))
typedef unsigned short bf16;
typedef unsigned v4u __attribute__((ext_vector_type(4)));
typedef unsigned v2u __attribute__((ext_vector_type(2)));
typedef float f32x4 __attribute__((ext_vector_type(4)));
typedef short bf16x8 __attribute__((ext_vector_type(8)));
typedef short s16x4 __attribute__((ext_vector_type(4)));
#define RLX_AGENT __ATOMIC_RELAXED, __HIP_MEMORY_SCOPE_AGENT
#define LDS_WAIT() asm volatile("s_waitcnt lgkmcnt(0)" ::: "memory")
#define VM_WAIT() asm volatile("s_waitcnt vmcnt(0)" ::: "memory")

typedef __bf16 bf16x2_t __attribute__((ext_vector_type(2))); typedef float f32x2_t __attribute__((ext_vector_type(2)));
__device__ __forceinline__ unsigned pk2(float lo, float hi) { return __builtin_bit_cast(unsigned, __builtin_convertvector((f32x2_t){lo, hi}, bf16x2_t)); }
__device__ __forceinline__ float bflo(unsigned w) { return __uint_as_float(w << 16); }
__device__ __forceinline__ float bfhi(unsigned w) { return __uint_as_float(w & 0xffff0000u); }
__device__ __forceinline__ float fexp2(float x) { return __builtin_amdgcn_exp2f(x); }
__device__ __forceinline__ float frcp(float x) { return __builtin_amdgcn_rcpf(x); }
__device__ __forceinline__ float gelu_tanh(float x) { const float u = x + 0.044715f * x * x * x; return x * frcp(1.0f + fexp2(-2.302208198144325f * u)); }
__device__ __forceinline__ float sigmoidf_(float x) { return frcp(1.0f + fexp2(-LOG2E * x)); }
__device__ __forceinline__ float wave_sum(float v) {
#pragma unroll
    for (int o = 1; o < 64; o <<= 1) v += __shfl_xor(v, o);
    return v;
}
__device__ __forceinline__ float wave_max(float v) {
#pragma unroll
    for (int o = 1; o < 64; o <<= 1) v = fmaxf(v, __shfl_xor(v, o));
    return v;
}
__device__ __forceinline__ s16x4 tr16(const LAS unsigned char* p) { return __builtin_bit_cast(s16x4, __builtin_amdgcn_ds_read_tr16_b64_v4i16((LAS s16x4*)p)); }
__device__ __forceinline__ bf16x8 cat8(s16x4 lo, s16x4 hi) { return (bf16x8){lo[0], lo[1], lo[2], lo[3], hi[0], hi[1], hi[2], hi[3]}; }
__device__ __forceinline__ f32x4 mfma16(bf16x8 a, bf16x8 b, f32x4 c) { return __builtin_amdgcn_mfma_f32_16x16x32_bf16(a, b, c, 0, 0, 0); }

struct Frame {
    LAS unsigned char* lds;
    int tid, lane, wave, G, vcu, bx;
    unsigned char* ws;
    const float* const* in;
    float* out;
};
enum { I_X = 0, I_C, I_WADA, I_BADA, I_WIN, I_SPW, I_SPB, I_WBA, I_WBB, I_WOUT, I_LN1G, I_LN1B, I_WR, I_BR, I_WUP, I_BUP, I_WDN, I_BDN, I_LN2G, I_LN2B };
template <class Tp> __device__ __forceinline__ Tp* wsp(const Frame& F, size_t off) { return (Tp*)(F.ws + off); }

template <class P> __device__ __forceinline__ P launder(P p) { unsigned lo = (unsigned)(uintptr_t)p, hi = (unsigned)((uintptr_t)p >> 32); asm volatile("" : "+v"(lo), "+v"(hi));
    lo = (unsigned)__builtin_amdgcn_readfirstlane((int)lo); hi = (unsigned)__builtin_amdgcn_readfirstlane((int)hi); return (P)(((uintptr_t)hi << 32) | (uintptr_t)lo); }
struct EpiIn {
    static constexpr int MID_T = 0; static constexpr bool PERM = true, AFTER_DRAIN = false;
    bf16 *U, *V, *Q, *K, *VV, *Gt; const float* rope;
    __device__ __forceinline__ void operator()(const f32x4 (&acc)[2][2][4][2], const pg8::Unit& u, int wr, int wc, int fr, int fq) const {
        const int pn = u.pn; int type, ld, colt; bf16* base;
        if (pn < 4) { type = 0; base = U; ld = 1024; colt = pn * 256; }
        else if (pn < 8) { type = 0; base = V; ld = 1024; colt = (pn - 4) * 256; }
        else if (pn < 14) { type = 1; base = Q; ld = 1536; colt = (pn - 8) * 256; }
        else if (pn < 20) { type = 2; base = K; ld = 1536; colt = (pn - 14) * 256; }
        else if (pn < 26) { type = 3; base = VV; ld = 1536; colt = (pn - 20) * 256; }
        else { type = 4; base = Gt; ld = 2048; colt = (pn - 26) * 256; }
        const int row0 = u.pm * 256 + wr * 64 + fr, col0 = colt + wc * 32 + 8 * fq;
        if (type == 0) {
#pragma unroll
            for (int ai = 0; ai < 2; ++ai)
#pragma unroll
                for (int m = 0; m < 4; ++m) { bf16* rowp = base + (size_t)(row0 + ai * 128 + m * 16) * ld + col0;
#pragma unroll
                    for (int bj = 0; bj < 2; ++bj) { const f32x4 v0 = acc[ai][bj][m][0], v1 = acc[ai][bj][m][1]; v4u w;
                        w.x = pk2(gelu_tanh(v0[0]), gelu_tanh(v0[1])); w.y = pk2(gelu_tanh(v0[2]), gelu_tanh(v0[3]));
                        w.z = pk2(gelu_tanh(v1[0]), gelu_tanh(v1[1])); w.w = pk2(gelu_tanh(v1[2]), gelu_tanh(v1[3]));
                        __builtin_nontemporal_store(w, (v4u*)(rowp + bj * 128)); } }
        } else if (type == 4) {
#pragma unroll
            for (int ai = 0; ai < 2; ++ai)
#pragma unroll
                for (int m = 0; m < 4; ++m) { bf16* rowp = base + (size_t)(row0 + ai * 128 + m * 16) * ld + col0;
#pragma unroll
                    for (int bj = 0; bj < 2; ++bj) { const f32x4 v0 = acc[ai][bj][m][0], v1 = acc[ai][bj][m][1]; v4u w;
                        w.x = pk2(sigmoidf_(v0[0]), sigmoidf_(v0[1])); w.y = pk2(sigmoidf_(v0[2]), sigmoidf_(v0[3]));
                        w.z = pk2(sigmoidf_(v1[0]), sigmoidf_(v1[1])); w.w = pk2(sigmoidf_(v1[2]), sigmoidf_(v1[3]));
                        __builtin_nontemporal_store(w, (v4u*)(rowp + bj * 128)); } }
        } else if (type == 3) {
#pragma unroll
            for (int ai = 0; ai < 2; ++ai)
#pragma unroll
                for (int m = 0; m < 4; ++m) { bf16* rowp = base + (size_t)(row0 + ai * 128 + m * 16) * ld + col0;
#pragma unroll
                    for (int bj = 0; bj < 2; ++bj) { const f32x4 v0 = acc[ai][bj][m][0], v1 = acc[ai][bj][m][1]; v4u w;
                        w.x = pk2(v0[0], v0[1]); w.y = pk2(v0[2], v0[3]); w.z = pk2(v1[0], v1[1]); w.w = pk2(v1[2], v1[3]);
                        __builtin_nontemporal_store(w, (v4u*)(rowp + bj * 128)); } }
        } else {
            const float sc = (type == 1) ? QSCALE : 1.0f;
            const bool ropew = (wc & 1) == 0;
#pragma unroll
            for (int ai = 0; ai < 2; ++ai)
#pragma unroll
                for (int m = 0; m < 4; ++m) { const int row = row0 + ai * 128 + m * 16; bf16* rowp = base + (size_t)row * ld + col0;
                    float cs[8], sn[8];
                    if (ropew) { const f32x4* rp = (const f32x4*)(rope + (size_t)(row & (SEQ - 1)) * 16); const f32x4 c0 = rp[0], c1 = rp[1], s0 = rp[2], s1 = rp[3];
#pragma unroll
                        for (int e = 0; e < 4; ++e) { cs[e] = c0[e]; cs[4 + e] = c1[e]; sn[e] = s0[e]; sn[4 + e] = s1[e]; } }
#pragma unroll
                    for (int bj = 0; bj < 2; ++bj) { f32x4 v0 = acc[ai][bj][m][0], v1 = acc[ai][bj][m][1];
                        if (ropew) {
#pragma unroll
                            for (int e = 0; e < 8; ++e) { const float x = (e < 4) ? v0[e & 3] : v1[e & 3]; const float p = __shfl_xor(x, 16);
                                float y = x;
                                if (fq == 0) y = x * cs[e] - p * sn[e];
                                if (fq == 1) y = x * cs[e] + p * sn[e];
                                if (e < 4) v0[e & 3] = y; else v1[e & 3] = y; } }
                        v4u w; w.x = pk2(v0[0] * sc, v0[1] * sc); w.y = pk2(v0[2] * sc, v0[3] * sc); w.z = pk2(v1[0] * sc, v1[1] * sc); w.w = pk2(v1[2] * sc, v1[3] * sc);
                        __builtin_nontemporal_store(w, (v4u*)(rowp + bj * 128)); } }
        }
    }
};
struct EpiProbe {
    static constexpr int MID_T = 0; static constexpr bool PERM = true, AFTER_DRAIN = false;
    bf16* O; int ld; int on;
    __device__ __forceinline__ void operator()(const f32x4 (&acc)[2][2][4][2], const pg8::Unit& u, int wr, int wc, int fr, int fq) const {
        if (!on) return;
        const int row0 = u.pm * 256 + wr * 64 + fr, col0 = ((on == 3) ? u.pn : (u.pn & 3)) * 256 + wc * 32 + 8 * fq;
#pragma unroll
        for (int ai = 0; ai < 2; ++ai)
#pragma unroll
            for (int m = 0; m < 4; ++m) { bf16* rowp = O + (size_t)(row0 + ai * 128 + m * 16) * ld + col0;
#pragma unroll
                for (int bj = 0; bj < 2; ++bj) { const f32x4 v0 = acc[ai][bj][m][0], v1 = acc[ai][bj][m][1]; v4u w;
                    w.x = pk2(v0[0], v0[1]); w.y = pk2(v0[2], v0[3]); w.z = pk2(v1[0], v1[1]); w.w = pk2(v1[2], v1[3]);
                    *(v4u*)(rowp + bj * 128) = w; } }
    }
};
struct EpiYA {
    static constexpr int MID_T = 0; static constexpr bool PERM = true, AFTER_DRAIN = false;
    const bf16* Gt; bf16* YA;
    __device__ __forceinline__ void operator()(const f32x4 (&acc)[2][2][4][2], const pg8::Unit& u, int wr, int wc, int fr, int fq) const {
        const int row0 = u.pm * 256 + wr * 64 + fr, col0 = u.pn * 256 + wc * 32 + 8 * fq;
#pragma unroll
        for (int ai = 0; ai < 2; ++ai)
#pragma unroll
            for (int m = 0; m < 4; ++m) { const size_t row = (size_t)(row0 + ai * 128 + m * 16);
#pragma unroll
                for (int bj = 0; bj < 2; ++bj) { const f32x4 v0 = acc[ai][bj][m][0], v1 = acc[ai][bj][m][1];
                    const v4u g = *(const v4u*)(Gt + row * 2048 + col0 + bj * 128); v4u w;
                    w.x = pk2(v0[0] * bflo(g.x), v0[1] * bfhi(g.x)); w.y = pk2(v0[2] * bflo(g.y), v0[3] * bfhi(g.y));
                    w.z = pk2(v1[0] * bflo(g.z), v1[1] * bfhi(g.z)); w.w = pk2(v1[2] * bflo(g.w), v1[3] * bfhi(g.w));
                    *(v4u*)(YA + row * 1024 + col0 + bj * 128) = w; } }
    }
};
struct EpiMg {
    static constexpr int MID_T = 0; static constexpr bool PERM = true, AFTER_DRAIN = false;
    const bf16* Gt; const bf16* YA; bf16* MG;
    __device__ __forceinline__ void operator()(const f32x4 (&acc)[2][2][4][2], const pg8::Unit& u, int wr, int wc, int fr, int fq) const {
        const int row0 = u.pm * 256 + wr * 64 + fr, col0 = u.pn * 256 + wc * 32 + 8 * fq;
#pragma unroll
        for (int ai = 0; ai < 2; ++ai)
#pragma unroll
            for (int m = 0; m < 4; ++m) { const size_t row = (size_t)(row0 + ai * 128 + m * 16);
#pragma unroll
                for (int bj = 0; bj < 2; ++bj) { const f32x4 v0 = acc[ai][bj][m][0], v1 = acc[ai][bj][m][1];
                    const v4u g = *(const v4u*)(Gt + row * 2048 + 1024 + col0 + bj * 128); const v4u y = *(const v4u*)(YA + row * 1024 + col0 + bj * 128); v4u w;
                    w.x = pk2(bflo(y.x) + v0[0] * bflo(g.x), bfhi(y.x) + v0[1] * bfhi(g.x)); w.y = pk2(bflo(y.y) + v0[2] * bflo(g.y), bfhi(y.y) + v0[3] * bfhi(g.y));
                    w.z = pk2(bflo(y.z) + v1[0] * bflo(g.z), bfhi(y.z) + v1[1] * bfhi(g.z)); w.w = pk2(bflo(y.w) + v1[2] * bflo(g.w), bfhi(y.w) + v1[3] * bfhi(g.w));
                    *(v4u*)(MG + row * 1024 + col0 + bj * 128) = w; } }
    }
};
struct EpiMg2 {
    static constexpr int MID_T = 16; static constexpr bool PERM = true, AFTER_DRAIN = false;
    const bf16* Gt; bf16* MG;
    __device__ __forceinline__ void mid(f32x4 (&acc)[2][2][4][2], const pg8::Unit& u, int wr, int wc, int fr, int fq) const {
        int row0 = u.pm * 256 + wr * 64 + fr; const int col0 = u.pn * 256 + wc * 32 + 8 * fq;
        asm volatile("" : "+v"(row0));
#pragma unroll
        for (int ai = 0; ai < 2; ++ai)
#pragma unroll
            for (int m = 0; m < 4; ++m) { const size_t row = (size_t)(row0 + ai * 128 + m * 16);
#pragma unroll
                for (int bj = 0; bj < 2; ++bj) { const v4u g0 = *(const v4u*)(Gt + row * 2048 + col0 + bj * 128), g1 = *(const v4u*)(Gt + row * 2048 + 1024 + col0 + bj * 128);
                    const unsigned a0[4] = {g0.x, g0.y, g0.z, g0.w}, a1[4] = {g1.x, g1.y, g1.z, g1.w};
#pragma unroll
                    for (int q = 0; q < 4; ++q) { const float r0 = bflo(a0[q]) * frcp(fmaxf(bflo(a1[q]), 1e-20f)), r1 = bfhi(a0[q]) * frcp(fmaxf(bfhi(a1[q]), 1e-20f));
                        acc[ai][bj][m][q >> 1][(q & 1) * 2] *= r0; acc[ai][bj][m][q >> 1][(q & 1) * 2 + 1] *= r1; } }
                if (m == 3) asm volatile("" ::: "memory"); }
    }
    __device__ __forceinline__ void operator()(const f32x4 (&acc)[2][2][4][2], const pg8::Unit& u, int wr, int wc, int fr, int fq) const {
        const int row0 = u.pm * 256 + wr * 64 + fr, col0 = u.pn * 256 + wc * 32 + 8 * fq;
#pragma unroll
        for (int ai = 0; ai < 2; ++ai)
#pragma unroll
            for (int m = 0; m < 4; ++m) { const size_t row = (size_t)(row0 + ai * 128 + m * 16);
#pragma unroll
                for (int bj = 0; bj < 2; ++bj) { const f32x4 v0 = acc[ai][bj][m][0], v1 = acc[ai][bj][m][1];
                    const v4u g = *(const v4u*)(Gt + row * 2048 + 1024 + col0 + bj * 128); v4u w;
                    w.x = pk2(v0[0] * fmaxf(bflo(g.x), 1e-20f), v0[1] * fmaxf(bfhi(g.x), 1e-20f)); w.y = pk2(v0[2] * fmaxf(bflo(g.y), 1e-20f), v0[3] * fmaxf(bfhi(g.y), 1e-20f));
                    w.z = pk2(v1[0] * fmaxf(bflo(g.z), 1e-20f), v1[1] * fmaxf(bfhi(g.z), 1e-20f)); w.w = pk2(v1[2] * fmaxf(bflo(g.w), 1e-20f), v1[3] * fmaxf(bfhi(g.w), 1e-20f));
                    *(v4u*)(MG + row * 1024 + col0 + bj * 128) = w; } }
    }
};
template <bool XF32> struct EpiOut {
    static constexpr int MID_T = 0; static constexpr bool PERM = true, AFTER_DRAIN = false;
    const void* xres; const float* modl  ; bf16* YPRE;
    __device__ __forceinline__ void operator()(const f32x4 (&acc)[2][2][4][2], const pg8::Unit& u, int wr, int wc, int fr, int fq) const {
        const int row0 = u.pm * 256 + wr * 64 + fr, col0 = u.pn * 256 + wc * 32 + 8 * fq; const int b = (u.pm * 256) >> 12;
        f32x4 gg[2][2];
#pragma unroll
        for (int bj = 0; bj < 2; ++bj)
#pragma unroll
            for (int n = 0; n < 2; ++n) gg[bj][n] = *(const f32x4*)(modl + (size_t)b * 6144 + 2048 + col0 + bj * 128 + 4 * n) + 1.0f;
#pragma unroll
        for (int ai = 0; ai < 2; ++ai)
#pragma unroll
            for (int m = 0; m < 4; ++m) { const size_t off = (size_t)(row0 + ai * 128 + m * 16) * 1024 + col0;
#pragma unroll
                for (int bj = 0; bj < 2; ++bj) { f32x4 x0, x1;
                    if (XF32) { x0 = *(const f32x4*)((const float*)xres + off + bj * 128); x1 = *(const f32x4*)((const float*)xres + off + bj * 128 + 4); }
                    else { const v4u xr = *(const v4u*)((const bf16*)xres + off + bj * 128); x0 = (f32x4){bflo(xr.x), bfhi(xr.x), bflo(xr.y), bfhi(xr.y)}; x1 = (f32x4){bflo(xr.z), bfhi(xr.z), bflo(xr.w), bfhi(xr.w)}; }
                    const f32x4 o0 = x0 * DN_ALPHA + gg[bj][0] * acc[ai][bj][m][0], o1 = x1 * DN_ALPHA + gg[bj][1] * acc[ai][bj][m][1];
                    v4u w; w.x = pk2(o0[0], o0[1]); w.y = pk2(o0[2], o0[3]); w.z = pk2(o1[0], o1[1]); w.w = pk2(o1[2], o1[3]);
                    *(v4u*)(YPRE + off + bj * 128) = w; }
                if (m == 3) asm volatile("" ::: "memory"); }
    }
};
struct EpiUp {
    static constexpr int MID_T = 0; static constexpr bool PERM = true, AFTER_DRAIN = false;
    const float* bup  ; bf16* ACT;
    __device__ __forceinline__ void operator()(const f32x4 (&acc)[2][2][4][2], const pg8::Unit& u, int wr, int wc, int fr, int fq) const {
        const int e = u.pn >> 3, pnl = u.pn & 7; const int row0 = u.pm * 256 + wr * 64 + fr, ac0 = pnl * 128 + wc * 32 + 8 * fq;
        const f32x4* bp = (const f32x4*)(bup + (size_t)e * 2048 + 2 * ac0); const f32x4 b0 = bp[0], b1 = bp[1], b2 = bp[2], b3 = bp[3];
        const float bg[8] = {b0[0], b0[2], b1[0], b1[2], b2[0], b2[2], b3[0], b3[2]}, bl[8] = {b0[1], b0[3], b1[1], b1[3], b2[1], b2[3], b3[1], b3[3]};
#pragma unroll
        for (int ai = 0; ai < 2; ++ai)
#pragma unroll
            for (int m = 0; m < 4; ++m) { float a[8];
#pragma unroll
                for (int j = 0; j < 8; ++j) { const float hg = acc[ai][0][m][j >> 2][j & 3] + bg[j], hl = acc[ai][1][m][j >> 2][j & 3] + bl[j];
                    const float glu = fminf(hg, 7.0f), lin = fminf(fmaxf(hl, -7.0f), 7.0f);
                    a[j] = glu * frcp(1.0f + fexp2(-2.4554669595930156f * glu)) * (lin + 1.0f); }
                v4u w; w.x = pk2(a[0], a[1]); w.y = pk2(a[2], a[3]); w.z = pk2(a[4], a[5]); w.w = pk2(a[6], a[7]);
                *(v4u*)(ACT + (size_t)(row0 + ai * 128 + m * 16) * 1024 + ac0) = w; }
    }
};
struct EpiDn {
    static constexpr int MID_T = 0; static constexpr bool PERM = true, AFTER_DRAIN = false;
    const float* bdn  ; bf16* YKS;
    __device__ __forceinline__ void operator()(const f32x4 (&acc)[2][2][4][2], const pg8::Unit& u, int wr, int wc, int fr, int fq) const {
        const int e = u.pn >> 2, pnl = u.pn & 3; const int row0 = u.pm * 256 + wr * 64 + fr, col0 = pnl * 256 + wc * 32 + 8 * fq;
        f32x4 bv[2][2];
#pragma unroll
        for (int bj = 0; bj < 2; ++bj)
#pragma unroll
            for (int n = 0; n < 2; ++n) bv[bj][n] = *(const f32x4*)(bdn + (size_t)e * 1024 + col0 + bj * 128 + 4 * n);
#pragma unroll
        for (int ai = 0; ai < 2; ++ai)
#pragma unroll
            for (int m = 0; m < 4; ++m) { bf16* op = YKS + (size_t)(row0 + ai * 128 + m * 16) * 1024 + col0;
#pragma unroll
                for (int bj = 0; bj < 2; ++bj) { const f32x4 v0 = acc[ai][bj][m][0] + bv[bj][0], v1 = acc[ai][bj][m][1] + bv[bj][1]; v4u w;
                    w.x = pk2(v0[0], v0[1]); w.y = pk2(v0[2], v0[3]); w.z = pk2(v1[0], v1[1]); w.w = pk2(v1[2], v1[3]);
                    *(v4u*)(op + bj * 128) = w; } }
    }
};
struct MoeOrder {
    static constexpr bool GATHER = false; __device__ __forceinline__ int arow(int, int r) const { return r; }
    int nM, nN, nwg, G, c, rev; const LAS unsigned char* tile_e;
    __device__ void init(int RT, int NN, int G_, int c_, const LAS unsigned char* te, int rev_ = 0) { nM = RT; nN = NN; nwg = RT * NN; G = G_; c = c_; tile_e = te; rev = rev_; }
    __device__ bool next(int i, pg8::Unit& u) const {
        const long L = (long)i * G + c; if (L >= nwg) return false;
        int wgid = (int)L; { const int q = nwg / pg8::NXCD, r = nwg % pg8::NXCD, xcd = wgid % pg8::NXCD, off = wgid / pg8::NXCD; wgid = (xcd < r ? xcd * (q + 1) : r * (q + 1) + (xcd - r) * q) + off; }
        const int nig = pg8::WGM * nN, gid = wgid / nig, fm = gid * pg8::WGM, gsz = (nM - fm) < pg8::WGM ? (nM - fm) : pg8::WGM;
        int pm = fm + ((wgid % nig) % gsz); const int pnl = (wgid % nig) / gsz; if (rev) pm = nM - 1 - pm;
        u.pm = pm; u.pn = (int)tile_e[pm] * nN + pnl; return true;
    }
    __device__ __forceinline__ void a_ready(const pg8::Unit&) const {}
    __device__ __forceinline__ void done(const pg8::Unit&) const {}
};

#ifndef STAG_N
#define STAG_N 1
#endif
#ifndef STAG_US
#define STAG_US 24
#endif
__device__ __forceinline__ void stagger(int slot, int us) {
    if (STAG_N <= 1) return;
    const unsigned long long t0 = __builtin_amdgcn_s_memrealtime(); const unsigned long long ticks = (unsigned long long)(slot % STAG_N) * (unsigned)us * 100ull / STAG_N;
    while (__builtin_amdgcn_s_memrealtime() - t0 < ticks) __builtin_amdgcn_s_sleep(16);
}
struct MoeGatherOrder : MoeOrder {
    static constexpr bool GATHER = true; const LAS unsigned short* tokl;
    __device__ __forceinline__ int arow(int ord, int r) const { return (int)tokl[ord * 256 + (r & 255)]; }
};
constexpr int X_TOKL = XOFF + 6144, TOKL_UNITS = 20;
constexpr int TR_NR = 16, TR_WAVE_BYTES = 128 * 32 * 4;
struct TrItem { const float* src; bf16* dst; int ld, K, kind, k0, c0, koff; };
__device__ __forceinline__ void tr_load(const TrItem& t, int lane, f32x4 (&r)[TR_NR]) {
    const int kk = lane >> 3, cc = lane & 7;
#pragma unroll
    for (int i = 0; i < TR_NR; ++i) r[i] = *(const f32x4*)(t.src + (size_t)(t.k0 + kk + 8 * i) * t.ld + t.c0 + 4 * cc);
}
__device__ __forceinline__ void tr_store(const TrItem& t, int lane, LAS float* scr, const f32x4 (&r)[TR_NR]) {
    { const int kk = lane >> 3, cc = lane & 7;
#pragma unroll
      for (int i = 0; i < TR_NR; ++i) *(LAS f32x4*)(scr + (kk + 8 * i) * 32 + 4 * (cc ^ (i & 7))) = r[i]; }
    LDS_WAIT(); asm volatile("" ::: "memory");
    const int c = lane & 15;
    const int pbase = (t.kind == 0) ? t.c0 : (256 * (t.c0 >> 8) + ((t.c0 & 255) >> 1));
#pragma unroll
    for (int j = 0; j < 8; ++j) { const int n = (lane >> 4) + 4 * j; const LAS float* sp = scr + (8 * c) * 32 + (n ^ ((c & 7) << 2));
        v4u o; o.x = pk2(sp[0 * 32], sp[1 * 32]); o.y = pk2(sp[2 * 32], sp[3 * 32]); o.z = pk2(sp[4 * 32], sp[5 * 32]); o.w = pk2(sp[6 * 32], sp[7 * 32]);
        const int drow = (t.kind == 0) ? (pbase + n) : (pbase + 128 * (n & 1) + (n >> 1));
        __builtin_nontemporal_store(o, (v4u*)(t.dst + (size_t)drow * t.K + t.koff + t.k0 + 8 * c)); }
    LDS_WAIT(); asm volatile("" ::: "memory");
}
__device__ __forceinline__ void sincos_d(double a, double& s, double& c) {
    const double k = rint(a * 0.63661977236758134308);
    const double y = fma(-k, 6.12323399573676603587e-17, fma(-k, 1.57079632679489655800, a));
    const double y2 = y * y;
    double sp = -7.6471637318198164759e-13; sp = fma(sp, y2, 1.6059043836821614599e-10); sp = fma(sp, y2, -2.5052108385441718775e-8); sp = fma(sp, y2, 2.7557319223985890653e-6);
    sp = fma(sp, y2, -1.9841269841269841270e-4); sp = fma(sp, y2, 8.3333333333333333333e-3); sp = fma(sp, y2, -1.6666666666666666667e-1); const double sy = fma(sp * y2, y, y);
    double cp = 4.7794773323873852974e-14; cp = fma(cp, y2, -1.1470745597729724714e-11); cp = fma(cp, y2, 2.0876756987868098979e-9); cp = fma(cp, y2, -2.7557319223985890653e-7);
    cp = fma(cp, y2, 2.4801587301587301587e-5); cp = fma(cp, y2, -1.3888888888888888889e-3); cp = fma(cp, y2, 4.1666666666666666667e-2); cp = fma(cp, y2, -0.5); const double cy = fma(cp, y2, 1.0);
    const int q = ((int)k) & 3;
    s = (q == 0) ? sy : (q == 1) ? cy : (q == 2) ? -sy : -cy;
    c = (q == 0) ? cy : (q == 1) ? -sy : (q == 2) ? -cy : sy;
}
__device__ __forceinline__ void phase_pro_a(Frame& F) {
    LAS float* scr = (LAS float*)(F.lds + F.wave * TR_WAVE_BYTES);
    const int gw = F.vcu * 8 + F.wave, NGW = F.G * 8;
    constexpr int I_IN = 8 * 272, I_SQ = 8 * 32, I_BB = 4 * 32, I_UP = 8 * 64;
    constexpr int S0 = NL * I_IN, S1 = S0 + NL * I_SQ, S2 = S1 + NL * I_BB, S3 = S2 + NL * I_SQ, S4 = S3 + NL * NE * I_SQ, S5 = S4 + NL * NE * I_UP;
    auto decode = [&](int it) -> TrItem { TrItem t; t.koff = 0;
        if (it < S0) { const int l = it / I_IN, r = it % I_IN; t.src = F.in[I_WIN] + (size_t)l * D * NIN; t.dst = wsp<bf16>(F, WS_WIN) + (size_t)l * NIN * D; t.ld = NIN; t.K = D; t.kind = 0; t.k0 = 128 * (r / 272); t.c0 = 32 * (r % 272); }
        else if (it < S1) { const int q = it - S0, l = q / I_SQ, r = q % I_SQ; t.src = F.in[I_WBA] + (size_t)l * D * D; t.dst = wsp<bf16>(F, WS_WBA) + (size_t)l * D * 1536; t.ld = D; t.K = 1536; t.kind = 0; t.k0 = 128 * (r / 32); t.c0 = 32 * (r % 32); }
        else if (it < S2) { const int q = it - S1, l = q / I_BB, r = q % I_BB; t.src = F.in[I_WBB] + (size_t)l * 512 * D; t.dst = wsp<bf16>(F, WS_WBA) + (size_t)l * D * 1536; t.ld = D; t.K = 1536; t.koff = 1024; t.kind = 0; t.k0 = 128 * (r / 32); t.c0 = 32 * (r % 32); }
        else if (it < S3) { const int q = it - S2, l = q / I_SQ, r = q % I_SQ; t.src = F.in[I_WOUT] + (size_t)l * D * D; t.dst = wsp<bf16>(F, WS_WOUT) + (size_t)l * D * D; t.ld = D; t.K = D; t.kind = 0; t.k0 = 128 * (r / 32); t.c0 = 32 * (r % 32); }
        else if (it < S4) { const int q = it - S3, le = q / I_SQ, r = q % I_SQ; t.src = F.in[I_WDN] + (size_t)le * FF * D; t.dst = wsp<bf16>(F, WS_WDN) + (size_t)le * D * FF; t.ld = D; t.K = FF; t.kind = 0; t.k0 = 128 * (r / 32); t.c0 = 32 * (r % 32); }
        else { const int q = it - S4, le = q / I_UP, r = q % I_UP; t.src = F.in[I_WUP] + (size_t)le * D * 2048; t.dst = wsp<bf16>(F, WS_WUP) + (size_t)le * 2048 * D; t.ld = 2048; t.K = D; t.kind = 1; t.k0 = 128 * (r / 64); t.c0 = 32 * (r % 64); }
        return t; };
    {
        f32x4 rn[TR_NR]; TrItem tn; int it = gw;
        if (it < S5) { tn = decode(it); tr_load(tn, F.lane, rn); }
#pragma unroll 1
        for (; it < S5; it += NGW) {
            const TrItem tc = tn; f32x4 rc[TR_NR];
#pragma unroll
            for (int i = 0; i < TR_NR; ++i) rc[i] = rn[i];
            if (it + NGW < S5) { tn = decode(it + NGW); tr_load(tn, F.lane, rn); }
            tr_store(tc, F.lane, scr, rc);
        }
    }
    __syncthreads();
    {
        LAS float* red = (LAS float*)F.lds;
        const float* cv = F.in[I_C];
        for (int u = F.vcu; u < NL * 96; u += F.G) {
            const int l = u / 96, n0 = 64 * (u % 96);
            float a[8];
#pragma unroll
            for (int b = 0; b < 8; ++b) a[b] = 0.f;
            const float* wp = F.in[I_WADA] + (size_t)l * D * 6144 + (size_t)(F.wave * 128) * 6144 + n0 + F.lane;
#pragma unroll 4
            for (int kk = 0; kk < 128; ++kk) { const float w = wp[(size_t)kk * 6144]; const int k = F.wave * 128 + kk;
#pragma unroll
                for (int b = 0; b < 8; ++b) a[b] += cv[b * 1024 + k] * w; }
#pragma unroll
            for (int b = 0; b < 8; ++b) red[(F.wave * 8 + b) * 64 + F.lane] = a[b];
            __syncthreads();
            { const int b = F.tid >> 6, ln = F.tid & 63; float s = F.in[I_BADA][l * 6144 + n0 + ln];
#pragma unroll
              for (int w = 0; w < 8; ++w) s += red[(w * 8 + b) * 64 + ln];
              wsp<float>(F, WS_MOD)[(size_t)(l * 8 + b) * 6144 + n0 + ln] = s; }
            __syncthreads();
        }
    }
    const int gt = F.vcu * 512 + F.tid, NT = F.G * 512;
    for (int i = gt; i < SEQ * 8; i += NT) { const int pos = i >> 3, f = i & 7;
        const double inv = (f == 0) ? 1.0 : (f == 1) ? 0.19392274474868576 : (f == 2) ? 0.03760603093086393 : (f == 3) ? 0.007292664737217109 : (f == 4) ? 0.001414213562373095 : (f == 5) ? 0.0002742481756762073 : (f == 6) ? 5.318295896944988e-05 : 1.031338537721246e-05;
        double s, c; sincos_d((double)pos * inv, s, c);
        float* rp = wsp<float>(F, WS_ROPE) + (size_t)pos * 16; rp[f] = (float)c; rp[8 + f] = (float)s; }
    for (int i = gt; i < NL * 4 * 128 * 128; i += NT) { const int j = i & 127, ii = (i >> 7) & 127; const float w = F.in[I_SPW][i];
        wsp<bf16>(F, WS_WSP)[i] = (bf16)(pk2((j <= ii) ? w : 0.f, 0.f) & 0xffffu); }
    for (int i = gt; i < NL * NE * D; i += NT) { const int k = i & 1023, e = (i >> 10) & 31, l = i >> 15; const float w = F.in[I_WR][((size_t)l * D + k) * NE + e];
        const unsigned hi = pk2(w, 0.f) & 0xffffu; const float lo = w - __uint_as_float(hi << 16);
        wsp<bf16>(F, WS_WRT)[i] = (bf16)hi; wsp<bf16>(F, WS_WRT)[NL * NE * D + i] = (bf16)(pk2(lo, 0.f) & 0xffffu); }
}
__device__ __forceinline__ void phase_pro_b(Frame& F) {
    const int gw = F.vcu * 8 + F.wave, NGW = F.G * 8;
    const float* mod = wsp<float>(F, WS_MOD);
    for (int m = gw; m < T; m += NGW) { const int b = m >> 12; const float* mb = mod + (size_t)b * 6144;
        const f32x4* xr = (const f32x4*)(F.in[I_X] + (size_t)m * D) + F.lane; v2u* hp = (v2u*)(wsp<bf16>(F, WS_H) + (size_t)m * D) + F.lane;
#pragma unroll
        for (int j = 0; j < 4; ++j) { const f32x4 x = xr[64 * j]; const f32x4 sh = *((const f32x4*)mb + F.lane + 64 * j), sc = *((const f32x4*)(mb + 1024) + F.lane + 64 * j);
            const f32x4 h = x * (sc + 1.0f) + sh; v2u o; o.x = pk2(h[0], h[1]); o.y = pk2(h[2], h[3]); hp[64 * j] = o; } }
}

constexpr int AT_RS = 144;
constexpr int AT_ROWS = 400, AT_VOFF = AT_ROWS * AT_RS;
#define LDS_BARRIER() do { asm volatile("s_waitcnt lgkmcnt(0)" ::: "memory"); __builtin_amdgcn_s_barrier(); asm volatile("" ::: "memory"); } while (0)
struct AtUnit { int g, b, h, r, n, d; size_t hoff; };
__device__ __forceinline__ AtUnit at_decode(int u) { AtUnit a; a.g = u >> 10; const int rem = u & 1023; a.b = rem >> 7; a.h = (rem >> 4) & 7; const int rn = rem & 15;
    const int dsh = 2 * a.g, nbs = 4 - dsh; a.d = 1 << dsh; a.r = rn >> nbs; a.n = 2 * (rn & ((1 << nbs) - 1)); a.hoff = (size_t)a.g * 512 + a.h * 64; return a; }
constexpr int AT_NU = 3 * 1024;
struct AtSlot { v4u k[6], v[6]; bf16x8 q0, q1, q2, q3; };
struct AtCtx { const bf16 *Qb, *Kb, *Vb; bf16* OG; float* LSE; LAS unsigned char *Ks, *Vs; int qi, g4, piece, jr; };
__device__ __forceinline__ void at_load(AtSlot& sl, int uu, const AtCtx& C, const Frame& F) {
    const AtUnit a_ = at_decode(uu);
#pragma unroll
    for (int ps = 0; ps < 6; ++ps) { const int lp = 128 * (a_.n - 1) + ps * 64 + C.jr; sl.k[ps] = (v4u){0u, 0u, 0u, 0u}; sl.v[ps] = sl.k[ps];
        if (lp >= 0) { const size_t off = ((size_t)a_.b * SEQ + (size_t)lp * a_.d + a_.r) * 1536 + a_.hoff + C.piece * 8; sl.k[ps] = *(const v4u*)(C.Kb + off); sl.v[ps] = *(const v4u*)(C.Vb + off); } }
    const size_t qrow_ = (size_t)a_.b * SEQ + (size_t)(128 * a_.n + 16 * F.wave + C.qi) * a_.d + a_.r; const bf16* qp = C.Qb + qrow_ * 1536 + a_.hoff + 8 * C.g4;
    sl.q0 = *(const bf16x8*)qp; sl.q1 = *(const bf16x8*)(qp + 32);
    const bf16* qp2 = qp + (size_t)128 * a_.d * 1536; sl.q2 = *(const bf16x8*)qp2; sl.q3 = *(const bf16x8*)(qp2 + 32);
}
__device__ __forceinline__ void at_unit(AtSlot& sl, int u, int unext, const AtCtx& C, const Frame& F) {
    bf16* OG = C.OG; float* LSE = C.LSE; LAS unsigned char* Ks = C.Ks; LAS unsigned char* Vs = C.Vs; const int qi = C.qi, g4 = C.g4;
    const AtUnit au = at_decode(u); const int g = au.g, b = au.b, h = au.h, r = au.r, n = au.n, d = au.d;
#pragma unroll
    for (int ps = 0; ps < 6; ++ps) { const int j = ps * 64 + C.jr; *(LAS v4u*)(Ks + j * AT_RS + C.piece * 16) = sl.k[ps]; *(LAS v4u*)(Vs + j * AT_RS + C.piece * 16) = sl.v[ps]; }
    const bf16x8 sl_q0 = sl.q0, sl_q1 = sl.q1, sl_q2 = sl.q2, sl_q3 = sl.q3;
    LDS_BARRIER();
    if (unext < AT_NU) at_load(sl, unext, C, F);
#pragma unroll
    for (int tq = 0; tq < 2; ++tq)
        {
            const int iq = 128 * tq + 16 * F.wave + qi; const int rb = 128 * tq + 16 * F.wave; const bf16x8 qf0 = tq ? sl_q2 : sl_q0, qf1 = tq ? sl_q3 : sl_q1; const size_t qrow = (size_t)b * SEQ + (size_t)(128 * n + iq) * d + r;
            f32x4 s[10]; float mx = -1e30f; const int dq = qi - 4 * g4; const bool first = (n == 0) && (tq == 0);
#pragma unroll
            for (int st = 0; st < 9; ++st) {
                const LAS unsigned char* kp = Ks + (rb + 16 * st + qi) * AT_RS + g4 * 16;
                const bf16x8 k0 = *(const LAS bf16x8*)kp, k1 = *(const LAS bf16x8*)(kp + 64);
                f32x4 a = (f32x4){0.f, 0.f, 0.f, 0.f};
                a = mfma16(k0, qf0, a); a = mfma16(k1, qf1, a);
                if (st == 0) {
#pragma unroll
                    for (int i = 0; i < 4; ++i) a[i] = (i >= dq) ? a[i] : -1e30f; }
                if (st == 8) {
#pragma unroll
                    for (int i = 0; i < 4; ++i) a[i] = (i <= dq) ? a[i] : -1e30f; }
                if (first) {
#pragma unroll
                    for (int i = 0; i < 4; ++i) a[i] = (rb + 16 * st + 4 * g4 + i >= 128) ? a[i] : -1e30f; }
#pragma unroll
                for (int i = 0; i < 4; ++i) mx = fmaxf(mx, a[i]);
                s[st] = a;
            }
            mx = fmaxf(mx, __shfl_xor(mx, 16)); mx = fmaxf(mx, __shfl_xor(mx, 32));
            float sum = 0.f;
#pragma unroll
            for (int st = 0; st < 9; ++st)
#pragma unroll
                for (int i = 0; i < 4; ++i) { const float p = fexp2(s[st][i] - mx); s[st][i] = p; sum += p; }
            s[9] = (f32x4){0.f, 0.f, 0.f, 0.f};
            sum += __shfl_xor(sum, 16); sum += __shfl_xor(sum, 32);
            f32x4 o[4];
#pragma unroll
            for (int dt = 0; dt < 4; ++dt) o[dt] = (f32x4){0.f, 0.f, 0.f, 0.f};
#pragma unroll
            for (int c = 0; c < 5; ++c) {
                v4u pw; pw.x = pk2(s[2 * c][0], s[2 * c][1]); pw.y = pk2(s[2 * c][2], s[2 * c][3]); pw.z = pk2(s[2 * c + 1][0], s[2 * c + 1][1]); pw.w = pk2(s[2 * c + 1][2], s[2 * c + 1][3]);
                const bf16x8 pf = __builtin_bit_cast(bf16x8, pw);
                const LAS unsigned char* vp = Vs + (rb + 32 * c + 4 * g4 + (qi >> 2)) * AT_RS + 8 * (qi & 3);
#pragma unroll
                for (int dt = 0; dt < 4; ++dt) { const s16x4 lo = tr16(vp + 32 * dt), hi = tr16(vp + 32 * dt + 16 * AT_RS);
                    o[dt] = mfma16(cat8(lo, hi), pf, o[dt]); }
            }
            const float inv = 1.0f / sum;
            bf16* op = OG + ((size_t)g * T + qrow) * 512 + h * 64 + 4 * g4;
#pragma unroll
            for (int dt = 0; dt < 4; ++dt) { v2u w; w.x = pk2(o[dt][0] * inv, o[dt][1] * inv); w.y = pk2(o[dt][2] * inv, o[dt][3] * inv); *(v2u*)(op + 16 * dt) = w; }
            if (g4 == 0) LSE[((size_t)g * T + qrow) * 8 + h] = mx + __log2f(sum);
        }
    LDS_BARRIER();
}
__device__ __forceinline__ void phase_attn(Frame& F) {
    AtCtx C; C.Qb = wsp<bf16>(F, WS_Q); C.Kb = wsp<bf16>(F, WS_K); C.Vb = wsp<bf16>(F, WS_VV); C.OG = wsp<bf16>(F, WS_OG); C.LSE = wsp<float>(F, WS_LSE);
    C.Ks = F.lds; C.Vs = F.lds + AT_VOFF; C.qi = F.lane & 15; C.g4 = F.lane >> 4; C.piece = F.tid & 7; C.jr = F.tid >> 3;
    if (F.tid < 144) { *(LAS v4u*)(C.Ks + 384 * AT_RS + F.tid * 16) = (v4u){0u, 0u, 0u, 0u}; *(LAS v4u*)(C.Vs + 384 * AT_RS + F.tid * 16) = (v4u){0u, 0u, 0u, 0u}; }
    AtSlot sa; const int u0 = F.vcu, G = F.G;
    if (u0 < AT_NU) at_load(sa, u0, C, F);
#pragma unroll 1
    for (int u = u0; u < AT_NU; u += G) at_unit(sa, u, u + G, C, F);
}

constexpr int SG_WOFF = 69632, SG_WRS = 264;
constexpr int SG_RS = 528;
__device__ __forceinline__ void phase_sg(Frame& F, int l) {
    const bf16* Ub = wsp<bf16>(F, WS_U); const bf16* Vb = wsp<bf16>(F, WS_V); bf16* TT = wsp<bf16>(F, WS_TT);
    const bf16* OG = wsp<bf16>(F, WS_OG); const float* LSE = wsp<float>(F, WS_LSE); bf16* OB = wsp<bf16>(F, WS_OB);
    const bf16* Wsp = wsp<bf16>(F, WS_WSP); const float* spb = F.in[I_SPB];
    LAS unsigned char* Vn = F.lds;
    const int qi = F.lane & 15, g4 = F.lane >> 4;
    const int l32 = F.lane & 31;
    v4u vraw[8];
#define SG_LOAD(uu) do { const int gi_ = (uu) & 3, m0_ = ((uu) >> 2) * 128; \
        _Pragma("unroll") for (int ps = 0; ps < 8; ++ps) vraw[ps] = *(const v4u*)(Vb + (size_t)(m0_ + 16 * ps + 2 * F.wave + (F.lane >> 5)) * 1024 + gi_ * 256 + 8 * l32); } while (0)
    if (F.vcu < 1024) SG_LOAD(F.vcu);
    const bool wlds = (F.G & 3) == 0; LAS unsigned char* Wl = F.lds + SG_WOFF;
    if (wlds) { const bf16* wsrc = Wsp + (size_t)(l * 4 + (F.vcu & 3)) * 128 * 128;
        for (int i = F.tid; i < 128 * 16; i += 512) { const int row = i >> 4, ch = i & 15; const v4u wv = *(const v4u*)(wsrc + row * 128 + ch * 8);
            *(LAS v2u*)(Wl + row * SG_WRS + ch * 16) = (v2u){wv.x, wv.y}; *(LAS v2u*)(Wl + row * SG_WRS + ch * 16 + 8) = (v2u){wv.z, wv.w}; } }
    for (int u = F.vcu; u < 1024; u += F.G) {
        const int gi = u & 3, m0 = (u >> 2) * 128;
        float ml[4][3]; v4u mo[4][3]; const int sub = F.tid & 7;
#pragma unroll
        for (int ps = 0; ps < 4; ++ps) { const int p = (F.tid >> 3) + 64 * ps; const size_t tok = (size_t)m0 + (p >> 1); const int hd = 2 * gi + (p & 1); const size_t off = tok * 512 + hd * 64 + 8 * sub;
#pragma unroll
            for (int gq = 0; gq < 3; ++gq) { ml[ps][gq] = LSE[((size_t)gq * T + tok) * 8 + hd]; mo[ps][gq] = *(const v4u*)(OG + (size_t)gq * T * 512 + off); } }
        {
            float sm[8], mean[8], rs[8];
#pragma unroll
            for (int ps = 0; ps < 8; ++ps) { const v4u raw = vraw[ps]; sm[ps] = ((bflo(raw.x) + bfhi(raw.x)) + (bflo(raw.y) + bfhi(raw.y))) + ((bflo(raw.z) + bfhi(raw.z)) + (bflo(raw.w) + bfhi(raw.w))); }
#pragma unroll
            for (int o = 1; o < 32; o <<= 1) {
#pragma unroll
                for (int ps = 0; ps < 8; ++ps) sm[ps] += __shfl_xor(sm[ps], o); }
#pragma unroll
            for (int ps = 0; ps < 8; ++ps) { const v4u raw = vraw[ps]; mean[ps] = sm[ps] * (1.0f / 256.0f); float q = 0.f;
                const float x[8] = {bflo(raw.x), bfhi(raw.x), bflo(raw.y), bfhi(raw.y), bflo(raw.z), bfhi(raw.z), bflo(raw.w), bfhi(raw.w)};
#pragma unroll
                for (int e = 0; e < 8; ++e) { const float dx = x[e] - mean[ps]; q += dx * dx; }
                sm[ps] = q; }
#pragma unroll
            for (int o = 1; o < 32; o <<= 1) {
#pragma unroll
                for (int ps = 0; ps < 8; ++ps) sm[ps] += __shfl_xor(sm[ps], o); }
#pragma unroll
            for (int ps = 0; ps < 8; ++ps) { rs[ps] = 1.0f / sqrtf(sm[ps] * (1.0f / 256.0f) + LN_EPS); const v4u raw = vraw[ps]; const int j = 16 * ps + 2 * F.wave + (F.lane >> 5);
                const float x[8] = {bflo(raw.x), bfhi(raw.x), bflo(raw.y), bfhi(raw.y), bflo(raw.z), bfhi(raw.z), bflo(raw.w), bfhi(raw.w)};
                v4u w; w.x = pk2((x[0] - mean[ps]) * rs[ps], (x[1] - mean[ps]) * rs[ps]); w.y = pk2((x[2] - mean[ps]) * rs[ps], (x[3] - mean[ps]) * rs[ps]);
                w.z = pk2((x[4] - mean[ps]) * rs[ps], (x[5] - mean[ps]) * rs[ps]); w.w = pk2((x[6] - mean[ps]) * rs[ps], (x[7] - mean[ps]) * rs[ps]);
                *(LAS v4u*)(Vn + j * SG_RS + l32 * 16) = w; }
        }
        LDS_BARRIER();
        if (u + F.G < 1024) SG_LOAD(u + F.G);
        {
#pragma unroll
          for (int ps = 0; ps < 4; ++ps) { const int p = (F.tid >> 3) + 64 * ps; const size_t tok = (size_t)m0 + (p >> 1); const int hd = 2 * gi + (p & 1);
              const float l0 = ml[ps][0], l1 = ml[ps][1], l2 = ml[ps][2];
              const float mxx = fmaxf(l0, fmaxf(l1, l2)); float w0 = fexp2(l0 - mxx), w1 = fexp2(l1 - mxx), w2 = fexp2(l2 - mxx); const float inv = 1.0f / (w0 + w1 + w2); w0 *= inv; w1 *= inv; w2 *= inv;
              const size_t off = tok * 512 + hd * 64 + 8 * sub;
              const v4u a = mo[ps][0], bq = mo[ps][1], cq = mo[ps][2]; v4u w;
              w.x = pk2(w0 * bflo(a.x) + w1 * bflo(bq.x) + w2 * bflo(cq.x), w0 * bfhi(a.x) + w1 * bfhi(bq.x) + w2 * bfhi(cq.x));
              w.y = pk2(w0 * bflo(a.y) + w1 * bflo(bq.y) + w2 * bflo(cq.y), w0 * bfhi(a.y) + w1 * bfhi(bq.y) + w2 * bfhi(cq.y));
              w.z = pk2(w0 * bflo(a.z) + w1 * bflo(bq.z) + w2 * bflo(cq.z), w0 * bfhi(a.z) + w1 * bfhi(bq.z) + w2 * bfhi(cq.z));
              w.w = pk2(w0 * bflo(a.w) + w1 * bflo(bq.w) + w2 * bflo(cq.w), w0 * bfhi(a.w) + w1 * bfhi(bq.w) + w2 * bfhi(cq.w));
              *(v4u*)(TT + tok * 1536 + 1024 + hd * 64 + 8 * sub) = w; } }
        v2u uq[8][2]; float ubias[8];
#pragma unroll
        for (int it = 0; it < 8; ++it) { const int i = 16 * it + qi; ubias[it] = spb[(l * 4 + gi) * 128 + i]; const size_t rowo = (size_t)(m0 + i) * 1024 + gi * 256 + 32 * F.wave + 4 * g4;
            uq[it][0] = *(const v2u*)(Ub + rowo); uq[it][1] = *(const v2u*)(Ub + rowo + 16); }
        {
            f32x4 acc[2][8];
#pragma unroll
            for (int ct = 0; ct < 2; ++ct)
#pragma unroll
                for (int it = 0; it < 8; ++it) acc[ct][it] = (f32x4){0.f, 0.f, 0.f, 0.f};
            const bf16* wbase = Wsp + (size_t)(l * 4 + gi) * 128 * 128 + (size_t)qi * 128 + 4 * g4;
#pragma unroll
            for (int kc = 0; kc < 4; ++kc) {
                bf16x8 af[2];
#pragma unroll
                for (int ct = 0; ct < 2; ++ct) { const LAS unsigned char* p = Vn + (32 * kc + 4 * g4 + (qi >> 2)) * SG_RS + (32 * F.wave + 16 * ct + 4 * (qi & 3)) * 2;
                    af[ct] = cat8(tr16(p), tr16(p + 16 * SG_RS)); }
#pragma unroll
                for (int it = 0; it < 8; ++it) if (it >= 2 * kc) {
                    const bf16* wp = wbase + (size_t)(16 * it) * 128 + 32 * kc; const LAS unsigned char* wq = Wl + (16 * it + qi) * SG_WRS + (32 * kc + 4 * g4) * 2;
                    const v2u b0 = wlds ? *(const LAS v2u*)wq : *(const v2u*)wp, b1 = wlds ? *(const LAS v2u*)(wq + 32) : *(const v2u*)(wp + 16);
                    const bf16x8 bfr = __builtin_bit_cast(bf16x8, (v4u){b0.x, b0.y, b1.x, b1.y});
                    acc[0][it] = mfma16(af[0], bfr, acc[0][it]); acc[1][it] = mfma16(af[1], bfr, acc[1][it]); }
            }
#pragma unroll
            for (int it = 0; it < 8; ++it) { const int i = 16 * it + qi; const float bias = ubias[it]; const size_t rowo = (size_t)(m0 + i) * 1536 + gi * 256 + 32 * F.wave + 4 * g4;
#pragma unroll
                for (int ct = 0; ct < 2; ++ct) { const v2u uu = uq[it][ct]; const f32x4 a = acc[ct][it]; v2u w;
                    w.x = pk2(bflo(uu.x) * (a[0] + bias), bfhi(uu.x) * (a[1] + bias)); w.y = pk2(bflo(uu.y) * (a[2] + bias), bfhi(uu.y) * (a[3] + bias));
                    *(v2u*)(TT + rowo + 16 * ct) = w; } }
        }
        LDS_BARRIER();
    }
#undef SG_LOAD
}

__device__ __forceinline__ void phase_ln1(Frame& F, int l, bool commit) {
    const bf16* YPRE = wsp<bf16>(F, WS_YPRE); bf16* H = wsp<bf16>(F, WS_H);
    const float* modl = wsp<float>(F, WS_MOD) + (size_t)l * 8 * 6144;
    const float* lg = F.in[I_LN1G] + l * D; const float* lb = F.in[I_LN1B] + l * D; const float* br = F.in[I_BR] + l * NE;
    const bf16* WH = wsp<bf16>(F, WS_WRT) + (size_t)l * NE * D; const bf16* WL = WH + (size_t)NL * NE * D;
    int* TOKINFO = wsp<int>(F, WS_TOKINFO); float* TOKW = wsp<float>(F, WS_TOKW);
    unsigned* cntg = wsp<unsigned>(F, WS_CTL) + CW_CNT + (size_t)l * NE * 64;
    LAS int* sel_e = (LAS int*)(F.lds + X_SELE);
    const int lane = F.lane, qi = lane & 15, g4 = lane >> 4;
    { const v4u* srcw = (const v4u*)WH;
#pragma unroll 4
      for (int i = F.tid; i < 2 * NE * 128; i += 512) { const int hl = i >> 12, e = (i >> 7) & 31, c = i & 127;
          *(LAS v4u*)(F.lds + hl * 65536 + e * 2048 + ((c ^ (e & 15)) << 4)) = srcw[(size_t)hl * (NL * NE * 128) + e * 128 + c]; } }
    __syncthreads();
    for (int tb = F.vcu; tb < T / 128; tb += F.G) {
        const int m0 = tb * 128; const int b = m0 >> 12; const float* mb = modl + (size_t)b * 6144; const int mw = m0 + 16 * F.wave;
        v2u pre[4][4];
#pragma unroll
        for (int r = 0; r < 4; ++r)
#pragma unroll
            for (int j = 0; j < 4; ++j) pre[r][j] = *((const v2u*)(YPRE + (size_t)(mw + r) * D) + lane + 64 * j);
#pragma unroll 1
        for (int rp = 0; rp < 4; ++rp) {
            f32x4 hh[4][4]; float mean[4], rstd[4];
            const int mrow = mw + 4 * rp;
#pragma unroll
            for (int r = 0; r < 4; ++r)
#pragma unroll
                for (int j = 0; j < 4; ++j) hh[r][j] = (f32x4){bflo(pre[r][j].x), bfhi(pre[r][j].x), bflo(pre[r][j].y), bfhi(pre[r][j].y)};
            if (rp < 3) {
#pragma unroll
                for (int r = 0; r < 4; ++r)
#pragma unroll
                    for (int j = 0; j < 4; ++j) pre[r][j] = *((const v2u*)(YPRE + (size_t)(mrow + 4 + r) * D) + lane + 64 * j); }
            { float sm[4], sq[4];
#pragma unroll
              for (int r = 0; r < 4; ++r) { sm[r] = 0.f; sq[r] = 0.f;
#pragma unroll
                  for (int j = 0; j < 4; ++j) { sm[r] += (hh[r][j][0] + hh[r][j][1]) + (hh[r][j][2] + hh[r][j][3]);
                      sq[r] += (hh[r][j][0] * hh[r][j][0] + hh[r][j][1] * hh[r][j][1]) + (hh[r][j][2] * hh[r][j][2] + hh[r][j][3] * hh[r][j][3]); } }
#pragma unroll
              for (int o = 1; o < 64; o <<= 1) {
#pragma unroll
                  for (int r = 0; r < 4; ++r) { sm[r] += __shfl_xor(sm[r], o); sq[r] += __shfl_xor(sq[r], o); } }
#pragma unroll
              for (int r = 0; r < 4; ++r) { mean[r] = sm[r] * (1.0f / D); rstd[r] = 1.0f / sqrtf(fmaxf(sq[r] * (1.0f / D) - mean[r] * mean[r], 0.f) + LN_EPS); } }
            if (lane < 4) { const float mq = (lane == 0) ? mean[0] : (lane == 1) ? mean[1] : (lane == 2) ? mean[2] : mean[3], rq = (lane == 0) ? rstd[0] : (lane == 1) ? rstd[1] : (lane == 2) ? rstd[2] : rstd[3];
                float* st = wsp<float>(F, WS_STAT) + (size_t)(mrow + lane) * 2; st[0] = mq; st[1] = rq; }
#pragma unroll
            for (int j = 0; j < 4; ++j) { const f32x4 gq = *((const f32x4*)lg + lane + 64 * j), bq = *((const f32x4*)lb + lane + 64 * j);
                const f32x4 shq = *((const f32x4*)(mb + 3072) + lane + 64 * j), scq = *((const f32x4*)(mb + 4096) + lane + 64 * j) + 1.0f;
#pragma unroll
                for (int r = 0; r < 4; ++r) { const f32x4 x1 = (hh[r][j] - mean[r]) * rstd[r] * gq + bq;
                    const f32x4 h2 = x1 * scq + shq; v2u o; o.x = pk2(h2[0], h2[1]); o.y = pk2(h2[2], h2[3]); *((v2u*)(H + (size_t)(mrow + r) * D) + lane + 64 * j) = o;
 } }
        }
        VM_WAIT(); asm volatile("" ::: "memory");
        f32x4 c0 = (f32x4){0.f, 0.f, 0.f, 0.f}, c1 = c0;
        { const bf16* hp = H + (size_t)(mw + qi) * D + 8 * g4;
          const LAS unsigned char* w0 = F.lds + qi * 2048; const LAS unsigned char* w1 = F.lds + (16 + qi) * 2048;
#pragma unroll 8
          for (int ks = 0; ks < 32; ++ks) {
              const bf16x8 hhi = *(const bf16x8*)(hp + 32 * ks);
              const int co = ((4 * ks + g4) ^ qi) << 4;
              const bf16x8 a0h = *(const LAS bf16x8*)(w0 + co), a0l = *(const LAS bf16x8*)(w0 + 65536 + co);
              const bf16x8 a1h = *(const LAS bf16x8*)(w1 + co), a1l = *(const LAS bf16x8*)(w1 + 65536 + co);
              c0 = mfma16(a0h, hhi, c0); c0 = mfma16(a0l, hhi, c0);
              c1 = mfma16(a1h, hhi, c1); c1 = mfma16(a1l, hhi, c1); } }
        {
            float v[8]; int id[8];
#pragma unroll
            for (int i = 0; i < 4; ++i) { id[i] = 4 * g4 + i; id[4 + i] = 16 + 4 * g4 + i; v[i] = c0[i] + br[4 * g4 + i]; v[4 + i] = c1[i] + br[16 + 4 * g4 + i]; }
            int ek[4]; float vk[4];
#pragma unroll
            for (int k = 0; k < 4; ++k) { float lm = v[0]; int li = id[0];
#pragma unroll
                for (int j = 1; j < 8; ++j) if (v[j] > lm) { lm = v[j]; li = id[j]; }
#pragma unroll
                for (int o = 16; o <= 32; o <<= 1) { const float om = __shfl_xor(lm, o); const int oi = __shfl_xor(li, o); if (om > lm || (om == lm && oi < li)) { lm = om; li = oi; } }
                ek[k] = li; vk[k] = lm;
#pragma unroll
                for (int j = 0; j < 8; ++j) if (id[j] == li) v[j] = -INFINITY; }
            const float e1 = __expf(vk[1] - vk[0]), e2 = __expf(vk[2] - vk[0]), e3 = __expf(vk[3] - vk[0]); const float inv = 1.0f / (1.0f + e1 + e2 + e3);
            if (g4 == 0) { const int tl = 16 * F.wave + qi;
                sel_e[tl * 4 + 0] = ek[0]; sel_e[tl * 4 + 1] = ek[1]; sel_e[tl * 4 + 2] = ek[2]; sel_e[tl * 4 + 3] = ek[3];
                *(f32x4*)(TOKW + (size_t)(m0 + tl) * 4) = (f32x4){inv, e1 * inv, e2 * inv, e3 * inv}; }
        }
        __syncthreads();
        { const int myE = sel_e[F.tid]; LAS unsigned long long* bm = (LAS unsigned long long*)(F.lds + X_SELR); unsigned long long mine = 0ull;
#pragma unroll
          for (int e = 0; e < 32; ++e) { const unsigned long long m = __ballot(myE == e); if (lane == e) mine = m; }
          if (lane < 32) bm[F.wave * 32 + lane] = mine;
          __syncthreads();
          int rk = __popcll(bm[F.wave * 32 + myE] & ((1ull << lane) - 1ull));
#pragma unroll
          for (int w = 0; w < 8; ++w) if (w < F.wave) rk += __popcll(bm[w * 32 + myE]);
          TOKINFO[(size_t)m0 * 4 + F.tid] = myE | (rk << 8);
          if (F.tid < 32) { int tot = 0;
#pragma unroll
              for (int w = 0; w < 8; ++w) tot += __popcll(bm[w * 32 + F.tid]);
              wsp<int>(F, WS_WGCNT)[((size_t)l * 256 + tb) * 32 + F.tid] = tot; if (tot && commit) (void)__hip_atomic_fetch_add(cntg + F.tid * 64, (unsigned)tot, RLX_AGENT); } }
        __syncthreads();
    }
}

__device__ __forceinline__ int moe_tables(Frame& F, int l) {
    const unsigned* cntg = wsp<unsigned>(F, WS_CTL) + CW_CNT + (size_t)l * NE * 64;
    LAS int* cnt_s = (LAS int*)(F.lds + X_CNTS); LAS int* off_s = (LAS int*)(F.lds + X_OFFS); LAS unsigned char* tile_e = (LAS unsigned char*)(F.lds + X_TILEE);
    if (F.tid < 32) cnt_s[F.tid] = (int)__hip_atomic_load(cntg + F.tid * 64, RLX_AGENT);
    __syncthreads();
    if (F.tid < 64) {
        const int e = F.tid & 31; const int c = (F.tid < 32) ? cnt_s[e] : 0; const int nt = (c + 255) >> 8; int incl = nt;
#pragma unroll
        for (int o = 1; o < 32; o <<= 1) { const int v = __shfl_up(incl, o); if ((F.tid & 63) >= o) incl += v; }
        if (F.tid < 32) { const int excl = incl - nt; off_s[e] = excl * 256; for (int t = 0; t < nt; ++t) tile_e[excl + t] = (unsigned char)e; if (e == 31) off_s[32] = incl * 256; }
    }
    __syncthreads();
    return off_s[32] >> 8;
}
__device__ __forceinline__ void phase_scat(Frame& F, int l) {
    (void)moe_tables(F, l);
    const LAS int* off_s = (const LAS int*)(F.lds + X_OFFS); const LAS int* cnt_s = (const LAS int*)(F.lds + X_CNTS); LAS int* base_s = (LAS int*)(F.lds + X_BASE);
    const int* TOKINFO = wsp<int>(F, WS_TOKINFO); const float* TOKW = wsp<float>(F, WS_TOKW);
    int* ROWTOK = wsp<int>(F, WS_ROWTOK); float* ROWW = wsp<float>(F, WS_ROWW); const int* WGC = wsp<int>(F, WS_WGCNT) + (size_t)l * 256 * 32; int* TOKINFO2 = wsp<int>(F, WS_TOKROW);
    for (int tb = F.vcu; tb < T / 128; tb += F.G) {
        if (F.tid < 32) base_s[F.tid] = 0;
        __syncthreads();
        { const int e = F.tid & 31, part = F.tid >> 5; int sacc = 0;
          for (int t2 = part * 16; t2 < part * 16 + 16; ++t2) if (t2 < tb) sacc += WGC[t2 * 32 + e];
          if (sacc) atomicAdd((int*)&base_s[e], sacc); }
        __syncthreads();
        { const size_t ent = (size_t)tb * 512 + F.tid; const int info = TOKINFO[ent]; const int e = info & 255, row = off_s[e] + base_s[e] + (info >> 8);
          ROWTOK[row] = (int)ent; ROWW[row] = TOKW[ent]; TOKINFO2[ent] = row; }
        __syncthreads();
    }
    if (F.vcu == 0) for (int e = 0; e < NE; ++e) for (int r = off_s[e] + cnt_s[e] + F.tid; r < off_s[e + 1]; r += 512) { ROWTOK[r] = 0; ROWW[r] = 0.f; }
}
__device__ __forceinline__ void phase_ln2(Frame& F, int l) {
    const bf16* X1 = wsp<bf16>(F, WS_YPRE); const bf16* YK = wsp<bf16>(F, WS_XG); bf16* H = wsp<bf16>(F, WS_H); const int* TOKROW = wsp<int>(F, WS_TOKROW); const float* TOKW = wsp<float>(F, WS_TOKW);
    const float* STAT = wsp<float>(F, WS_STAT); const float* l1g = F.in[I_LN1G] + l * D; const float* l1b = F.in[I_LN1B] + l * D;
    float* XO = F.out; bf16* XB = wsp<bf16>(F, WS_X2);
    const float* modl = wsp<float>(F, WS_MOD) + (size_t)l * 8 * 6144; const float* modn = wsp<float>(F, WS_MOD) + (size_t)((l + 1) & 3) * 8 * 6144;
    const float* lg = F.in[I_LN2G] + l * D; const float* lb = F.in[I_LN2B] + l * D;
    const int lane = F.lane; const int gw = F.vcu * 8 + F.wave, NGW = F.G * 8;
    v2u px[4]; v2u py[4][4]; float pst[2], nst[2]; f32x4 pw4, nw4;
#define LN2_LOAD(mm) do { nst[0] = STAT[(size_t)(mm) * 2]; nst[1] = STAT[(size_t)(mm) * 2 + 1]; nw4 = *(const f32x4*)(TOKW + (size_t)(mm) * 4); \
        int rw_[4]; _Pragma("unroll") for (int k = 0; k < 4; ++k) rw_[k] = TOKROW[(size_t)(mm) * 4 + k]; \
        _Pragma("unroll") for (int j = 0; j < 4; ++j) { px[j] = __builtin_nontemporal_load((const v2u*)(X1 + (size_t)(mm) * D) + lane + 64 * j); \
        _Pragma("unroll") for (int k = 0; k < 4; ++k) py[j][k] = __builtin_nontemporal_load((const v2u*)(YK + (size_t)rw_[k] * D) + lane + 64 * j); } } while (0)
    if (gw < T) LN2_LOAD(gw);
#pragma unroll 1
    for (int m = gw; m < T; m += NGW) { const int b = m >> 12; const float* mb = modl + (size_t)b * 6144; const float* mn = modn + (size_t)b * 6144;
        f32x4 v[4]; float s = 0.f; pst[0] = nst[0]; pst[1] = nst[1]; pw4 = nw4;
#pragma unroll
        for (int j = 0; j < 4; ++j) { f32x4 y = (f32x4){0.f, 0.f, 0.f, 0.f};
#pragma unroll
            for (int k = 0; k < 4; ++k) { const v2u w = py[j][k]; const float cw = pw4[k]; y[0] += cw * bflo(w.x); y[1] += cw * bfhi(w.x); y[2] += cw * bflo(w.y); y[3] += cw * bfhi(w.y); }
            const f32x4 g2 = *((const f32x4*)(mb + 5120) + lane + 64 * j) + 1.0f;
            const f32x4 pxf = (f32x4){bflo(px[j].x), bfhi(px[j].x), bflo(px[j].y), bfhi(px[j].y)};
            const f32x4 x1 = (pxf - pst[0]) * pst[1] * *((const f32x4*)l1g + lane + 64 * j) + *((const f32x4*)l1b + lane + 64 * j);
            v[j] = x1 * DN_ALPHA + g2 * y; s += (v[j][0] + v[j][1]) + (v[j][2] + v[j][3]); }
        if (m + NGW < T) LN2_LOAD(m + NGW);
        float s2 = 0.f;
#pragma unroll
        for (int j = 0; j < 4; ++j) s2 += (v[j][0] * v[j][0] + v[j][1] * v[j][1]) + (v[j][2] * v[j][2] + v[j][3] * v[j][3]);
#pragma unroll
        for (int o = 1; o < 64; o <<= 1) { s += __shfl_xor(s, o); s2 += __shfl_xor(s2, o); }
        const float mean = s * (1.0f / D); const float rstd = 1.0f / sqrtf(fmaxf(s2 * (1.0f / D) - mean * mean, 0.f) + LN_EPS);
#pragma unroll
        for (int j = 0; j < 4; ++j) v[j] = v[j] - mean;
        f32x4* xo = (f32x4*)(XO + (size_t)m * D) + lane; v2u* xb = (v2u*)(XB + (size_t)m * D) + lane; v2u* ho = (v2u*)(H + (size_t)m * D) + lane;
#pragma unroll
        for (int j = 0; j < 4; ++j) { const f32x4 gvj = *((const f32x4*)lg + lane + 64 * j), bvj = *((const f32x4*)lb + lane + 64 * j); const f32x4 x2 = v[j] * rstd * gvj + bvj;
            if (l == NL - 1) __builtin_nontemporal_store(x2, xo + 64 * j); else { v2u xq; xq.x = pk2(x2[0], x2[1]); xq.y = pk2(x2[2], x2[3]); __builtin_nontemporal_store(xq, xb + 64 * j); }
            if (l < NL - 1) { const f32x4 sh = *((const f32x4*)mn + lane + 64 * j), sc = *((const f32x4*)(mn + 1024) + lane + 64 * j) + 1.0f; const f32x4 h = x2 * sc + sh;
                v2u o; o.x = pk2(h[0], h[1]); o.y = pk2(h[2], h[3]); ho[64 * j] = o; } } }
#undef LN2_LOAD
}

#ifndef PH_MASK
#define PH_MASK 0xFFFF
#endif
#define PHM(b) ((PH_MASK >> (b)) & 1)
#ifndef DUP_MASK
#define DUP_MASK 0
#endif
#define REPS(b) (((DUP_MASK >> (b)) & 1) ? 2 : 1)
constexpr int NPH_L = 10, NPHASE = 2 + NL * NPH_L;
struct Args { const float* in[20]; float* out; unsigned char* ws; int ph_lo, ph_hi; };
__global__ void __launch_bounds__(512, 2) fwd(Args args) {
    extern __shared__ __attribute__((aligned(16))) unsigned char lds[];
    Frame F;
    F.lds = (LAS unsigned char*)lds;
#define FRESH() do { int zv_ = 0; asm volatile("" : "+v"(zv_)); const int z_ = __builtin_amdgcn_readfirstlane(zv_); \
        F.tid = (int)threadIdx.x + zv_; F.lane = F.tid & 63; F.wave = __builtin_amdgcn_readfirstlane(F.tid >> 6); \
        F.G = (int)gridDim.x + z_; F.bx = (int)blockIdx.x + z_; F.vcu = (F.G % 8 == 0) ? (F.bx % 8) * (F.G / 8) + F.bx / 8 : F.bx; \
        F.ws = args.ws + z_; F.in = args.in + z_; F.out = args.out + z_; F.lds = (LAS unsigned char*)lds + z_; } while (0)
    FRESH();
    for (int u = F.tid; u < (LDS_BYTES - XOFF) / 4; u += 512) ((LAS unsigned*)(F.lds + XOFF))[u] = 0u;
    __syncthreads();
    unsigned* ctl = wsp<unsigned>(F, WS_CTL);
    XcdBarrier bar; bar.bar = ctl + CW_BAR; bar.x = 0; bar.st = nullptr;
    if (!MK_PER_PHASE) bar = xcd_barrier_post(ctl + CW_BAR, (volatile LAS unsigned*)(F.lds + X_MISC) + 8);
    const int lo = args.ph_lo, hi = args.ph_hi;
#define IN(k) (lo <= (k) && (k) < hi)
#ifndef BAR_REPS
#define BAR_REPS 1
#endif
#define SEAM(k) do { if (!MK_PER_PHASE && IN(k) && IN((k) + 1)) for (int br_ = 0; br_ < BAR_REPS; ++br_) xcd_barrier(bar); } while (0)

    if (PHM(0) && IN(0)) for (int rep = 0; rep < REPS(0); ++rep) { FRESH(); phase_pro_a(F); } SEAM(0);
    if (PHM(1) && IN(1)) for (int rep = 0; rep < REPS(1); ++rep) { FRESH(); phase_pro_b(F); } SEAM(1);
    for (int l = 0; l < NL; ++l) {
        const int pb = 2 + l * NPH_L;
        if (PHM(2) && IN(pb + 0)) for (int rep = 0; rep < REPS(2); ++rep) { FRESH();
            pg8::Gemm g{wsp<bf16>(F, WS_H), wsp<bf16>(F, WS_WIN) + (size_t)l * NIN * D, T, NIN, D}; pg8::StaticOrder S; S.init(T, NIN, F.G, F.bx);
            EpiIn E{wsp<bf16>(F, WS_U), wsp<bf16>(F, WS_V), wsp<bf16>(F, WS_Q), wsp<bf16>(F, WS_K), wsp<bf16>(F, WS_VV), wsp<bf16>(F, WS_G), wsp<float>(F, WS_ROPE)};
            stagger(F.bx >> 3, STAG_US);
            pg8::gemm_phase<EpiIn, pg8::StaticOrder, PG8_ALIGN, PG8_SP2>(F.lds, g, S, E, F.tid);
#if defined(XPROBE)
            { FRESH(); pg8::Gemm g2{wsp<bf16>(F, WS_H), wsp<bf16>(F, WS_WIN) + (size_t)l * NIN * D, T, NIN, D}; pg8::StaticOrder S2; S2.init(T, NIN, F.G, F.bx);
              EpiProbe E2{wsp<bf16>(F, WS_XG), (XPROBE == 3) ? NIN : 1024, (XPROBE >= 2) ? (XPROBE == 3 ? 3 : 1) : (F.G == 0x7ffffff0 ? 1 : 0)};
              pg8::gemm_phase<EpiProbe, pg8::StaticOrder, PG8_ALIGN, PG8_SP2>(F.lds, g2, S2, E2, F.tid); }
#endif
        } SEAM(pb + 0);
        if (PHM(3) && IN(pb + 1)) for (int rep = 0; rep < REPS(3); ++rep) { FRESH(); phase_attn(F); } SEAM(pb + 1);
        if (PHM(4) && IN(pb + 2)) for (int rep = 0; rep < REPS(4); ++rep) { FRESH(); phase_sg(F, l); } SEAM(pb + 2);
        if (PHM(5) && IN(pb + 3)) for (int rep = 0; rep < REPS(5); ++rep) { FRESH();
            pg8::Gemm g{wsp<bf16>(F, WS_TT), wsp<bf16>(F, WS_WBA) + (size_t)l * D * 1536, T, D, 1536}; pg8::StaticOrder S; S.init(T, D, F.G, F.bx);
            EpiMg2 E{wsp<bf16>(F, WS_G), wsp<bf16>(F, WS_MG)}; pg8::gemm_phase<EpiMg2, pg8::StaticOrder, PG8_ALIGN, PG8_SP2>(F.lds, g, S, E, F.tid);
        } SEAM(pb + 3);
        if (PHM(6) && IN(pb + 4)) for (int rep = 0; rep < REPS(6); ++rep) { FRESH();
            pg8::Gemm g{wsp<bf16>(F, WS_MG), wsp<bf16>(F, WS_WOUT) + (size_t)l * D * D, T, D, D}; pg8::StaticOrder S; S.init(T, D, F.G, F.bx);
            if (l == 0) { EpiOut<true> E{(const void*)F.in[I_X], wsp<float>(F, WS_MOD) + (size_t)l * 8 * 6144, wsp<bf16>(F, WS_YPRE)}; pg8::gemm_phase<EpiOut<true>, pg8::StaticOrder, PG8_ALIGN, PG8_SP2>(F.lds, g, S, E, F.tid); }
            else { EpiOut<false> E{(const void*)wsp<bf16>(F, WS_X2), wsp<float>(F, WS_MOD) + (size_t)l * 8 * 6144, wsp<bf16>(F, WS_YPRE)}; pg8::gemm_phase<EpiOut<false>, pg8::StaticOrder, PG8_ALIGN, PG8_SP2>(F.lds, g, S, E, F.tid); }
        } SEAM(pb + 4);
        if (PHM(7) && IN(pb + 5)) for (int rep = 0; rep < REPS(7); ++rep) { FRESH(); phase_ln1(F, l, rep == 0); } SEAM(pb + 5);
        if (PHM(8) && IN(pb + 6)) for (int rep = 0; rep < REPS(8); ++rep) { FRESH(); phase_scat(F, l); } SEAM(pb + 6);
        if (PHM(9) && IN(pb + 7)) for (int rep = 0; rep < REPS(9); ++rep) { FRESH();
            const int RT = moe_tables(F, l);
            pg8::Gemm g{wsp<bf16>(F, WS_H), wsp<bf16>(F, WS_WUP) + (size_t)l * NE * 2048 * D, RT * 256, NE * 2048, D};
            MoeGatherOrder S; S.init(RT, 8, F.G, F.bx, (const LAS unsigned char*)(F.lds + X_TILEE)); S.tokl = (const LAS unsigned short*)(F.lds + X_TOKL);
            { const int* rowtok = wsp<int>(F, WS_ROWTOK); LAS unsigned short* tl = (LAS unsigned short*)(F.lds + X_TOKL); pg8::Unit uu;
              for (int i = 0; i < TOKL_UNITS && S.next(i, uu); ++i) if (F.tid < 256) tl[i * 256 + F.tid] = (unsigned short)(rowtok[uu.pm * 256 + F.tid] >> 2);
              __syncthreads(); }
            EpiUp E{F.in[I_BUP] + (size_t)l * NE * 2048, wsp<bf16>(F, WS_ACT)};
            stagger(F.bx >> 3, STAG_US);
            pg8::gemm_phase<EpiUp, MoeGatherOrder, PG8_ALIGN, true>(F.lds, g, S, E, F.tid);
        } SEAM(pb + 7);
        if (PHM(10) && IN(pb + 8)) for (int rep = 0; rep < REPS(10); ++rep) { FRESH();
            const int RT = moe_tables(F, l);
            pg8::Gemm g{wsp<bf16>(F, WS_ACT), wsp<bf16>(F, WS_WDN) + (size_t)l * NE * D * FF, RT * 256, NE * D, FF};
            MoeOrder S; S.init(RT, 4, F.G, F.bx, (const LAS unsigned char*)(F.lds + X_TILEE), 1);
            EpiDn E{F.in[I_BDN] + (size_t)l * NE * D, wsp<bf16>(F, WS_XG)};
            stagger(F.bx >> 3, STAG_US);
            pg8::gemm_phase<EpiDn, MoeOrder, PG8_ALIGN, PG8_SP2>(F.lds, g, S, E, F.tid);
        } SEAM(pb + 8);
        if (PHM(11) && IN(pb + 9)) for (int rep = 0; rep < REPS(11); ++rep) { FRESH(); phase_ln2(F, l); } SEAM(pb + 9);
    }
#undef IN
#undef SEAM
#undef FRESH
}

extern "C" void kernel_launch(void* const* d_in, const int* in_sizes, int n_in, void* d_out, int out_size, void* d_ws, size_t ws_size, hipStream_t stream) {
    static int grid = 0;
    if (grid == 0) {
        if (n_in != 20 || out_size != T * D || ws_size < WS_END) { fprintf(stderr, "kernel_launch: unexpected shapes (n_in %d, out %d, ws %zu < %zu)\n", n_in, out_size, ws_size, (size_t)WS_END); grid = -1; return; }
        int dev = 0, cus = 0;
        if (hipGetDevice(&dev) != hipSuccess || hipDeviceGetAttribute(&cus, hipDeviceAttributeMultiprocessorCount, dev) != hipSuccess) { grid = -1; return; }
        if (hipFuncSetAttribute((const void*)fwd, hipFuncAttributeMaxDynamicSharedMemorySize, LDS_BYTES) != hipSuccess) { fprintf(stderr, "kernel_launch: hipFuncSetAttribute failed\n"); grid = -1; return; }
        int per_cu = 0;
        if (hipOccupancyMaxActiveBlocksPerMultiprocessor(&per_cu, (const void*)fwd, 512, LDS_BYTES) != hipSuccess || per_cu < 1) fprintf(stderr, "kernel_launch: occupancy query says %d blocks per CU\n", per_cu);
        (void)hipGetLastError();
        grid = cus;
    }
    if (grid < 0) return;
    (void)in_sizes;
    if (hipMemsetAsync((char*)d_ws + WS_CTL, 0, CTL_ZERO_BYTES, stream) != hipSuccess) return;
    Args a{};
    for (int i = 0; i < 20; ++i) a.in[i] = (const float*)d_in[i];
    a.out = (float*)d_out; a.ws = (unsigned char*)d_ws;
#if MK_PER_PHASE
    for (int p = 0; p < NPHASE; ++p) { a.ph_lo = p; a.ph_hi = p + 1; hipLaunchKernelGGL(fwd, dim3(grid), dim3(512), LDS_BYTES, stream, a); }
#else
    a.ph_lo = 0; a.ph_hi = NPHASE;
    hipLaunchKernelGGL(fwd, dim3(grid), dim3(512), LDS_BYTES, stream, a);
#endif
    const hipError_t le = hipPeekAtLastError();
    if (le != hipSuccess) fprintf(stderr, "kernel_launch: launch failed: %s\n", hipGetErrorName(le));
}
```

```cpp
#include <hip/hip_runtime.h>
#include <cstdio>
#include <cstdint>
#ifndef MK_PER_PHASE
#define MK_PER_PHASE 0
#endif
namespace pg8 {
#define PG8_LAS __attribute__((address_space(3)))
typedef unsigned short bf16_t;
typedef short bf16x8 __attribute__((ext_vector_type(8)));
typedef float f32x4 __attribute__((ext_vector_type(4)));
typedef unsigned u32x4 __attribute__((ext_vector_type(4)));
constexpr int BM = 256, BK = 64, HALF = 128, HTB = HALF * BK * 2  , STAGE_BYTES = 8 * HTB, NXCD = 8;
#ifndef PG8_WGM
#define PG8_WGM 8
#endif
constexpr int WGM = PG8_WGM;

__host__ __device__ __forceinline__ int lds_byte(int r, int c) { const int st = (r >> 4) * 2 + (c >> 5), rr = r & 15, cc = c & 31, ob = rr * 64 + cc * 2; return st * 1024 + (ob ^ (((ob >> 9) & 1) << 5)); }
__host__ __device__ __forceinline__ void stage_rc(int b, int& R, int& C) { const int st = b / 1024, sb = b % 1024, swz = sb ^ (((sb >> 9) & 1) << 5); R = (st >> 1) * 16 + swz / 64; C = (st & 1) * 32 + (swz % 64) / 2; }
__host__ __device__ __forceinline__ int perm32(int rho) { const int n = rho >> 4, i = rho & 15; return 8 * (i >> 2) + 4 * n + (i & 3); }

struct Unit { int pm, pn; };
struct Gemm { const bf16_t* A; const bf16_t* Bt; int M, N, K; };

struct StaticOrder {
    static constexpr bool GATHER = false; __device__ __forceinline__ int arow(int, int r) const { return r; }
    int nM, nN, nwg, G, c;
    __host__ __device__ void init(int M, int N, int G_, int c_) { nM = M / BM; nN = N / BM; nwg = nM * nN; G = G_; c = c_; }
    __host__ __device__ bool next(int i, Unit& u) const {
        const long L = (long)i * G + c; if (L >= nwg) return false;
        int wgid = (int)L; { const int q = nwg / NXCD, r = nwg % NXCD, xcd = wgid % NXCD, off = wgid / NXCD; wgid = (xcd < r ? xcd * (q + 1) : r * (q + 1) + (xcd - r) * q) + off; }
        const int nig = WGM * nN, gid = wgid / nig, fm = gid * WGM, gsz = (nM - fm) < WGM ? (nM - fm) : WGM;
        u.pm = fm + ((wgid % nig) % gsz); u.pn = (wgid % nig) / gsz; return true;
    }
    __device__ __forceinline__ void a_ready(const Unit&) const {}
    __device__ __forceinline__ void done(const Unit&) const {}
};

__device__ __forceinline__ unsigned cvt_pk_bf16(float lo, float hi) { unsigned r; asm volatile("v_cvt_pk_bf16_f32 %0, %1, %2" : "=v"(r) : "v"(lo), "v"(hi)); return r; }
typedef float f32x2 __attribute__((ext_vector_type(2)));

template <class Epi, class Sched, bool ALIGN_EPI = false, bool SP2 = false>
__device__ __forceinline__ void gemm_phase(PG8_LAS unsigned char* lds, const Gemm g, const Sched& S, const Epi& E, const int tid_in) {
    const int tid = tid_in, wid = __builtin_amdgcn_readfirstlane(tid >> 6), lane = tid & 63, wr = wid >> 2, wc = wid & 3, fr = lane & 15, fq = lane >> 4;
    const int K = g.K, nt = K / BK;
    unsigned voffA[2], voffB[2];
#pragma unroll
    for (int i = 0; i < 2; ++i) { int R, C; stage_rc(tid * 16 + i * 8192, R, C); const int Rb = Epi::PERM ? ((R & ~31) + perm32(R & 31)) : R;
        voffA[i] = (unsigned)(R * K + C) * 2u; voffB[i] = (unsigned)(Rb * K + C) * 2u; }
    const size_t kstep = (size_t)(BK * 2);
    const size_t hstep = (size_t)HALF * K * 2;
    const size_t tstep = 2 * hstep;
    const unsigned ldsw = (unsigned)wid * 1024u;
    const int aoff = lds_byte(wr * 64 + fr, fq * 8), boff = lds_byte(wc * 32 + fr, fq * 8);
#define PG8_SA(b, h) (((b) * 2 + (h)) * HTB)
#define PG8_SB(b, h) ((4 + (b) * 2 + (h)) * HTB)
    unsigned gc[2][2], gn[2][2];
#define PG8_GOFF(dst, pmv, ordv) do { if constexpr (Sched::GATHER) { _Pragma("unroll") for (int _h = 0; _h < 2; ++_h) _Pragma("unroll") for (int _i = 0; _i < 2; ++_i) { int _R, _C; stage_rc(tid * 16 + _i * 8192, _R, _C); \
        dst[_h][_i] = (unsigned)S.arow((ordv), (pmv) * 256 + _h * 128 + _R) * (unsigned)(K * 2) + (unsigned)(_C * 2); } } } while (0)
#define PG8_STAGE_A(bufoff, origptr, nextf, hh, kbytes) do { if constexpr (Sched::GATHER) { _Pragma("unroll") for (int _i = 0; _i < 2; ++_i) { const unsigned _o = (nextf) ? gn[hh][_i] : gc[hh][_i]; \
        __builtin_amdgcn_global_load_lds((const unsigned*)((const char*)g.A + (kbytes) + _o), (PG8_LAS unsigned*)(lds + (bufoff) + ldsw + _i * 8192), 16, 0, 0); } } else { PG8_STAGE(bufoff, origptr, voffA); } } while (0)
#define PG8_STAGE(bufoff, gbase, voff) do { _Pragma("unroll") for (int _i = 0; _i < 2; ++_i) \
        __builtin_amdgcn_global_load_lds((const unsigned*)((const char*)(gbase) + (voff)[_i]), (PG8_LAS unsigned*)(lds + (bufoff) + ldsw + _i * 8192), 16, 0, 0); } while (0)
#define PG8_LDA(dst, b, h) do { _Pragma("unroll") for (int m = 0; m < 4; ++m) _Pragma("unroll") for (int k = 0; k < 2; ++k) dst[m][k] = *(const PG8_LAS bf16x8*)(lds + PG8_SA(b, h) + aoff + m * 2048 + k * 1024); } while (0)
#define PG8_LDB(dst, b, h) do { _Pragma("unroll") for (int n = 0; n < 2; ++n) _Pragma("unroll") for (int k = 0; k < 2; ++k) dst[n][k] = *(const PG8_LAS bf16x8*)(lds + PG8_SB(b, h) + boff + n * 2048 + k * 1024); } while (0)
#define PG8_MMA(ai, bj, At, Bt) do { __builtin_amdgcn_s_setprio(1); _Pragma("unroll") for (int m = 0; m < 4; ++m) _Pragma("unroll") for (int n = 0; n < 2; ++n) _Pragma("unroll") for (int k = 0; k < 2; ++k) \
        acc[ai][bj][m][n] = __builtin_amdgcn_mfma_f32_16x16x32_bf16(Bt[n][k], At[m][k], acc[ai][bj][m][n], 0, 0, 0); __builtin_amdgcn_s_setprio(0); } while (0)
#define PG8_WAIT_V(n) asm volatile("s_waitcnt vmcnt(" #n ")" ::: "memory")
#define PG8_WAIT_L(n) asm volatile("s_waitcnt lgkmcnt(" #n ")" ::: "memory")
#define PG8_BAR __builtin_amdgcn_s_barrier()
#define PG8_SCHED __builtin_amdgcn_sched_barrier(0)
    Unit cur, nxt; int ui = 0;
    if (!S.next(0, cur)) return;
    f32x4 acc[2][2][4][2];
#pragma unroll
    for (int a = 0; a < 2; ++a)
#pragma unroll
        for (int b = 0; b < 2; ++b)
#pragma unroll
            for (int m = 0; m < 4; ++m)
#pragma unroll
                for (int n = 0; n < 2; ++n) acc[a][b][m][n] = (f32x4){0.f, 0.f, 0.f, 0.f};
    bf16x8 At[4][2], B0[2][2], B1[2][2];
    const char* cA = (const char*)g.A + (size_t)cur.pm * tstep; const char* cB = (const char*)g.Bt + (size_t)cur.pn * tstep;
    S.a_ready(cur);
    PG8_GOFF(gc, cur.pm, 0);
    if constexpr (SP2) {
        PG8_STAGE(PG8_SB(0, 0), cB, voffB); PG8_STAGE(PG8_SB(0, 1), cB + hstep, voffB); PG8_STAGE_A(PG8_SA(0, 0), cA, false, 0, 0); PG8_STAGE_A(PG8_SA(0, 1), cA + hstep, false, 1, 0);
        if (wr == 1) PG8_BAR;
        PG8_WAIT_V(2); PG8_BAR;
        PG8_STAGE(PG8_SB(1, 0), cB + kstep, voffB); PG8_STAGE_A(PG8_SA(1, 0), cA + kstep, false, 0, kstep); PG8_STAGE(PG8_SB(1, 1), cB + hstep + kstep, voffB);
        PG8_WAIT_V(6); PG8_BAR;
    } else {
        PG8_STAGE(PG8_SB(0, 0), cB, voffB); PG8_STAGE(PG8_SA(0, 0), cA, voffA); PG8_STAGE(PG8_SB(0, 1), cB + hstep, voffB); PG8_STAGE(PG8_SA(0, 1), cA + hstep, voffA);
        if (wr == 1) PG8_BAR;
        PG8_WAIT_V(4); PG8_BAR;
        PG8_STAGE(PG8_SB(1, 0), cB + kstep, voffB); PG8_STAGE(PG8_SA(1, 0), cA + kstep, voffA); PG8_STAGE(PG8_SB(1, 1), cB + hstep + kstep, voffB);
        PG8_WAIT_V(6); PG8_BAR;
    }
    for (;;) {
        const bool has_next = S.next(ui + 1, nxt);
        if constexpr (Sched::GATHER) { if (has_next) { PG8_GOFF(gn, nxt.pm, ui + 1); } else { gn[0][0] = gc[0][0]; gn[0][1] = gc[0][1]; gn[1][0] = gc[1][0]; gn[1][1] = gc[1][1]; } }
        const char* nA = has_next ? (const char*)g.A + (size_t)nxt.pm * tstep : cA; const char* nB = has_next ? (const char*)g.Bt + (size_t)nxt.pn * tstep : cB;
#pragma unroll
        for (int seg = 0; seg < (Epi::MID_T > 0 ? 2 : 1); ++seg) {
        if constexpr (Epi::MID_T > 0) { if (seg == 1) { PG8_SCHED; E.mid(acc, cur, wr, wc, fr, fq); PG8_SCHED; } }
        const int t_lo = seg ? Epi::MID_T : 0, t_hi = (Epi::MID_T > 0 && seg == 0) ? Epi::MID_T : nt;
        for (int t = t_lo; t < t_hi; t += 2) {
            const bool last = (t == nt - 2);
            const char* a1 = cA + (size_t)(t + 1) * kstep;
            const char* a2 = last ? nA : cA + (size_t)(t + 2) * kstep; const char* b2 = last ? nB : cB + (size_t)(t + 2) * kstep;
            const char* a3 = a2 + kstep; const char* b3 = b2 + kstep; const size_t k2b = last ? (size_t)0 : (size_t)(t + 2) * kstep;
            if (last && has_next) S.a_ready(nxt);
            if constexpr (SP2) {
            PG8_LDB(B0, 0, 0); PG8_LDB(B1, 0, 1); PG8_SCHED; PG8_LDA(At, 0, 0); PG8_STAGE_A(PG8_SA(1, 1), a1 + hstep, false, 1, (size_t)(t + 1) * kstep);
            PG8_WAIT_V(8); PG8_WAIT_L(0); PG8_BAR; PG8_MMA(0, 0, At, B0); PG8_MMA(0, 1, At, B1); PG8_BAR; PG8_SCHED;
            PG8_LDA(At, 0, 1); PG8_STAGE(PG8_SB(0, 0), b2, voffB); PG8_STAGE(PG8_SB(0, 1), b2 + hstep, voffB); PG8_STAGE_A(PG8_SA(0, 0), a2, last, 0, k2b);
            PG8_WAIT_V(8); PG8_WAIT_L(0); PG8_BAR; PG8_MMA(1, 0, At, B0); PG8_MMA(1, 1, At, B1); PG8_BAR; PG8_SCHED;
            PG8_LDB(B0, 1, 0); PG8_LDB(B1, 1, 1); PG8_SCHED; PG8_LDA(At, 1, 0); PG8_STAGE_A(PG8_SA(0, 1), a2 + hstep, last, 1, k2b);
            PG8_WAIT_V(8); PG8_WAIT_L(0); PG8_BAR; PG8_MMA(0, 0, At, B0); PG8_MMA(0, 1, At, B1); PG8_BAR; PG8_SCHED;
            PG8_LDA(At, 1, 1); PG8_STAGE(PG8_SB(1, 0), b3, voffB); PG8_STAGE(PG8_SB(1, 1), b3 + hstep, voffB); PG8_STAGE_A(PG8_SA(1, 0), a3, last, 0, k2b + kstep);
            PG8_WAIT_V(8); PG8_WAIT_L(0); PG8_BAR; PG8_MMA(1, 0, At, B0); PG8_MMA(1, 1, At, B1); PG8_BAR; PG8_SCHED;
            } else {
            PG8_LDB(B0, 0, 0); PG8_SCHED; PG8_LDA(At, 0, 0); PG8_STAGE(PG8_SA(1, 1), a1 + hstep, voffA);
            PG8_WAIT_L(8); PG8_BAR; PG8_WAIT_L(0); PG8_MMA(0, 0, At, B0); PG8_BAR; PG8_SCHED;
            PG8_LDB(B1, 0, 1); PG8_STAGE(PG8_SB(0, 0), b2, voffB);
            PG8_BAR; PG8_WAIT_L(0); PG8_MMA(0, 1, At, B1); PG8_BAR;
            PG8_LDA(At, 0, 1); PG8_STAGE(PG8_SA(0, 0), a2, voffA);
            PG8_BAR; PG8_WAIT_L(0); PG8_MMA(1, 0, At, B0); PG8_BAR; PG8_SCHED;
            PG8_STAGE(PG8_SB(0, 1), b2 + hstep, voffB);
            PG8_WAIT_V(6); PG8_BAR; PG8_MMA(1, 1, At, B1); PG8_BAR;
            PG8_LDB(B0, 1, 0); PG8_SCHED; PG8_LDA(At, 1, 0); PG8_STAGE(PG8_SA(0, 1), a2 + hstep, voffA);
            PG8_WAIT_L(8); PG8_BAR; PG8_WAIT_L(0); PG8_MMA(0, 0, At, B0); PG8_BAR; PG8_SCHED;
            PG8_LDB(B1, 1, 1); PG8_STAGE(PG8_SB(1, 0), b3, voffB);
            PG8_BAR; PG8_WAIT_L(0); PG8_MMA(0, 1, At, B1); PG8_BAR;
            PG8_LDA(At, 1, 1); PG8_STAGE(PG8_SA(1, 0), a3, voffA);
            PG8_BAR; PG8_WAIT_L(0); PG8_MMA(1, 0, At, B0); PG8_BAR; PG8_SCHED;
            PG8_STAGE(PG8_SB(1, 1), b3 + hstep, voffB);
            PG8_WAIT_V(6); PG8_BAR; PG8_MMA(1, 1, At, B1); PG8_BAR;
            }
        }
        }
        if constexpr (ALIGN_EPI) { if (wr == 0) PG8_BAR; }
        if constexpr (!Epi::AFTER_DRAIN) { E(acc, cur, wr, wc, fr, fq); S.done(cur); }
        if (!has_next) break;
#pragma unroll
        for (int a = 0; a < 2; ++a)
#pragma unroll
            for (int b = 0; b < 2; ++b)
#pragma unroll
                for (int m = 0; m < 4; ++m)
#pragma unroll
                    for (int n = 0; n < 2; ++n) acc[a][b][m][n] = (f32x4){0.f, 0.f, 0.f, 0.f};
        cur = nxt; cA = nA; cB = nB; ++ui;
        if constexpr (Sched::GATHER) { gc[0][0] = gn[0][0]; gc[0][1] = gn[0][1]; gc[1][0] = gn[1][0]; gc[1][1] = gn[1][1]; }
        if constexpr (ALIGN_EPI) { if (wr == 1) PG8_BAR; }
    }
    PG8_WAIT_V(0);
    if constexpr (!ALIGN_EPI) { if (wr == 0) PG8_BAR; }
    PG8_BAR;
    if constexpr (Epi::AFTER_DRAIN) { E.fused(acc, cur, wr, wc, fr, fq, lds, wid, lane); S.done(cur); }
#undef PG8_SA
#undef PG8_SB
#undef PG8_STAGE
#undef PG8_STAGE_A
#undef PG8_GOFF
#undef PG8_LDA
#undef PG8_LDB
#undef PG8_MMA
#undef PG8_WAIT_V
#undef PG8_WAIT_L
#undef PG8_BAR
#undef PG8_SCHED
}
}
#define LAS __attribute__((address_space(3)))
#define XB_TMO      128
#define XB_XCNT(j)  (256  + 64 * (j))
#define XB_XSUB(j)  (1280 + 64 * (j))
#define XB_XGEN(j)  (2304 + 64 * (j))
#define XB_TOP      3328
#define XB_TOPGEN   3392
#define XCD_BAR_WORDS 3456
#define XB_SPIN_CAP (1u << 18)

__device__ __forceinline__ unsigned xb_ld(unsigned* p)              { return __hip_atomic_load(p, __ATOMIC_RELAXED, __HIP_MEMORY_SCOPE_AGENT); }
__device__ __forceinline__ unsigned xb_add(unsigned* p, unsigned v) { return __hip_atomic_fetch_add(p, v, __ATOMIC_RELAXED, __HIP_MEMORY_SCOPE_AGENT); }
__device__ __forceinline__ unsigned xb_xcc_id() { return (unsigned)__builtin_amdgcn_s_getreg((3 << 11) | 20) & 0xFu; }
#define XB_SPIN(cond, bar) do { unsigned _sp = 0; while (cond) { __builtin_amdgcn_s_sleep(1); \
    if ((++_sp & 255u) == 0u) { if (xb_ld(&(bar)[XB_TMO])) break; if (_sp > XB_SPIN_CAP) { atomicAdd(&(bar)[XB_TMO], 1u); break; } } } } while (0)

struct XcdBarrier {
    unsigned* bar; unsigned x;
    volatile LAS unsigned* st;
};

__device__ __forceinline__ XcdBarrier xcd_barrier_post(unsigned* bar, volatile LAS unsigned* st) {
    XcdBarrier b; b.bar = bar; b.x = xb_xcc_id(); b.st = st;
    if (threadIdx.x == 0) (void)xb_add(&bar[XB_XCNT(b.x)], 1u);
    return b;
}
__device__ __forceinline__ void xcd_barrier_complete(unsigned* bar, unsigned x, unsigned& nloc, unsigned& nx) {
    const unsigned G = gridDim.x * gridDim.y * gridDim.z;
    unsigned sum, cnt, mine, sp = 0u;
    for (;;) {
        sum = 0u; cnt = 0u; mine = 0u;
#pragma unroll
        for (unsigned j = 0; j < 16; ++j) { const unsigned c = xb_ld(&bar[XB_XCNT(j)]); sum += c; cnt += (c > 0u) ? 1u : 0u; mine = (j == x) ? c : mine; }
        if (sum == G) break;
        __builtin_amdgcn_s_sleep(1);
        if ((++sp & 255u) == 0u) { if (xb_ld(&bar[XB_TMO])) break; if (sp > XB_SPIN_CAP) { atomicAdd(&bar[XB_TMO], 1u); break; } }
    }
    nloc = mine > 0u ? mine : 1u; nx = cnt > 0u ? cnt : 1u;
}

__device__ __forceinline__ void xcd_barrier(const XcdBarrier& b) {
    asm volatile("s_waitcnt vmcnt(0)" ::: "memory");
    __syncthreads();
    if (threadIdx.x == 0) {
        unsigned* bar = b.bar;
        __builtin_amdgcn_s_waitcnt(0);
        unsigned nloc = b.st[0], nx = b.st[1];
        if (nloc == 0u) { xcd_barrier_complete(bar, b.x, nloc, nx); b.st[0] = nloc; b.st[1] = nx; }
        const unsigned old = xb_add(&bar[XB_XSUB(b.x)], 1u);
        const unsigned gen = old / nloc;
        if (old + 1u == (gen + 1u) * nloc) {
            __builtin_amdgcn_fence(__ATOMIC_RELEASE, "agent");
            asm volatile("s_waitcnt vmcnt(0)" ::: "memory");
            const unsigned og = xb_add(&bar[XB_TOP], 1u);
            const unsigned tg = og / nx;
            if (og + 1u == (tg + 1u) * nx) xb_add(&bar[XB_TOPGEN], 1u);
            else XB_SPIN(xb_ld(&bar[XB_TOPGEN]) == tg, bar);
            __builtin_amdgcn_fence(__ATOMIC_ACQUIRE, "agent");
            xb_add(&bar[XB_XGEN(b.x)], 1u);
            asm volatile("s_waitcnt vmcnt(0)" ::: "memory");
        } else {
            XB_SPIN(xb_ld(&bar[XB_XGEN(b.x)]) == gen, bar);
            __builtin_amdgcn_fence(__ATOMIC_ACQUIRE, "agent");
            asm volatile("s_waitcnt vmcnt(0)" ::: "memory");
        }
    }
    __syncthreads();
}


#ifndef PG8_SP2
#define PG8_SP2 true
#endif
#ifndef PG8_ALIGN
#define PG8_ALIGN true
#endif
constexpr int D = 1024, NB = 8, SEQ = 4096, T = NB * SEQ, NL = 4;
constexpr int NIN = 8704, NE = 32, FF = 1024;
constexpr int RMAX = 139264;
constexpr float LN_EPS = 1e-5f, DN_ALPHA = 1.681792830507429f;
constexpr float QSCALE = 0.18033688011112042f;
constexpr float LOG2E = 1.4426950408889634f;

constexpr size_t MiB = 1u << 20;
constexpr size_t WS_CTL = 0, CTL_ZERO_BYTES = 1 * MiB;
constexpr size_t WS_MOD = 1 * MiB;
constexpr size_t WS_ROPE = 2 * MiB;
constexpr size_t WS_WSP = 3 * MiB;
constexpr size_t WS_WRT = 4 * MiB;
constexpr size_t WS_TOKINFO = 5 * MiB;
constexpr size_t WS_TOKW = 5 * MiB + 512 * 1024;
constexpr size_t WS_ROWTOK = 6 * MiB;
constexpr size_t WS_ROWW = 7 * MiB;
constexpr size_t WS_LSE = 8 * MiB;
constexpr size_t WS_TOKROW = 14 * MiB;
constexpr size_t WS_STAT = 13 * MiB;
constexpr size_t WS_WGCNT = 12 * MiB;
constexpr size_t WS_WIN = 16 * MiB;
constexpr size_t WS_WBA = 84 * MiB;
constexpr size_t WS_WBB = 92 * MiB;
constexpr size_t WS_WOUT = 96 * MiB;
constexpr size_t WS_WUP = 104 * MiB;
constexpr size_t WS_WDN = 616 * MiB;
constexpr size_t WS_H = 872 * MiB;
constexpr size_t WS_X1 = 936 * MiB;
constexpr size_t WS_X2 = 1064 * MiB;
constexpr size_t WS_YPRE = 1192 * MiB;
constexpr size_t WS_U = 1320 * MiB, WS_V = 1384 * MiB;
constexpr size_t WS_Q = 1448 * MiB, WS_K = 1544 * MiB, WS_VV = 1640 * MiB;
constexpr size_t WS_G = 1736 * MiB;
constexpr size_t WS_OG = 1864 * MiB;
constexpr size_t WS_TT = 1960 * MiB;
constexpr size_t WS_OB = 2024 * MiB;
constexpr size_t WS_YA = 2056 * MiB;
constexpr size_t WS_MG = 2120 * MiB;
constexpr size_t WS_XG = 2184 * MiB;
constexpr size_t WS_ACT = 2456 * MiB;
constexpr size_t WS_YK = 2728 * MiB;
constexpr size_t WS_END = 2984 * MiB;
constexpr int CW_BAR = 4096;
constexpr int CW_CNT = 16384;

constexpr int RING_BYTES = 131072;
constexpr int XOFF = RING_BYTES;
constexpr int X_MISC = XOFF;
constexpr int X_SELE = XOFF + 256;
constexpr int X_SELR = XOFF + 2304;
constexpr int X_CNTL = XOFF + 4352;
constexpr int X_BASE = XOFF + 4480;
constexpr int X_TILEE = XOFF + 4608;
constexpr int X_CNTS = XOFF + 5632;
constexpr int X_OFFS = XOFF + 5760;
constexpr int LDS_BYTES = 147456;

#define GAS __attribute__((address_space(1)))
typedef unsigned short bf16;
typedef unsigned v4u __attribute__((ext_vector_type(4)));
typedef unsigned v2u __attribute__((ext_vector_type(2)));
typedef float f32x4 __attribute__((ext_vector_type(4)));
typedef short bf16x8 __attribute__((ext_vector_type(8)));
typedef short s16x4 __attribute__((ext_vector_type(4)));
#define RLX_AGENT __ATOMIC_RELAXED, __HIP_MEMORY_SCOPE_AGENT
#define LDS_WAIT() asm volatile("s_waitcnt lgkmcnt(0)" ::: "memory")
#define VM_WAIT() asm volatile("s_waitcnt vmcnt(0)" ::: "memory")

typedef __bf16 bf16x2_t __attribute__((ext_vector_type(2))); typedef float f32x2_t __attribute__((ext_vector_type(2)));
__device__ __forceinline__ unsigned pk2(float lo, float hi) { return __builtin_bit_cast(unsigned, __builtin_convertvector((f32x2_t){lo, hi}, bf16x2_t)); }
__device__ __forceinline__ float bflo(unsigned w) { return __uint_as_float(w << 16); }
__device__ __forceinline__ float bfhi(unsigned w) { return __uint_as_float(w & 0xffff0000u); }
__device__ __forceinline__ float fexp2(float x) { return __builtin_amdgcn_exp2f(x); }
__device__ __forceinline__ float frcp(float x) { return __builtin_amdgcn_rcpf(x); }
__device__ __forceinline__ float gelu_tanh(float x) { const float u = x + 0.044715f * x * x * x; return x * frcp(1.0f + fexp2(-2.302208198144325f * u)); }
__device__ __forceinline__ float sigmoidf_(float x) { return frcp(1.0f + fexp2(-LOG2E * x)); }
__device__ __forceinline__ float wave_sum(float v) {
#pragma unroll
    for (int o = 1; o < 64; o <<= 1) v += __shfl_xor(v, o);
    return v;
}
__device__ __forceinline__ float wave_max(float v) {
#pragma unroll
    for (int o = 1; o < 64; o <<= 1) v = fmaxf(v, __shfl_xor(v, o));
    return v;
}
__device__ __forceinline__ s16x4 tr16(const LAS unsigned char* p) { return __builtin_bit_cast(s16x4, __builtin_amdgcn_ds_read_tr16_b64_v4i16((LAS s16x4*)p)); }
__device__ __forceinline__ bf16x8 cat8(s16x4 lo, s16x4 hi) { return (bf16x8){lo[0], lo[1], lo[2], lo[3], hi[0], hi[1], hi[2], hi[3]}; }
__device__ __forceinline__ f32x4 mfma16(bf16x8 a, bf16x8 b, f32x4 c) { return __builtin_amdgcn_mfma_f32_16x16x32_bf16(a, b, c, 0, 0, 0); }

struct Frame {
    LAS unsigned char* lds;
    int tid, lane, wave, G, vcu, bx;
    unsigned char* ws;
    const float* const* in;
    float* out;
};
enum { I_X = 0, I_C, I_WADA, I_BADA, I_WIN, I_SPW, I_SPB, I_WBA, I_WBB, I_WOUT, I_LN1G, I_LN1B, I_WR, I_BR, I_WUP, I_BUP, I_WDN, I_BDN, I_LN2G, I_LN2B };
template <class Tp> __device__ __forceinline__ Tp* wsp(const Frame& F, size_t off) { return (Tp*)(F.ws + off); }

template <class P> __device__ __forceinline__ P launder(P p) { unsigned lo = (unsigned)(uintptr_t)p, hi = (unsigned)((uintptr_t)p >> 32); asm volatile("" : "+v"(lo), "+v"(hi));
    lo = (unsigned)__builtin_amdgcn_readfirstlane((int)lo); hi = (unsigned)__builtin_amdgcn_readfirstlane((int)hi); return (P)(((uintptr_t)hi << 32) | (uintptr_t)lo); }
struct EpiIn {
    static constexpr int MID_T = 0; static constexpr bool PERM = true, AFTER_DRAIN = false;
    bf16 *U, *V, *Q, *K, *VV, *Gt; const float* rope;
    __device__ __forceinline__ void operator()(const f32x4 (&acc)[2][2][4][2], const pg8::Unit& u, int wr, int wc, int fr, int fq) const {
        const int pn = u.pn; int type, ld, colt; bf16* base;
        if (pn < 4) { type = 0; base = U; ld = 1024; colt = pn * 256; }
        else if (pn < 8) { type = 0; base = V; ld = 1024; colt = (pn - 4) * 256; }
        else if (pn < 14) { type = 1; base = Q; ld = 1536; colt = (pn - 8) * 256; }
        else if (pn < 20) { type = 2; base = K; ld = 1536; colt = (pn - 14) * 256; }
        else if (pn < 26) { type = 3; base = VV; ld = 1536; colt = (pn - 20) * 256; }
        else { type = 4; base = Gt; ld = 2048; colt = (pn - 26) * 256; }
        const int row0 = u.pm * 256 + wr * 64 + fr, col0 = colt + wc * 32 + 8 * fq;
        if (type == 0) {
#pragma unroll
            for (int ai = 0; ai < 2; ++ai)
#pragma unroll
                for (int m = 0; m < 4; ++m) { bf16* rowp = base + (size_t)(row0 + ai * 128 + m * 16) * ld + col0;
#pragma unroll
                    for (int bj = 0; bj < 2; ++bj) { const f32x4 v0 = acc[ai][bj][m][0], v1 = acc[ai][bj][m][1]; v4u w;
                        w.x = pk2(gelu_tanh(v0[0]), gelu_tanh(v0[1])); w.y = pk2(gelu_tanh(v0[2]), gelu_tanh(v0[3]));
                        w.z = pk2(gelu_tanh(v1[0]), gelu_tanh(v1[1])); w.w = pk2(gelu_tanh(v1[2]), gelu_tanh(v1[3]));
                        __builtin_nontemporal_store(w, (v4u*)(rowp + bj * 128)); } }
        } else if (type == 4) {
#pragma unroll
            for (int ai = 0; ai < 2; ++ai)
#pragma unroll
                for (int m = 0; m < 4; ++m) { bf16* rowp = base + (size_t)(row0 + ai * 128 + m * 16) * ld + col0;
#pragma unroll
                    for (int bj = 0; bj < 2; ++bj) { const f32x4 v0 = acc[ai][bj][m][0], v1 = acc[ai][bj][m][1]; v4u w;
                        w.x = pk2(sigmoidf_(v0[0]), sigmoidf_(v0[1])); w.y = pk2(sigmoidf_(v0[2]), sigmoidf_(v0[3]));
                        w.z = pk2(sigmoidf_(v1[0]), sigmoidf_(v1[1])); w.w = pk2(sigmoidf_(v1[2]), sigmoidf_(v1[3]));
                        __builtin_nontemporal_store(w, (v4u*)(rowp + bj * 128)); } }
        } else if (type == 3) {
#pragma unroll
            for (int ai = 0; ai < 2; ++ai)
#pragma unroll
                for (int m = 0; m < 4; ++m) { bf16* rowp = base + (size_t)(row0 + ai * 128 + m * 16) * ld + col0;
#pragma unroll
                    for (int bj = 0; bj < 2; ++bj) { const f32x4 v0 = acc[ai][bj][m][0], v1 = acc[ai][bj][m][1]; v4u w;
                        w.x = pk2(v0[0], v0[1]); w.y = pk2(v0[2], v0[3]); w.z = pk2(v1[0], v1[1]); w.w = pk2(v1[2], v1[3]);
                        __builtin_nontemporal_store(w, (v4u*)(rowp + bj * 128)); } }
        } else {
            const float sc = (type == 1) ? QSCALE : 1.0f;
            const bool ropew = (wc & 1) == 0;
#pragma unroll
            for (int ai = 0; ai < 2; ++ai)
#pragma unroll
                for (int m = 0; m < 4; ++m) { const int row = row0 + ai * 128 + m * 16; bf16* rowp = base + (size_t)row * ld + col0;
                    float cs[8], sn[8];
                    if (ropew) { const f32x4* rp = (const f32x4*)(rope + (size_t)(row & (SEQ - 1)) * 16); const f32x4 c0 = rp[0], c1 = rp[1], s0 = rp[2], s1 = rp[3];
#pragma unroll
                        for (int e = 0; e < 4; ++e) { cs[e] = c0[e]; cs[4 + e] = c1[e]; sn[e] = s0[e]; sn[4 + e] = s1[e]; } }
#pragma unroll
                    for (int bj = 0; bj < 2; ++bj) { f32x4 v0 = acc[ai][bj][m][0], v1 = acc[ai][bj][m][1];
                        if (ropew) {
#pragma unroll
                            for (int e = 0; e < 8; ++e) { const float x = (e < 4) ? v0[e & 3] : v1[e & 3]; const float p = __shfl_xor(x, 16);
                                float y = x;
                                if (fq == 0) y = x * cs[e] - p * sn[e];
                                if (fq == 1) y = x * cs[e] + p * sn[e];
                                if (e < 4) v0[e & 3] = y; else v1[e & 3] = y; } }
                        v4u w; w.x = pk2(v0[0] * sc, v0[1] * sc); w.y = pk2(v0[2] * sc, v0[3] * sc); w.z = pk2(v1[0] * sc, v1[1] * sc); w.w = pk2(v1[2] * sc, v1[3] * sc);
                        __builtin_nontemporal_store(w, (v4u*)(rowp + bj * 128)); } }
        }
    }
};
struct EpiProbe {
    static constexpr int MID_T = 0; static constexpr bool PERM = true, AFTER_DRAIN = false;
    bf16* O; int ld; int on;
    __device__ __forceinline__ void operator()(const f32x4 (&acc)[2][2][4][2], const pg8::Unit& u, int wr, int wc, int fr, int fq) const {
        if (!on) return;
        const int row0 = u.pm * 256 + wr * 64 + fr, col0 = ((on == 3) ? u.pn : (u.pn & 3)) * 256 + wc * 32 + 8 * fq;
#pragma unroll
        for (int ai = 0; ai < 2; ++ai)
#pragma unroll
            for (int m = 0; m < 4; ++m) { bf16* rowp = O + (size_t)(row0 + ai * 128 + m * 16) * ld + col0;
#pragma unroll
                for (int bj = 0; bj < 2; ++bj) { const f32x4 v0 = acc[ai][bj][m][0], v1 = acc[ai][bj][m][1]; v4u w;
                    w.x = pk2(v0[0], v0[1]); w.y = pk2(v0[2], v0[3]); w.z = pk2(v1[0], v1[1]); w.w = pk2(v1[2], v1[3]);
                    *(v4u*)(rowp + bj * 128) = w; } }
    }
};
struct EpiYA {
    static constexpr int MID_T = 0; static constexpr bool PERM = true, AFTER_DRAIN = false;
    const bf16* Gt; bf16* YA;
    __device__ __forceinline__ void operator()(const f32x4 (&acc)[2][2][4][2], const pg8::Unit& u, int wr, int wc, int fr, int fq) const {
        const int row0 = u.pm * 256 + wr * 64 + fr, col0 = u.pn * 256 + wc * 32 + 8 * fq;
#pragma unroll
        for (int ai = 0; ai < 2; ++ai)
#pragma unroll
            for (int m = 0; m < 4; ++m) { const size_t row = (size_t)(row0 + ai * 128 + m * 16);
#pragma unroll
                for (int bj = 0; bj < 2; ++bj) { const f32x4 v0 = acc[ai][bj][m][0], v1 = acc[ai][bj][m][1];
                    const v4u g = *(const v4u*)(Gt + row * 2048 + col0 + bj * 128); v4u w;
                    w.x = pk2(v0[0] * bflo(g.x), v0[1] * bfhi(g.x)); w.y = pk2(v0[2] * bflo(g.y), v0[3] * bfhi(g.y));
                    w.z = pk2(v1[0] * bflo(g.z), v1[1] * bfhi(g.z)); w.w = pk2(v1[2] * bflo(g.w), v1[3] * bfhi(g.w));
                    *(v4u*)(YA + row * 1024 + col0 + bj * 128) = w; } }
    }
};
struct EpiMg {
    static constexpr int MID_T = 0; static constexpr bool PERM = true, AFTER_DRAIN = false;
    const bf16* Gt; const bf16* YA; bf16* MG;
    __device__ __forceinline__ void operator()(const f32x4 (&acc)[2][2][4][2], const pg8::Unit& u, int wr, int wc, int fr, int fq) const {
        const int row0 = u.pm * 256 + wr * 64 + fr, col0 = u.pn * 256 + wc * 32 + 8 * fq;
#pragma unroll
        for (int ai = 0; ai < 2; ++ai)
#pragma unroll
            for (int m = 0; m < 4; ++m) { const size_t row = (size_t)(row0 + ai * 128 + m * 16);
#pragma unroll
                for (int bj = 0; bj < 2; ++bj) { const f32x4 v0 = acc[ai][bj][m][0], v1 = acc[ai][bj][m][1];
                    const v4u g = *(const v4u*)(Gt + row * 2048 + 1024 + col0 + bj * 128); const v4u y = *(const v4u*)(YA + row * 1024 + col0 + bj * 128); v4u w;
                    w.x = pk2(bflo(y.x) + v0[0] * bflo(g.x), bfhi(y.x) + v0[1] * bfhi(g.x)); w.y = pk2(bflo(y.y) + v0[2] * bflo(g.y), bfhi(y.y) + v0[3] * bfhi(g.y));
                    w.z = pk2(bflo(y.z) + v1[0] * bflo(g.z), bfhi(y.z) + v1[1] * bfhi(g.z)); w.w = pk2(bflo(y.w) + v1[2] * bflo(g.w), bfhi(y.w) + v1[3] * bfhi(g.w));
                    *(v4u*)(MG + row * 1024 + col0 + bj * 128) = w; } }
    }
};
struct EpiMg2 {
    static constexpr int MID_T = 16; static constexpr bool PERM = true, AFTER_DRAIN = false;
    const bf16* Gt; bf16* MG;
    __device__ __forceinline__ void mid(f32x4 (&acc)[2][2][4][2], const pg8::Unit& u, int wr, int wc, int fr, int fq) const {
        int row0 = u.pm * 256 + wr * 64 + fr; const int col0 = u.pn * 256 + wc * 32 + 8 * fq;
        asm volatile("" : "+v"(row0));
#pragma unroll
        for (int ai = 0; ai < 2; ++ai)
#pragma unroll
            for (int m = 0; m < 4; ++m) { const size_t row = (size_t)(row0 + ai * 128 + m * 16);
#pragma unroll
                for (int bj = 0; bj < 2; ++bj) { const v4u g0 = *(const v4u*)(Gt + row * 2048 + col0 + bj * 128), g1 = *(const v4u*)(Gt + row * 2048 + 1024 + col0 + bj * 128);
                    const unsigned a0[4] = {g0.x, g0.y, g0.z, g0.w}, a1[4] = {g1.x, g1.y, g1.z, g1.w};
#pragma unroll
                    for (int q = 0; q < 4; ++q) { const float r0 = bflo(a0[q]) * frcp(fmaxf(bflo(a1[q]), 1e-20f)), r1 = bfhi(a0[q]) * frcp(fmaxf(bfhi(a1[q]), 1e-20f));
                        acc[ai][bj][m][q >> 1][(q & 1) * 2] *= r0; acc[ai][bj][m][q >> 1][(q & 1) * 2 + 1] *= r1; } }
                if (m == 3) asm volatile("" ::: "memory"); }
    }
    __device__ __forceinline__ void operator()(const f32x4 (&acc)[2][2][4][2], const pg8::Unit& u, int wr, int wc, int fr, int fq) const {
        const int row0 = u.pm * 256 + wr * 64 + fr, col0 = u.pn * 256 + wc * 32 + 8 * fq;
#pragma unroll
        for (int ai = 0; ai < 2; ++ai)
#pragma unroll
            for (int m = 0; m < 4; ++m) { const size_t row = (size_t)(row0 + ai * 128 + m * 16);
#pragma unroll
                for (int bj = 0; bj < 2; ++bj) { const f32x4 v0 = acc[ai][bj][m][0], v1 = acc[ai][bj][m][1];
                    const v4u g = *(const v4u*)(Gt + row * 2048 + 1024 + col0 + bj * 128); v4u w;
                    w.x = pk2(v0[0] * fmaxf(bflo(g.x), 1e-20f), v0[1] * fmaxf(bfhi(g.x), 1e-20f)); w.y = pk2(v0[2] * fmaxf(bflo(g.y), 1e-20f), v0[3] * fmaxf(bfhi(g.y), 1e-20f));
                    w.z = pk2(v1[0] * fmaxf(bflo(g.z), 1e-20f), v1[1] * fmaxf(bfhi(g.z), 1e-20f)); w.w = pk2(v1[2] * fmaxf(bflo(g.w), 1e-20f), v1[3] * fmaxf(bfhi(g.w), 1e-20f));
                    *(v4u*)(MG + row * 1024 + col0 + bj * 128) = w; } }
    }
};
template <bool XF32> struct EpiOut {
    static constexpr int MID_T = 0; static constexpr bool PERM = true, AFTER_DRAIN = false;
    const void* xres; const float* modl  ; bf16* YPRE;
    __device__ __forceinline__ void operator()(const f32x4 (&acc)[2][2][4][2], const pg8::Unit& u, int wr, int wc, int fr, int fq) const {
        const int row0 = u.pm * 256 + wr * 64 + fr, col0 = u.pn * 256 + wc * 32 + 8 * fq; const int b = (u.pm * 256) >> 12;
        f32x4 gg[2][2];
#pragma unroll
        for (int bj = 0; bj < 2; ++bj)
#pragma unroll
            for (int n = 0; n < 2; ++n) gg[bj][n] = *(const f32x4*)(modl + (size_t)b * 6144 + 2048 + col0 + bj * 128 + 4 * n) + 1.0f;
#pragma unroll
        for (int ai = 0; ai < 2; ++ai)
#pragma unroll
            for (int m = 0; m < 4; ++m) { const size_t off = (size_t)(row0 + ai * 128 + m * 16) * 1024 + col0;
#pragma unroll
                for (int bj = 0; bj < 2; ++bj) { f32x4 x0, x1;
                    if (XF32) { x0 = *(const f32x4*)((const float*)xres + off + bj * 128); x1 = *(const f32x4*)((const float*)xres + off + bj * 128 + 4); }
                    else { const v4u xr = *(const v4u*)((const bf16*)xres + off + bj * 128); x0 = (f32x4){bflo(xr.x), bfhi(xr.x), bflo(xr.y), bfhi(xr.y)}; x1 = (f32x4){bflo(xr.z), bfhi(xr.z), bflo(xr.w), bfhi(xr.w)}; }
                    const f32x4 o0 = x0 * DN_ALPHA + gg[bj][0] * acc[ai][bj][m][0], o1 = x1 * DN_ALPHA + gg[bj][1] * acc[ai][bj][m][1];
                    v4u w; w.x = pk2(o0[0], o0[1]); w.y = pk2(o0[2], o0[3]); w.z = pk2(o1[0], o1[1]); w.w = pk2(o1[2], o1[3]);
                    *(v4u*)(YPRE + off + bj * 128) = w; }
                if (m == 3) asm volatile("" ::: "memory"); }
    }
};
struct EpiUp {
    static constexpr int MID_T = 0; static constexpr bool PERM = true, AFTER_DRAIN = false;
    const float* bup  ; bf16* ACT;
    __device__ __forceinline__ void operator()(const f32x4 (&acc)[2][2][4][2], const pg8::Unit& u, int wr, int wc, int fr, int fq) const {
        const int e = u.pn >> 3, pnl = u.pn & 7; const int row0 = u.pm * 256 + wr * 64 + fr, ac0 = pnl * 128 + wc * 32 + 8 * fq;
        const f32x4* bp = (const f32x4*)(bup + (size_t)e * 2048 + 2 * ac0); const f32x4 b0 = bp[0], b1 = bp[1], b2 = bp[2], b3 = bp[3];
        const float bg[8] = {b0[0], b0[2], b1[0], b1[2], b2[0], b2[2], b3[0], b3[2]}, bl[8] = {b0[1], b0[3], b1[1], b1[3], b2[1], b2[3], b3[1], b3[3]};
#pragma unroll
        for (int ai = 0; ai < 2; ++ai)
#pragma unroll
            for (int m = 0; m < 4; ++m) { float a[8];
#pragma unroll
                for (int j = 0; j < 8; ++j) { const float hg = acc[ai][0][m][j >> 2][j & 3] + bg[j], hl = acc[ai][1][m][j >> 2][j & 3] + bl[j];
                    const float glu = fminf(hg, 7.0f), lin = fminf(fmaxf(hl, -7.0f), 7.0f);
                    a[j] = glu * frcp(1.0f + fexp2(-2.4554669595930156f * glu)) * (lin + 1.0f); }
                v4u w; w.x = pk2(a[0], a[1]); w.y = pk2(a[2], a[3]); w.z = pk2(a[4], a[5]); w.w = pk2(a[6], a[7]);
                *(v4u*)(ACT + (size_t)(row0 + ai * 128 + m * 16) * 1024 + ac0) = w; }
    }
};
struct EpiDn {
    static constexpr int MID_T = 0; static constexpr bool PERM = true, AFTER_DRAIN = false;
    const float* bdn  ; bf16* YKS;
    __device__ __forceinline__ void operator()(const f32x4 (&acc)[2][2][4][2], const pg8::Unit& u, int wr, int wc, int fr, int fq) const {
        const int e = u.pn >> 2, pnl = u.pn & 3; const int row0 = u.pm * 256 + wr * 64 + fr, col0 = pnl * 256 + wc * 32 + 8 * fq;
        f32x4 bv[2][2];
#pragma unroll
        for (int bj = 0; bj < 2; ++bj)
#pragma unroll
            for (int n = 0; n < 2; ++n) bv[bj][n] = *(const f32x4*)(bdn + (size_t)e * 1024 + col0 + bj * 128 + 4 * n);
#pragma unroll
        for (int ai = 0; ai < 2; ++ai)
#pragma unroll
            for (int m = 0; m < 4; ++m) { bf16* op = YKS + (size_t)(row0 + ai * 128 + m * 16) * 1024 + col0;
#pragma unroll
                for (int bj = 0; bj < 2; ++bj) { const f32x4 v0 = acc[ai][bj][m][0] + bv[bj][0], v1 = acc[ai][bj][m][1] + bv[bj][1]; v4u w;
                    w.x = pk2(v0[0], v0[1]); w.y = pk2(v0[2], v0[3]); w.z = pk2(v1[0], v1[1]); w.w = pk2(v1[2], v1[3]);
                    *(v4u*)(op + bj * 128) = w; } }
    }
};
struct MoeOrder {
    static constexpr bool GATHER = false; __device__ __forceinline__ int arow(int, int r) const { return r; }
    int nM, nN, nwg, G, c, rev; const LAS unsigned char* tile_e;
    __device__ void init(int RT, int NN, int G_, int c_, const LAS unsigned char* te, int rev_ = 0) { nM = RT; nN = NN; nwg = RT * NN; G = G_; c = c_; tile_e = te; rev = rev_; }
    __device__ bool next(int i, pg8::Unit& u) const {
        const long L = (long)i * G + c; if (L >= nwg) return false;
        int wgid = (int)L; { const int q = nwg / pg8::NXCD, r = nwg % pg8::NXCD, xcd = wgid % pg8::NXCD, off = wgid / pg8::NXCD; wgid = (xcd < r ? xcd * (q + 1) : r * (q + 1) + (xcd - r) * q) + off; }
        const int nig = pg8::WGM * nN, gid = wgid / nig, fm = gid * pg8::WGM, gsz = (nM - fm) < pg8::WGM ? (nM - fm) : pg8::WGM;
        int pm = fm + ((wgid % nig) % gsz); const int pnl = (wgid % nig) / gsz; if (rev) pm = nM - 1 - pm;
        u.pm = pm; u.pn = (int)tile_e[pm] * nN + pnl; return true;
    }
    __device__ __forceinline__ void a_ready(const pg8::Unit&) const {}
    __device__ __forceinline__ void done(const pg8::Unit&) const {}
};

#ifndef STAG_N
#define STAG_N 1
#endif
#ifndef STAG_US
#define STAG_US 24
#endif
__device__ __forceinline__ void stagger(int slot, int us) {
    if (STAG_N <= 1) return;
    const unsigned long long t0 = __builtin_amdgcn_s_memrealtime(); const unsigned long long ticks = (unsigned long long)(slot % STAG_N) * (unsigned)us * 100ull / STAG_N;
    while (__builtin_amdgcn_s_memrealtime() - t0 < ticks) __builtin_amdgcn_s_sleep(16);
}
struct MoeGatherOrder : MoeOrder {
    static constexpr bool GATHER = true; const LAS unsigned short* tokl;
    __device__ __forceinline__ int arow(int ord, int r) const { return (int)tokl[ord * 256 + (r & 255)]; }
};
constexpr int X_TOKL = XOFF + 6144, TOKL_UNITS = 20;
constexpr int TR_NR = 32, TR_WAVE_BYTES = 64 * 64 * 4;
struct TrItem { const float* src; bf16* dst; int ld, K, kind, k0, c0, koff; };
__device__ __forceinline__ void tr_load(const TrItem& t, int lane, f32x4 (&r)[TR_NR]) {
    const int kq = lane >> 4, cc = lane & 15;
#pragma unroll
    for (int i = 0; i < TR_NR; ++i) r[i] = *(const f32x4*)(t.src + (size_t)(t.k0 + 2 * (kq + 4 * (i >> 1)) + (i & 1)) * t.ld + t.c0 + 4 * cc);
}
__device__ __forceinline__ void tr_tile(int lane, LAS unsigned* scr, const f32x4 (&r)[TR_NR]) {
    const int kq = lane >> 4, cc = lane & 15;
#pragma unroll
    for (int i2 = 0; i2 < TR_NR / 2; ++i2) { LAS unsigned* p = scr + (4 * cc) * 64 + ((kq + 4 * i2) ^ (cc << 2));
#pragma unroll
        for (int e = 0; e < 4; ++e) p[e * 64] = pk2(r[2 * i2][e], r[2 * i2 + 1][e]); }
    LDS_WAIT(); asm volatile("" ::: "memory");
}
__device__ __forceinline__ void tr_store(const TrItem& t, int lane, const LAS unsigned* scr) {
    const int c = lane & 15;
    const int pbase = (t.kind == 0) ? t.c0 : (256 * (t.c0 >> 8) + ((t.c0 & 255) >> 1));
#pragma unroll
    for (int j = 0; j < 16; ++j) { const int n = (lane >> 4) + 4 * j; const v4u o = *(const LAS v4u*)(scr + n * 64 + ((c ^ j) << 2));
        const int drow = (t.kind == 0) ? (pbase + n) : (pbase + 128 * (n & 1) + (n >> 1));
        __builtin_nontemporal_store(o, (v4u*)(t.dst + (size_t)drow * t.K + t.koff + t.k0 + 8 * c)); }
    LDS_WAIT(); asm volatile("" ::: "memory");
}
__device__ __forceinline__ void sincos_d(double a, double& s, double& c) {
    const double k = rint(a * 0.63661977236758134308);
    const double y = fma(-k, 6.12323399573676603587e-17, fma(-k, 1.57079632679489655800, a));
    const double y2 = y * y;
    double sp = -7.6471637318198164759e-13; sp = fma(sp, y2, 1.6059043836821614599e-10); sp = fma(sp, y2, -2.5052108385441718775e-8); sp = fma(sp, y2, 2.7557319223985890653e-6);
    sp = fma(sp, y2, -1.9841269841269841270e-4); sp = fma(sp, y2, 8.3333333333333333333e-3); sp = fma(sp, y2, -1.6666666666666666667e-1); const double sy = fma(sp * y2, y, y);
    double cp = 4.7794773323873852974e-14; cp = fma(cp, y2, -1.1470745597729724714e-11); cp = fma(cp, y2, 2.0876756987868098979e-9); cp = fma(cp, y2, -2.7557319223985890653e-7);
    cp = fma(cp, y2, 2.4801587301587301587e-5); cp = fma(cp, y2, -1.3888888888888888889e-3); cp = fma(cp, y2, 4.1666666666666666667e-2); cp = fma(cp, y2, -0.5); const double cy = fma(cp, y2, 1.0);
    const int q = ((int)k) & 3;
    s = (q == 0) ? sy : (q == 1) ? cy : (q == 2) ? -sy : -cy;
    c = (q == 0) ? cy : (q == 1) ? -sy : (q == 2) ? -cy : sy;
}
__device__ __forceinline__ void phase_pro_a(Frame& F) {
    LAS unsigned* scr = (LAS unsigned*)(F.lds + F.wave * TR_WAVE_BYTES);
    const int gw = F.vcu * 8 + F.wave, NGW = F.G * 8;
    constexpr int I_IN = 8 * 136, I_SQ = 8 * 16, I_BB = 4 * 16, I_UP = 8 * 32;
    constexpr int S0 = NL * I_IN, S1 = S0 + NL * I_SQ, S2 = S1 + NL * I_BB, S3 = S2 + NL * I_SQ, S4 = S3 + NL * NE * I_SQ, S5 = S4 + NL * NE * I_UP;
    auto decode = [&](int it) -> TrItem { TrItem t; t.koff = 0;
        if (it < S0) { const int l = it / I_IN, r = it % I_IN; t.src = F.in[I_WIN] + (size_t)l * D * NIN; t.dst = wsp<bf16>(F, WS_WIN) + (size_t)l * NIN * D; t.ld = NIN; t.K = D; t.kind = 0; t.k0 = 128 * (r / 136); t.c0 = 64 * (r % 136); }
        else if (it < S1) { const int q = it - S0, l = q / I_SQ, r = q % I_SQ; t.src = F.in[I_WBA] + (size_t)l * D * D; t.dst = wsp<bf16>(F, WS_WBA) + (size_t)l * D * 1536; t.ld = D; t.K = 1536; t.kind = 0; t.k0 = 128 * (r / 16); t.c0 = 64 * (r % 16); }
        else if (it < S2) { const int q = it - S1, l = q / I_BB, r = q % I_BB; t.src = F.in[I_WBB] + (size_t)l * 512 * D; t.dst = wsp<bf16>(F, WS_WBA) + (size_t)l * D * 1536; t.ld = D; t.K = 1536; t.koff = 1024; t.kind = 0; t.k0 = 128 * (r / 16); t.c0 = 64 * (r % 16); }
        else if (it < S3) { const int q = it - S2, l = q / I_SQ, r = q % I_SQ; t.src = F.in[I_WOUT] + (size_t)l * D * D; t.dst = wsp<bf16>(F, WS_WOUT) + (size_t)l * D * D; t.ld = D; t.K = D; t.kind = 0; t.k0 = 128 * (r / 16); t.c0 = 64 * (r % 16); }
        else if (it < S4) { const int q = it - S3, le = q / I_SQ, r = q % I_SQ; t.src = F.in[I_WDN] + (size_t)le * FF * D; t.dst = wsp<bf16>(F, WS_WDN) + (size_t)le * D * FF; t.ld = D; t.K = FF; t.kind = 0; t.k0 = 128 * (r / 16); t.c0 = 64 * (r % 16); }
        else { const int q = it - S4, le = q / I_UP, r = q % I_UP; t.src = F.in[I_WUP] + (size_t)le * D * 2048; t.dst = wsp<bf16>(F, WS_WUP) + (size_t)le * 2048 * D; t.ld = 2048; t.K = D; t.kind = 1; t.k0 = 128 * (r / 32); t.c0 = 64 * (r % 32); }
        return t; };
    {
        f32x4 rn[TR_NR]; TrItem tn; int it = gw;
        if (it < S5) { tn = decode(it); tr_load(tn, F.lane, rn); }
#pragma unroll 1
        for (; it < S5; it += NGW) {
            const TrItem tc = tn;
            tr_tile(F.lane, scr, rn);
            if (it + NGW < S5) { tn = decode(it + NGW); tr_load(tn, F.lane, rn); }
            tr_store(tc, F.lane, scr);
        }
    }
    __syncthreads();
    {
        LAS float* red = (LAS float*)F.lds;
        const float* cv = F.in[I_C];
        for (int u = F.vcu; u < NL * 96; u += F.G) {
            const int l = u / 96, n0 = 64 * (u % 96);
            float a[8];
#pragma unroll
            for (int b = 0; b < 8; ++b) a[b] = 0.f;
            const float* wp = F.in[I_WADA] + (size_t)l * D * 6144 + (size_t)(F.wave * 128) * 6144 + n0 + F.lane;
#pragma unroll 4
            for (int kk = 0; kk < 128; ++kk) { const float w = wp[(size_t)kk * 6144]; const int k = F.wave * 128 + kk;
#pragma unroll
                for (int b = 0; b < 8; ++b) a[b] += cv[b * 1024 + k] * w; }
#pragma unroll
            for (int b = 0; b < 8; ++b) red[(F.wave * 8 + b) * 64 + F.lane] = a[b];
            __syncthreads();
            { const int b = F.tid >> 6, ln = F.tid & 63; float s = F.in[I_BADA][l * 6144 + n0 + ln];
#pragma unroll
              for (int w = 0; w < 8; ++w) s += red[(w * 8 + b) * 64 + ln];
              wsp<float>(F, WS_MOD)[(size_t)(l * 8 + b) * 6144 + n0 + ln] = s; }
            __syncthreads();
        }
    }
    const int gt = F.vcu * 512 + F.tid, NT = F.G * 512;
    for (int i = gt; i < SEQ * 8; i += NT) { const int pos = i >> 3, f = i & 7;
        const double inv = (f == 0) ? 1.0 : (f == 1) ? 0.19392274474868576 : (f == 2) ? 0.03760603093086393 : (f == 3) ? 0.007292664737217109 : (f == 4) ? 0.001414213562373095 : (f == 5) ? 0.0002742481756762073 : (f == 6) ? 5.318295896944988e-05 : 1.031338537721246e-05;
        double s, c; sincos_d((double)pos * inv, s, c);
        float* rp = wsp<float>(F, WS_ROPE) + (size_t)pos * 16; rp[f] = (float)c; rp[8 + f] = (float)s; }
    for (int i = gt; i < NL * 4 * 128 * 128; i += NT) { const int j = i & 127, ii = (i >> 7) & 127; const float w = F.in[I_SPW][i];
        wsp<bf16>(F, WS_WSP)[i] = (bf16)(pk2((j <= ii) ? w : 0.f, 0.f) & 0xffffu); }
    for (int i = gt; i < NL * NE * D; i += NT) { const int k = i & 1023, e = (i >> 10) & 31, l = i >> 15; const float w = F.in[I_WR][((size_t)l * D + k) * NE + e];
        const unsigned hi = pk2(w, 0.f) & 0xffffu; const float lo = w - __uint_as_float(hi << 16);
        wsp<bf16>(F, WS_WRT)[i] = (bf16)hi; wsp<bf16>(F, WS_WRT)[NL * NE * D + i] = (bf16)(pk2(lo, 0.f) & 0xffffu); }
}
__device__ __forceinline__ void phase_pro_b(Frame& F) {
    const int gw = F.vcu * 8 + F.wave, NGW = F.G * 8;
    const float* mod = wsp<float>(F, WS_MOD);
    for (int m = gw; m < T; m += NGW) { const int b = m >> 12; const float* mb = mod + (size_t)b * 6144;
        const f32x4* xr = (const f32x4*)(F.in[I_X] + (size_t)m * D) + F.lane; v2u* hp = (v2u*)(wsp<bf16>(F, WS_H) + (size_t)m * D) + F.lane;
#pragma unroll
        for (int j = 0; j < 4; ++j) { const f32x4 x = xr[64 * j]; const f32x4 sh = *((const f32x4*)mb + F.lane + 64 * j), sc = *((const f32x4*)(mb + 1024) + F.lane + 64 * j);
            const f32x4 h = x * (sc + 1.0f) + sh; v2u o; o.x = pk2(h[0], h[1]); o.y = pk2(h[2], h[3]); hp[64 * j] = o; } }
}

constexpr int AT_RS = 144;
constexpr int AT_ROWS = 400, AT_VOFF = AT_ROWS * AT_RS;
#define LDS_BARRIER() do { asm volatile("s_waitcnt lgkmcnt(0)" ::: "memory"); __builtin_amdgcn_s_barrier(); asm volatile("" ::: "memory"); } while (0)
struct AtUnit { int g, b, h, r, n, d; size_t hoff; };
__device__ __forceinline__ AtUnit at_decode(int u) { AtUnit a; a.g = u >> 10; const int rem = u & 1023; a.b = rem >> 7; a.h = (rem >> 4) & 7; const int rn = rem & 15;
    const int dsh = 2 * a.g, nbs = 4 - dsh; a.d = 1 << dsh; a.r = rn >> nbs; a.n = 2 * (rn & ((1 << nbs) - 1)); a.hoff = (size_t)a.g * 512 + a.h * 64; return a; }
constexpr int AT_NU = 3 * 1024;
struct AtSlot { v4u k[6], v[6]; bf16x8 q0, q1, q2, q3; };
struct AtCtx { const bf16 *Qb, *Kb, *Vb; bf16* OG; float* LSE; LAS unsigned char *Ks, *Vs; int qi, g4, piece, jr; };
__device__ __forceinline__ void at_load(AtSlot& sl, int uu, const AtCtx& C, const Frame& F) {
    const AtUnit a_ = at_decode(uu);
#pragma unroll
    for (int ps = 0; ps < 6; ++ps) { const int lp = 128 * (a_.n - 1) + ps * 64 + C.jr; sl.k[ps] = (v4u){0u, 0u, 0u, 0u}; sl.v[ps] = sl.k[ps];
        if (lp >= 0) { const size_t off = ((size_t)a_.b * SEQ + (size_t)lp * a_.d + a_.r) * 1536 + a_.hoff + C.piece * 8; sl.k[ps] = *(const v4u*)(C.Kb + off); sl.v[ps] = *(const v4u*)(C.Vb + off); } }
    const size_t qrow_ = (size_t)a_.b * SEQ + (size_t)(128 * a_.n + 16 * F.wave + C.qi) * a_.d + a_.r; const bf16* qp = C.Qb + qrow_ * 1536 + a_.hoff + 8 * C.g4;
    sl.q0 = *(const bf16x8*)qp; sl.q1 = *(const bf16x8*)(qp + 32);
    const bf16* qp2 = qp + (size_t)128 * a_.d * 1536; sl.q2 = *(const bf16x8*)qp2; sl.q3 = *(const bf16x8*)(qp2 + 32);
}
__device__ __forceinline__ void at_unit(AtSlot& sl, int u, int unext, const AtCtx& C, const Frame& F) {
    bf16* OG = C.OG; float* LSE = C.LSE; LAS unsigned char* Ks = C.Ks; LAS unsigned char* Vs = C.Vs; const int qi = C.qi, g4 = C.g4;
    const AtUnit au = at_decode(u); const int g = au.g, b = au.b, h = au.h, r = au.r, n = au.n, d = au.d;
#pragma unroll
    for (int ps = 0; ps < 6; ++ps) { const int j = ps * 64 + C.jr; *(LAS v4u*)(Ks + j * AT_RS + C.piece * 16) = sl.k[ps]; *(LAS v4u*)(Vs + j * AT_RS + C.piece * 16) = sl.v[ps]; }
    const bf16x8 sl_q0 = sl.q0, sl_q1 = sl.q1, sl_q2 = sl.q2, sl_q3 = sl.q3;
    LDS_BARRIER();
    if (unext < AT_NU) at_load(sl, unext, C, F);
#pragma unroll
    for (int tq = 0; tq < 2; ++tq)
        {
            const int iq = 128 * tq + 16 * F.wave + qi; const int rb = 128 * tq + 16 * F.wave; const bf16x8 qf0 = tq ? sl_q2 : sl_q0, qf1 = tq ? sl_q3 : sl_q1; const size_t qrow = (size_t)b * SEQ + (size_t)(128 * n + iq) * d + r;
            f32x4 s[10]; float mx = -1e30f; const int dq = qi - 4 * g4; const bool first = (n == 0) && (tq == 0);
#pragma unroll
            for (int st = 0; st < 9; ++st) {
                const LAS unsigned char* kp = Ks + (rb + 16 * st + qi) * AT_RS + g4 * 16;
                const bf16x8 k0 = *(const LAS bf16x8*)kp, k1 = *(const LAS bf16x8*)(kp + 64);
                f32x4 a = (f32x4){0.f, 0.f, 0.f, 0.f};
                a = mfma16(k0, qf0, a); a = mfma16(k1, qf1, a);
                if (st == 0) {
#pragma unroll
                    for (int i = 0; i < 4; ++i) a[i] = (i >= dq) ? a[i] : -1e30f; }
                if (st == 8) {
#pragma unroll
                    for (int i = 0; i < 4; ++i) a[i] = (i <= dq) ? a[i] : -1e30f; }
                if (first) {
#pragma unroll
                    for (int i = 0; i < 4; ++i) a[i] = (rb + 16 * st + 4 * g4 + i >= 128) ? a[i] : -1e30f; }
#pragma unroll
                for (int i = 0; i < 4; ++i) mx = fmaxf(mx, a[i]);
                s[st] = a;
            }
            mx = fmaxf(mx, __shfl_xor(mx, 16)); mx = fmaxf(mx, __shfl_xor(mx, 32));
            float sum = 0.f;
#pragma unroll
            for (int st = 0; st < 9; ++st)
#pragma unroll
                for (int i = 0; i < 4; ++i) { const float p = fexp2(s[st][i] - mx); s[st][i] = p; sum += p; }
            s[9] = (f32x4){0.f, 0.f, 0.f, 0.f};
            sum += __shfl_xor(sum, 16); sum += __shfl_xor(sum, 32);
            f32x4 o[4];
#pragma unroll
            for (int dt = 0; dt < 4; ++dt) o[dt] = (f32x4){0.f, 0.f, 0.f, 0.f};
#pragma unroll
            for (int c = 0; c < 5; ++c) {
                v4u pw; pw.x = pk2(s[2 * c][0], s[2 * c][1]); pw.y = pk2(s[2 * c][2], s[2 * c][3]); pw.z = pk2(s[2 * c + 1][0], s[2 * c + 1][1]); pw.w = pk2(s[2 * c + 1][2], s[2 * c + 1][3]);
                const bf16x8 pf = __builtin_bit_cast(bf16x8, pw);
                const LAS unsigned char* vp = Vs + (rb + 32 * c + 4 * g4 + (qi >> 2)) * AT_RS + 8 * (qi & 3);
#pragma unroll
                for (int dt = 0; dt < 4; ++dt) { const s16x4 lo = tr16(vp + 32 * dt), hi = tr16(vp + 32 * dt + 16 * AT_RS);
                    o[dt] = mfma16(cat8(lo, hi), pf, o[dt]); }
            }
            const float inv = 1.0f / sum;
            bf16* op = OG + ((size_t)g * T + qrow) * 512 + h * 64 + 4 * g4;
#pragma unroll
            for (int dt = 0; dt < 4; ++dt) { v2u w; w.x = pk2(o[dt][0] * inv, o[dt][1] * inv); w.y = pk2(o[dt][2] * inv, o[dt][3] * inv); *(v2u*)(op + 16 * dt) = w; }
            if (g4 == 0) LSE[((size_t)g * T + qrow) * 8 + h] = mx + __log2f(sum);
        }
    LDS_BARRIER();
}
__device__ __forceinline__ void phase_attn(Frame& F) {
    AtCtx C; C.Qb = wsp<bf16>(F, WS_Q); C.Kb = wsp<bf16>(F, WS_K); C.Vb = wsp<bf16>(F, WS_VV); C.OG = wsp<bf16>(F, WS_OG); C.LSE = wsp<float>(F, WS_LSE);
    C.Ks = F.lds; C.Vs = F.lds + AT_VOFF; C.qi = F.lane & 15; C.g4 = F.lane >> 4; C.piece = F.tid & 7; C.jr = F.tid >> 3;
    if (F.tid < 144) { *(LAS v4u*)(C.Ks + 384 * AT_RS + F.tid * 16) = (v4u){0u, 0u, 0u, 0u}; *(LAS v4u*)(C.Vs + 384 * AT_RS + F.tid * 16) = (v4u){0u, 0u, 0u, 0u}; }
    AtSlot sa; const int u0 = F.vcu, G = F.G;
    if (u0 < AT_NU) at_load(sa, u0, C, F);
#pragma unroll 1
    for (int u = u0; u < AT_NU; u += G) at_unit(sa, u, u + G, C, F);
}

constexpr int SG_WOFF = 69632, SG_WRS = 264;
constexpr int SG_RS = 528;
__device__ __forceinline__ void phase_sg(Frame& F, int l) {
    const bf16* Ub = wsp<bf16>(F, WS_U); const bf16* Vb = wsp<bf16>(F, WS_V); bf16* TT = wsp<bf16>(F, WS_TT);
    const bf16* OG = wsp<bf16>(F, WS_OG); const float* LSE = wsp<float>(F, WS_LSE); bf16* OB = wsp<bf16>(F, WS_OB);
    const bf16* Wsp = wsp<bf16>(F, WS_WSP); const float* spb = F.in[I_SPB];
    LAS unsigned char* Vn = F.lds;
    const int qi = F.lane & 15, g4 = F.lane >> 4;
    const int l32 = F.lane & 31;
    v4u vraw[8];
#define SG_LOAD(uu) do { const int gi_ = (uu) & 3, m0_ = ((uu) >> 2) * 128; \
        _Pragma("unroll") for (int ps = 0; ps < 8; ++ps) vraw[ps] = *(const v4u*)(Vb + (size_t)(m0_ + 16 * ps + 2 * F.wave + (F.lane >> 5)) * 1024 + gi_ * 256 + 8 * l32); } while (0)
    if (F.vcu < 1024) SG_LOAD(F.vcu);
    const bool wlds = (F.G & 3) == 0; LAS unsigned char* Wl = F.lds + SG_WOFF;
    if (wlds) { const bf16* wsrc = Wsp + (size_t)(l * 4 + (F.vcu & 3)) * 128 * 128;
        for (int i = F.tid; i < 128 * 16; i += 512) { const int row = i >> 4, ch = i & 15; const v4u wv = *(const v4u*)(wsrc + row * 128 + ch * 8);
            *(LAS v2u*)(Wl + row * SG_WRS + ch * 16) = (v2u){wv.x, wv.y}; *(LAS v2u*)(Wl + row * SG_WRS + ch * 16 + 8) = (v2u){wv.z, wv.w}; } }
    for (int u = F.vcu; u < 1024; u += F.G) {
        const int gi = u & 3, m0 = (u >> 2) * 128;
        float ml[4][3]; v4u mo[4][3]; const int sub = F.tid & 7;
#pragma unroll
        for (int ps = 0; ps < 4; ++ps) { const int p = (F.tid >> 3) + 64 * ps; const size_t tok = (size_t)m0 + (p >> 1); const int hd = 2 * gi + (p & 1); const size_t off = tok * 512 + hd * 64 + 8 * sub;
#pragma unroll
            for (int gq = 0; gq < 3; ++gq) { ml[ps][gq] = LSE[((size_t)gq * T + tok) * 8 + hd]; mo[ps][gq] = *(const v4u*)(OG + (size_t)gq * T * 512 + off); } }
        {
            float sm[8], mean[8], rs[8];
#pragma unroll
            for (int ps = 0; ps < 8; ++ps) { const v4u raw = vraw[ps]; sm[ps] = ((bflo(raw.x) + bfhi(raw.x)) + (bflo(raw.y) + bfhi(raw.y))) + ((bflo(raw.z) + bfhi(raw.z)) + (bflo(raw.w) + bfhi(raw.w))); }
#pragma unroll
            for (int o = 1; o < 32; o <<= 1) {
#pragma unroll
                for (int ps = 0; ps < 8; ++ps) sm[ps] += __shfl_xor(sm[ps], o); }
#pragma unroll
            for (int ps = 0; ps < 8; ++ps) { const v4u raw = vraw[ps]; mean[ps] = sm[ps] * (1.0f / 256.0f); float q = 0.f;
                const float x[8] = {bflo(raw.x), bfhi(raw.x), bflo(raw.y), bfhi(raw.y), bflo(raw.z), bfhi(raw.z), bflo(raw.w), bfhi(raw.w)};
#pragma unroll
                for (int e = 0; e < 8; ++e) { const float dx = x[e] - mean[ps]; q += dx * dx; }
                sm[ps] = q; }
#pragma unroll
            for (int o = 1; o < 32; o <<= 1) {
#pragma unroll
                for (int ps = 0; ps < 8; ++ps) sm[ps] += __shfl_xor(sm[ps], o); }
#pragma unroll
            for (int ps = 0; ps < 8; ++ps) { rs[ps] = 1.0f / sqrtf(sm[ps] * (1.0f / 256.0f) + LN_EPS); const v4u raw = vraw[ps]; const int j = 16 * ps + 2 * F.wave + (F.lane >> 5);
                const float x[8] = {bflo(raw.x), bfhi(raw.x), bflo(raw.y), bfhi(raw.y), bflo(raw.z), bfhi(raw.z), bflo(raw.w), bfhi(raw.w)};
                v4u w; w.x = pk2((x[0] - mean[ps]) * rs[ps], (x[1] - mean[ps]) * rs[ps]); w.y = pk2((x[2] - mean[ps]) * rs[ps], (x[3] - mean[ps]) * rs[ps]);
                w.z = pk2((x[4] - mean[ps]) * rs[ps], (x[5] - mean[ps]) * rs[ps]); w.w = pk2((x[6] - mean[ps]) * rs[ps], (x[7] - mean[ps]) * rs[ps]);
                *(LAS v4u*)(Vn + j * SG_RS + l32 * 16) = w; }
        }
        LDS_BARRIER();
        if (u + F.G < 1024) SG_LOAD(u + F.G);
        {
#pragma unroll
          for (int ps = 0; ps < 4; ++ps) { const int p = (F.tid >> 3) + 64 * ps; const size_t tok = (size_t)m0 + (p >> 1); const int hd = 2 * gi + (p & 1);
              const float l0 = ml[ps][0], l1 = ml[ps][1], l2 = ml[ps][2];
              const float mxx = fmaxf(l0, fmaxf(l1, l2)); float w0 = fexp2(l0 - mxx), w1 = fexp2(l1 - mxx), w2 = fexp2(l2 - mxx); const float inv = 1.0f / (w0 + w1 + w2); w0 *= inv; w1 *= inv; w2 *= inv;
              const size_t off = tok * 512 + hd * 64 + 8 * sub;
              const v4u a = mo[ps][0], bq = mo[ps][1], cq = mo[ps][2]; v4u w;
              w.x = pk2(w0 * bflo(a.x) + w1 * bflo(bq.x) + w2 * bflo(cq.x), w0 * bfhi(a.x) + w1 * bfhi(bq.x) + w2 * bfhi(cq.x));
              w.y = pk2(w0 * bflo(a.y) + w1 * bflo(bq.y) + w2 * bflo(cq.y), w0 * bfhi(a.y) + w1 * bfhi(bq.y) + w2 * bfhi(cq.y));
              w.z = pk2(w0 * bflo(a.z) + w1 * bflo(bq.z) + w2 * bflo(cq.z), w0 * bfhi(a.z) + w1 * bfhi(bq.z) + w2 * bfhi(cq.z));
              w.w = pk2(w0 * bflo(a.w) + w1 * bflo(bq.w) + w2 * bflo(cq.w), w0 * bfhi(a.w) + w1 * bfhi(bq.w) + w2 * bfhi(cq.w));
              *(v4u*)(TT + tok * 1536 + 1024 + hd * 64 + 8 * sub) = w; } }
        v2u uq[8][2]; float ubias[8];
#pragma unroll
        for (int it = 0; it < 8; ++it) { const int i = 16 * it + qi; ubias[it] = spb[(l * 4 + gi) * 128 + i]; const size_t rowo = (size_t)(m0 + i) * 1024 + gi * 256 + 32 * F.wave + 4 * g4;
            uq[it][0] = *(const v2u*)(Ub + rowo); uq[it][1] = *(const v2u*)(Ub + rowo + 16); }
        {
            f32x4 acc[2][8];
#pragma unroll
            for (int ct = 0; ct < 2; ++ct)
#pragma unroll
                for (int it = 0; it < 8; ++it) acc[ct][it] = (f32x4){0.f, 0.f, 0.f, 0.f};
            const bf16* wbase = Wsp + (size_t)(l * 4 + gi) * 128 * 128 + (size_t)qi * 128 + 4 * g4;
#pragma unroll
            for (int kc = 0; kc < 4; ++kc) {
                bf16x8 af[2];
#pragma unroll
                for (int ct = 0; ct < 2; ++ct) { const LAS unsigned char* p = Vn + (32 * kc + 4 * g4 + (qi >> 2)) * SG_RS + (32 * F.wave + 16 * ct + 4 * (qi & 3)) * 2;
                    af[ct] = cat8(tr16(p), tr16(p + 16 * SG_RS)); }
#pragma unroll
                for (int it = 0; it < 8; ++it) if (it >= 2 * kc) {
                    const bf16* wp = wbase + (size_t)(16 * it) * 128 + 32 * kc; const LAS unsigned char* wq = Wl + (16 * it + qi) * SG_WRS + (32 * kc + 4 * g4) * 2;
                    const v2u b0 = wlds ? *(const LAS v2u*)wq : *(const v2u*)wp, b1 = wlds ? *(const LAS v2u*)(wq + 32) : *(const v2u*)(wp + 16);
                    const bf16x8 bfr = __builtin_bit_cast(bf16x8, (v4u){b0.x, b0.y, b1.x, b1.y});
                    acc[0][it] = mfma16(af[0], bfr, acc[0][it]); acc[1][it] = mfma16(af[1], bfr, acc[1][it]); }
            }
#pragma unroll
            for (int it = 0; it < 8; ++it) { const int i = 16 * it + qi; const float bias = ubias[it]; const size_t rowo = (size_t)(m0 + i) * 1536 + gi * 256 + 32 * F.wave + 4 * g4;
#pragma unroll
                for (int ct = 0; ct < 2; ++ct) { const v2u uu = uq[it][ct]; const f32x4 a = acc[ct][it]; v2u w;
                    w.x = pk2(bflo(uu.x) * (a[0] + bias), bfhi(uu.x) * (a[1] + bias)); w.y = pk2(bflo(uu.y) * (a[2] + bias), bfhi(uu.y) * (a[3] + bias));
                    *(v2u*)(TT + rowo + 16 * ct) = w; } }
        }
        LDS_BARRIER();
    }
#undef SG_LOAD
}

__device__ __forceinline__ void phase_ln1(Frame& F, int l, bool commit) {
    const bf16* YPRE = wsp<bf16>(F, WS_YPRE); bf16* H = wsp<bf16>(F, WS_H);
    const float* modl = wsp<float>(F, WS_MOD) + (size_t)l * 8 * 6144;
    const float* lg = F.in[I_LN1G] + l * D; const float* lb = F.in[I_LN1B] + l * D; const float* br = F.in[I_BR] + l * NE;
    const bf16* WH = wsp<bf16>(F, WS_WRT) + (size_t)l * NE * D; const bf16* WL = WH + (size_t)NL * NE * D;
    int* TOKINFO = wsp<int>(F, WS_TOKINFO); float* TOKW = wsp<float>(F, WS_TOKW);
    unsigned* cntg = wsp<unsigned>(F, WS_CTL) + CW_CNT + (size_t)l * NE * 64;
    LAS int* sel_e = (LAS int*)(F.lds + X_SELE);
    const int lane = F.lane, qi = lane & 15, g4 = lane >> 4;
    { const v4u* srcw = (const v4u*)WH;
#pragma unroll 4
      for (int i = F.tid; i < 2 * NE * 128; i += 512) { const int hl = i >> 12, e = (i >> 7) & 31, c = i & 127;
          *(LAS v4u*)(F.lds + hl * 65536 + e * 2048 + ((c ^ (e & 15)) << 4)) = srcw[(size_t)hl * (NL * NE * 128) + e * 128 + c]; } }
    __syncthreads();
    for (int tb = F.vcu; tb < T / 128; tb += F.G) {
        const int m0 = tb * 128; const int b = m0 >> 12; const float* mb = modl + (size_t)b * 6144; const int mw = m0 + 16 * F.wave;
        v2u pre[4][4];
#pragma unroll
        for (int r = 0; r < 4; ++r)
#pragma unroll
            for (int j = 0; j < 4; ++j) pre[r][j] = *((const v2u*)(YPRE + (size_t)(mw + r) * D) + lane + 64 * j);
#pragma unroll 1
        for (int rp = 0; rp < 4; ++rp) {
            f32x4 hh[4][4]; float mean[4], rstd[4];
            const int mrow = mw + 4 * rp;
#pragma unroll
            for (int r = 0; r < 4; ++r)
#pragma unroll
                for (int j = 0; j < 4; ++j) hh[r][j] = (f32x4){bflo(pre[r][j].x), bfhi(pre[r][j].x), bflo(pre[r][j].y), bfhi(pre[r][j].y)};
            if (rp < 3) {
#pragma unroll
                for (int r = 0; r < 4; ++r)
#pragma unroll
                    for (int j = 0; j < 4; ++j) pre[r][j] = *((const v2u*)(YPRE + (size_t)(mrow + 4 + r) * D) + lane + 64 * j); }
            { float sm[4], sq[4];
#pragma unroll
              for (int r = 0; r < 4; ++r) { sm[r] = 0.f; sq[r] = 0.f;
#pragma unroll
                  for (int j = 0; j < 4; ++j) { sm[r] += (hh[r][j][0] + hh[r][j][1]) + (hh[r][j][2] + hh[r][j][3]);
                      sq[r] += (hh[r][j][0] * hh[r][j][0] + hh[r][j][1] * hh[r][j][1]) + (hh[r][j][2] * hh[r][j][2] + hh[r][j][3] * hh[r][j][3]); } }
#pragma unroll
              for (int o = 1; o < 64; o <<= 1) {
#pragma unroll
                  for (int r = 0; r < 4; ++r) { sm[r] += __shfl_xor(sm[r], o); sq[r] += __shfl_xor(sq[r], o); } }
#pragma unroll
              for (int r = 0; r < 4; ++r) { mean[r] = sm[r] * (1.0f / D); rstd[r] = 1.0f / sqrtf(fmaxf(sq[r] * (1.0f / D) - mean[r] * mean[r], 0.f) + LN_EPS); } }
            if (lane < 4) { const float mq = (lane == 0) ? mean[0] : (lane == 1) ? mean[1] : (lane == 2) ? mean[2] : mean[3], rq = (lane == 0) ? rstd[0] : (lane == 1) ? rstd[1] : (lane == 2) ? rstd[2] : rstd[3];
                float* st = wsp<float>(F, WS_STAT) + (size_t)(mrow + lane) * 2; st[0] = mq; st[1] = rq; }
#pragma unroll
            for (int j = 0; j < 4; ++j) { const f32x4 gq = *((const f32x4*)lg + lane + 64 * j), bq = *((const f32x4*)lb + lane + 64 * j);
                const f32x4 shq = *((const f32x4*)(mb + 3072) + lane + 64 * j), scq = *((const f32x4*)(mb + 4096) + lane + 64 * j) + 1.0f;
#pragma unroll
                for (int r = 0; r < 4; ++r) { const f32x4 x1 = (hh[r][j] - mean[r]) * rstd[r] * gq + bq;
                    const f32x4 h2 = x1 * scq + shq; v2u o; o.x = pk2(h2[0], h2[1]); o.y = pk2(h2[2], h2[3]); *((v2u*)(H + (size_t)(mrow + r) * D) + lane + 64 * j) = o;
 } }
        }
        VM_WAIT(); asm volatile("" ::: "memory");
        f32x4 c0 = (f32x4){0.f, 0.f, 0.f, 0.f}, c1 = c0;
        { const bf16* hp = H + (size_t)(mw + qi) * D + 8 * g4;
          const LAS unsigned char* w0 = F.lds + qi * 2048; const LAS unsigned char* w1 = F.lds + (16 + qi) * 2048;
#pragma unroll 8
          for (int ks = 0; ks < 32; ++ks) {
              const bf16x8 hhi = *(const bf16x8*)(hp + 32 * ks);
              const int co = ((4 * ks + g4) ^ qi) << 4;
              const bf16x8 a0h = *(const LAS bf16x8*)(w0 + co), a0l = *(const LAS bf16x8*)(w0 + 65536 + co);
              const bf16x8 a1h = *(const LAS bf16x8*)(w1 + co), a1l = *(const LAS bf16x8*)(w1 + 65536 + co);
              c0 = mfma16(a0h, hhi, c0); c0 = mfma16(a0l, hhi, c0);
              c1 = mfma16(a1h, hhi, c1); c1 = mfma16(a1l, hhi, c1); } }
        {
            float v[8]; int id[8];
#pragma unroll
            for (int i = 0; i < 4; ++i) { id[i] = 4 * g4 + i; id[4 + i] = 16 + 4 * g4 + i; v[i] = c0[i] + br[4 * g4 + i]; v[4 + i] = c1[i] + br[16 + 4 * g4 + i]; }
            int ek[4]; float vk[4];
#pragma unroll
            for (int k = 0; k < 4; ++k) { float lm = v[0]; int li = id[0];
#pragma unroll
                for (int j = 1; j < 8; ++j) if (v[j] > lm) { lm = v[j]; li = id[j]; }
#pragma unroll
                for (int o = 16; o <= 32; o <<= 1) { const float om = __shfl_xor(lm, o); const int oi = __shfl_xor(li, o); if (om > lm || (om == lm && oi < li)) { lm = om; li = oi; } }
                ek[k] = li; vk[k] = lm;
#pragma unroll
                for (int j = 0; j < 8; ++j) if (id[j] == li) v[j] = -INFINITY; }
            const float e1 = __expf(vk[1] - vk[0]), e2 = __expf(vk[2] - vk[0]), e3 = __expf(vk[3] - vk[0]); const float inv = 1.0f / (1.0f + e1 + e2 + e3);
            if (g4 == 0) { const int tl = 16 * F.wave + qi;
                sel_e[tl * 4 + 0] = ek[0]; sel_e[tl * 4 + 1] = ek[1]; sel_e[tl * 4 + 2] = ek[2]; sel_e[tl * 4 + 3] = ek[3];
                *(f32x4*)(TOKW + (size_t)(m0 + tl) * 4) = (f32x4){inv, e1 * inv, e2 * inv, e3 * inv}; }
        }
        __syncthreads();
        { const int myE = sel_e[F.tid]; LAS unsigned long long* bm = (LAS unsigned long long*)(F.lds + X_SELR); unsigned long long mine = 0ull;
#pragma unroll
          for (int e = 0; e < 32; ++e) { const unsigned long long m = __ballot(myE == e); if (lane == e) mine = m; }
          if (lane < 32) bm[F.wave * 32 + lane] = mine;
          __syncthreads();
          int rk = __popcll(bm[F.wave * 32 + myE] & ((1ull << lane) - 1ull));
#pragma unroll
          for (int w = 0; w < 8; ++w) if (w < F.wave) rk += __popcll(bm[w * 32 + myE]);
          TOKINFO[(size_t)m0 * 4 + F.tid] = myE | (rk << 8);
          if (F.tid < 32) { int tot = 0;
#pragma unroll
              for (int w = 0; w < 8; ++w) tot += __popcll(bm[w * 32 + F.tid]);
              wsp<int>(F, WS_WGCNT)[((size_t)l * 256 + tb) * 32 + F.tid] = tot; if (tot && commit) (void)__hip_atomic_fetch_add(cntg + F.tid * 64, (unsigned)tot, RLX_AGENT); } }
        __syncthreads();
    }
}

__device__ __forceinline__ int moe_tables(Frame& F, int l) {
    const unsigned* cntg = wsp<unsigned>(F, WS_CTL) + CW_CNT + (size_t)l * NE * 64;
    LAS int* cnt_s = (LAS int*)(F.lds + X_CNTS); LAS int* off_s = (LAS int*)(F.lds + X_OFFS); LAS unsigned char* tile_e = (LAS unsigned char*)(F.lds + X_TILEE);
    if (F.tid < 32) cnt_s[F.tid] = (int)__hip_atomic_load(cntg + F.tid * 64, RLX_AGENT);
    __syncthreads();
    if (F.tid < 64) {
        const int e = F.tid & 31; const int c = (F.tid < 32) ? cnt_s[e] : 0; const int nt = (c + 255) >> 8; int incl = nt;
#pragma unroll
        for (int o = 1; o < 32; o <<= 1) { const int v = __shfl_up(incl, o); if ((F.tid & 63) >= o) incl += v; }
        if (F.tid < 32) { const int excl = incl - nt; off_s[e] = excl * 256; for (int t = 0; t < nt; ++t) tile_e[excl + t] = (unsigned char)e; if (e == 31) off_s[32] = incl * 256; }
    }
    __syncthreads();
    return off_s[32] >> 8;
}
__device__ __forceinline__ void phase_scat(Frame& F, int l) {
    (void)moe_tables(F, l);
    const LAS int* off_s = (const LAS int*)(F.lds + X_OFFS); const LAS int* cnt_s = (const LAS int*)(F.lds + X_CNTS); LAS int* base_s = (LAS int*)(F.lds + X_BASE);
    const int* TOKINFO = wsp<int>(F, WS_TOKINFO); const float* TOKW = wsp<float>(F, WS_TOKW);
    int* ROWTOK = wsp<int>(F, WS_ROWTOK); float* ROWW = wsp<float>(F, WS_ROWW); const int* WGC = wsp<int>(F, WS_WGCNT) + (size_t)l * 256 * 32; int* TOKINFO2 = wsp<int>(F, WS_TOKROW);
    for (int tb = F.vcu; tb < T / 128; tb += F.G) {
        if (F.tid < 32) base_s[F.tid] = 0;
        __syncthreads();
        { const int e = F.tid & 31, part = F.tid >> 5; int sacc = 0;
          for (int t2 = part * 16; t2 < part * 16 + 16; ++t2) if (t2 < tb) sacc += WGC[t2 * 32 + e];
          if (sacc) atomicAdd((int*)&base_s[e], sacc); }
        __syncthreads();
        { const size_t ent = (size_t)tb * 512 + F.tid; const int info = TOKINFO[ent]; const int e = info & 255, row = off_s[e] + base_s[e] + (info >> 8);
          ROWTOK[row] = (int)ent; ROWW[row] = TOKW[ent]; TOKINFO2[ent] = row; }
        __syncthreads();
    }
    if (F.vcu == 0) for (int e = 0; e < NE; ++e) for (int r = off_s[e] + cnt_s[e] + F.tid; r < off_s[e + 1]; r += 512) { ROWTOK[r] = 0; ROWW[r] = 0.f; }
}
__device__ __forceinline__ void phase_ln2(Frame& F, int l) {
    const bf16* X1 = wsp<bf16>(F, WS_YPRE); const bf16* YK = wsp<bf16>(F, WS_XG); bf16* H = wsp<bf16>(F, WS_H); const int* TOKROW = wsp<int>(F, WS_TOKROW); const float* TOKW = wsp<float>(F, WS_TOKW);
    const float* STAT = wsp<float>(F, WS_STAT); const float* l1g = F.in[I_LN1G] + l * D; const float* l1b = F.in[I_LN1B] + l * D;
    float* XO = F.out; bf16* XB = wsp<bf16>(F, WS_X2);
    const float* modl = wsp<float>(F, WS_MOD) + (size_t)l * 8 * 6144; const float* modn = wsp<float>(F, WS_MOD) + (size_t)((l + 1) & 3) * 8 * 6144;
    const float* lg = F.in[I_LN2G] + l * D; const float* lb = F.in[I_LN2B] + l * D;
    const int lane = F.lane; const int gw = F.vcu * 8 + F.wave, NGW = F.G * 8;
    v2u px[4]; v2u py[4][4]; float pst[2], nst[2]; f32x4 pw4, nw4;
#define LN2_LOAD(mm) do { nst[0] = STAT[(size_t)(mm) * 2]; nst[1] = STAT[(size_t)(mm) * 2 + 1]; nw4 = *(const f32x4*)(TOKW + (size_t)(mm) * 4); \
        int rw_[4]; _Pragma("unroll") for (int k = 0; k < 4; ++k) rw_[k] = TOKROW[(size_t)(mm) * 4 + k]; \
        _Pragma("unroll") for (int j = 0; j < 4; ++j) { px[j] = __builtin_nontemporal_load((const v2u*)(X1 + (size_t)(mm) * D) + lane + 64 * j); \
        _Pragma("unroll") for (int k = 0; k < 4; ++k) py[j][k] = __builtin_nontemporal_load((const v2u*)(YK + (size_t)rw_[k] * D) + lane + 64 * j); } } while (0)
    if (gw < T) LN2_LOAD(gw);
#pragma unroll 1
    for (int m = gw; m < T; m += NGW) { const int b = m >> 12; const float* mb = modl + (size_t)b * 6144; const float* mn = modn + (size_t)b * 6144;
        f32x4 v[4]; float s = 0.f; pst[0] = nst[0]; pst[1] = nst[1]; pw4 = nw4;
#pragma unroll
        for (int j = 0; j < 4; ++j) { f32x4 y = (f32x4){0.f, 0.f, 0.f, 0.f};
#pragma unroll
            for (int k = 0; k < 4; ++k) { const v2u w = py[j][k]; const float cw = pw4[k]; y[0] += cw * bflo(w.x); y[1] += cw * bfhi(w.x); y[2] += cw * bflo(w.y); y[3] += cw * bfhi(w.y); }
            const f32x4 g2 = *((const f32x4*)(mb + 5120) + lane + 64 * j) + 1.0f;
            const f32x4 pxf = (f32x4){bflo(px[j].x), bfhi(px[j].x), bflo(px[j].y), bfhi(px[j].y)};
            const f32x4 x1 = (pxf - pst[0]) * pst[1] * *((const f32x4*)l1g + lane + 64 * j) + *((const f32x4*)l1b + lane + 64 * j);
            v[j] = x1 * DN_ALPHA + g2 * y; s += (v[j][0] + v[j][1]) + (v[j][2] + v[j][3]); }
        if (m + NGW < T) LN2_LOAD(m + NGW);
        float s2 = 0.f;
#pragma unroll
        for (int j = 0; j < 4; ++j) s2 += (v[j][0] * v[j][0] + v[j][1] * v[j][1]) + (v[j][2] * v[j][2] + v[j][3] * v[j][3]);
#pragma unroll
        for (int o = 1; o < 64; o <<= 1) { s += __shfl_xor(s, o); s2 += __shfl_xor(s2, o); }
        const float mean = s * (1.0f / D); const float rstd = 1.0f / sqrtf(fmaxf(s2 * (1.0f / D) - mean * mean, 0.f) + LN_EPS);
#pragma unroll
        for (int j = 0; j < 4; ++j) v[j] = v[j] - mean;
        f32x4* xo = (f32x4*)(XO + (size_t)m * D) + lane; v2u* xb = (v2u*)(XB + (size_t)m * D) + lane; v2u* ho = (v2u*)(H + (size_t)m * D) + lane;
#pragma unroll
        for (int j = 0; j < 4; ++j) { const f32x4 gvj = *((const f32x4*)lg + lane + 64 * j), bvj = *((const f32x4*)lb + lane + 64 * j); const f32x4 x2 = v[j] * rstd * gvj + bvj;
            if (l == NL - 1) __builtin_nontemporal_store(x2, xo + 64 * j); else { v2u xq; xq.x = pk2(x2[0], x2[1]); xq.y = pk2(x2[2], x2[3]); __builtin_nontemporal_store(xq, xb + 64 * j); }
            if (l < NL - 1) { const f32x4 sh = *((const f32x4*)mn + lane + 64 * j), sc = *((const f32x4*)(mn + 1024) + lane + 64 * j) + 1.0f; const f32x4 h = x2 * sc + sh;
                v2u o; o.x = pk2(h[0], h[1]); o.y = pk2(h[2], h[3]); ho[64 * j] = o; } } }
#undef LN2_LOAD
}

#ifndef PH_MASK
#define PH_MASK 0xFFFF
#endif
#define PHM(b) ((PH_MASK >> (b)) & 1)
#ifndef DUP_MASK
#define DUP_MASK 0
#endif
#define REPS(b) (((DUP_MASK >> (b)) & 1) ? 2 : 1)
constexpr int NPH_L = 10, NPHASE = 2 + NL * NPH_L;
struct Args { const float* in[20]; float* out; unsigned char* ws; int ph_lo, ph_hi; };
__global__ void __launch_bounds__(512, 2) fwd(Args args) {
    extern __shared__ __attribute__((aligned(16))) unsigned char lds[];
    Frame F;
    F.lds = (LAS unsigned char*)lds;
#define FRESH() do { int zv_ = 0; asm volatile("" : "+v"(zv_)); const int z_ = __builtin_amdgcn_readfirstlane(zv_); \
        F.tid = (int)threadIdx.x + zv_; F.lane = F.tid & 63; F.wave = __builtin_amdgcn_readfirstlane(F.tid >> 6); \
        F.G = (int)gridDim.x + z_; F.bx = (int)blockIdx.x + z_; F.vcu = (F.G % 8 == 0) ? (F.bx % 8) * (F.G / 8) + F.bx / 8 : F.bx; \
        F.ws = args.ws + z_; F.in = args.in + z_; F.out = args.out + z_; F.lds = (LAS unsigned char*)lds + z_; } while (0)
    FRESH();
    for (int u = F.tid; u < (LDS_BYTES - XOFF) / 4; u += 512) ((LAS unsigned*)(F.lds + XOFF))[u] = 0u;
    __syncthreads();
    unsigned* ctl = wsp<unsigned>(F, WS_CTL);
    XcdBarrier bar; bar.bar = ctl + CW_BAR; bar.x = 0; bar.st = nullptr;
    if (!MK_PER_PHASE) bar = xcd_barrier_post(ctl + CW_BAR, (volatile LAS unsigned*)(F.lds + X_MISC) + 8);
    const int lo = args.ph_lo, hi = args.ph_hi;
#define IN(k) (lo <= (k) && (k) < hi)
#ifndef BAR_REPS
#define BAR_REPS 1
#endif
#define SEAM(k) do { if (!MK_PER_PHASE && IN(k) && IN((k) + 1)) for (int br_ = 0; br_ < BAR_REPS; ++br_) xcd_barrier(bar); } while (0)

    if (PHM(0) && IN(0)) for (int rep = 0; rep < REPS(0); ++rep) { FRESH(); phase_pro_a(F); } SEAM(0);
    if (PHM(1) && IN(1)) for (int rep = 0; rep < REPS(1); ++rep) { FRESH(); phase_pro_b(F); } SEAM(1);
    for (int l = 0; l < NL; ++l) {
        const int pb = 2 + l * NPH_L;
        if (PHM(2) && IN(pb + 0)) for (int rep = 0; rep < REPS(2); ++rep) { FRESH();
            pg8::Gemm g{wsp<bf16>(F, WS_H), wsp<bf16>(F, WS_WIN) + (size_t)l * NIN * D, T, NIN, D}; pg8::StaticOrder S; S.init(T, NIN, F.G, F.bx);
            EpiIn E{wsp<bf16>(F, WS_U), wsp<bf16>(F, WS_V), wsp<bf16>(F, WS_Q), wsp<bf16>(F, WS_K), wsp<bf16>(F, WS_VV), wsp<bf16>(F, WS_G), wsp<float>(F, WS_ROPE)};
            stagger(F.bx >> 3, STAG_US);
            pg8::gemm_phase<EpiIn, pg8::StaticOrder, PG8_ALIGN, PG8_SP2>(F.lds, g, S, E, F.tid);
#if defined(XPROBE)
            { FRESH(); pg8::Gemm g2{wsp<bf16>(F, WS_H), wsp<bf16>(F, WS_WIN) + (size_t)l * NIN * D, T, NIN, D}; pg8::StaticOrder S2; S2.init(T, NIN, F.G, F.bx);
              EpiProbe E2{wsp<bf16>(F, WS_XG), (XPROBE == 3) ? NIN : 1024, (XPROBE >= 2) ? (XPROBE == 3 ? 3 : 1) : (F.G == 0x7ffffff0 ? 1 : 0)};
              pg8::gemm_phase<EpiProbe, pg8::StaticOrder, PG8_ALIGN, PG8_SP2>(F.lds, g2, S2, E2, F.tid); }
#endif
        } SEAM(pb + 0);
        if (PHM(3) && IN(pb + 1)) for (int rep = 0; rep < REPS(3); ++rep) { FRESH(); phase_attn(F); } SEAM(pb + 1);
        if (PHM(4) && IN(pb + 2)) for (int rep = 0; rep < REPS(4); ++rep) { FRESH(); phase_sg(F, l); } SEAM(pb + 2);
        if (PHM(5) && IN(pb + 3)) for (int rep = 0; rep < REPS(5); ++rep) { FRESH();
            pg8::Gemm g{wsp<bf16>(F, WS_TT), wsp<bf16>(F, WS_WBA) + (size_t)l * D * 1536, T, D, 1536}; pg8::StaticOrder S; S.init(T, D, F.G, F.bx);
            EpiMg2 E{wsp<bf16>(F, WS_G), wsp<bf16>(F, WS_MG)}; pg8::gemm_phase<EpiMg2, pg8::StaticOrder, PG8_ALIGN, PG8_SP2>(F.lds, g, S, E, F.tid);
        } SEAM(pb + 3);
        if (PHM(6) && IN(pb + 4)) for (int rep = 0; rep < REPS(6); ++rep) { FRESH();
            pg8::Gemm g{wsp<bf16>(F, WS_MG), wsp<bf16>(F, WS_WOUT) + (size_t)l * D * D, T, D, D}; pg8::StaticOrder S; S.init(T, D, F.G, F.bx);
            if (l == 0) { EpiOut<true> E{(const void*)F.in[I_X], wsp<float>(F, WS_MOD) + (size_t)l * 8 * 6144, wsp<bf16>(F, WS_YPRE)}; pg8::gemm_phase<EpiOut<true>, pg8::StaticOrder, PG8_ALIGN, PG8_SP2>(F.lds, g, S, E, F.tid); }
            else { EpiOut<false> E{(const void*)wsp<bf16>(F, WS_X2), wsp<float>(F, WS_MOD) + (size_t)l * 8 * 6144, wsp<bf16>(F, WS_YPRE)}; pg8::gemm_phase<EpiOut<false>, pg8::StaticOrder, PG8_ALIGN, PG8_SP2>(F.lds, g, S, E, F.tid); }
        } SEAM(pb + 4);
        if (PHM(7) && IN(pb + 5)) for (int rep = 0; rep < REPS(7); ++rep) { FRESH(); phase_ln1(F, l, rep == 0); } SEAM(pb + 5);
        if (PHM(8) && IN(pb + 6)) for (int rep = 0; rep < REPS(8); ++rep) { FRESH(); phase_scat(F, l); } SEAM(pb + 6);
        if (PHM(9) && IN(pb + 7)) for (int rep = 0; rep < REPS(9); ++rep) { FRESH();
            const int RT = moe_tables(F, l);
            pg8::Gemm g{wsp<bf16>(F, WS_H), wsp<bf16>(F, WS_WUP) + (size_t)l * NE * 2048 * D, RT * 256, NE * 2048, D};
            MoeGatherOrder S; S.init(RT, 8, F.G, F.bx, (const LAS unsigned char*)(F.lds + X_TILEE)); S.tokl = (const LAS unsigned short*)(F.lds + X_TOKL);
            { const int* rowtok = wsp<int>(F, WS_ROWTOK); LAS unsigned short* tl = (LAS unsigned short*)(F.lds + X_TOKL); pg8::Unit uu;
              for (int i = 0; i < TOKL_UNITS && S.next(i, uu); ++i) if (F.tid < 256) tl[i * 256 + F.tid] = (unsigned short)(rowtok[uu.pm * 256 + F.tid] >> 2);
              __syncthreads(); }
            EpiUp E{F.in[I_BUP] + (size_t)l * NE * 2048, wsp<bf16>(F, WS_ACT)};
            stagger(F.bx >> 3, STAG_US);
            pg8::gemm_phase<EpiUp, MoeGatherOrder, PG8_ALIGN, true>(F.lds, g, S, E, F.tid);
        } SEAM(pb + 7);
        if (PHM(10) && IN(pb + 8)) for (int rep = 0; rep < REPS(10); ++rep) { FRESH();
            const int RT = moe_tables(F, l);
            pg8::Gemm g{wsp<bf16>(F, WS_ACT), wsp<bf16>(F, WS_WDN) + (size_t)l * NE * D * FF, RT * 256, NE * D, FF};
            MoeOrder S; S.init(RT, 4, F.G, F.bx, (const LAS unsigned char*)(F.lds + X_TILEE), 1);
            EpiDn E{F.in[I_BDN] + (size_t)l * NE * D, wsp<bf16>(F, WS_XG)};
            stagger(F.bx >> 3, STAG_US);
            pg8::gemm_phase<EpiDn, MoeOrder, PG8_ALIGN, PG8_SP2>(F.lds, g, S, E, F.tid);
        } SEAM(pb + 8);
        if (PHM(11) && IN(pb + 9)) for (int rep = 0; rep < REPS(11); ++rep) { FRESH(); phase_ln2(F, l); } SEAM(pb + 9);
    }
#undef IN
#undef SEAM
#undef FRESH
}

extern "C" void kernel_launch(void* const* d_in, const int* in_sizes, int n_in, void* d_out, int out_size, void* d_ws, size_t ws_size, hipStream_t stream) {
    static int grid = 0;
    if (grid == 0) {
        if (n_in != 20 || out_size != T * D || ws_size < WS_END) { fprintf(stderr, "kernel_launch: unexpected shapes (n_in %d, out %d, ws %zu < %zu)\n", n_in, out_size, ws_size, (size_t)WS_END); grid = -1; return; }
        int dev = 0, cus = 0;
        if (hipGetDevice(&dev) != hipSuccess || hipDeviceGetAttribute(&cus, hipDeviceAttributeMultiprocessorCount, dev) != hipSuccess) { grid = -1; return; }
        if (hipFuncSetAttribute((const void*)fwd, hipFuncAttributeMaxDynamicSharedMemorySize, LDS_BYTES) != hipSuccess) { fprintf(stderr, "kernel_launch: hipFuncSetAttribute failed\n"); grid = -1; return; }
        int per_cu = 0;
        if (hipOccupancyMaxActiveBlocksPerMultiprocessor(&per_cu, (const void*)fwd, 512, LDS_BYTES) != hipSuccess || per_cu < 1) fprintf(stderr, "kernel_launch: occupancy query says %d blocks per CU\n", per_cu);
        (void)hipGetLastError();
        grid = cus;
    }
    if (grid < 0) return;
    (void)in_sizes;
    if (hipMemsetAsync((char*)d_ws + WS_CTL, 0, CTL_ZERO_BYTES, stream) != hipSuccess) return;
    Args a{};
    for (int i = 0; i < 20; ++i) a.in[i] = (const float*)d_in[i];
    a.out = (float*)d_out; a.ws = (unsigned char*)d_ws;
#if MK_PER_PHASE
    for (int p = 0; p < NPHASE; ++p) { a.ph_lo = p; a.ph_hi = p + 1; hipLaunchKernelGGL(fwd, dim3(grid), dim3(512), LDS_BYTES, stream, a); }
#else
    a.ph_lo = 0; a.ph_hi = NPHASE;
    hipLaunchKernelGGL(fwd, dim3(grid), dim3(512), LDS_BYTES, stream, a);
#endif
    const hipError_t le = hipPeekAtLastError();
    if (le != hipSuccess) fprintf(stderr, "kernel_launch: launch failed: %s\n", hipGetErrorName(le));
}
```

```cpp
#include <hip/hip_runtime.h>
#include <cstdio>
#include <cstdint>
#ifndef MK_PER_PHASE
#define MK_PER_PHASE 0
#endif
namespace pg8 {
#define PG8_LAS __attribute__((address_space(3)))
typedef unsigned short bf16_t;
typedef short bf16x8 __attribute__((ext_vector_type(8)));
typedef float f32x4 __attribute__((ext_vector_type(4)));
typedef unsigned u32x4 __attribute__((ext_vector_type(4)));
constexpr int BM = 256, BK = 64, HALF = 128, HTB = HALF * BK * 2  , STAGE_BYTES = 8 * HTB, NXCD = 8;
#ifndef PG8_WGM
#define PG8_WGM 8
#endif
constexpr int WGM = PG8_WGM;

__host__ __device__ __forceinline__ int lds_byte(int r, int c) { const int st = (r >> 4) * 2 + (c >> 5), rr = r & 15, cc = c & 31, ob = rr * 64 + cc * 2; return st * 1024 + (ob ^ (((ob >> 9) & 1) << 5)); }
__host__ __device__ __forceinline__ void stage_rc(int b, int& R, int& C) { const int st = b / 1024, sb = b % 1024, swz = sb ^ (((sb >> 9) & 1) << 5); R = (st >> 1) * 16 + swz / 64; C = (st & 1) * 32 + (swz % 64) / 2; }
__host__ __device__ __forceinline__ int perm32(int rho) { const int n = rho >> 4, i = rho & 15; return 8 * (i >> 2) + 4 * n + (i & 3); }

struct Unit { int pm, pn; };
struct Gemm { const bf16_t* A; const bf16_t* Bt; int M, N, K; };

struct StaticOrder {
    static constexpr bool GATHER = false; __device__ __forceinline__ int arow(int, int r) const { return r; }
    int nM, nN, nwg, G, c;
    __host__ __device__ void init(int M, int N, int G_, int c_) { nM = M / BM; nN = N / BM; nwg = nM * nN; G = G_; c = c_; }
    __host__ __device__ bool next(int i, Unit& u) const {
        const long L = (long)i * G + c; if (L >= nwg) return false;
        int wgid = (int)L; { const int q = nwg / NXCD, r = nwg % NXCD, xcd = wgid % NXCD, off = wgid / NXCD; wgid = (xcd < r ? xcd * (q + 1) : r * (q + 1) + (xcd - r) * q) + off; }
        const int nig = WGM * nN, gid = wgid / nig, fm = gid * WGM, gsz = (nM - fm) < WGM ? (nM - fm) : WGM;
        u.pm = fm + ((wgid % nig) % gsz); u.pn = (wgid % nig) / gsz; return true;
    }
    __device__ __forceinline__ void a_ready(const Unit&) const {}
    __device__ __forceinline__ void done(const Unit&) const {}
};

__device__ __forceinline__ unsigned cvt_pk_bf16(float lo, float hi) { unsigned r; asm volatile("v_cvt_pk_bf16_f32 %0, %1, %2" : "=v"(r) : "v"(lo), "v"(hi)); return r; }
typedef float f32x2 __attribute__((ext_vector_type(2)));

template <class Epi, class Sched, bool ALIGN_EPI = false, bool SP2 = false>
__device__ __forceinline__ void gemm_phase(PG8_LAS unsigned char* lds, const Gemm g, const Sched& S, const Epi& E, const int tid_in) {
    const int tid = tid_in, wid = __builtin_amdgcn_readfirstlane(tid >> 6), lane = tid & 63, wr = wid >> 2, wc = wid & 3, fr = lane & 15, fq = lane >> 4;
    const int K = g.K, nt = K / BK;
    unsigned voffA[2], voffB[2];
#pragma unroll
    for (int i = 0; i < 2; ++i) { int R, C; stage_rc(tid * 16 + i * 8192, R, C); const int Rb = Epi::PERM ? ((R & ~31) + perm32(R & 31)) : R;
        voffA[i] = (unsigned)(R * K + C) * 2u; voffB[i] = (unsigned)(Rb * K + C) * 2u; }
    const size_t kstep = (size_t)(BK * 2);
    const size_t hstep = (size_t)HALF * K * 2;
    const size_t tstep = 2 * hstep;
    const unsigned ldsw = (unsigned)wid * 1024u;
    const int aoff = lds_byte(wr * 64 + fr, fq * 8), boff = lds_byte(wc * 32 + fr, fq * 8);
#define PG8_SA(b, h) (((b) * 2 + (h)) * HTB)
#define PG8_SB(b, h) ((4 + (b) * 2 + (h)) * HTB)
    unsigned gc[2][2], gn[2][2];
#define PG8_GOFF(dst, pmv, ordv) do { if constexpr (Sched::GATHER) { _Pragma("unroll") for (int _h = 0; _h < 2; ++_h) _Pragma("unroll") for (int _i = 0; _i < 2; ++_i) { int _R, _C; stage_rc(tid * 16 + _i * 8192, _R, _C); \
        dst[_h][_i] = (unsigned)S.arow((ordv), (pmv) * 256 + _h * 128 + _R) * (unsigned)(K * 2) + (unsigned)(_C * 2); } } } while (0)
#define PG8_STAGE_A(bufoff, origptr, nextf, hh, kbytes) do { if constexpr (Sched::GATHER) { _Pragma("unroll") for (int _i = 0; _i < 2; ++_i) { const unsigned _o = (nextf) ? gn[hh][_i] : gc[hh][_i]; \
        __builtin_amdgcn_global_load_lds((const unsigned*)((const char*)g.A + (kbytes) + _o), (PG8_LAS unsigned*)(lds + (bufoff) + ldsw + _i * 8192), 16, 0, 0); } } else { PG8_STAGE(bufoff, origptr, voffA); } } while (0)
#define PG8_STAGE(bufoff, gbase, voff) do { _Pragma("unroll") for (int _i = 0; _i < 2; ++_i) \
        __builtin_amdgcn_global_load_lds((const unsigned*)((const char*)(gbase) + (voff)[_i]), (PG8_LAS unsigned*)(lds + (bufoff) + ldsw + _i * 8192), 16, 0, 0); } while (0)
#define PG8_LDA(dst, b, h) do { _Pragma("unroll") for (int m = 0; m < 4; ++m) _Pragma("unroll") for (int k = 0; k < 2; ++k) dst[m][k] = *(const PG8_LAS bf16x8*)(lds + PG8_SA(b, h) + aoff + m * 2048 + k * 1024); } while (0)
#define PG8_LDB(dst, b, h) do { _Pragma("unroll") for (int n = 0; n < 2; ++n) _Pragma("unroll") for (int k = 0; k < 2; ++k) dst[n][k] = *(const PG8_LAS bf16x8*)(lds + PG8_SB(b, h) + boff + n * 2048 + k * 1024); } while (0)
#define PG8_MMA(ai, bj, At, Bt) do { __builtin_amdgcn_s_setprio(1); _Pragma("unroll") for (int m = 0; m < 4; ++m) _Pragma("unroll") for (int n = 0; n < 2; ++n) _Pragma("unroll") for (int k = 0; k < 2; ++k) \
        acc[ai][bj][m][n] = __builtin_amdgcn_mfma_f32_16x16x32_bf16(Bt[n][k], At[m][k], acc[ai][bj][m][n], 0, 0, 0); __builtin_amdgcn_s_setprio(0); } while (0)
#define PG8_WAIT_V(n) asm volatile("s_waitcnt vmcnt(" #n ")" ::: "memory")
#define PG8_WAIT_L(n) asm volatile("s_waitcnt lgkmcnt(" #n ")" ::: "memory")
#define PG8_BAR __builtin_amdgcn_s_barrier()
#define PG8_SCHED __builtin_amdgcn_sched_barrier(0)
    Unit cur, nxt; int ui = 0;
    if (!S.next(0, cur)) return;
    f32x4 acc[2][2][4][2];
#pragma unroll
    for (int a = 0; a < 2; ++a)
#pragma unroll
        for (int b = 0; b < 2; ++b)
#pragma unroll
            for (int m = 0; m < 4; ++m)
#pragma unroll
                for (int n = 0; n < 2; ++n) acc[a][b][m][n] = (f32x4){0.f, 0.f, 0.f, 0.f};
    bf16x8 At[4][2], B0[2][2], B1[2][2];
    const char* cA = (const char*)g.A + (size_t)cur.pm * tstep; const char* cB = (const char*)g.Bt + (size_t)cur.pn * tstep;
    S.a_ready(cur);
    PG8_GOFF(gc, cur.pm, 0);
    if constexpr (SP2) {
        PG8_STAGE(PG8_SB(0, 0), cB, voffB); PG8_STAGE(PG8_SB(0, 1), cB + hstep, voffB); PG8_STAGE_A(PG8_SA(0, 0), cA, false, 0, 0); PG8_STAGE_A(PG8_SA(0, 1), cA + hstep, false, 1, 0);
        if (wr == 1) PG8_BAR;
        PG8_WAIT_V(2); PG8_BAR;
        PG8_STAGE(PG8_SB(1, 0), cB + kstep, voffB); PG8_STAGE_A(PG8_SA(1, 0), cA + kstep, false, 0, kstep); PG8_STAGE(PG8_SB(1, 1), cB + hstep + kstep, voffB);
        PG8_WAIT_V(6); PG8_BAR;
    } else {
        PG8_STAGE(PG8_SB(0, 0), cB, voffB); PG8_STAGE(PG8_SA(0, 0), cA, voffA); PG8_STAGE(PG8_SB(0, 1), cB + hstep, voffB); PG8_STAGE(PG8_SA(0, 1), cA + hstep, voffA);
        if (wr == 1) PG8_BAR;
        PG8_WAIT_V(4); PG8_BAR;
        PG8_STAGE(PG8_SB(1, 0), cB + kstep, voffB); PG8_STAGE(PG8_SA(1, 0), cA + kstep, voffA); PG8_STAGE(PG8_SB(1, 1), cB + hstep + kstep, voffB);
        PG8_WAIT_V(6); PG8_BAR;
    }
    for (;;) {
        const bool has_next = S.next(ui + 1, nxt);
        if constexpr (Sched::GATHER) { if (has_next) { PG8_GOFF(gn, nxt.pm, ui + 1); } else { gn[0][0] = gc[0][0]; gn[0][1] = gc[0][1]; gn[1][0] = gc[1][0]; gn[1][1] = gc[1][1]; } }
        const char* nA = has_next ? (const char*)g.A + (size_t)nxt.pm * tstep : cA; const char* nB = has_next ? (const char*)g.Bt + (size_t)nxt.pn * tstep : cB;
#pragma unroll
        for (int seg = 0; seg < (Epi::MID_T > 0 ? 2 : 1); ++seg) {
        if constexpr (Epi::MID_T > 0) { if (seg == 1) { PG8_SCHED; E.mid(acc, cur, wr, wc, fr, fq); PG8_SCHED; } }
        const int t_lo = seg ? Epi::MID_T : 0, t_hi = (Epi::MID_T > 0 && seg == 0) ? Epi::MID_T : nt;
        for (int t = t_lo; t < t_hi; t += 2) {
            const bool last = (t == nt - 2);
            const char* a1 = cA + (size_t)(t + 1) * kstep;
            const char* a2 = last ? nA : cA + (size_t)(t + 2) * kstep; const char* b2 = last ? nB : cB + (size_t)(t + 2) * kstep;
            const char* a3 = a2 + kstep; const char* b3 = b2 + kstep; const size_t k2b = last ? (size_t)0 : (size_t)(t + 2) * kstep;
            if (last && has_next) S.a_ready(nxt);
            if constexpr (SP2) {
            PG8_LDB(B0, 0, 0); PG8_LDB(B1, 0, 1); PG8_SCHED; PG8_LDA(At, 0, 0); PG8_STAGE_A(PG8_SA(1, 1), a1 + hstep, false, 1, (size_t)(t + 1) * kstep);
            PG8_WAIT_V(8); PG8_WAIT_L(0); PG8_BAR; PG8_MMA(0, 0, At, B0); PG8_MMA(0, 1, At, B1); PG8_BAR; PG8_SCHED;
            PG8_LDA(At, 0, 1); PG8_STAGE(PG8_SB(0, 0), b2, voffB); PG8_STAGE(PG8_SB(0, 1), b2 + hstep, voffB); PG8_STAGE_A(PG8_SA(0, 0), a2, last, 0, k2b);
            PG8_WAIT_V(8); PG8_WAIT_L(0); PG8_BAR; PG8_MMA(1, 0, At, B0); PG8_MMA(1, 1, At, B1); PG8_BAR; PG8_SCHED;
            PG8_LDB(B0, 1, 0); PG8_LDB(B1, 1, 1); PG8_SCHED; PG8_LDA(At, 1, 0); PG8_STAGE_A(PG8_SA(0, 1), a2 + hstep, last, 1, k2b);
            PG8_WAIT_V(8); PG8_WAIT_L(0); PG8_BAR; PG8_MMA(0, 0, At, B0); PG8_MMA(0, 1, At, B1); PG8_BAR; PG8_SCHED;
            PG8_LDA(At, 1, 1); PG8_STAGE(PG8_SB(1, 0), b3, voffB); PG8_STAGE(PG8_SB(1, 1), b3 + hstep, voffB); PG8_STAGE_A(PG8_SA(1, 0), a3, last, 0, k2b + kstep);
            PG8_WAIT_V(8); PG8_WAIT_L(0); PG8_BAR; PG8_MMA(1, 0, At, B0); PG8_MMA(1, 1, At, B1); PG8_BAR; PG8_SCHED;
            } else {
            PG8_LDB(B0, 0, 0); PG8_SCHED; PG8_LDA(At, 0, 0); PG8_STAGE(PG8_SA(1, 1), a1 + hstep, voffA);
            PG8_WAIT_L(8); PG8_BAR; PG8_WAIT_L(0); PG8_MMA(0, 0, At, B0); PG8_BAR; PG8_SCHED;
            PG8_LDB(B1, 0, 1); PG8_STAGE(PG8_SB(0, 0), b2, voffB);
            PG8_BAR; PG8_WAIT_L(0); PG8_MMA(0, 1, At, B1); PG8_BAR;
            PG8_LDA(At, 0, 1); PG8_STAGE(PG8_SA(0, 0), a2, voffA);
            PG8_BAR; PG8_WAIT_L(0); PG8_MMA(1, 0, At, B0); PG8_BAR; PG8_SCHED;
            PG8_STAGE(PG8_SB(0, 1), b2 + hstep, voffB);
            PG8_WAIT_V(6); PG8_BAR; PG8_MMA(1, 1, At, B1); PG8_BAR;
            PG8_LDB(B0, 1, 0); PG8_SCHED; PG8_LDA(At, 1, 0); PG8_STAGE(PG8_SA(0, 1), a2 + hstep, voffA);
            PG8_WAIT_L(8); PG8_BAR; PG8_WAIT_L(0); PG8_MMA(0, 0, At, B0); PG8_BAR; PG8_SCHED;
            PG8_LDB(B1, 1, 1); PG8_STAGE(PG8_SB(1, 0), b3, voffB);
            PG8_BAR; PG8_WAIT_L(0); PG8_MMA(0, 1, At, B1); PG8_BAR;
            PG8_LDA(At, 1, 1); PG8_STAGE(PG8_SA(1, 0), a3, voffA);
            PG8_BAR; PG8_WAIT_L(0); PG8_MMA(1, 0, At, B0); PG8_BAR; PG8_SCHED;
            PG8_STAGE(PG8_SB(1, 1), b3 + hstep, voffB);
            PG8_WAIT_V(6); PG8_BAR; PG8_MMA(1, 1, At, B1); PG8_BAR;
            }
        }
        }
        if constexpr (ALIGN_EPI) { if (wr == 0) PG8_BAR; }
        if constexpr (!Epi::AFTER_DRAIN) { E(acc, cur, wr, wc, fr, fq); S.done(cur); }
        if (!has_next) break;
#pragma unroll
        for (int a = 0; a < 2; ++a)
#pragma unroll
            for (int b = 0; b < 2; ++b)
#pragma unroll
                for (int m = 0; m < 4; ++m)
#pragma unroll
                    for (int n = 0; n < 2; ++n) acc[a][b][m][n] = (f32x4){0.f, 0.f, 0.f, 0.f};
        cur = nxt; cA = nA; cB = nB; ++ui;
        if constexpr (Sched::GATHER) { gc[0][0] = gn[0][0]; gc[0][1] = gn[0][1]; gc[1][0] = gn[1][0]; gc[1][1] = gn[1][1]; }
        if constexpr (ALIGN_EPI) { if (wr == 1) PG8_BAR; }
    }
    PG8_WAIT_V(0);
    if constexpr (!ALIGN_EPI) { if (wr == 0) PG8_BAR; }
    PG8_BAR;
    if constexpr (Epi::AFTER_DRAIN) { E.fused(acc, cur, wr, wc, fr, fq, lds, wid, lane); S.done(cur); }
#undef PG8_SA
#undef PG8_SB
#undef PG8_STAGE
#undef PG8_STAGE_A
#undef PG8_GOFF
#undef PG8_LDA
#undef PG8_LDB
#undef PG8_MMA
#undef PG8_WAIT_V
#undef PG8_WAIT_L
#undef PG8_BAR
#undef PG8_SCHED
}
}
#define LAS __attribute__((address_space(3)))
#define XB_TMO      128
#define XB_XCNT(j)  (256  + 64 * (j))
#define XB_XSUB(j)  (1280 + 64 * (j))
#define XB_XGEN(j)  (2304 + 64 * (j))
#define XB_TOP      3328
#define XB_TOPGEN   3392
#define XCD_BAR_WORDS 3456
#define XB_SPIN_CAP (1u << 18)

__device__ __forceinline__ unsigned xb_ld(unsigned* p)              { return __hip_atomic_load(p, __ATOMIC_RELAXED, __HIP_MEMORY_SCOPE_AGENT); }
__device__ __forceinline__ unsigned xb_add(unsigned* p, unsigned v) { return __hip_atomic_fetch_add(p, v, __ATOMIC_RELAXED, __HIP_MEMORY_SCOPE_AGENT); }
__device__ __forceinline__ unsigned xb_xcc_id() { return (unsigned)__builtin_amdgcn_s_getreg((3 << 11) | 20) & 0xFu; }
#define XB_SPIN(cond, bar) do { unsigned _sp = 0; while (cond) { __builtin_amdgcn_s_sleep(1); \
    if ((++_sp & 255u) == 0u) { if (xb_ld(&(bar)[XB_TMO])) break; if (_sp > XB_SPIN_CAP) { atomicAdd(&(bar)[XB_TMO], 1u); break; } } } } while (0)

struct XcdBarrier {
    unsigned* bar; unsigned x;
    volatile LAS unsigned* st;
};

__device__ __forceinline__ XcdBarrier xcd_barrier_post(unsigned* bar, volatile LAS unsigned* st) {
    XcdBarrier b; b.bar = bar; b.x = xb_xcc_id(); b.st = st;
    if (threadIdx.x == 0) (void)xb_add(&bar[XB_XCNT(b.x)], 1u);
    return b;
}
__device__ __forceinline__ void xcd_barrier_complete(unsigned* bar, unsigned x, unsigned& nloc, unsigned& nx) {
    const unsigned G = gridDim.x * gridDim.y * gridDim.z;
    unsigned sum, cnt, mine, sp = 0u;
    for (;;) {
        sum = 0u; cnt = 0u; mine = 0u;
#pragma unroll
        for (unsigned j = 0; j < 16; ++j) { const unsigned c = xb_ld(&bar[XB_XCNT(j)]); sum += c; cnt += (c > 0u) ? 1u : 0u; mine = (j == x) ? c : mine; }
        if (sum == G) break;
        __builtin_amdgcn_s_sleep(1);
        if ((++sp & 255u) == 0u) { if (xb_ld(&bar[XB_TMO])) break; if (sp > XB_SPIN_CAP) { atomicAdd(&bar[XB_TMO], 1u); break; } }
    }
    nloc = mine > 0u ? mine : 1u; nx = cnt > 0u ? cnt : 1u;
}

__device__ __forceinline__ void xcd_barrier(const XcdBarrier& b) {
    asm volatile("s_waitcnt vmcnt(0)" ::: "memory");
    __syncthreads();
    if (threadIdx.x == 0) {
        unsigned* bar = b.bar;
        __builtin_amdgcn_s_waitcnt(0);
        unsigned nloc = b.st[0], nx = b.st[1];
        if (nloc == 0u) { xcd_barrier_complete(bar, b.x, nloc, nx); b.st[0] = nloc; b.st[1] = nx; }
        const unsigned old = xb_add(&bar[XB_XSUB(b.x)], 1u);
        const unsigned gen = old / nloc;
        if (old + 1u == (gen + 1u) * nloc) {
            __builtin_amdgcn_fence(__ATOMIC_RELEASE, "agent");
            asm volatile("s_waitcnt vmcnt(0)" ::: "memory");
            const unsigned og = xb_add(&bar[XB_TOP], 1u);
            const unsigned tg = og / nx;
            if (og + 1u == (tg + 1u) * nx) xb_add(&bar[XB_TOPGEN], 1u);
            else XB_SPIN(xb_ld(&bar[XB_TOPGEN]) == tg, bar);
            __builtin_amdgcn_fence(__ATOMIC_ACQUIRE, "agent");
            xb_add(&bar[XB_XGEN(b.x)], 1u);
            asm volatile("s_waitcnt vmcnt(0)" ::: "memory");
        } else {
            XB_SPIN(xb_ld(&bar[XB_XGEN(b.x)]) == gen, bar);
            __builtin_amdgcn_fence(__ATOMIC_ACQUIRE, "agent");
            asm volatile("s_waitcnt vmcnt(0)" ::: "memory");
        }
    }
    __syncthreads();
}


#ifndef PG8_SP2
#define PG8_SP2 true
#endif
#ifndef PG8_ALIGN
#define PG8_ALIGN true
#endif
constexpr int D = 1024, NB = 8, SEQ = 4096, T = NB * SEQ, NL = 4;
constexpr int NIN = 8704, NE = 32, FF = 1024;
constexpr int RMAX = 139264;
constexpr float LN_EPS = 1e-5f, DN_ALPHA = 1.681792830507429f;
constexpr float QSCALE = 0.18033688011112042f;
constexpr float LOG2E = 1.4426950408889634f;

constexpr size_t MiB = 1u << 20;
constexpr size_t WS_CTL = 0, CTL_ZERO_BYTES = 1 * MiB;
constexpr size_t WS_MOD = 1 * MiB;
constexpr size_t WS_ROPE = 2 * MiB;
constexpr size_t WS_WSP = 3 * MiB;
constexpr size_t WS_WRT = 4 * MiB;
constexpr size_t WS_TOKINFO = 5 * MiB;
constexpr size_t WS_TOKW = 5 * MiB + 512 * 1024;
constexpr size_t WS_ROWTOK = 6 * MiB;
constexpr size_t WS_ROWW = 7 * MiB;
constexpr size_t WS_LSE = 8 * MiB;
constexpr size_t WS_TOKROW = 14 * MiB;
constexpr size_t WS_STAT = 13 * MiB;
constexpr size_t WS_WGCNT = 12 * MiB;
constexpr size_t WS_WIN = 16 * MiB;
constexpr size_t WS_WBA = 84 * MiB;
constexpr size_t WS_WBB = 92 * MiB;
constexpr size_t WS_WOUT = 96 * MiB;
constexpr size_t WS_WUP = 104 * MiB;
constexpr size_t WS_WDN = 616 * MiB;
constexpr size_t WS_H = 872 * MiB;
constexpr size_t WS_X1 = 936 * MiB;
constexpr size_t WS_X2 = 1064 * MiB;
constexpr size_t WS_YPRE = 1192 * MiB;
constexpr size_t WS_U = 1320 * MiB, WS_V = 1384 * MiB;
constexpr size_t WS_Q = 1448 * MiB, WS_K = 1544 * MiB, WS_VV = 1640 * MiB;
constexpr size_t WS_G = 1736 * MiB;
constexpr size_t WS_OG = 1864 * MiB;
constexpr size_t WS_TT = 1960 * MiB;
constexpr size_t WS_OB = 2024 * MiB;
constexpr size_t WS_YA = 2056 * MiB;
constexpr size_t WS_MG = 2120 * MiB;
constexpr size_t WS_XG = 2184 * MiB;
constexpr size_t WS_ACT = 2456 * MiB;
constexpr size_t WS_YK = 2728 * MiB;
constexpr size_t WS_END = 2984 * MiB;
constexpr int CW_BAR = 4096;
constexpr int CW_CNT = 16384;

constexpr int RING_BYTES = 131072;
constexpr int XOFF = RING_BYTES;
constexpr int X_MISC = XOFF;
constexpr int X_SELE = XOFF + 256;
constexpr int X_SELR = XOFF + 2304;
constexpr int X_CNTL = XOFF + 4352;
constexpr int X_BASE = XOFF + 4480;
constexpr int X_TILEE = XOFF + 4608;
constexpr int X_CNTS = XOFF + 5632;
constexpr int X_OFFS = XOFF + 5760;
constexpr int LDS_BYTES = 147456;

#define GAS __attribute__((address_space(1)))
typedef unsigned short bf16;
typedef unsigned v4u __attribute__((ext_vector_type(4)));
typedef unsigned v2u __attribute__((ext_vector_type(2)));
typedef float f32x4 __attribute__((ext_vector_type(4)));
typedef short bf16x8 __attribute__((ext_vector_type(8)));
typedef short s16x4 __attribute__((ext_vector_type(4)));
#define RLX_AGENT __ATOMIC_RELAXED, __HIP_MEMORY_SCOPE_AGENT
#define LDS_WAIT() asm volatile("s_waitcnt lgkmcnt(0)" ::: "memory")
#define VM_WAIT() asm volatile("s_waitcnt vmcnt(0)" ::: "memory")

typedef __bf16 bf16x2_t __attribute__((ext_vector_type(2))); typedef float f32x2_t __attribute__((ext_vector_type(2)));
__device__ __forceinline__ unsigned pk2(float lo, float hi) { return __builtin_bit_cast(unsigned, __builtin_convertvector((f32x2_t){lo, hi}, bf16x2_t)); }
__device__ __forceinline__ float bflo(unsigned w) { return __uint_as_float(w << 16); }
__device__ __forceinline__ float bfhi(unsigned w) { return __uint_as_float(w & 0xffff0000u); }
__device__ __forceinline__ float fexp2(float x) { return __builtin_amdgcn_exp2f(x); }
__device__ __forceinline__ float frcp(float x) { return __builtin_amdgcn_rcpf(x); }
__device__ __forceinline__ float gelu_tanh(float x) { const float u = x + 0.044715f * x * x * x; return x * frcp(1.0f + fexp2(-2.302208198144325f * u)); }
__device__ __forceinline__ float sigmoidf_(float x) { return frcp(1.0f + fexp2(-LOG2E * x)); }
__device__ __forceinline__ float wave_sum(float v) {
#pragma unroll
    for (int o = 1; o < 64; o <<= 1) v += __shfl_xor(v, o);
    return v;
}
__device__ __forceinline__ float wave_max(float v) {
#pragma unroll
    for (int o = 1; o < 64; o <<= 1) v = fmaxf(v, __shfl_xor(v, o));
    return v;
}
__device__ __forceinline__ s16x4 tr16(const LAS unsigned char* p) { return __builtin_bit_cast(s16x4, __builtin_amdgcn_ds_read_tr16_b64_v4i16((LAS s16x4*)p)); }
__device__ __forceinline__ bf16x8 cat8(s16x4 lo, s16x4 hi) { return (bf16x8){lo[0], lo[1], lo[2], lo[3], hi[0], hi[1], hi[2], hi[3]}; }
__device__ __forceinline__ f32x4 mfma16(bf16x8 a, bf16x8 b, f32x4 c) { return __builtin_amdgcn_mfma_f32_16x16x32_bf16(a, b, c, 0, 0, 0); }

struct Frame {
    LAS unsigned char* lds;
    int tid, lane, wave, G, vcu, bx;
    unsigned char* ws;
    const float* const* in;
    float* out;
};
enum { I_X = 0, I_C, I_WADA, I_BADA, I_WIN, I_SPW, I_SPB, I_WBA, I_WBB, I_WOUT, I_LN1G, I_LN1B, I_WR, I_BR, I_WUP, I_BUP, I_WDN, I_BDN, I_LN2G, I_LN2B };
template <class Tp> __device__ __forceinline__ Tp* wsp(const Frame& F, size_t off) { return (Tp*)(F.ws + off); }

template <class P> __device__ __forceinline__ P launder(P p) { unsigned lo = (unsigned)(uintptr_t)p, hi = (unsigned)((uintptr_t)p >> 32); asm volatile("" : "+v"(lo), "+v"(hi));
    lo = (unsigned)__builtin_amdgcn_readfirstlane((int)lo); hi = (unsigned)__builtin_amdgcn_readfirstlane((int)hi); return (P)(((uintptr_t)hi << 32) | (uintptr_t)lo); }
struct EpiIn {
    static constexpr int MID_T = 0; static constexpr bool PERM = true, AFTER_DRAIN = false;
    bf16 *U, *V, *Q, *K, *VV, *Gt; const float* rope;
    __device__ __forceinline__ void operator()(const f32x4 (&acc)[2][2][4][2], const pg8::Unit& u, int wr, int wc, int fr, int fq) const {
        const int pn = u.pn; int type, ld, colt; bf16* base;
        if (pn < 4) { type = 0; base = U; ld = 1024; colt = pn * 256; }
        else if (pn < 8) { type = 0; base = V; ld = 1024; colt = (pn - 4) * 256; }
        else if (pn < 14) { type = 1; base = Q; ld = 1536; colt = (pn - 8) * 256; }
        else if (pn < 20) { type = 2; base = K; ld = 1536; colt = (pn - 14) * 256; }
        else if (pn < 26) { type = 3; base = VV; ld = 1536; colt = (pn - 20) * 256; }
        else { type = 4; base = Gt; ld = 2048; colt = (pn - 26) * 256; }
        const int row0 = u.pm * 256 + wr * 64 + fr, col0 = colt + wc * 32 + 8 * fq;
        if (type == 0) {
#pragma unroll
            for (int ai = 0; ai < 2; ++ai)
#pragma unroll
                for (int m = 0; m < 4; ++m) { bf16* rowp = base + (size_t)(row0 + ai * 128 + m * 16) * ld + col0;
#pragma unroll
                    for (int bj = 0; bj < 2; ++bj) { const f32x4 v0 = acc[ai][bj][m][0], v1 = acc[ai][bj][m][1]; v4u w;
                        w.x = pk2(gelu_tanh(v0[0]), gelu_tanh(v0[1])); w.y = pk2(gelu_tanh(v0[2]), gelu_tanh(v0[3]));
                        w.z = pk2(gelu_tanh(v1[0]), gelu_tanh(v1[1])); w.w = pk2(gelu_tanh(v1[2]), gelu_tanh(v1[3]));
                        __builtin_nontemporal_store(w, (v4u*)(rowp + bj * 128)); } }
        } else if (type == 4) {
#pragma unroll
            for (int ai = 0; ai < 2; ++ai)
#pragma unroll
                for (int m = 0; m < 4; ++m) { bf16* rowp = base + (size_t)(row0 + ai * 128 + m * 16) * ld + col0;
#pragma unroll
                    for (int bj = 0; bj < 2; ++bj) { const f32x4 v0 = acc[ai][bj][m][0], v1 = acc[ai][bj][m][1]; v4u w;
                        w.x = pk2(sigmoidf_(v0[0]), sigmoidf_(v0[1])); w.y = pk2(sigmoidf_(v0[2]), sigmoidf_(v0[3]));
                        w.z = pk2(sigmoidf_(v1[0]), sigmoidf_(v1[1])); w.w = pk2(sigmoidf_(v1[2]), sigmoidf_(v1[3]));
                        __builtin_nontemporal_store(w, (v4u*)(rowp + bj * 128)); } }
        } else if (type == 3) {
#pragma unroll
            for (int ai = 0; ai < 2; ++ai)
#pragma unroll
                for (int m = 0; m < 4; ++m) { bf16* rowp = base + (size_t)(row0 + ai * 128 + m * 16) * ld + col0;
#pragma unroll
                    for (int bj = 0; bj < 2; ++bj) { const f32x4 v0 = acc[ai][bj][m][0], v1 = acc[ai][bj][m][1]; v4u w;
                        w.x = pk2(v0[0], v0[1]); w.y = pk2(v0[2], v0[3]); w.z = pk2(v1[0], v1[1]); w.w = pk2(v1[2], v1[3]);
                        __builtin_nontemporal_store(w, (v4u*)(rowp + bj * 128)); } }
        } else {
            const float sc = (type == 1) ? QSCALE : 1.0f;
            const bool ropew = (wc & 1) == 0;
#pragma unroll
            for (int ai = 0; ai < 2; ++ai)
#pragma unroll
                for (int m = 0; m < 4; ++m) { const int row = row0 + ai * 128 + m * 16; bf16* rowp = base + (size_t)row * ld + col0;
                    float cs[8], sn[8];
                    if (ropew) { const f32x4* rp = (const f32x4*)(rope + (size_t)(row & (SEQ - 1)) * 16); const f32x4 c0 = rp[0], c1 = rp[1], s0 = rp[2], s1 = rp[3];
#pragma unroll
                        for (int e = 0; e < 4; ++e) { cs[e] = c0[e]; cs[4 + e] = c1[e]; sn[e] = s0[e]; sn[4 + e] = s1[e]; } }
#pragma unroll
                    for (int bj = 0; bj < 2; ++bj) { f32x4 v0 = acc[ai][bj][m][0], v1 = acc[ai][bj][m][1];
                        if (ropew) {
#pragma unroll
                            for (int e = 0; e < 8; ++e) { const float x = (e < 4) ? v0[e & 3] : v1[e & 3]; const float p = __shfl_xor(x, 16);
                                float y = x;
                                if (fq == 0) y = x * cs[e] - p * sn[e];
                                if (fq == 1) y = x * cs[e] + p * sn[e];
                                if (e < 4) v0[e & 3] = y; else v1[e & 3] = y; } }
                        v4u w; w.x = pk2(v0[0] * sc, v0[1] * sc); w.y = pk2(v0[2] * sc, v0[3] * sc); w.z = pk2(v1[0] * sc, v1[1] * sc); w.w = pk2(v1[2] * sc, v1[3] * sc);
                        __builtin_nontemporal_store(w, (v4u*)(rowp + bj * 128)); } }
        }
    }
};
struct EpiProbe {
    static constexpr int MID_T = 0; static constexpr bool PERM = true, AFTER_DRAIN = false;
    bf16* O; int ld; int on;
    __device__ __forceinline__ void operator()(const f32x4 (&acc)[2][2][4][2], const pg8::Unit& u, int wr, int wc, int fr, int fq) const {
        if (!on) return;
        const int row0 = u.pm * 256 + wr * 64 + fr, col0 = ((on == 3) ? u.pn : (u.pn & 3)) * 256 + wc * 32 + 8 * fq;
#pragma unroll
        for (int ai = 0; ai < 2; ++ai)
#pragma unroll
            for (int m = 0; m < 4; ++m) { bf16* rowp = O + (size_t)(row0 + ai * 128 + m * 16) * ld + col0;
#pragma unroll
                for (int bj = 0; bj < 2; ++bj) { const f32x4 v0 = acc[ai][bj][m][0], v1 = acc[ai][bj][m][1]; v4u w;
                    w.x = pk2(v0[0], v0[1]); w.y = pk2(v0[2], v0[3]); w.z = pk2(v1[0], v1[1]); w.w = pk2(v1[2], v1[3]);
                    *(v4u*)(rowp + bj * 128) = w; } }
    }
};
struct EpiYA {
    static constexpr int MID_T = 0; static constexpr bool PERM = true, AFTER_DRAIN = false;
    const bf16* Gt; bf16* YA;
    __device__ __forceinline__ void operator()(const f32x4 (&acc)[2][2][4][2], const pg8::Unit& u, int wr, int wc, int fr, int fq) const {
        const int row0 = u.pm * 256 + wr * 64 + fr, col0 = u.pn * 256 + wc * 32 + 8 * fq;
#pragma unroll
        for (int ai = 0; ai < 2; ++ai)
#pragma unroll
            for (int m = 0; m < 4; ++m) { const size_t row = (size_t)(row0 + ai * 128 + m * 16);
#pragma unroll
                for (int bj = 0; bj < 2; ++bj) { const f32x4 v0 = acc[ai][bj][m][0], v1 = acc[ai][bj][m][1];
                    const v4u g = *(const v4u*)(Gt + row * 2048 + col0 + bj * 128); v4u w;
                    w.x = pk2(v0[0] * bflo(g.x), v0[1] * bfhi(g.x)); w.y = pk2(v0[2] * bflo(g.y), v0[3] * bfhi(g.y));
                    w.z = pk2(v1[0] * bflo(g.z), v1[1] * bfhi(g.z)); w.w = pk2(v1[2] * bflo(g.w), v1[3] * bfhi(g.w));
                    *(v4u*)(YA + row * 1024 + col0 + bj * 128) = w; } }
    }
};
struct EpiMg {
    static constexpr int MID_T = 0; static constexpr bool PERM = true, AFTER_DRAIN = false;
    const bf16* Gt; const bf16* YA; bf16* MG;
    __device__ __forceinline__ void operator()(const f32x4 (&acc)[2][2][4][2], const pg8::Unit& u, int wr, int wc, int fr, int fq) const {
        const int row0 = u.pm * 256 + wr * 64 + fr, col0 = u.pn * 256 + wc * 32 + 8 * fq;
#pragma unroll
        for (int ai = 0; ai < 2; ++ai)
#pragma unroll
            for (int m = 0; m < 4; ++m) { const size_t row = (size_t)(row0 + ai * 128 + m * 16);
#pragma unroll
                for (int bj = 0; bj < 2; ++bj) { const f32x4 v0 = acc[ai][bj][m][0], v1 = acc[ai][bj][m][1];
                    const v4u g = *(const v4u*)(Gt + row * 2048 + 1024 + col0 + bj * 128); const v4u y = *(const v4u*)(YA + row * 1024 + col0 + bj * 128); v4u w;
                    w.x = pk2(bflo(y.x) + v0[0] * bflo(g.x), bfhi(y.x) + v0[1] * bfhi(g.x)); w.y = pk2(bflo(y.y) + v0[2] * bflo(g.y), bfhi(y.y) + v0[3] * bfhi(g.y));
                    w.z = pk2(bflo(y.z) + v1[0] * bflo(g.z), bfhi(y.z) + v1[1] * bfhi(g.z)); w.w = pk2(bflo(y.w) + v1[2] * bflo(g.w), bfhi(y.w) + v1[3] * bfhi(g.w));
                    *(v4u*)(MG + row * 1024 + col0 + bj * 128) = w; } }
    }
};
struct EpiMg2 {
    static constexpr int MID_T = 16; static constexpr bool PERM = true, AFTER_DRAIN = false;
    const bf16* Gt; bf16* MG;
    __device__ __forceinline__ void mid(f32x4 (&acc)[2][2][4][2], const pg8::Unit& u, int wr, int wc, int fr, int fq) const {
        int row0 = u.pm * 256 + wr * 64 + fr; const int col0 = u.pn * 256 + wc * 32 + 8 * fq;
        asm volatile("" : "+v"(row0));
#pragma unroll
        for (int ai = 0; ai < 2; ++ai)
#pragma unroll
            for (int m = 0; m < 4; ++m) { const size_t row = (size_t)(row0 + ai * 128 + m * 16);
#pragma unroll
                for (int bj = 0; bj < 2; ++bj) { const v4u g0 = *(const v4u*)(Gt + row * 2048 + col0 + bj * 128), g1 = *(const v4u*)(Gt + row * 2048 + 1024 + col0 + bj * 128);
                    const unsigned a0[4] = {g0.x, g0.y, g0.z, g0.w}, a1[4] = {g1.x, g1.y, g1.z, g1.w};
#pragma unroll
                    for (int q = 0; q < 4; ++q) { const float r0 = bflo(a0[q]) * frcp(fmaxf(bflo(a1[q]), 1e-20f)), r1 = bfhi(a0[q]) * frcp(fmaxf(bfhi(a1[q]), 1e-20f));
                        acc[ai][bj][m][q >> 1][(q & 1) * 2] *= r0; acc[ai][bj][m][q >> 1][(q & 1) * 2 + 1] *= r1; } }
                if (m == 3) asm volatile("" ::: "memory"); }
    }
    __device__ __forceinline__ void operator()(const f32x4 (&acc)[2][2][4][2], const pg8::Unit& u, int wr, int wc, int fr, int fq) const {
        const int row0 = u.pm * 256 + wr * 64 + fr, col0 = u.pn * 256 + wc * 32 + 8 * fq;
#pragma unroll
        for (int ai = 0; ai < 2; ++ai)
#pragma unroll
            for (int m = 0; m < 4; ++m) { const size_t row = (size_t)(row0 + ai * 128 + m * 16);
#pragma unroll
                for (int bj = 0; bj < 2; ++bj) { const f32x4 v0 = acc[ai][bj][m][0], v1 = acc[ai][bj][m][1];
                    const v4u g = *(const v4u*)(Gt + row * 2048 + 1024 + col0 + bj * 128); v4u w;
                    w.x = pk2(v0[0] * fmaxf(bflo(g.x), 1e-20f), v0[1] * fmaxf(bfhi(g.x), 1e-20f)); w.y = pk2(v0[2] * fmaxf(bflo(g.y), 1e-20f), v0[3] * fmaxf(bfhi(g.y), 1e-20f));
                    w.z = pk2(v1[0] * fmaxf(bflo(g.z), 1e-20f), v1[1] * fmaxf(bfhi(g.z), 1e-20f)); w.w = pk2(v1[2] * fmaxf(bflo(g.w), 1e-20f), v1[3] * fmaxf(bfhi(g.w), 1e-20f));
                    *(v4u*)(MG + row * 1024 + col0 + bj * 128) = w; } }
    }
};
template <bool XF32> struct EpiOut {
    static constexpr int MID_T = 0; static constexpr bool PERM = true, AFTER_DRAIN = false;
    const void* xres; const float* modl  ; bf16* YPRE;
    __device__ __forceinline__ void operator()(const f32x4 (&acc)[2][2][4][2], const pg8::Unit& u, int wr, int wc, int fr, int fq) const {
        const int row0 = u.pm * 256 + wr * 64 + fr, col0 = u.pn * 256 + wc * 32 + 8 * fq; const int b = (u.pm * 256) >> 12;
        f32x4 gg[2][2];
#pragma unroll
        for (int bj = 0; bj < 2; ++bj)
#pragma unroll
            for (int n = 0; n < 2; ++n) gg[bj][n] = *(const f32x4*)(modl + (size_t)b * 6144 + 2048 + col0 + bj * 128 + 4 * n) + 1.0f;
#pragma unroll
        for (int ai = 0; ai < 2; ++ai)
#pragma unroll
            for (int m = 0; m < 4; ++m) { const size_t off = (size_t)(row0 + ai * 128 + m * 16) * 1024 + col0;
#pragma unroll
                for (int bj = 0; bj < 2; ++bj) { f32x4 x0, x1;
                    if (XF32) { x0 = *(const f32x4*)((const float*)xres + off + bj * 128); x1 = *(const f32x4*)((const float*)xres + off + bj * 128 + 4); }
                    else { const v4u xr = *(const v4u*)((const bf16*)xres + off + bj * 128); x0 = (f32x4){bflo(xr.x), bfhi(xr.x), bflo(xr.y), bfhi(xr.y)}; x1 = (f32x4){bflo(xr.z), bfhi(xr.z), bflo(xr.w), bfhi(xr.w)}; }
                    const f32x4 o0 = x0 * DN_ALPHA + gg[bj][0] * acc[ai][bj][m][0], o1 = x1 * DN_ALPHA + gg[bj][1] * acc[ai][bj][m][1];
                    v4u w; w.x = pk2(o0[0], o0[1]); w.y = pk2(o0[2], o0[3]); w.z = pk2(o1[0], o1[1]); w.w = pk2(o1[2], o1[3]);
                    *(v4u*)(YPRE + off + bj * 128) = w; }
                if (m == 3) asm volatile("" ::: "memory"); }
    }
};
struct EpiUp {
    static constexpr int MID_T = 0; static constexpr bool PERM = true, AFTER_DRAIN = false;
    const float* bup  ; bf16* ACT;
    __device__ __forceinline__ void operator()(const f32x4 (&acc)[2][2][4][2], const pg8::Unit& u, int wr, int wc, int fr, int fq) const {
        const int e = u.pn >> 3, pnl = u.pn & 7; const int row0 = u.pm * 256 + wr * 64 + fr, ac0 = pnl * 128 + wc * 32 + 8 * fq;
        const f32x4* bp = (const f32x4*)(bup + (size_t)e * 2048 + 2 * ac0); const f32x4 b0 = bp[0], b1 = bp[1], b2 = bp[2], b3 = bp[3];
        const float bg[8] = {b0[0], b0[2], b1[0], b1[2], b2[0], b2[2], b3[0], b3[2]}, bl[8] = {b0[1], b0[3], b1[1], b1[3], b2[1], b2[3], b3[1], b3[3]};
#pragma unroll
        for (int ai = 0; ai < 2; ++ai)
#pragma unroll
            for (int m = 0; m < 4; ++m) { float a[8];
#pragma unroll
                for (int j = 0; j < 8; ++j) { const float hg = acc[ai][0][m][j >> 2][j & 3] + bg[j], hl = acc[ai][1][m][j >> 2][j & 3] + bl[j];
                    const float glu = fminf(hg, 7.0f), lin = fminf(fmaxf(hl, -7.0f), 7.0f);
                    a[j] = glu * frcp(1.0f + fexp2(-2.4554669595930156f * glu)) * (lin + 1.0f); }
                v4u w; w.x = pk2(a[0], a[1]); w.y = pk2(a[2], a[3]); w.z = pk2(a[4], a[5]); w.w = pk2(a[6], a[7]);
                *(v4u*)(ACT + (size_t)(row0 + ai * 128 + m * 16) * 1024 + ac0) = w; }
    }
};
struct EpiDn {
    static constexpr int MID_T = 0; static constexpr bool PERM = true, AFTER_DRAIN = false;
    const float* bdn  ; bf16* YKS;
    __device__ __forceinline__ void operator()(const f32x4 (&acc)[2][2][4][2], const pg8::Unit& u, int wr, int wc, int fr, int fq) const {
        const int e = u.pn >> 2, pnl = u.pn & 3; const int row0 = u.pm * 256 + wr * 64 + fr, col0 = pnl * 256 + wc * 32 + 8 * fq;
        f32x4 bv[2][2];
#pragma unroll
        for (int bj = 0; bj < 2; ++bj)
#pragma unroll
            for (int n = 0; n < 2; ++n) bv[bj][n] = *(const f32x4*)(bdn + (size_t)e * 1024 + col0 + bj * 128 + 4 * n);
#pragma unroll
        for (int ai = 0; ai < 2; ++ai)
#pragma unroll
            for (int m = 0; m < 4; ++m) { bf16* op = YKS + (size_t)(row0 + ai * 128 + m * 16) * 1024 + col0;
#pragma unroll
                for (int bj = 0; bj < 2; ++bj) { const f32x4 v0 = acc[ai][bj][m][0] + bv[bj][0], v1 = acc[ai][bj][m][1] + bv[bj][1]; v4u w;
                    w.x = pk2(v0[0], v0[1]); w.y = pk2(v0[2], v0[3]); w.z = pk2(v1[0], v1[1]); w.w = pk2(v1[2], v1[3]);
                    *(v4u*)(op + bj * 128) = w; } }
    }
};
struct MoeOrder {
    static constexpr bool GATHER = false; __device__ __forceinline__ int arow(int, int r) const { return r; }
    int nM, nN, nwg, G, c, rev; const LAS unsigned char* tile_e;
    __device__ void init(int RT, int NN, int G_, int c_, const LAS unsigned char* te, int rev_ = 0) { nM = RT; nN = NN; nwg = RT * NN; G = G_; c = c_; tile_e = te; rev = rev_; }
    __device__ bool next(int i, pg8::Unit& u) const {
        const long L = (long)i * G + c; if (L >= nwg) return false;
        int wgid = (int)L; { const int q = nwg / pg8::NXCD, r = nwg % pg8::NXCD, xcd = wgid % pg8::NXCD, off = wgid / pg8::NXCD; wgid = (xcd < r ? xcd * (q + 1) : r * (q + 1) + (xcd - r) * q) + off; }
        const int nig = pg8::WGM * nN, gid = wgid / nig, fm = gid * pg8::WGM, gsz = (nM - fm) < pg8::WGM ? (nM - fm) : pg8::WGM;
        int pm = fm + ((wgid % nig) % gsz); const int pnl = (wgid % nig) / gsz; if (rev) pm = nM - 1 - pm;
        u.pm = pm; u.pn = (int)tile_e[pm] * nN + pnl; return true;
    }
    __device__ __forceinline__ void a_ready(const pg8::Unit&) const {}
    __device__ __forceinline__ void done(const pg8::Unit&) const {}
};

#ifndef STAG_N
#define STAG_N 1
#endif
#ifndef STAG_US
#define STAG_US 24
#endif
__device__ __forceinline__ void stagger(int slot, int us) {
    if (STAG_N <= 1) return;
    const unsigned long long t0 = __builtin_amdgcn_s_memrealtime(); const unsigned long long ticks = (unsigned long long)(slot % STAG_N) * (unsigned)us * 100ull / STAG_N;
    while (__builtin_amdgcn_s_memrealtime() - t0 < ticks) __builtin_amdgcn_s_sleep(16);
}
struct MoeGatherOrder : MoeOrder {
    static constexpr bool GATHER = true; const LAS unsigned short* tokl;
    __device__ __forceinline__ int arow(int ord, int r) const { return (int)tokl[ord * 256 + (r & 255)]; }
};
constexpr int X_TOKL = XOFF + 6144, TOKL_UNITS = 20;
constexpr int TR_NR = 32, TR_WAVE_BYTES = 64 * 64 * 4;
struct TrItem { const float* src; bf16* dst; int ld, K, kind, k0, c0, koff; };
__device__ __forceinline__ void tr_load(const TrItem& t, int lane, f32x4 (&r)[TR_NR]) {
    const int kq = lane >> 4, cc = lane & 15;
#pragma unroll
    for (int i = 0; i < TR_NR; ++i) r[i] = *(const f32x4*)(t.src + (size_t)(t.k0 + 2 * (kq + 4 * (i >> 1)) + (i & 1)) * t.ld + t.c0 + 4 * cc);
}
__device__ __forceinline__ void tr_tile(int lane, LAS unsigned* scr, const f32x4 (&r)[TR_NR]) {
    const int kq = lane >> 4, cc = lane & 15;
#pragma unroll
    for (int i2 = 0; i2 < TR_NR / 2; ++i2) { LAS unsigned* p = scr + (4 * cc) * 64 + ((kq + 4 * i2) ^ (cc << 2));
#pragma unroll
        for (int e = 0; e < 4; ++e) p[e * 64] = pk2(r[2 * i2][e], r[2 * i2 + 1][e]); }
    LDS_WAIT(); asm volatile("" ::: "memory");
}
__device__ __forceinline__ void tr_store(const TrItem& t, int lane, const LAS unsigned* scr) {
    const int c = lane & 15;
    const int pbase = (t.kind == 0) ? t.c0 : (256 * (t.c0 >> 8) + ((t.c0 & 255) >> 1));
#pragma unroll
    for (int j = 0; j < 16; ++j) { const int n = (lane >> 4) + 4 * j; const v4u o = *(const LAS v4u*)(scr + n * 64 + ((c ^ j) << 2));
        const int drow = (t.kind == 0) ? (pbase + n) : (pbase + 128 * (n & 1) + (n >> 1));
        __builtin_nontemporal_store(o, (v4u*)(t.dst + (size_t)drow * t.K + t.koff + t.k0 + 8 * c)); }
    LDS_WAIT(); asm volatile("" ::: "memory");
}
__device__ __forceinline__ void sincos_d(double a, double& s, double& c) {
    const double k = rint(a * 0.63661977236758134308);
    const double y = fma(-k, 6.12323399573676603587e-17, fma(-k, 1.57079632679489655800, a));
    const double y2 = y * y;
    double sp = -7.6471637318198164759e-13; sp = fma(sp, y2, 1.6059043836821614599e-10); sp = fma(sp, y2, -2.5052108385441718775e-8); sp = fma(sp, y2, 2.7557319223985890653e-6);
    sp = fma(sp, y2, -1.9841269841269841270e-4); sp = fma(sp, y2, 8.3333333333333333333e-3); sp = fma(sp, y2, -1.6666666666666666667e-1); const double sy = fma(sp * y2, y, y);
    double cp = 4.7794773323873852974e-14; cp = fma(cp, y2, -1.1470745597729724714e-11); cp = fma(cp, y2, 2.0876756987868098979e-9); cp = fma(cp, y2, -2.7557319223985890653e-7);
    cp = fma(cp, y2, 2.4801587301587301587e-5); cp = fma(cp, y2, -1.3888888888888888889e-3); cp = fma(cp, y2, 4.1666666666666666667e-2); cp = fma(cp, y2, -0.5); const double cy = fma(cp, y2, 1.0);
    const int q = ((int)k) & 3;
    s = (q == 0) ? sy : (q == 1) ? cy : (q == 2) ? -sy : -cy;
    c = (q == 0) ? cy : (q == 1) ? -sy : (q == 2) ? -cy : sy;
}
__device__ __forceinline__ void phase_pro_a(Frame& F) {
    LAS unsigned* scr = (LAS unsigned*)(F.lds + F.wave * TR_WAVE_BYTES);
    const int gw = F.vcu * 8 + F.wave, NGW = F.G * 8;
    constexpr int I_IN = 8 * 136, I_SQ = 8 * 16, I_BB = 4 * 16, I_UP = 8 * 32;
    constexpr int S0 = NL * I_IN, S1 = S0 + NL * I_SQ, S2 = S1 + NL * I_BB, S3 = S2 + NL * I_SQ, S4 = S3 + NL * NE * I_SQ, S5 = S4 + NL * NE * I_UP;
    auto decode = [&](int it) -> TrItem { TrItem t; t.koff = 0;
        if (it < S0) { const int l = it / I_IN, r = it % I_IN; t.src = F.in[I_WIN] + (size_t)l * D * NIN; t.dst = wsp<bf16>(F, WS_WIN) + (size_t)l * NIN * D; t.ld = NIN; t.K = D; t.kind = 0; t.k0 = 128 * (r / 136); t.c0 = 64 * (r % 136); }
        else if (it < S1) { const int q = it - S0, l = q / I_SQ, r = q % I_SQ; t.src = F.in[I_WBA] + (size_t)l * D * D; t.dst = wsp<bf16>(F, WS_WBA) + (size_t)l * D * 1536; t.ld = D; t.K = 1536; t.kind = 0; t.k0 = 128 * (r / 16); t.c0 = 64 * (r % 16); }
        else if (it < S2) { const int q = it - S1, l = q / I_BB, r = q % I_BB; t.src = F.in[I_WBB] + (size_t)l * 512 * D; t.dst = wsp<bf16>(F, WS_WBA) + (size_t)l * D * 1536; t.ld = D; t.K = 1536; t.koff = 1024; t.kind = 0; t.k0 = 128 * (r / 16); t.c0 = 64 * (r % 16); }
        else if (it < S3) { const int q = it - S2, l = q / I_SQ, r = q % I_SQ; t.src = F.in[I_WOUT] + (size_t)l * D * D; t.dst = wsp<bf16>(F, WS_WOUT) + (size_t)l * D * D; t.ld = D; t.K = D; t.kind = 0; t.k0 = 128 * (r / 16); t.c0 = 64 * (r % 16); }
        else if (it < S4) { const int q = it - S3, le = q / I_SQ, r = q % I_SQ; t.src = F.in[I_WDN] + (size_t)le * FF * D; t.dst = wsp<bf16>(F, WS_WDN) + (size_t)le * D * FF; t.ld = D; t.K = FF; t.kind = 0; t.k0 = 128 * (r / 16); t.c0 = 64 * (r % 16); }
        else { const int q = it - S4, le = q / I_UP, r = q % I_UP; t.src = F.in[I_WUP] + (size_t)le * D * 2048; t.dst = wsp<bf16>(F, WS_WUP) + (size_t)le * 2048 * D; t.ld = 2048; t.K = D; t.kind = 1; t.k0 = 128 * (r / 32); t.c0 = 64 * (r % 32); }
        return t; };
    {
        f32x4 rn[TR_NR]; TrItem tn; int it = gw;
        if (it < S5) { tn = decode(it); tr_load(tn, F.lane, rn); }
#pragma unroll 1
        for (; it < S5; it += NGW) {
            const TrItem tc = tn;
            tr_tile(F.lane, scr, rn);
            if (it + NGW < S5) { tn = decode(it + NGW); tr_load(tn, F.lane, rn); }
            tr_store(tc, F.lane, scr);
        }
    }
    __syncthreads();
    {
        LAS float* cT = (LAS float*)F.lds;
        LAS float* red = (LAS float*)(F.lds + 32768);
        const float* cv = F.in[I_C];
        for (int i = F.tid; i < 8 * 1024; i += 512) { const int bb = i >> 10, k = i & 1023; cT[k * 8 + bb] = cv[i]; }
        __syncthreads();
        const int hf = F.lane >> 5, c4 = F.lane & 31;
        for (int u = F.vcu; u < NL * 48; u += F.G) {
            const int l = u / 48, n0 = 128 * (u % 48);
            f32x4 a[8];
#pragma unroll
            for (int bb = 0; bb < 8; ++bb) a[bb] = (f32x4){0.f, 0.f, 0.f, 0.f};
            const int kb = F.wave * 128 + hf;
            const float* wp = F.in[I_WADA] + (size_t)l * D * 6144 + (size_t)kb * 6144 + n0 + 4 * c4;
#pragma unroll 8
            for (int kk = 0; kk < 64; ++kk) { const f32x4 w = *(const f32x4*)(wp + (size_t)(2 * kk) * 6144);
                const f32x4 c0 = *(const LAS f32x4*)(cT + (kb + 2 * kk) * 8), c1 = *(const LAS f32x4*)(cT + (kb + 2 * kk) * 8 + 4);
#pragma unroll
                for (int bb = 0; bb < 4; ++bb) { a[bb] += w * c0[bb]; a[4 + bb] += w * c1[bb]; } }
#pragma unroll
            for (int bb = 0; bb < 8; ++bb) *(LAS f32x4*)(red + ((F.wave * 2 + hf) * 8 + bb) * 128 + 4 * c4) = a[bb];
            __syncthreads();
#pragma unroll
            for (int q = 0; q < 2; ++q) { const int o = F.tid + 512 * q, bb = o >> 7, cn = o & 127; float sum = F.in[I_BADA][l * 6144 + n0 + cn];
#pragma unroll
                for (int p = 0; p < 16; ++p) sum += red[(p * 8 + bb) * 128 + cn];
                wsp<float>(F, WS_MOD)[(size_t)(l * 8 + bb) * 6144 + n0 + cn] = sum; }
            __syncthreads();
        }
    }
    const int gt = F.vcu * 512 + F.tid, NT = F.G * 512;
    for (int i = gt; i < SEQ * 8; i += NT) { const int pos = i >> 3, f = i & 7;
        const double inv = (f == 0) ? 1.0 : (f == 1) ? 0.19392274474868576 : (f == 2) ? 0.03760603093086393 : (f == 3) ? 0.007292664737217109 : (f == 4) ? 0.001414213562373095 : (f == 5) ? 0.0002742481756762073 : (f == 6) ? 5.318295896944988e-05 : 1.031338537721246e-05;
        double s, c; sincos_d((double)pos * inv, s, c);
        float* rp = wsp<float>(F, WS_ROPE) + (size_t)pos * 16; rp[f] = (float)c; rp[8 + f] = (float)s; }
    for (int i = gt; i < NL * 4 * 128 * 128; i += NT) { const int j = i & 127, ii = (i >> 7) & 127; const float w = F.in[I_SPW][i];
        wsp<bf16>(F, WS_WSP)[i] = (bf16)(pk2((j <= ii) ? w : 0.f, 0.f) & 0xffffu); }
    for (int i = gt; i < NL * NE * D; i += NT) { const int k = i & 1023, e = (i >> 10) & 31, l = i >> 15; const float w = F.in[I_WR][((size_t)l * D + k) * NE + e];
        const unsigned hi = pk2(w, 0.f) & 0xffffu; const float lo = w - __uint_as_float(hi << 16);
        wsp<bf16>(F, WS_WRT)[i] = (bf16)hi; wsp<bf16>(F, WS_WRT)[NL * NE * D + i] = (bf16)(pk2(lo, 0.f) & 0xffffu); }
}
__device__ __forceinline__ void phase_pro_b(Frame& F) {
    const int gw = F.vcu * 8 + F.wave, NGW = F.G * 8;
    const float* mod = wsp<float>(F, WS_MOD);
    for (int m = gw; m < T; m += NGW) { const int b = m >> 12; const float* mb = mod + (size_t)b * 6144;
        const f32x4* xr = (const f32x4*)(F.in[I_X] + (size_t)m * D) + F.lane; v2u* hp = (v2u*)(wsp<bf16>(F, WS_H) + (size_t)m * D) + F.lane;
#pragma unroll
        for (int j = 0; j < 4; ++j) { const f32x4 x = xr[64 * j]; const f32x4 sh = *((const f32x4*)mb + F.lane + 64 * j), sc = *((const f32x4*)(mb + 1024) + F.lane + 64 * j);
            const f32x4 h = x * (sc + 1.0f) + sh; v2u o; o.x = pk2(h[0], h[1]); o.y = pk2(h[2], h[3]); hp[64 * j] = o; } }
}

constexpr int AT_RS = 144;
constexpr int AT_ROWS = 400, AT_VOFF = AT_ROWS * AT_RS;
#define LDS_BARRIER() do { asm volatile("s_waitcnt lgkmcnt(0)" ::: "memory"); __builtin_amdgcn_s_barrier(); asm volatile("" ::: "memory"); } while (0)
struct AtUnit { int g, b, h, r, n, d; size_t hoff; };
__device__ __forceinline__ AtUnit at_decode(int u) { AtUnit a; a.g = u >> 10; const int rem = u & 1023; a.b = rem >> 7; a.h = (rem >> 4) & 7; const int rn = rem & 15;
    const int dsh = 2 * a.g, nbs = 4 - dsh; a.d = 1 << dsh; a.r = rn >> nbs; a.n = 2 * (rn & ((1 << nbs) - 1)); a.hoff = (size_t)a.g * 512 + a.h * 64; return a; }
constexpr int AT_NU = 3 * 1024;
struct AtSlot { v4u k[6], v[6]; bf16x8 q0, q1, q2, q3; };
struct AtCtx { const bf16 *Qb, *Kb, *Vb; bf16* OG; float* LSE; LAS unsigned char *Ks, *Vs; int qi, g4, piece, jr; };
__device__ __forceinline__ void at_load(AtSlot& sl, int uu, const AtCtx& C, const Frame& F) {
    const AtUnit a_ = at_decode(uu);
#pragma unroll
    for (int ps = 0; ps < 6; ++ps) { const int lp = 128 * (a_.n - 1) + ps * 64 + C.jr; sl.k[ps] = (v4u){0u, 0u, 0u, 0u}; sl.v[ps] = sl.k[ps];
        if (lp >= 0) { const size_t off = ((size_t)a_.b * SEQ + (size_t)lp * a_.d + a_.r) * 1536 + a_.hoff + C.piece * 8; sl.k[ps] = *(const v4u*)(C.Kb + off); sl.v[ps] = *(const v4u*)(C.Vb + off); } }
    const size_t qrow_ = (size_t)a_.b * SEQ + (size_t)(128 * a_.n + 16 * F.wave + C.qi) * a_.d + a_.r; const bf16* qp = C.Qb + qrow_ * 1536 + a_.hoff + 8 * C.g4;
    sl.q0 = *(const bf16x8*)qp; sl.q1 = *(const bf16x8*)(qp + 32);
    const bf16* qp2 = qp + (size_t)128 * a_.d * 1536; sl.q2 = *(const bf16x8*)qp2; sl.q3 = *(const bf16x8*)(qp2 + 32);
}
__device__ __forceinline__ void at_unit(AtSlot& sl, int u, int unext, const AtCtx& C, const Frame& F) {
    bf16* OG = C.OG; float* LSE = C.LSE; LAS unsigned char* Ks = C.Ks; LAS unsigned char* Vs = C.Vs; const int qi = C.qi, g4 = C.g4;
    const AtUnit au = at_decode(u); const int g = au.g, b = au.b, h = au.h, r = au.r, n = au.n, d = au.d;
#pragma unroll
    for (int ps = 0; ps < 6; ++ps) { const int j = ps * 64 + C.jr; *(LAS v4u*)(Ks + j * AT_RS + C.piece * 16) = sl.k[ps]; *(LAS v4u*)(Vs + j * AT_RS + C.piece * 16) = sl.v[ps]; }
    const bf16x8 sl_q0 = sl.q0, sl_q1 = sl.q1, sl_q2 = sl.q2, sl_q3 = sl.q3;
    LDS_BARRIER();
    if (unext < AT_NU) at_load(sl, unext, C, F);
#pragma unroll
    for (int tq = 0; tq < 2; ++tq)
        {
            const int iq = 128 * tq + 16 * F.wave + qi; const int rb = 128 * tq + 16 * F.wave; const bf16x8 qf0 = tq ? sl_q2 : sl_q0, qf1 = tq ? sl_q3 : sl_q1; const size_t qrow = (size_t)b * SEQ + (size_t)(128 * n + iq) * d + r;
            f32x4 s[10]; float mx = -1e30f; const int dq = qi - 4 * g4; const bool first = (n == 0) && (tq == 0);
#pragma unroll
            for (int st = 0; st < 9; ++st) {
                const LAS unsigned char* kp = Ks + (rb + 16 * st + qi) * AT_RS + g4 * 16;
                const bf16x8 k0 = *(const LAS bf16x8*)kp, k1 = *(const LAS bf16x8*)(kp + 64);
                f32x4 a = (f32x4){0.f, 0.f, 0.f, 0.f};
                a = mfma16(k0, qf0, a); a = mfma16(k1, qf1, a);
                if (st == 0) {
#pragma unroll
                    for (int i = 0; i < 4; ++i) a[i] = (i >= dq) ? a[i] : -1e30f; }
                if (st == 8) {
#pragma unroll
                    for (int i = 0; i < 4; ++i) a[i] = (i <= dq) ? a[i] : -1e30f; }
                if (first) {
#pragma unroll
                    for (int i = 0; i < 4; ++i) a[i] = (rb + 16 * st + 4 * g4 + i >= 128) ? a[i] : -1e30f; }
#pragma unroll
                for (int i = 0; i < 4; ++i) mx = fmaxf(mx, a[i]);
                s[st] = a;
            }
            mx = fmaxf(mx, __shfl_xor(mx, 16)); mx = fmaxf(mx, __shfl_xor(mx, 32));
            float sum = 0.f;
#pragma unroll
            for (int st = 0; st < 9; ++st)
#pragma unroll
                for (int i = 0; i < 4; ++i) { const float p = fexp2(s[st][i] - mx); s[st][i] = p; sum += p; }
            s[9] = (f32x4){0.f, 0.f, 0.f, 0.f};
            sum += __shfl_xor(sum, 16); sum += __shfl_xor(sum, 32);
            f32x4 o[4];
#pragma unroll
            for (int dt = 0; dt < 4; ++dt) o[dt] = (f32x4){0.f, 0.f, 0.f, 0.f};
#pragma unroll
            for (int c = 0; c < 5; ++c) {
                v4u pw; pw.x = pk2(s[2 * c][0], s[2 * c][1]); pw.y = pk2(s[2 * c][2], s[2 * c][3]); pw.z = pk2(s[2 * c + 1][0], s[2 * c + 1][1]); pw.w = pk2(s[2 * c + 1][2], s[2 * c + 1][3]);
                const bf16x8 pf = __builtin_bit_cast(bf16x8, pw);
                const LAS unsigned char* vp = Vs + (rb + 32 * c + 4 * g4 + (qi >> 2)) * AT_RS + 8 * (qi & 3);
#pragma unroll
                for (int dt = 0; dt < 4; ++dt) { const s16x4 lo = tr16(vp + 32 * dt), hi = tr16(vp + 32 * dt + 16 * AT_RS);
                    o[dt] = mfma16(cat8(lo, hi), pf, o[dt]); }
            }
            const float inv = 1.0f / sum;
            bf16* op = OG + ((size_t)g * T + qrow) * 512 + h * 64 + 4 * g4;
#pragma unroll
            for (int dt = 0; dt < 4; ++dt) { v2u w; w.x = pk2(o[dt][0] * inv, o[dt][1] * inv); w.y = pk2(o[dt][2] * inv, o[dt][3] * inv); *(v2u*)(op + 16 * dt) = w; }
            if (g4 == 0) LSE[((size_t)g * T + qrow) * 8 + h] = mx + __log2f(sum);
        }
    LDS_BARRIER();
}
__device__ __forceinline__ void phase_attn(Frame& F) {
    AtCtx C; C.Qb = wsp<bf16>(F, WS_Q); C.Kb = wsp<bf16>(F, WS_K); C.Vb = wsp<bf16>(F, WS_VV); C.OG = wsp<bf16>(F, WS_OG); C.LSE = wsp<float>(F, WS_LSE);
    C.Ks = F.lds; C.Vs = F.lds + AT_VOFF; C.qi = F.lane & 15; C.g4 = F.lane >> 4; C.piece = F.tid & 7; C.jr = F.tid >> 3;
    if (F.tid < 144) { *(LAS v4u*)(C.Ks + 384 * AT_RS + F.tid * 16) = (v4u){0u, 0u, 0u, 0u}; *(LAS v4u*)(C.Vs + 384 * AT_RS + F.tid * 16) = (v4u){0u, 0u, 0u, 0u}; }
    AtSlot sa; const int u0 = F.vcu, G = F.G;
    if (u0 < AT_NU) at_load(sa, u0, C, F);
#pragma unroll 1
    for (int u = u0; u < AT_NU; u += G) at_unit(sa, u, u + G, C, F);
}

constexpr int SG_WOFF = 69632, SG_WRS = 264;
constexpr int SG_RS = 528;
__device__ __forceinline__ void phase_sg(Frame& F, int l) {
    const bf16* Ub = wsp<bf16>(F, WS_U); const bf16* Vb = wsp<bf16>(F, WS_V); bf16* TT = wsp<bf16>(F, WS_TT);
    const bf16* OG = wsp<bf16>(F, WS_OG); const float* LSE = wsp<float>(F, WS_LSE); bf16* OB = wsp<bf16>(F, WS_OB);
    const bf16* Wsp = wsp<bf16>(F, WS_WSP); const float* spb = F.in[I_SPB];
    LAS unsigned char* Vn = F.lds;
    const int qi = F.lane & 15, g4 = F.lane >> 4;
    const int l32 = F.lane & 31;
    v4u vraw[8];
#define SG_LOAD(uu) do { const int gi_ = (uu) & 3, m0_ = ((uu) >> 2) * 128; \
        _Pragma("unroll") for (int ps = 0; ps < 8; ++ps) vraw[ps] = *(const v4u*)(Vb + (size_t)(m0_ + 16 * ps + 2 * F.wave + (F.lane >> 5)) * 1024 + gi_ * 256 + 8 * l32); } while (0)
    if (F.vcu < 1024) SG_LOAD(F.vcu);
    const bool wlds = (F.G & 3) == 0; LAS unsigned char* Wl = F.lds + SG_WOFF;
    if (wlds) { const bf16* wsrc = Wsp + (size_t)(l * 4 + (F.vcu & 3)) * 128 * 128;
        for (int i = F.tid; i < 128 * 16; i += 512) { const int row = i >> 4, ch = i & 15; const v4u wv = *(const v4u*)(wsrc + row * 128 + ch * 8);
            *(LAS v2u*)(Wl + row * SG_WRS + ch * 16) = (v2u){wv.x, wv.y}; *(LAS v2u*)(Wl + row * SG_WRS + ch * 16 + 8) = (v2u){wv.z, wv.w}; } }
    for (int u = F.vcu; u < 1024; u += F.G) {
        const int gi = u & 3, m0 = (u >> 2) * 128;
        float ml[4][3]; v4u mo[4][3]; const int sub = F.tid & 7;
#pragma unroll
        for (int ps = 0; ps < 4; ++ps) { const int p = (F.tid >> 3) + 64 * ps; const size_t tok = (size_t)m0 + (p >> 1); const int hd = 2 * gi + (p & 1); const size_t off = tok * 512 + hd * 64 + 8 * sub;
#pragma unroll
            for (int gq = 0; gq < 3; ++gq) { ml[ps][gq] = LSE[((size_t)gq * T + tok) * 8 + hd]; mo[ps][gq] = *(const v4u*)(OG + (size_t)gq * T * 512 + off); } }
        {
            float sm[8], mean[8], rs[8];
#pragma unroll
            for (int ps = 0; ps < 8; ++ps) { const v4u raw = vraw[ps]; sm[ps] = ((bflo(raw.x) + bfhi(raw.x)) + (bflo(raw.y) + bfhi(raw.y))) + ((bflo(raw.z) + bfhi(raw.z)) + (bflo(raw.w) + bfhi(raw.w))); }
#pragma unroll
            for (int o = 1; o < 32; o <<= 1) {
#pragma unroll
                for (int ps = 0; ps < 8; ++ps) sm[ps] += __shfl_xor(sm[ps], o); }
#pragma unroll
            for (int ps = 0; ps < 8; ++ps) { const v4u raw = vraw[ps]; mean[ps] = sm[ps] * (1.0f / 256.0f); float q = 0.f;
                const float x[8] = {bflo(raw.x), bfhi(raw.x), bflo(raw.y), bfhi(raw.y), bflo(raw.z), bfhi(raw.z), bflo(raw.w), bfhi(raw.w)};
#pragma unroll
                for (int e = 0; e < 8; ++e) { const float dx = x[e] - mean[ps]; q += dx * dx; }
                sm[ps] = q; }
#pragma unroll
            for (int o = 1; o < 32; o <<= 1) {
#pragma unroll
                for (int ps = 0; ps < 8; ++ps) sm[ps] += __shfl_xor(sm[ps], o); }
#pragma unroll
            for (int ps = 0; ps < 8; ++ps) { rs[ps] = 1.0f / sqrtf(sm[ps] * (1.0f / 256.0f) + LN_EPS); const v4u raw = vraw[ps]; const int j = 16 * ps + 2 * F.wave + (F.lane >> 5);
                const float x[8] = {bflo(raw.x), bfhi(raw.x), bflo(raw.y), bfhi(raw.y), bflo(raw.z), bfhi(raw.z), bflo(raw.w), bfhi(raw.w)};
                v4u w; w.x = pk2((x[0] - mean[ps]) * rs[ps], (x[1] - mean[ps]) * rs[ps]); w.y = pk2((x[2] - mean[ps]) * rs[ps], (x[3] - mean[ps]) * rs[ps]);
                w.z = pk2((x[4] - mean[ps]) * rs[ps], (x[5] - mean[ps]) * rs[ps]); w.w = pk2((x[6] - mean[ps]) * rs[ps], (x[7] - mean[ps]) * rs[ps]);
                *(LAS v4u*)(Vn + j * SG_RS + l32 * 16) = w; }
        }
        LDS_BARRIER();
        if (u + F.G < 1024) SG_LOAD(u + F.G);
        {
#pragma unroll
          for (int ps = 0; ps < 4; ++ps) { const int p = (F.tid >> 3) + 64 * ps; const size_t tok = (size_t)m0 + (p >> 1); const int hd = 2 * gi + (p & 1);
              const float l0 = ml[ps][0], l1 = ml[ps][1], l2 = ml[ps][2];
              const float mxx = fmaxf(l0, fmaxf(l1, l2)); float w0 = fexp2(l0 - mxx), w1 = fexp2(l1 - mxx), w2 = fexp2(l2 - mxx); const float inv = 1.0f / (w0 + w1 + w2); w0 *= inv; w1 *= inv; w2 *= inv;
              const size_t off = tok * 512 + hd * 64 + 8 * sub;
              const v4u a = mo[ps][0], bq = mo[ps][1], cq = mo[ps][2]; v4u w;
              w.x = pk2(w0 * bflo(a.x) + w1 * bflo(bq.x) + w2 * bflo(cq.x), w0 * bfhi(a.x) + w1 * bfhi(bq.x) + w2 * bfhi(cq.x));
              w.y = pk2(w0 * bflo(a.y) + w1 * bflo(bq.y) + w2 * bflo(cq.y), w0 * bfhi(a.y) + w1 * bfhi(bq.y) + w2 * bfhi(cq.y));
              w.z = pk2(w0 * bflo(a.z) + w1 * bflo(bq.z) + w2 * bflo(cq.z), w0 * bfhi(a.z) + w1 * bfhi(bq.z) + w2 * bfhi(cq.z));
              w.w = pk2(w0 * bflo(a.w) + w1 * bflo(bq.w) + w2 * bflo(cq.w), w0 * bfhi(a.w) + w1 * bfhi(bq.w) + w2 * bfhi(cq.w));
              *(v4u*)(TT + tok * 1536 + 1024 + hd * 64 + 8 * sub) = w; } }
        v2u uq[8][2]; float ubias[8];
#pragma unroll
        for (int it = 0; it < 8; ++it) { const int i = 16 * it + qi; ubias[it] = spb[(l * 4 + gi) * 128 + i]; const size_t rowo = (size_t)(m0 + i) * 1024 + gi * 256 + 32 * F.wave + 4 * g4;
            uq[it][0] = *(const v2u*)(Ub + rowo); uq[it][1] = *(const v2u*)(Ub + rowo + 16); }
        {
            f32x4 acc[2][8];
#pragma unroll
            for (int ct = 0; ct < 2; ++ct)
#pragma unroll
                for (int it = 0; it < 8; ++it) acc[ct][it] = (f32x4){0.f, 0.f, 0.f, 0.f};
            const bf16* wbase = Wsp + (size_t)(l * 4 + gi) * 128 * 128 + (size_t)qi * 128 + 4 * g4;
#pragma unroll
            for (int kc = 0; kc < 4; ++kc) {
                bf16x8 af[2];
#pragma unroll
                for (int ct = 0; ct < 2; ++ct) { const LAS unsigned char* p = Vn + (32 * kc + 4 * g4 + (qi >> 2)) * SG_RS + (32 * F.wave + 16 * ct + 4 * (qi & 3)) * 2;
                    af[ct] = cat8(tr16(p), tr16(p + 16 * SG_RS)); }
#pragma unroll
                for (int it = 0; it < 8; ++it) if (it >= 2 * kc) {
                    const bf16* wp = wbase + (size_t)(16 * it) * 128 + 32 * kc; const LAS unsigned char* wq = Wl + (16 * it + qi) * SG_WRS + (32 * kc + 4 * g4) * 2;
                    const v2u b0 = wlds ? *(const LAS v2u*)wq : *(const v2u*)wp, b1 = wlds ? *(const LAS v2u*)(wq + 32) : *(const v2u*)(wp + 16);
                    const bf16x8 bfr = __builtin_bit_cast(bf16x8, (v4u){b0.x, b0.y, b1.x, b1.y});
                    acc[0][it] = mfma16(af[0], bfr, acc[0][it]); acc[1][it] = mfma16(af[1], bfr, acc[1][it]); }
            }
#pragma unroll
            for (int it = 0; it < 8; ++it) { const int i = 16 * it + qi; const float bias = ubias[it]; const size_t rowo = (size_t)(m0 + i) * 1536 + gi * 256 + 32 * F.wave + 4 * g4;
#pragma unroll
                for (int ct = 0; ct < 2; ++ct) { const v2u uu = uq[it][ct]; const f32x4 a = acc[ct][it]; v2u w;
                    w.x = pk2(bflo(uu.x) * (a[0] + bias), bfhi(uu.x) * (a[1] + bias)); w.y = pk2(bflo(uu.y) * (a[2] + bias), bfhi(uu.y) * (a[3] + bias));
                    *(v2u*)(TT + rowo + 16 * ct) = w; } }
        }
        LDS_BARRIER();
    }
#undef SG_LOAD
}

__device__ __forceinline__ void phase_ln1(Frame& F, int l, bool commit) {
    const bf16* YPRE = wsp<bf16>(F, WS_YPRE); bf16* H = wsp<bf16>(F, WS_H);
    const float* modl = wsp<float>(F, WS_MOD) + (size_t)l * 8 * 6144;
    const float* lg = F.in[I_LN1G] + l * D; const float* lb = F.in[I_LN1B] + l * D; const float* br = F.in[I_BR] + l * NE;
    const bf16* WH = wsp<bf16>(F, WS_WRT) + (size_t)l * NE * D; const bf16* WL = WH + (size_t)NL * NE * D;
    int* TOKINFO = wsp<int>(F, WS_TOKINFO); float* TOKW = wsp<float>(F, WS_TOKW);
    unsigned* cntg = wsp<unsigned>(F, WS_CTL) + CW_CNT + (size_t)l * NE * 64;
    LAS int* sel_e = (LAS int*)(F.lds + X_SELE);
    const int lane = F.lane, qi = lane & 15, g4 = lane >> 4;
    { const v4u* srcw = (const v4u*)WH;
#pragma unroll 4
      for (int i = F.tid; i < 2 * NE * 128; i += 512) { const int hl = i >> 12, e = (i >> 7) & 31, c = i & 127;
          *(LAS v4u*)(F.lds + hl * 65536 + e * 2048 + ((c ^ (e & 15)) << 4)) = srcw[(size_t)hl * (NL * NE * 128) + e * 128 + c]; } }
    __syncthreads();
    for (int tb = F.vcu; tb < T / 128; tb += F.G) {
        const int m0 = tb * 128; const int b = m0 >> 12; const float* mb = modl + (size_t)b * 6144; const int mw = m0 + 16 * F.wave;
        v2u pre[4][4];
#pragma unroll
        for (int r = 0; r < 4; ++r)
#pragma unroll
            for (int j = 0; j < 4; ++j) pre[r][j] = *((const v2u*)(YPRE + (size_t)(mw + r) * D) + lane + 64 * j);
#pragma unroll 1
        for (int rp = 0; rp < 4; ++rp) {
            f32x4 hh[4][4]; float mean[4], rstd[4];
            const int mrow = mw + 4 * rp;
#pragma unroll
            for (int r = 0; r < 4; ++r)
#pragma unroll
                for (int j = 0; j < 4; ++j) hh[r][j] = (f32x4){bflo(pre[r][j].x), bfhi(pre[r][j].x), bflo(pre[r][j].y), bfhi(pre[r][j].y)};
            if (rp < 3) {
#pragma unroll
                for (int r = 0; r < 4; ++r)
#pragma unroll
                    for (int j = 0; j < 4; ++j) pre[r][j] = *((const v2u*)(YPRE + (size_t)(mrow + 4 + r) * D) + lane + 64 * j); }
            { float sm[4], sq[4];
#pragma unroll
              for (int r = 0; r < 4; ++r) { sm[r] = 0.f; sq[r] = 0.f;
#pragma unroll
                  for (int j = 0; j < 4; ++j) { sm[r] += (hh[r][j][0] + hh[r][j][1]) + (hh[r][j][2] + hh[r][j][3]);
                      sq[r] += (hh[r][j][0] * hh[r][j][0] + hh[r][j][1] * hh[r][j][1]) + (hh[r][j][2] * hh[r][j][2] + hh[r][j][3] * hh[r][j][3]); } }
#pragma unroll
              for (int o = 1; o < 64; o <<= 1) {
#pragma unroll
                  for (int r = 0; r < 4; ++r) { sm[r] += __shfl_xor(sm[r], o); sq[r] += __shfl_xor(sq[r], o); } }
#pragma unroll
              for (int r = 0; r < 4; ++r) { mean[r] = sm[r] * (1.0f / D); rstd[r] = 1.0f / sqrtf(fmaxf(sq[r] * (1.0f / D) - mean[r] * mean[r], 0.f) + LN_EPS); } }
            if (lane < 4) { const float mq = (lane == 0) ? mean[0] : (lane == 1) ? mean[1] : (lane == 2) ? mean[2] : mean[3], rq = (lane == 0) ? rstd[0] : (lane == 1) ? rstd[1] : (lane == 2) ? rstd[2] : rstd[3];
                float* st = wsp<float>(F, WS_STAT) + (size_t)(mrow + lane) * 2; st[0] = mq; st[1] = rq; }
#pragma unroll
            for (int j = 0; j < 4; ++j) { const f32x4 gq = *((const f32x4*)lg + lane + 64 * j), bq = *((const f32x4*)lb + lane + 64 * j);
                const f32x4 shq = *((const f32x4*)(mb + 3072) + lane + 64 * j), scq = *((const f32x4*)(mb + 4096) + lane + 64 * j) + 1.0f;
#pragma unroll
                for (int r = 0; r < 4; ++r) { const f32x4 x1 = (hh[r][j] - mean[r]) * rstd[r] * gq + bq;
                    const f32x4 h2 = x1 * scq + shq; v2u o; o.x = pk2(h2[0], h2[1]); o.y = pk2(h2[2], h2[3]); *((v2u*)(H + (size_t)(mrow + r) * D) + lane + 64 * j) = o;
 } }
        }
        VM_WAIT(); asm volatile("" ::: "memory");
        f32x4 c0 = (f32x4){0.f, 0.f, 0.f, 0.f}, c1 = c0;
        { const bf16* hp = H + (size_t)(mw + qi) * D + 8 * g4;
          const LAS unsigned char* w0 = F.lds + qi * 2048; const LAS unsigned char* w1 = F.lds + (16 + qi) * 2048;
#pragma unroll 8
          for (int ks = 0; ks < 32; ++ks) {
              const bf16x8 hhi = *(const bf16x8*)(hp + 32 * ks);
              const int co = ((4 * ks + g4) ^ qi) << 4;
              const bf16x8 a0h = *(const LAS bf16x8*)(w0 + co), a0l = *(const LAS bf16x8*)(w0 + 65536 + co);
              const bf16x8 a1h = *(const LAS bf16x8*)(w1 + co), a1l = *(const LAS bf16x8*)(w1 + 65536 + co);
              c0 = mfma16(a0h, hhi, c0); c0 = mfma16(a0l, hhi, c0);
              c1 = mfma16(a1h, hhi, c1); c1 = mfma16(a1l, hhi, c1); } }
        {
            float v[8]; int id[8];
#pragma unroll
            for (int i = 0; i < 4; ++i) { id[i] = 4 * g4 + i; id[4 + i] = 16 + 4 * g4 + i; v[i] = c0[i] + br[4 * g4 + i]; v[4 + i] = c1[i] + br[16 + 4 * g4 + i]; }
            int ek[4]; float vk[4];
#pragma unroll
            for (int k = 0; k < 4; ++k) { float lm = v[0]; int li = id[0];
#pragma unroll
                for (int j = 1; j < 8; ++j) if (v[j] > lm) { lm = v[j]; li = id[j]; }
#pragma unroll
                for (int o = 16; o <= 32; o <<= 1) { const float om = __shfl_xor(lm, o); const int oi = __shfl_xor(li, o); if (om > lm || (om == lm && oi < li)) { lm = om; li = oi; } }
                ek[k] = li; vk[k] = lm;
#pragma unroll
                for (int j = 0; j < 8; ++j) if (id[j] == li) v[j] = -INFINITY; }
            const float e1 = __expf(vk[1] - vk[0]), e2 = __expf(vk[2] - vk[0]), e3 = __expf(vk[3] - vk[0]); const float inv = 1.0f / (1.0f + e1 + e2 + e3);
            if (g4 == 0) { const int tl = 16 * F.wave + qi;
                sel_e[tl * 4 + 0] = ek[0]; sel_e[tl * 4 + 1] = ek[1]; sel_e[tl * 4 + 2] = ek[2]; sel_e[tl * 4 + 3] = ek[3];
                *(f32x4*)(TOKW + (size_t)(m0 + tl) * 4) = (f32x4){inv, e1 * inv, e2 * inv, e3 * inv}; }
        }
        __syncthreads();
        { const int myE = sel_e[F.tid]; LAS unsigned long long* bm = (LAS unsigned long long*)(F.lds + X_SELR); unsigned long long mine = 0ull;
#pragma unroll
          for (int e = 0; e < 32; ++e) { const unsigned long long m = __ballot(myE == e); if (lane == e) mine = m; }
          if (lane < 32) bm[F.wave * 32 + lane] = mine;
          __syncthreads();
          int rk = __popcll(bm[F.wave * 32 + myE] & ((1ull << lane) - 1ull));
#pragma unroll
          for (int w = 0; w < 8; ++w) if (w < F.wave) rk += __popcll(bm[w * 32 + myE]);
          TOKINFO[(size_t)m0 * 4 + F.tid] = myE | (rk << 8);
          if (F.tid < 32) { int tot = 0;
#pragma unroll
              for (int w = 0; w < 8; ++w) tot += __popcll(bm[w * 32 + F.tid]);
              wsp<int>(F, WS_WGCNT)[((size_t)l * 256 + tb) * 32 + F.tid] = tot; if (tot && commit) (void)__hip_atomic_fetch_add(cntg + F.tid * 64, (unsigned)tot, RLX_AGENT); } }
        __syncthreads();
    }
}

__device__ __forceinline__ int moe_tables(Frame& F, int l) {
    const unsigned* cntg = wsp<unsigned>(F, WS_CTL) + CW_CNT + (size_t)l * NE * 64;
    LAS int* cnt_s = (LAS int*)(F.lds + X_CNTS); LAS int* off_s = (LAS int*)(F.lds + X_OFFS); LAS unsigned char* tile_e = (LAS unsigned char*)(F.lds + X_TILEE);
    if (F.tid < 32) cnt_s[F.tid] = (int)__hip_atomic_load(cntg + F.tid * 64, RLX_AGENT);
    __syncthreads();
    if (F.tid < 64) {
        const int e = F.tid & 31; const int c = (F.tid < 32) ? cnt_s[e] : 0; const int nt = (c + 255) >> 8; int incl = nt;
#pragma unroll
        for (int o = 1; o < 32; o <<= 1) { const int v = __shfl_up(incl, o); if ((F.tid & 63) >= o) incl += v; }
        if (F.tid < 32) { const int excl = incl - nt; off_s[e] = excl * 256; for (int t = 0; t < nt; ++t) tile_e[excl + t] = (unsigned char)e; if (e == 31) off_s[32] = incl * 256; }
    }
    __syncthreads();
    return off_s[32] >> 8;
}
__device__ __forceinline__ void phase_scat(Frame& F, int l) {
    (void)moe_tables(F, l);
    const LAS int* off_s = (const LAS int*)(F.lds + X_OFFS); const LAS int* cnt_s = (const LAS int*)(F.lds + X_CNTS); LAS int* base_s = (LAS int*)(F.lds + X_BASE);
    const int* TOKINFO = wsp<int>(F, WS_TOKINFO); const float* TOKW = wsp<float>(F, WS_TOKW);
    int* ROWTOK = wsp<int>(F, WS_ROWTOK); float* ROWW = wsp<float>(F, WS_ROWW); const int* WGC = wsp<int>(F, WS_WGCNT) + (size_t)l * 256 * 32; int* TOKINFO2 = wsp<int>(F, WS_TOKROW);
    for (int tb = F.vcu; tb < T / 128; tb += F.G) {
        if (F.tid < 32) base_s[F.tid] = 0;
        __syncthreads();
        { const int e = F.tid & 31, part = F.tid >> 5; int sacc = 0;
          for (int t2 = part * 16; t2 < part * 16 + 16; ++t2) if (t2 < tb) sacc += WGC[t2 * 32 + e];
          if (sacc) atomicAdd((int*)&base_s[e], sacc); }
        __syncthreads();
        { const size_t ent = (size_t)tb * 512 + F.tid; const int info = TOKINFO[ent]; const int e = info & 255, row = off_s[e] + base_s[e] + (info >> 8);
          ROWTOK[row] = (int)ent; ROWW[row] = TOKW[ent]; TOKINFO2[ent] = row; }
        __syncthreads();
    }
    if (F.vcu == 0) for (int e = 0; e < NE; ++e) for (int r = off_s[e] + cnt_s[e] + F.tid; r < off_s[e + 1]; r += 512) { ROWTOK[r] = 0; ROWW[r] = 0.f; }
}
__device__ __forceinline__ void phase_ln2(Frame& F, int l) {
    const bf16* X1 = wsp<bf16>(F, WS_YPRE); const bf16* YK = wsp<bf16>(F, WS_XG); bf16* H = wsp<bf16>(F, WS_H); const int* TOKROW = wsp<int>(F, WS_TOKROW); const float* TOKW = wsp<float>(F, WS_TOKW);
    const float* STAT = wsp<float>(F, WS_STAT); const float* l1g = F.in[I_LN1G] + l * D; const float* l1b = F.in[I_LN1B] + l * D;
    float* XO = F.out; bf16* XB = wsp<bf16>(F, WS_X2);
    const float* modl = wsp<float>(F, WS_MOD) + (size_t)l * 8 * 6144; const float* modn = wsp<float>(F, WS_MOD) + (size_t)((l + 1) & 3) * 8 * 6144;
    const float* lg = F.in[I_LN2G] + l * D; const float* lb = F.in[I_LN2B] + l * D;
    const int lane = F.lane; const int gw = F.vcu * 8 + F.wave, NGW = F.G * 8;
    v2u px[4]; v2u py[4][4]; float pst[2], nst[2]; f32x4 pw4, nw4;
#define LN2_LOAD(mm) do { nst[0] = STAT[(size_t)(mm) * 2]; nst[1] = STAT[(size_t)(mm) * 2 + 1]; nw4 = *(const f32x4*)(TOKW + (size_t)(mm) * 4); \
        int rw_[4]; _Pragma("unroll") for (int k = 0; k < 4; ++k) rw_[k] = TOKROW[(size_t)(mm) * 4 + k]; \
        _Pragma("unroll") for (int j = 0; j < 4; ++j) { px[j] = __builtin_nontemporal_load((const v2u*)(X1 + (size_t)(mm) * D) + lane + 64 * j); \
        _Pragma("unroll") for (int k = 0; k < 4; ++k) py[j][k] = __builtin_nontemporal_load((const v2u*)(YK + (size_t)rw_[k] * D) + lane + 64 * j); } } while (0)
    if (gw < T) LN2_LOAD(gw);
#pragma unroll 1
    for (int m = gw; m < T; m += NGW) { const int b = m >> 12; const float* mb = modl + (size_t)b * 6144; const float* mn = modn + (size_t)b * 6144;
        f32x4 v[4]; float s = 0.f; pst[0] = nst[0]; pst[1] = nst[1]; pw4 = nw4;
#pragma unroll
        for (int j = 0; j < 4; ++j) { f32x4 y = (f32x4){0.f, 0.f, 0.f, 0.f};
#pragma unroll
            for (int k = 0; k < 4; ++k) { const v2u w = py[j][k]; const float cw = pw4[k]; y[0] += cw * bflo(w.x); y[1] += cw * bfhi(w.x); y[2] += cw * bflo(w.y); y[3] += cw * bfhi(w.y); }
            const f32x4 g2 = *((const f32x4*)(mb + 5120) + lane + 64 * j) + 1.0f;
            const f32x4 pxf = (f32x4){bflo(px[j].x), bfhi(px[j].x), bflo(px[j].y), bfhi(px[j].y)};
            const f32x4 x1 = (pxf - pst[0]) * pst[1] * *((const f32x4*)l1g + lane + 64 * j) + *((const f32x4*)l1b + lane + 64 * j);
            v[j] = x1 * DN_ALPHA + g2 * y; s += (v[j][0] + v[j][1]) + (v[j][2] + v[j][3]); }
        if (m + NGW < T) LN2_LOAD(m + NGW);
        float s2 = 0.f;
#pragma unroll
        for (int j = 0; j < 4; ++j) s2 += (v[j][0] * v[j][0] + v[j][1] * v[j][1]) + (v[j][2] * v[j][2] + v[j][3] * v[j][3]);
#pragma unroll
        for (int o = 1; o < 64; o <<= 1) { s += __shfl_xor(s, o); s2 += __shfl_xor(s2, o); }
        const float mean = s * (1.0f / D); const float rstd = 1.0f / sqrtf(fmaxf(s2 * (1.0f / D) - mean * mean, 0.f) + LN_EPS);
#pragma unroll
        for (int j = 0; j < 4; ++j) v[j] = v[j] - mean;
        f32x4* xo = (f32x4*)(XO + (size_t)m * D) + lane; v2u* xb = (v2u*)(XB + (size_t)m * D) + lane; v2u* ho = (v2u*)(H + (size_t)m * D) + lane;
#pragma unroll
        for (int j = 0; j < 4; ++j) { const f32x4 gvj = *((const f32x4*)lg + lane + 64 * j), bvj = *((const f32x4*)lb + lane + 64 * j); const f32x4 x2 = v[j] * rstd * gvj + bvj;
            if (l == NL - 1) __builtin_nontemporal_store(x2, xo + 64 * j); else { v2u xq; xq.x = pk2(x2[0], x2[1]); xq.y = pk2(x2[2], x2[3]); __builtin_nontemporal_store(xq, xb + 64 * j); }
            if (l < NL - 1) { const f32x4 sh = *((const f32x4*)mn + lane + 64 * j), sc = *((const f32x4*)(mn + 1024) + lane + 64 * j) + 1.0f; const f32x4 h = x2 * sc + sh;
                v2u o; o.x = pk2(h[0], h[1]); o.y = pk2(h[2], h[3]); ho[64 * j] = o; } } }
#undef LN2_LOAD
}

#ifndef PH_MASK
#define PH_MASK 0xFFFF
#endif
#define PHM(b) ((PH_MASK >> (b)) & 1)
#ifndef DUP_MASK
#define DUP_MASK 0
#endif
#define REPS(b) (((DUP_MASK >> (b)) & 1) ? 2 : 1)
constexpr int NPH_L = 10, NPHASE = 2 + NL * NPH_L;
struct Args { const float* in[20]; float* out; unsigned char* ws; int ph_lo, ph_hi; };
__global__ void __launch_bounds__(512, 2) fwd(Args args) {
    extern __shared__ __attribute__((aligned(16))) unsigned char lds[];
    Frame F;
    F.lds = (LAS unsigned char*)lds;
#define FRESH() do { int zv_ = 0; asm volatile("" : "+v"(zv_)); const int z_ = __builtin_amdgcn_readfirstlane(zv_); \
        F.tid = (int)threadIdx.x + zv_; F.lane = F.tid & 63; F.wave = __builtin_amdgcn_readfirstlane(F.tid >> 6); \
        F.G = (int)gridDim.x + z_; F.bx = (int)blockIdx.x + z_; F.vcu = (F.G % 8 == 0) ? (F.bx % 8) * (F.G / 8) + F.bx / 8 : F.bx; \
        F.ws = args.ws + z_; F.in = args.in + z_; F.out = args.out + z_; F.lds = (LAS unsigned char*)lds + z_; } while (0)
    FRESH();
    for (int u = F.tid; u < (LDS_BYTES - XOFF) / 4; u += 512) ((LAS unsigned*)(F.lds + XOFF))[u] = 0u;
    __syncthreads();
    unsigned* ctl = wsp<unsigned>(F, WS_CTL);
    XcdBarrier bar; bar.bar = ctl + CW_BAR; bar.x = 0; bar.st = nullptr;
    if (!MK_PER_PHASE) bar = xcd_barrier_post(ctl + CW_BAR, (volatile LAS unsigned*)(F.lds + X_MISC) + 8);
    const int lo = args.ph_lo, hi = args.ph_hi;
#define IN(k) (lo <= (k) && (k) < hi)
#ifndef BAR_REPS
#define BAR_REPS 1
#endif
#define SEAM(k) do { if (!MK_PER_PHASE && IN(k) && IN((k) + 1)) for (int br_ = 0; br_ < BAR_REPS; ++br_) xcd_barrier(bar); } while (0)

    if (PHM(0) && IN(0)) for (int rep = 0; rep < REPS(0); ++rep) { FRESH(); phase_pro_a(F); } SEAM(0);
    if (PHM(1) && IN(1)) for (int rep = 0; rep < REPS(1); ++rep) { FRESH(); phase_pro_b(F); } SEAM(1);
    for (int l = 0; l < NL; ++l) {
        const int pb = 2 + l * NPH_L;
        if (PHM(2) && IN(pb + 0)) for (int rep = 0; rep < REPS(2); ++rep) { FRESH();
            pg8::Gemm g{wsp<bf16>(F, WS_H), wsp<bf16>(F, WS_WIN) + (size_t)l * NIN * D, T, NIN, D}; pg8::StaticOrder S; S.init(T, NIN, F.G, F.bx);
            EpiIn E{wsp<bf16>(F, WS_U), wsp<bf16>(F, WS_V), wsp<bf16>(F, WS_Q), wsp<bf16>(F, WS_K), wsp<bf16>(F, WS_VV), wsp<bf16>(F, WS_G), wsp<float>(F, WS_ROPE)};
            stagger(F.bx >> 3, STAG_US);
            pg8::gemm_phase<EpiIn, pg8::StaticOrder, PG8_ALIGN, PG8_SP2>(F.lds, g, S, E, F.tid);
#if defined(XPROBE)
            { FRESH(); pg8::Gemm g2{wsp<bf16>(F, WS_H), wsp<bf16>(F, WS_WIN) + (size_t)l * NIN * D, T, NIN, D}; pg8::StaticOrder S2; S2.init(T, NIN, F.G, F.bx);
              EpiProbe E2{wsp<bf16>(F, WS_XG), (XPROBE == 3) ? NIN : 1024, (XPROBE >= 2) ? (XPROBE == 3 ? 3 : 1) : (F.G == 0x7ffffff0 ? 1 : 0)};
              pg8::gemm_phase<EpiProbe, pg8::StaticOrder, PG8_ALIGN, PG8_SP2>(F.lds, g2, S2, E2, F.tid); }
#endif
        } SEAM(pb + 0);
        if (PHM(3) && IN(pb + 1)) for (int rep = 0; rep < REPS(3); ++rep) { FRESH(); phase_attn(F); } SEAM(pb + 1);
        if (PHM(4) && IN(pb + 2)) for (int rep = 0; rep < REPS(4); ++rep) { FRESH(); phase_sg(F, l); } SEAM(pb + 2);
        if (PHM(5) && IN(pb + 3)) for (int rep = 0; rep < REPS(5); ++rep) { FRESH();
            pg8::Gemm g{wsp<bf16>(F, WS_TT), wsp<bf16>(F, WS_WBA) + (size_t)l * D * 1536, T, D, 1536}; pg8::StaticOrder S; S.init(T, D, F.G, F.bx);
            EpiMg2 E{wsp<bf16>(F, WS_G), wsp<bf16>(F, WS_MG)}; pg8::gemm_phase<EpiMg2, pg8::StaticOrder, PG8_ALIGN, PG8_SP2>(F.lds, g, S, E, F.tid);
        } SEAM(pb + 3);
        if (PHM(6) && IN(pb + 4)) for (int rep = 0; rep < REPS(6); ++rep) { FRESH();
            pg8::Gemm g{wsp<bf16>(F, WS_MG), wsp<bf16>(F, WS_WOUT) + (size_t)l * D * D, T, D, D}; pg8::StaticOrder S; S.init(T, D, F.G, F.bx);
            if (l == 0) { EpiOut<true> E{(const void*)F.in[I_X], wsp<float>(F, WS_MOD) + (size_t)l * 8 * 6144, wsp<bf16>(F, WS_YPRE)}; pg8::gemm_phase<EpiOut<true>, pg8::StaticOrder, PG8_ALIGN, PG8_SP2>(F.lds, g, S, E, F.tid); }
            else { EpiOut<false> E{(const void*)wsp<bf16>(F, WS_X2), wsp<float>(F, WS_MOD) + (size_t)l * 8 * 6144, wsp<bf16>(F, WS_YPRE)}; pg8::gemm_phase<EpiOut<false>, pg8::StaticOrder, PG8_ALIGN, PG8_SP2>(F.lds, g, S, E, F.tid); }
        } SEAM(pb + 4);
        if (PHM(7) && IN(pb + 5)) for (int rep = 0; rep < REPS(7); ++rep) { FRESH(); phase_ln1(F, l, rep == 0); } SEAM(pb + 5);
        if (PHM(8) && IN(pb + 6)) for (int rep = 0; rep < REPS(8); ++rep) { FRESH(); phase_scat(F, l); } SEAM(pb + 6);
        if (PHM(9) && IN(pb + 7)) for (int rep = 0; rep < REPS(9); ++rep) { FRESH();
            const int RT = moe_tables(F, l);
            pg8::Gemm g{wsp<bf16>(F, WS_H), wsp<bf16>(F, WS_WUP) + (size_t)l * NE * 2048 * D, RT * 256, NE * 2048, D};
            MoeGatherOrder S; S.init(RT, 8, F.G, F.bx, (const LAS unsigned char*)(F.lds + X_TILEE)); S.tokl = (const LAS unsigned short*)(F.lds + X_TOKL);
            { const int* rowtok = wsp<int>(F, WS_ROWTOK); LAS unsigned short* tl = (LAS unsigned short*)(F.lds + X_TOKL); pg8::Unit uu;
              for (int i = 0; i < TOKL_UNITS && S.next(i, uu); ++i) if (F.tid < 256) tl[i * 256 + F.tid] = (unsigned short)(rowtok[uu.pm * 256 + F.tid] >> 2);
              __syncthreads(); }
            EpiUp E{F.in[I_BUP] + (size_t)l * NE * 2048, wsp<bf16>(F, WS_ACT)};
            stagger(F.bx >> 3, STAG_US);
            pg8::gemm_phase<EpiUp, MoeGatherOrder, PG8_ALIGN, true>(F.lds, g, S, E, F.tid);
        } SEAM(pb + 7);
        if (PHM(10) && IN(pb + 8)) for (int rep = 0; rep < REPS(10); ++rep) { FRESH();
            const int RT = moe_tables(F, l);
            pg8::Gemm g{wsp<bf16>(F, WS_ACT), wsp<bf16>(F, WS_WDN) + (size_t)l * NE * D * FF, RT * 256, NE * D, FF};
            MoeOrder S; S.init(RT, 4, F.G, F.bx, (const LAS unsigned char*)(F.lds + X_TILEE), 1);
            EpiDn E{F.in[I_BDN] + (size_t)l * NE * D, wsp<bf16>(F, WS_XG)};
            stagger(F.bx >> 3, STAG_US);
            pg8::gemm_phase<EpiDn, MoeOrder, PG8_ALIGN, PG8_SP2>(F.lds, g, S, E, F.tid);
        } SEAM(pb + 8);
        if (PHM(11) && IN(pb + 9)) for (int rep = 0; rep < REPS(11); ++rep) { FRESH(); phase_ln2(F, l); } SEAM(pb + 9);
    }
#undef IN
#undef SEAM
#undef FRESH
}

extern "C" void kernel_launch(void* const* d_in, const int* in_sizes, int n_in, void* d_out, int out_size, void* d_ws, size_t ws_size, hipStream_t stream) {
    static int grid = 0;
    if (grid == 0) {
        if (n_in != 20 || out_size != T * D || ws_size < WS_END) { fprintf(stderr, "kernel_launch: unexpected shapes (n_in %d, out %d, ws %zu < %zu)\n", n_in, out_size, ws_size, (size_t)WS_END); grid = -1; return; }
        int dev = 0, cus = 0;
        if (hipGetDevice(&dev) != hipSuccess || hipDeviceGetAttribute(&cus, hipDeviceAttributeMultiprocessorCount, dev) != hipSuccess) { grid = -1; return; }
        if (hipFuncSetAttribute((const void*)fwd, hipFuncAttributeMaxDynamicSharedMemorySize, LDS_BYTES) != hipSuccess) { fprintf(stderr, "kernel_launch: hipFuncSetAttribute failed\n"); grid = -1; return; }
        int per_cu = 0;
        if (hipOccupancyMaxActiveBlocksPerMultiprocessor(&per_cu, (const void*)fwd, 512, LDS_BYTES) != hipSuccess || per_cu < 1) fprintf(stderr, "kernel_launch: occupancy query says %d blocks per CU\n", per_cu);
        (void)hipGetLastError();
        grid = cus;
    }
    if (grid < 0) return;
    (void)in_sizes;
    if (hipMemsetAsync((char*)d_ws + WS_CTL, 0, CTL_ZERO_BYTES, stream) != hipSuccess) return;
    Args a{};
    for (int i = 0; i < 20; ++i) a.in[i] = (const float*)d_in[i];
    a.out = (float*)d_out; a.ws = (unsigned char*)d_ws;
#if MK_PER_PHASE
    for (int p = 0; p < NPHASE; ++p) { a.ph_lo = p; a.ph_hi = p + 1; hipLaunchKernelGGL(fwd, dim3(grid), dim3(512), LDS_BYTES, stream, a); }
#else
    a.ph_lo = 0; a.ph_hi = NPHASE;
    hipLaunchKernelGGL(fwd, dim3(grid), dim3(512), LDS_BYTES, stream, a);
#endif
    const hipError_t le = hipPeekAtLastError();
    if (le != hipSuccess) fprintf(stderr, "kernel_launch: launch failed: %s\n", hipGetErrorName(le));
}
```

```cpp
#include <hip/hip_runtime.h>
#include <cstdio>
#include <cstdint>
#ifndef MK_PER_PHASE
#define MK_PER_PHASE 0
#endif
namespace pg8 {
#define PG8_LAS __attribute__((address_space(3)))
typedef unsigned short bf16_t;
typedef short bf16x8 __attribute__((ext_vector_type(8)));
typedef float f32x4 __attribute__((ext_vector_type(4)));
typedef unsigned u32x4 __attribute__((ext_vector_type(4)));
constexpr int BM = 256, BK = 64, HALF = 128, HTB = HALF * BK * 2  , STAGE_BYTES = 8 * HTB, NXCD = 8;
#ifndef PG8_WGM
#define PG8_WGM 8
#endif
constexpr int WGM = PG8_WGM;

__host__ __device__ __forceinline__ int lds_byte(int r, int c) { const int st = (r >> 4) * 2 + (c >> 5), rr = r & 15, cc = c & 31, ob = rr * 64 + cc * 2; return st * 1024 + (ob ^ (((ob >> 9) & 1) << 5)); }
__host__ __device__ __forceinline__ void stage_rc(int b, int& R, int& C) { const int st = b / 1024, sb = b % 1024, swz = sb ^ (((sb >> 9) & 1) << 5); R = (st >> 1) * 16 + swz / 64; C = (st & 1) * 32 + (swz % 64) / 2; }
__host__ __device__ __forceinline__ int perm32(int rho) { const int n = rho >> 4, i = rho & 15; return 8 * (i >> 2) + 4 * n + (i & 3); }

struct Unit { int pm, pn; };
struct Gemm { const bf16_t* A; const bf16_t* Bt; int M, N, K; };

struct StaticOrder {
    static constexpr bool GATHER = false; __device__ __forceinline__ int arow(int, int r) const { return r; }
    int nM, nN, nwg, G, c;
    __host__ __device__ void init(int M, int N, int G_, int c_) { nM = M / BM; nN = N / BM; nwg = nM * nN; G = G_; c = c_; }
    __host__ __device__ bool next(int i, Unit& u) const {
        const long L = (long)i * G + c; if (L >= nwg) return false;
        int wgid = (int)L; { const int q = nwg / NXCD, r = nwg % NXCD, xcd = wgid % NXCD, off = wgid / NXCD; wgid = (xcd < r ? xcd * (q + 1) : r * (q + 1) + (xcd - r) * q) + off; }
        const int nig = WGM * nN, gid = wgid / nig, fm = gid * WGM, gsz = (nM - fm) < WGM ? (nM - fm) : WGM;
        u.pm = fm + ((wgid % nig) % gsz); u.pn = (wgid % nig) / gsz; return true;
    }
    __device__ __forceinline__ void a_ready(const Unit&) const {}
    __device__ __forceinline__ void done(const Unit&) const {}
};

__device__ __forceinline__ unsigned cvt_pk_bf16(float lo, float hi) { unsigned r; asm volatile("v_cvt_pk_bf16_f32 %0, %1, %2" : "=v"(r) : "v"(lo), "v"(hi)); return r; }
typedef float f32x2 __attribute__((ext_vector_type(2)));

template <class Epi, class Sched, bool ALIGN_EPI = false, bool SP2 = false>
__device__ __forceinline__ void gemm_phase(PG8_LAS unsigned char* lds, const Gemm g, const Sched& S, const Epi& E, const int tid_in) {
    const int tid = tid_in, wid = __builtin_amdgcn_readfirstlane(tid >> 6), lane = tid & 63, wr = wid >> 2, wc = wid & 3, fr = lane & 15, fq = lane >> 4;
    const int K = g.K, nt = K / BK;
    unsigned voffA[2], voffB[2];
#pragma unroll
    for (int i = 0; i < 2; ++i) { int R, C; stage_rc(tid * 16 + i * 8192, R, C); const int Rb = Epi::PERM ? ((R & ~31) + perm32(R & 31)) : R;
        voffA[i] = (unsigned)(R * K + C) * 2u; voffB[i] = (unsigned)(Rb * K + C) * 2u; }
    const size_t kstep = (size_t)(BK * 2);
    const size_t hstep = (size_t)HALF * K * 2;
    const size_t tstep = 2 * hstep;
    const unsigned ldsw = (unsigned)wid * 1024u;
    const int aoff = lds_byte(wr * 64 + fr, fq * 8), boff = lds_byte(wc * 32 + fr, fq * 8);
#define PG8_SA(b, h) (((b) * 2 + (h)) * HTB)
#define PG8_SB(b, h) ((4 + (b) * 2 + (h)) * HTB)
    unsigned gc[2][2], gn[2][2];
#define PG8_GOFF(dst, pmv, ordv) do { if constexpr (Sched::GATHER) { _Pragma("unroll") for (int _h = 0; _h < 2; ++_h) _Pragma("unroll") for (int _i = 0; _i < 2; ++_i) { int _R, _C; stage_rc(tid * 16 + _i * 8192, _R, _C); \
        dst[_h][_i] = (unsigned)S.arow((ordv), (pmv) * 256 + _h * 128 + _R) * (unsigned)(K * 2) + (unsigned)(_C * 2); } } } while (0)
#define PG8_STAGE_A(bufoff, origptr, nextf, hh, kbytes) do { if constexpr (Sched::GATHER) { _Pragma("unroll") for (int _i = 0; _i < 2; ++_i) { const unsigned _o = (nextf) ? gn[hh][_i] : gc[hh][_i]; \
        __builtin_amdgcn_global_load_lds((const unsigned*)((const char*)g.A + (kbytes) + _o), (PG8_LAS unsigned*)(lds + (bufoff) + ldsw + _i * 8192), 16, 0, 0); } } else { PG8_STAGE(bufoff, origptr, voffA); } } while (0)
#define PG8_STAGE(bufoff, gbase, voff) do { _Pragma("unroll") for (int _i = 0; _i < 2; ++_i) \
        __builtin_amdgcn_global_load_lds((const unsigned*)((const char*)(gbase) + (voff)[_i]), (PG8_LAS unsigned*)(lds + (bufoff) + ldsw + _i * 8192), 16, 0, 0); } while (0)
#define PG8_LDA(dst, b, h) do { _Pragma("unroll") for (int m = 0; m < 4; ++m) _Pragma("unroll") for (int k = 0; k < 2; ++k) dst[m][k] = *(const PG8_LAS bf16x8*)(lds + PG8_SA(b, h) + aoff + m * 2048 + k * 1024); } while (0)
#define PG8_LDB(dst, b, h) do { _Pragma("unroll") for (int n = 0; n < 2; ++n) _Pragma("unroll") for (int k = 0; k < 2; ++k) dst[n][k] = *(const PG8_LAS bf16x8*)(lds + PG8_SB(b, h) + boff + n * 2048 + k * 1024); } while (0)
#define PG8_MMA(ai, bj, At, Bt) do { __builtin_amdgcn_s_setprio(1); _Pragma("unroll") for (int m = 0; m < 4; ++m) _Pragma("unroll") for (int n = 0; n < 2; ++n) _Pragma("unroll") for (int k = 0; k < 2; ++k) \
        acc[ai][bj][m][n] = __builtin_amdgcn_mfma_f32_16x16x32_bf16(Bt[n][k], At[m][k], acc[ai][bj][m][n], 0, 0, 0); __builtin_amdgcn_s_setprio(0); } while (0)
#define PG8_WAIT_V(n) asm volatile("s_waitcnt vmcnt(" #n ")" ::: "memory")
#define PG8_WAIT_L(n) asm volatile("s_waitcnt lgkmcnt(" #n ")" ::: "memory")
#define PG8_BAR __builtin_amdgcn_s_barrier()
#define PG8_SCHED __builtin_amdgcn_sched_barrier(0)
    Unit cur, nxt; int ui = 0;
    if (!S.next(0, cur)) return;
    f32x4 acc[2][2][4][2];
#pragma unroll
    for (int a = 0; a < 2; ++a)
#pragma unroll
        for (int b = 0; b < 2; ++b)
#pragma unroll
            for (int m = 0; m < 4; ++m)
#pragma unroll
                for (int n = 0; n < 2; ++n) acc[a][b][m][n] = (f32x4){0.f, 0.f, 0.f, 0.f};
    bf16x8 At[4][2], B0[2][2], B1[2][2];
    const char* cA = (const char*)g.A + (size_t)cur.pm * tstep; const char* cB = (const char*)g.Bt + (size_t)cur.pn * tstep;
    S.a_ready(cur);
    PG8_GOFF(gc, cur.pm, 0);
    if constexpr (SP2) {
        PG8_STAGE(PG8_SB(0, 0), cB, voffB); PG8_STAGE(PG8_SB(0, 1), cB + hstep, voffB); PG8_STAGE_A(PG8_SA(0, 0), cA, false, 0, 0); PG8_STAGE_A(PG8_SA(0, 1), cA + hstep, false, 1, 0);
        if (wr == 1) PG8_BAR;
        PG8_WAIT_V(2); PG8_BAR;
        PG8_STAGE(PG8_SB(1, 0), cB + kstep, voffB); PG8_STAGE_A(PG8_SA(1, 0), cA + kstep, false, 0, kstep); PG8_STAGE(PG8_SB(1, 1), cB + hstep + kstep, voffB);
        PG8_WAIT_V(6); PG8_BAR;
    } else {
        PG8_STAGE(PG8_SB(0, 0), cB, voffB); PG8_STAGE(PG8_SA(0, 0), cA, voffA); PG8_STAGE(PG8_SB(0, 1), cB + hstep, voffB); PG8_STAGE(PG8_SA(0, 1), cA + hstep, voffA);
        if (wr == 1) PG8_BAR;
        PG8_WAIT_V(4); PG8_BAR;
        PG8_STAGE(PG8_SB(1, 0), cB + kstep, voffB); PG8_STAGE(PG8_SA(1, 0), cA + kstep, voffA); PG8_STAGE(PG8_SB(1, 1), cB + hstep + kstep, voffB);
        PG8_WAIT_V(6); PG8_BAR;
    }
    for (;;) {
        const bool has_next = S.next(ui + 1, nxt);
        if constexpr (Sched::GATHER) { if (has_next) { PG8_GOFF(gn, nxt.pm, ui + 1); } else { gn[0][0] = gc[0][0]; gn[0][1] = gc[0][1]; gn[1][0] = gc[1][0]; gn[1][1] = gc[1][1]; } }
        const char* nA = has_next ? (const char*)g.A + (size_t)nxt.pm * tstep : cA; const char* nB = has_next ? (const char*)g.Bt + (size_t)nxt.pn * tstep : cB;
#pragma unroll
        for (int seg = 0; seg < (Epi::MID_T > 0 ? 2 : 1); ++seg) {
        if constexpr (Epi::MID_T > 0) { if (seg == 1) { PG8_SCHED; E.mid(acc, cur, wr, wc, fr, fq); PG8_SCHED; } }
        const int t_lo = seg ? Epi::MID_T : 0, t_hi = (Epi::MID_T > 0 && seg == 0) ? Epi::MID_T : nt;
        for (int t = t_lo; t < t_hi; t += 2) {
            const bool last = (t == nt - 2);
            const char* a1 = cA + (size_t)(t + 1) * kstep;
            const char* a2 = last ? nA : cA + (size_t)(t + 2) * kstep; const char* b2 = last ? nB : cB + (size_t)(t + 2) * kstep;
            const char* a3 = a2 + kstep; const char* b3 = b2 + kstep; const size_t k2b = last ? (size_t)0 : (size_t)(t + 2) * kstep;
            if (last && has_next) S.a_ready(nxt);
            if constexpr (SP2) {
            PG8_LDB(B0, 0, 0); PG8_LDB(B1, 0, 1); PG8_SCHED; PG8_LDA(At, 0, 0); PG8_STAGE_A(PG8_SA(1, 1), a1 + hstep, false, 1, (size_t)(t + 1) * kstep);
            PG8_WAIT_V(8); PG8_WAIT_L(0); PG8_BAR; PG8_MMA(0, 0, At, B0); PG8_MMA(0, 1, At, B1); PG8_BAR; PG8_SCHED;
            PG8_LDA(At, 0, 1); PG8_STAGE(PG8_SB(0, 0), b2, voffB); PG8_STAGE(PG8_SB(0, 1), b2 + hstep, voffB); PG8_STAGE_A(PG8_SA(0, 0), a2, last, 0, k2b);
            PG8_WAIT_V(8); PG8_WAIT_L(0); PG8_BAR; PG8_MMA(1, 0, At, B0); PG8_MMA(1, 1, At, B1); PG8_BAR; PG8_SCHED;
            PG8_LDB(B0, 1, 0); PG8_LDB(B1, 1, 1); PG8_SCHED; PG8_LDA(At, 1, 0); PG8_STAGE_A(PG8_SA(0, 1), a2 + hstep, last, 1, k2b);
            PG8_WAIT_V(8); PG8_WAIT_L(0); PG8_BAR; PG8_MMA(0, 0, At, B0); PG8_MMA(0, 1, At, B1); PG8_BAR; PG8_SCHED;
            PG8_LDA(At, 1, 1); PG8_STAGE(PG8_SB(1, 0), b3, voffB); PG8_STAGE(PG8_SB(1, 1), b3 + hstep, voffB); PG8_STAGE_A(PG8_SA(1, 0), a3, last, 0, k2b + kstep);
            PG8_WAIT_V(8); PG8_WAIT_L(0); PG8_BAR; PG8_MMA(1, 0, At, B0); PG8_MMA(1, 1, At, B1); PG8_BAR; PG8_SCHED;
            } else {
            PG8_LDB(B0, 0, 0); PG8_SCHED; PG8_LDA(At, 0, 0); PG8_STAGE(PG8_SA(1, 1), a1 + hstep, voffA);
            PG8_WAIT_L(8); PG8_BAR; PG8_WAIT_L(0); PG8_MMA(0, 0, At, B0); PG8_BAR; PG8_SCHED;
            PG8_LDB(B1, 0, 1); PG8_STAGE(PG8_SB(0, 0), b2, voffB);
            PG8_BAR; PG8_WAIT_L(0); PG8_MMA(0, 1, At, B1); PG8_BAR;
            PG8_LDA(At, 0, 1); PG8_STAGE(PG8_SA(0, 0), a2, voffA);
            PG8_BAR; PG8_WAIT_L(0); PG8_MMA(1, 0, At, B0); PG8_BAR; PG8_SCHED;
            PG8_STAGE(PG8_SB(0, 1), b2 + hstep, voffB);
            PG8_WAIT_V(6); PG8_BAR; PG8_MMA(1, 1, At, B1); PG8_BAR;
            PG8_LDB(B0, 1, 0); PG8_SCHED; PG8_LDA(At, 1, 0); PG8_STAGE(PG8_SA(0, 1), a2 + hstep, voffA);
            PG8_WAIT_L(8); PG8_BAR; PG8_WAIT_L(0); PG8_MMA(0, 0, At, B0); PG8_BAR; PG8_SCHED;
            PG8_LDB(B1, 1, 1); PG8_STAGE(PG8_SB(1, 0), b3, voffB);
            PG8_BAR; PG8_WAIT_L(0); PG8_MMA(0, 1, At, B1); PG8_BAR;
            PG8_LDA(At, 1, 1); PG8_STAGE(PG8_SA(1, 0), a3, voffA);
            PG8_BAR; PG8_WAIT_L(0); PG8_MMA(1, 0, At, B0); PG8_BAR; PG8_SCHED;
            PG8_STAGE(PG8_SB(1, 1), b3 + hstep, voffB);
            PG8_WAIT_V(6); PG8_BAR; PG8_MMA(1, 1, At, B1); PG8_BAR;
            }
        }
        }
        if constexpr (ALIGN_EPI) { if (wr == 0) PG8_BAR; }
        if constexpr (!Epi::AFTER_DRAIN) { E(acc, cur, wr, wc, fr, fq); S.done(cur); }
        if (!has_next) break;
#pragma unroll
        for (int a = 0; a < 2; ++a)
#pragma unroll
            for (int b = 0; b < 2; ++b)
#pragma unroll
                for (int m = 0; m < 4; ++m)
#pragma unroll
                    for (int n = 0; n < 2; ++n) acc[a][b][m][n] = (f32x4){0.f, 0.f, 0.f, 0.f};
        cur = nxt; cA = nA; cB = nB; ++ui;
        if constexpr (Sched::GATHER) { gc[0][0] = gn[0][0]; gc[0][1] = gn[0][1]; gc[1][0] = gn[1][0]; gc[1][1] = gn[1][1]; }
        if constexpr (ALIGN_EPI) { if (wr == 1) PG8_BAR; }
    }
    PG8_WAIT_V(0);
    if constexpr (!ALIGN_EPI) { if (wr == 0) PG8_BAR; }
    PG8_BAR;
    if constexpr (Epi::AFTER_DRAIN) { E.fused(acc, cur, wr, wc, fr, fq, lds, wid, lane); S.done(cur); }
#undef PG8_SA
#undef PG8_SB
#undef PG8_STAGE
#undef PG8_STAGE_A
#undef PG8_GOFF
#undef PG8_LDA
#undef PG8_LDB
#undef PG8_MMA
#undef PG8_WAIT_V
#undef PG8_WAIT_L
#undef PG8_BAR
#undef PG8_SCHED
}
}
#define LAS __attribute__((address_space(3)))
#define XB_TMO      128
#define XB_XCNT(j)  (256  + 64 * (j))
#define XB_XSUB(j)  (1280 + 64 * (j))
#define XB_XGEN(j)  (2304 + 64 * (j))
#define XB_TOP      3328
#define XB_TOPGEN   3392
#define XCD_BAR_WORDS 3456
#define XB_SPIN_CAP (1u << 18)

__device__ __forceinline__ unsigned xb_ld(unsigned* p)              { return __hip_atomic_load(p, __ATOMIC_RELAXED, __HIP_MEMORY_SCOPE_AGENT); }
__device__ __forceinline__ unsigned xb_add(unsigned* p, unsigned v) { return __hip_atomic_fetch_add(p, v, __ATOMIC_RELAXED, __HIP_MEMORY_SCOPE_AGENT); }
__device__ __forceinline__ unsigned xb_xcc_id() { return (unsigned)__builtin_amdgcn_s_getreg((3 << 11) | 20) & 0xFu; }
#define XB_SPIN(cond, bar) do { unsigned _sp = 0; while (cond) { __builtin_amdgcn_s_sleep(1); \
    if ((++_sp & 255u) == 0u) { if (xb_ld(&(bar)[XB_TMO])) break; if (_sp > XB_SPIN_CAP) { atomicAdd(&(bar)[XB_TMO], 1u); break; } } } } while (0)

struct XcdBarrier {
    unsigned* bar; unsigned x;
    volatile LAS unsigned* st;
};

__device__ __forceinline__ XcdBarrier xcd_barrier_post(unsigned* bar, volatile LAS unsigned* st) {
    XcdBarrier b; b.bar = bar; b.x = xb_xcc_id(); b.st = st;
    if (threadIdx.x == 0) (void)xb_add(&bar[XB_XCNT(b.x)], 1u);
    return b;
}
__device__ __forceinline__ void xcd_barrier_complete(unsigned* bar, unsigned x, unsigned& nloc, unsigned& nx) {
    const unsigned G = gridDim.x * gridDim.y * gridDim.z;
    unsigned sum, cnt, mine, sp = 0u;
    for (;;) {
        sum = 0u; cnt = 0u; mine = 0u;
#pragma unroll
        for (unsigned j = 0; j < 16; ++j) { const unsigned c = xb_ld(&bar[XB_XCNT(j)]); sum += c; cnt += (c > 0u) ? 1u : 0u; mine = (j == x) ? c : mine; }
        if (sum == G) break;
        __builtin_amdgcn_s_sleep(1);
        if ((++sp & 255u) == 0u) { if (xb_ld(&bar[XB_TMO])) break; if (sp > XB_SPIN_CAP) { atomicAdd(&bar[XB_TMO], 1u); break; } }
    }
    nloc = mine > 0u ? mine : 1u; nx = cnt > 0u ? cnt : 1u;
}

__device__ __forceinline__ void xcd_barrier(const XcdBarrier& b) {
    asm volatile("s_waitcnt vmcnt(0)" ::: "memory");
    __syncthreads();
    if (threadIdx.x == 0) {
        unsigned* bar = b.bar;
        __builtin_amdgcn_s_waitcnt(0);
        unsigned nloc = b.st[0], nx = b.st[1];
        if (nloc == 0u) { xcd_barrier_complete(bar, b.x, nloc, nx); b.st[0] = nloc; b.st[1] = nx; }
        const unsigned old = xb_add(&bar[XB_XSUB(b.x)], 1u);
        const unsigned gen = old / nloc;
        if (old + 1u == (gen + 1u) * nloc) {
            __builtin_amdgcn_fence(__ATOMIC_RELEASE, "agent");
            asm volatile("s_waitcnt vmcnt(0)" ::: "memory");
            const unsigned og = xb_add(&bar[XB_TOP], 1u);
            const unsigned tg = og / nx;
            if (og + 1u == (tg + 1u) * nx) xb_add(&bar[XB_TOPGEN], 1u);
            else XB_SPIN(xb_ld(&bar[XB_TOPGEN]) == tg, bar);
            __builtin_amdgcn_fence(__ATOMIC_ACQUIRE, "agent");
            xb_add(&bar[XB_XGEN(b.x)], 1u);
            asm volatile("s_waitcnt vmcnt(0)" ::: "memory");
        } else {
            XB_SPIN(xb_ld(&bar[XB_XGEN(b.x)]) == gen, bar);
            __builtin_amdgcn_fence(__ATOMIC_ACQUIRE, "agent");
            asm volatile("s_waitcnt vmcnt(0)" ::: "memory");
        }
    }
    __syncthreads();
}


#ifndef PG8_SP2
#define PG8_SP2 true
#endif
#ifndef PG8_ALIGN
#define PG8_ALIGN true
#endif
constexpr int D = 1024, NB = 8, SEQ = 4096, T = NB * SEQ, NL = 4;
constexpr int NIN = 8704, NE = 32, FF = 1024;
constexpr int RMAX = 139264;
constexpr float LN_EPS = 1e-5f, DN_ALPHA = 1.681792830507429f;
constexpr float QSCALE = 0.18033688011112042f;
constexpr float LOG2E = 1.4426950408889634f;

constexpr size_t MiB = 1u << 20;
constexpr size_t WS_CTL = 0, CTL_ZERO_BYTES = 1 * MiB;
constexpr size_t WS_MOD = 1 * MiB;
constexpr size_t WS_ROPE = 2 * MiB;
constexpr size_t WS_WSP = 3 * MiB;
constexpr size_t WS_WRT = 4 * MiB;
constexpr size_t WS_TOKINFO = 5 * MiB;
constexpr size_t WS_TOKW = 5 * MiB + 512 * 1024;
constexpr size_t WS_ROWTOK = 6 * MiB;
constexpr size_t WS_ROWW = 7 * MiB;
constexpr size_t WS_LSE = 8 * MiB;
constexpr size_t WS_TOKROW = 14 * MiB;
constexpr size_t WS_STAT = 13 * MiB;
constexpr size_t WS_WGCNT = 12 * MiB;
constexpr size_t WS_WIN = 16 * MiB;
constexpr size_t WS_WBA = 84 * MiB;
constexpr size_t WS_WBB = 92 * MiB;
constexpr size_t WS_WOUT = 96 * MiB;
constexpr size_t WS_WUP = 104 * MiB;
constexpr size_t WS_WDN = 616 * MiB;
constexpr size_t WS_H = 872 * MiB;
constexpr size_t WS_X1 = 936 * MiB;
constexpr size_t WS_X2 = 1064 * MiB;
constexpr size_t WS_YPRE = 1192 * MiB;
constexpr size_t WS_U = 1320 * MiB, WS_V = 1384 * MiB;
constexpr size_t WS_Q = 1448 * MiB, WS_K = 1544 * MiB, WS_VV = 1640 * MiB;
constexpr size_t WS_G = 1736 * MiB;
constexpr size_t WS_OG = 1864 * MiB;
constexpr size_t WS_TT = 1960 * MiB;
constexpr size_t WS_OB = 2024 * MiB;
constexpr size_t WS_YA = 2056 * MiB;
constexpr size_t WS_MG = 2120 * MiB;
constexpr size_t WS_XG = 2184 * MiB;
constexpr size_t WS_ACT = 2456 * MiB;
constexpr size_t WS_YK = 2728 * MiB;
constexpr size_t WS_END = 2984 * MiB;
constexpr int CW_BAR = 4096;
constexpr int CW_CNT = 16384;

constexpr int RING_BYTES = 131072;
constexpr int XOFF = RING_BYTES;
constexpr int X_MISC = XOFF;
constexpr int X_SELE = XOFF + 256;
constexpr int X_SELR = XOFF + 2304;
constexpr int X_CNTL = XOFF + 4352;
constexpr int X_BASE = XOFF + 4480;
constexpr int X_TILEE = XOFF + 4608;
constexpr int X_CNTS = XOFF + 5632;
constexpr int X_OFFS = XOFF + 5760;
constexpr int LDS_BYTES = 147456;

#define GAS __attribute__((address_space(1)))
typedef unsigned short bf16;
typedef unsigned v4u __attribute__((ext_vector_type(4)));
typedef unsigned v2u __attribute__((ext_vector_type(2)));
typedef float f32x4 __attribute__((ext_vector_type(4)));
typedef short bf16x8 __attribute__((ext_vector_type(8)));
typedef short s16x4 __attribute__((ext_vector_type(4)));
#define RLX_AGENT __ATOMIC_RELAXED, __HIP_MEMORY_SCOPE_AGENT
#define LDS_WAIT() asm volatile("s_waitcnt lgkmcnt(0)" ::: "memory")
#define VM_WAIT() asm volatile("s_waitcnt vmcnt(0)" ::: "memory")

typedef __bf16 bf16x2_t __attribute__((ext_vector_type(2))); typedef float f32x2_t __attribute__((ext_vector_type(2)));
__device__ __forceinline__ unsigned pk2(float lo, float hi) { return __builtin_bit_cast(unsigned, __builtin_convertvector((f32x2_t){lo, hi}, bf16x2_t)); }
__device__ __forceinline__ float bflo(unsigned w) { return __uint_as_float(w << 16); }
__device__ __forceinline__ float bfhi(unsigned w) { return __uint_as_float(w & 0xffff0000u); }
__device__ __forceinline__ float fexp2(float x) { return __builtin_amdgcn_exp2f(x); }
__device__ __forceinline__ float frcp(float x) { return __builtin_amdgcn_rcpf(x); }
__device__ __forceinline__ float gelu_tanh(float x) { const float u = x + 0.044715f * x * x * x; return x * frcp(1.0f + fexp2(-2.302208198144325f * u)); }
__device__ __forceinline__ float sigmoidf_(float x) { return frcp(1.0f + fexp2(-LOG2E * x)); }
__device__ __forceinline__ float wave_sum(float v) {
#pragma unroll
    for (int o = 1; o < 64; o <<= 1) v += __shfl_xor(v, o);
    return v;
}
__device__ __forceinline__ float wave_max(float v) {
#pragma unroll
    for (int o = 1; o < 64; o <<= 1) v = fmaxf(v, __shfl_xor(v, o));
    return v;
}
__device__ __forceinline__ s16x4 tr16(const LAS unsigned char* p) { return __builtin_bit_cast(s16x4, __builtin_amdgcn_ds_read_tr16_b64_v4i16((LAS s16x4*)p)); }
__device__ __forceinline__ bf16x8 cat8(s16x4 lo, s16x4 hi) { return (bf16x8){lo[0], lo[1], lo[2], lo[3], hi[0], hi[1], hi[2], hi[3]}; }
__device__ __forceinline__ f32x4 mfma16(bf16x8 a, bf16x8 b, f32x4 c) { return __builtin_amdgcn_mfma_f32_16x16x32_bf16(a, b, c, 0, 0, 0); }

struct Frame {
    LAS unsigned char* lds;
    int tid, lane, wave, G, vcu, bx;
    unsigned char* ws;
    const float* const* in;
    float* out;
};
enum { I_X = 0, I_C, I_WADA, I_BADA, I_WIN, I_SPW, I_SPB, I_WBA, I_WBB, I_WOUT, I_LN1G, I_LN1B, I_WR, I_BR, I_WUP, I_BUP, I_WDN, I_BDN, I_LN2G, I_LN2B };
template <class Tp> __device__ __forceinline__ Tp* wsp(const Frame& F, size_t off) { return (Tp*)(F.ws + off); }

template <class P> __device__ __forceinline__ P launder(P p) { unsigned lo = (unsigned)(uintptr_t)p, hi = (unsigned)((uintptr_t)p >> 32); asm volatile("" : "+v"(lo), "+v"(hi));
    lo = (unsigned)__builtin_amdgcn_readfirstlane((int)lo); hi = (unsigned)__builtin_amdgcn_readfirstlane((int)hi); return (P)(((uintptr_t)hi << 32) | (uintptr_t)lo); }
struct EpiIn {
    static constexpr int MID_T = 0; static constexpr bool PERM = true, AFTER_DRAIN = false;
    bf16 *U, *V, *Q, *K, *VV, *Gt; const float* rope;
    __device__ __forceinline__ void operator()(const f32x4 (&acc)[2][2][4][2], const pg8::Unit& u, int wr, int wc, int fr, int fq) const {
        const int pn = u.pn; int type, ld, colt; bf16* base;
        if (pn < 4) { type = 0; base = U; ld = 1024; colt = pn * 256; }
        else if (pn < 8) { type = 0; base = V; ld = 1024; colt = (pn - 4) * 256; }
        else if (pn < 14) { type = 1; base = Q; ld = 1536; colt = (pn - 8) * 256; }
        else if (pn < 20) { type = 2; base = K; ld = 1536; colt = (pn - 14) * 256; }
        else if (pn < 26) { type = 3; base = VV; ld = 1536; colt = (pn - 20) * 256; }
        else { type = 4; base = Gt; ld = 2048; colt = (pn - 26) * 256; }
        const int row0 = u.pm * 256 + wr * 64 + fr, col0 = colt + wc * 32 + 8 * fq;
        if (type == 0) {
#pragma unroll
            for (int ai = 0; ai < 2; ++ai)
#pragma unroll
                for (int m = 0; m < 4; ++m) { bf16* rowp = base + (size_t)(row0 + ai * 128 + m * 16) * ld + col0;
#pragma unroll
                    for (int bj = 0; bj < 2; ++bj) { const f32x4 v0 = acc[ai][bj][m][0], v1 = acc[ai][bj][m][1]; v4u w;
                        w.x = pk2(gelu_tanh(v0[0]), gelu_tanh(v0[1])); w.y = pk2(gelu_tanh(v0[2]), gelu_tanh(v0[3]));
                        w.z = pk2(gelu_tanh(v1[0]), gelu_tanh(v1[1])); w.w = pk2(gelu_tanh(v1[2]), gelu_tanh(v1[3]));
                        __builtin_nontemporal_store(w, (v4u*)(rowp + bj * 128)); } }
        } else if (type == 4) {
#pragma unroll
            for (int ai = 0; ai < 2; ++ai)
#pragma unroll
                for (int m = 0; m < 4; ++m) { bf16* rowp = base + (size_t)(row0 + ai * 128 + m * 16) * ld + col0;
#pragma unroll
                    for (int bj = 0; bj < 2; ++bj) { const f32x4 v0 = acc[ai][bj][m][0], v1 = acc[ai][bj][m][1]; v4u w;
                        w.x = pk2(sigmoidf_(v0[0]), sigmoidf_(v0[1])); w.y = pk2(sigmoidf_(v0[2]), sigmoidf_(v0[3]));
                        w.z = pk2(sigmoidf_(v1[0]), sigmoidf_(v1[1])); w.w = pk2(sigmoidf_(v1[2]), sigmoidf_(v1[3]));
                        __builtin_nontemporal_store(w, (v4u*)(rowp + bj * 128)); } }
        } else if (type == 3) {
#pragma unroll
            for (int ai = 0; ai < 2; ++ai)
#pragma unroll
                for (int m = 0; m < 4; ++m) { bf16* rowp = base + (size_t)(row0 + ai * 128 + m * 16) * ld + col0;
#pragma unroll
                    for (int bj = 0; bj < 2; ++bj) { const f32x4 v0 = acc[ai][bj][m][0], v1 = acc[ai][bj][m][1]; v4u w;
                        w.x = pk2(v0[0], v0[1]); w.y = pk2(v0[2], v0[3]); w.z = pk2(v1[0], v1[1]); w.w = pk2(v1[2], v1[3]);
                        __builtin_nontemporal_store(w, (v4u*)(rowp + bj * 128)); } }
        } else {
            const float sc = (type == 1) ? QSCALE : 1.0f;
            const bool ropew = (wc & 1) == 0;
#pragma unroll
            for (int ai = 0; ai < 2; ++ai)
#pragma unroll
                for (int m = 0; m < 4; ++m) { const int row = row0 + ai * 128 + m * 16; bf16* rowp = base + (size_t)row * ld + col0;
                    float cs[8], sn[8];
                    if (ropew) { const f32x4* rp = (const f32x4*)(rope + (size_t)(row & (SEQ - 1)) * 16); const f32x4 c0 = rp[0], c1 = rp[1], s0 = rp[2], s1 = rp[3];
#pragma unroll
                        for (int e = 0; e < 4; ++e) { cs[e] = c0[e]; cs[4 + e] = c1[e]; sn[e] = s0[e]; sn[4 + e] = s1[e]; } }
#pragma unroll
                    for (int bj = 0; bj < 2; ++bj) { f32x4 v0 = acc[ai][bj][m][0], v1 = acc[ai][bj][m][1];
                        if (ropew) {
#pragma unroll
                            for (int e = 0; e < 8; ++e) { const float x = (e < 4) ? v0[e & 3] : v1[e & 3]; const float p = __shfl_xor(x, 16);
                                float y = x;
                                if (fq == 0) y = x * cs[e] - p * sn[e];
                                if (fq == 1) y = x * cs[e] + p * sn[e];
                                if (e < 4) v0[e & 3] = y; else v1[e & 3] = y; } }
                        v4u w; w.x = pk2(v0[0] * sc, v0[1] * sc); w.y = pk2(v0[2] * sc, v0[3] * sc); w.z = pk2(v1[0] * sc, v1[1] * sc); w.w = pk2(v1[2] * sc, v1[3] * sc);
                        __builtin_nontemporal_store(w, (v4u*)(rowp + bj * 128)); } }
        }
    }
};
struct EpiProbe {
    static constexpr int MID_T = 0; static constexpr bool PERM = true, AFTER_DRAIN = false;
    bf16* O; int ld; int on;
    __device__ __forceinline__ void operator()(const f32x4 (&acc)[2][2][4][2], const pg8::Unit& u, int wr, int wc, int fr, int fq) const {
        if (!on) return;
        const int row0 = u.pm * 256 + wr * 64 + fr, col0 = ((on == 3) ? u.pn : (u.pn & 3)) * 256 + wc * 32 + 8 * fq;
#pragma unroll
        for (int ai = 0; ai < 2; ++ai)
#pragma unroll
            for (int m = 0; m < 4; ++m) { bf16* rowp = O + (size_t)(row0 + ai * 128 + m * 16) * ld + col0;
#pragma unroll
                for (int bj = 0; bj < 2; ++bj) { const f32x4 v0 = acc[ai][bj][m][0], v1 = acc[ai][bj][m][1]; v4u w;
                    w.x = pk2(v0[0], v0[1]); w.y = pk2(v0[2], v0[3]); w.z = pk2(v1[0], v1[1]); w.w = pk2(v1[2], v1[3]);
                    *(v4u*)(rowp + bj * 128) = w; } }
    }
};
struct EpiYA {
    static constexpr int MID_T = 0; static constexpr bool PERM = true, AFTER_DRAIN = false;
    const bf16* Gt; bf16* YA;
    __device__ __forceinline__ void operator()(const f32x4 (&acc)[2][2][4][2], const pg8::Unit& u, int wr, int wc, int fr, int fq) const {
        const int row0 = u.pm * 256 + wr * 64 + fr, col0 = u.pn * 256 + wc * 32 + 8 * fq;
#pragma unroll
        for (int ai = 0; ai < 2; ++ai)
#pragma unroll
            for (int m = 0; m < 4; ++m) { const size_t row = (size_t)(row0 + ai * 128 + m * 16);
#pragma unroll
                for (int bj = 0; bj < 2; ++bj) { const f32x4 v0 = acc[ai][bj][m][0], v1 = acc[ai][bj][m][1];
                    const v4u g = *(const v4u*)(Gt + row * 2048 + col0 + bj * 128); v4u w;
                    w.x = pk2(v0[0] * bflo(g.x), v0[1] * bfhi(g.x)); w.y = pk2(v0[2] * bflo(g.y), v0[3] * bfhi(g.y));
                    w.z = pk2(v1[0] * bflo(g.z), v1[1] * bfhi(g.z)); w.w = pk2(v1[2] * bflo(g.w), v1[3] * bfhi(g.w));
                    *(v4u*)(YA + row * 1024 + col0 + bj * 128) = w; } }
    }
};
struct EpiMg {
    static constexpr int MID_T = 0; static constexpr bool PERM = true, AFTER_DRAIN = false;
    const bf16* Gt; const bf16* YA; bf16* MG;
    __device__ __forceinline__ void operator()(const f32x4 (&acc)[2][2][4][2], const pg8::Unit& u, int wr, int wc, int fr, int fq) const {
        const int row0 = u.pm * 256 + wr * 64 + fr, col0 = u.pn * 256 + wc * 32 + 8 * fq;
#pragma unroll
        for (int ai = 0; ai < 2; ++ai)
#pragma unroll
            for (int m = 0; m < 4; ++m) { const size_t row = (size_t)(row0 + ai * 128 + m * 16);
#pragma unroll
                for (int bj = 0; bj < 2; ++bj) { const f32x4 v0 = acc[ai][bj][m][0], v1 = acc[ai][bj][m][1];
                    const v4u g = *(const v4u*)(Gt + row * 2048 + 1024 + col0 + bj * 128); const v4u y = *(const v4u*)(YA + row * 1024 + col0 + bj * 128); v4u w;
                    w.x = pk2(bflo(y.x) + v0[0] * bflo(g.x), bfhi(y.x) + v0[1] * bfhi(g.x)); w.y = pk2(bflo(y.y) + v0[2] * bflo(g.y), bfhi(y.y) + v0[3] * bfhi(g.y));
                    w.z = pk2(bflo(y.z) + v1[0] * bflo(g.z), bfhi(y.z) + v1[1] * bfhi(g.z)); w.w = pk2(bflo(y.w) + v1[2] * bflo(g.w), bfhi(y.w) + v1[3] * bfhi(g.w));
                    *(v4u*)(MG + row * 1024 + col0 + bj * 128) = w; } }
    }
};
struct EpiMg2 {
    static constexpr int MID_T = 16; static constexpr bool PERM = true, AFTER_DRAIN = false;
    const bf16* Gt; bf16* MG;
    __device__ __forceinline__ void mid(f32x4 (&acc)[2][2][4][2], const pg8::Unit& u, int wr, int wc, int fr, int fq) const {
        int row0 = u.pm * 256 + wr * 64 + fr; const int col0 = u.pn * 256 + wc * 32 + 8 * fq;
        asm volatile("" : "+v"(row0));
#pragma unroll
        for (int ai = 0; ai < 2; ++ai)
#pragma unroll
            for (int m = 0; m < 4; ++m) { const size_t row = (size_t)(row0 + ai * 128 + m * 16);
#pragma unroll
                for (int bj = 0; bj < 2; ++bj) { const v4u g0 = *(const v4u*)(Gt + row * 2048 + col0 + bj * 128), g1 = *(const v4u*)(Gt + row * 2048 + 1024 + col0 + bj * 128);
                    const unsigned a0[4] = {g0.x, g0.y, g0.z, g0.w}, a1[4] = {g1.x, g1.y, g1.z, g1.w};
#pragma unroll
                    for (int q = 0; q < 4; ++q) { const float r0 = bflo(a0[q]) * frcp(fmaxf(bflo(a1[q]), 1e-20f)), r1 = bfhi(a0[q]) * frcp(fmaxf(bfhi(a1[q]), 1e-20f));
                        acc[ai][bj][m][q >> 1][(q & 1) * 2] *= r0; acc[ai][bj][m][q >> 1][(q & 1) * 2 + 1] *= r1; } }
                if (m == 3) asm volatile("" ::: "memory"); }
    }
    __device__ __forceinline__ void operator()(const f32x4 (&acc)[2][2][4][2], const pg8::Unit& u, int wr, int wc, int fr, int fq) const {
        const int row0 = u.pm * 256 + wr * 64 + fr, col0 = u.pn * 256 + wc * 32 + 8 * fq;
#pragma unroll
        for (int ai = 0; ai < 2; ++ai)
#pragma unroll
            for (int m = 0; m < 4; ++m) { const size_t row = (size_t)(row0 + ai * 128 + m * 16);
#pragma unroll
                for (int bj = 0; bj < 2; ++bj) { const f32x4 v0 = acc[ai][bj][m][0], v1 = acc[ai][bj][m][1];
                    const v4u g = *(const v4u*)(Gt + row * 2048 + 1024 + col0 + bj * 128); v4u w;
                    w.x = pk2(v0[0] * fmaxf(bflo(g.x), 1e-20f), v0[1] * fmaxf(bfhi(g.x), 1e-20f)); w.y = pk2(v0[2] * fmaxf(bflo(g.y), 1e-20f), v0[3] * fmaxf(bfhi(g.y), 1e-20f));
                    w.z = pk2(v1[0] * fmaxf(bflo(g.z), 1e-20f), v1[1] * fmaxf(bfhi(g.z), 1e-20f)); w.w = pk2(v1[2] * fmaxf(bflo(g.w), 1e-20f), v1[3] * fmaxf(bfhi(g.w), 1e-20f));
                    *(v4u*)(MG + row * 1024 + col0 + bj * 128) = w; } }
    }
};
template <bool XF32> struct EpiOut {
    static constexpr int MID_T = 0; static constexpr bool PERM = true, AFTER_DRAIN = false;
    const void* xres; const float* modl  ; bf16* YPRE;
    __device__ __forceinline__ void operator()(const f32x4 (&acc)[2][2][4][2], const pg8::Unit& u, int wr, int wc, int fr, int fq) const {
        const int row0 = u.pm * 256 + wr * 64 + fr, col0 = u.pn * 256 + wc * 32 + 8 * fq; const int b = (u.pm * 256) >> 12;
        f32x4 gg[2][2];
#pragma unroll
        for (int bj = 0; bj < 2; ++bj)
#pragma unroll
            for (int n = 0; n < 2; ++n) gg[bj][n] = *(const f32x4*)(modl + (size_t)b * 6144 + 2048 + col0 + bj * 128 + 4 * n) + 1.0f;
#pragma unroll
        for (int ai = 0; ai < 2; ++ai)
#pragma unroll
            for (int m = 0; m < 4; ++m) { const size_t off = (size_t)(row0 + ai * 128 + m * 16) * 1024 + col0;
#pragma unroll
                for (int bj = 0; bj < 2; ++bj) { f32x4 x0, x1;
                    if (XF32) { x0 = *(const f32x4*)((const float*)xres + off + bj * 128); x1 = *(const f32x4*)((const float*)xres + off + bj * 128 + 4); }
                    else { const v4u xr = *(const v4u*)((const bf16*)xres + off + bj * 128); x0 = (f32x4){bflo(xr.x), bfhi(xr.x), bflo(xr.y), bfhi(xr.y)}; x1 = (f32x4){bflo(xr.z), bfhi(xr.z), bflo(xr.w), bfhi(xr.w)}; }
                    const f32x4 o0 = x0 * DN_ALPHA + gg[bj][0] * acc[ai][bj][m][0], o1 = x1 * DN_ALPHA + gg[bj][1] * acc[ai][bj][m][1];
                    v4u w; w.x = pk2(o0[0], o0[1]); w.y = pk2(o0[2], o0[3]); w.z = pk2(o1[0], o1[1]); w.w = pk2(o1[2], o1[3]);
                    *(v4u*)(YPRE + off + bj * 128) = w; }
                if (m == 3) asm volatile("" ::: "memory"); }
    }
};
struct EpiUp {
    static constexpr int MID_T = 0; static constexpr bool PERM = true, AFTER_DRAIN = false;
    const float* bup  ; bf16* ACT;
    __device__ __forceinline__ void operator()(const f32x4 (&acc)[2][2][4][2], const pg8::Unit& u, int wr, int wc, int fr, int fq) const {
        const int e = u.pn >> 3, pnl = u.pn & 7; const int row0 = u.pm * 256 + wr * 64 + fr, ac0 = pnl * 128 + wc * 32 + 8 * fq;
        const f32x4* bp = (const f32x4*)(bup + (size_t)e * 2048 + 2 * ac0); const f32x4 b0 = bp[0], b1 = bp[1], b2 = bp[2], b3 = bp[3];
        const float bg[8] = {b0[0], b0[2], b1[0], b1[2], b2[0], b2[2], b3[0], b3[2]}, bl[8] = {b0[1], b0[3], b1[1], b1[3], b2[1], b2[3], b3[1], b3[3]};
#pragma unroll
        for (int ai = 0; ai < 2; ++ai)
#pragma unroll
            for (int m = 0; m < 4; ++m) { float a[8];
#pragma unroll
                for (int j = 0; j < 8; ++j) { const float hg = acc[ai][0][m][j >> 2][j & 3] + bg[j], hl = acc[ai][1][m][j >> 2][j & 3] + bl[j];
                    const float glu = fminf(hg, 7.0f), lin = fminf(fmaxf(hl, -7.0f), 7.0f);
                    a[j] = glu * frcp(1.0f + fexp2(-2.4554669595930156f * glu)) * (lin + 1.0f); }
                v4u w; w.x = pk2(a[0], a[1]); w.y = pk2(a[2], a[3]); w.z = pk2(a[4], a[5]); w.w = pk2(a[6], a[7]);
                *(v4u*)(ACT + (size_t)(row0 + ai * 128 + m * 16) * 1024 + ac0) = w; }
    }
};
struct EpiDn {
    static constexpr int MID_T = 0; static constexpr bool PERM = true, AFTER_DRAIN = false;
    const float* bdn  ; bf16* YKS;
    __device__ __forceinline__ void operator()(const f32x4 (&acc)[2][2][4][2], const pg8::Unit& u, int wr, int wc, int fr, int fq) const {
        const int e = u.pn >> 2, pnl = u.pn & 3; const int row0 = u.pm * 256 + wr * 64 + fr, col0 = pnl * 256 + wc * 32 + 8 * fq;
        f32x4 bv[2][2];
#pragma unroll
        for (int bj = 0; bj < 2; ++bj)
#pragma unroll
            for (int n = 0; n < 2; ++n) bv[bj][n] = *(const f32x4*)(bdn + (size_t)e * 1024 + col0 + bj * 128 + 4 * n);
#pragma unroll
        for (int ai = 0; ai < 2; ++ai)
#pragma unroll
            for (int m = 0; m < 4; ++m) { bf16* op = YKS + (size_t)(row0 + ai * 128 + m * 16) * 1024 + col0;
#pragma unroll
                for (int bj = 0; bj < 2; ++bj) { const f32x4 v0 = acc[ai][bj][m][0] + bv[bj][0], v1 = acc[ai][bj][m][1] + bv[bj][1]; v4u w;
                    w.x = pk2(v0[0], v0[1]); w.y = pk2(v0[2], v0[3]); w.z = pk2(v1[0], v1[1]); w.w = pk2(v1[2], v1[3]);
                    *(v4u*)(op + bj * 128) = w; } }
    }
};
struct MoeOrder {
    static constexpr bool GATHER = false; __device__ __forceinline__ int arow(int, int r) const { return r; }
    int nM, nN, nwg, G, c, rev; const LAS unsigned char* tile_e;
    __device__ void init(int RT, int NN, int G_, int c_, const LAS unsigned char* te, int rev_ = 0) { nM = RT; nN = NN; nwg = RT * NN; G = G_; c = c_; tile_e = te; rev = rev_; }
    __device__ bool next(int i, pg8::Unit& u) const {
        const long L = (long)i * G + c; if (L >= nwg) return false;
        int wgid = (int)L; { const int q = nwg / pg8::NXCD, r = nwg % pg8::NXCD, xcd = wgid % pg8::NXCD, off = wgid / pg8::NXCD; wgid = (xcd < r ? xcd * (q + 1) : r * (q + 1) + (xcd - r) * q) + off; }
        const int nig = pg8::WGM * nN, gid = wgid / nig, fm = gid * pg8::WGM, gsz = (nM - fm) < pg8::WGM ? (nM - fm) : pg8::WGM;
        int pm = fm + ((wgid % nig) % gsz); const int pnl = (wgid % nig) / gsz; if (rev) pm = nM - 1 - pm;
        u.pm = pm; u.pn = (int)tile_e[pm] * nN + pnl; return true;
    }
    __device__ __forceinline__ void a_ready(const pg8::Unit&) const {}
    __device__ __forceinline__ void done(const pg8::Unit&) const {}
};

#ifndef STAG_N
#define STAG_N 1
#endif
#ifndef STAG_US
#define STAG_US 24
#endif
__device__ __forceinline__ void stagger(int slot, int us) {
    if (STAG_N <= 1) return;
    const unsigned long long t0 = __builtin_amdgcn_s_memrealtime(); const unsigned long long ticks = (unsigned long long)(slot % STAG_N) * (unsigned)us * 100ull / STAG_N;
    while (__builtin_amdgcn_s_memrealtime() - t0 < ticks) __builtin_amdgcn_s_sleep(16);
}
struct MoeGatherOrder : MoeOrder {
    static constexpr bool GATHER = true; const LAS unsigned short* tokl;
    __device__ __forceinline__ int arow(int ord, int r) const { return (int)tokl[ord * 256 + (r & 255)]; }
};
constexpr int X_TOKL = XOFF + 6144, TOKL_UNITS = 20;
constexpr int TR_NR = 32, TR_WAVE_BYTES = 64 * 64 * 4;
struct TrItem { const float* src; bf16* dst; int ld, K, kind, k0, c0, koff; };
__device__ __forceinline__ void tr_load(const TrItem& t, int lane, f32x4 (&r)[TR_NR]) {
    const int kq = lane >> 4, cc = lane & 15;
#pragma unroll
    for (int i = 0; i < TR_NR; ++i) r[i] = __builtin_nontemporal_load((const f32x4*)(t.src + (size_t)(t.k0 + 2 * (kq + 4 * (i >> 1)) + (i & 1)) * t.ld + t.c0 + 4 * cc));
}
__device__ __forceinline__ void tr_tile(int lane, LAS unsigned* scr, const f32x4 (&r)[TR_NR]) {
    const int kq = lane >> 4, cc = lane & 15;
#pragma unroll
    for (int i2 = 0; i2 < TR_NR / 2; ++i2) { LAS unsigned* p = scr + (4 * cc) * 64 + ((kq + 4 * i2) ^ (cc << 2));
#pragma unroll
        for (int e = 0; e < 4; ++e) p[e * 64] = pk2(r[2 * i2][e], r[2 * i2 + 1][e]); }
    LDS_WAIT(); asm volatile("" ::: "memory");
}
__device__ __forceinline__ void tr_store(const TrItem& t, int lane, const LAS unsigned* scr) {
    const int c = lane & 15;
    const int pbase = (t.kind == 0) ? t.c0 : (256 * (t.c0 >> 8) + ((t.c0 & 255) >> 1));
#pragma unroll
    for (int j = 0; j < 16; ++j) { const int n = (lane >> 4) + 4 * j; const v4u o = *(const LAS v4u*)(scr + n * 64 + ((c ^ j) << 2));
        const int drow = (t.kind == 0) ? (pbase + n) : (pbase + 128 * (n & 1) + (n >> 1));
        __builtin_nontemporal_store(o, (v4u*)(t.dst + (size_t)drow * t.K + t.koff + t.k0 + 8 * c)); }
    LDS_WAIT(); asm volatile("" ::: "memory");
}
__device__ __forceinline__ void sincos_d(double a, double& s, double& c) {
    const double k = rint(a * 0.63661977236758134308);
    const double y = fma(-k, 6.12323399573676603587e-17, fma(-k, 1.57079632679489655800, a));
    const double y2 = y * y;
    double sp = -7.6471637318198164759e-13; sp = fma(sp, y2, 1.6059043836821614599e-10); sp = fma(sp, y2, -2.5052108385441718775e-8); sp = fma(sp, y2, 2.7557319223985890653e-6);
    sp = fma(sp, y2, -1.9841269841269841270e-4); sp = fma(sp, y2, 8.3333333333333333333e-3); sp = fma(sp, y2, -1.6666666666666666667e-1); const double sy = fma(sp * y2, y, y);
    double cp = 4.7794773323873852974e-14; cp = fma(cp, y2, -1.1470745597729724714e-11); cp = fma(cp, y2, 2.0876756987868098979e-9); cp = fma(cp, y2, -2.7557319223985890653e-7);
    cp = fma(cp, y2, 2.4801587301587301587e-5); cp = fma(cp, y2, -1.3888888888888888889e-3); cp = fma(cp, y2, 4.1666666666666666667e-2); cp = fma(cp, y2, -0.5); const double cy = fma(cp, y2, 1.0);
    const int q = ((int)k) & 3;
    s = (q == 0) ? sy : (q == 1) ? cy : (q == 2) ? -sy : -cy;
    c = (q == 0) ? cy : (q == 1) ? -sy : (q == 2) ? -cy : sy;
}
__device__ __forceinline__ void phase_pro_a(Frame& F) {
    LAS unsigned* scr = (LAS unsigned*)(F.lds + F.wave * TR_WAVE_BYTES);
    const int gw = F.vcu * 8 + F.wave, NGW = F.G * 8;
    constexpr int I_IN = 8 * 136, I_SQ = 8 * 16, I_BB = 4 * 16, I_UP = 8 * 32;
    constexpr int S0 = NL * I_IN, S1 = S0 + NL * I_SQ, S2 = S1 + NL * I_BB, S3 = S2 + NL * I_SQ, S4 = S3 + NL * NE * I_SQ, S5 = S4 + NL * NE * I_UP;
    auto decode = [&](int it) -> TrItem { TrItem t; t.koff = 0;
        if (it < S0) { const int l = it / I_IN, r = it % I_IN; t.src = F.in[I_WIN] + (size_t)l * D * NIN; t.dst = wsp<bf16>(F, WS_WIN) + (size_t)l * NIN * D; t.ld = NIN; t.K = D; t.kind = 0; t.k0 = 128 * (r / 136); t.c0 = 64 * (r % 136); }
        else if (it < S1) { const int q = it - S0, l = q / I_SQ, r = q % I_SQ; t.src = F.in[I_WBA] + (size_t)l * D * D; t.dst = wsp<bf16>(F, WS_WBA) + (size_t)l * D * 1536; t.ld = D; t.K = 1536; t.kind = 0; t.k0 = 128 * (r / 16); t.c0 = 64 * (r % 16); }
        else if (it < S2) { const int q = it - S1, l = q / I_BB, r = q % I_BB; t.src = F.in[I_WBB] + (size_t)l * 512 * D; t.dst = wsp<bf16>(F, WS_WBA) + (size_t)l * D * 1536; t.ld = D; t.K = 1536; t.koff = 1024; t.kind = 0; t.k0 = 128 * (r / 16); t.c0 = 64 * (r % 16); }
        else if (it < S3) { const int q = it - S2, l = q / I_SQ, r = q % I_SQ; t.src = F.in[I_WOUT] + (size_t)l * D * D; t.dst = wsp<bf16>(F, WS_WOUT) + (size_t)l * D * D; t.ld = D; t.K = D; t.kind = 0; t.k0 = 128 * (r / 16); t.c0 = 64 * (r % 16); }
        else if (it < S4) { const int q = it - S3, le = q / I_SQ, r = q % I_SQ; t.src = F.in[I_WDN] + (size_t)le * FF * D; t.dst = wsp<bf16>(F, WS_WDN) + (size_t)le * D * FF; t.ld = D; t.K = FF; t.kind = 0; t.k0 = 128 * (r / 16); t.c0 = 64 * (r % 16); }
        else { const int q = it - S4, le = q / I_UP, r = q % I_UP; t.src = F.in[I_WUP] + (size_t)le * D * 2048; t.dst = wsp<bf16>(F, WS_WUP) + (size_t)le * 2048 * D; t.ld = 2048; t.K = D; t.kind = 1; t.k0 = 128 * (r / 32); t.c0 = 64 * (r % 32); }
        return t; };
    {
        f32x4 rn[TR_NR]; TrItem tn; int it = gw;
        if (it < S5) { tn = decode(it); tr_load(tn, F.lane, rn); }
#pragma unroll 1
        for (; it < S5; it += NGW) {
            const TrItem tc = tn;
            tr_tile(F.lane, scr, rn);
            if (it + NGW < S5) { tn = decode(it + NGW); tr_load(tn, F.lane, rn); }
            tr_store(tc, F.lane, scr);
        }
    }
    __syncthreads();
    {
        LAS float* cT = (LAS float*)F.lds;
        LAS float* red = (LAS float*)(F.lds + 32768);
        const float* cv = F.in[I_C];
        for (int i = F.tid; i < 8 * 1024; i += 512) { const int bb = i >> 10, k = i & 1023; cT[k * 8 + bb] = cv[i]; }
        __syncthreads();
        const int hf = F.lane >> 5, c4 = F.lane & 31;
        for (int u = F.vcu; u < NL * 48; u += F.G) {
            const int l = u / 48, n0 = 128 * (u % 48);
            f32x4 a[8];
#pragma unroll
            for (int bb = 0; bb < 8; ++bb) a[bb] = (f32x4){0.f, 0.f, 0.f, 0.f};
            const int kb = F.wave * 128 + hf;
            const float* wp = F.in[I_WADA] + (size_t)l * D * 6144 + (size_t)kb * 6144 + n0 + 4 * c4;
#pragma unroll 8
            for (int kk = 0; kk < 64; ++kk) { const f32x4 w = *(const f32x4*)(wp + (size_t)(2 * kk) * 6144);
                const f32x4 c0 = *(const LAS f32x4*)(cT + (kb + 2 * kk) * 8), c1 = *(const LAS f32x4*)(cT + (kb + 2 * kk) * 8 + 4);
#pragma unroll
                for (int bb = 0; bb < 4; ++bb) { a[bb] += w * c0[bb]; a[4 + bb] += w * c1[bb]; } }
#pragma unroll
            for (int bb = 0; bb < 8; ++bb) *(LAS f32x4*)(red + ((F.wave * 2 + hf) * 8 + bb) * 128 + 4 * c4) = a[bb];
            __syncthreads();
#pragma unroll
            for (int q = 0; q < 2; ++q) { const int o = F.tid + 512 * q, bb = o >> 7, cn = o & 127; float sum = F.in[I_BADA][l * 6144 + n0 + cn];
#pragma unroll
                for (int p = 0; p < 16; ++p) sum += red[(p * 8 + bb) * 128 + cn];
                wsp<float>(F, WS_MOD)[(size_t)(l * 8 + bb) * 6144 + n0 + cn] = sum; }
            __syncthreads();
        }
    }
    const int gt = F.vcu * 512 + F.tid, NT = F.G * 512;
    for (int i = gt; i < SEQ * 8; i += NT) { const int pos = i >> 3, f = i & 7;
        const double inv = (f == 0) ? 1.0 : (f == 1) ? 0.19392274474868576 : (f == 2) ? 0.03760603093086393 : (f == 3) ? 0.007292664737217109 : (f == 4) ? 0.001414213562373095 : (f == 5) ? 0.0002742481756762073 : (f == 6) ? 5.318295896944988e-05 : 1.031338537721246e-05;
        double s, c; sincos_d((double)pos * inv, s, c);
        float* rp = wsp<float>(F, WS_ROPE) + (size_t)pos * 16; rp[f] = (float)c; rp[8 + f] = (float)s; }
    for (int i = gt; i < NL * 4 * 128 * 128; i += NT) { const int j = i & 127, ii = (i >> 7) & 127; const float w = F.in[I_SPW][i];
        wsp<bf16>(F, WS_WSP)[i] = (bf16)(pk2((j <= ii) ? w : 0.f, 0.f) & 0xffffu); }
    for (int i = gt; i < NL * NE * D; i += NT) { const int k = i & 1023, e = (i >> 10) & 31, l = i >> 15; const float w = F.in[I_WR][((size_t)l * D + k) * NE + e];
        const unsigned hi = pk2(w, 0.f) & 0xffffu; const float lo = w - __uint_as_float(hi << 16);
        wsp<bf16>(F, WS_WRT)[i] = (bf16)hi; wsp<bf16>(F, WS_WRT)[NL * NE * D + i] = (bf16)(pk2(lo, 0.f) & 0xffffu); }
}
__device__ __forceinline__ void phase_pro_b(Frame& F) {
    const int gw = F.vcu * 8 + F.wave, NGW = F.G * 8;
    const float* mod = wsp<float>(F, WS_MOD);
    for (int m = gw; m < T; m += NGW) { const int b = m >> 12; const float* mb = mod + (size_t)b * 6144;
        const f32x4* xr = (const f32x4*)(F.in[I_X] + (size_t)m * D) + F.lane; v2u* hp = (v2u*)(wsp<bf16>(F, WS_H) + (size_t)m * D) + F.lane;
#pragma unroll
        for (int j = 0; j < 4; ++j) { const f32x4 x = xr[64 * j]; const f32x4 sh = *((const f32x4*)mb + F.lane + 64 * j), sc = *((const f32x4*)(mb + 1024) + F.lane + 64 * j);
            const f32x4 h = x * (sc + 1.0f) + sh; v2u o; o.x = pk2(h[0], h[1]); o.y = pk2(h[2], h[3]); hp[64 * j] = o; } }
}

constexpr int AT_RS = 144;
constexpr int AT_ROWS = 400, AT_VOFF = AT_ROWS * AT_RS;
#define LDS_BARRIER() do { asm volatile("s_waitcnt lgkmcnt(0)" ::: "memory"); __builtin_amdgcn_s_barrier(); asm volatile("" ::: "memory"); } while (0)
struct AtUnit { int g, b, h, r, n, d; size_t hoff; };
__device__ __forceinline__ AtUnit at_decode(int u) { AtUnit a; a.g = u >> 10; const int rem = u & 1023; a.b = rem >> 7; a.h = (rem >> 4) & 7; const int rn = rem & 15;
    const int dsh = 2 * a.g, nbs = 4 - dsh; a.d = 1 << dsh; a.r = rn >> nbs; a.n = 2 * (rn & ((1 << nbs) - 1)); a.hoff = (size_t)a.g * 512 + a.h * 64; return a; }
constexpr int AT_NU = 3 * 1024;
struct AtSlot { v4u k[6], v[6]; bf16x8 q0, q1, q2, q3; };
struct AtCtx { const bf16 *Qb, *Kb, *Vb; bf16* OG; float* LSE; LAS unsigned char *Ks, *Vs; int qi, g4, piece, jr; };
__device__ __forceinline__ void at_load(AtSlot& sl, int uu, const AtCtx& C, const Frame& F) {
    const AtUnit a_ = at_decode(uu);
#pragma unroll
    for (int ps = 0; ps < 6; ++ps) { const int lp = 128 * (a_.n - 1) + ps * 64 + C.jr; sl.k[ps] = (v4u){0u, 0u, 0u, 0u}; sl.v[ps] = sl.k[ps];
        if (lp >= 0) { const size_t off = ((size_t)a_.b * SEQ + (size_t)lp * a_.d + a_.r) * 1536 + a_.hoff + C.piece * 8; sl.k[ps] = *(const v4u*)(C.Kb + off); sl.v[ps] = *(const v4u*)(C.Vb + off); } }
    const size_t qrow_ = (size_t)a_.b * SEQ + (size_t)(128 * a_.n + 16 * F.wave + C.qi) * a_.d + a_.r; const bf16* qp = C.Qb + qrow_ * 1536 + a_.hoff + 8 * C.g4;
    sl.q0 = *(const bf16x8*)qp; sl.q1 = *(const bf16x8*)(qp + 32);
    const bf16* qp2 = qp + (size_t)128 * a_.d * 1536; sl.q2 = *(const bf16x8*)qp2; sl.q3 = *(const bf16x8*)(qp2 + 32);
}
__device__ __forceinline__ void at_unit(AtSlot& sl, int u, int unext, const AtCtx& C, const Frame& F) {
    bf16* OG = C.OG; float* LSE = C.LSE; LAS unsigned char* Ks = C.Ks; LAS unsigned char* Vs = C.Vs; const int qi = C.qi, g4 = C.g4;
    const AtUnit au = at_decode(u); const int g = au.g, b = au.b, h = au.h, r = au.r, n = au.n, d = au.d;
#pragma unroll
    for (int ps = 0; ps < 6; ++ps) { const int j = ps * 64 + C.jr; *(LAS v4u*)(Ks + j * AT_RS + C.piece * 16) = sl.k[ps]; *(LAS v4u*)(Vs + j * AT_RS + C.piece * 16) = sl.v[ps]; }
    const bf16x8 sl_q0 = sl.q0, sl_q1 = sl.q1, sl_q2 = sl.q2, sl_q3 = sl.q3;
    LDS_BARRIER();
    if (unext < AT_NU) at_load(sl, unext, C, F);
#pragma unroll
    for (int tq = 0; tq < 2; ++tq)
        {
            const int iq = 128 * tq + 16 * F.wave + qi; const int rb = 128 * tq + 16 * F.wave; const bf16x8 qf0 = tq ? sl_q2 : sl_q0, qf1 = tq ? sl_q3 : sl_q1; const size_t qrow = (size_t)b * SEQ + (size_t)(128 * n + iq) * d + r;
            f32x4 s[10]; float mx = -1e30f; const int dq = qi - 4 * g4; const bool first = (n == 0) && (tq == 0);
#pragma unroll
            for (int st = 0; st < 9; ++st) {
                const LAS unsigned char* kp = Ks + (rb + 16 * st + qi) * AT_RS + g4 * 16;
                const bf16x8 k0 = *(const LAS bf16x8*)kp, k1 = *(const LAS bf16x8*)(kp + 64);
                f32x4 a = (f32x4){0.f, 0.f, 0.f, 0.f};
                a = mfma16(k0, qf0, a); a = mfma16(k1, qf1, a);
                if (st == 0) {
#pragma unroll
                    for (int i = 0; i < 4; ++i) a[i] = (i >= dq) ? a[i] : -1e30f; }
                if (st == 8) {
#pragma unroll
                    for (int i = 0; i < 4; ++i) a[i] = (i <= dq) ? a[i] : -1e30f; }
                if (first) {
#pragma unroll
                    for (int i = 0; i < 4; ++i) a[i] = (rb + 16 * st + 4 * g4 + i >= 128) ? a[i] : -1e30f; }
#pragma unroll
                for (int i = 0; i < 4; ++i) mx = fmaxf(mx, a[i]);
                s[st] = a;
            }
            mx = fmaxf(mx, __shfl_xor(mx, 16)); mx = fmaxf(mx, __shfl_xor(mx, 32));
            float sum = 0.f;
#pragma unroll
            for (int st = 0; st < 9; ++st)
#pragma unroll
                for (int i = 0; i < 4; ++i) { const float p = fexp2(s[st][i] - mx); s[st][i] = p; sum += p; }
            s[9] = (f32x4){0.f, 0.f, 0.f, 0.f};
            sum += __shfl_xor(sum, 16); sum += __shfl_xor(sum, 32);
            f32x4 o[4];
#pragma unroll
            for (int dt = 0; dt < 4; ++dt) o[dt] = (f32x4){0.f, 0.f, 0.f, 0.f};
#pragma unroll
            for (int c = 0; c < 5; ++c) {
                v4u pw; pw.x = pk2(s[2 * c][0], s[2 * c][1]); pw.y = pk2(s[2 * c][2], s[2 * c][3]); pw.z = pk2(s[2 * c + 1][0], s[2 * c + 1][1]); pw.w = pk2(s[2 * c + 1][2], s[2 * c + 1][3]);
                const bf16x8 pf = __builtin_bit_cast(bf16x8, pw);
                const LAS unsigned char* vp = Vs + (rb + 32 * c + 4 * g4 + (qi >> 2)) * AT_RS + 8 * (qi & 3);
#pragma unroll
                for (int dt = 0; dt < 4; ++dt) { const s16x4 lo = tr16(vp + 32 * dt), hi = tr16(vp + 32 * dt + 16 * AT_RS);
                    o[dt] = mfma16(cat8(lo, hi), pf, o[dt]); }
            }
            const float inv = 1.0f / sum;
            bf16* op = OG + ((size_t)g * T + qrow) * 512 + h * 64 + 4 * g4;
#pragma unroll
            for (int dt = 0; dt < 4; ++dt) { v2u w; w.x = pk2(o[dt][0] * inv, o[dt][1] * inv); w.y = pk2(o[dt][2] * inv, o[dt][3] * inv); *(v2u*)(op + 16 * dt) = w; }
            if (g4 == 0) LSE[((size_t)g * T + qrow) * 8 + h] = mx + __log2f(sum);
        }
    LDS_BARRIER();
}
__device__ __forceinline__ void phase_attn(Frame& F) {
    AtCtx C; C.Qb = wsp<bf16>(F, WS_Q); C.Kb = wsp<bf16>(F, WS_K); C.Vb = wsp<bf16>(F, WS_VV); C.OG = wsp<bf16>(F, WS_OG); C.LSE = wsp<float>(F, WS_LSE);
    C.Ks = F.lds; C.Vs = F.lds + AT_VOFF; C.qi = F.lane & 15; C.g4 = F.lane >> 4; C.piece = F.tid & 7; C.jr = F.tid >> 3;
    if (F.tid < 144) { *(LAS v4u*)(C.Ks + 384 * AT_RS + F.tid * 16) = (v4u){0u, 0u, 0u, 0u}; *(LAS v4u*)(C.Vs + 384 * AT_RS + F.tid * 16) = (v4u){0u, 0u, 0u, 0u}; }
    AtSlot sa; const int u0 = F.vcu, G = F.G;
    if (u0 < AT_NU) at_load(sa, u0, C, F);
#pragma unroll 1
    for (int u = u0; u < AT_NU; u += G) at_unit(sa, u, u + G, C, F);
}

constexpr int SG_WOFF = 69632, SG_WRS = 264;
constexpr int SG_RS = 528;
__device__ __forceinline__ void phase_sg(Frame& F, int l) {
    const bf16* Ub = wsp<bf16>(F, WS_U); const bf16* Vb = wsp<bf16>(F, WS_V); bf16* TT = wsp<bf16>(F, WS_TT);
    const bf16* OG = wsp<bf16>(F, WS_OG); const float* LSE = wsp<float>(F, WS_LSE); bf16* OB = wsp<bf16>(F, WS_OB);
    const bf16* Wsp = wsp<bf16>(F, WS_WSP); const float* spb = F.in[I_SPB];
    LAS unsigned char* Vn = F.lds;
    const int qi = F.lane & 15, g4 = F.lane >> 4;
    const int l32 = F.lane & 31;
    v4u vraw[8];
#define SG_LOAD(uu) do { const int gi_ = (uu) & 3, m0_ = ((uu) >> 2) * 128; \
        _Pragma("unroll") for (int ps = 0; ps < 8; ++ps) vraw[ps] = *(const v4u*)(Vb + (size_t)(m0_ + 16 * ps + 2 * F.wave + (F.lane >> 5)) * 1024 + gi_ * 256 + 8 * l32); } while (0)
    if (F.vcu < 1024) SG_LOAD(F.vcu);
    const bool wlds = (F.G & 3) == 0; LAS unsigned char* Wl = F.lds + SG_WOFF;
    if (wlds) { const bf16* wsrc = Wsp + (size_t)(l * 4 + (F.vcu & 3)) * 128 * 128;
        for (int i = F.tid; i < 128 * 16; i += 512) { const int row = i >> 4, ch = i & 15; const v4u wv = *(const v4u*)(wsrc + row * 128 + ch * 8);
            *(LAS v2u*)(Wl + row * SG_WRS + ch * 16) = (v2u){wv.x, wv.y}; *(LAS v2u*)(Wl + row * SG_WRS + ch * 16 + 8) = (v2u){wv.z, wv.w}; } }
    for (int u = F.vcu; u < 1024; u += F.G) {
        const int gi = u & 3, m0 = (u >> 2) * 128;
        float ml[4][3]; v4u mo[4][3]; const int sub = F.tid & 7;
#pragma unroll
        for (int ps = 0; ps < 4; ++ps) { const int p = (F.tid >> 3) + 64 * ps; const size_t tok = (size_t)m0 + (p >> 1); const int hd = 2 * gi + (p & 1); const size_t off = tok * 512 + hd * 64 + 8 * sub;
#pragma unroll
            for (int gq = 0; gq < 3; ++gq) { ml[ps][gq] = LSE[((size_t)gq * T + tok) * 8 + hd]; mo[ps][gq] = *(const v4u*)(OG + (size_t)gq * T * 512 + off); } }
        {
            float sm[8], mean[8], rs[8];
#pragma unroll
            for (int ps = 0; ps < 8; ++ps) { const v4u raw = vraw[ps]; sm[ps] = ((bflo(raw.x) + bfhi(raw.x)) + (bflo(raw.y) + bfhi(raw.y))) + ((bflo(raw.z) + bfhi(raw.z)) + (bflo(raw.w) + bfhi(raw.w))); }
#pragma unroll
            for (int o = 1; o < 32; o <<= 1) {
#pragma unroll
                for (int ps = 0; ps < 8; ++ps) sm[ps] += __shfl_xor(sm[ps], o); }
#pragma unroll
            for (int ps = 0; ps < 8; ++ps) { const v4u raw = vraw[ps]; mean[ps] = sm[ps] * (1.0f / 256.0f); float q = 0.f;
                const float x[8] = {bflo(raw.x), bfhi(raw.x), bflo(raw.y), bfhi(raw.y), bflo(raw.z), bfhi(raw.z), bflo(raw.w), bfhi(raw.w)};
#pragma unroll
                for (int e = 0; e < 8; ++e) { const float dx = x[e] - mean[ps]; q += dx * dx; }
                sm[ps] = q; }
#pragma unroll
            for (int o = 1; o < 32; o <<= 1) {
#pragma unroll
                for (int ps = 0; ps < 8; ++ps) sm[ps] += __shfl_xor(sm[ps], o); }
#pragma unroll
            for (int ps = 0; ps < 8; ++ps) { rs[ps] = 1.0f / sqrtf(sm[ps] * (1.0f / 256.0f) + LN_EPS); const v4u raw = vraw[ps]; const int j = 16 * ps + 2 * F.wave + (F.lane >> 5);
                const float x[8] = {bflo(raw.x), bfhi(raw.x), bflo(raw.y), bfhi(raw.y), bflo(raw.z), bfhi(raw.z), bflo(raw.w), bfhi(raw.w)};
                v4u w; w.x = pk2((x[0] - mean[ps]) * rs[ps], (x[1] - mean[ps]) * rs[ps]); w.y = pk2((x[2] - mean[ps]) * rs[ps], (x[3] - mean[ps]) * rs[ps]);
                w.z = pk2((x[4] - mean[ps]) * rs[ps], (x[5] - mean[ps]) * rs[ps]); w.w = pk2((x[6] - mean[ps]) * rs[ps], (x[7] - mean[ps]) * rs[ps]);
                *(LAS v4u*)(Vn + j * SG_RS + l32 * 16) = w; }
        }
        LDS_BARRIER();
        if (u + F.G < 1024) SG_LOAD(u + F.G);
        {
#pragma unroll
          for (int ps = 0; ps < 4; ++ps) { const int p = (F.tid >> 3) + 64 * ps; const size_t tok = (size_t)m0 + (p >> 1); const int hd = 2 * gi + (p & 1);
              const float l0 = ml[ps][0], l1 = ml[ps][1], l2 = ml[ps][2];
              const float mxx = fmaxf(l0, fmaxf(l1, l2)); float w0 = fexp2(l0 - mxx), w1 = fexp2(l1 - mxx), w2 = fexp2(l2 - mxx); const float inv = 1.0f / (w0 + w1 + w2); w0 *= inv; w1 *= inv; w2 *= inv;
              const size_t off = tok * 512 + hd * 64 + 8 * sub;
              const v4u a = mo[ps][0], bq = mo[ps][1], cq = mo[ps][2]; v4u w;
              w.x = pk2(w0 * bflo(a.x) + w1 * bflo(bq.x) + w2 * bflo(cq.x), w0 * bfhi(a.x) + w1 * bfhi(bq.x) + w2 * bfhi(cq.x));
              w.y = pk2(w0 * bflo(a.y) + w1 * bflo(bq.y) + w2 * bflo(cq.y), w0 * bfhi(a.y) + w1 * bfhi(bq.y) + w2 * bfhi(cq.y));
              w.z = pk2(w0 * bflo(a.z) + w1 * bflo(bq.z) + w2 * bflo(cq.z), w0 * bfhi(a.z) + w1 * bfhi(bq.z) + w2 * bfhi(cq.z));
              w.w = pk2(w0 * bflo(a.w) + w1 * bflo(bq.w) + w2 * bflo(cq.w), w0 * bfhi(a.w) + w1 * bfhi(bq.w) + w2 * bfhi(cq.w));
              *(v4u*)(TT + tok * 1536 + 1024 + hd * 64 + 8 * sub) = w; } }
        v2u uq[8][2]; float ubias[8];
#pragma unroll
        for (int it = 0; it < 8; ++it) { const int i = 16 * it + qi; ubias[it] = spb[(l * 4 + gi) * 128 + i]; const size_t rowo = (size_t)(m0 + i) * 1024 + gi * 256 + 32 * F.wave + 4 * g4;
            uq[it][0] = *(const v2u*)(Ub + rowo); uq[it][1] = *(const v2u*)(Ub + rowo + 16); }
        {
            f32x4 acc[2][8];
#pragma unroll
            for (int ct = 0; ct < 2; ++ct)
#pragma unroll
                for (int it = 0; it < 8; ++it) acc[ct][it] = (f32x4){0.f, 0.f, 0.f, 0.f};
            const bf16* wbase = Wsp + (size_t)(l * 4 + gi) * 128 * 128 + (size_t)qi * 128 + 4 * g4;
#pragma unroll
            for (int kc = 0; kc < 4; ++kc) {
                bf16x8 af[2];
#pragma unroll
                for (int ct = 0; ct < 2; ++ct) { const LAS unsigned char* p = Vn + (32 * kc + 4 * g4 + (qi >> 2)) * SG_RS + (32 * F.wave + 16 * ct + 4 * (qi & 3)) * 2;
                    af[ct] = cat8(tr16(p), tr16(p + 16 * SG_RS)); }
#pragma unroll
                for (int it = 0; it < 8; ++it) if (it >= 2 * kc) {
                    const bf16* wp = wbase + (size_t)(16 * it) * 128 + 32 * kc; const LAS unsigned char* wq = Wl + (16 * it + qi) * SG_WRS + (32 * kc + 4 * g4) * 2;
                    const v2u b0 = wlds ? *(const LAS v2u*)wq : *(const v2u*)wp, b1 = wlds ? *(const LAS v2u*)(wq + 32) : *(const v2u*)(wp + 16);
                    const bf16x8 bfr = __builtin_bit_cast(bf16x8, (v4u){b0.x, b0.y, b1.x, b1.y});
                    acc[0][it] = mfma16(af[0], bfr, acc[0][it]); acc[1][it] = mfma16(af[1], bfr, acc[1][it]); }
            }
#pragma unroll
            for (int it = 0; it < 8; ++it) { const int i = 16 * it + qi; const float bias = ubias[it]; const size_t rowo = (size_t)(m0 + i) * 1536 + gi * 256 + 32 * F.wave + 4 * g4;
#pragma unroll
                for (int ct = 0; ct < 2; ++ct) { const v2u uu = uq[it][ct]; const f32x4 a = acc[ct][it]; v2u w;
                    w.x = pk2(bflo(uu.x) * (a[0] + bias), bfhi(uu.x) * (a[1] + bias)); w.y = pk2(bflo(uu.y) * (a[2] + bias), bfhi(uu.y) * (a[3] + bias));
                    *(v2u*)(TT + rowo + 16 * ct) = w; } }
        }
        LDS_BARRIER();
    }
#undef SG_LOAD
}

__device__ __forceinline__ void phase_ln1(Frame& F, int l, bool commit) {
    const bf16* YPRE = wsp<bf16>(F, WS_YPRE); bf16* H = wsp<bf16>(F, WS_H);
    const float* modl = wsp<float>(F, WS_MOD) + (size_t)l * 8 * 6144;
    const float* lg = F.in[I_LN1G] + l * D; const float* lb = F.in[I_LN1B] + l * D; const float* br = F.in[I_BR] + l * NE;
    const bf16* WH = wsp<bf16>(F, WS_WRT) + (size_t)l * NE * D; const bf16* WL = WH + (size_t)NL * NE * D;
    int* TOKINFO = wsp<int>(F, WS_TOKINFO); float* TOKW = wsp<float>(F, WS_TOKW);
    unsigned* cntg = wsp<unsigned>(F, WS_CTL) + CW_CNT + (size_t)l * NE * 64;
    LAS int* sel_e = (LAS int*)(F.lds + X_SELE);
    const int lane = F.lane, qi = lane & 15, g4 = lane >> 4;
    { const v4u* srcw = (const v4u*)WH;
#pragma unroll 4
      for (int i = F.tid; i < 2 * NE * 128; i += 512) { const int hl = i >> 12, e = (i >> 7) & 31, c = i & 127;
          *(LAS v4u*)(F.lds + hl * 65536 + e * 2048 + ((c ^ (e & 15)) << 4)) = srcw[(size_t)hl * (NL * NE * 128) + e * 128 + c]; } }
    __syncthreads();
    for (int tb = F.vcu; tb < T / 128; tb += F.G) {
        const int m0 = tb * 128; const int b = m0 >> 12; const float* mb = modl + (size_t)b * 6144; const int mw = m0 + 16 * F.wave;
        v2u pre[4][4];
#pragma unroll
        for (int r = 0; r < 4; ++r)
#pragma unroll
            for (int j = 0; j < 4; ++j) pre[r][j] = *((const v2u*)(YPRE + (size_t)(mw + r) * D) + lane + 64 * j);
#pragma unroll 1
        for (int rp = 0; rp < 4; ++rp) {
            f32x4 hh[4][4]; float mean[4], rstd[4];
            const int mrow = mw + 4 * rp;
#pragma unroll
            for (int r = 0; r < 4; ++r)
#pragma unroll
                for (int j = 0; j < 4; ++j) hh[r][j] = (f32x4){bflo(pre[r][j].x), bfhi(pre[r][j].x), bflo(pre[r][j].y), bfhi(pre[r][j].y)};
            if (rp < 3) {
#pragma unroll
                for (int r = 0; r < 4; ++r)
#pragma unroll
                    for (int j = 0; j < 4; ++j) pre[r][j] = *((const v2u*)(YPRE + (size_t)(mrow + 4 + r) * D) + lane + 64 * j); }
            { float sm[4], sq[4];
#pragma unroll
              for (int r = 0; r < 4; ++r) { sm[r] = 0.f; sq[r] = 0.f;
#pragma unroll
                  for (int j = 0; j < 4; ++j) { sm[r] += (hh[r][j][0] + hh[r][j][1]) + (hh[r][j][2] + hh[r][j][3]);
                      sq[r] += (hh[r][j][0] * hh[r][j][0] + hh[r][j][1] * hh[r][j][1]) + (hh[r][j][2] * hh[r][j][2] + hh[r][j][3] * hh[r][j][3]); } }
#pragma unroll
              for (int o = 1; o < 64; o <<= 1) {
#pragma unroll
                  for (int r = 0; r < 4; ++r) { sm[r] += __shfl_xor(sm[r], o); sq[r] += __shfl_xor(sq[r], o); } }
#pragma unroll
              for (int r = 0; r < 4; ++r) { mean[r] = sm[r] * (1.0f / D); rstd[r] = 1.0f / sqrtf(fmaxf(sq[r] * (1.0f / D) - mean[r] * mean[r], 0.f) + LN_EPS); } }
            if (lane < 4) { const float mq = (lane == 0) ? mean[0] : (lane == 1) ? mean[1] : (lane == 2) ? mean[2] : mean[3], rq = (lane == 0) ? rstd[0] : (lane == 1) ? rstd[1] : (lane == 2) ? rstd[2] : rstd[3];
                float* st = wsp<float>(F, WS_STAT) + (size_t)(mrow + lane) * 2; st[0] = mq; st[1] = rq; }
#pragma unroll
            for (int j = 0; j < 4; ++j) { const f32x4 gq = *((const f32x4*)lg + lane + 64 * j), bq = *((const f32x4*)lb + lane + 64 * j);
                const f32x4 shq = *((const f32x4*)(mb + 3072) + lane + 64 * j), scq = *((const f32x4*)(mb + 4096) + lane + 64 * j) + 1.0f;
#pragma unroll
                for (int r = 0; r < 4; ++r) { const f32x4 x1 = (hh[r][j] - mean[r]) * rstd[r] * gq + bq;
                    const f32x4 h2 = x1 * scq + shq; v2u o; o.x = pk2(h2[0], h2[1]); o.y = pk2(h2[2], h2[3]); *((v2u*)(H + (size_t)(mrow + r) * D) + lane + 64 * j) = o;
 } }
        }
        VM_WAIT(); asm volatile("" ::: "memory");
        f32x4 c0 = (f32x4){0.f, 0.f, 0.f, 0.f}, c1 = c0;
        { const bf16* hp = H + (size_t)(mw + qi) * D + 8 * g4;
          const LAS unsigned char* w0 = F.lds + qi * 2048; const LAS unsigned char* w1 = F.lds + (16 + qi) * 2048;
#pragma unroll 8
          for (int ks = 0; ks < 32; ++ks) {
              const bf16x8 hhi = *(const bf16x8*)(hp + 32 * ks);
              const int co = ((4 * ks + g4) ^ qi) << 4;
              const bf16x8 a0h = *(const LAS bf16x8*)(w0 + co), a0l = *(const LAS bf16x8*)(w0 + 65536 + co);
              const bf16x8 a1h = *(const LAS bf16x8*)(w1 + co), a1l = *(const LAS bf16x8*)(w1 + 65536 + co);
              c0 = mfma16(a0h, hhi, c0); c0 = mfma16(a0l, hhi, c0);
              c1 = mfma16(a1h, hhi, c1); c1 = mfma16(a1l, hhi, c1); } }
        {
            float v[8]; int id[8];
#pragma unroll
            for (int i = 0; i < 4; ++i) { id[i] = 4 * g4 + i; id[4 + i] = 16 + 4 * g4 + i; v[i] = c0[i] + br[4 * g4 + i]; v[4 + i] = c1[i] + br[16 + 4 * g4 + i]; }
            int ek[4]; float vk[4];
#pragma unroll
            for (int k = 0; k < 4; ++k) { float lm = v[0]; int li = id[0];
#pragma unroll
                for (int j = 1; j < 8; ++j) if (v[j] > lm) { lm = v[j]; li = id[j]; }
#pragma unroll
                for (int o = 16; o <= 32; o <<= 1) { const float om = __shfl_xor(lm, o); const int oi = __shfl_xor(li, o); if (om > lm || (om == lm && oi < li)) { lm = om; li = oi; } }
                ek[k] = li; vk[k] = lm;
#pragma unroll
                for (int j = 0; j < 8; ++j) if (id[j] == li) v[j] = -INFINITY; }
            const float e1 = __expf(vk[1] - vk[0]), e2 = __expf(vk[2] - vk[0]), e3 = __expf(vk[3] - vk[0]); const float inv = 1.0f / (1.0f + e1 + e2 + e3);
            if (g4 == 0) { const int tl = 16 * F.wave + qi;
                sel_e[tl * 4 + 0] = ek[0]; sel_e[tl * 4 + 1] = ek[1]; sel_e[tl * 4 + 2] = ek[2]; sel_e[tl * 4 + 3] = ek[3];
                *(f32x4*)(TOKW + (size_t)(m0 + tl) * 4) = (f32x4){inv, e1 * inv, e2 * inv, e3 * inv}; }
        }
        __syncthreads();
        { const int myE = sel_e[F.tid]; LAS unsigned long long* bm = (LAS unsigned long long*)(F.lds + X_SELR); unsigned long long mine = 0ull;
#pragma unroll
          for (int e = 0; e < 32; ++e) { const unsigned long long m = __ballot(myE == e); if (lane == e) mine = m; }
          if (lane < 32) bm[F.wave * 32 + lane] = mine;
          __syncthreads();
          int rk = __popcll(bm[F.wave * 32 + myE] & ((1ull << lane) - 1ull));
#pragma unroll
          for (int w = 0; w < 8; ++w) if (w < F.wave) rk += __popcll(bm[w * 32 + myE]);
          TOKINFO[(size_t)m0 * 4 + F.tid] = myE | (rk << 8);
          if (F.tid < 32) { int tot = 0;
#pragma unroll
              for (int w = 0; w < 8; ++w) tot += __popcll(bm[w * 32 + F.tid]);
              wsp<int>(F, WS_WGCNT)[((size_t)l * 256 + tb) * 32 + F.tid] = tot; if (tot && commit) (void)__hip_atomic_fetch_add(cntg + F.tid * 64, (unsigned)tot, RLX_AGENT); } }
        __syncthreads();
    }
}

__device__ __forceinline__ int moe_tables(Frame& F, int l) {
    const unsigned* cntg = wsp<unsigned>(F, WS_CTL) + CW_CNT + (size_t)l * NE * 64;
    LAS int* cnt_s = (LAS int*)(F.lds + X_CNTS); LAS int* off_s = (LAS int*)(F.lds + X_OFFS); LAS unsigned char* tile_e = (LAS unsigned char*)(F.lds + X_TILEE);
    if (F.tid < 32) cnt_s[F.tid] = (int)__hip_atomic_load(cntg + F.tid * 64, RLX_AGENT);
    __syncthreads();
    if (F.tid < 64) {
        const int e = F.tid & 31; const int c = (F.tid < 32) ? cnt_s[e] : 0; const int nt = (c + 255) >> 8; int incl = nt;
#pragma unroll
        for (int o = 1; o < 32; o <<= 1) { const int v = __shfl_up(incl, o); if ((F.tid & 63) >= o) incl += v; }
        if (F.tid < 32) { const int excl = incl - nt; off_s[e] = excl * 256; for (int t = 0; t < nt; ++t) tile_e[excl + t] = (unsigned char)e; if (e == 31) off_s[32] = incl * 256; }
    }
    __syncthreads();
    return off_s[32] >> 8;
}
__device__ __forceinline__ void phase_scat(Frame& F, int l) {
    (void)moe_tables(F, l);
    const LAS int* off_s = (const LAS int*)(F.lds + X_OFFS); const LAS int* cnt_s = (const LAS int*)(F.lds + X_CNTS); LAS int* base_s = (LAS int*)(F.lds + X_BASE);
    const int* TOKINFO = wsp<int>(F, WS_TOKINFO); const float* TOKW = wsp<float>(F, WS_TOKW);
    int* ROWTOK = wsp<int>(F, WS_ROWTOK); float* ROWW = wsp<float>(F, WS_ROWW); const int* WGC = wsp<int>(F, WS_WGCNT) + (size_t)l * 256 * 32; int* TOKINFO2 = wsp<int>(F, WS_TOKROW);
    for (int tb = F.vcu; tb < T / 128; tb += F.G) {
        if (F.tid < 32) base_s[F.tid] = 0;
        __syncthreads();
        { const int e = F.tid & 31, part = F.tid >> 5; int sacc = 0;
          for (int t2 = part * 16; t2 < part * 16 + 16; ++t2) if (t2 < tb) sacc += WGC[t2 * 32 + e];
          if (sacc) atomicAdd((int*)&base_s[e], sacc); }
        __syncthreads();
        { const size_t ent = (size_t)tb * 512 + F.tid; const int info = TOKINFO[ent]; const int e = info & 255, row = off_s[e] + base_s[e] + (info >> 8);
          ROWTOK[row] = (int)ent; ROWW[row] = TOKW[ent]; TOKINFO2[ent] = row; }
        __syncthreads();
    }
    if (F.vcu == 0) for (int e = 0; e < NE; ++e) for (int r = off_s[e] + cnt_s[e] + F.tid; r < off_s[e + 1]; r += 512) { ROWTOK[r] = 0; ROWW[r] = 0.f; }
}
__device__ __forceinline__ void phase_ln2(Frame& F, int l) {
    const bf16* X1 = wsp<bf16>(F, WS_YPRE); const bf16* YK = wsp<bf16>(F, WS_XG); bf16* H = wsp<bf16>(F, WS_H); const int* TOKROW = wsp<int>(F, WS_TOKROW); const float* TOKW = wsp<float>(F, WS_TOKW);
    const float* STAT = wsp<float>(F, WS_STAT); const float* l1g = F.in[I_LN1G] + l * D; const float* l1b = F.in[I_LN1B] + l * D;
    float* XO = F.out; bf16* XB = wsp<bf16>(F, WS_X2);
    const float* modl = wsp<float>(F, WS_MOD) + (size_t)l * 8 * 6144; const float* modn = wsp<float>(F, WS_MOD) + (size_t)((l + 1) & 3) * 8 * 6144;
    const float* lg = F.in[I_LN2G] + l * D; const float* lb = F.in[I_LN2B] + l * D;
    const int lane = F.lane; const int gw = F.vcu * 8 + F.wave, NGW = F.G * 8;
    v2u px[4]; v2u py[4][4]; float pst[2], nst[2]; f32x4 pw4, nw4;
#define LN2_LOAD(mm) do { nst[0] = STAT[(size_t)(mm) * 2]; nst[1] = STAT[(size_t)(mm) * 2 + 1]; nw4 = *(const f32x4*)(TOKW + (size_t)(mm) * 4); \
        int rw_[4]; _Pragma("unroll") for (int k = 0; k < 4; ++k) rw_[k] = TOKROW[(size_t)(mm) * 4 + k]; \
        _Pragma("unroll") for (int j = 0; j < 4; ++j) { px[j] = __builtin_nontemporal_load((const v2u*)(X1 + (size_t)(mm) * D) + lane + 64 * j); \
        _Pragma("unroll") for (int k = 0; k < 4; ++k) py[j][k] = __builtin_nontemporal_load((const v2u*)(YK + (size_t)rw_[k] * D) + lane + 64 * j); } } while (0)
    if (gw < T) LN2_LOAD(gw);
#pragma unroll 1
    for (int m = gw; m < T; m += NGW) { const int b = m >> 12; const float* mb = modl + (size_t)b * 6144; const float* mn = modn + (size_t)b * 6144;
        f32x4 v[4]; float s = 0.f; pst[0] = nst[0]; pst[1] = nst[1]; pw4 = nw4;
#pragma unroll
        for (int j = 0; j < 4; ++j) { f32x4 y = (f32x4){0.f, 0.f, 0.f, 0.f};
#pragma unroll
            for (int k = 0; k < 4; ++k) { const v2u w = py[j][k]; const float cw = pw4[k]; y[0] += cw * bflo(w.x); y[1] += cw * bfhi(w.x); y[2] += cw * bflo(w.y); y[3] += cw * bfhi(w.y); }
            const f32x4 g2 = *((const f32x4*)(mb + 5120) + lane + 64 * j) + 1.0f;
            const f32x4 pxf = (f32x4){bflo(px[j].x), bfhi(px[j].x), bflo(px[j].y), bfhi(px[j].y)};
            const f32x4 x1 = (pxf - pst[0]) * pst[1] * *((const f32x4*)l1g + lane + 64 * j) + *((const f32x4*)l1b + lane + 64 * j);
            v[j] = x1 * DN_ALPHA + g2 * y; s += (v[j][0] + v[j][1]) + (v[j][2] + v[j][3]); }
        if (m + NGW < T) LN2_LOAD(m + NGW);
        float s2 = 0.f;
#pragma unroll
        for (int j = 0; j < 4; ++j) s2 += (v[j][0] * v[j][0] + v[j][1] * v[j][1]) + (v[j][2] * v[j][2] + v[j][3] * v[j][3]);
#pragma unroll
        for (int o = 1; o < 64; o <<= 1) { s += __shfl_xor(s, o); s2 += __shfl_xor(s2, o); }
        const float mean = s * (1.0f / D); const float rstd = 1.0f / sqrtf(fmaxf(s2 * (1.0f / D) - mean * mean, 0.f) + LN_EPS);
#pragma unroll
        for (int j = 0; j < 4; ++j) v[j] = v[j] - mean;
        f32x4* xo = (f32x4*)(XO + (size_t)m * D) + lane; v2u* xb = (v2u*)(XB + (size_t)m * D) + lane; v2u* ho = (v2u*)(H + (size_t)m * D) + lane;
#pragma unroll
        for (int j = 0; j < 4; ++j) { const f32x4 gvj = *((const f32x4*)lg + lane + 64 * j), bvj = *((const f32x4*)lb + lane + 64 * j); const f32x4 x2 = v[j] * rstd * gvj + bvj;
            if (l == NL - 1) __builtin_nontemporal_store(x2, xo + 64 * j); else { v2u xq; xq.x = pk2(x2[0], x2[1]); xq.y = pk2(x2[2], x2[3]); __builtin_nontemporal_store(xq, xb + 64 * j); }
            if (l < NL - 1) { const f32x4 sh = *((const f32x4*)mn + lane + 64 * j), sc = *((const f32x4*)(mn + 1024) + lane + 64 * j) + 1.0f; const f32x4 h = x2 * sc + sh;
                v2u o; o.x = pk2(h[0], h[1]); o.y = pk2(h[2], h[3]); ho[64 * j] = o; } } }
#undef LN2_LOAD
}

#ifndef PH_MASK
#define PH_MASK 0xFFFF
#endif
#define PHM(b) ((PH_MASK >> (b)) & 1)
#ifndef DUP_MASK
#define DUP_MASK 0
#endif
#define REPS(b) (((DUP_MASK >> (b)) & 1) ? 2 : 1)
constexpr int NPH_L = 10, NPHASE = 2 + NL * NPH_L;
struct Args { const float* in[20]; float* out; unsigned char* ws; int ph_lo, ph_hi; };
__global__ void __launch_bounds__(512, 2) fwd(Args args) {
    extern __shared__ __attribute__((aligned(16))) unsigned char lds[];
    Frame F;
    F.lds = (LAS unsigned char*)lds;
#define FRESH() do { int zv_ = 0; asm volatile("" : "+v"(zv_)); const int z_ = __builtin_amdgcn_readfirstlane(zv_); \
        F.tid = (int)threadIdx.x + zv_; F.lane = F.tid & 63; F.wave = __builtin_amdgcn_readfirstlane(F.tid >> 6); \
        F.G = (int)gridDim.x + z_; F.bx = (int)blockIdx.x + z_; F.vcu = (F.G % 8 == 0) ? (F.bx % 8) * (F.G / 8) + F.bx / 8 : F.bx; \
        F.ws = args.ws + z_; F.in = args.in + z_; F.out = args.out + z_; F.lds = (LAS unsigned char*)lds + z_; } while (0)
    FRESH();
    for (int u = F.tid; u < (LDS_BYTES - XOFF) / 4; u += 512) ((LAS unsigned*)(F.lds + XOFF))[u] = 0u;
    __syncthreads();
    unsigned* ctl = wsp<unsigned>(F, WS_CTL);
    XcdBarrier bar; bar.bar = ctl + CW_BAR; bar.x = 0; bar.st = nullptr;
    if (!MK_PER_PHASE) bar = xcd_barrier_post(ctl + CW_BAR, (volatile LAS unsigned*)(F.lds + X_MISC) + 8);
    const int lo = args.ph_lo, hi = args.ph_hi;
#define IN(k) (lo <= (k) && (k) < hi)
#ifndef BAR_REPS
#define BAR_REPS 1
#endif
#define SEAM(k) do { if (!MK_PER_PHASE && IN(k) && IN((k) + 1)) for (int br_ = 0; br_ < BAR_REPS; ++br_) xcd_barrier(bar); } while (0)

    if (PHM(0) && IN(0)) for (int rep = 0; rep < REPS(0); ++rep) { FRESH(); phase_pro_a(F); } SEAM(0);
    if (PHM(1) && IN(1)) for (int rep = 0; rep < REPS(1); ++rep) { FRESH(); phase_pro_b(F); } SEAM(1);
    for (int l = 0; l < NL; ++l) {
        const int pb = 2 + l * NPH_L;
        if (PHM(2) && IN(pb + 0)) for (int rep = 0; rep < REPS(2); ++rep) { FRESH();
            pg8::Gemm g{wsp<bf16>(F, WS_H), wsp<bf16>(F, WS_WIN) + (size_t)l * NIN * D, T, NIN, D}; pg8::StaticOrder S; S.init(T, NIN, F.G, F.bx);
            EpiIn E{wsp<bf16>(F, WS_U), wsp<bf16>(F, WS_V), wsp<bf16>(F, WS_Q), wsp<bf16>(F, WS_K), wsp<bf16>(F, WS_VV), wsp<bf16>(F, WS_G), wsp<float>(F, WS_ROPE)};
            stagger(F.bx >> 3, STAG_US);
            pg8::gemm_phase<EpiIn, pg8::StaticOrder, PG8_ALIGN, PG8_SP2>(F.lds, g, S, E, F.tid);
#if defined(XPROBE)
            { FRESH(); pg8::Gemm g2{wsp<bf16>(F, WS_H), wsp<bf16>(F, WS_WIN) + (size_t)l * NIN * D, T, NIN, D}; pg8::StaticOrder S2; S2.init(T, NIN, F.G, F.bx);
              EpiProbe E2{wsp<bf16>(F, WS_XG), (XPROBE == 3) ? NIN : 1024, (XPROBE >= 2) ? (XPROBE == 3 ? 3 : 1) : (F.G == 0x7ffffff0 ? 1 : 0)};
              pg8::gemm_phase<EpiProbe, pg8::StaticOrder, PG8_ALIGN, PG8_SP2>(F.lds, g2, S2, E2, F.tid); }
#endif
        } SEAM(pb + 0);
        if (PHM(3) && IN(pb + 1)) for (int rep = 0; rep < REPS(3); ++rep) { FRESH(); phase_attn(F); } SEAM(pb + 1);
        if (PHM(4) && IN(pb + 2)) for (int rep = 0; rep < REPS(4); ++rep) { FRESH(); phase_sg(F, l); } SEAM(pb + 2);
        if (PHM(5) && IN(pb + 3)) for (int rep = 0; rep < REPS(5); ++rep) { FRESH();
            pg8::Gemm g{wsp<bf16>(F, WS_TT), wsp<bf16>(F, WS_WBA) + (size_t)l * D * 1536, T, D, 1536}; pg8::StaticOrder S; S.init(T, D, F.G, F.bx);
            EpiMg2 E{wsp<bf16>(F, WS_G), wsp<bf16>(F, WS_MG)}; pg8::gemm_phase<EpiMg2, pg8::StaticOrder, PG8_ALIGN, PG8_SP2>(F.lds, g, S, E, F.tid);
        } SEAM(pb + 3);
        if (PHM(6) && IN(pb + 4)) for (int rep = 0; rep < REPS(6); ++rep) { FRESH();
            pg8::Gemm g{wsp<bf16>(F, WS_MG), wsp<bf16>(F, WS_WOUT) + (size_t)l * D * D, T, D, D}; pg8::StaticOrder S; S.init(T, D, F.G, F.bx);
            if (l == 0) { EpiOut<true> E{(const void*)F.in[I_X], wsp<float>(F, WS_MOD) + (size_t)l * 8 * 6144, wsp<bf16>(F, WS_YPRE)}; pg8::gemm_phase<EpiOut<true>, pg8::StaticOrder, PG8_ALIGN, PG8_SP2>(F.lds, g, S, E, F.tid); }
            else { EpiOut<false> E{(const void*)wsp<bf16>(F, WS_X2), wsp<float>(F, WS_MOD) + (size_t)l * 8 * 6144, wsp<bf16>(F, WS_YPRE)}; pg8::gemm_phase<EpiOut<false>, pg8::StaticOrder, PG8_ALIGN, PG8_SP2>(F.lds, g, S, E, F.tid); }
        } SEAM(pb + 4);
        if (PHM(7) && IN(pb + 5)) for (int rep = 0; rep < REPS(7); ++rep) { FRESH(); phase_ln1(F, l, rep == 0); } SEAM(pb + 5);
        if (PHM(8) && IN(pb + 6)) for (int rep = 0; rep < REPS(8); ++rep) { FRESH(); phase_scat(F, l); } SEAM(pb + 6);
        if (PHM(9) && IN(pb + 7)) for (int rep = 0; rep < REPS(9); ++rep) { FRESH();
            const int RT = moe_tables(F, l);
            pg8::Gemm g{wsp<bf16>(F, WS_H), wsp<bf16>(F, WS_WUP) + (size_t)l * NE * 2048 * D, RT * 256, NE * 2048, D};
            MoeGatherOrder S; S.init(RT, 8, F.G, F.bx, (const LAS unsigned char*)(F.lds + X_TILEE)); S.tokl = (const LAS unsigned short*)(F.lds + X_TOKL);
            { const int* rowtok = wsp<int>(F, WS_ROWTOK); LAS unsigned short* tl = (LAS unsigned short*)(F.lds + X_TOKL); pg8::Unit uu;
              for (int i = 0; i < TOKL_UNITS && S.next(i, uu); ++i) if (F.tid < 256) tl[i * 256 + F.tid] = (unsigned short)(rowtok[uu.pm * 256 + F.tid] >> 2);
              __syncthreads(); }
            EpiUp E{F.in[I_BUP] + (size_t)l * NE * 2048, wsp<bf16>(F, WS_ACT)};
            stagger(F.bx >> 3, STAG_US);
            pg8::gemm_phase<EpiUp, MoeGatherOrder, PG8_ALIGN, true>(F.lds, g, S, E, F.tid);
        } SEAM(pb + 7);
        if (PHM(10) && IN(pb + 8)) for (int rep = 0; rep < REPS(10); ++rep) { FRESH();
            const int RT = moe_tables(F, l);
            pg8::Gemm g{wsp<bf16>(F, WS_ACT), wsp<bf16>(F, WS_WDN) + (size_t)l * NE * D * FF, RT * 256, NE * D, FF};
            MoeOrder S; S.init(RT, 4, F.G, F.bx, (const LAS unsigned char*)(F.lds + X_TILEE), 1);
            EpiDn E{F.in[I_BDN] + (size_t)l * NE * D, wsp<bf16>(F, WS_XG)};
            stagger(F.bx >> 3, STAG_US);
            pg8::gemm_phase<EpiDn, MoeOrder, PG8_ALIGN, PG8_SP2>(F.lds, g, S, E, F.tid);
        } SEAM(pb + 8);
        if (PHM(11) && IN(pb + 9)) for (int rep = 0; rep < REPS(11); ++rep) { FRESH(); phase_ln2(F, l); } SEAM(pb + 9);
    }
#undef IN
#undef SEAM
#undef FRESH
}

extern "C" void kernel_launch(void* const* d_in, const int* in_sizes, int n_in, void* d_out, int out_size, void* d_ws, size_t ws_size, hipStream_t stream) {
    static int grid = 0;
    if (grid == 0) {
        if (n_in != 20 || out_size != T * D || ws_size < WS_END) { fprintf(stderr, "kernel_launch: unexpected shapes (n_in %d, out %d, ws %zu < %zu)\n", n_in, out_size, ws_size, (size_t)WS_END); grid = -1; return; }
        int dev = 0, cus = 0;
        if (hipGetDevice(&dev) != hipSuccess || hipDeviceGetAttribute(&cus, hipDeviceAttributeMultiprocessorCount, dev) != hipSuccess) { grid = -1; return; }
        if (hipFuncSetAttribute((const void*)fwd, hipFuncAttributeMaxDynamicSharedMemorySize, LDS_BYTES) != hipSuccess) { fprintf(stderr, "kernel_launch: hipFuncSetAttribute failed\n"); grid = -1; return; }
        int per_cu = 0;
        if (hipOccupancyMaxActiveBlocksPerMultiprocessor(&per_cu, (const void*)fwd, 512, LDS_BYTES) != hipSuccess || per_cu < 1) fprintf(stderr, "kernel_launch: occupancy query says %d blocks per CU\n", per_cu);
        (void)hipGetLastError();
        grid = cus;
    }
    if (grid < 0) return;
    (void)in_sizes;
    if (hipMemsetAsync((char*)d_ws + WS_CTL, 0, CTL_ZERO_BYTES, stream) != hipSuccess) return;
    Args a{};
    for (int i = 0; i < 20; ++i) a.in[i] = (const float*)d_in[i];
    a.out = (float*)d_out; a.ws = (unsigned char*)d_ws;
#if MK_PER_PHASE
    for (int p = 0; p < NPHASE; ++p) { a.ph_lo = p; a.ph_hi = p + 1; hipLaunchKernelGGL(fwd, dim3(grid), dim3(512), LDS_BYTES, stream, a); }
#else
    a.ph_lo = 0; a.ph_hi = NPHASE;
    hipLaunchKernelGGL(fwd, dim3(grid), dim3(512), LDS_BYTES, stream, a);
#endif
    const hipError_t le = hipPeekAtLastError();
    if (le != hipSuccess) fprintf(stderr, "kernel_launch: launch failed: %s\n", hipGetErrorName(le));
}
```

```cpp
#include <hip/hip_runtime.h>
#include <cstdio>
#include <cstdint>
#ifndef MK_PER_PHASE
#define MK_PER_PHASE 0
#endif
namespace pg8 {
#define PG8_LAS __attribute__((address_space(3)))
typedef unsigned short bf16_t;
typedef short bf16x8 __attribute__((ext_vector_type(8)));
typedef float f32x4 __attribute__((ext_vector_type(4)));
typedef unsigned u32x4 __attribute__((ext_vector_type(4)));
constexpr int BM = 256, BK = 64, HALF = 128, HTB = HALF * BK * 2  , STAGE_BYTES = 8 * HTB, NXCD = 8;
#ifndef PG8_WGM
#define PG8_WGM 8
#endif
constexpr int WGM = PG8_WGM;

__host__ __device__ __forceinline__ int lds_byte(int r, int c) { const int st = (r >> 4) * 2 + (c >> 5), rr = r & 15, cc = c & 31, ob = rr * 64 + cc * 2; return st * 1024 + (ob ^ (((ob >> 9) & 1) << 5)); }
__host__ __device__ __forceinline__ void stage_rc(int b, int& R, int& C) { const int st = b / 1024, sb = b % 1024, swz = sb ^ (((sb >> 9) & 1) << 5); R = (st >> 1) * 16 + swz / 64; C = (st & 1) * 32 + (swz % 64) / 2; }
__host__ __device__ __forceinline__ int perm32(int rho) { const int n = rho >> 4, i = rho & 15; return 8 * (i >> 2) + 4 * n + (i & 3); }

struct Unit { int pm, pn; };
struct Gemm { const bf16_t* A; const bf16_t* Bt; int M, N, K; };

struct StaticOrder {
    static constexpr bool GATHER = false; __device__ __forceinline__ int arow(int, int r) const { return r; }
    int nM, nN, nwg, G, c;
    __host__ __device__ void init(int M, int N, int G_, int c_) { nM = M / BM; nN = N / BM; nwg = nM * nN; G = G_; c = c_; }
    __host__ __device__ bool next(int i, Unit& u) const {
        const long L = (long)i * G + c; if (L >= nwg) return false;
        int wgid = (int)L; { const int q = nwg / NXCD, r = nwg % NXCD, xcd = wgid % NXCD, off = wgid / NXCD; wgid = (xcd < r ? xcd * (q + 1) : r * (q + 1) + (xcd - r) * q) + off; }
        const int nig = WGM * nN, gid = wgid / nig, fm = gid * WGM, gsz = (nM - fm) < WGM ? (nM - fm) : WGM;
        u.pm = fm + ((wgid % nig) % gsz); u.pn = (wgid % nig) / gsz; return true;
    }
    __device__ __forceinline__ void a_ready(const Unit&) const {}
    __device__ __forceinline__ void done(const Unit&) const {}
};

__device__ __forceinline__ unsigned cvt_pk_bf16(float lo, float hi) { unsigned r; asm volatile("v_cvt_pk_bf16_f32 %0, %1, %2" : "=v"(r) : "v"(lo), "v"(hi)); return r; }
typedef float f32x2 __attribute__((ext_vector_type(2)));

template <class Epi, class Sched, bool ALIGN_EPI = false, bool SP2 = false>
__device__ __forceinline__ void gemm_phase(PG8_LAS unsigned char* lds, const Gemm g, const Sched& S, const Epi& E, const int tid_in) {
    const int tid = tid_in, wid = __builtin_amdgcn_readfirstlane(tid >> 6), lane = tid & 63, wr = wid >> 2, wc = wid & 3, fr = lane & 15, fq = lane >> 4;
    const int K = g.K, nt = K / BK;
    unsigned voffA[2], voffB[2];
#pragma unroll
    for (int i = 0; i < 2; ++i) { int R, C; stage_rc(tid * 16 + i * 8192, R, C); const int Rb = Epi::BADJ ? (64 * (R >> 5) + perm32(R & 31)) : Epi::PERM ? ((R & ~31) + perm32(R & 31)) : R;
        voffA[i] = (unsigned)(R * K + C) * 2u; voffB[i] = (unsigned)(Rb * K + C) * 2u; }
    const size_t kstep = (size_t)(BK * 2);
    const size_t hstep = (size_t)HALF * K * 2;
    const size_t tstep = 2 * hstep;
    const size_t bhstep = Epi::BADJ ? (size_t)32 * K * 2 : hstep;
    const unsigned ldsw = (unsigned)wid * 1024u;
    const int aoff = lds_byte(wr * 64 + fr, fq * 8), boff = lds_byte(wc * 32 + fr, fq * 8);
#define PG8_SA(b, h) (((b) * 2 + (h)) * HTB)
#define PG8_SB(b, h) ((4 + (b) * 2 + (h)) * HTB)
    unsigned gc[2][2], gn[2][2];
#define PG8_GOFF(dst, pmv, ordv) do { if constexpr (Sched::GATHER) { _Pragma("unroll") for (int _h = 0; _h < 2; ++_h) _Pragma("unroll") for (int _i = 0; _i < 2; ++_i) { int _R, _C; stage_rc(tid * 16 + _i * 8192, _R, _C); \
        dst[_h][_i] = (unsigned)S.arow((ordv), (pmv) * 256 + _h * 128 + _R) * (unsigned)(K * 2) + (unsigned)(_C * 2); } } } while (0)
#define PG8_STAGE_A(bufoff, origptr, nextf, hh, kbytes) do { if constexpr (Sched::GATHER) { _Pragma("unroll") for (int _i = 0; _i < 2; ++_i) { const unsigned _o = (nextf) ? gn[hh][_i] : gc[hh][_i]; \
        __builtin_amdgcn_global_load_lds((const unsigned*)((const char*)g.A + (kbytes) + _o), (PG8_LAS unsigned*)(lds + (bufoff) + ldsw + _i * 8192), 16, 0, 0); } } else { PG8_STAGE(bufoff, origptr, voffA); } } while (0)
#define PG8_STAGE(bufoff, gbase, voff) do { _Pragma("unroll") for (int _i = 0; _i < 2; ++_i) \
        __builtin_amdgcn_global_load_lds((const unsigned*)((const char*)(gbase) + (voff)[_i]), (PG8_LAS unsigned*)(lds + (bufoff) + ldsw + _i * 8192), 16, 0, 0); } while (0)
#define PG8_LDA(dst, b, h) do { _Pragma("unroll") for (int m = 0; m < 4; ++m) _Pragma("unroll") for (int k = 0; k < 2; ++k) dst[m][k] = *(const PG8_LAS bf16x8*)(lds + PG8_SA(b, h) + aoff + m * 2048 + k * 1024); } while (0)
#define PG8_LDB(dst, b, h) do { _Pragma("unroll") for (int n = 0; n < 2; ++n) _Pragma("unroll") for (int k = 0; k < 2; ++k) dst[n][k] = *(const PG8_LAS bf16x8*)(lds + PG8_SB(b, h) + boff + n * 2048 + k * 1024); } while (0)
#define PG8_MMA(ai, bj, At, Bt) do { __builtin_amdgcn_s_setprio(1); _Pragma("unroll") for (int m = 0; m < 4; ++m) _Pragma("unroll") for (int n = 0; n < 2; ++n) _Pragma("unroll") for (int k = 0; k < 2; ++k) \
        acc[ai][bj][m][n] = __builtin_amdgcn_mfma_f32_16x16x32_bf16(Bt[n][k], At[m][k], acc[ai][bj][m][n], 0, 0, 0); __builtin_amdgcn_s_setprio(0); } while (0)
#define PG8_WAIT_V(n) asm volatile("s_waitcnt vmcnt(" #n ")" ::: "memory")
#define PG8_WAIT_L(n) asm volatile("s_waitcnt lgkmcnt(" #n ")" ::: "memory")
#define PG8_BAR __builtin_amdgcn_s_barrier()
#define PG8_SCHED __builtin_amdgcn_sched_barrier(0)
    Unit cur, nxt; int ui = 0;
    if (!S.next(0, cur)) return;
    f32x4 acc[2][2][4][2];
#pragma unroll
    for (int a = 0; a < 2; ++a)
#pragma unroll
        for (int b = 0; b < 2; ++b)
#pragma unroll
            for (int m = 0; m < 4; ++m)
#pragma unroll
                for (int n = 0; n < 2; ++n) acc[a][b][m][n] = (f32x4){0.f, 0.f, 0.f, 0.f};
    bf16x8 At[4][2], B0[2][2], B1[2][2];
    const char* cA = (const char*)g.A + (size_t)cur.pm * tstep; const char* cB = (const char*)g.Bt + (size_t)cur.pn * tstep;
    S.a_ready(cur);
    PG8_GOFF(gc, cur.pm, 0);
    if constexpr (SP2) {
        PG8_STAGE(PG8_SB(0, 0), cB, voffB); PG8_STAGE(PG8_SB(0, 1), cB + bhstep, voffB); PG8_STAGE_A(PG8_SA(0, 0), cA, false, 0, 0); PG8_STAGE_A(PG8_SA(0, 1), cA + hstep, false, 1, 0);
        if (wr == 1) PG8_BAR;
        PG8_WAIT_V(2); PG8_BAR;
        PG8_STAGE(PG8_SB(1, 0), cB + kstep, voffB); PG8_STAGE_A(PG8_SA(1, 0), cA + kstep, false, 0, kstep); PG8_STAGE(PG8_SB(1, 1), cB + bhstep + kstep, voffB);
        PG8_WAIT_V(6); PG8_BAR;
    } else {
        PG8_STAGE(PG8_SB(0, 0), cB, voffB); PG8_STAGE(PG8_SA(0, 0), cA, voffA); PG8_STAGE(PG8_SB(0, 1), cB + bhstep, voffB); PG8_STAGE(PG8_SA(0, 1), cA + hstep, voffA);
        if (wr == 1) PG8_BAR;
        PG8_WAIT_V(4); PG8_BAR;
        PG8_STAGE(PG8_SB(1, 0), cB + kstep, voffB); PG8_STAGE(PG8_SA(1, 0), cA + kstep, voffA); PG8_STAGE(PG8_SB(1, 1), cB + bhstep + kstep, voffB);
        PG8_WAIT_V(6); PG8_BAR;
    }
    for (;;) {
        const bool has_next = S.next(ui + 1, nxt);
        if constexpr (Sched::GATHER) { if (has_next) { PG8_GOFF(gn, nxt.pm, ui + 1); } else { gn[0][0] = gc[0][0]; gn[0][1] = gc[0][1]; gn[1][0] = gc[1][0]; gn[1][1] = gc[1][1]; } }
        const char* nA = has_next ? (const char*)g.A + (size_t)nxt.pm * tstep : cA; const char* nB = has_next ? (const char*)g.Bt + (size_t)nxt.pn * tstep : cB;
#pragma unroll
        for (int seg = 0; seg < (Epi::MID_T > 0 ? 2 : 1); ++seg) {
        if constexpr (Epi::MID_T > 0) { if (seg == 1) { PG8_SCHED; E.mid(acc, cur, wr, wc, fr, fq); PG8_SCHED; } }
        const int t_lo = seg ? Epi::MID_T : 0, t_hi = (Epi::MID_T > 0 && seg == 0) ? Epi::MID_T : nt;
        for (int t = t_lo; t < t_hi; t += 2) {
            const bool last = (t == nt - 2);
            const char* a1 = cA + (size_t)(t + 1) * kstep;
            const char* a2 = last ? nA : cA + (size_t)(t + 2) * kstep; const char* b2 = last ? nB : cB + (size_t)(t + 2) * kstep;
            const char* a3 = a2 + kstep; const char* b3 = b2 + kstep; const size_t k2b = last ? (size_t)0 : (size_t)(t + 2) * kstep;
            if (last && has_next) S.a_ready(nxt);
            if constexpr (SP2) {
            PG8_LDB(B0, 0, 0); PG8_LDB(B1, 0, 1); PG8_SCHED; PG8_LDA(At, 0, 0); PG8_STAGE_A(PG8_SA(1, 1), a1 + hstep, false, 1, (size_t)(t + 1) * kstep);
            PG8_WAIT_V(8); PG8_WAIT_L(0); PG8_BAR; PG8_MMA(0, 0, At, B0); PG8_MMA(0, 1, At, B1); PG8_BAR; PG8_SCHED;
            PG8_LDA(At, 0, 1); PG8_STAGE(PG8_SB(0, 0), b2, voffB); PG8_STAGE(PG8_SB(0, 1), b2 + bhstep, voffB); PG8_STAGE_A(PG8_SA(0, 0), a2, last, 0, k2b);
            PG8_WAIT_V(8); PG8_WAIT_L(0); PG8_BAR; PG8_MMA(1, 0, At, B0); PG8_MMA(1, 1, At, B1); PG8_BAR; PG8_SCHED;
            PG8_LDB(B0, 1, 0); PG8_LDB(B1, 1, 1); PG8_SCHED; PG8_LDA(At, 1, 0); PG8_STAGE_A(PG8_SA(0, 1), a2 + hstep, last, 1, k2b);
            PG8_WAIT_V(8); PG8_WAIT_L(0); PG8_BAR; PG8_MMA(0, 0, At, B0); PG8_MMA(0, 1, At, B1); PG8_BAR; PG8_SCHED;
            PG8_LDA(At, 1, 1); PG8_STAGE(PG8_SB(1, 0), b3, voffB); PG8_STAGE(PG8_SB(1, 1), b3 + bhstep, voffB); PG8_STAGE_A(PG8_SA(1, 0), a3, last, 0, k2b + kstep);
            PG8_WAIT_V(8); PG8_WAIT_L(0); PG8_BAR; PG8_MMA(1, 0, At, B0); PG8_MMA(1, 1, At, B1); PG8_BAR; PG8_SCHED;
            } else {
            PG8_LDB(B0, 0, 0); PG8_SCHED; PG8_LDA(At, 0, 0); PG8_STAGE(PG8_SA(1, 1), a1 + hstep, voffA);
            PG8_WAIT_L(8); PG8_BAR; PG8_WAIT_L(0); PG8_MMA(0, 0, At, B0); PG8_BAR; PG8_SCHED;
            PG8_LDB(B1, 0, 1); PG8_STAGE(PG8_SB(0, 0), b2, voffB);
            PG8_BAR; PG8_WAIT_L(0); PG8_MMA(0, 1, At, B1); PG8_BAR;
            PG8_LDA(At, 0, 1); PG8_STAGE(PG8_SA(0, 0), a2, voffA);
            PG8_BAR; PG8_WAIT_L(0); PG8_MMA(1, 0, At, B0); PG8_BAR; PG8_SCHED;
            PG8_STAGE(PG8_SB(0, 1), b2 + bhstep, voffB);
            PG8_WAIT_V(6); PG8_BAR; PG8_MMA(1, 1, At, B1); PG8_BAR;
            PG8_LDB(B0, 1, 0); PG8_SCHED; PG8_LDA(At, 1, 0); PG8_STAGE(PG8_SA(0, 1), a2 + hstep, voffA);
            PG8_WAIT_L(8); PG8_BAR; PG8_WAIT_L(0); PG8_MMA(0, 0, At, B0); PG8_BAR; PG8_SCHED;
            PG8_LDB(B1, 1, 1); PG8_STAGE(PG8_SB(1, 0), b3, voffB);
            PG8_BAR; PG8_WAIT_L(0); PG8_MMA(0, 1, At, B1); PG8_BAR;
            PG8_LDA(At, 1, 1); PG8_STAGE(PG8_SA(1, 0), a3, voffA);
            PG8_BAR; PG8_WAIT_L(0); PG8_MMA(1, 0, At, B0); PG8_BAR; PG8_SCHED;
            PG8_STAGE(PG8_SB(1, 1), b3 + bhstep, voffB);
            PG8_WAIT_V(6); PG8_BAR; PG8_MMA(1, 1, At, B1); PG8_BAR;
            }
        }
        }
        if constexpr (ALIGN_EPI) { if (wr == 0) PG8_BAR; }
        if constexpr (!Epi::AFTER_DRAIN) { E(acc, cur, wr, wc, fr, fq); S.done(cur); }
        if (!has_next) break;
#pragma unroll
        for (int a = 0; a < 2; ++a)
#pragma unroll
            for (int b = 0; b < 2; ++b)
#pragma unroll
                for (int m = 0; m < 4; ++m)
#pragma unroll
                    for (int n = 0; n < 2; ++n) acc[a][b][m][n] = (f32x4){0.f, 0.f, 0.f, 0.f};
        cur = nxt; cA = nA; cB = nB; ++ui;
        if constexpr (Sched::GATHER) { gc[0][0] = gn[0][0]; gc[0][1] = gn[0][1]; gc[1][0] = gn[1][0]; gc[1][1] = gn[1][1]; }
        if constexpr (ALIGN_EPI) { if (wr == 1) PG8_BAR; }
    }
    PG8_WAIT_V(0);
    if constexpr (!ALIGN_EPI) { if (wr == 0) PG8_BAR; }
    PG8_BAR;
    if constexpr (Epi::AFTER_DRAIN) { E.fused(acc, cur, wr, wc, fr, fq, lds, wid, lane); S.done(cur); }
#undef PG8_SA
#undef PG8_SB
#undef PG8_STAGE
#undef PG8_STAGE_A
#undef PG8_GOFF
#undef PG8_LDA
#undef PG8_LDB
#undef PG8_MMA
#undef PG8_WAIT_V
#undef PG8_WAIT_L
#undef PG8_BAR
#undef PG8_SCHED
}
}
#define LAS __attribute__((address_space(3)))
#define XB_TMO      128
#define XB_XCNT(j)  (256  + 64 * (j))
#define XB_XSUB(j)  (1280 + 64 * (j))
#define XB_XGEN(j)  (2304 + 64 * (j))
#define XB_TOP      3328
#define XB_TOPGEN   3392
#define XCD_BAR_WORDS 3456
#define XB_SPIN_CAP (1u << 18)

__device__ __forceinline__ unsigned xb_ld(unsigned* p)              { return __hip_atomic_load(p, __ATOMIC_RELAXED, __HIP_MEMORY_SCOPE_AGENT); }
__device__ __forceinline__ unsigned xb_add(unsigned* p, unsigned v) { return __hip_atomic_fetch_add(p, v, __ATOMIC_RELAXED, __HIP_MEMORY_SCOPE_AGENT); }
__device__ __forceinline__ unsigned xb_xcc_id() { return (unsigned)__builtin_amdgcn_s_getreg((3 << 11) | 20) & 0xFu; }
#define XB_SPIN(cond, bar) do { unsigned _sp = 0; while (cond) { __builtin_amdgcn_s_sleep(1); \
    if ((++_sp & 255u) == 0u) { if (xb_ld(&(bar)[XB_TMO])) break; if (_sp > XB_SPIN_CAP) { atomicAdd(&(bar)[XB_TMO], 1u); break; } } } } while (0)

struct XcdBarrier {
    unsigned* bar; unsigned x;
    volatile LAS unsigned* st;
};

__device__ __forceinline__ XcdBarrier xcd_barrier_post(unsigned* bar, volatile LAS unsigned* st) {
    XcdBarrier b; b.bar = bar; b.x = xb_xcc_id(); b.st = st;
    if (threadIdx.x == 0) (void)xb_add(&bar[XB_XCNT(b.x)], 1u);
    return b;
}
__device__ __forceinline__ void xcd_barrier_complete(unsigned* bar, unsigned x, unsigned& nloc, unsigned& nx) {
    const unsigned G = gridDim.x * gridDim.y * gridDim.z;
    unsigned sum, cnt, mine, sp = 0u;
    for (;;) {
        sum = 0u; cnt = 0u; mine = 0u;
#pragma unroll
        for (unsigned j = 0; j < 16; ++j) { const unsigned c = xb_ld(&bar[XB_XCNT(j)]); sum += c; cnt += (c > 0u) ? 1u : 0u; mine = (j == x) ? c : mine; }
        if (sum == G) break;
        __builtin_amdgcn_s_sleep(1);
        if ((++sp & 255u) == 0u) { if (xb_ld(&bar[XB_TMO])) break; if (sp > XB_SPIN_CAP) { atomicAdd(&bar[XB_TMO], 1u); break; } }
    }
    nloc = mine > 0u ? mine : 1u; nx = cnt > 0u ? cnt : 1u;
}

__device__ __forceinline__ void xcd_barrier(const XcdBarrier& b) {
    asm volatile("s_waitcnt vmcnt(0)" ::: "memory");
    __syncthreads();
    if (threadIdx.x == 0) {
        unsigned* bar = b.bar;
        __builtin_amdgcn_s_waitcnt(0);
        unsigned nloc = b.st[0], nx = b.st[1];
        if (nloc == 0u) { xcd_barrier_complete(bar, b.x, nloc, nx); b.st[0] = nloc; b.st[1] = nx; }
        const unsigned old = xb_add(&bar[XB_XSUB(b.x)], 1u);
        const unsigned gen = old / nloc;
        if (old + 1u == (gen + 1u) * nloc) {
            __builtin_amdgcn_fence(__ATOMIC_RELEASE, "agent");
            asm volatile("s_waitcnt vmcnt(0)" ::: "memory");
            const unsigned og = xb_add(&bar[XB_TOP], 1u);
            const unsigned tg = og / nx;
            if (og + 1u == (tg + 1u) * nx) xb_add(&bar[XB_TOPGEN], 1u);
            else XB_SPIN(xb_ld(&bar[XB_TOPGEN]) == tg, bar);
            __builtin_amdgcn_fence(__ATOMIC_ACQUIRE, "agent");
            xb_add(&bar[XB_XGEN(b.x)], 1u);
            asm volatile("s_waitcnt vmcnt(0)" ::: "memory");
        } else {
            XB_SPIN(xb_ld(&bar[XB_XGEN(b.x)]) == gen, bar);
            __builtin_amdgcn_fence(__ATOMIC_ACQUIRE, "agent");
            asm volatile("s_waitcnt vmcnt(0)" ::: "memory");
        }
    }
    __syncthreads();
}


#ifndef PG8_SP2
#define PG8_SP2 true
#endif
#ifndef PG8_ALIGN
#define PG8_ALIGN true
#endif
constexpr int D = 1024, NB = 8, SEQ = 4096, T = NB * SEQ, NL = 4;
constexpr int NIN = 8704, NE = 32, FF = 1024;
constexpr int RMAX = 139264;
constexpr float LN_EPS = 1e-5f, DN_ALPHA = 1.681792830507429f;
constexpr float QSCALE = 0.18033688011112042f;
constexpr float LOG2E = 1.4426950408889634f;

constexpr size_t MiB = 1u << 20;
constexpr size_t WS_CTL = 0, CTL_ZERO_BYTES = 1 * MiB;
constexpr size_t WS_MOD = 1 * MiB;
constexpr size_t WS_ROPE = 2 * MiB;
constexpr size_t WS_WSP = 3 * MiB;
constexpr size_t WS_WRT = 4 * MiB;
constexpr size_t WS_TOKINFO = 5 * MiB;
constexpr size_t WS_TOKW = 5 * MiB + 512 * 1024;
constexpr size_t WS_ROWTOK = 6 * MiB;
constexpr size_t WS_ROWW = 7 * MiB;
constexpr size_t WS_LSE = 8 * MiB;
constexpr size_t WS_TOKROW = 14 * MiB;
constexpr size_t WS_STAT = 13 * MiB;
constexpr size_t WS_WGCNT = 12 * MiB;
constexpr size_t WS_WIN = 16 * MiB;
constexpr size_t WS_WBA = 84 * MiB;
constexpr size_t WS_WBB = 92 * MiB;
constexpr size_t WS_WOUT = 96 * MiB;
constexpr size_t WS_WUP = 104 * MiB;
constexpr size_t WS_WDN = 616 * MiB;
constexpr size_t WS_H = 872 * MiB;
constexpr size_t WS_X1 = 936 * MiB;
constexpr size_t WS_X2 = 1064 * MiB;
constexpr size_t WS_YPRE = 1192 * MiB;
constexpr size_t WS_U = 1320 * MiB, WS_V = 1384 * MiB;
constexpr size_t WS_Q = 1448 * MiB, WS_K = 1544 * MiB, WS_VV = 1640 * MiB;
constexpr size_t WS_G = 1736 * MiB;
constexpr size_t WS_OG = 1864 * MiB;
constexpr size_t WS_TT = 1960 * MiB;
constexpr size_t WS_OB = 2024 * MiB;
constexpr size_t WS_YA = 2056 * MiB;
constexpr size_t WS_MG = 2120 * MiB;
constexpr size_t WS_XG = 2184 * MiB;
constexpr size_t WS_ACT = 2456 * MiB;
constexpr size_t WS_YK = 2728 * MiB;
constexpr size_t WS_END = 2984 * MiB;
constexpr int CW_BAR = 4096;
constexpr int CW_CNT = 16384;

constexpr int RING_BYTES = 131072;
constexpr int XOFF = RING_BYTES;
constexpr int X_MISC = XOFF;
constexpr int X_SELE = XOFF + 256;
constexpr int X_SELR = XOFF + 2304;
constexpr int X_CNTL = XOFF + 4352;
constexpr int X_BASE = XOFF + 4480;
constexpr int X_TILEE = XOFF + 4608;
constexpr int X_CNTS = XOFF + 5632;
constexpr int X_OFFS = XOFF + 5760;
constexpr int LDS_BYTES = 147456;

#define GAS __attribute__((address_space(1)))
typedef unsigned short bf16;
typedef unsigned v4u __attribute__((ext_vector_type(4)));
typedef unsigned v2u __attribute__((ext_vector_type(2)));
typedef float f32x4 __attribute__((ext_vector_type(4)));
typedef short bf16x8 __attribute__((ext_vector_type(8)));
typedef short s16x4 __attribute__((ext_vector_type(4)));
#define RLX_AGENT __ATOMIC_RELAXED, __HIP_MEMORY_SCOPE_AGENT
#define LDS_WAIT() asm volatile("s_waitcnt lgkmcnt(0)" ::: "memory")
#define VM_WAIT() asm volatile("s_waitcnt vmcnt(0)" ::: "memory")

typedef __bf16 bf16x2_t __attribute__((ext_vector_type(2))); typedef float f32x2_t __attribute__((ext_vector_type(2)));
__device__ __forceinline__ unsigned pk2(float lo, float hi) { return __builtin_bit_cast(unsigned, __builtin_convertvector((f32x2_t){lo, hi}, bf16x2_t)); }
__device__ __forceinline__ float bflo(unsigned w) { return __uint_as_float(w << 16); }
__device__ __forceinline__ float bfhi(unsigned w) { return __uint_as_float(w & 0xffff0000u); }
__device__ __forceinline__ float fexp2(float x) { return __builtin_amdgcn_exp2f(x); }
__device__ __forceinline__ float frcp(float x) { return __builtin_amdgcn_rcpf(x); }
__device__ __forceinline__ float gelu_tanh(float x) { const float u = x + 0.044715f * x * x * x; return x * frcp(1.0f + fexp2(-2.302208198144325f * u)); }
__device__ __forceinline__ float sigmoidf_(float x) { return frcp(1.0f + fexp2(-LOG2E * x)); }
__device__ __forceinline__ float wave_sum(float v) {
#pragma unroll
    for (int o = 1; o < 64; o <<= 1) v += __shfl_xor(v, o);
    return v;
}
__device__ __forceinline__ float wave_max(float v) {
#pragma unroll
    for (int o = 1; o < 64; o <<= 1) v = fmaxf(v, __shfl_xor(v, o));
    return v;
}
__device__ __forceinline__ s16x4 tr16(const LAS unsigned char* p) { return __builtin_bit_cast(s16x4, __builtin_amdgcn_ds_read_tr16_b64_v4i16((LAS s16x4*)p)); }
__device__ __forceinline__ bf16x8 cat8(s16x4 lo, s16x4 hi) { return (bf16x8){lo[0], lo[1], lo[2], lo[3], hi[0], hi[1], hi[2], hi[3]}; }
__device__ __forceinline__ f32x4 mfma16(bf16x8 a, bf16x8 b, f32x4 c) { return __builtin_amdgcn_mfma_f32_16x16x32_bf16(a, b, c, 0, 0, 0); }

struct Frame {
    LAS unsigned char* lds;
    int tid, lane, wave, G, vcu, bx;
    unsigned char* ws;
    const float* const* in;
    float* out;
};
enum { I_X = 0, I_C, I_WADA, I_BADA, I_WIN, I_SPW, I_SPB, I_WBA, I_WBB, I_WOUT, I_LN1G, I_LN1B, I_WR, I_BR, I_WUP, I_BUP, I_WDN, I_BDN, I_LN2G, I_LN2B };
template <class Tp> __device__ __forceinline__ Tp* wsp(const Frame& F, size_t off) { return (Tp*)(F.ws + off); }

template <class P> __device__ __forceinline__ P launder(P p) { unsigned lo = (unsigned)(uintptr_t)p, hi = (unsigned)((uintptr_t)p >> 32); asm volatile("" : "+v"(lo), "+v"(hi));
    lo = (unsigned)__builtin_amdgcn_readfirstlane((int)lo); hi = (unsigned)__builtin_amdgcn_readfirstlane((int)hi); return (P)(((uintptr_t)hi << 32) | (uintptr_t)lo); }
struct EpiIn {
    static constexpr int MID_T = 0; static constexpr bool PERM = true, AFTER_DRAIN = false, BADJ = true;
    bf16 *U, *V, *Q, *K, *VV, *Gt; const float* rope;
    static __device__ __forceinline__ unsigned x8(unsigned v) { return (unsigned)__builtin_amdgcn_update_dpp(0, (int)v, 0x128, 0xf, 0xf, false); }
    static __device__ __forceinline__ void put(bf16* p, size_t ld, bool lo, const v4u& w0, const v4u& w1) {
        v4u sd; sd.x = lo ? w1.x : w0.x; sd.y = lo ? w1.y : w0.y; sd.z = lo ? w1.z : w0.z; sd.w = lo ? w1.w : w0.w;
        v4u rc; rc.x = x8(sd.x); rc.y = x8(sd.y); rc.z = x8(sd.z); rc.w = x8(sd.w);
        v4u oa, ob; oa.x = lo ? w0.x : rc.x; oa.y = lo ? w0.y : rc.y; oa.z = lo ? w0.z : rc.z; oa.w = lo ? w0.w : rc.w;
        ob.x = lo ? rc.x : w1.x; ob.y = lo ? rc.y : w1.y; ob.z = lo ? rc.z : w1.z; ob.w = lo ? rc.w : w1.w;
        __builtin_nontemporal_store(oa, (v4u*)p); __builtin_nontemporal_store(ob, (v4u*)(p + 8 * ld)); }
    __device__ __forceinline__ void operator()(const f32x4 (&acc)[2][2][4][2], const pg8::Unit& u, int wr, int wc, int fr, int fq) const {
        const int pn = u.pn; int type, ld, colt; bf16* base;
        if (pn < 4) { type = 0; base = U; ld = 1024; colt = pn * 256; }
        else if (pn < 8) { type = 0; base = V; ld = 1024; colt = (pn - 4) * 256; }
        else if (pn < 14) { type = 1; base = Q; ld = 1536; colt = (pn - 8) * 256; }
        else if (pn < 20) { type = 2; base = K; ld = 1536; colt = (pn - 14) * 256; }
        else if (pn < 26) { type = 3; base = VV; ld = 1536; colt = (pn - 20) * 256; }
        else { type = 4; base = Gt; ld = 2048; colt = (pn - 26) * 256; }
        const bool lo = fr < 8;
        const int rowl = u.pm * 256 + wr * 64 + fr;
        bf16* const pst = base + (size_t)(u.pm * 256 + wr * 64 + (fr & 7)) * ld + colt + wc * 64 + (fr >> 3) * 32 + 8 * fq;
        if (type == 0) {
#pragma unroll
            for (int ai = 0; ai < 2; ++ai)
#pragma unroll
                for (int m = 0; m < 4; ++m) { v4u w[2];
#pragma unroll
                    for (int bj = 0; bj < 2; ++bj) { const f32x4 v0 = acc[ai][bj][m][0], v1 = acc[ai][bj][m][1];
                        w[bj].x = pk2(gelu_tanh(v0[0]), gelu_tanh(v0[1])); w[bj].y = pk2(gelu_tanh(v0[2]), gelu_tanh(v0[3]));
                        w[bj].z = pk2(gelu_tanh(v1[0]), gelu_tanh(v1[1])); w[bj].w = pk2(gelu_tanh(v1[2]), gelu_tanh(v1[3])); }
                    put(pst + (size_t)(ai * 128 + m * 16) * ld, ld, lo, w[0], w[1]); }
        } else if (type == 4) {
#pragma unroll
            for (int ai = 0; ai < 2; ++ai)
#pragma unroll
                for (int m = 0; m < 4; ++m) { v4u w[2];
#pragma unroll
                    for (int bj = 0; bj < 2; ++bj) { const f32x4 v0 = acc[ai][bj][m][0], v1 = acc[ai][bj][m][1];
                        w[bj].x = pk2(sigmoidf_(v0[0]), sigmoidf_(v0[1])); w[bj].y = pk2(sigmoidf_(v0[2]), sigmoidf_(v0[3]));
                        w[bj].z = pk2(sigmoidf_(v1[0]), sigmoidf_(v1[1])); w[bj].w = pk2(sigmoidf_(v1[2]), sigmoidf_(v1[3])); }
                    put(pst + (size_t)(ai * 128 + m * 16) * ld, ld, lo, w[0], w[1]); }
        } else if (type == 3) {
#pragma unroll
            for (int ai = 0; ai < 2; ++ai)
#pragma unroll
                for (int m = 0; m < 4; ++m) { v4u w[2];
#pragma unroll
                    for (int bj = 0; bj < 2; ++bj) { const f32x4 v0 = acc[ai][bj][m][0], v1 = acc[ai][bj][m][1];
                        w[bj].x = pk2(v0[0], v0[1]); w[bj].y = pk2(v0[2], v0[3]); w[bj].z = pk2(v1[0], v1[1]); w[bj].w = pk2(v1[2], v1[3]); }
                    put(pst + (size_t)(ai * 128 + m * 16) * ld, ld, lo, w[0], w[1]); }
        } else {
            const float sc = (type == 1) ? QSCALE : 1.0f;
#pragma unroll
            for (int ai = 0; ai < 2; ++ai)
#pragma unroll
                for (int m = 0; m < 4; ++m) { const int row = rowl + ai * 128 + m * 16;
                    const f32x4* rp = (const f32x4*)(rope + (size_t)(row & (SEQ - 1)) * 16); const f32x4 c0 = rp[0], c1 = rp[1], s0 = rp[2], s1 = rp[3];
                    float cs[8], sn[8];
#pragma unroll
                    for (int e = 0; e < 4; ++e) { cs[e] = c0[e]; cs[4 + e] = c1[e]; sn[e] = s0[e]; sn[4 + e] = s1[e]; }
                    v4u w[2];
#pragma unroll
                    for (int bj = 0; bj < 2; ++bj) { f32x4 v0 = acc[ai][bj][m][0], v1 = acc[ai][bj][m][1];
                        if (bj == 0) {
#pragma unroll
                            for (int e = 0; e < 8; ++e) { const float x = (e < 4) ? v0[e & 3] : v1[e & 3]; const float p = __shfl_xor(x, 16);
                                float y = x;
                                if (fq == 0) y = x * cs[e] - p * sn[e];
                                if (fq == 1) y = x * cs[e] + p * sn[e];
                                if (e < 4) v0[e & 3] = y; else v1[e & 3] = y; } }
                        w[bj].x = pk2(v0[0] * sc, v0[1] * sc); w[bj].y = pk2(v0[2] * sc, v0[3] * sc); w[bj].z = pk2(v1[0] * sc, v1[1] * sc); w[bj].w = pk2(v1[2] * sc, v1[3] * sc); }
                    put(pst + (size_t)(ai * 128 + m * 16) * ld, ld, lo, w[0], w[1]); }
        }
    }
};
struct EpiProbe {
    static constexpr int MID_T = 0; static constexpr bool PERM = true, AFTER_DRAIN = false, BADJ = false;
    bf16* O; int ld; int on;
    __device__ __forceinline__ void operator()(const f32x4 (&acc)[2][2][4][2], const pg8::Unit& u, int wr, int wc, int fr, int fq) const {
        if (!on) return;
        const int row0 = u.pm * 256 + wr * 64 + fr, col0 = ((on == 3) ? u.pn : (u.pn & 3)) * 256 + wc * 32 + 8 * fq;
#pragma unroll
        for (int ai = 0; ai < 2; ++ai)
#pragma unroll
            for (int m = 0; m < 4; ++m) { bf16* rowp = O + (size_t)(row0 + ai * 128 + m * 16) * ld + col0;
#pragma unroll
                for (int bj = 0; bj < 2; ++bj) { const f32x4 v0 = acc[ai][bj][m][0], v1 = acc[ai][bj][m][1]; v4u w;
                    w.x = pk2(v0[0], v0[1]); w.y = pk2(v0[2], v0[3]); w.z = pk2(v1[0], v1[1]); w.w = pk2(v1[2], v1[3]);
                    *(v4u*)(rowp + bj * 128) = w; } }
    }
};
struct EpiYA {
    static constexpr int MID_T = 0; static constexpr bool PERM = true, AFTER_DRAIN = false, BADJ = false;
    const bf16* Gt; bf16* YA;
    __device__ __forceinline__ void operator()(const f32x4 (&acc)[2][2][4][2], const pg8::Unit& u, int wr, int wc, int fr, int fq) const {
        const int row0 = u.pm * 256 + wr * 64 + fr, col0 = u.pn * 256 + wc * 32 + 8 * fq;
#pragma unroll
        for (int ai = 0; ai < 2; ++ai)
#pragma unroll
            for (int m = 0; m < 4; ++m) { const size_t row = (size_t)(row0 + ai * 128 + m * 16);
#pragma unroll
                for (int bj = 0; bj < 2; ++bj) { const f32x4 v0 = acc[ai][bj][m][0], v1 = acc[ai][bj][m][1];
                    const v4u g = *(const v4u*)(Gt + row * 2048 + col0 + bj * 128); v4u w;
                    w.x = pk2(v0[0] * bflo(g.x), v0[1] * bfhi(g.x)); w.y = pk2(v0[2] * bflo(g.y), v0[3] * bfhi(g.y));
                    w.z = pk2(v1[0] * bflo(g.z), v1[1] * bfhi(g.z)); w.w = pk2(v1[2] * bflo(g.w), v1[3] * bfhi(g.w));
                    *(v4u*)(YA + row * 1024 + col0 + bj * 128) = w; } }
    }
};
struct EpiMg {
    static constexpr int MID_T = 0; static constexpr bool PERM = true, AFTER_DRAIN = false, BADJ = false;
    const bf16* Gt; const bf16* YA; bf16* MG;
    __device__ __forceinline__ void operator()(const f32x4 (&acc)[2][2][4][2], const pg8::Unit& u, int wr, int wc, int fr, int fq) const {
        const int row0 = u.pm * 256 + wr * 64 + fr, col0 = u.pn * 256 + wc * 32 + 8 * fq;
#pragma unroll
        for (int ai = 0; ai < 2; ++ai)
#pragma unroll
            for (int m = 0; m < 4; ++m) { const size_t row = (size_t)(row0 + ai * 128 + m * 16);
#pragma unroll
                for (int bj = 0; bj < 2; ++bj) { const f32x4 v0 = acc[ai][bj][m][0], v1 = acc[ai][bj][m][1];
                    const v4u g = *(const v4u*)(Gt + row * 2048 + 1024 + col0 + bj * 128); const v4u y = *(const v4u*)(YA + row * 1024 + col0 + bj * 128); v4u w;
                    w.x = pk2(bflo(y.x) + v0[0] * bflo(g.x), bfhi(y.x) + v0[1] * bfhi(g.x)); w.y = pk2(bflo(y.y) + v0[2] * bflo(g.y), bfhi(y.y) + v0[3] * bfhi(g.y));
                    w.z = pk2(bflo(y.z) + v1[0] * bflo(g.z), bfhi(y.z) + v1[1] * bfhi(g.z)); w.w = pk2(bflo(y.w) + v1[2] * bflo(g.w), bfhi(y.w) + v1[3] * bfhi(g.w));
                    *(v4u*)(MG + row * 1024 + col0 + bj * 128) = w; } }
    }
};
struct EpiMg2 {
    static constexpr int MID_T = 16; static constexpr bool PERM = true, AFTER_DRAIN = false, BADJ = false;
    const bf16* Gt; bf16* MG;
    __device__ __forceinline__ void mid(f32x4 (&acc)[2][2][4][2], const pg8::Unit& u, int wr, int wc, int fr, int fq) const {
        int row0 = u.pm * 256 + wr * 64 + fr; const int col0 = u.pn * 256 + wc * 32 + 8 * fq;
        asm volatile("" : "+v"(row0));
#pragma unroll
        for (int ai = 0; ai < 2; ++ai)
#pragma unroll
            for (int m = 0; m < 4; ++m) { const size_t row = (size_t)(row0 + ai * 128 + m * 16);
#pragma unroll
                for (int bj = 0; bj < 2; ++bj) { const v4u g0 = *(const v4u*)(Gt + row * 2048 + col0 + bj * 128), g1 = *(const v4u*)(Gt + row * 2048 + 1024 + col0 + bj * 128);
                    const unsigned a0[4] = {g0.x, g0.y, g0.z, g0.w}, a1[4] = {g1.x, g1.y, g1.z, g1.w};
#pragma unroll
                    for (int q = 0; q < 4; ++q) { const float r0 = bflo(a0[q]) * frcp(fmaxf(bflo(a1[q]), 1e-20f)), r1 = bfhi(a0[q]) * frcp(fmaxf(bfhi(a1[q]), 1e-20f));
                        acc[ai][bj][m][q >> 1][(q & 1) * 2] *= r0; acc[ai][bj][m][q >> 1][(q & 1) * 2 + 1] *= r1; } }
                if (m == 3) asm volatile("" ::: "memory"); }
    }
    __device__ __forceinline__ void operator()(const f32x4 (&acc)[2][2][4][2], const pg8::Unit& u, int wr, int wc, int fr, int fq) const {
        const int row0 = u.pm * 256 + wr * 64 + fr, col0 = u.pn * 256 + wc * 32 + 8 * fq;
#pragma unroll
        for (int ai = 0; ai < 2; ++ai)
#pragma unroll
            for (int m = 0; m < 4; ++m) { const size_t row = (size_t)(row0 + ai * 128 + m * 16);
#pragma unroll
                for (int bj = 0; bj < 2; ++bj) { const f32x4 v0 = acc[ai][bj][m][0], v1 = acc[ai][bj][m][1];
                    const v4u g = *(const v4u*)(Gt + row * 2048 + 1024 + col0 + bj * 128); v4u w;
                    w.x = pk2(v0[0] * fmaxf(bflo(g.x), 1e-20f), v0[1] * fmaxf(bfhi(g.x), 1e-20f)); w.y = pk2(v0[2] * fmaxf(bflo(g.y), 1e-20f), v0[3] * fmaxf(bfhi(g.y), 1e-20f));
                    w.z = pk2(v1[0] * fmaxf(bflo(g.z), 1e-20f), v1[1] * fmaxf(bfhi(g.z), 1e-20f)); w.w = pk2(v1[2] * fmaxf(bflo(g.w), 1e-20f), v1[3] * fmaxf(bfhi(g.w), 1e-20f));
                    *(v4u*)(MG + row * 1024 + col0 + bj * 128) = w; } }
    }
};
template <bool XF32> struct EpiOut {
    static constexpr int MID_T = 0; static constexpr bool PERM = true, AFTER_DRAIN = false, BADJ = false;
    const void* xres; const float* modl  ; bf16* YPRE;
    __device__ __forceinline__ void operator()(const f32x4 (&acc)[2][2][4][2], const pg8::Unit& u, int wr, int wc, int fr, int fq) const {
        const int row0 = u.pm * 256 + wr * 64 + fr, col0 = u.pn * 256 + wc * 32 + 8 * fq; const int b = (u.pm * 256) >> 12;
        f32x4 gg[2][2];
#pragma unroll
        for (int bj = 0; bj < 2; ++bj)
#pragma unroll
            for (int n = 0; n < 2; ++n) gg[bj][n] = *(const f32x4*)(modl + (size_t)b * 6144 + 2048 + col0 + bj * 128 + 4 * n) + 1.0f;
#pragma unroll
        for (int ai = 0; ai < 2; ++ai)
#pragma unroll
            for (int m = 0; m < 4; ++m) { const size_t off = (size_t)(row0 + ai * 128 + m * 16) * 1024 + col0;
#pragma unroll
                for (int bj = 0; bj < 2; ++bj) { f32x4 x0, x1;
                    if (XF32) { x0 = *(const f32x4*)((const float*)xres + off + bj * 128); x1 = *(const f32x4*)((const float*)xres + off + bj * 128 + 4); }
                    else { const v4u xr = *(const v4u*)((const bf16*)xres + off + bj * 128); x0 = (f32x4){bflo(xr.x), bfhi(xr.x), bflo(xr.y), bfhi(xr.y)}; x1 = (f32x4){bflo(xr.z), bfhi(xr.z), bflo(xr.w), bfhi(xr.w)}; }
                    const f32x4 o0 = x0 * DN_ALPHA + gg[bj][0] * acc[ai][bj][m][0], o1 = x1 * DN_ALPHA + gg[bj][1] * acc[ai][bj][m][1];
                    v4u w; w.x = pk2(o0[0], o0[1]); w.y = pk2(o0[2], o0[3]); w.z = pk2(o1[0], o1[1]); w.w = pk2(o1[2], o1[3]);
                    *(v4u*)(YPRE + off + bj * 128) = w; }
                if (m == 3) asm volatile("" ::: "memory"); }
    }
};
struct EpiUp {
    static constexpr int MID_T = 0; static constexpr bool PERM = true, AFTER_DRAIN = false, BADJ = false;
    const float* bup  ; bf16* ACT;
    __device__ __forceinline__ void operator()(const f32x4 (&acc)[2][2][4][2], const pg8::Unit& u, int wr, int wc, int fr, int fq) const {
        const int e = u.pn >> 3, pnl = u.pn & 7; const int row0 = u.pm * 256 + wr * 64 + fr, ac0 = pnl * 128 + wc * 32 + 8 * fq;
        const f32x4* bp = (const f32x4*)(bup + (size_t)e * 2048 + 2 * ac0); const f32x4 b0 = bp[0], b1 = bp[1], b2 = bp[2], b3 = bp[3];
        const float bg[8] = {b0[0], b0[2], b1[0], b1[2], b2[0], b2[2], b3[0], b3[2]}, bl[8] = {b0[1], b0[3], b1[1], b1[3], b2[1], b2[3], b3[1], b3[3]};
#pragma unroll
        for (int ai = 0; ai < 2; ++ai)
#pragma unroll
            for (int m = 0; m < 4; ++m) { float a[8];
#pragma unroll
                for (int j = 0; j < 8; ++j) { const float hg = acc[ai][0][m][j >> 2][j & 3] + bg[j], hl = acc[ai][1][m][j >> 2][j & 3] + bl[j];
                    const float glu = fminf(hg, 7.0f), lin = fminf(fmaxf(hl, -7.0f), 7.0f);
                    a[j] = glu * frcp(1.0f + fexp2(-2.4554669595930156f * glu)) * (lin + 1.0f); }
                v4u w; w.x = pk2(a[0], a[1]); w.y = pk2(a[2], a[3]); w.z = pk2(a[4], a[5]); w.w = pk2(a[6], a[7]);
                *(v4u*)(ACT + (size_t)(row0 + ai * 128 + m * 16) * 1024 + ac0) = w; }
    }
};
struct EpiDn {
    static constexpr int MID_T = 0; static constexpr bool PERM = true, AFTER_DRAIN = false, BADJ = false;
    const float* bdn  ; bf16* YKS;
    __device__ __forceinline__ void operator()(const f32x4 (&acc)[2][2][4][2], const pg8::Unit& u, int wr, int wc, int fr, int fq) const {
        const int e = u.pn >> 2, pnl = u.pn & 3; const int row0 = u.pm * 256 + wr * 64 + fr, col0 = pnl * 256 + wc * 32 + 8 * fq;
        f32x4 bv[2][2];
#pragma unroll
        for (int bj = 0; bj < 2; ++bj)
#pragma unroll
            for (int n = 0; n < 2; ++n) bv[bj][n] = *(const f32x4*)(bdn + (size_t)e * 1024 + col0 + bj * 128 + 4 * n);
#pragma unroll
        for (int ai = 0; ai < 2; ++ai)
#pragma unroll
            for (int m = 0; m < 4; ++m) { bf16* op = YKS + (size_t)(row0 + ai * 128 + m * 16) * 1024 + col0;
#pragma unroll
                for (int bj = 0; bj < 2; ++bj) { const f32x4 v0 = acc[ai][bj][m][0] + bv[bj][0], v1 = acc[ai][bj][m][1] + bv[bj][1]; v4u w;
                    w.x = pk2(v0[0], v0[1]); w.y = pk2(v0[2], v0[3]); w.z = pk2(v1[0], v1[1]); w.w = pk2(v1[2], v1[3]);
                    *(v4u*)(op + bj * 128) = w; } }
    }
};
struct MoeOrder {
    static constexpr bool GATHER = false; __device__ __forceinline__ int arow(int, int r) const { return r; }
    int nM, nN, nwg, G, c, rev; const LAS unsigned char* tile_e;
    __device__ void init(int RT, int NN, int G_, int c_, const LAS unsigned char* te, int rev_ = 0) { nM = RT; nN = NN; nwg = RT * NN; G = G_; c = c_; tile_e = te; rev = rev_; }
    __device__ bool next(int i, pg8::Unit& u) const {
        const long L = (long)i * G + c; if (L >= nwg) return false;
        int wgid = (int)L; { const int q = nwg / pg8::NXCD, r = nwg % pg8::NXCD, xcd = wgid % pg8::NXCD, off = wgid / pg8::NXCD; wgid = (xcd < r ? xcd * (q + 1) : r * (q + 1) + (xcd - r) * q) + off; }
        const int nig = pg8::WGM * nN, gid = wgid / nig, fm = gid * pg8::WGM, gsz = (nM - fm) < pg8::WGM ? (nM - fm) : pg8::WGM;
        int pm = fm + ((wgid % nig) % gsz); const int pnl = (wgid % nig) / gsz; if (rev) pm = nM - 1 - pm;
        u.pm = pm; u.pn = (int)tile_e[pm] * nN + pnl; return true;
    }
    __device__ __forceinline__ void a_ready(const pg8::Unit&) const {}
    __device__ __forceinline__ void done(const pg8::Unit&) const {}
};

#ifndef STAG_N
#define STAG_N 1
#endif
#ifndef STAG_US
#define STAG_US 24
#endif
__device__ __forceinline__ void stagger(int slot, int us) {
    if (STAG_N <= 1) return;
    const unsigned long long t0 = __builtin_amdgcn_s_memrealtime(); const unsigned long long ticks = (unsigned long long)(slot % STAG_N) * (unsigned)us * 100ull / STAG_N;
    while (__builtin_amdgcn_s_memrealtime() - t0 < ticks) __builtin_amdgcn_s_sleep(16);
}
struct MoeGatherOrder : MoeOrder {
    static constexpr bool GATHER = true; const LAS unsigned short* tokl;
    __device__ __forceinline__ int arow(int ord, int r) const { return (int)tokl[ord * 256 + (r & 255)]; }
};
constexpr int X_TOKL = XOFF + 6144, TOKL_UNITS = 20;
constexpr int TR_NR = 32, TR_WAVE_BYTES = 64 * 64 * 4;
struct TrItem { const float* src; bf16* dst; int ld, K, kind, k0, c0, koff; };
__device__ __forceinline__ void tr_load(const TrItem& t, int lane, f32x4 (&r)[TR_NR]) {
    const int kq = lane >> 4, cc = lane & 15;
#pragma unroll
    for (int i = 0; i < TR_NR; ++i) r[i] = __builtin_nontemporal_load((const f32x4*)(t.src + (size_t)(t.k0 + 2 * (kq + 4 * (i >> 1)) + (i & 1)) * t.ld + t.c0 + 4 * cc));
}
__device__ __forceinline__ void tr_tile(int lane, LAS unsigned* scr, const f32x4 (&r)[TR_NR]) {
    const int kq = lane >> 4, cc = lane & 15;
#pragma unroll
    for (int i2 = 0; i2 < TR_NR / 2; ++i2) { LAS unsigned* p = scr + (4 * cc) * 64 + ((kq + 4 * i2) ^ (cc << 2));
#pragma unroll
        for (int e = 0; e < 4; ++e) p[e * 64] = pk2(r[2 * i2][e], r[2 * i2 + 1][e]); }
    LDS_WAIT(); asm volatile("" ::: "memory");
}
__device__ __forceinline__ void tr_store(const TrItem& t, int lane, const LAS unsigned* scr) {
    const int c = lane & 15;
    const int pbase = (t.kind == 0) ? t.c0 : (256 * (t.c0 >> 8) + ((t.c0 & 255) >> 1));
#pragma unroll
    for (int j = 0; j < 16; ++j) { const int n = (lane >> 4) + 4 * j; const v4u o = *(const LAS v4u*)(scr + n * 64 + ((c ^ j) << 2));
        const int drow = (t.kind == 0) ? (pbase + n) : (pbase + 128 * (n & 1) + (n >> 1));
        __builtin_nontemporal_store(o, (v4u*)(t.dst + (size_t)drow * t.K + t.koff + t.k0 + 8 * c)); }
    LDS_WAIT(); asm volatile("" ::: "memory");
}
__device__ __forceinline__ void sincos_d(double a, double& s, double& c) {
    const double k = rint(a * 0.63661977236758134308);
    const double y = fma(-k, 6.12323399573676603587e-17, fma(-k, 1.57079632679489655800, a));
    const double y2 = y * y;
    double sp = -7.6471637318198164759e-13; sp = fma(sp, y2, 1.6059043836821614599e-10); sp = fma(sp, y2, -2.5052108385441718775e-8); sp = fma(sp, y2, 2.7557319223985890653e-6);
    sp = fma(sp, y2, -1.9841269841269841270e-4); sp = fma(sp, y2, 8.3333333333333333333e-3); sp = fma(sp, y2, -1.6666666666666666667e-1); const double sy = fma(sp * y2, y, y);
    double cp = 4.7794773323873852974e-14; cp = fma(cp, y2, -1.1470745597729724714e-11); cp = fma(cp, y2, 2.0876756987868098979e-9); cp = fma(cp, y2, -2.7557319223985890653e-7);
    cp = fma(cp, y2, 2.4801587301587301587e-5); cp = fma(cp, y2, -1.3888888888888888889e-3); cp = fma(cp, y2, 4.1666666666666666667e-2); cp = fma(cp, y2, -0.5); const double cy = fma(cp, y2, 1.0);
    const int q = ((int)k) & 3;
    s = (q == 0) ? sy : (q == 1) ? cy : (q == 2) ? -sy : -cy;
    c = (q == 0) ? cy : (q == 1) ? -sy : (q == 2) ? -cy : sy;
}
__device__ __forceinline__ void phase_pro_a(Frame& F) {
    LAS unsigned* scr = (LAS unsigned*)(F.lds + F.wave * TR_WAVE_BYTES);
    const int gw = F.vcu * 8 + F.wave, NGW = F.G * 8;
    constexpr int I_IN = 8 * 136, I_SQ = 8 * 16, I_BB = 4 * 16, I_UP = 8 * 32;
    constexpr int S0 = NL * I_IN, S1 = S0 + NL * I_SQ, S2 = S1 + NL * I_BB, S3 = S2 + NL * I_SQ, S4 = S3 + NL * NE * I_SQ, S5 = S4 + NL * NE * I_UP;
    auto decode = [&](int it) -> TrItem { TrItem t; t.koff = 0;
        if (it < S0) { const int l = it / I_IN, r = it % I_IN; t.src = F.in[I_WIN] + (size_t)l * D * NIN; t.dst = wsp<bf16>(F, WS_WIN) + (size_t)l * NIN * D; t.ld = NIN; t.K = D; t.kind = 0; t.k0 = 128 * (r / 136); t.c0 = 64 * (r % 136); }
        else if (it < S1) { const int q = it - S0, l = q / I_SQ, r = q % I_SQ; t.src = F.in[I_WBA] + (size_t)l * D * D; t.dst = wsp<bf16>(F, WS_WBA) + (size_t)l * D * 1536; t.ld = D; t.K = 1536; t.kind = 0; t.k0 = 128 * (r / 16); t.c0 = 64 * (r % 16); }
        else if (it < S2) { const int q = it - S1, l = q / I_BB, r = q % I_BB; t.src = F.in[I_WBB] + (size_t)l * 512 * D; t.dst = wsp<bf16>(F, WS_WBA) + (size_t)l * D * 1536; t.ld = D; t.K = 1536; t.koff = 1024; t.kind = 0; t.k0 = 128 * (r / 16); t.c0 = 64 * (r % 16); }
        else if (it < S3) { const int q = it - S2, l = q / I_SQ, r = q % I_SQ; t.src = F.in[I_WOUT] + (size_t)l * D * D; t.dst = wsp<bf16>(F, WS_WOUT) + (size_t)l * D * D; t.ld = D; t.K = D; t.kind = 0; t.k0 = 128 * (r / 16); t.c0 = 64 * (r % 16); }
        else if (it < S4) { const int q = it - S3, le = q / I_SQ, r = q % I_SQ; t.src = F.in[I_WDN] + (size_t)le * FF * D; t.dst = wsp<bf16>(F, WS_WDN) + (size_t)le * D * FF; t.ld = D; t.K = FF; t.kind = 0; t.k0 = 128 * (r / 16); t.c0 = 64 * (r % 16); }
        else { const int q = it - S4, le = q / I_UP, r = q % I_UP; t.src = F.in[I_WUP] + (size_t)le * D * 2048; t.dst = wsp<bf16>(F, WS_WUP) + (size_t)le * 2048 * D; t.ld = 2048; t.K = D; t.kind = 1; t.k0 = 128 * (r / 32); t.c0 = 64 * (r % 32); }
        return t; };
    {
        f32x4 rn[TR_NR]; TrItem tn; int it = gw;
        if (it < S5) { tn = decode(it); tr_load(tn, F.lane, rn); }
#pragma unroll 1
        for (; it < S5; it += NGW) {
            const TrItem tc = tn;
            tr_tile(F.lane, scr, rn);
            if (it + NGW < S5) { tn = decode(it + NGW); tr_load(tn, F.lane, rn); }
            tr_store(tc, F.lane, scr);
        }
    }
    __syncthreads();
    {
        LAS float* cT = (LAS float*)F.lds;
        LAS float* red = (LAS float*)(F.lds + 32768);
        const float* cv = F.in[I_C];
        for (int i = F.tid; i < 8 * 1024; i += 512) { const int bb = i >> 10, k = i & 1023; cT[k * 8 + bb] = cv[i]; }
        __syncthreads();
        const int hf = F.lane >> 5, c4 = F.lane & 31;
        for (int u = F.vcu; u < NL * 48; u += F.G) {
            const int l = u / 48, n0 = 128 * (u % 48);
            f32x4 a[8];
#pragma unroll
            for (int bb = 0; bb < 8; ++bb) a[bb] = (f32x4){0.f, 0.f, 0.f, 0.f};
            const int kb = F.wave * 128 + hf;
            const float* wp = F.in[I_WADA] + (size_t)l * D * 6144 + (size_t)kb * 6144 + n0 + 4 * c4;
#pragma unroll 8
            for (int kk = 0; kk < 64; ++kk) { const f32x4 w = *(const f32x4*)(wp + (size_t)(2 * kk) * 6144);
                const f32x4 c0 = *(const LAS f32x4*)(cT + (kb + 2 * kk) * 8), c1 = *(const LAS f32x4*)(cT + (kb + 2 * kk) * 8 + 4);
#pragma unroll
                for (int bb = 0; bb < 4; ++bb) { a[bb] += w * c0[bb]; a[4 + bb] += w * c1[bb]; } }
#pragma unroll
            for (int bb = 0; bb < 8; ++bb) *(LAS f32x4*)(red + ((F.wave * 2 + hf) * 8 + bb) * 128 + 4 * c4) = a[bb];
            __syncthreads();
#pragma unroll
            for (int q = 0; q < 2; ++q) { const int o = F.tid + 512 * q, bb = o >> 7, cn = o & 127; float sum = F.in[I_BADA][l * 6144 + n0 + cn];
#pragma unroll
                for (int p = 0; p < 16; ++p) sum += red[(p * 8 + bb) * 128 + cn];
                wsp<float>(F, WS_MOD)[(size_t)(l * 8 + bb) * 6144 + n0 + cn] = sum; }
            __syncthreads();
        }
    }
    const int gt = F.vcu * 512 + F.tid, NT = F.G * 512;
    for (int i = gt; i < SEQ * 8; i += NT) { const int pos = i >> 3, f = i & 7;
        const double inv = (f == 0) ? 1.0 : (f == 1) ? 0.19392274474868576 : (f == 2) ? 0.03760603093086393 : (f == 3) ? 0.007292664737217109 : (f == 4) ? 0.001414213562373095 : (f == 5) ? 0.0002742481756762073 : (f == 6) ? 5.318295896944988e-05 : 1.031338537721246e-05;
        double s, c; sincos_d((double)pos * inv, s, c);
        float* rp = wsp<float>(F, WS_ROPE) + (size_t)pos * 16; rp[f] = (float)c; rp[8 + f] = (float)s; }
    for (int i = gt; i < NL * 4 * 128 * 128; i += NT) { const int j = i & 127, ii = (i >> 7) & 127; const float w = F.in[I_SPW][i];
        wsp<bf16>(F, WS_WSP)[i] = (bf16)(pk2((j <= ii) ? w : 0.f, 0.f) & 0xffffu); }
    for (int i = gt; i < NL * NE * D; i += NT) { const int k = i & 1023, e = (i >> 10) & 31, l = i >> 15; const float w = F.in[I_WR][((size_t)l * D + k) * NE + e];
        const unsigned hi = pk2(w, 0.f) & 0xffffu; const float lo = w - __uint_as_float(hi << 16);
        wsp<bf16>(F, WS_WRT)[i] = (bf16)hi; wsp<bf16>(F, WS_WRT)[NL * NE * D + i] = (bf16)(pk2(lo, 0.f) & 0xffffu); }
}
__device__ __forceinline__ void phase_pro_b(Frame& F) {
    const int gw = F.vcu * 8 + F.wave, NGW = F.G * 8;
    const float* mod = wsp<float>(F, WS_MOD);
    for (int m = gw; m < T; m += NGW) { const int b = m >> 12; const float* mb = mod + (size_t)b * 6144;
        const f32x4* xr = (const f32x4*)(F.in[I_X] + (size_t)m * D) + F.lane; v2u* hp = (v2u*)(wsp<bf16>(F, WS_H) + (size_t)m * D) + F.lane;
#pragma unroll
        for (int j = 0; j < 4; ++j) { const f32x4 x = xr[64 * j]; const f32x4 sh = *((const f32x4*)mb + F.lane + 64 * j), sc = *((const f32x4*)(mb + 1024) + F.lane + 64 * j);
            const f32x4 h = x * (sc + 1.0f) + sh; v2u o; o.x = pk2(h[0], h[1]); o.y = pk2(h[2], h[3]); hp[64 * j] = o; } }
}

constexpr int AT_RS = 144;
constexpr int AT_ROWS = 400, AT_VOFF = AT_ROWS * AT_RS;
#define LDS_BARRIER() do { asm volatile("s_waitcnt lgkmcnt(0)" ::: "memory"); __builtin_amdgcn_s_barrier(); asm volatile("" ::: "memory"); } while (0)
struct AtUnit { int g, b, h, r, n, d; size_t hoff; };
__device__ __forceinline__ AtUnit at_decode(int u) { AtUnit a; a.g = u >> 10; const int rem = u & 1023; a.b = rem >> 7; a.h = (rem >> 4) & 7; const int rn = rem & 15;
    const int dsh = 2 * a.g, nbs = 4 - dsh; a.d = 1 << dsh; a.r = rn >> nbs; a.n = 2 * (rn & ((1 << nbs) - 1)); a.hoff = (size_t)a.g * 512 + a.h * 64; return a; }
constexpr int AT_NU = 3 * 1024;
struct AtSlot { v4u k[6], v[6]; bf16x8 q0, q1, q2, q3; };
struct AtCtx { const bf16 *Qb, *Kb, *Vb; bf16* OG; float* LSE; LAS unsigned char *Ks, *Vs; int qi, g4, piece, jr; };
__device__ __forceinline__ void at_load(AtSlot& sl, int uu, const AtCtx& C, const Frame& F) {
    const AtUnit a_ = at_decode(uu);
#pragma unroll
    for (int ps = 0; ps < 6; ++ps) { const int lp = 128 * (a_.n - 1) + ps * 64 + C.jr; sl.k[ps] = (v4u){0u, 0u, 0u, 0u}; sl.v[ps] = sl.k[ps];
        if (lp >= 0) { const size_t off = ((size_t)a_.b * SEQ + (size_t)lp * a_.d + a_.r) * 1536 + a_.hoff + C.piece * 8; sl.k[ps] = *(const v4u*)(C.Kb + off); sl.v[ps] = *(const v4u*)(C.Vb + off); } }
    const size_t qrow_ = (size_t)a_.b * SEQ + (size_t)(128 * a_.n + 16 * F.wave + C.qi) * a_.d + a_.r; const bf16* qp = C.Qb + qrow_ * 1536 + a_.hoff + 8 * C.g4;
    sl.q0 = *(const bf16x8*)qp; sl.q1 = *(const bf16x8*)(qp + 32);
    const bf16* qp2 = qp + (size_t)128 * a_.d * 1536; sl.q2 = *(const bf16x8*)qp2; sl.q3 = *(const bf16x8*)(qp2 + 32);
}
__device__ __forceinline__ void at_unit(AtSlot& sl, int u, int unext, const AtCtx& C, const Frame& F) {
    bf16* OG = C.OG; float* LSE = C.LSE; LAS unsigned char* Ks = C.Ks; LAS unsigned char* Vs = C.Vs; const int qi = C.qi, g4 = C.g4;
    const AtUnit au = at_decode(u); const int g = au.g, b = au.b, h = au.h, r = au.r, n = au.n, d = au.d;
#pragma unroll
    for (int ps = 0; ps < 6; ++ps) { const int j = ps * 64 + C.jr; *(LAS v4u*)(Ks + j * AT_RS + C.piece * 16) = sl.k[ps]; *(LAS v4u*)(Vs + j * AT_RS + C.piece * 16) = sl.v[ps]; }
    const bf16x8 sl_q0 = sl.q0, sl_q1 = sl.q1, sl_q2 = sl.q2, sl_q3 = sl.q3;
    LDS_BARRIER();
    if (unext < AT_NU) at_load(sl, unext, C, F);
#pragma unroll
    for (int tq = 0; tq < 2; ++tq)
        {
            const int iq = 128 * tq + 16 * F.wave + qi; const int rb = 128 * tq + 16 * F.wave; const bf16x8 qf0 = tq ? sl_q2 : sl_q0, qf1 = tq ? sl_q3 : sl_q1; const size_t qrow = (size_t)b * SEQ + (size_t)(128 * n + iq) * d + r;
            f32x4 s[10]; float mx = -1e30f; const int dq = qi - 4 * g4; const bool first = (n == 0) && (tq == 0);
#pragma unroll
            for (int st = 0; st < 9; ++st) {
                const LAS unsigned char* kp = Ks + (rb + 16 * st + qi) * AT_RS + g4 * 16;
                const bf16x8 k0 = *(const LAS bf16x8*)kp, k1 = *(const LAS bf16x8*)(kp + 64);
                f32x4 a = (f32x4){0.f, 0.f, 0.f, 0.f};
                a = mfma16(k0, qf0, a); a = mfma16(k1, qf1, a);
                if (st == 0) {
#pragma unroll
                    for (int i = 0; i < 4; ++i) a[i] = (i >= dq) ? a[i] : -1e30f; }
                if (st == 8) {
#pragma unroll
                    for (int i = 0; i < 4; ++i) a[i] = (i <= dq) ? a[i] : -1e30f; }
                if (first) {
#pragma unroll
                    for (int i = 0; i < 4; ++i) a[i] = (rb + 16 * st + 4 * g4 + i >= 128) ? a[i] : -1e30f; }
#pragma unroll
                for (int i = 0; i < 4; ++i) mx = fmaxf(mx, a[i]);
                s[st] = a;
            }
            mx = fmaxf(mx, __shfl_xor(mx, 16)); mx = fmaxf(mx, __shfl_xor(mx, 32));
            float sum = 0.f;
#pragma unroll
            for (int st = 0; st < 9; ++st)
#pragma unroll
                for (int i = 0; i < 4; ++i) { const float p = fexp2(s[st][i] - mx); s[st][i] = p; sum += p; }
            s[9] = (f32x4){0.f, 0.f, 0.f, 0.f};
            sum += __shfl_xor(sum, 16); sum += __shfl_xor(sum, 32);
            f32x4 o[4];
#pragma unroll
            for (int dt = 0; dt < 4; ++dt) o[dt] = (f32x4){0.f, 0.f, 0.f, 0.f};
#pragma unroll
            for (int c = 0; c < 5; ++c) {
                v4u pw; pw.x = pk2(s[2 * c][0], s[2 * c][1]); pw.y = pk2(s[2 * c][2], s[2 * c][3]); pw.z = pk2(s[2 * c + 1][0], s[2 * c + 1][1]); pw.w = pk2(s[2 * c + 1][2], s[2 * c + 1][3]);
                const bf16x8 pf = __builtin_bit_cast(bf16x8, pw);
                const LAS unsigned char* vp = Vs + (rb + 32 * c + 4 * g4 + (qi >> 2)) * AT_RS + 8 * (qi & 3);
#pragma unroll
                for (int dt = 0; dt < 4; ++dt) { const s16x4 lo = tr16(vp + 32 * dt), hi = tr16(vp + 32 * dt + 16 * AT_RS);
                    o[dt] = mfma16(cat8(lo, hi), pf, o[dt]); }
            }
            const float inv = 1.0f / sum;
            bf16* op = OG + ((size_t)g * T + qrow) * 512 + h * 64 + 4 * g4;
#pragma unroll
            for (int dt = 0; dt < 4; ++dt) { v2u w; w.x = pk2(o[dt][0] * inv, o[dt][1] * inv); w.y = pk2(o[dt][2] * inv, o[dt][3] * inv); *(v2u*)(op + 16 * dt) = w; }
            if (g4 == 0) LSE[((size_t)g * T + qrow) * 8 + h] = mx + __log2f(sum);
        }
    LDS_BARRIER();
}
__device__ __forceinline__ void phase_attn(Frame& F) {
    AtCtx C; C.Qb = wsp<bf16>(F, WS_Q); C.Kb = wsp<bf16>(F, WS_K); C.Vb = wsp<bf16>(F, WS_VV); C.OG = wsp<bf16>(F, WS_OG); C.LSE = wsp<float>(F, WS_LSE);
    C.Ks = F.lds; C.Vs = F.lds + AT_VOFF; C.qi = F.lane & 15; C.g4 = F.lane >> 4; C.piece = F.tid & 7; C.jr = F.tid >> 3;
    if (F.tid < 144) { *(LAS v4u*)(C.Ks + 384 * AT_RS + F.tid * 16) = (v4u){0u, 0u, 0u, 0u}; *(LAS v4u*)(C.Vs + 384 * AT_RS + F.tid * 16) = (v4u){0u, 0u, 0u, 0u}; }
    AtSlot sa; const int u0 = F.vcu, G = F.G;
    if (u0 < AT_NU) at_load(sa, u0, C, F);
#pragma unroll 1
    for (int u = u0; u < AT_NU; u += G) at_unit(sa, u, u + G, C, F);
}

constexpr int SG_WOFF = 69632, SG_WRS = 264;
constexpr int SG_RS = 528;
__device__ __forceinline__ void phase_sg(Frame& F, int l) {
    const bf16* Ub = wsp<bf16>(F, WS_U); const bf16* Vb = wsp<bf16>(F, WS_V); bf16* TT = wsp<bf16>(F, WS_TT);
    const bf16* OG = wsp<bf16>(F, WS_OG); const float* LSE = wsp<float>(F, WS_LSE); bf16* OB = wsp<bf16>(F, WS_OB);
    const bf16* Wsp = wsp<bf16>(F, WS_WSP); const float* spb = F.in[I_SPB];
    LAS unsigned char* Vn = F.lds;
    const int qi = F.lane & 15, g4 = F.lane >> 4;
    const int l32 = F.lane & 31;
    v4u vraw[8];
#define SG_LOAD(uu) do { const int gi_ = (uu) & 3, m0_ = ((uu) >> 2) * 128; \
        _Pragma("unroll") for (int ps = 0; ps < 8; ++ps) vraw[ps] = *(const v4u*)(Vb + (size_t)(m0_ + 16 * ps + 2 * F.wave + (F.lane >> 5)) * 1024 + gi_ * 256 + 8 * l32); } while (0)
    if (F.vcu < 1024) SG_LOAD(F.vcu);
    const bool wlds = (F.G & 3) == 0; LAS unsigned char* Wl = F.lds + SG_WOFF;
    if (wlds) { const bf16* wsrc = Wsp + (size_t)(l * 4 + (F.vcu & 3)) * 128 * 128;
        for (int i = F.tid; i < 128 * 16; i += 512) { const int row = i >> 4, ch = i & 15; const v4u wv = *(const v4u*)(wsrc + row * 128 + ch * 8);
            *(LAS v2u*)(Wl + row * SG_WRS + ch * 16) = (v2u){wv.x, wv.y}; *(LAS v2u*)(Wl + row * SG_WRS + ch * 16 + 8) = (v2u){wv.z, wv.w}; } }
    for (int u = F.vcu; u < 1024; u += F.G) {
        const int gi = u & 3, m0 = (u >> 2) * 128;
        float ml[4][3]; v4u mo[4][3]; const int sub = F.tid & 7;
#pragma unroll
        for (int ps = 0; ps < 4; ++ps) { const int p = (F.tid >> 3) + 64 * ps; const size_t tok = (size_t)m0 + (p >> 1); const int hd = 2 * gi + (p & 1); const size_t off = tok * 512 + hd * 64 + 8 * sub;
#pragma unroll
            for (int gq = 0; gq < 3; ++gq) { ml[ps][gq] = LSE[((size_t)gq * T + tok) * 8 + hd]; mo[ps][gq] = *(const v4u*)(OG + (size_t)gq * T * 512 + off); } }
        {
            float sm[8], mean[8], rs[8];
#pragma unroll
            for (int ps = 0; ps < 8; ++ps) { const v4u raw = vraw[ps]; sm[ps] = ((bflo(raw.x) + bfhi(raw.x)) + (bflo(raw.y) + bfhi(raw.y))) + ((bflo(raw.z) + bfhi(raw.z)) + (bflo(raw.w) + bfhi(raw.w))); }
#pragma unroll
            for (int o = 1; o < 32; o <<= 1) {
#pragma unroll
                for (int ps = 0; ps < 8; ++ps) sm[ps] += __shfl_xor(sm[ps], o); }
#pragma unroll
            for (int ps = 0; ps < 8; ++ps) { const v4u raw = vraw[ps]; mean[ps] = sm[ps] * (1.0f / 256.0f); float q = 0.f;
                const float x[8] = {bflo(raw.x), bfhi(raw.x), bflo(raw.y), bfhi(raw.y), bflo(raw.z), bfhi(raw.z), bflo(raw.w), bfhi(raw.w)};
#pragma unroll
                for (int e = 0; e < 8; ++e) { const float dx = x[e] - mean[ps]; q += dx * dx; }
                sm[ps] = q; }
#pragma unroll
            for (int o = 1; o < 32; o <<= 1) {
#pragma unroll
                for (int ps = 0; ps < 8; ++ps) sm[ps] += __shfl_xor(sm[ps], o); }
#pragma unroll
            for (int ps = 0; ps < 8; ++ps) { rs[ps] = 1.0f / sqrtf(sm[ps] * (1.0f / 256.0f) + LN_EPS); const v4u raw = vraw[ps]; const int j = 16 * ps + 2 * F.wave + (F.lane >> 5);
                const float x[8] = {bflo(raw.x), bfhi(raw.x), bflo(raw.y), bfhi(raw.y), bflo(raw.z), bfhi(raw.z), bflo(raw.w), bfhi(raw.w)};
                v4u w; w.x = pk2((x[0] - mean[ps]) * rs[ps], (x[1] - mean[ps]) * rs[ps]); w.y = pk2((x[2] - mean[ps]) * rs[ps], (x[3] - mean[ps]) * rs[ps]);
                w.z = pk2((x[4] - mean[ps]) * rs[ps], (x[5] - mean[ps]) * rs[ps]); w.w = pk2((x[6] - mean[ps]) * rs[ps], (x[7] - mean[ps]) * rs[ps]);
                *(LAS v4u*)(Vn + j * SG_RS + l32 * 16) = w; }
        }
        LDS_BARRIER();
        if (u + F.G < 1024) SG_LOAD(u + F.G);
        {
#pragma unroll
          for (int ps = 0; ps < 4; ++ps) { const int p = (F.tid >> 3) + 64 * ps; const size_t tok = (size_t)m0 + (p >> 1); const int hd = 2 * gi + (p & 1);
              const float l0 = ml[ps][0], l1 = ml[ps][1], l2 = ml[ps][2];
              const float mxx = fmaxf(l0, fmaxf(l1, l2)); float w0 = fexp2(l0 - mxx), w1 = fexp2(l1 - mxx), w2 = fexp2(l2 - mxx); const float inv = 1.0f / (w0 + w1 + w2); w0 *= inv; w1 *= inv; w2 *= inv;
              const size_t off = tok * 512 + hd * 64 + 8 * sub;
              const v4u a = mo[ps][0], bq = mo[ps][1], cq = mo[ps][2]; v4u w;
              w.x = pk2(w0 * bflo(a.x) + w1 * bflo(bq.x) + w2 * bflo(cq.x), w0 * bfhi(a.x) + w1 * bfhi(bq.x) + w2 * bfhi(cq.x));
              w.y = pk2(w0 * bflo(a.y) + w1 * bflo(bq.y) + w2 * bflo(cq.y), w0 * bfhi(a.y) + w1 * bfhi(bq.y) + w2 * bfhi(cq.y));
              w.z = pk2(w0 * bflo(a.z) + w1 * bflo(bq.z) + w2 * bflo(cq.z), w0 * bfhi(a.z) + w1 * bfhi(bq.z) + w2 * bfhi(cq.z));
              w.w = pk2(w0 * bflo(a.w) + w1 * bflo(bq.w) + w2 * bflo(cq.w), w0 * bfhi(a.w) + w1 * bfhi(bq.w) + w2 * bfhi(cq.w));
              *(v4u*)(TT + tok * 1536 + 1024 + hd * 64 + 8 * sub) = w; } }
        v2u uq[8][2]; float ubias[8];
#pragma unroll
        for (int it = 0; it < 8; ++it) { const int i = 16 * it + qi; ubias[it] = spb[(l * 4 + gi) * 128 + i]; const size_t rowo = (size_t)(m0 + i) * 1024 + gi * 256 + 32 * F.wave + 4 * g4;
            uq[it][0] = *(const v2u*)(Ub + rowo); uq[it][1] = *(const v2u*)(Ub + rowo + 16); }
        {
            f32x4 acc[2][8];
#pragma unroll
            for (int ct = 0; ct < 2; ++ct)
#pragma unroll
                for (int it = 0; it < 8; ++it) acc[ct][it] = (f32x4){0.f, 0.f, 0.f, 0.f};
            const bf16* wbase = Wsp + (size_t)(l * 4 + gi) * 128 * 128 + (size_t)qi * 128 + 4 * g4;
#pragma unroll
            for (int kc = 0; kc < 4; ++kc) {
                bf16x8 af[2];
#pragma unroll
                for (int ct = 0; ct < 2; ++ct) { const LAS unsigned char* p = Vn + (32 * kc + 4 * g4 + (qi >> 2)) * SG_RS + (32 * F.wave + 16 * ct + 4 * (qi & 3)) * 2;
                    af[ct] = cat8(tr16(p), tr16(p + 16 * SG_RS)); }
#pragma unroll
                for (int it = 0; it < 8; ++it) if (it >= 2 * kc) {
                    const bf16* wp = wbase + (size_t)(16 * it) * 128 + 32 * kc; const LAS unsigned char* wq = Wl + (16 * it + qi) * SG_WRS + (32 * kc + 4 * g4) * 2;
                    const v2u b0 = wlds ? *(const LAS v2u*)wq : *(const v2u*)wp, b1 = wlds ? *(const LAS v2u*)(wq + 32) : *(const v2u*)(wp + 16);
                    const bf16x8 bfr = __builtin_bit_cast(bf16x8, (v4u){b0.x, b0.y, b1.x, b1.y});
                    acc[0][it] = mfma16(af[0], bfr, acc[0][it]); acc[1][it] = mfma16(af[1], bfr, acc[1][it]); }
            }
#pragma unroll
            for (int it = 0; it < 8; ++it) { const int i = 16 * it + qi; const float bias = ubias[it]; const size_t rowo = (size_t)(m0 + i) * 1536 + gi * 256 + 32 * F.wave + 4 * g4;
#pragma unroll
                for (int ct = 0; ct < 2; ++ct) { const v2u uu = uq[it][ct]; const f32x4 a = acc[ct][it]; v2u w;
                    w.x = pk2(bflo(uu.x) * (a[0] + bias), bfhi(uu.x) * (a[1] + bias)); w.y = pk2(bflo(uu.y) * (a[2] + bias), bfhi(uu.y) * (a[3] + bias));
                    *(v2u*)(TT + rowo + 16 * ct) = w; } }
        }
        LDS_BARRIER();
    }
#undef SG_LOAD
}

__device__ __forceinline__ void phase_ln1(Frame& F, int l, bool commit) {
    const bf16* YPRE = wsp<bf16>(F, WS_YPRE); bf16* H = wsp<bf16>(F, WS_H);
    const float* modl = wsp<float>(F, WS_MOD) + (size_t)l * 8 * 6144;
    const float* lg = F.in[I_LN1G] + l * D; const float* lb = F.in[I_LN1B] + l * D; const float* br = F.in[I_BR] + l * NE;
    const bf16* WH = wsp<bf16>(F, WS_WRT) + (size_t)l * NE * D; const bf16* WL = WH + (size_t)NL * NE * D;
    int* TOKINFO = wsp<int>(F, WS_TOKINFO); float* TOKW = wsp<float>(F, WS_TOKW);
    unsigned* cntg = wsp<unsigned>(F, WS_CTL) + CW_CNT + (size_t)l * NE * 64;
    LAS int* sel_e = (LAS int*)(F.lds + X_SELE);
    const int lane = F.lane, qi = lane & 15, g4 = lane >> 4;
    { const v4u* srcw = (const v4u*)WH;
#pragma unroll 4
      for (int i = F.tid; i < 2 * NE * 128; i += 512) { const int hl = i >> 12, e = (i >> 7) & 31, c = i & 127;
          *(LAS v4u*)(F.lds + hl * 65536 + e * 2048 + ((c ^ (e & 15)) << 4)) = srcw[(size_t)hl * (NL * NE * 128) + e * 128 + c]; } }
    __syncthreads();
    for (int tb = F.vcu; tb < T / 128; tb += F.G) {
        const int m0 = tb * 128; const int b = m0 >> 12; const float* mb = modl + (size_t)b * 6144; const int mw = m0 + 16 * F.wave;
        v2u pre[4][4];
#pragma unroll
        for (int r = 0; r < 4; ++r)
#pragma unroll
            for (int j = 0; j < 4; ++j) pre[r][j] = *((const v2u*)(YPRE + (size_t)(mw + r) * D) + lane + 64 * j);
#pragma unroll 1
        for (int rp = 0; rp < 4; ++rp) {
            f32x4 hh[4][4]; float mean[4], rstd[4];
            const int mrow = mw + 4 * rp;
#pragma unroll
            for (int r = 0; r < 4; ++r)
#pragma unroll
                for (int j = 0; j < 4; ++j) hh[r][j] = (f32x4){bflo(pre[r][j].x), bfhi(pre[r][j].x), bflo(pre[r][j].y), bfhi(pre[r][j].y)};
            if (rp < 3) {
#pragma unroll
                for (int r = 0; r < 4; ++r)
#pragma unroll
                    for (int j = 0; j < 4; ++j) pre[r][j] = *((const v2u*)(YPRE + (size_t)(mrow + 4 + r) * D) + lane + 64 * j); }
            { float sm[4], sq[4];
#pragma unroll
              for (int r = 0; r < 4; ++r) { sm[r] = 0.f; sq[r] = 0.f;
#pragma unroll
                  for (int j = 0; j < 4; ++j) { sm[r] += (hh[r][j][0] + hh[r][j][1]) + (hh[r][j][2] + hh[r][j][3]);
                      sq[r] += (hh[r][j][0] * hh[r][j][0] + hh[r][j][1] * hh[r][j][1]) + (hh[r][j][2] * hh[r][j][2] + hh[r][j][3] * hh[r][j][3]); } }
#pragma unroll
              for (int o = 1; o < 64; o <<= 1) {
#pragma unroll
                  for (int r = 0; r < 4; ++r) { sm[r] += __shfl_xor(sm[r], o); sq[r] += __shfl_xor(sq[r], o); } }
#pragma unroll
              for (int r = 0; r < 4; ++r) { mean[r] = sm[r] * (1.0f / D); rstd[r] = 1.0f / sqrtf(fmaxf(sq[r] * (1.0f / D) - mean[r] * mean[r], 0.f) + LN_EPS); } }
            if (lane < 4) { const float mq = (lane == 0) ? mean[0] : (lane == 1) ? mean[1] : (lane == 2) ? mean[2] : mean[3], rq = (lane == 0) ? rstd[0] : (lane == 1) ? rstd[1] : (lane == 2) ? rstd[2] : rstd[3];
                float* st = wsp<float>(F, WS_STAT) + (size_t)(mrow + lane) * 2; st[0] = mq; st[1] = rq; }
#pragma unroll
            for (int j = 0; j < 4; ++j) { const f32x4 gq = *((const f32x4*)lg + lane + 64 * j), bq = *((const f32x4*)lb + lane + 64 * j);
                const f32x4 shq = *((const f32x4*)(mb + 3072) + lane + 64 * j), scq = *((const f32x4*)(mb + 4096) + lane + 64 * j) + 1.0f;
#pragma unroll
                for (int r = 0; r < 4; ++r) { const f32x4 x1 = (hh[r][j] - mean[r]) * rstd[r] * gq + bq;
                    const f32x4 h2 = x1 * scq + shq; v2u o; o.x = pk2(h2[0], h2[1]); o.y = pk2(h2[2], h2[3]); *((v2u*)(H + (size_t)(mrow + r) * D) + lane + 64 * j) = o;
 } }
        }
        VM_WAIT(); asm volatile("" ::: "memory");
        f32x4 c0 = (f32x4){0.f, 0.f, 0.f, 0.f}, c1 = c0;
        { const bf16* hp = H + (size_t)(mw + qi) * D + 8 * g4;
          const LAS unsigned char* w0 = F.lds + qi * 2048; const LAS unsigned char* w1 = F.lds + (16 + qi) * 2048;
#pragma unroll 8
          for (int ks = 0; ks < 32; ++ks) {
              const bf16x8 hhi = *(const bf16x8*)(hp + 32 * ks);
              const int co = ((4 * ks + g4) ^ qi) << 4;
              const bf16x8 a0h = *(const LAS bf16x8*)(w0 + co), a0l = *(const LAS bf16x8*)(w0 + 65536 + co);
              const bf16x8 a1h = *(const LAS bf16x8*)(w1 + co), a1l = *(const LAS bf16x8*)(w1 + 65536 + co);
              c0 = mfma16(a0h, hhi, c0); c0 = mfma16(a0l, hhi, c0);
              c1 = mfma16(a1h, hhi, c1); c1 = mfma16(a1l, hhi, c1); } }
        {
            float v[8]; int id[8];
#pragma unroll
            for (int i = 0; i < 4; ++i) { id[i] = 4 * g4 + i; id[4 + i] = 16 + 4 * g4 + i; v[i] = c0[i] + br[4 * g4 + i]; v[4 + i] = c1[i] + br[16 + 4 * g4 + i]; }
            int ek[4]; float vk[4];
#pragma unroll
            for (int k = 0; k < 4; ++k) { float lm = v[0]; int li = id[0];
#pragma unroll
                for (int j = 1; j < 8; ++j) if (v[j] > lm) { lm = v[j]; li = id[j]; }
#pragma unroll
                for (int o = 16; o <= 32; o <<= 1) { const float om = __shfl_xor(lm, o); const int oi = __shfl_xor(li, o); if (om > lm || (om == lm && oi < li)) { lm = om; li = oi; } }
                ek[k] = li; vk[k] = lm;
#pragma unroll
                for (int j = 0; j < 8; ++j) if (id[j] == li) v[j] = -INFINITY; }
            const float e1 = __expf(vk[1] - vk[0]), e2 = __expf(vk[2] - vk[0]), e3 = __expf(vk[3] - vk[0]); const float inv = 1.0f / (1.0f + e1 + e2 + e3);
            if (g4 == 0) { const int tl = 16 * F.wave + qi;
                sel_e[tl * 4 + 0] = ek[0]; sel_e[tl * 4 + 1] = ek[1]; sel_e[tl * 4 + 2] = ek[2]; sel_e[tl * 4 + 3] = ek[3];
                *(f32x4*)(TOKW + (size_t)(m0 + tl) * 4) = (f32x4){inv, e1 * inv, e2 * inv, e3 * inv}; }
        }
        __syncthreads();
        { const int myE = sel_e[F.tid]; LAS unsigned long long* bm = (LAS unsigned long long*)(F.lds + X_SELR); unsigned long long mine = 0ull;
#pragma unroll
          for (int e = 0; e < 32; ++e) { const unsigned long long m = __ballot(myE == e); if (lane == e) mine = m; }
          if (lane < 32) bm[F.wave * 32 + lane] = mine;
          __syncthreads();
          int rk = __popcll(bm[F.wave * 32 + myE] & ((1ull << lane) - 1ull));
#pragma unroll
          for (int w = 0; w < 8; ++w) if (w < F.wave) rk += __popcll(bm[w * 32 + myE]);
          TOKINFO[(size_t)m0 * 4 + F.tid] = myE | (rk << 8);
          if (F.tid < 32) { int tot = 0;
#pragma unroll
              for (int w = 0; w < 8; ++w) tot += __popcll(bm[w * 32 + F.tid]);
              wsp<int>(F, WS_WGCNT)[((size_t)l * 256 + tb) * 32 + F.tid] = tot; if (tot && commit) (void)__hip_atomic_fetch_add(cntg + F.tid * 64, (unsigned)tot, RLX_AGENT); } }
        __syncthreads();
    }
}

__device__ __forceinline__ int moe_tables(Frame& F, int l) {
    const unsigned* cntg = wsp<unsigned>(F, WS_CTL) + CW_CNT + (size_t)l * NE * 64;
    LAS int* cnt_s = (LAS int*)(F.lds + X_CNTS); LAS int* off_s = (LAS int*)(F.lds + X_OFFS); LAS unsigned char* tile_e = (LAS unsigned char*)(F.lds + X_TILEE);
    if (F.tid < 32) cnt_s[F.tid] = (int)__hip_atomic_load(cntg + F.tid * 64, RLX_AGENT);
    __syncthreads();
    if (F.tid < 64) {
        const int e = F.tid & 31; const int c = (F.tid < 32) ? cnt_s[e] : 0; const int nt = (c + 255) >> 8; int incl = nt;
#pragma unroll
        for (int o = 1; o < 32; o <<= 1) { const int v = __shfl_up(incl, o); if ((F.tid & 63) >= o) incl += v; }
        if (F.tid < 32) { const int excl = incl - nt; off_s[e] = excl * 256; for (int t = 0; t < nt; ++t) tile_e[excl + t] = (unsigned char)e; if (e == 31) off_s[32] = incl * 256; }
    }
    __syncthreads();
    return off_s[32] >> 8;
}
__device__ __forceinline__ void phase_scat(Frame& F, int l) {
    (void)moe_tables(F, l);
    const LAS int* off_s = (const LAS int*)(F.lds + X_OFFS); const LAS int* cnt_s = (const LAS int*)(F.lds + X_CNTS); LAS int* base_s = (LAS int*)(F.lds + X_BASE);
    const int* TOKINFO = wsp<int>(F, WS_TOKINFO); const float* TOKW = wsp<float>(F, WS_TOKW);
    int* ROWTOK = wsp<int>(F, WS_ROWTOK); float* ROWW = wsp<float>(F, WS_ROWW); const int* WGC = wsp<int>(F, WS_WGCNT) + (size_t)l * 256 * 32; int* TOKINFO2 = wsp<int>(F, WS_TOKROW);
    for (int tb = F.vcu; tb < T / 128; tb += F.G) {
        if (F.tid < 32) base_s[F.tid] = 0;
        __syncthreads();
        { const int e = F.tid & 31, part = F.tid >> 5; int sacc = 0;
          for (int t2 = part * 16; t2 < part * 16 + 16; ++t2) if (t2 < tb) sacc += WGC[t2 * 32 + e];
          if (sacc) atomicAdd((int*)&base_s[e], sacc); }
        __syncthreads();
        { const size_t ent = (size_t)tb * 512 + F.tid; const int info = TOKINFO[ent]; const int e = info & 255, row = off_s[e] + base_s[e] + (info >> 8);
          ROWTOK[row] = (int)ent; ROWW[row] = TOKW[ent]; TOKINFO2[ent] = row; }
        __syncthreads();
    }
    if (F.vcu == 0) for (int e = 0; e < NE; ++e) for (int r = off_s[e] + cnt_s[e] + F.tid; r < off_s[e + 1]; r += 512) { ROWTOK[r] = 0; ROWW[r] = 0.f; }
}
__device__ __forceinline__ void phase_ln2(Frame& F, int l) {
    const bf16* X1 = wsp<bf16>(F, WS_YPRE); const bf16* YK = wsp<bf16>(F, WS_XG); bf16* H = wsp<bf16>(F, WS_H); const int* TOKROW = wsp<int>(F, WS_TOKROW); const float* TOKW = wsp<float>(F, WS_TOKW);
    const float* STAT = wsp<float>(F, WS_STAT); const float* l1g = F.in[I_LN1G] + l * D; const float* l1b = F.in[I_LN1B] + l * D;
    float* XO = F.out; bf16* XB = wsp<bf16>(F, WS_X2);
    const float* modl = wsp<float>(F, WS_MOD) + (size_t)l * 8 * 6144; const float* modn = wsp<float>(F, WS_MOD) + (size_t)((l + 1) & 3) * 8 * 6144;
    const float* lg = F.in[I_LN2G] + l * D; const float* lb = F.in[I_LN2B] + l * D;
    const int lane = F.lane; const int gw = F.vcu * 8 + F.wave, NGW = F.G * 8;
    v2u px[4]; v2u py[4][4]; float pst[2], nst[2]; f32x4 pw4, nw4;
#define LN2_LOAD(mm) do { nst[0] = STAT[(size_t)(mm) * 2]; nst[1] = STAT[(size_t)(mm) * 2 + 1]; nw4 = *(const f32x4*)(TOKW + (size_t)(mm) * 4); \
        int rw_[4]; _Pragma("unroll") for (int k = 0; k < 4; ++k) rw_[k] = TOKROW[(size_t)(mm) * 4 + k]; \
        _Pragma("unroll") for (int j = 0; j < 4; ++j) { px[j] = __builtin_nontemporal_load((const v2u*)(X1 + (size_t)(mm) * D) + lane + 64 * j); \
        _Pragma("unroll") for (int k = 0; k < 4; ++k) py[j][k] = __builtin_nontemporal_load((const v2u*)(YK + (size_t)rw_[k] * D) + lane + 64 * j); } } while (0)
    if (gw < T) LN2_LOAD(gw);
#pragma unroll 1
    for (int m = gw; m < T; m += NGW) { const int b = m >> 12; const float* mb = modl + (size_t)b * 6144; const float* mn = modn + (size_t)b * 6144;
        f32x4 v[4]; float s = 0.f; pst[0] = nst[0]; pst[1] = nst[1]; pw4 = nw4;
#pragma unroll
        for (int j = 0; j < 4; ++j) { f32x4 y = (f32x4){0.f, 0.f, 0.f, 0.f};
#pragma unroll
            for (int k = 0; k < 4; ++k) { const v2u w = py[j][k]; const float cw = pw4[k]; y[0] += cw * bflo(w.x); y[1] += cw * bfhi(w.x); y[2] += cw * bflo(w.y); y[3] += cw * bfhi(w.y); }
            const f32x4 g2 = *((const f32x4*)(mb + 5120) + lane + 64 * j) + 1.0f;
            const f32x4 pxf = (f32x4){bflo(px[j].x), bfhi(px[j].x), bflo(px[j].y), bfhi(px[j].y)};
            const f32x4 x1 = (pxf - pst[0]) * pst[1] * *((const f32x4*)l1g + lane + 64 * j) + *((const f32x4*)l1b + lane + 64 * j);
            v[j] = x1 * DN_ALPHA + g2 * y; s += (v[j][0] + v[j][1]) + (v[j][2] + v[j][3]); }
        if (m + NGW < T) LN2_LOAD(m + NGW);
        float s2 = 0.f;
#pragma unroll
        for (int j = 0; j < 4; ++j) s2 += (v[j][0] * v[j][0] + v[j][1] * v[j][1]) + (v[j][2] * v[j][2] + v[j][3] * v[j][3]);
#pragma unroll
        for (int o = 1; o < 64; o <<= 1) { s += __shfl_xor(s, o); s2 += __shfl_xor(s2, o); }
        const float mean = s * (1.0f / D); const float rstd = 1.0f / sqrtf(fmaxf(s2 * (1.0f / D) - mean * mean, 0.f) + LN_EPS);
#pragma unroll
        for (int j = 0; j < 4; ++j) v[j] = v[j] - mean;
        f32x4* xo = (f32x4*)(XO + (size_t)m * D) + lane; v2u* xb = (v2u*)(XB + (size_t)m * D) + lane; v2u* ho = (v2u*)(H + (size_t)m * D) + lane;
#pragma unroll
        for (int j = 0; j < 4; ++j) { const f32x4 gvj = *((const f32x4*)lg + lane + 64 * j), bvj = *((const f32x4*)lb + lane + 64 * j); const f32x4 x2 = v[j] * rstd * gvj + bvj;
            if (l == NL - 1) __builtin_nontemporal_store(x2, xo + 64 * j); else { v2u xq; xq.x = pk2(x2[0], x2[1]); xq.y = pk2(x2[2], x2[3]); __builtin_nontemporal_store(xq, xb + 64 * j); }
            if (l < NL - 1) { const f32x4 sh = *((const f32x4*)mn + lane + 64 * j), sc = *((const f32x4*)(mn + 1024) + lane + 64 * j) + 1.0f; const f32x4 h = x2 * sc + sh;
                v2u o; o.x = pk2(h[0], h[1]); o.y = pk2(h[2], h[3]); ho[64 * j] = o; } } }
#undef LN2_LOAD
}

#ifndef PH_MASK
#define PH_MASK 0xFFFF
#endif
#define PHM(b) ((PH_MASK >> (b)) & 1)
#ifndef DUP_MASK
#define DUP_MASK 0
#endif
#define REPS(b) (((DUP_MASK >> (b)) & 1) ? 2 : 1)
constexpr int NPH_L = 10, NPHASE = 2 + NL * NPH_L;
struct Args { const float* in[20]; float* out; unsigned char* ws; int ph_lo, ph_hi; };
__global__ void __launch_bounds__(512, 2) fwd(Args args) {
    extern __shared__ __attribute__((aligned(16))) unsigned char lds[];
    Frame F;
    F.lds = (LAS unsigned char*)lds;
#define FRESH() do { int zv_ = 0; asm volatile("" : "+v"(zv_)); const int z_ = __builtin_amdgcn_readfirstlane(zv_); \
        F.tid = (int)threadIdx.x + zv_; F.lane = F.tid & 63; F.wave = __builtin_amdgcn_readfirstlane(F.tid >> 6); \
        F.G = (int)gridDim.x + z_; F.bx = (int)blockIdx.x + z_; F.vcu = (F.G % 8 == 0) ? (F.bx % 8) * (F.G / 8) + F.bx / 8 : F.bx; \
        F.ws = args.ws + z_; F.in = args.in + z_; F.out = args.out + z_; F.lds = (LAS unsigned char*)lds + z_; } while (0)
    FRESH();
    for (int u = F.tid; u < (LDS_BYTES - XOFF) / 4; u += 512) ((LAS unsigned*)(F.lds + XOFF))[u] = 0u;
    __syncthreads();
    unsigned* ctl = wsp<unsigned>(F, WS_CTL);
    XcdBarrier bar; bar.bar = ctl + CW_BAR; bar.x = 0; bar.st = nullptr;
    if (!MK_PER_PHASE) bar = xcd_barrier_post(ctl + CW_BAR, (volatile LAS unsigned*)(F.lds + X_MISC) + 8);
    const int lo = args.ph_lo, hi = args.ph_hi;
#define IN(k) (lo <= (k) && (k) < hi)
#ifndef BAR_REPS
#define BAR_REPS 1
#endif
#define SEAM(k) do { if (!MK_PER_PHASE && IN(k) && IN((k) + 1)) for (int br_ = 0; br_ < BAR_REPS; ++br_) xcd_barrier(bar); } while (0)

    if (PHM(0) && IN(0)) for (int rep = 0; rep < REPS(0); ++rep) { FRESH(); phase_pro_a(F); } SEAM(0);
    if (PHM(1) && IN(1)) for (int rep = 0; rep < REPS(1); ++rep) { FRESH(); phase_pro_b(F); } SEAM(1);
    for (int l = 0; l < NL; ++l) {
        const int pb = 2 + l * NPH_L;
        if (PHM(2) && IN(pb + 0)) for (int rep = 0; rep < REPS(2); ++rep) { FRESH();
            pg8::Gemm g{wsp<bf16>(F, WS_H), wsp<bf16>(F, WS_WIN) + (size_t)l * NIN * D, T, NIN, D}; pg8::StaticOrder S; S.init(T, NIN, F.G, F.bx);
            EpiIn E{wsp<bf16>(F, WS_U), wsp<bf16>(F, WS_V), wsp<bf16>(F, WS_Q), wsp<bf16>(F, WS_K), wsp<bf16>(F, WS_VV), wsp<bf16>(F, WS_G), wsp<float>(F, WS_ROPE)};
            stagger(F.bx >> 3, STAG_US);
            pg8::gemm_phase<EpiIn, pg8::StaticOrder, PG8_ALIGN, PG8_SP2>(F.lds, g, S, E, F.tid);
#if defined(XPROBE)
            { FRESH(); pg8::Gemm g2{wsp<bf16>(F, WS_H), wsp<bf16>(F, WS_WIN) + (size_t)l * NIN * D, T, NIN, D}; pg8::StaticOrder S2; S2.init(T, NIN, F.G, F.bx);
              EpiProbe E2{wsp<bf16>(F, WS_XG), (XPROBE == 3) ? NIN : 1024, (XPROBE >= 2) ? (XPROBE == 3 ? 3 : 1) : (F.G == 0x7ffffff0 ? 1 : 0)};
              pg8::gemm_phase<EpiProbe, pg8::StaticOrder, PG8_ALIGN, PG8_SP2>(F.lds, g2, S2, E2, F.tid); }
#endif
        } SEAM(pb + 0);
        if (PHM(3) && IN(pb + 1)) for (int rep = 0; rep < REPS(3); ++rep) { FRESH(); phase_attn(F); } SEAM(pb + 1);
        if (PHM(4) && IN(pb + 2)) for (int rep = 0; rep < REPS(4); ++rep) { FRESH(); phase_sg(F, l); } SEAM(pb + 2);
        if (PHM(5) && IN(pb + 3)) for (int rep = 0; rep < REPS(5); ++rep) { FRESH();
            pg8::Gemm g{wsp<bf16>(F, WS_TT), wsp<bf16>(F, WS_WBA) + (size_t)l * D * 1536, T, D, 1536}; pg8::StaticOrder S; S.init(T, D, F.G, F.bx);
            EpiMg2 E{wsp<bf16>(F, WS_G), wsp<bf16>(F, WS_MG)}; pg8::gemm_phase<EpiMg2, pg8::StaticOrder, PG8_ALIGN, PG8_SP2>(F.lds, g, S, E, F.tid);
        } SEAM(pb + 3);
        if (PHM(6) && IN(pb + 4)) for (int rep = 0; rep < REPS(6); ++rep) { FRESH();
            pg8::Gemm g{wsp<bf16>(F, WS_MG), wsp<bf16>(F, WS_WOUT) + (size_t)l * D * D, T, D, D}; pg8::StaticOrder S; S.init(T, D, F.G, F.bx);
            if (l == 0) { EpiOut<true> E{(const void*)F.in[I_X], wsp<float>(F, WS_MOD) + (size_t)l * 8 * 6144, wsp<bf16>(F, WS_YPRE)}; pg8::gemm_phase<EpiOut<true>, pg8::StaticOrder, PG8_ALIGN, PG8_SP2>(F.lds, g, S, E, F.tid); }
            else { EpiOut<false> E{(const void*)wsp<bf16>(F, WS_X2), wsp<float>(F, WS_MOD) + (size_t)l * 8 * 6144, wsp<bf16>(F, WS_YPRE)}; pg8::gemm_phase<EpiOut<false>, pg8::StaticOrder, PG8_ALIGN, PG8_SP2>(F.lds, g, S, E, F.tid); }
        } SEAM(pb + 4);
        if (PHM(7) && IN(pb + 5)) for (int rep = 0; rep < REPS(7); ++rep) { FRESH(); phase_ln1(F, l, rep == 0); } SEAM(pb + 5);
        if (PHM(8) && IN(pb + 6)) for (int rep = 0; rep < REPS(8); ++rep) { FRESH(); phase_scat(F, l); } SEAM(pb + 6);
        if (PHM(9) && IN(pb + 7)) for (int rep = 0; rep < REPS(9); ++rep) { FRESH();
            const int RT = moe_tables(F, l);
            pg8::Gemm g{wsp<bf16>(F, WS_H), wsp<bf16>(F, WS_WUP) + (size_t)l * NE * 2048 * D, RT * 256, NE * 2048, D};
            MoeGatherOrder S; S.init(RT, 8, F.G, F.bx, (const LAS unsigned char*)(F.lds + X_TILEE)); S.tokl = (const LAS unsigned short*)(F.lds + X_TOKL);
            { const int* rowtok = wsp<int>(F, WS_ROWTOK); LAS unsigned short* tl = (LAS unsigned short*)(F.lds + X_TOKL); pg8::Unit uu;
              for (int i = 0; i < TOKL_UNITS && S.next(i, uu); ++i) if (F.tid < 256) tl[i * 256 + F.tid] = (unsigned short)(rowtok[uu.pm * 256 + F.tid] >> 2);
              __syncthreads(); }
            EpiUp E{F.in[I_BUP] + (size_t)l * NE * 2048, wsp<bf16>(F, WS_ACT)};
            stagger(F.bx >> 3, STAG_US);
            pg8::gemm_phase<EpiUp, MoeGatherOrder, PG8_ALIGN, true>(F.lds, g, S, E, F.tid);
        } SEAM(pb + 7);
        if (PHM(10) && IN(pb + 8)) for (int rep = 0; rep < REPS(10); ++rep) { FRESH();
            const int RT = moe_tables(F, l);
            pg8::Gemm g{wsp<bf16>(F, WS_ACT), wsp<bf16>(F, WS_WDN) + (size_t)l * NE * D * FF, RT * 256, NE * D, FF};
            MoeOrder S; S.init(RT, 4, F.G, F.bx, (const LAS unsigned char*)(F.lds + X_TILEE), 1);
            EpiDn E{F.in[I_BDN] + (size_t)l * NE * D, wsp<bf16>(F, WS_XG)};
            stagger(F.bx >> 3, STAG_US);
            pg8::gemm_phase<EpiDn, MoeOrder, PG8_ALIGN, PG8_SP2>(F.lds, g, S, E, F.tid);
        } SEAM(pb + 8);
        if (PHM(11) && IN(pb + 9)) for (int rep = 0; rep < REPS(11); ++rep) { FRESH(); phase_ln2(F, l); } SEAM(pb + 9);
    }
#undef IN
#undef SEAM
#undef FRESH
}

extern "C" void kernel_launch(void* const* d_in, const int* in_sizes, int n_in, void* d_out, int out_size, void* d_ws, size_t ws_size, hipStream_t stream) {
    static int grid = 0;
    if (grid == 0) {
        if (n_in != 20 || out_size != T * D || ws_size < WS_END) { fprintf(stderr, "kernel_launch: unexpected shapes (n_in %d, out %d, ws %zu < %zu)\n", n_in, out_size, ws_size, (size_t)WS_END); grid = -1; return; }
        int dev = 0, cus = 0;
        if (hipGetDevice(&dev) != hipSuccess || hipDeviceGetAttribute(&cus, hipDeviceAttributeMultiprocessorCount, dev) != hipSuccess) { grid = -1; return; }
        if (hipFuncSetAttribute((const void*)fwd, hipFuncAttributeMaxDynamicSharedMemorySize, LDS_BYTES) != hipSuccess) { fprintf(stderr, "kernel_launch: hipFuncSetAttribute failed\n"); grid = -1; return; }
        int per_cu = 0;
        if (hipOccupancyMaxActiveBlocksPerMultiprocessor(&per_cu, (const void*)fwd, 512, LDS_BYTES) != hipSuccess || per_cu < 1) fprintf(stderr, "kernel_launch: occupancy query says %d blocks per CU\n", per_cu);
        (void)hipGetLastError();
        grid = cus;
    }
    if (grid < 0) return;
    (void)in_sizes;
    if (hipMemsetAsync((char*)d_ws + WS_CTL, 0, CTL_ZERO_BYTES, stream) != hipSuccess) return;
    Args a{};
    for (int i = 0; i < 20; ++i) a.in[i] = (const float*)d_in[i];
    a.out = (float*)d_out; a.ws = (unsigned char*)d_ws;
#if MK_PER_PHASE
    for (int p = 0; p < NPHASE; ++p) { a.ph_lo = p; a.ph_hi = p + 1; hipLaunchKernelGGL(fwd, dim3(grid), dim3(512), LDS_BYTES, stream, a); }
#else
    a.ph_lo = 0; a.ph_hi = NPHASE;
    hipLaunchKernelGGL(fwd, dim3(grid), dim3(512), LDS_BYTES, stream, a);
#endif
    const hipError_t le = hipPeekAtLastError();
    if (le != hipSuccess) fprintf(stderr, "kernel_launch: launch failed: %s\n", hipGetErrorName(le));
}
```

```cpp
#include <hip/hip_runtime.h>
#include <cstdio>
#include <cstdint>
#ifndef MK_PER_PHASE
#define MK_PER_PHASE 0
#endif
namespace pg8 {
#define PG8_LAS __attribute__((address_space(3)))
typedef unsigned short bf16_t;
typedef short bf16x8 __attribute__((ext_vector_type(8)));
typedef float f32x4 __attribute__((ext_vector_type(4)));
typedef unsigned u32x4 __attribute__((ext_vector_type(4)));
constexpr int BM = 256, BK = 64, HALF = 128, HTB = HALF * BK * 2  , STAGE_BYTES = 8 * HTB, NXCD = 8;
#ifndef PG8_WGM
#define PG8_WGM 8
#endif
constexpr int WGM = PG8_WGM;

__host__ __device__ __forceinline__ int lds_byte(int r, int c) { const int st = (r >> 4) * 2 + (c >> 5), rr = r & 15, cc = c & 31, ob = rr * 64 + cc * 2; return st * 1024 + (ob ^ (((ob >> 9) & 1) << 5)); }
__host__ __device__ __forceinline__ void stage_rc(int b, int& R, int& C) { const int st = b / 1024, sb = b % 1024, swz = sb ^ (((sb >> 9) & 1) << 5); R = (st >> 1) * 16 + swz / 64; C = (st & 1) * 32 + (swz % 64) / 2; }
__host__ __device__ __forceinline__ int perm32(int rho) { const int n = rho >> 4, i = rho & 15; return 8 * (i >> 2) + 4 * n + (i & 3); }

struct Unit { int pm, pn; };
struct Gemm { const bf16_t* A; const bf16_t* Bt; int M, N, K; };

struct StaticOrder {
    static constexpr bool GATHER = false; __device__ __forceinline__ int arow(int, int r) const { return r; }
    int nM, nN, nwg, G, c;
    __host__ __device__ void init(int M, int N, int G_, int c_) { nM = M / BM; nN = N / BM; nwg = nM * nN; G = G_; c = c_; }
    __host__ __device__ bool next(int i, Unit& u) const {
        const long L = (long)i * G + c; if (L >= nwg) return false;
        int wgid = (int)L; { const int q = nwg / NXCD, r = nwg % NXCD, xcd = wgid % NXCD, off = wgid / NXCD; wgid = (xcd < r ? xcd * (q + 1) : r * (q + 1) + (xcd - r) * q) + off; }
        const int nig = WGM * nN, gid = wgid / nig, fm = gid * WGM, gsz = (nM - fm) < WGM ? (nM - fm) : WGM;
        u.pm = fm + ((wgid % nig) % gsz); u.pn = (wgid % nig) / gsz; return true;
    }
    __device__ __forceinline__ void a_ready(const Unit&) const {}
    __device__ __forceinline__ void done(const Unit&) const {}
};

__device__ __forceinline__ unsigned cvt_pk_bf16(float lo, float hi) { unsigned r; asm volatile("v_cvt_pk_bf16_f32 %0, %1, %2" : "=v"(r) : "v"(lo), "v"(hi)); return r; }
typedef float f32x2 __attribute__((ext_vector_type(2)));

template <class Epi, class Sched, bool ALIGN_EPI = false, bool SP2 = false>
__device__ __forceinline__ void gemm_phase(PG8_LAS unsigned char* lds, const Gemm g, const Sched& S, const Epi& E, const int tid_in) {
    const int tid = tid_in, wid = __builtin_amdgcn_readfirstlane(tid >> 6), lane = tid & 63, wr = wid >> 2, wc = wid & 3, fr = lane & 15, fq = lane >> 4;
    const int K = g.K, nt = K / BK;
    unsigned voffA[2], voffB[2];
#pragma unroll
    for (int i = 0; i < 2; ++i) { int R, C; stage_rc(tid * 16 + i * 8192, R, C); const int Rb = Epi::BADJ ? (64 * (R >> 5) + perm32(R & 31)) : Epi::PERM ? ((R & ~31) + perm32(R & 31)) : R;
        voffA[i] = (unsigned)(R * K + C) * 2u; voffB[i] = (unsigned)(Rb * K + C) * 2u; }
    const size_t kstep = (size_t)(BK * 2);
    const size_t hstep = (size_t)HALF * K * 2;
    const size_t tstep = 2 * hstep;
    const size_t bhstep = Epi::BADJ ? (size_t)32 * K * 2 : hstep;
    const unsigned ldsw = (unsigned)wid * 1024u;
    const int aoff = lds_byte(wr * 64 + fr, fq * 8), boff = lds_byte(wc * 32 + fr, fq * 8);
#define PG8_SA(b, h) (((b) * 2 + (h)) * HTB)
#define PG8_SB(b, h) ((4 + (b) * 2 + (h)) * HTB)
    unsigned gc[2][2], gn[2][2];
#define PG8_GOFF(dst, pmv, ordv) do { if constexpr (Sched::GATHER) { _Pragma("unroll") for (int _h = 0; _h < 2; ++_h) _Pragma("unroll") for (int _i = 0; _i < 2; ++_i) { int _R, _C; stage_rc(tid * 16 + _i * 8192, _R, _C); \
        dst[_h][_i] = (unsigned)S.arow((ordv), (pmv) * 256 + _h * 128 + _R) * (unsigned)(K * 2) + (unsigned)(_C * 2); } } } while (0)
#define PG8_STAGE_A(bufoff, origptr, nextf, hh, kbytes) do { if constexpr (Sched::GATHER) { _Pragma("unroll") for (int _i = 0; _i < 2; ++_i) { const unsigned _o = (nextf) ? gn[hh][_i] : gc[hh][_i]; \
        __builtin_amdgcn_global_load_lds((const unsigned*)((const char*)g.A + (kbytes) + _o), (PG8_LAS unsigned*)(lds + (bufoff) + ldsw + _i * 8192), 16, 0, 0); } } else { PG8_STAGE(bufoff, origptr, voffA); } } while (0)
#define PG8_STAGE(bufoff, gbase, voff) do { _Pragma("unroll") for (int _i = 0; _i < 2; ++_i) \
        __builtin_amdgcn_global_load_lds((const unsigned*)((const char*)(gbase) + (voff)[_i]), (PG8_LAS unsigned*)(lds + (bufoff) + ldsw + _i * 8192), 16, 0, 0); } while (0)
#define PG8_LDA(dst, b, h) do { _Pragma("unroll") for (int m = 0; m < 4; ++m) _Pragma("unroll") for (int k = 0; k < 2; ++k) dst[m][k] = *(const PG8_LAS bf16x8*)(lds + PG8_SA(b, h) + aoff + m * 2048 + k * 1024); } while (0)
#define PG8_LDB(dst, b, h) do { _Pragma("unroll") for (int n = 0; n < 2; ++n) _Pragma("unroll") for (int k = 0; k < 2; ++k) dst[n][k] = *(const PG8_LAS bf16x8*)(lds + PG8_SB(b, h) + boff + n * 2048 + k * 1024); } while (0)
#define PG8_MMA(ai, bj, At, Bt) do { __builtin_amdgcn_s_setprio(1); _Pragma("unroll") for (int m = 0; m < 4; ++m) _Pragma("unroll") for (int n = 0; n < 2; ++n) _Pragma("unroll") for (int k = 0; k < 2; ++k) \
        acc[ai][bj][m][n] = __builtin_amdgcn_mfma_f32_16x16x32_bf16(Bt[n][k], At[m][k], acc[ai][bj][m][n], 0, 0, 0); __builtin_amdgcn_s_setprio(0); } while (0)
#define PG8_WAIT_V(n) asm volatile("s_waitcnt vmcnt(" #n ")" ::: "memory")
#define PG8_WAIT_L(n) asm volatile("s_waitcnt lgkmcnt(" #n ")" ::: "memory")
#define PG8_BAR __builtin_amdgcn_s_barrier()
#define PG8_SCHED __builtin_amdgcn_sched_barrier(0)
    Unit cur, nxt; int ui = 0;
    if (!S.next(0, cur)) return;
    f32x4 acc[2][2][4][2];
#pragma unroll
    for (int a = 0; a < 2; ++a)
#pragma unroll
        for (int b = 0; b < 2; ++b)
#pragma unroll
            for (int m = 0; m < 4; ++m)
#pragma unroll
                for (int n = 0; n < 2; ++n) acc[a][b][m][n] = (f32x4){0.f, 0.f, 0.f, 0.f};
    bf16x8 At[4][2], B0[2][2], B1[2][2];
    const char* cA = (const char*)g.A + (size_t)cur.pm * tstep; const char* cB = (const char*)g.Bt + (size_t)cur.pn * tstep;
    S.a_ready(cur);
    PG8_GOFF(gc, cur.pm, 0);
    if constexpr (SP2) {
        PG8_STAGE(PG8_SB(0, 0), cB, voffB); PG8_STAGE(PG8_SB(0, 1), cB + bhstep, voffB); PG8_STAGE_A(PG8_SA(0, 0), cA, false, 0, 0); PG8_STAGE_A(PG8_SA(0, 1), cA + hstep, false, 1, 0);
        if (wr == 1) PG8_BAR;
        PG8_WAIT_V(2); PG8_BAR;
        PG8_STAGE(PG8_SB(1, 0), cB + kstep, voffB); PG8_STAGE_A(PG8_SA(1, 0), cA + kstep, false, 0, kstep); PG8_STAGE(PG8_SB(1, 1), cB + bhstep + kstep, voffB);
        PG8_WAIT_V(6); PG8_BAR;
    } else {
        PG8_STAGE(PG8_SB(0, 0), cB, voffB); PG8_STAGE(PG8_SA(0, 0), cA, voffA); PG8_STAGE(PG8_SB(0, 1), cB + bhstep, voffB); PG8_STAGE(PG8_SA(0, 1), cA + hstep, voffA);
        if (wr == 1) PG8_BAR;
        PG8_WAIT_V(4); PG8_BAR;
        PG8_STAGE(PG8_SB(1, 0), cB + kstep, voffB); PG8_STAGE(PG8_SA(1, 0), cA + kstep, voffA); PG8_STAGE(PG8_SB(1, 1), cB + bhstep + kstep, voffB);
        PG8_WAIT_V(6); PG8_BAR;
    }
    for (;;) {
        const bool has_next = S.next(ui + 1, nxt);
        if constexpr (Sched::GATHER) { if (has_next) { PG8_GOFF(gn, nxt.pm, ui + 1); } else { gn[0][0] = gc[0][0]; gn[0][1] = gc[0][1]; gn[1][0] = gc[1][0]; gn[1][1] = gc[1][1]; } }
        const char* nA = has_next ? (const char*)g.A + (size_t)nxt.pm * tstep : cA; const char* nB = has_next ? (const char*)g.Bt + (size_t)nxt.pn * tstep : cB;
#pragma unroll
        for (int seg = 0; seg < (Epi::MID_T > 0 ? 2 : 1); ++seg) {
        if constexpr (Epi::MID_T > 0) { if (seg == 1) { PG8_SCHED; E.mid(acc, cur, wr, wc, fr, fq); PG8_SCHED; } }
        const int t_lo = seg ? Epi::MID_T : 0, t_hi = (Epi::MID_T > 0 && seg == 0) ? Epi::MID_T : nt;
        for (int t = t_lo; t < t_hi; t += 2) {
            const bool last = (t == nt - 2);
            const char* a1 = cA + (size_t)(t + 1) * kstep;
            const char* a2 = last ? nA : cA + (size_t)(t + 2) * kstep; const char* b2 = last ? nB : cB + (size_t)(t + 2) * kstep;
            const char* a3 = a2 + kstep; const char* b3 = b2 + kstep; const size_t k2b = last ? (size_t)0 : (size_t)(t + 2) * kstep;
            if (last && has_next) S.a_ready(nxt);
            if constexpr (SP2) {
            PG8_LDB(B0, 0, 0); PG8_LDB(B1, 0, 1); PG8_SCHED; PG8_LDA(At, 0, 0); PG8_STAGE_A(PG8_SA(1, 1), a1 + hstep, false, 1, (size_t)(t + 1) * kstep);
            PG8_WAIT_V(8); PG8_WAIT_L(0); PG8_BAR; PG8_MMA(0, 0, At, B0); PG8_MMA(0, 1, At, B1); PG8_BAR; PG8_SCHED;
            PG8_LDA(At, 0, 1); PG8_STAGE(PG8_SB(0, 0), b2, voffB); PG8_STAGE(PG8_SB(0, 1), b2 + bhstep, voffB); PG8_STAGE_A(PG8_SA(0, 0), a2, last, 0, k2b);
            PG8_WAIT_V(8); PG8_WAIT_L(0); PG8_BAR; PG8_MMA(1, 0, At, B0); PG8_MMA(1, 1, At, B1); PG8_BAR; PG8_SCHED;
            PG8_LDB(B0, 1, 0); PG8_LDB(B1, 1, 1); PG8_SCHED; PG8_LDA(At, 1, 0); PG8_STAGE_A(PG8_SA(0, 1), a2 + hstep, last, 1, k2b);
            PG8_WAIT_V(8); PG8_WAIT_L(0); PG8_BAR; PG8_MMA(0, 0, At, B0); PG8_MMA(0, 1, At, B1); PG8_BAR; PG8_SCHED;
            PG8_LDA(At, 1, 1); PG8_STAGE(PG8_SB(1, 0), b3, voffB); PG8_STAGE(PG8_SB(1, 1), b3 + bhstep, voffB); PG8_STAGE_A(PG8_SA(1, 0), a3, last, 0, k2b + kstep);
            PG8_WAIT_V(8); PG8_WAIT_L(0); PG8_BAR; PG8_MMA(1, 0, At, B0); PG8_MMA(1, 1, At, B1); PG8_BAR; PG8_SCHED;
            } else {
            PG8_LDB(B0, 0, 0); PG8_SCHED; PG8_LDA(At, 0, 0); PG8_STAGE(PG8_SA(1, 1), a1 + hstep, voffA);
            PG8_WAIT_L(8); PG8_BAR; PG8_WAIT_L(0); PG8_MMA(0, 0, At, B0); PG8_BAR; PG8_SCHED;
            PG8_LDB(B1, 0, 1); PG8_STAGE(PG8_SB(0, 0), b2, voffB);
            PG8_BAR; PG8_WAIT_L(0); PG8_MMA(0, 1, At, B1); PG8_BAR;
            PG8_LDA(At, 0, 1); PG8_STAGE(PG8_SA(0, 0), a2, voffA);
            PG8_BAR; PG8_WAIT_L(0); PG8_MMA(1, 0, At, B0); PG8_BAR; PG8_SCHED;
            PG8_STAGE(PG8_SB(0, 1), b2 + bhstep, voffB);
            PG8_WAIT_V(6); PG8_BAR; PG8_MMA(1, 1, At, B1); PG8_BAR;
            PG8_LDB(B0, 1, 0); PG8_SCHED; PG8_LDA(At, 1, 0); PG8_STAGE(PG8_SA(0, 1), a2 + hstep, voffA);
            PG8_WAIT_L(8); PG8_BAR; PG8_WAIT_L(0); PG8_MMA(0, 0, At, B0); PG8_BAR; PG8_SCHED;
            PG8_LDB(B1, 1, 1); PG8_STAGE(PG8_SB(1, 0), b3, voffB);
            PG8_BAR; PG8_WAIT_L(0); PG8_MMA(0, 1, At, B1); PG8_BAR;
            PG8_LDA(At, 1, 1); PG8_STAGE(PG8_SA(1, 0), a3, voffA);
            PG8_BAR; PG8_WAIT_L(0); PG8_MMA(1, 0, At, B0); PG8_BAR; PG8_SCHED;
            PG8_STAGE(PG8_SB(1, 1), b3 + bhstep, voffB);
            PG8_WAIT_V(6); PG8_BAR; PG8_MMA(1, 1, At, B1); PG8_BAR;
            }
        }
        }
        if constexpr (ALIGN_EPI) { if (wr == 0) PG8_BAR; }
        if constexpr (!Epi::AFTER_DRAIN) { E(acc, cur, wr, wc, fr, fq); S.done(cur); }
        if (!has_next) break;
#pragma unroll
        for (int a = 0; a < 2; ++a)
#pragma unroll
            for (int b = 0; b < 2; ++b)
#pragma unroll
                for (int m = 0; m < 4; ++m)
#pragma unroll
                    for (int n = 0; n < 2; ++n) acc[a][b][m][n] = (f32x4){0.f, 0.f, 0.f, 0.f};
        cur = nxt; cA = nA; cB = nB; ++ui;
        if constexpr (Sched::GATHER) { gc[0][0] = gn[0][0]; gc[0][1] = gn[0][1]; gc[1][0] = gn[1][0]; gc[1][1] = gn[1][1]; }
        if constexpr (ALIGN_EPI) { if (wr == 1) PG8_BAR; }
    }
    PG8_WAIT_V(0);
    if constexpr (!ALIGN_EPI) { if (wr == 0) PG8_BAR; }
    PG8_BAR;
    if constexpr (Epi::AFTER_DRAIN) { E.fused(acc, cur, wr, wc, fr, fq, lds, wid, lane); S.done(cur); }
#undef PG8_SA
#undef PG8_SB
#undef PG8_STAGE
#undef PG8_STAGE_A
#undef PG8_GOFF
#undef PG8_LDA
#undef PG8_LDB
#undef PG8_MMA
#undef PG8_WAIT_V
#undef PG8_WAIT_L
#undef PG8_BAR
#undef PG8_SCHED
}
}
#define LAS __attribute__((address_space(3)))
#define XB_TMO      128
#define XB_XCNT(j)  (256  + 64 * (j))
#define XB_XSUB(j)  (1280 + 64 * (j))
#define XB_XGEN(j)  (2304 + 64 * (j))
#define XB_TOP      3328
#define XB_TOPGEN   3392
#define XCD_BAR_WORDS 3456
#define XB_SPIN_CAP (1u << 18)

__device__ __forceinline__ unsigned xb_ld(unsigned* p)              { return __hip_atomic_load(p, __ATOMIC_RELAXED, __HIP_MEMORY_SCOPE_AGENT); }
__device__ __forceinline__ unsigned xb_add(unsigned* p, unsigned v) { return __hip_atomic_fetch_add(p, v, __ATOMIC_RELAXED, __HIP_MEMORY_SCOPE_AGENT); }
__device__ __forceinline__ unsigned xb_xcc_id() { return (unsigned)__builtin_amdgcn_s_getreg((3 << 11) | 20) & 0xFu; }
#define XB_SPIN(cond, bar) do { unsigned _sp = 0; while (cond) { __builtin_amdgcn_s_sleep(1); \
    if ((++_sp & 255u) == 0u) { if (xb_ld(&(bar)[XB_TMO])) break; if (_sp > XB_SPIN_CAP) { atomicAdd(&(bar)[XB_TMO], 1u); break; } } } } while (0)

struct XcdBarrier {
    unsigned* bar; unsigned x;
    volatile LAS unsigned* st;
};

__device__ __forceinline__ XcdBarrier xcd_barrier_post(unsigned* bar, volatile LAS unsigned* st) {
    XcdBarrier b; b.bar = bar; b.x = xb_xcc_id(); b.st = st;
    if (threadIdx.x == 0) (void)xb_add(&bar[XB_XCNT(b.x)], 1u);
    return b;
}
__device__ __forceinline__ void xcd_barrier_complete(unsigned* bar, unsigned x, unsigned& nloc, unsigned& nx) {
    const unsigned G = gridDim.x * gridDim.y * gridDim.z;
    unsigned sum, cnt, mine, sp = 0u;
    for (;;) {
        sum = 0u; cnt = 0u; mine = 0u;
#pragma unroll
        for (unsigned j = 0; j < 16; ++j) { const unsigned c = xb_ld(&bar[XB_XCNT(j)]); sum += c; cnt += (c > 0u) ? 1u : 0u; mine = (j == x) ? c : mine; }
        if (sum == G) break;
        __builtin_amdgcn_s_sleep(1);
        if ((++sp & 255u) == 0u) { if (xb_ld(&bar[XB_TMO])) break; if (sp > XB_SPIN_CAP) { atomicAdd(&bar[XB_TMO], 1u); break; } }
    }
    nloc = mine > 0u ? mine : 1u; nx = cnt > 0u ? cnt : 1u;
}

__device__ __forceinline__ void xcd_barrier(const XcdBarrier& b) {
    asm volatile("s_waitcnt vmcnt(0)" ::: "memory");
    __syncthreads();
    if (threadIdx.x == 0) {
        unsigned* bar = b.bar;
        __builtin_amdgcn_s_waitcnt(0);
        unsigned nloc = b.st[0], nx = b.st[1];
        if (nloc == 0u) { xcd_barrier_complete(bar, b.x, nloc, nx); b.st[0] = nloc; b.st[1] = nx; }
        const unsigned old = xb_add(&bar[XB_XSUB(b.x)], 1u);
        const unsigned gen = old / nloc;
        if (old + 1u == (gen + 1u) * nloc) {
            __builtin_amdgcn_fence(__ATOMIC_RELEASE, "agent");
            asm volatile("s_waitcnt vmcnt(0)" ::: "memory");
            const unsigned og = xb_add(&bar[XB_TOP], 1u);
            const unsigned tg = og / nx;
            if (og + 1u == (tg + 1u) * nx) xb_add(&bar[XB_TOPGEN], 1u);
            else XB_SPIN(xb_ld(&bar[XB_TOPGEN]) == tg, bar);
            __builtin_amdgcn_fence(__ATOMIC_ACQUIRE, "agent");
            xb_add(&bar[XB_XGEN(b.x)], 1u);
            asm volatile("s_waitcnt vmcnt(0)" ::: "memory");
        } else {
            XB_SPIN(xb_ld(&bar[XB_XGEN(b.x)]) == gen, bar);
            __builtin_amdgcn_fence(__ATOMIC_ACQUIRE, "agent");
            asm volatile("s_waitcnt vmcnt(0)" ::: "memory");
        }
    }
    __syncthreads();
}


#ifndef PG8_SP2
#define PG8_SP2 true
#endif
#ifndef PG8_ALIGN
#define PG8_ALIGN true
#endif
constexpr int D = 1024, NB = 8, SEQ = 4096, T = NB * SEQ, NL = 4;
constexpr int NIN = 8704, NE = 32, FF = 1024;
constexpr int RMAX = 139264;
constexpr float LN_EPS = 1e-5f, DN_ALPHA = 1.681792830507429f;
constexpr float QSCALE = 0.18033688011112042f;
constexpr float LOG2E = 1.4426950408889634f;

constexpr size_t MiB = 1u << 20;
constexpr size_t WS_CTL = 0, CTL_ZERO_BYTES = 1 * MiB;
constexpr size_t WS_MOD = 1 * MiB;
constexpr size_t WS_ROPE = 2 * MiB;
constexpr size_t WS_WSP = 3 * MiB;
constexpr size_t WS_WRT = 4 * MiB;
constexpr size_t WS_TOKINFO = 5 * MiB;
constexpr size_t WS_TOKW = 5 * MiB + 512 * 1024;
constexpr size_t WS_ROWTOK = 6 * MiB;
constexpr size_t WS_ROWW = 7 * MiB;
constexpr size_t WS_LSE = 8 * MiB;
constexpr size_t WS_TOKROW = 14 * MiB;
constexpr size_t WS_STAT = 13 * MiB;
constexpr size_t WS_WGCNT = 12 * MiB;
constexpr size_t WS_WIN = 16 * MiB;
constexpr size_t WS_WBA = 84 * MiB;
constexpr size_t WS_WBB = 92 * MiB;
constexpr size_t WS_WOUT = 96 * MiB;
constexpr size_t WS_WUP = 104 * MiB;
constexpr size_t WS_WDN = 616 * MiB;
constexpr size_t WS_H = 872 * MiB;
constexpr size_t WS_X1 = 936 * MiB;
constexpr size_t WS_X2 = 1064 * MiB;
constexpr size_t WS_YPRE = 1192 * MiB;
constexpr size_t WS_U = 1320 * MiB, WS_V = 1384 * MiB;
constexpr size_t WS_Q = 1448 * MiB, WS_K = 1544 * MiB, WS_VV = 1640 * MiB;
constexpr size_t WS_G = 1736 * MiB;
constexpr size_t WS_OG = 1864 * MiB;
constexpr size_t WS_TT = 1960 * MiB;
constexpr size_t WS_OB = 2024 * MiB;
constexpr size_t WS_YA = 2056 * MiB;
constexpr size_t WS_MG = 2120 * MiB;
constexpr size_t WS_XG = 2184 * MiB;
constexpr size_t WS_ACT = 2456 * MiB;
constexpr size_t WS_YK = 2728 * MiB;
constexpr size_t WS_END = 2984 * MiB;
constexpr int CW_BAR = 4096;
constexpr int CW_CNT = 16384;

constexpr int RING_BYTES = 131072;
constexpr int XOFF = RING_BYTES;
constexpr int X_MISC = XOFF;
constexpr int X_SELE = XOFF + 256;
constexpr int X_SELR = XOFF + 2304;
constexpr int X_CNTL = XOFF + 4352;
constexpr int X_BASE = XOFF + 4480;
constexpr int X_TILEE = XOFF + 4608;
constexpr int X_CNTS = XOFF + 5632;
constexpr int X_OFFS = XOFF + 5760;
constexpr int LDS_BYTES = 147456;

#define GAS __attribute__((address_space(1)))
typedef unsigned short bf16;
typedef unsigned v4u __attribute__((ext_vector_type(4)));
typedef unsigned v2u __attribute__((ext_vector_type(2)));
typedef float f32x4 __attribute__((ext_vector_type(4)));
typedef short bf16x8 __attribute__((ext_vector_type(8)));
typedef short s16x4 __attribute__((ext_vector_type(4)));
#define RLX_AGENT __ATOMIC_RELAXED, __HIP_MEMORY_SCOPE_AGENT
#define LDS_WAIT() asm volatile("s_waitcnt lgkmcnt(0)" ::: "memory")
#define VM_WAIT() asm volatile("s_waitcnt vmcnt(0)" ::: "memory")

typedef __bf16 bf16x2_t __attribute__((ext_vector_type(2))); typedef float f32x2_t __attribute__((ext_vector_type(2)));
__device__ __forceinline__ unsigned pk2(float lo, float hi) { return __builtin_bit_cast(unsigned, __builtin_convertvector((f32x2_t){lo, hi}, bf16x2_t)); }
__device__ __forceinline__ float bflo(unsigned w) { return __uint_as_float(w << 16); }
__device__ __forceinline__ float bfhi(unsigned w) { return __uint_as_float(w & 0xffff0000u); }
__device__ __forceinline__ float fexp2(float x) { return __builtin_amdgcn_exp2f(x); }
__device__ __forceinline__ float frcp(float x) { return __builtin_amdgcn_rcpf(x); }
__device__ __forceinline__ float gelu_tanh(float x) { const float u = x + 0.044715f * x * x * x; return x * frcp(1.0f + fexp2(-2.302208198144325f * u)); }
__device__ __forceinline__ float sigmoidf_(float x) { return frcp(1.0f + fexp2(-LOG2E * x)); }
__device__ __forceinline__ float wave_sum(float v) {
#pragma unroll
    for (int o = 1; o < 64; o <<= 1) v += __shfl_xor(v, o);
    return v;
}
__device__ __forceinline__ float wave_max(float v) {
#pragma unroll
    for (int o = 1; o < 64; o <<= 1) v = fmaxf(v, __shfl_xor(v, o));
    return v;
}
__device__ __forceinline__ s16x4 tr16(const LAS unsigned char* p) { return __builtin_bit_cast(s16x4, __builtin_amdgcn_ds_read_tr16_b64_v4i16((LAS s16x4*)p)); }
__device__ __forceinline__ bf16x8 cat8(s16x4 lo, s16x4 hi) { return (bf16x8){lo[0], lo[1], lo[2], lo[3], hi[0], hi[1], hi[2], hi[3]}; }
__device__ __forceinline__ f32x4 mfma16(bf16x8 a, bf16x8 b, f32x4 c) { return __builtin_amdgcn_mfma_f32_16x16x32_bf16(a, b, c, 0, 0, 0); }

struct Frame {
    LAS unsigned char* lds;
    int tid, lane, wave, G, vcu, bx;
    unsigned char* ws;
    const float* const* in;
    float* out;
};
enum { I_X = 0, I_C, I_WADA, I_BADA, I_WIN, I_SPW, I_SPB, I_WBA, I_WBB, I_WOUT, I_LN1G, I_LN1B, I_WR, I_BR, I_WUP, I_BUP, I_WDN, I_BDN, I_LN2G, I_LN2B };
template <class Tp> __device__ __forceinline__ Tp* wsp(const Frame& F, size_t off) { return (Tp*)(F.ws + off); }

template <class P> __device__ __forceinline__ P launder(P p) { unsigned lo = (unsigned)(uintptr_t)p, hi = (unsigned)((uintptr_t)p >> 32); asm volatile("" : "+v"(lo), "+v"(hi));
    lo = (unsigned)__builtin_amdgcn_readfirstlane((int)lo); hi = (unsigned)__builtin_amdgcn_readfirstlane((int)hi); return (P)(((uintptr_t)hi << 32) | (uintptr_t)lo); }
__device__ __forceinline__ unsigned fl_x8(unsigned v) { return (unsigned)__builtin_amdgcn_update_dpp(0, (int)v, 0x128, 0xf, 0xf, false); }
#ifndef FLNT
#define FLNT true
#endif
template <bool NT> __device__ __forceinline__ void fl_put(bf16* p, size_t ld, bool lo, const v4u& w0, const v4u& w1) {
    v4u sd; sd.x = lo ? w1.x : w0.x; sd.y = lo ? w1.y : w0.y; sd.z = lo ? w1.z : w0.z; sd.w = lo ? w1.w : w0.w;
    v4u rc; rc.x = fl_x8(sd.x); rc.y = fl_x8(sd.y); rc.z = fl_x8(sd.z); rc.w = fl_x8(sd.w);
    v4u oa, ob; oa.x = lo ? w0.x : rc.x; oa.y = lo ? w0.y : rc.y; oa.z = lo ? w0.z : rc.z; oa.w = lo ? w0.w : rc.w;
    ob.x = lo ? rc.x : w1.x; ob.y = lo ? rc.y : w1.y; ob.z = lo ? rc.z : w1.z; ob.w = lo ? rc.w : w1.w;
    if (NT) { __builtin_nontemporal_store(oa, (v4u*)p); __builtin_nontemporal_store(ob, (v4u*)(p + 8 * ld)); } else { *(v4u*)p = oa; *(v4u*)(p + 8 * ld) = ob; } }
struct EpiIn {
    static constexpr int MID_T = 0; static constexpr bool PERM = true, AFTER_DRAIN = false, BADJ = true;
    bf16 *U, *V, *Q, *K, *VV, *Gt; const float* rope;
    __device__ __forceinline__ void operator()(const f32x4 (&acc)[2][2][4][2], const pg8::Unit& u, int wr, int wc, int fr, int fq) const {
        const int pn = u.pn; int type, ld, colt; bf16* base;
        if (pn < 4) { type = 0; base = U; ld = 1024; colt = pn * 256; }
        else if (pn < 8) { type = 0; base = V; ld = 1024; colt = (pn - 4) * 256; }
        else if (pn < 14) { type = 1; base = Q; ld = 1536; colt = (pn - 8) * 256; }
        else if (pn < 20) { type = 2; base = K; ld = 1536; colt = (pn - 14) * 256; }
        else if (pn < 26) { type = 3; base = VV; ld = 1536; colt = (pn - 20) * 256; }
        else { type = 4; base = Gt; ld = 2048; colt = (pn - 26) * 256; }
        const bool lo = fr < 8;
        const int rowl = u.pm * 256 + wr * 64 + fr;
        bf16* const pst = base + (size_t)(u.pm * 256 + wr * 64 + (fr & 7)) * ld + colt + wc * 64 + (fr >> 3) * 32 + 8 * fq;
        if (type == 0) {
#pragma unroll
            for (int ai = 0; ai < 2; ++ai)
#pragma unroll
                for (int m = 0; m < 4; ++m) { v4u w[2];
#pragma unroll
                    for (int bj = 0; bj < 2; ++bj) { const f32x4 v0 = acc[ai][bj][m][0], v1 = acc[ai][bj][m][1];
                        w[bj].x = pk2(gelu_tanh(v0[0]), gelu_tanh(v0[1])); w[bj].y = pk2(gelu_tanh(v0[2]), gelu_tanh(v0[3]));
                        w[bj].z = pk2(gelu_tanh(v1[0]), gelu_tanh(v1[1])); w[bj].w = pk2(gelu_tanh(v1[2]), gelu_tanh(v1[3])); }
                    fl_put<true>(pst + (size_t)(ai * 128 + m * 16) * ld, ld, lo, w[0], w[1]); }
        } else if (type == 4) {
#pragma unroll
            for (int ai = 0; ai < 2; ++ai)
#pragma unroll
                for (int m = 0; m < 4; ++m) { v4u w[2];
#pragma unroll
                    for (int bj = 0; bj < 2; ++bj) { const f32x4 v0 = acc[ai][bj][m][0], v1 = acc[ai][bj][m][1];
                        w[bj].x = pk2(sigmoidf_(v0[0]), sigmoidf_(v0[1])); w[bj].y = pk2(sigmoidf_(v0[2]), sigmoidf_(v0[3]));
                        w[bj].z = pk2(sigmoidf_(v1[0]), sigmoidf_(v1[1])); w[bj].w = pk2(sigmoidf_(v1[2]), sigmoidf_(v1[3])); }
                    fl_put<true>(pst + (size_t)(ai * 128 + m * 16) * ld, ld, lo, w[0], w[1]); }
        } else if (type == 3) {
#pragma unroll
            for (int ai = 0; ai < 2; ++ai)
#pragma unroll
                for (int m = 0; m < 4; ++m) { v4u w[2];
#pragma unroll
                    for (int bj = 0; bj < 2; ++bj) { const f32x4 v0 = acc[ai][bj][m][0], v1 = acc[ai][bj][m][1];
                        w[bj].x = pk2(v0[0], v0[1]); w[bj].y = pk2(v0[2], v0[3]); w[bj].z = pk2(v1[0], v1[1]); w[bj].w = pk2(v1[2], v1[3]); }
                    fl_put<true>(pst + (size_t)(ai * 128 + m * 16) * ld, ld, lo, w[0], w[1]); }
        } else {
            const float sc = (type == 1) ? QSCALE : 1.0f;
#pragma unroll
            for (int ai = 0; ai < 2; ++ai)
#pragma unroll
                for (int m = 0; m < 4; ++m) { const int row = rowl + ai * 128 + m * 16;
                    const f32x4* rp = (const f32x4*)(rope + (size_t)(row & (SEQ - 1)) * 16); const f32x4 c0 = rp[0], c1 = rp[1], s0 = rp[2], s1 = rp[3];
                    float cs[8], sn[8];
#pragma unroll
                    for (int e = 0; e < 4; ++e) { cs[e] = c0[e]; cs[4 + e] = c1[e]; sn[e] = s0[e]; sn[4 + e] = s1[e]; }
                    v4u w[2];
#pragma unroll
                    for (int bj = 0; bj < 2; ++bj) { f32x4 v0 = acc[ai][bj][m][0], v1 = acc[ai][bj][m][1];
                        if (bj == 0) {
#pragma unroll
                            for (int e = 0; e < 8; ++e) { const float x = (e < 4) ? v0[e & 3] : v1[e & 3]; const float p = __shfl_xor(x, 16);
                                float y = x;
                                if (fq == 0) y = x * cs[e] - p * sn[e];
                                if (fq == 1) y = x * cs[e] + p * sn[e];
                                if (e < 4) v0[e & 3] = y; else v1[e & 3] = y; } }
                        w[bj].x = pk2(v0[0] * sc, v0[1] * sc); w[bj].y = pk2(v0[2] * sc, v0[3] * sc); w[bj].z = pk2(v1[0] * sc, v1[1] * sc); w[bj].w = pk2(v1[2] * sc, v1[3] * sc); }
                    fl_put<true>(pst + (size_t)(ai * 128 + m * 16) * ld, ld, lo, w[0], w[1]); }
        }
    }
};
struct EpiProbe {
    static constexpr int MID_T = 0; static constexpr bool PERM = true, AFTER_DRAIN = false, BADJ = false;
    bf16* O; int ld; int on;
    __device__ __forceinline__ void operator()(const f32x4 (&acc)[2][2][4][2], const pg8::Unit& u, int wr, int wc, int fr, int fq) const {
        if (!on) return;
        const int row0 = u.pm * 256 + wr * 64 + fr, col0 = ((on == 3) ? u.pn : (u.pn & 3)) * 256 + wc * 32 + 8 * fq;
#pragma unroll
        for (int ai = 0; ai < 2; ++ai)
#pragma unroll
            for (int m = 0; m < 4; ++m) { bf16* rowp = O + (size_t)(row0 + ai * 128 + m * 16) * ld + col0;
#pragma unroll
                for (int bj = 0; bj < 2; ++bj) { const f32x4 v0 = acc[ai][bj][m][0], v1 = acc[ai][bj][m][1]; v4u w;
                    w.x = pk2(v0[0], v0[1]); w.y = pk2(v0[2], v0[3]); w.z = pk2(v1[0], v1[1]); w.w = pk2(v1[2], v1[3]);
                    *(v4u*)(rowp + bj * 128) = w; } }
    }
};
struct EpiYA {
    static constexpr int MID_T = 0; static constexpr bool PERM = true, AFTER_DRAIN = false, BADJ = false;
    const bf16* Gt; bf16* YA;
    __device__ __forceinline__ void operator()(const f32x4 (&acc)[2][2][4][2], const pg8::Unit& u, int wr, int wc, int fr, int fq) const {
        const int row0 = u.pm * 256 + wr * 64 + fr, col0 = u.pn * 256 + wc * 32 + 8 * fq;
#pragma unroll
        for (int ai = 0; ai < 2; ++ai)
#pragma unroll
            for (int m = 0; m < 4; ++m) { const size_t row = (size_t)(row0 + ai * 128 + m * 16);
#pragma unroll
                for (int bj = 0; bj < 2; ++bj) { const f32x4 v0 = acc[ai][bj][m][0], v1 = acc[ai][bj][m][1];
                    const v4u g = *(const v4u*)(Gt + row * 2048 + col0 + bj * 128); v4u w;
                    w.x = pk2(v0[0] * bflo(g.x), v0[1] * bfhi(g.x)); w.y = pk2(v0[2] * bflo(g.y), v0[3] * bfhi(g.y));
                    w.z = pk2(v1[0] * bflo(g.z), v1[1] * bfhi(g.z)); w.w = pk2(v1[2] * bflo(g.w), v1[3] * bfhi(g.w));
                    *(v4u*)(YA + row * 1024 + col0 + bj * 128) = w; } }
    }
};
struct EpiMg {
    static constexpr int MID_T = 0; static constexpr bool PERM = true, AFTER_DRAIN = false, BADJ = false;
    const bf16* Gt; const bf16* YA; bf16* MG;
    __device__ __forceinline__ void operator()(const f32x4 (&acc)[2][2][4][2], const pg8::Unit& u, int wr, int wc, int fr, int fq) const {
        const int row0 = u.pm * 256 + wr * 64 + fr, col0 = u.pn * 256 + wc * 32 + 8 * fq;
#pragma unroll
        for (int ai = 0; ai < 2; ++ai)
#pragma unroll
            for (int m = 0; m < 4; ++m) { const size_t row = (size_t)(row0 + ai * 128 + m * 16);
#pragma unroll
                for (int bj = 0; bj < 2; ++bj) { const f32x4 v0 = acc[ai][bj][m][0], v1 = acc[ai][bj][m][1];
                    const v4u g = *(const v4u*)(Gt + row * 2048 + 1024 + col0 + bj * 128); const v4u y = *(const v4u*)(YA + row * 1024 + col0 + bj * 128); v4u w;
                    w.x = pk2(bflo(y.x) + v0[0] * bflo(g.x), bfhi(y.x) + v0[1] * bfhi(g.x)); w.y = pk2(bflo(y.y) + v0[2] * bflo(g.y), bfhi(y.y) + v0[3] * bfhi(g.y));
                    w.z = pk2(bflo(y.z) + v1[0] * bflo(g.z), bfhi(y.z) + v1[1] * bfhi(g.z)); w.w = pk2(bflo(y.w) + v1[2] * bflo(g.w), bfhi(y.w) + v1[3] * bfhi(g.w));
                    *(v4u*)(MG + row * 1024 + col0 + bj * 128) = w; } }
    }
};
struct EpiMg2 {
    static constexpr int MID_T = 16; static constexpr bool PERM = true, AFTER_DRAIN = false, BADJ = true;
    const bf16* Gt; bf16* MG;
    __device__ __forceinline__ void mid(f32x4 (&acc)[2][2][4][2], const pg8::Unit& u, int wr, int wc, int fr, int fq) const {
        int row0 = u.pm * 256 + wr * 64 + fr; const int col0 = u.pn * 256 + wc * 64 + 8 * fq;
        asm volatile("" : "+v"(row0));
#pragma unroll
        for (int ai = 0; ai < 2; ++ai)
#pragma unroll
            for (int m = 0; m < 4; ++m) { const size_t row = (size_t)(row0 + ai * 128 + m * 16);
#pragma unroll
                for (int bj = 0; bj < 2; ++bj) { const v4u g0 = *(const v4u*)(Gt + row * 2048 + col0 + bj * 32), g1 = *(const v4u*)(Gt + row * 2048 + 1024 + col0 + bj * 32);
                    const unsigned a0[4] = {g0.x, g0.y, g0.z, g0.w}, a1[4] = {g1.x, g1.y, g1.z, g1.w};
#pragma unroll
                    for (int q = 0; q < 4; ++q) { const float r0 = bflo(a0[q]) * frcp(fmaxf(bflo(a1[q]), 1e-20f)), r1 = bfhi(a0[q]) * frcp(fmaxf(bfhi(a1[q]), 1e-20f));
                        acc[ai][bj][m][q >> 1][(q & 1) * 2] *= r0; acc[ai][bj][m][q >> 1][(q & 1) * 2 + 1] *= r1; } }
                if (m == 3) asm volatile("" ::: "memory"); }
    }
    __device__ __forceinline__ void operator()(const f32x4 (&acc)[2][2][4][2], const pg8::Unit& u, int wr, int wc, int fr, int fq) const {
        const int row0 = u.pm * 256 + wr * 64 + fr, col0 = u.pn * 256 + wc * 64 + 8 * fq; const bool lo = fr < 8;
        bf16* const pst = MG + (size_t)(u.pm * 256 + wr * 64 + (fr & 7)) * 1024 + u.pn * 256 + wc * 64 + (fr >> 3) * 32 + 8 * fq;
#pragma unroll
        for (int ai = 0; ai < 2; ++ai)
#pragma unroll
            for (int m = 0; m < 4; ++m) { const size_t row = (size_t)(row0 + ai * 128 + m * 16); v4u w[2];
#pragma unroll
                for (int bj = 0; bj < 2; ++bj) { const f32x4 v0 = acc[ai][bj][m][0], v1 = acc[ai][bj][m][1];
                    const v4u g = *(const v4u*)(Gt + row * 2048 + 1024 + col0 + bj * 32);
                    w[bj].x = pk2(v0[0] * fmaxf(bflo(g.x), 1e-20f), v0[1] * fmaxf(bfhi(g.x), 1e-20f)); w[bj].y = pk2(v0[2] * fmaxf(bflo(g.y), 1e-20f), v0[3] * fmaxf(bfhi(g.y), 1e-20f));
                    w[bj].z = pk2(v1[0] * fmaxf(bflo(g.z), 1e-20f), v1[1] * fmaxf(bfhi(g.z), 1e-20f)); w[bj].w = pk2(v1[2] * fmaxf(bflo(g.w), 1e-20f), v1[3] * fmaxf(bfhi(g.w), 1e-20f)); }
                fl_put<FLNT>(pst + (size_t)(ai * 128 + m * 16) * 1024, 1024, lo, w[0], w[1]); }
    }
};
template <bool XF32> struct EpiOut {
    static constexpr int MID_T = 0; static constexpr bool PERM = true, AFTER_DRAIN = false, BADJ = true;
    const void* xres; const float* modl  ; bf16* YPRE;
    __device__ __forceinline__ void operator()(const f32x4 (&acc)[2][2][4][2], const pg8::Unit& u, int wr, int wc, int fr, int fq) const {
        const int row0 = u.pm * 256 + wr * 64 + fr, col0 = u.pn * 256 + wc * 64 + 8 * fq; const int b = (u.pm * 256) >> 12; const bool lo = fr < 8;
        bf16* const pst = YPRE + (size_t)(u.pm * 256 + wr * 64 + (fr & 7)) * 1024 + u.pn * 256 + wc * 64 + (fr >> 3) * 32 + 8 * fq;
        f32x4 gg[2][2];
#pragma unroll
        for (int bj = 0; bj < 2; ++bj)
#pragma unroll
            for (int n = 0; n < 2; ++n) gg[bj][n] = *(const f32x4*)(modl + (size_t)b * 6144 + 2048 + col0 + bj * 32 + 4 * n) + 1.0f;
#pragma unroll
        for (int ai = 0; ai < 2; ++ai)
#pragma unroll
            for (int m = 0; m < 4; ++m) { const size_t off = (size_t)(row0 + ai * 128 + m * 16) * 1024 + col0; v4u w[2];
#pragma unroll
                for (int bj = 0; bj < 2; ++bj) { f32x4 x0, x1;
                    if (XF32) { x0 = *(const f32x4*)((const float*)xres + off + bj * 32); x1 = *(const f32x4*)((const float*)xres + off + bj * 32 + 4); }
                    else { const v4u xr = *(const v4u*)((const bf16*)xres + off + bj * 32); x0 = (f32x4){bflo(xr.x), bfhi(xr.x), bflo(xr.y), bfhi(xr.y)}; x1 = (f32x4){bflo(xr.z), bfhi(xr.z), bflo(xr.w), bfhi(xr.w)}; }
                    const f32x4 o0 = x0 * DN_ALPHA + gg[bj][0] * acc[ai][bj][m][0], o1 = x1 * DN_ALPHA + gg[bj][1] * acc[ai][bj][m][1];
                    w[bj].x = pk2(o0[0], o0[1]); w[bj].y = pk2(o0[2], o0[3]); w[bj].z = pk2(o1[0], o1[1]); w[bj].w = pk2(o1[2], o1[3]); }
                fl_put<FLNT>(pst + (size_t)(ai * 128 + m * 16) * 1024, 1024, lo, w[0], w[1]);
                if (m == 3) asm volatile("" ::: "memory"); }
    }
};
struct EpiUp {
    static constexpr int MID_T = 0; static constexpr bool PERM = true, AFTER_DRAIN = false, BADJ = false;
    const float* bup  ; bf16* ACT;
    __device__ __forceinline__ void operator()(const f32x4 (&acc)[2][2][4][2], const pg8::Unit& u, int wr, int wc, int fr, int fq) const {
        const int e = u.pn >> 3, pnl = u.pn & 7; const int row0 = u.pm * 256 + wr * 64 + fr, ac0 = pnl * 128 + wc * 32 + 8 * fq;
        const f32x4* bp = (const f32x4*)(bup + (size_t)e * 2048 + 2 * ac0); const f32x4 b0 = bp[0], b1 = bp[1], b2 = bp[2], b3 = bp[3];
        const float bg[8] = {b0[0], b0[2], b1[0], b1[2], b2[0], b2[2], b3[0], b3[2]}, bl[8] = {b0[1], b0[3], b1[1], b1[3], b2[1], b2[3], b3[1], b3[3]};
#pragma unroll
        for (int ai = 0; ai < 2; ++ai)
#pragma unroll
            for (int m = 0; m < 4; ++m) { float a[8];
#pragma unroll
                for (int j = 0; j < 8; ++j) { const float hg = acc[ai][0][m][j >> 2][j & 3] + bg[j], hl = acc[ai][1][m][j >> 2][j & 3] + bl[j];
                    const float glu = fminf(hg, 7.0f), lin = fminf(fmaxf(hl, -7.0f), 7.0f);
                    a[j] = glu * frcp(1.0f + fexp2(-2.4554669595930156f * glu)) * (lin + 1.0f); }
                v4u w; w.x = pk2(a[0], a[1]); w.y = pk2(a[2], a[3]); w.z = pk2(a[4], a[5]); w.w = pk2(a[6], a[7]);
                *(v4u*)(ACT + (size_t)(row0 + ai * 128 + m * 16) * 1024 + ac0) = w; }
    }
};
struct EpiDn {
    static constexpr int MID_T = 0; static constexpr bool PERM = true, AFTER_DRAIN = false, BADJ = true;
    const float* bdn  ; bf16* YKS;
    __device__ __forceinline__ void operator()(const f32x4 (&acc)[2][2][4][2], const pg8::Unit& u, int wr, int wc, int fr, int fq) const {
        const int e = u.pn >> 2, pnl = u.pn & 3; const int col0 = pnl * 256 + wc * 64 + 8 * fq; const bool lo = fr < 8;
        bf16* const pst = YKS + (size_t)(u.pm * 256 + wr * 64 + (fr & 7)) * 1024 + pnl * 256 + wc * 64 + (fr >> 3) * 32 + 8 * fq;
        f32x4 bv[2][2];
#pragma unroll
        for (int bj = 0; bj < 2; ++bj)
#pragma unroll
            for (int n = 0; n < 2; ++n) bv[bj][n] = *(const f32x4*)(bdn + (size_t)e * 1024 + col0 + bj * 32 + 4 * n);
#pragma unroll
        for (int ai = 0; ai < 2; ++ai)
#pragma unroll
            for (int m = 0; m < 4; ++m) { v4u w[2];
#pragma unroll
                for (int bj = 0; bj < 2; ++bj) { const f32x4 v0 = acc[ai][bj][m][0] + bv[bj][0], v1 = acc[ai][bj][m][1] + bv[bj][1];
                    w[bj].x = pk2(v0[0], v0[1]); w[bj].y = pk2(v0[2], v0[3]); w[bj].z = pk2(v1[0], v1[1]); w[bj].w = pk2(v1[2], v1[3]); }
                fl_put<FLNT>(pst + (size_t)(ai * 128 + m * 16) * 1024, 1024, lo, w[0], w[1]); }
    }
};
struct MoeOrder {
    static constexpr bool GATHER = false; __device__ __forceinline__ int arow(int, int r) const { return r; }
    int nM, nN, nwg, G, c, rev; const LAS unsigned char* tile_e;
    __device__ void init(int RT, int NN, int G_, int c_, const LAS unsigned char* te, int rev_ = 0) { nM = RT; nN = NN; nwg = RT * NN; G = G_; c = c_; tile_e = te; rev = rev_; }
    __device__ bool next(int i, pg8::Unit& u) const {
        const long L = (long)i * G + c; if (L >= nwg) return false;
        int wgid = (int)L; { const int q = nwg / pg8::NXCD, r = nwg % pg8::NXCD, xcd = wgid % pg8::NXCD, off = wgid / pg8::NXCD; wgid = (xcd < r ? xcd * (q + 1) : r * (q + 1) + (xcd - r) * q) + off; }
        const int nig = pg8::WGM * nN, gid = wgid / nig, fm = gid * pg8::WGM, gsz = (nM - fm) < pg8::WGM ? (nM - fm) : pg8::WGM;
        int pm = fm + ((wgid % nig) % gsz); const int pnl = (wgid % nig) / gsz; if (rev) pm = nM - 1 - pm;
        u.pm = pm; u.pn = (int)tile_e[pm] * nN + pnl; return true;
    }
    __device__ __forceinline__ void a_ready(const pg8::Unit&) const {}
    __device__ __forceinline__ void done(const pg8::Unit&) const {}
};

#ifndef STAG_N
#define STAG_N 1
#endif
#ifndef STAG_US
#define STAG_US 24
#endif
__device__ __forceinline__ void stagger(int slot, int us) {
    if (STAG_N <= 1) return;
    const unsigned long long t0 = __builtin_amdgcn_s_memrealtime(); const unsigned long long ticks = (unsigned long long)(slot % STAG_N) * (unsigned)us * 100ull / STAG_N;
    while (__builtin_amdgcn_s_memrealtime() - t0 < ticks) __builtin_amdgcn_s_sleep(16);
}
struct MoeGatherOrder : MoeOrder {
    static constexpr bool GATHER = true; const LAS unsigned short* tokl;
    __device__ __forceinline__ int arow(int ord, int r) const { return (int)tokl[ord * 256 + (r & 255)]; }
};
constexpr int X_TOKL = XOFF + 6144, TOKL_UNITS = 20;
constexpr int TR_NR = 32, TR_WAVE_BYTES = 64 * 64 * 4;
struct TrItem { const float* src; bf16* dst; int ld, K, kind, k0, c0, koff; };
__device__ __forceinline__ void tr_load(const TrItem& t, int lane, f32x4 (&r)[TR_NR]) {
    const int kq = lane >> 4, cc = lane & 15;
#pragma unroll
    for (int i = 0; i < TR_NR; ++i) r[i] = __builtin_nontemporal_load((const f32x4*)(t.src + (size_t)(t.k0 + 2 * (kq + 4 * (i >> 1)) + (i & 1)) * t.ld + t.c0 + 4 * cc));
}
__device__ __forceinline__ void tr_tile(int lane, LAS unsigned* scr, const f32x4 (&r)[TR_NR]) {
    const int kq = lane >> 4, cc = lane & 15;
#pragma unroll
    for (int i2 = 0; i2 < TR_NR / 2; ++i2) { LAS unsigned* p = scr + (4 * cc) * 64 + ((kq + 4 * i2) ^ (cc << 2));
#pragma unroll
        for (int e = 0; e < 4; ++e) p[e * 64] = pk2(r[2 * i2][e], r[2 * i2 + 1][e]); }
    LDS_WAIT(); asm volatile("" ::: "memory");
}
__device__ __forceinline__ void tr_store(const TrItem& t, int lane, const LAS unsigned* scr) {
    const int c = lane & 15;
    const int pbase = (t.kind == 0) ? t.c0 : (256 * (t.c0 >> 8) + ((t.c0 & 255) >> 1));
#pragma unroll
    for (int j = 0; j < 16; ++j) { const int n = (lane >> 4) + 4 * j; const v4u o = *(const LAS v4u*)(scr + n * 64 + ((c ^ j) << 2));
        const int drow = (t.kind == 0) ? (pbase + n) : (pbase + 128 * (n & 1) + (n >> 1));
        __builtin_nontemporal_store(o, (v4u*)(t.dst + (size_t)drow * t.K + t.koff + t.k0 + 8 * c)); }
    LDS_WAIT(); asm volatile("" ::: "memory");
}
__device__ __forceinline__ void sincos_d(double a, double& s, double& c) {
    const double k = rint(a * 0.63661977236758134308);
    const double y = fma(-k, 6.12323399573676603587e-17, fma(-k, 1.57079632679489655800, a));
    const double y2 = y * y;
    double sp = -7.6471637318198164759e-13; sp = fma(sp, y2, 1.6059043836821614599e-10); sp = fma(sp, y2, -2.5052108385441718775e-8); sp = fma(sp, y2, 2.7557319223985890653e-6);
    sp = fma(sp, y2, -1.9841269841269841270e-4); sp = fma(sp, y2, 8.3333333333333333333e-3); sp = fma(sp, y2, -1.6666666666666666667e-1); const double sy = fma(sp * y2, y, y);
    double cp = 4.7794773323873852974e-14; cp = fma(cp, y2, -1.1470745597729724714e-11); cp = fma(cp, y2, 2.0876756987868098979e-9); cp = fma(cp, y2, -2.7557319223985890653e-7);
    cp = fma(cp, y2, 2.4801587301587301587e-5); cp = fma(cp, y2, -1.3888888888888888889e-3); cp = fma(cp, y2, 4.1666666666666666667e-2); cp = fma(cp, y2, -0.5); const double cy = fma(cp, y2, 1.0);
    const int q = ((int)k) & 3;
    s = (q == 0) ? sy : (q == 1) ? cy : (q == 2) ? -sy : -cy;
    c = (q == 0) ? cy : (q == 1) ? -sy : (q == 2) ? -cy : sy;
}
__device__ __forceinline__ void phase_pro_a(Frame& F) {
    LAS unsigned* scr = (LAS unsigned*)(F.lds + F.wave * TR_WAVE_BYTES);
    const int gw = F.vcu * 8 + F.wave, NGW = F.G * 8;
    constexpr int I_IN = 8 * 136, I_SQ = 8 * 16, I_BB = 4 * 16, I_UP = 8 * 32;
    constexpr int S0 = NL * I_IN, S1 = S0 + NL * I_SQ, S2 = S1 + NL * I_BB, S3 = S2 + NL * I_SQ, S4 = S3 + NL * NE * I_SQ, S5 = S4 + NL * NE * I_UP;
    auto decode = [&](int it) -> TrItem { TrItem t; t.koff = 0;
        if (it < S0) { const int l = it / I_IN, r = it % I_IN; t.src = F.in[I_WIN] + (size_t)l * D * NIN; t.dst = wsp<bf16>(F, WS_WIN) + (size_t)l * NIN * D; t.ld = NIN; t.K = D; t.kind = 0; t.k0 = 128 * (r / 136); t.c0 = 64 * (r % 136); }
        else if (it < S1) { const int q = it - S0, l = q / I_SQ, r = q % I_SQ; t.src = F.in[I_WBA] + (size_t)l * D * D; t.dst = wsp<bf16>(F, WS_WBA) + (size_t)l * D * 1536; t.ld = D; t.K = 1536; t.kind = 0; t.k0 = 128 * (r / 16); t.c0 = 64 * (r % 16); }
        else if (it < S2) { const int q = it - S1, l = q / I_BB, r = q % I_BB; t.src = F.in[I_WBB] + (size_t)l * 512 * D; t.dst = wsp<bf16>(F, WS_WBA) + (size_t)l * D * 1536; t.ld = D; t.K = 1536; t.koff = 1024; t.kind = 0; t.k0 = 128 * (r / 16); t.c0 = 64 * (r % 16); }
        else if (it < S3) { const int q = it - S2, l = q / I_SQ, r = q % I_SQ; t.src = F.in[I_WOUT] + (size_t)l * D * D; t.dst = wsp<bf16>(F, WS_WOUT) + (size_t)l * D * D; t.ld = D; t.K = D; t.kind = 0; t.k0 = 128 * (r / 16); t.c0 = 64 * (r % 16); }
        else if (it < S4) { const int q = it - S3, le = q / I_SQ, r = q % I_SQ; t.src = F.in[I_WDN] + (size_t)le * FF * D; t.dst = wsp<bf16>(F, WS_WDN) + (size_t)le * D * FF; t.ld = D; t.K = FF; t.kind = 0; t.k0 = 128 * (r / 16); t.c0 = 64 * (r % 16); }
        else { const int q = it - S4, le = q / I_UP, r = q % I_UP; t.src = F.in[I_WUP] + (size_t)le * D * 2048; t.dst = wsp<bf16>(F, WS_WUP) + (size_t)le * 2048 * D; t.ld = 2048; t.K = D; t.kind = 1; t.k0 = 128 * (r / 32); t.c0 = 64 * (r % 32); }
        return t; };
    {
        f32x4 rn[TR_NR]; TrItem tn; int it = gw;
        if (it < S5) { tn = decode(it); tr_load(tn, F.lane, rn); }
#pragma unroll 1
        for (; it < S5; it += NGW) {
            const TrItem tc = tn;
            tr_tile(F.lane, scr, rn);
            if (it + NGW < S5) { tn = decode(it + NGW); tr_load(tn, F.lane, rn); }
            tr_store(tc, F.lane, scr);
        }
    }
    __syncthreads();
    {
        LAS float* cT = (LAS float*)F.lds;
        LAS float* red = (LAS float*)(F.lds + 32768);
        const float* cv = F.in[I_C];
        for (int i = F.tid; i < 8 * 1024; i += 512) { const int bb = i >> 10, k = i & 1023; cT[k * 8 + bb] = cv[i]; }
        __syncthreads();
        const int hf = F.lane >> 5, c4 = F.lane & 31;
        for (int u = F.vcu; u < NL * 48; u += F.G) {
            const int l = u / 48, n0 = 128 * (u % 48);
            f32x4 a[8];
#pragma unroll
            for (int bb = 0; bb < 8; ++bb) a[bb] = (f32x4){0.f, 0.f, 0.f, 0.f};
            const int kb = F.wave * 128 + hf;
            const float* wp = F.in[I_WADA] + (size_t)l * D * 6144 + (size_t)kb * 6144 + n0 + 4 * c4;
#pragma unroll 8
            for (int kk = 0; kk < 64; ++kk) { const f32x4 w = *(const f32x4*)(wp + (size_t)(2 * kk) * 6144);
                const f32x4 c0 = *(const LAS f32x4*)(cT + (kb + 2 * kk) * 8), c1 = *(const LAS f32x4*)(cT + (kb + 2 * kk) * 8 + 4);
#pragma unroll
                for (int bb = 0; bb < 4; ++bb) { a[bb] += w * c0[bb]; a[4 + bb] += w * c1[bb]; } }
#pragma unroll
            for (int bb = 0; bb < 8; ++bb) *(LAS f32x4*)(red + ((F.wave * 2 + hf) * 8 + bb) * 128 + 4 * c4) = a[bb];
            __syncthreads();
#pragma unroll
            for (int q = 0; q < 2; ++q) { const int o = F.tid + 512 * q, bb = o >> 7, cn = o & 127; float sum = F.in[I_BADA][l * 6144 + n0 + cn];
#pragma unroll
                for (int p = 0; p < 16; ++p) sum += red[(p * 8 + bb) * 128 + cn];
                wsp<float>(F, WS_MOD)[(size_t)(l * 8 + bb) * 6144 + n0 + cn] = sum; }
            __syncthreads();
        }
    }
    const int gt = F.vcu * 512 + F.tid, NT = F.G * 512;
    for (int i = gt; i < SEQ * 8; i += NT) { const int pos = i >> 3, f = i & 7;
        const double inv = (f == 0) ? 1.0 : (f == 1) ? 0.19392274474868576 : (f == 2) ? 0.03760603093086393 : (f == 3) ? 0.007292664737217109 : (f == 4) ? 0.001414213562373095 : (f == 5) ? 0.0002742481756762073 : (f == 6) ? 5.318295896944988e-05 : 1.031338537721246e-05;
        double s, c; sincos_d((double)pos * inv, s, c);
        float* rp = wsp<float>(F, WS_ROPE) + (size_t)pos * 16; rp[f] = (float)c; rp[8 + f] = (float)s; }
    for (int i = gt; i < NL * 4 * 128 * 128; i += NT) { const int j = i & 127, ii = (i >> 7) & 127; const float w = F.in[I_SPW][i];
        wsp<bf16>(F, WS_WSP)[i] = (bf16)(pk2((j <= ii) ? w : 0.f, 0.f) & 0xffffu); }
    for (int i = gt; i < NL * NE * D; i += NT) { const int k = i & 1023, e = (i >> 10) & 31, l = i >> 15; const float w = F.in[I_WR][((size_t)l * D + k) * NE + e];
        const unsigned hi = pk2(w, 0.f) & 0xffffu; const float lo = w - __uint_as_float(hi << 16);
        wsp<bf16>(F, WS_WRT)[i] = (bf16)hi; wsp<bf16>(F, WS_WRT)[NL * NE * D + i] = (bf16)(pk2(lo, 0.f) & 0xffffu); }
}
__device__ __forceinline__ void phase_pro_b(Frame& F) {
    const int gw = F.vcu * 8 + F.wave, NGW = F.G * 8;
    const float* mod = wsp<float>(F, WS_MOD);
    for (int m = gw; m < T; m += NGW) { const int b = m >> 12; const float* mb = mod + (size_t)b * 6144;
        const f32x4* xr = (const f32x4*)(F.in[I_X] + (size_t)m * D) + F.lane; v2u* hp = (v2u*)(wsp<bf16>(F, WS_H) + (size_t)m * D) + F.lane;
#pragma unroll
        for (int j = 0; j < 4; ++j) { const f32x4 x = xr[64 * j]; const f32x4 sh = *((const f32x4*)mb + F.lane + 64 * j), sc = *((const f32x4*)(mb + 1024) + F.lane + 64 * j);
            const f32x4 h = x * (sc + 1.0f) + sh; v2u o; o.x = pk2(h[0], h[1]); o.y = pk2(h[2], h[3]); hp[64 * j] = o; } }
}

constexpr int AT_RS = 144;
constexpr int AT_ROWS = 400, AT_VOFF = AT_ROWS * AT_RS;
#define LDS_BARRIER() do { asm volatile("s_waitcnt lgkmcnt(0)" ::: "memory"); __builtin_amdgcn_s_barrier(); asm volatile("" ::: "memory"); } while (0)
struct AtUnit { int g, b, h, r, n, d; size_t hoff; };
__device__ __forceinline__ AtUnit at_decode(int u) { AtUnit a; a.g = u >> 10; const int rem = u & 1023; a.b = rem >> 7; a.h = (rem >> 4) & 7; const int rn = rem & 15;
    const int dsh = 2 * a.g, nbs = 4 - dsh; a.d = 1 << dsh; a.r = rn >> nbs; a.n = 2 * (rn & ((1 << nbs) - 1)); a.hoff = (size_t)a.g * 512 + a.h * 64; return a; }
constexpr int AT_NU = 3 * 1024;
struct AtSlot { v4u k[6], v[6]; bf16x8 q0, q1, q2, q3; };
struct AtCtx { const bf16 *Qb, *Kb, *Vb; bf16* OG; float* LSE; LAS unsigned char *Ks, *Vs; int qi, g4, piece, jr; };
__device__ __forceinline__ void at_load(AtSlot& sl, int uu, const AtCtx& C, const Frame& F) {
    const AtUnit a_ = at_decode(uu);
#pragma unroll
    for (int ps = 0; ps < 6; ++ps) { const int lp = 128 * (a_.n - 1) + ps * 64 + C.jr; sl.k[ps] = (v4u){0u, 0u, 0u, 0u}; sl.v[ps] = sl.k[ps];
        if (lp >= 0) { const size_t off = ((size_t)a_.b * SEQ + (size_t)lp * a_.d + a_.r) * 1536 + a_.hoff + C.piece * 8; sl.k[ps] = *(const v4u*)(C.Kb + off); sl.v[ps] = *(const v4u*)(C.Vb + off); } }
    const size_t qrow_ = (size_t)a_.b * SEQ + (size_t)(128 * a_.n + 16 * F.wave + C.qi) * a_.d + a_.r; const bf16* qp = C.Qb + qrow_ * 1536 + a_.hoff + 8 * C.g4;
    sl.q0 = *(const bf16x8*)qp; sl.q1 = *(const bf16x8*)(qp + 32);
    const bf16* qp2 = qp + (size_t)128 * a_.d * 1536; sl.q2 = *(const bf16x8*)qp2; sl.q3 = *(const bf16x8*)(qp2 + 32);
}
__device__ __forceinline__ void at_unit(AtSlot& sl, int u, int unext, const AtCtx& C, const Frame& F) {
    bf16* OG = C.OG; float* LSE = C.LSE; LAS unsigned char* Ks = C.Ks; LAS unsigned char* Vs = C.Vs; const int qi = C.qi, g4 = C.g4;
    const AtUnit au = at_decode(u); const int g = au.g, b = au.b, h = au.h, r = au.r, n = au.n, d = au.d;
#pragma unroll
    for (int ps = 0; ps < 6; ++ps) { const int j = ps * 64 + C.jr; *(LAS v4u*)(Ks + j * AT_RS + C.piece * 16) = sl.k[ps]; *(LAS v4u*)(Vs + j * AT_RS + C.piece * 16) = sl.v[ps]; }
    const bf16x8 sl_q0 = sl.q0, sl_q1 = sl.q1, sl_q2 = sl.q2, sl_q3 = sl.q3;
    LDS_BARRIER();
    if (unext < AT_NU) at_load(sl, unext, C, F);
#pragma unroll
    for (int tq = 0; tq < 2; ++tq)
        {
            const int iq = 128 * tq + 16 * F.wave + qi; const int rb = 128 * tq + 16 * F.wave; const bf16x8 qf0 = tq ? sl_q2 : sl_q0, qf1 = tq ? sl_q3 : sl_q1; const size_t qrow = (size_t)b * SEQ + (size_t)(128 * n + iq) * d + r;
            f32x4 s[10]; float mx = -1e30f; const int dq = qi - 4 * g4; const bool first = (n == 0) && (tq == 0);
#pragma unroll
            for (int st = 0; st < 9; ++st) {
                const LAS unsigned char* kp = Ks + (rb + 16 * st + qi) * AT_RS + g4 * 16;
                const bf16x8 k0 = *(const LAS bf16x8*)kp, k1 = *(const LAS bf16x8*)(kp + 64);
                f32x4 a = (f32x4){0.f, 0.f, 0.f, 0.f};
                a = mfma16(k0, qf0, a); a = mfma16(k1, qf1, a);
                if (st == 0) {
#pragma unroll
                    for (int i = 0; i < 4; ++i) a[i] = (i >= dq) ? a[i] : -1e30f; }
                if (st == 8) {
#pragma unroll
                    for (int i = 0; i < 4; ++i) a[i] = (i <= dq) ? a[i] : -1e30f; }
                if (first) {
#pragma unroll
                    for (int i = 0; i < 4; ++i) a[i] = (rb + 16 * st + 4 * g4 + i >= 128) ? a[i] : -1e30f; }
#pragma unroll
                for (int i = 0; i < 4; ++i) mx = fmaxf(mx, a[i]);
                s[st] = a;
            }
            mx = fmaxf(mx, __shfl_xor(mx, 16)); mx = fmaxf(mx, __shfl_xor(mx, 32));
            float sum = 0.f;
#pragma unroll
            for (int st = 0; st < 9; ++st)
#pragma unroll
                for (int i = 0; i < 4; ++i) { const float p = fexp2(s[st][i] - mx); s[st][i] = p; sum += p; }
            s[9] = (f32x4){0.f, 0.f, 0.f, 0.f};
            sum += __shfl_xor(sum, 16); sum += __shfl_xor(sum, 32);
            f32x4 o[4];
#pragma unroll
            for (int dt = 0; dt < 4; ++dt) o[dt] = (f32x4){0.f, 0.f, 0.f, 0.f};
#pragma unroll
            for (int c = 0; c < 5; ++c) {
                v4u pw; pw.x = pk2(s[2 * c][0], s[2 * c][1]); pw.y = pk2(s[2 * c][2], s[2 * c][3]); pw.z = pk2(s[2 * c + 1][0], s[2 * c + 1][1]); pw.w = pk2(s[2 * c + 1][2], s[2 * c + 1][3]);
                const bf16x8 pf = __builtin_bit_cast(bf16x8, pw);
                const LAS unsigned char* vp = Vs + (rb + 32 * c + 4 * g4 + (qi >> 2)) * AT_RS + 8 * (qi & 3);
#pragma unroll
                for (int dt = 0; dt < 4; ++dt) { const s16x4 lo = tr16(vp + 32 * dt), hi = tr16(vp + 32 * dt + 16 * AT_RS);
                    o[dt] = mfma16(cat8(lo, hi), pf, o[dt]); }
            }
            const float inv = 1.0f / sum;
            bf16* op = OG + ((size_t)g * T + qrow) * 512 + h * 64 + 4 * g4;
#pragma unroll
            for (int dt = 0; dt < 4; ++dt) { v2u w; w.x = pk2(o[dt][0] * inv, o[dt][1] * inv); w.y = pk2(o[dt][2] * inv, o[dt][3] * inv); *(v2u*)(op + 16 * dt) = w; }
            if (g4 == 0) LSE[((size_t)g * T + qrow) * 8 + h] = mx + __log2f(sum);
        }
    LDS_BARRIER();
}
__device__ __forceinline__ void phase_attn(Frame& F) {
    AtCtx C; C.Qb = wsp<bf16>(F, WS_Q); C.Kb = wsp<bf16>(F, WS_K); C.Vb = wsp<bf16>(F, WS_VV); C.OG = wsp<bf16>(F, WS_OG); C.LSE = wsp<float>(F, WS_LSE);
    C.Ks = F.lds; C.Vs = F.lds + AT_VOFF; C.qi = F.lane & 15; C.g4 = F.lane >> 4; C.piece = F.tid & 7; C.jr = F.tid >> 3;
    if (F.tid < 144) { *(LAS v4u*)(C.Ks + 384 * AT_RS + F.tid * 16) = (v4u){0u, 0u, 0u, 0u}; *(LAS v4u*)(C.Vs + 384 * AT_RS + F.tid * 16) = (v4u){0u, 0u, 0u, 0u}; }
    AtSlot sa; const int u0 = F.vcu, G = F.G;
    if (u0 < AT_NU) at_load(sa, u0, C, F);
#pragma unroll 1
    for (int u = u0; u < AT_NU; u += G) at_unit(sa, u, u + G, C, F);
}

constexpr int SG_WOFF = 69632, SG_WRS = 264;
constexpr int SG_RS = 528;
__device__ __forceinline__ void phase_sg(Frame& F, int l) {
    const bf16* Ub = wsp<bf16>(F, WS_U); const bf16* Vb = wsp<bf16>(F, WS_V); bf16* TT = wsp<bf16>(F, WS_TT);
    const bf16* OG = wsp<bf16>(F, WS_OG); const float* LSE = wsp<float>(F, WS_LSE); bf16* OB = wsp<bf16>(F, WS_OB);
    const bf16* Wsp = wsp<bf16>(F, WS_WSP); const float* spb = F.in[I_SPB];
    LAS unsigned char* Vn = F.lds;
    const int qi = F.lane & 15, g4 = F.lane >> 4;
    const int l32 = F.lane & 31;
    v4u vraw[8];
#define SG_LOAD(uu) do { const int gi_ = (uu) & 3, m0_ = ((uu) >> 2) * 128; \
        _Pragma("unroll") for (int ps = 0; ps < 8; ++ps) vraw[ps] = *(const v4u*)(Vb + (size_t)(m0_ + 16 * ps + 2 * F.wave + (F.lane >> 5)) * 1024 + gi_ * 256 + 8 * l32); } while (0)
    if (F.vcu < 1024) SG_LOAD(F.vcu);
    const bool wlds = (F.G & 3) == 0; LAS unsigned char* Wl = F.lds + SG_WOFF;
    if (wlds) { const bf16* wsrc = Wsp + (size_t)(l * 4 + (F.vcu & 3)) * 128 * 128;
        for (int i = F.tid; i < 128 * 16; i += 512) { const int row = i >> 4, ch = i & 15; const v4u wv = *(const v4u*)(wsrc + row * 128 + ch * 8);
            *(LAS v2u*)(Wl + row * SG_WRS + ch * 16) = (v2u){wv.x, wv.y}; *(LAS v2u*)(Wl + row * SG_WRS + ch * 16 + 8) = (v2u){wv.z, wv.w}; } }
    for (int u = F.vcu; u < 1024; u += F.G) {
        const int gi = u & 3, m0 = (u >> 2) * 128;
        float ml[4][3]; v4u mo[4][3]; const int sub = F.tid & 7;
#pragma unroll
        for (int ps = 0; ps < 4; ++ps) { const int p = (F.tid >> 3) + 64 * ps; const size_t tok = (size_t)m0 + (p >> 1); const int hd = 2 * gi + (p & 1); const size_t off = tok * 512 + hd * 64 + 8 * sub;
#pragma unroll
            for (int gq = 0; gq < 3; ++gq) { ml[ps][gq] = LSE[((size_t)gq * T + tok) * 8 + hd]; mo[ps][gq] = *(const v4u*)(OG + (size_t)gq * T * 512 + off); } }
        {
            float sm[8], mean[8], rs[8];
#pragma unroll
            for (int ps = 0; ps < 8; ++ps) { const v4u raw = vraw[ps]; sm[ps] = ((bflo(raw.x) + bfhi(raw.x)) + (bflo(raw.y) + bfhi(raw.y))) + ((bflo(raw.z) + bfhi(raw.z)) + (bflo(raw.w) + bfhi(raw.w))); }
#pragma unroll
            for (int o = 1; o < 32; o <<= 1) {
#pragma unroll
                for (int ps = 0; ps < 8; ++ps) sm[ps] += __shfl_xor(sm[ps], o); }
#pragma unroll
            for (int ps = 0; ps < 8; ++ps) { const v4u raw = vraw[ps]; mean[ps] = sm[ps] * (1.0f / 256.0f); float q = 0.f;
                const float x[8] = {bflo(raw.x), bfhi(raw.x), bflo(raw.y), bfhi(raw.y), bflo(raw.z), bfhi(raw.z), bflo(raw.w), bfhi(raw.w)};
#pragma unroll
                for (int e = 0; e < 8; ++e) { const float dx = x[e] - mean[ps]; q += dx * dx; }
                sm[ps] = q; }
#pragma unroll
            for (int o = 1; o < 32; o <<= 1) {
#pragma unroll
                for (int ps = 0; ps < 8; ++ps) sm[ps] += __shfl_xor(sm[ps], o); }
#pragma unroll
            for (int ps = 0; ps < 8; ++ps) { rs[ps] = 1.0f / sqrtf(sm[ps] * (1.0f / 256.0f) + LN_EPS); const v4u raw = vraw[ps]; const int j = 16 * ps + 2 * F.wave + (F.lane >> 5);
                const float x[8] = {bflo(raw.x), bfhi(raw.x), bflo(raw.y), bfhi(raw.y), bflo(raw.z), bfhi(raw.z), bflo(raw.w), bfhi(raw.w)};
                v4u w; w.x = pk2((x[0] - mean[ps]) * rs[ps], (x[1] - mean[ps]) * rs[ps]); w.y = pk2((x[2] - mean[ps]) * rs[ps], (x[3] - mean[ps]) * rs[ps]);
                w.z = pk2((x[4] - mean[ps]) * rs[ps], (x[5] - mean[ps]) * rs[ps]); w.w = pk2((x[6] - mean[ps]) * rs[ps], (x[7] - mean[ps]) * rs[ps]);
                *(LAS v4u*)(Vn + j * SG_RS + l32 * 16) = w; }
        }
        LDS_BARRIER();
        if (u + F.G < 1024) SG_LOAD(u + F.G);
        {
#pragma unroll
          for (int ps = 0; ps < 4; ++ps) { const int p = (F.tid >> 3) + 64 * ps; const size_t tok = (size_t)m0 + (p >> 1); const int hd = 2 * gi + (p & 1);
              const float l0 = ml[ps][0], l1 = ml[ps][1], l2 = ml[ps][2];
              const float mxx = fmaxf(l0, fmaxf(l1, l2)); float w0 = fexp2(l0 - mxx), w1 = fexp2(l1 - mxx), w2 = fexp2(l2 - mxx); const float inv = 1.0f / (w0 + w1 + w2); w0 *= inv; w1 *= inv; w2 *= inv;
              const size_t off = tok * 512 + hd * 64 + 8 * sub;
              const v4u a = mo[ps][0], bq = mo[ps][1], cq = mo[ps][2]; v4u w;
              w.x = pk2(w0 * bflo(a.x) + w1 * bflo(bq.x) + w2 * bflo(cq.x), w0 * bfhi(a.x) + w1 * bfhi(bq.x) + w2 * bfhi(cq.x));
              w.y = pk2(w0 * bflo(a.y) + w1 * bflo(bq.y) + w2 * bflo(cq.y), w0 * bfhi(a.y) + w1 * bfhi(bq.y) + w2 * bfhi(cq.y));
              w.z = pk2(w0 * bflo(a.z) + w1 * bflo(bq.z) + w2 * bflo(cq.z), w0 * bfhi(a.z) + w1 * bfhi(bq.z) + w2 * bfhi(cq.z));
              w.w = pk2(w0 * bflo(a.w) + w1 * bflo(bq.w) + w2 * bflo(cq.w), w0 * bfhi(a.w) + w1 * bfhi(bq.w) + w2 * bfhi(cq.w));
              *(v4u*)(TT + tok * 1536 + 1024 + hd * 64 + 8 * sub) = w; } }
        v2u uq[8][2]; float ubias[8];
#pragma unroll
        for (int it = 0; it < 8; ++it) { const int i = 16 * it + qi; ubias[it] = spb[(l * 4 + gi) * 128 + i]; const size_t rowo = (size_t)(m0 + i) * 1024 + gi * 256 + 32 * F.wave + 4 * g4;
            uq[it][0] = *(const v2u*)(Ub + rowo); uq[it][1] = *(const v2u*)(Ub + rowo + 16); }
        {
            f32x4 acc[2][8];
#pragma unroll
            for (int ct = 0; ct < 2; ++ct)
#pragma unroll
                for (int it = 0; it < 8; ++it) acc[ct][it] = (f32x4){0.f, 0.f, 0.f, 0.f};
            const bf16* wbase = Wsp + (size_t)(l * 4 + gi) * 128 * 128 + (size_t)qi * 128 + 4 * g4;
#pragma unroll
            for (int kc = 0; kc < 4; ++kc) {
                bf16x8 af[2];
#pragma unroll
                for (int ct = 0; ct < 2; ++ct) { const LAS unsigned char* p = Vn + (32 * kc + 4 * g4 + (qi >> 2)) * SG_RS + (32 * F.wave + 16 * ct + 4 * (qi & 3)) * 2;
                    af[ct] = cat8(tr16(p), tr16(p + 16 * SG_RS)); }
#pragma unroll
                for (int it = 0; it < 8; ++it) if (it >= 2 * kc) {
                    const bf16* wp = wbase + (size_t)(16 * it) * 128 + 32 * kc; const LAS unsigned char* wq = Wl + (16 * it + qi) * SG_WRS + (32 * kc + 4 * g4) * 2;
                    const v2u b0 = wlds ? *(const LAS v2u*)wq : *(const v2u*)wp, b1 = wlds ? *(const LAS v2u*)(wq + 32) : *(const v2u*)(wp + 16);
                    const bf16x8 bfr = __builtin_bit_cast(bf16x8, (v4u){b0.x, b0.y, b1.x, b1.y});
                    acc[0][it] = mfma16(af[0], bfr, acc[0][it]); acc[1][it] = mfma16(af[1], bfr, acc[1][it]); }
            }
#pragma unroll
            for (int it = 0; it < 8; ++it) { const int i = 16 * it + qi; const float bias = ubias[it]; const size_t rowo = (size_t)(m0 + i) * 1536 + gi * 256 + 32 * F.wave + 4 * g4;
#pragma unroll
                for (int ct = 0; ct < 2; ++ct) { const v2u uu = uq[it][ct]; const f32x4 a = acc[ct][it]; v2u w;
                    w.x = pk2(bflo(uu.x) * (a[0] + bias), bfhi(uu.x) * (a[1] + bias)); w.y = pk2(bflo(uu.y) * (a[2] + bias), bfhi(uu.y) * (a[3] + bias));
                    *(v2u*)(TT + rowo + 16 * ct) = w; } }
        }
        LDS_BARRIER();
    }
#undef SG_LOAD
}

__device__ __forceinline__ void phase_ln1(Frame& F, int l, bool commit) {
    const bf16* YPRE = wsp<bf16>(F, WS_YPRE); bf16* H = wsp<bf16>(F, WS_H);
    const float* modl = wsp<float>(F, WS_MOD) + (size_t)l * 8 * 6144;
    const float* lg = F.in[I_LN1G] + l * D; const float* lb = F.in[I_LN1B] + l * D; const float* br = F.in[I_BR] + l * NE;
    const bf16* WH = wsp<bf16>(F, WS_WRT) + (size_t)l * NE * D; const bf16* WL = WH + (size_t)NL * NE * D;
    int* TOKINFO = wsp<int>(F, WS_TOKINFO); float* TOKW = wsp<float>(F, WS_TOKW);
    unsigned* cntg = wsp<unsigned>(F, WS_CTL) + CW_CNT + (size_t)l * NE * 64;
    LAS int* sel_e = (LAS int*)(F.lds + X_SELE);
    const int lane = F.lane, qi = lane & 15, g4 = lane >> 4;
    { const v4u* srcw = (const v4u*)WH;
#pragma unroll 4
      for (int i = F.tid; i < 2 * NE * 128; i += 512) { const int hl = i >> 12, e = (i >> 7) & 31, c = i & 127;
          *(LAS v4u*)(F.lds + hl * 65536 + e * 2048 + ((c ^ (e & 15)) << 4)) = srcw[(size_t)hl * (NL * NE * 128) + e * 128 + c]; } }
    __syncthreads();
    for (int tb = F.vcu; tb < T / 128; tb += F.G) {
        const int m0 = tb * 128; const int b = m0 >> 12; const float* mb = modl + (size_t)b * 6144; const int mw = m0 + 16 * F.wave;
        v2u pre[4][4];
#pragma unroll
        for (int r = 0; r < 4; ++r)
#pragma unroll
            for (int j = 0; j < 4; ++j) pre[r][j] = *((const v2u*)(YPRE + (size_t)(mw + r) * D) + lane + 64 * j);
#pragma unroll 1
        for (int rp = 0; rp < 4; ++rp) {
            f32x4 hh[4][4]; float mean[4], rstd[4];
            const int mrow = mw + 4 * rp;
#pragma unroll
            for (int r = 0; r < 4; ++r)
#pragma unroll
                for (int j = 0; j < 4; ++j) hh[r][j] = (f32x4){bflo(pre[r][j].x), bfhi(pre[r][j].x), bflo(pre[r][j].y), bfhi(pre[r][j].y)};
            if (rp < 3) {
#pragma unroll
                for (int r = 0; r < 4; ++r)
#pragma unroll
                    for (int j = 0; j < 4; ++j) pre[r][j] = *((const v2u*)(YPRE + (size_t)(mrow + 4 + r) * D) + lane + 64 * j); }
            { float sm[4], sq[4];
#pragma unroll
              for (int r = 0; r < 4; ++r) { sm[r] = 0.f; sq[r] = 0.f;
#pragma unroll
                  for (int j = 0; j < 4; ++j) { sm[r] += (hh[r][j][0] + hh[r][j][1]) + (hh[r][j][2] + hh[r][j][3]);
                      sq[r] += (hh[r][j][0] * hh[r][j][0] + hh[r][j][1] * hh[r][j][1]) + (hh[r][j][2] * hh[r][j][2] + hh[r][j][3] * hh[r][j][3]); } }
#pragma unroll
              for (int o = 1; o < 64; o <<= 1) {
#pragma unroll
                  for (int r = 0; r < 4; ++r) { sm[r] += __shfl_xor(sm[r], o); sq[r] += __shfl_xor(sq[r], o); } }
#pragma unroll
              for (int r = 0; r < 4; ++r) { mean[r] = sm[r] * (1.0f / D); rstd[r] = 1.0f / sqrtf(fmaxf(sq[r] * (1.0f / D) - mean[r] * mean[r], 0.f) + LN_EPS); } }
            if (lane < 4) { const float mq = (lane == 0) ? mean[0] : (lane == 1) ? mean[1] : (lane == 2) ? mean[2] : mean[3], rq = (lane == 0) ? rstd[0] : (lane == 1) ? rstd[1] : (lane == 2) ? rstd[2] : rstd[3];
                float* st = wsp<float>(F, WS_STAT) + (size_t)(mrow + lane) * 2; st[0] = mq; st[1] = rq; }
#pragma unroll
            for (int j = 0; j < 4; ++j) { const f32x4 gq = *((const f32x4*)lg + lane + 64 * j), bq = *((const f32x4*)lb + lane + 64 * j);
                const f32x4 shq = *((const f32x4*)(mb + 3072) + lane + 64 * j), scq = *((const f32x4*)(mb + 4096) + lane + 64 * j) + 1.0f;
#pragma unroll
                for (int r = 0; r < 4; ++r) { const f32x4 x1 = (hh[r][j] - mean[r]) * rstd[r] * gq + bq;
                    const f32x4 h2 = x1 * scq + shq; v2u o; o.x = pk2(h2[0], h2[1]); o.y = pk2(h2[2], h2[3]); *((v2u*)(H + (size_t)(mrow + r) * D) + lane + 64 * j) = o;
 } }
        }
        VM_WAIT(); asm volatile("" ::: "memory");
        f32x4 c0 = (f32x4){0.f, 0.f, 0.f, 0.f}, c1 = c0;
        { const bf16* hp = H + (size_t)(mw + qi) * D + 8 * g4;
          const LAS unsigned char* w0 = F.lds + qi * 2048; const LAS unsigned char* w1 = F.lds + (16 + qi) * 2048;
#pragma unroll 8
          for (int ks = 0; ks < 32; ++ks) {
              const bf16x8 hhi = *(const bf16x8*)(hp + 32 * ks);
              const int co = ((4 * ks + g4) ^ qi) << 4;
              const bf16x8 a0h = *(const LAS bf16x8*)(w0 + co), a0l = *(const LAS bf16x8*)(w0 + 65536 + co);
              const bf16x8 a1h = *(const LAS bf16x8*)(w1 + co), a1l = *(const LAS bf16x8*)(w1 + 65536 + co);
              c0 = mfma16(a0h, hhi, c0); c0 = mfma16(a0l, hhi, c0);
              c1 = mfma16(a1h, hhi, c1); c1 = mfma16(a1l, hhi, c1); } }
        {
            float v[8]; int id[8];
#pragma unroll
            for (int i = 0; i < 4; ++i) { id[i] = 4 * g4 + i; id[4 + i] = 16 + 4 * g4 + i; v[i] = c0[i] + br[4 * g4 + i]; v[4 + i] = c1[i] + br[16 + 4 * g4 + i]; }
            int ek[4]; float vk[4];
#pragma unroll
            for (int k = 0; k < 4; ++k) { float lm = v[0]; int li = id[0];
#pragma unroll
                for (int j = 1; j < 8; ++j) if (v[j] > lm) { lm = v[j]; li = id[j]; }
#pragma unroll
                for (int o = 16; o <= 32; o <<= 1) { const float om = __shfl_xor(lm, o); const int oi = __shfl_xor(li, o); if (om > lm || (om == lm && oi < li)) { lm = om; li = oi; } }
                ek[k] = li; vk[k] = lm;
#pragma unroll
                for (int j = 0; j < 8; ++j) if (id[j] == li) v[j] = -INFINITY; }
            const float e1 = __expf(vk[1] - vk[0]), e2 = __expf(vk[2] - vk[0]), e3 = __expf(vk[3] - vk[0]); const float inv = 1.0f / (1.0f + e1 + e2 + e3);
            if (g4 == 0) { const int tl = 16 * F.wave + qi;
                sel_e[tl * 4 + 0] = ek[0]; sel_e[tl * 4 + 1] = ek[1]; sel_e[tl * 4 + 2] = ek[2]; sel_e[tl * 4 + 3] = ek[3];
                *(f32x4*)(TOKW + (size_t)(m0 + tl) * 4) = (f32x4){inv, e1 * inv, e2 * inv, e3 * inv}; }
        }
        __syncthreads();
        { const int myE = sel_e[F.tid]; LAS unsigned long long* bm = (LAS unsigned long long*)(F.lds + X_SELR); unsigned long long mine = 0ull;
#pragma unroll
          for (int e = 0; e < 32; ++e) { const unsigned long long m = __ballot(myE == e); if (lane == e) mine = m; }
          if (lane < 32) bm[F.wave * 32 + lane] = mine;
          __syncthreads();
          int rk = __popcll(bm[F.wave * 32 + myE] & ((1ull << lane) - 1ull));
#pragma unroll
          for (int w = 0; w < 8; ++w) if (w < F.wave) rk += __popcll(bm[w * 32 + myE]);
          TOKINFO[(size_t)m0 * 4 + F.tid] = myE | (rk << 8);
          if (F.tid < 32) { int tot = 0;
#pragma unroll
              for (int w = 0; w < 8; ++w) tot += __popcll(bm[w * 32 + F.tid]);
              wsp<int>(F, WS_WGCNT)[((size_t)l * 256 + tb) * 32 + F.tid] = tot; if (tot && commit) (void)__hip_atomic_fetch_add(cntg + F.tid * 64, (unsigned)tot, RLX_AGENT); } }
        __syncthreads();
    }
}

__device__ __forceinline__ int moe_tables(Frame& F, int l) {
    const unsigned* cntg = wsp<unsigned>(F, WS_CTL) + CW_CNT + (size_t)l * NE * 64;
    LAS int* cnt_s = (LAS int*)(F.lds + X_CNTS); LAS int* off_s = (LAS int*)(F.lds + X_OFFS); LAS unsigned char* tile_e = (LAS unsigned char*)(F.lds + X_TILEE);
    if (F.tid < 32) cnt_s[F.tid] = (int)__hip_atomic_load(cntg + F.tid * 64, RLX_AGENT);
    __syncthreads();
    if (F.tid < 64) {
        const int e = F.tid & 31; const int c = (F.tid < 32) ? cnt_s[e] : 0; const int nt = (c + 255) >> 8; int incl = nt;
#pragma unroll
        for (int o = 1; o < 32; o <<= 1) { const int v = __shfl_up(incl, o); if ((F.tid & 63) >= o) incl += v; }
        if (F.tid < 32) { const int excl = incl - nt; off_s[e] = excl * 256; for (int t = 0; t < nt; ++t) tile_e[excl + t] = (unsigned char)e; if (e == 31) off_s[32] = incl * 256; }
    }
    __syncthreads();
    return off_s[32] >> 8;
}
__device__ __forceinline__ void phase_scat(Frame& F, int l) {
    (void)moe_tables(F, l);
    const LAS int* off_s = (const LAS int*)(F.lds + X_OFFS); const LAS int* cnt_s = (const LAS int*)(F.lds + X_CNTS); LAS int* base_s = (LAS int*)(F.lds + X_BASE);
    const int* TOKINFO = wsp<int>(F, WS_TOKINFO); const float* TOKW = wsp<float>(F, WS_TOKW);
    int* ROWTOK = wsp<int>(F, WS_ROWTOK); float* ROWW = wsp<float>(F, WS_ROWW); const int* WGC = wsp<int>(F, WS_WGCNT) + (size_t)l * 256 * 32; int* TOKINFO2 = wsp<int>(F, WS_TOKROW);
    for (int tb = F.vcu; tb < T / 128; tb += F.G) {
        if (F.tid < 32) base_s[F.tid] = 0;
        __syncthreads();
        { const int e = F.tid & 31, part = F.tid >> 5; int sacc = 0;
          for (int t2 = part * 16; t2 < part * 16 + 16; ++t2) if (t2 < tb) sacc += WGC[t2 * 32 + e];
          if (sacc) atomicAdd((int*)&base_s[e], sacc); }
        __syncthreads();
        { const size_t ent = (size_t)tb * 512 + F.tid; const int info = TOKINFO[ent]; const int e = info & 255, row = off_s[e] + base_s[e] + (info >> 8);
          ROWTOK[row] = (int)ent; ROWW[row] = TOKW[ent]; TOKINFO2[ent] = row; }
        __syncthreads();
    }
    if (F.vcu == 0) for (int e = 0; e < NE; ++e) for (int r = off_s[e] + cnt_s[e] + F.tid; r < off_s[e + 1]; r += 512) { ROWTOK[r] = 0; ROWW[r] = 0.f; }
}
__device__ __forceinline__ void phase_ln2(Frame& F, int l) {
    const bf16* X1 = wsp<bf16>(F, WS_YPRE); const bf16* YK = wsp<bf16>(F, WS_XG); bf16* H = wsp<bf16>(F, WS_H); const int* TOKROW = wsp<int>(F, WS_TOKROW); const float* TOKW = wsp<float>(F, WS_TOKW);
    const float* STAT = wsp<float>(F, WS_STAT); const float* l1g = F.in[I_LN1G] + l * D; const float* l1b = F.in[I_LN1B] + l * D;
    float* XO = F.out; bf16* XB = wsp<bf16>(F, WS_X2);
    const float* modl = wsp<float>(F, WS_MOD) + (size_t)l * 8 * 6144; const float* modn = wsp<float>(F, WS_MOD) + (size_t)((l + 1) & 3) * 8 * 6144;
    const float* lg = F.in[I_LN2G] + l * D; const float* lb = F.in[I_LN2B] + l * D;
    const int lane = F.lane; const int gw = F.vcu * 8 + F.wave, NGW = F.G * 8;
    v2u px[4]; v2u py[4][4]; float pst[2], nst[2]; f32x4 pw4, nw4;
#define LN2_LOAD(mm) do { nst[0] = STAT[(size_t)(mm) * 2]; nst[1] = STAT[(size_t)(mm) * 2 + 1]; nw4 = *(const f32x4*)(TOKW + (size_t)(mm) * 4); \
        int rw_[4]; _Pragma("unroll") for (int k = 0; k < 4; ++k) rw_[k] = TOKROW[(size_t)(mm) * 4 + k]; \
        _Pragma("unroll") for (int j = 0; j < 4; ++j) { px[j] = __builtin_nontemporal_load((const v2u*)(X1 + (size_t)(mm) * D) + lane + 64 * j); \
        _Pragma("unroll") for (int k = 0; k < 4; ++k) py[j][k] = __builtin_nontemporal_load((const v2u*)(YK + (size_t)rw_[k] * D) + lane + 64 * j); } } while (0)
    if (gw < T) LN2_LOAD(gw);
#pragma unroll 1
    for (int m = gw; m < T; m += NGW) { const int b = m >> 12; const float* mb = modl + (size_t)b * 6144; const float* mn = modn + (size_t)b * 6144;
        f32x4 v[4]; float s = 0.f; pst[0] = nst[0]; pst[1] = nst[1]; pw4 = nw4;
#pragma unroll
        for (int j = 0; j < 4; ++j) { f32x4 y = (f32x4){0.f, 0.f, 0.f, 0.f};
#pragma unroll
            for (int k = 0; k < 4; ++k) { const v2u w = py[j][k]; const float cw = pw4[k]; y[0] += cw * bflo(w.x); y[1] += cw * bfhi(w.x); y[2] += cw * bflo(w.y); y[3] += cw * bfhi(w.y); }
            const f32x4 g2 = *((const f32x4*)(mb + 5120) + lane + 64 * j) + 1.0f;
            const f32x4 pxf = (f32x4){bflo(px[j].x), bfhi(px[j].x), bflo(px[j].y), bfhi(px[j].y)};
            const f32x4 x1 = (pxf - pst[0]) * pst[1] * *((const f32x4*)l1g + lane + 64 * j) + *((const f32x4*)l1b + lane + 64 * j);
            v[j] = x1 * DN_ALPHA + g2 * y; s += (v[j][0] + v[j][1]) + (v[j][2] + v[j][3]); }
        if (m + NGW < T) LN2_LOAD(m + NGW);
        float s2 = 0.f;
#pragma unroll
        for (int j = 0; j < 4; ++j) s2 += (v[j][0] * v[j][0] + v[j][1] * v[j][1]) + (v[j][2] * v[j][2] + v[j][3] * v[j][3]);
#pragma unroll
        for (int o = 1; o < 64; o <<= 1) { s += __shfl_xor(s, o); s2 += __shfl_xor(s2, o); }
        const float mean = s * (1.0f / D); const float rstd = 1.0f / sqrtf(fmaxf(s2 * (1.0f / D) - mean * mean, 0.f) + LN_EPS);
#pragma unroll
        for (int j = 0; j < 4; ++j) v[j] = v[j] - mean;
        f32x4* xo = (f32x4*)(XO + (size_t)m * D) + lane; v2u* xb = (v2u*)(XB + (size_t)m * D) + lane; v2u* ho = (v2u*)(H + (size_t)m * D) + lane;
#pragma unroll
        for (int j = 0; j < 4; ++j) { const f32x4 gvj = *((const f32x4*)lg + lane + 64 * j), bvj = *((const f32x4*)lb + lane + 64 * j); const f32x4 x2 = v[j] * rstd * gvj + bvj;
            if (l == NL - 1) __builtin_nontemporal_store(x2, xo + 64 * j); else { v2u xq; xq.x = pk2(x2[0], x2[1]); xq.y = pk2(x2[2], x2[3]); __builtin_nontemporal_store(xq, xb + 64 * j); }
            if (l < NL - 1) { const f32x4 sh = *((const f32x4*)mn + lane + 64 * j), sc = *((const f32x4*)(mn + 1024) + lane + 64 * j) + 1.0f; const f32x4 h = x2 * sc + sh;
                v2u o; o.x = pk2(h[0], h[1]); o.y = pk2(h[2], h[3]); ho[64 * j] = o; } } }
#undef LN2_LOAD
}

#ifndef PH_MASK
#define PH_MASK 0xFFFF
#endif
#define PHM(b) ((PH_MASK >> (b)) & 1)
#ifndef DUP_MASK
#define DUP_MASK 0
#endif
#define REPS(b) (((DUP_MASK >> (b)) & 1) ? 2 : 1)
constexpr int NPH_L = 10, NPHASE = 2 + NL * NPH_L;
struct Args { const float* in[20]; float* out; unsigned char* ws; int ph_lo, ph_hi; };
__global__ void __launch_bounds__(512, 2) fwd(Args args) {
    extern __shared__ __attribute__((aligned(16))) unsigned char lds[];
    Frame F;
    F.lds = (LAS unsigned char*)lds;
#define FRESH() do { int zv_ = 0; asm volatile("" : "+v"(zv_)); const int z_ = __builtin_amdgcn_readfirstlane(zv_); \
        F.tid = (int)threadIdx.x + zv_; F.lane = F.tid & 63; F.wave = __builtin_amdgcn_readfirstlane(F.tid >> 6); \
        F.G = (int)gridDim.x + z_; F.bx = (int)blockIdx.x + z_; F.vcu = (F.G % 8 == 0) ? (F.bx % 8) * (F.G / 8) + F.bx / 8 : F.bx; \
        F.ws = args.ws + z_; F.in = args.in + z_; F.out = args.out + z_; F.lds = (LAS unsigned char*)lds + z_; } while (0)
    FRESH();
    for (int u = F.tid; u < (LDS_BYTES - XOFF) / 4; u += 512) ((LAS unsigned*)(F.lds + XOFF))[u] = 0u;
    __syncthreads();
    unsigned* ctl = wsp<unsigned>(F, WS_CTL);
    XcdBarrier bar; bar.bar = ctl + CW_BAR; bar.x = 0; bar.st = nullptr;
    if (!MK_PER_PHASE) bar = xcd_barrier_post(ctl + CW_BAR, (volatile LAS unsigned*)(F.lds + X_MISC) + 8);
    const int lo = args.ph_lo, hi = args.ph_hi;
#define IN(k) (lo <= (k) && (k) < hi)
#ifndef BAR_REPS
#define BAR_REPS 1
#endif
#define SEAM(k) do { if (!MK_PER_PHASE && IN(k) && IN((k) + 1)) for (int br_ = 0; br_ < BAR_REPS; ++br_) xcd_barrier(bar); } while (0)

    if (PHM(0) && IN(0)) for (int rep = 0; rep < REPS(0); ++rep) { FRESH(); phase_pro_a(F); } SEAM(0);
    if (PHM(1) && IN(1)) for (int rep = 0; rep < REPS(1); ++rep) { FRESH(); phase_pro_b(F); } SEAM(1);
    for (int l = 0; l < NL; ++l) {
        const int pb = 2 + l * NPH_L;
        if (PHM(2) && IN(pb + 0)) for (int rep = 0; rep < REPS(2); ++rep) { FRESH();
            pg8::Gemm g{wsp<bf16>(F, WS_H), wsp<bf16>(F, WS_WIN) + (size_t)l * NIN * D, T, NIN, D}; pg8::StaticOrder S; S.init(T, NIN, F.G, F.bx);
            EpiIn E{wsp<bf16>(F, WS_U), wsp<bf16>(F, WS_V), wsp<bf16>(F, WS_Q), wsp<bf16>(F, WS_K), wsp<bf16>(F, WS_VV), wsp<bf16>(F, WS_G), wsp<float>(F, WS_ROPE)};
            stagger(F.bx >> 3, STAG_US);
            pg8::gemm_phase<EpiIn, pg8::StaticOrder, PG8_ALIGN, PG8_SP2>(F.lds, g, S, E, F.tid);
#if defined(XPROBE)
            { FRESH(); pg8::Gemm g2{wsp<bf16>(F, WS_H), wsp<bf16>(F, WS_WIN) + (size_t)l * NIN * D, T, NIN, D}; pg8::StaticOrder S2; S2.init(T, NIN, F.G, F.bx);
              EpiProbe E2{wsp<bf16>(F, WS_XG), (XPROBE == 3) ? NIN : 1024, (XPROBE >= 2) ? (XPROBE == 3 ? 3 : 1) : (F.G == 0x7ffffff0 ? 1 : 0)};
              pg8::gemm_phase<EpiProbe, pg8::StaticOrder, PG8_ALIGN, PG8_SP2>(F.lds, g2, S2, E2, F.tid); }
#endif
        } SEAM(pb + 0);
        if (PHM(3) && IN(pb + 1)) for (int rep = 0; rep < REPS(3); ++rep) { FRESH(); phase_attn(F); } SEAM(pb + 1);
        if (PHM(4) && IN(pb + 2)) for (int rep = 0; rep < REPS(4); ++rep) { FRESH(); phase_sg(F, l); } SEAM(pb + 2);
        if (PHM(5) && IN(pb + 3)) for (int rep = 0; rep < REPS(5); ++rep) { FRESH();
            pg8::Gemm g{wsp<bf16>(F, WS_TT), wsp<bf16>(F, WS_WBA) + (size_t)l * D * 1536, T, D, 1536}; pg8::StaticOrder S; S.init(T, D, F.G, F.bx);
            EpiMg2 E{wsp<bf16>(F, WS_G), wsp<bf16>(F, WS_MG)}; pg8::gemm_phase<EpiMg2, pg8::StaticOrder, PG8_ALIGN, PG8_SP2>(F.lds, g, S, E, F.tid);
        } SEAM(pb + 3);
        if (PHM(6) && IN(pb + 4)) for (int rep = 0; rep < REPS(6); ++rep) { FRESH();
            pg8::Gemm g{wsp<bf16>(F, WS_MG), wsp<bf16>(F, WS_WOUT) + (size_t)l * D * D, T, D, D}; pg8::StaticOrder S; S.init(T, D, F.G, F.bx);
            if (l == 0) { EpiOut<true> E{(const void*)F.in[I_X], wsp<float>(F, WS_MOD) + (size_t)l * 8 * 6144, wsp<bf16>(F, WS_YPRE)}; pg8::gemm_phase<EpiOut<true>, pg8::StaticOrder, PG8_ALIGN, PG8_SP2>(F.lds, g, S, E, F.tid); }
            else { EpiOut<false> E{(const void*)wsp<bf16>(F, WS_X2), wsp<float>(F, WS_MOD) + (size_t)l * 8 * 6144, wsp<bf16>(F, WS_YPRE)}; pg8::gemm_phase<EpiOut<false>, pg8::StaticOrder, PG8_ALIGN, PG8_SP2>(F.lds, g, S, E, F.tid); }
        } SEAM(pb + 4);
        if (PHM(7) && IN(pb + 5)) for (int rep = 0; rep < REPS(7); ++rep) { FRESH(); phase_ln1(F, l, rep == 0); } SEAM(pb + 5);
        if (PHM(8) && IN(pb + 6)) for (int rep = 0; rep < REPS(8); ++rep) { FRESH(); phase_scat(F, l); } SEAM(pb + 6);
        if (PHM(9) && IN(pb + 7)) for (int rep = 0; rep < REPS(9); ++rep) { FRESH();
            const int RT = moe_tables(F, l);
            pg8::Gemm g{wsp<bf16>(F, WS_H), wsp<bf16>(F, WS_WUP) + (size_t)l * NE * 2048 * D, RT * 256, NE * 2048, D};
            MoeGatherOrder S; S.init(RT, 8, F.G, F.bx, (const LAS unsigned char*)(F.lds + X_TILEE)); S.tokl = (const LAS unsigned short*)(F.lds + X_TOKL);
            { const int* rowtok = wsp<int>(F, WS_ROWTOK); LAS unsigned short* tl = (LAS unsigned short*)(F.lds + X_TOKL); pg8::Unit uu;
              for (int i = 0; i < TOKL_UNITS && S.next(i, uu); ++i) if (F.tid < 256) tl[i * 256 + F.tid] = (unsigned short)(rowtok[uu.pm * 256 + F.tid] >> 2);
              __syncthreads(); }
            EpiUp E{F.in[I_BUP] + (size_t)l * NE * 2048, wsp<bf16>(F, WS_ACT)};
            stagger(F.bx >> 3, STAG_US);
            pg8::gemm_phase<EpiUp, MoeGatherOrder, PG8_ALIGN, true>(F.lds, g, S, E, F.tid);
        } SEAM(pb + 7);
        if (PHM(10) && IN(pb + 8)) for (int rep = 0; rep < REPS(10); ++rep) { FRESH();
            const int RT = moe_tables(F, l);
            pg8::Gemm g{wsp<bf16>(F, WS_ACT), wsp<bf16>(F, WS_WDN) + (size_t)l * NE * D * FF, RT * 256, NE * D, FF};
            MoeOrder S; S.init(RT, 4, F.G, F.bx, (const LAS unsigned char*)(F.lds + X_TILEE), 1);
            EpiDn E{F.in[I_BDN] + (size_t)l * NE * D, wsp<bf16>(F, WS_XG)};
            stagger(F.bx >> 3, STAG_US);
            pg8::gemm_phase<EpiDn, MoeOrder, PG8_ALIGN, PG8_SP2>(F.lds, g, S, E, F.tid);
        } SEAM(pb + 8);
        if (PHM(11) && IN(pb + 9)) for (int rep = 0; rep < REPS(11); ++rep) { FRESH(); phase_ln2(F, l); } SEAM(pb + 9);
    }
#undef IN
#undef SEAM
#undef FRESH
}

extern "C" void kernel_launch(void* const* d_in, const int* in_sizes, int n_in, void* d_out, int out_size, void* d_ws, size_t ws_size, hipStream_t stream) {
    static int grid = 0;
    if (grid == 0) {
        if (n_in != 20 || out_size != T * D || ws_size < WS_END) { fprintf(stderr, "kernel_launch: unexpected shapes (n_in %d, out %d, ws %zu < %zu)\n", n_in, out_size, ws_size, (size_t)WS_END); grid = -1; return; }
        int dev = 0, cus = 0;
        if (hipGetDevice(&dev) != hipSuccess || hipDeviceGetAttribute(&cus, hipDeviceAttributeMultiprocessorCount, dev) != hipSuccess) { grid = -1; return; }
        if (hipFuncSetAttribute((const void*)fwd, hipFuncAttributeMaxDynamicSharedMemorySize, LDS_BYTES) != hipSuccess) { fprintf(stderr, "kernel_launch: hipFuncSetAttribute failed\n"); grid = -1; return; }
        int per_cu = 0;
        if (hipOccupancyMaxActiveBlocksPerMultiprocessor(&per_cu, (const void*)fwd, 512, LDS_BYTES) != hipSuccess || per_cu < 1) fprintf(stderr, "kernel_launch: occupancy query says %d blocks per CU\n", per_cu);
        (void)hipGetLastError();
        grid = cus;
    }
    if (grid < 0) return;
    (void)in_sizes;
    if (hipMemsetAsync((char*)d_ws + WS_CTL, 0, CTL_ZERO_BYTES, stream) != hipSuccess) return;
    Args a{};
    for (int i = 0; i < 20; ++i) a.in[i] = (const float*)d_in[i];
    a.out = (float*)d_out; a.ws = (unsigned char*)d_ws;
#if MK_PER_PHASE
    for (int p = 0; p < NPHASE; ++p) { a.ph_lo = p; a.ph_hi = p + 1; hipLaunchKernelGGL(fwd, dim3(grid), dim3(512), LDS_BYTES, stream, a); }
#else
    a.ph_lo = 0; a.ph_hi = NPHASE;
    hipLaunchKernelGGL(fwd, dim3(grid), dim3(512), LDS_BYTES, stream, a);
#endif
    const hipError_t le = hipPeekAtLastError();
    if (le != hipSuccess) fprintf(stderr, "kernel_launch: launch failed: %s\n", hipGetErrorName(le));
}
```

```cpp
#include <hip/hip_runtime.h>
#include <cstdio>
#include <cstdint>
#ifndef MK_PER_PHASE
#define MK_PER_PHASE 0
#endif
namespace pg8 {
#define PG8_LAS __attribute__((address_space(3)))
typedef unsigned short bf16_t;
typedef short bf16x8 __attribute__((ext_vector_type(8)));
typedef float f32x4 __attribute__((ext_vector_type(4)));
typedef unsigned u32x4 __attribute__((ext_vector_type(4)));
constexpr int BM = 256, BK = 64, HALF = 128, HTB = HALF * BK * 2  , STAGE_BYTES = 8 * HTB, NXCD = 8;
#ifndef PG8_WGM
#define PG8_WGM 8
#endif
constexpr int WGM = PG8_WGM;

__host__ __device__ __forceinline__ int lds_byte(int r, int c) { const int st = (r >> 4) * 2 + (c >> 5), rr = r & 15, cc = c & 31, ob = rr * 64 + cc * 2; return st * 1024 + (ob ^ (((ob >> 9) & 1) << 5)); }
__host__ __device__ __forceinline__ void stage_rc(int b, int& R, int& C) { const int st = b / 1024, sb = b % 1024, swz = sb ^ (((sb >> 9) & 1) << 5); R = (st >> 1) * 16 + swz / 64; C = (st & 1) * 32 + (swz % 64) / 2; }
__host__ __device__ __forceinline__ int perm32(int rho) { const int n = rho >> 4, i = rho & 15; return 8 * (i >> 2) + 4 * n + (i & 3); }

struct Unit { int pm, pn; };
struct Gemm { const bf16_t* A; const bf16_t* Bt; int M, N, K; };

struct StaticOrder {
    static constexpr bool GATHER = false; __device__ __forceinline__ int arow(int, int r) const { return r; }
    int nM, nN, nwg, G, c;
    __host__ __device__ void init(int M, int N, int G_, int c_) { nM = M / BM; nN = N / BM; nwg = nM * nN; G = G_; c = c_; }
    __host__ __device__ bool next(int i, Unit& u) const {
        const long L = (long)i * G + c; if (L >= nwg) return false;
        int wgid = (int)L; { const int q = nwg / NXCD, r = nwg % NXCD, xcd = wgid % NXCD, off = wgid / NXCD; wgid = (xcd < r ? xcd * (q + 1) : r * (q + 1) + (xcd - r) * q) + off; }
        const int nig = WGM * nN, gid = wgid / nig, fm = gid * WGM, gsz = (nM - fm) < WGM ? (nM - fm) : WGM;
        u.pm = fm + ((wgid % nig) % gsz); u.pn = (wgid % nig) / gsz; return true;
    }
    __device__ __forceinline__ void a_ready(const Unit&) const {}
    __device__ __forceinline__ void done(const Unit&) const {}
};

__device__ __forceinline__ unsigned cvt_pk_bf16(float lo, float hi) { unsigned r; asm volatile("v_cvt_pk_bf16_f32 %0, %1, %2" : "=v"(r) : "v"(lo), "v"(hi)); return r; }
typedef float f32x2 __attribute__((ext_vector_type(2)));

template <class Epi, class Sched, bool ALIGN_EPI = false, bool SP2 = false>
__device__ __forceinline__ void gemm_phase(PG8_LAS unsigned char* lds, const Gemm g, const Sched& S, const Epi& E, const int tid_in) {
    const int tid = tid_in, wid = __builtin_amdgcn_readfirstlane(tid >> 6), lane = tid & 63, wr = wid >> 2, wc = wid & 3, fr = lane & 15, fq = lane >> 4;
    const int K = g.K, nt = K / BK;
    unsigned voffA[2], voffB[2];
#pragma unroll
    for (int i = 0; i < 2; ++i) { int R, C; stage_rc(tid * 16 + i * 8192, R, C); const int Rb = Epi::BADJ ? (64 * (R >> 5) + perm32(R & 31)) : Epi::PERM ? ((R & ~31) + perm32(R & 31)) : R;
        voffA[i] = (unsigned)(R * K + C) * 2u; voffB[i] = (unsigned)(Rb * K + C) * 2u; }
    const size_t kstep = (size_t)(BK * 2);
    const size_t hstep = (size_t)HALF * K * 2;
    const size_t tstep = 2 * hstep;
    const size_t bhstep = Epi::BADJ ? (size_t)32 * K * 2 : hstep;
    const unsigned ldsw = (unsigned)wid * 1024u;
    const int aoff = lds_byte(wr * 64 + fr, fq * 8), boff = lds_byte(wc * 32 + fr, fq * 8);
#define PG8_SA(b, h) (((b) * 2 + (h)) * HTB)
#define PG8_SB(b, h) ((4 + (b) * 2 + (h)) * HTB)
    unsigned gc[2][2], gn[2][2];
#define PG8_GOFF(dst, pmv, ordv) do { if constexpr (Sched::GATHER) { _Pragma("unroll") for (int _h = 0; _h < 2; ++_h) _Pragma("unroll") for (int _i = 0; _i < 2; ++_i) { int _R, _C; stage_rc(tid * 16 + _i * 8192, _R, _C); \
        dst[_h][_i] = (unsigned)S.arow((ordv), (pmv) * 256 + _h * 128 + _R) * (unsigned)(K * 2) + (unsigned)(_C * 2); } } } while (0)
#define PG8_STAGE_A(bufoff, origptr, nextf, hh, kbytes) do { if constexpr (Sched::GATHER) { _Pragma("unroll") for (int _i = 0; _i < 2; ++_i) { const unsigned _o = (nextf) ? gn[hh][_i] : gc[hh][_i]; \
        __builtin_amdgcn_global_load_lds((const unsigned*)((const char*)g.A + (kbytes) + _o), (PG8_LAS unsigned*)(lds + (bufoff) + ldsw + _i * 8192), 16, 0, 0); } } else { PG8_STAGE(bufoff, origptr, voffA); } } while (0)
#define PG8_STAGE(bufoff, gbase, voff) do { _Pragma("unroll") for (int _i = 0; _i < 2; ++_i) \
        __builtin_amdgcn_global_load_lds((const unsigned*)((const char*)(gbase) + (voff)[_i]), (PG8_LAS unsigned*)(lds + (bufoff) + ldsw + _i * 8192), 16, 0, 0); } while (0)
#define PG8_LDA(dst, b, h) do { _Pragma("unroll") for (int m = 0; m < 4; ++m) _Pragma("unroll") for (int k = 0; k < 2; ++k) dst[m][k] = *(const PG8_LAS bf16x8*)(lds + PG8_SA(b, h) + aoff + m * 2048 + k * 1024); } while (0)
#define PG8_LDB(dst, b, h) do { _Pragma("unroll") for (int n = 0; n < 2; ++n) _Pragma("unroll") for (int k = 0; k < 2; ++k) dst[n][k] = *(const PG8_LAS bf16x8*)(lds + PG8_SB(b, h) + boff + n * 2048 + k * 1024); } while (0)
#define PG8_MMA(ai, bj, At, Bt) do { __builtin_amdgcn_s_setprio(1); _Pragma("unroll") for (int m = 0; m < 4; ++m) _Pragma("unroll") for (int n = 0; n < 2; ++n) _Pragma("unroll") for (int k = 0; k < 2; ++k) \
        acc[ai][bj][m][n] = __builtin_amdgcn_mfma_f32_16x16x32_bf16(Bt[n][k], At[m][k], acc[ai][bj][m][n], 0, 0, 0); __builtin_amdgcn_s_setprio(0); } while (0)
#define PG8_WAIT_V(n) asm volatile("s_waitcnt vmcnt(" #n ")" ::: "memory")
#define PG8_WAIT_L(n) asm volatile("s_waitcnt lgkmcnt(" #n ")" ::: "memory")
#define PG8_BAR __builtin_amdgcn_s_barrier()
#define PG8_SCHED __builtin_amdgcn_sched_barrier(0)
    Unit cur, nxt; int ui = 0;
    if (!S.next(0, cur)) return;
    f32x4 acc[2][2][4][2];
#pragma unroll
    for (int a = 0; a < 2; ++a)
#pragma unroll
        for (int b = 0; b < 2; ++b)
#pragma unroll
            for (int m = 0; m < 4; ++m)
#pragma unroll
                for (int n = 0; n < 2; ++n) acc[a][b][m][n] = (f32x4){0.f, 0.f, 0.f, 0.f};
    bf16x8 At[4][2], B0[2][2], B1[2][2];
    const char* cA = (const char*)g.A + (size_t)cur.pm * tstep; const char* cB = (const char*)g.Bt + (size_t)cur.pn * tstep;
    S.a_ready(cur);
    PG8_GOFF(gc, cur.pm, 0);
    if constexpr (SP2) {
        PG8_STAGE(PG8_SB(0, 0), cB, voffB); PG8_STAGE(PG8_SB(0, 1), cB + bhstep, voffB); PG8_STAGE_A(PG8_SA(0, 0), cA, false, 0, 0); PG8_STAGE_A(PG8_SA(0, 1), cA + hstep, false, 1, 0);
        if (wr == 1) PG8_BAR;
        PG8_WAIT_V(2); PG8_BAR;
        PG8_STAGE(PG8_SB(1, 0), cB + kstep, voffB); PG8_STAGE_A(PG8_SA(1, 0), cA + kstep, false, 0, kstep); PG8_STAGE(PG8_SB(1, 1), cB + bhstep + kstep, voffB);
        PG8_WAIT_V(6); PG8_BAR;
    } else {
        PG8_STAGE(PG8_SB(0, 0), cB, voffB); PG8_STAGE(PG8_SA(0, 0), cA, voffA); PG8_STAGE(PG8_SB(0, 1), cB + bhstep, voffB); PG8_STAGE(PG8_SA(0, 1), cA + hstep, voffA);
        if (wr == 1) PG8_BAR;
        PG8_WAIT_V(4); PG8_BAR;
        PG8_STAGE(PG8_SB(1, 0), cB + kstep, voffB); PG8_STAGE(PG8_SA(1, 0), cA + kstep, voffA); PG8_STAGE(PG8_SB(1, 1), cB + bhstep + kstep, voffB);
        PG8_WAIT_V(6); PG8_BAR;
    }
    for (;;) {
        const bool has_next = S.next(ui + 1, nxt);
        if constexpr (Sched::GATHER) { if (has_next) { PG8_GOFF(gn, nxt.pm, ui + 1); } else { gn[0][0] = gc[0][0]; gn[0][1] = gc[0][1]; gn[1][0] = gc[1][0]; gn[1][1] = gc[1][1]; } }
        const char* nA = has_next ? (const char*)g.A + (size_t)nxt.pm * tstep : cA; const char* nB = has_next ? (const char*)g.Bt + (size_t)nxt.pn * tstep : cB;
#pragma unroll
        for (int seg = 0; seg < (Epi::MID_T > 0 ? 2 : 1); ++seg) {
        if constexpr (Epi::MID_T > 0) { if (seg == 1) { PG8_SCHED; E.mid(acc, cur, wr, wc, fr, fq); PG8_SCHED; } }
        const int t_lo = seg ? Epi::MID_T : 0, t_hi = (Epi::MID_T > 0 && seg == 0) ? Epi::MID_T : nt;
        for (int t = t_lo; t < t_hi; t += 2) {
            const bool last = (t == nt - 2);
            const char* a1 = cA + (size_t)(t + 1) * kstep;
            const char* a2 = last ? nA : cA + (size_t)(t + 2) * kstep; const char* b2 = last ? nB : cB + (size_t)(t + 2) * kstep;
            const char* a3 = a2 + kstep; const char* b3 = b2 + kstep; const size_t k2b = last ? (size_t)0 : (size_t)(t + 2) * kstep;
            if (last && has_next) S.a_ready(nxt);
            if constexpr (SP2) {
            PG8_LDB(B0, 0, 0); PG8_LDB(B1, 0, 1); PG8_SCHED; PG8_LDA(At, 0, 0); PG8_STAGE_A(PG8_SA(1, 1), a1 + hstep, false, 1, (size_t)(t + 1) * kstep);
            PG8_WAIT_V(8); PG8_WAIT_L(0); PG8_BAR; PG8_MMA(0, 0, At, B0); PG8_MMA(0, 1, At, B1); PG8_BAR; PG8_SCHED;
            PG8_LDA(At, 0, 1); PG8_STAGE(PG8_SB(0, 0), b2, voffB); PG8_STAGE(PG8_SB(0, 1), b2 + bhstep, voffB); PG8_STAGE_A(PG8_SA(0, 0), a2, last, 0, k2b);
            PG8_WAIT_V(8); PG8_WAIT_L(0); PG8_BAR; PG8_MMA(1, 0, At, B0); PG8_MMA(1, 1, At, B1); PG8_BAR; PG8_SCHED;
            PG8_LDB(B0, 1, 0); PG8_LDB(B1, 1, 1); PG8_SCHED; PG8_LDA(At, 1, 0); PG8_STAGE_A(PG8_SA(0, 1), a2 + hstep, last, 1, k2b);
            PG8_WAIT_V(8); PG8_WAIT_L(0); PG8_BAR; PG8_MMA(0, 0, At, B0); PG8_MMA(0, 1, At, B1); PG8_BAR; PG8_SCHED;
            PG8_LDA(At, 1, 1); PG8_STAGE(PG8_SB(1, 0), b3, voffB); PG8_STAGE(PG8_SB(1, 1), b3 + bhstep, voffB); PG8_STAGE_A(PG8_SA(1, 0), a3, last, 0, k2b + kstep);
            PG8_WAIT_V(8); PG8_WAIT_L(0); PG8_BAR; PG8_MMA(1, 0, At, B0); PG8_MMA(1, 1, At, B1); PG8_BAR; PG8_SCHED;
            } else {
            PG8_LDB(B0, 0, 0); PG8_SCHED; PG8_LDA(At, 0, 0); PG8_STAGE(PG8_SA(1, 1), a1 + hstep, voffA);
            PG8_WAIT_L(8); PG8_BAR; PG8_WAIT_L(0); PG8_MMA(0, 0, At, B0); PG8_BAR; PG8_SCHED;
            PG8_LDB(B1, 0, 1); PG8_STAGE(PG8_SB(0, 0), b2, voffB);
            PG8_BAR; PG8_WAIT_L(0); PG8_MMA(0, 1, At, B1); PG8_BAR;
            PG8_LDA(At, 0, 1); PG8_STAGE(PG8_SA(0, 0), a2, voffA);
            PG8_BAR; PG8_WAIT_L(0); PG8_MMA(1, 0, At, B0); PG8_BAR; PG8_SCHED;
            PG8_STAGE(PG8_SB(0, 1), b2 + bhstep, voffB);
            PG8_WAIT_V(6); PG8_BAR; PG8_MMA(1, 1, At, B1); PG8_BAR;
            PG8_LDB(B0, 1, 0); PG8_SCHED; PG8_LDA(At, 1, 0); PG8_STAGE(PG8_SA(0, 1), a2 + hstep, voffA);
            PG8_WAIT_L(8); PG8_BAR; PG8_WAIT_L(0); PG8_MMA(0, 0, At, B0); PG8_BAR; PG8_SCHED;
            PG8_LDB(B1, 1, 1); PG8_STAGE(PG8_SB(1, 0), b3, voffB);
            PG8_BAR; PG8_WAIT_L(0); PG8_MMA(0, 1, At, B1); PG8_BAR;
            PG8_LDA(At, 1, 1); PG8_STAGE(PG8_SA(1, 0), a3, voffA);
            PG8_BAR; PG8_WAIT_L(0); PG8_MMA(1, 0, At, B0); PG8_BAR; PG8_SCHED;
            PG8_STAGE(PG8_SB(1, 1), b3 + bhstep, voffB);
            PG8_WAIT_V(6); PG8_BAR; PG8_MMA(1, 1, At, B1); PG8_BAR;
            }
        }
        }
        if constexpr (ALIGN_EPI) { if (wr == 0) PG8_BAR; }
        if constexpr (!Epi::AFTER_DRAIN) { E(acc, cur, wr, wc, fr, fq); S.done(cur); }
        if (!has_next) break;
#pragma unroll
        for (int a = 0; a < 2; ++a)
#pragma unroll
            for (int b = 0; b < 2; ++b)
#pragma unroll
                for (int m = 0; m < 4; ++m)
#pragma unroll
                    for (int n = 0; n < 2; ++n) acc[a][b][m][n] = (f32x4){0.f, 0.f, 0.f, 0.f};
        cur = nxt; cA = nA; cB = nB; ++ui;
        if constexpr (Sched::GATHER) { gc[0][0] = gn[0][0]; gc[0][1] = gn[0][1]; gc[1][0] = gn[1][0]; gc[1][1] = gn[1][1]; }
        if constexpr (ALIGN_EPI) { if (wr == 1) PG8_BAR; }
    }
    PG8_WAIT_V(0);
    if constexpr (!ALIGN_EPI) { if (wr == 0) PG8_BAR; }
    PG8_BAR;
    if constexpr (Epi::AFTER_DRAIN) { E.fused(acc, cur, wr, wc, fr, fq, lds, wid, lane); S.done(cur); }
#undef PG8_SA
#undef PG8_SB
#undef PG8_STAGE
#undef PG8_STAGE_A
#undef PG8_GOFF
#undef PG8_LDA
#undef PG8_LDB
#undef PG8_MMA
#undef PG8_WAIT_V
#undef PG8_WAIT_L
#undef PG8_BAR
#undef PG8_SCHED
}
}
#define LAS __attribute__((address_space(3)))
#define XB_TMO      128
#define XB_XCNT(j)  (256  + 64 * (j))
#define XB_XSUB(j)  (1280 + 64 * (j))
#define XB_XGEN(j)  (2304 + 64 * (j))
#define XB_TOP      3328
#define XB_TOPGEN   3392
#define XCD_BAR_WORDS 3456
#define XB_SPIN_CAP (1u << 18)

__device__ __forceinline__ unsigned xb_ld(unsigned* p)              { return __hip_atomic_load(p, __ATOMIC_RELAXED, __HIP_MEMORY_SCOPE_AGENT); }
__device__ __forceinline__ unsigned xb_add(unsigned* p, unsigned v) { return __hip_atomic_fetch_add(p, v, __ATOMIC_RELAXED, __HIP_MEMORY_SCOPE_AGENT); }
__device__ __forceinline__ unsigned xb_xcc_id() { return (unsigned)__builtin_amdgcn_s_getreg((3 << 11) | 20) & 0xFu; }
#define XB_SPIN(cond, bar) do { unsigned _sp = 0; while (cond) { __builtin_amdgcn_s_sleep(1); \
    if ((++_sp & 255u) == 0u) { if (xb_ld(&(bar)[XB_TMO])) break; if (_sp > XB_SPIN_CAP) { atomicAdd(&(bar)[XB_TMO], 1u); break; } } } } while (0)

struct XcdBarrier {
    unsigned* bar; unsigned x;
    volatile LAS unsigned* st;
};

__device__ __forceinline__ XcdBarrier xcd_barrier_post(unsigned* bar, volatile LAS unsigned* st) {
    XcdBarrier b; b.bar = bar; b.x = xb_xcc_id(); b.st = st;
    if (threadIdx.x == 0) (void)xb_add(&bar[XB_XCNT(b.x)], 1u);
    return b;
}
__device__ __forceinline__ void xcd_barrier_complete(unsigned* bar, unsigned x, unsigned& nloc, unsigned& nx) {
    const unsigned G = gridDim.x * gridDim.y * gridDim.z;
    unsigned sum, cnt, mine, sp = 0u;
    for (;;) {
        sum = 0u; cnt = 0u; mine = 0u;
#pragma unroll
        for (unsigned j = 0; j < 16; ++j) { const unsigned c = xb_ld(&bar[XB_XCNT(j)]); sum += c; cnt += (c > 0u) ? 1u : 0u; mine = (j == x) ? c : mine; }
        if (sum == G) break;
        __builtin_amdgcn_s_sleep(1);
        if ((++sp & 255u) == 0u) { if (xb_ld(&bar[XB_TMO])) break; if (sp > XB_SPIN_CAP) { atomicAdd(&bar[XB_TMO], 1u); break; } }
    }
    nloc = mine > 0u ? mine : 1u; nx = cnt > 0u ? cnt : 1u;
}

__device__ __forceinline__ void xcd_barrier(const XcdBarrier& b) {
    asm volatile("s_waitcnt vmcnt(0)" ::: "memory");
    __syncthreads();
    if (threadIdx.x == 0) {
        unsigned* bar = b.bar;
        __builtin_amdgcn_s_waitcnt(0);
        unsigned nloc = b.st[0], nx = b.st[1];
        if (nloc == 0u) { xcd_barrier_complete(bar, b.x, nloc, nx); b.st[0] = nloc; b.st[1] = nx; }
        const unsigned old = xb_add(&bar[XB_XSUB(b.x)], 1u);
        const unsigned gen = old / nloc;
        if (old + 1u == (gen + 1u) * nloc) {
            __builtin_amdgcn_fence(__ATOMIC_RELEASE, "agent");
            asm volatile("s_waitcnt vmcnt(0)" ::: "memory");
            const unsigned og = xb_add(&bar[XB_TOP], 1u);
            const unsigned tg = og / nx;
            if (og + 1u == (tg + 1u) * nx) xb_add(&bar[XB_TOPGEN], 1u);
            else XB_SPIN(xb_ld(&bar[XB_TOPGEN]) == tg, bar);
            __builtin_amdgcn_fence(__ATOMIC_ACQUIRE, "agent");
            xb_add(&bar[XB_XGEN(b.x)], 1u);
            asm volatile("s_waitcnt vmcnt(0)" ::: "memory");
        } else {
            XB_SPIN(xb_ld(&bar[XB_XGEN(b.x)]) == gen, bar);
            __builtin_amdgcn_fence(__ATOMIC_ACQUIRE, "agent");
            asm volatile("s_waitcnt vmcnt(0)" ::: "memory");
        }
    }
    __syncthreads();
}


#ifndef PG8_SP2
#define PG8_SP2 true
#endif
#ifndef PG8_ALIGN
#define PG8_ALIGN true
#endif
constexpr int D = 1024, NB = 8, SEQ = 4096, T = NB * SEQ, NL = 4;
constexpr int NIN = 8704, NE = 32, FF = 1024;
constexpr int RMAX = 139264;
constexpr float LN_EPS = 1e-5f, DN_ALPHA = 1.681792830507429f;
constexpr float QSCALE = 0.18033688011112042f;
constexpr float LOG2E = 1.4426950408889634f;

constexpr size_t MiB = 1u << 20;
constexpr size_t WS_CTL = 0, CTL_ZERO_BYTES = 1 * MiB;
constexpr size_t WS_MOD = 1 * MiB;
constexpr size_t WS_ROPE = 2 * MiB;
constexpr size_t WS_WSP = 3 * MiB;
constexpr size_t WS_WRT = 4 * MiB;
constexpr size_t WS_TOKINFO = 5 * MiB;
constexpr size_t WS_TOKW = 5 * MiB + 512 * 1024;
constexpr size_t WS_ROWTOK = 6 * MiB;
constexpr size_t WS_ROWW = 7 * MiB;
constexpr size_t WS_LSE = 8 * MiB;
constexpr size_t WS_TOKROW = 14 * MiB;
constexpr size_t WS_STAT = 13 * MiB;
constexpr size_t WS_WGCNT = 12 * MiB;
constexpr size_t WS_WIN = 16 * MiB;
constexpr size_t WS_WBA = 84 * MiB;
constexpr size_t WS_WBB = 92 * MiB;
constexpr size_t WS_WOUT = 96 * MiB;
constexpr size_t WS_WUP = 104 * MiB;
constexpr size_t WS_WDN = 616 * MiB;
constexpr size_t WS_H = 872 * MiB;
constexpr size_t WS_X1 = 936 * MiB;
constexpr size_t WS_X2 = 1064 * MiB;
constexpr size_t WS_YPRE = 1192 * MiB;
constexpr size_t WS_U = 1320 * MiB, WS_V = 1384 * MiB;
constexpr size_t WS_Q = 1448 * MiB, WS_K = 1544 * MiB, WS_VV = 1640 * MiB;
constexpr size_t WS_G = 1736 * MiB;
constexpr size_t WS_OG = 1864 * MiB;
constexpr size_t WS_TT = 1960 * MiB;
constexpr size_t WS_OB = 2024 * MiB;
constexpr size_t WS_YA = 2056 * MiB;
constexpr size_t WS_MG = 2120 * MiB;
constexpr size_t WS_XG = 2184 * MiB;
constexpr size_t WS_ACT = 2456 * MiB;
constexpr size_t WS_YK = 2728 * MiB;
constexpr size_t WS_END = 2984 * MiB;
constexpr int CW_BAR = 4096;
constexpr int CW_CNT = 16384;

constexpr int RING_BYTES = 131072;
constexpr int XOFF = RING_BYTES;
constexpr int X_MISC = XOFF;
constexpr int X_SELE = XOFF + 256;
constexpr int X_SELR = XOFF + 2304;
constexpr int X_CNTL = XOFF + 4352;
constexpr int X_BASE = XOFF + 4480;
constexpr int X_TILEE = XOFF + 4608;
constexpr int X_CNTS = XOFF + 5632;
constexpr int X_OFFS = XOFF + 5760;
constexpr int LDS_BYTES = 147456;

#define GAS __attribute__((address_space(1)))
typedef unsigned short bf16;
typedef unsigned v4u __attribute__((ext_vector_type(4)));
typedef unsigned v2u __attribute__((ext_vector_type(2)));
typedef float f32x4 __attribute__((ext_vector_type(4)));
typedef short bf16x8 __attribute__((ext_vector_type(8)));
typedef short s16x4 __attribute__((ext_vector_type(4)));
#define RLX_AGENT __ATOMIC_RELAXED, __HIP_MEMORY_SCOPE_AGENT
#define LDS_WAIT() asm volatile("s_waitcnt lgkmcnt(0)" ::: "memory")
#define VM_WAIT() asm volatile("s_waitcnt vmcnt(0)" ::: "memory")

typedef __bf16 bf16x2_t __attribute__((ext_vector_type(2))); typedef float f32x2_t __attribute__((ext_vector_type(2)));
__device__ __forceinline__ unsigned pk2(float lo, float hi) { return __builtin_bit_cast(unsigned, __builtin_convertvector((f32x2_t){lo, hi}, bf16x2_t)); }
__device__ __forceinline__ float bflo(unsigned w) { return __uint_as_float(w << 16); }
__device__ __forceinline__ float bfhi(unsigned w) { return __uint_as_float(w & 0xffff0000u); }
__device__ __forceinline__ float fexp2(float x) { return __builtin_amdgcn_exp2f(x); }
__device__ __forceinline__ float frcp(float x) { return __builtin_amdgcn_rcpf(x); }
__device__ __forceinline__ float gelu_tanh(float x) { const float u = x + 0.044715f * x * x * x; return x * frcp(1.0f + fexp2(-2.302208198144325f * u)); }
__device__ __forceinline__ float sigmoidf_(float x) { return frcp(1.0f + fexp2(-LOG2E * x)); }
__device__ __forceinline__ float wave_sum(float v) {
#pragma unroll
    for (int o = 1; o < 64; o <<= 1) v += __shfl_xor(v, o);
    return v;
}
__device__ __forceinline__ float wave_max(float v) {
#pragma unroll
    for (int o = 1; o < 64; o <<= 1) v = fmaxf(v, __shfl_xor(v, o));
    return v;
}
__device__ __forceinline__ s16x4 tr16(const LAS unsigned char* p) { return __builtin_bit_cast(s16x4, __builtin_amdgcn_ds_read_tr16_b64_v4i16((LAS s16x4*)p)); }
__device__ __forceinline__ bf16x8 cat8(s16x4 lo, s16x4 hi) { return (bf16x8){lo[0], lo[1], lo[2], lo[3], hi[0], hi[1], hi[2], hi[3]}; }
__device__ __forceinline__ f32x4 mfma16(bf16x8 a, bf16x8 b, f32x4 c) { return __builtin_amdgcn_mfma_f32_16x16x32_bf16(a, b, c, 0, 0, 0); }

struct Frame {
    LAS unsigned char* lds;
    int tid, lane, wave, G, vcu, bx;
    unsigned char* ws;
    const float* const* in;
    float* out;
};
enum { I_X = 0, I_C, I_WADA, I_BADA, I_WIN, I_SPW, I_SPB, I_WBA, I_WBB, I_WOUT, I_LN1G, I_LN1B, I_WR, I_BR, I_WUP, I_BUP, I_WDN, I_BDN, I_LN2G, I_LN2B };
template <class Tp> __device__ __forceinline__ Tp* wsp(const Frame& F, size_t off) { return (Tp*)(F.ws + off); }

template <class P> __device__ __forceinline__ P launder(P p) { unsigned lo = (unsigned)(uintptr_t)p, hi = (unsigned)((uintptr_t)p >> 32); asm volatile("" : "+v"(lo), "+v"(hi));
    lo = (unsigned)__builtin_amdgcn_readfirstlane((int)lo); hi = (unsigned)__builtin_amdgcn_readfirstlane((int)hi); return (P)(((uintptr_t)hi << 32) | (uintptr_t)lo); }
__device__ __forceinline__ unsigned fl_x8(unsigned v) { return (unsigned)__builtin_amdgcn_update_dpp(0, (int)v, 0x128, 0xf, 0xf, false); }
#ifndef FLNT
#define FLNT true
#endif
template <bool NT> __device__ __forceinline__ void fl_put(bf16* p, size_t ld, bool lo, const v4u& w0, const v4u& w1) {
    v4u sd; sd.x = lo ? w1.x : w0.x; sd.y = lo ? w1.y : w0.y; sd.z = lo ? w1.z : w0.z; sd.w = lo ? w1.w : w0.w;
    v4u rc; rc.x = fl_x8(sd.x); rc.y = fl_x8(sd.y); rc.z = fl_x8(sd.z); rc.w = fl_x8(sd.w);
    v4u oa, ob; oa.x = lo ? w0.x : rc.x; oa.y = lo ? w0.y : rc.y; oa.z = lo ? w0.z : rc.z; oa.w = lo ? w0.w : rc.w;
    ob.x = lo ? rc.x : w1.x; ob.y = lo ? rc.y : w1.y; ob.z = lo ? rc.z : w1.z; ob.w = lo ? rc.w : w1.w;
    if (NT) { __builtin_nontemporal_store(oa, (v4u*)p); __builtin_nontemporal_store(ob, (v4u*)(p + 8 * ld)); } else { *(v4u*)p = oa; *(v4u*)(p + 8 * ld) = ob; } }
struct EpiIn {
    static constexpr int MID_T = 0; static constexpr bool PERM = true, AFTER_DRAIN = false, BADJ = true;
    bf16 *U, *V, *Q, *K, *VV, *Gt; const float* rope;
    __device__ __forceinline__ void operator()(const f32x4 (&acc)[2][2][4][2], const pg8::Unit& u, int wr, int wc, int fr, int fq) const {
        const int pn = u.pn; int type, ld, colt; bf16* base;
        if (pn < 4) { type = 0; base = U; ld = 1024; colt = pn * 256; }
        else if (pn < 8) { type = 0; base = V; ld = 1024; colt = (pn - 4) * 256; }
        else if (pn < 14) { type = 1; base = Q; ld = 1536; colt = (pn - 8) * 256; }
        else if (pn < 20) { type = 2; base = K; ld = 1536; colt = (pn - 14) * 256; }
        else if (pn < 26) { type = 3; base = VV; ld = 1536; colt = (pn - 20) * 256; }
        else { type = 4; base = Gt; ld = 2048; colt = (pn - 26) * 256; }
        const bool lo = fr < 8;
        const int rowl = u.pm * 256 + wr * 64 + fr;
        bf16* const pst = base + (size_t)(u.pm * 256 + wr * 64 + (fr & 7)) * ld + colt + wc * 64 + (fr >> 3) * 32 + 8 * fq;
        if (type == 0) {
#pragma unroll
            for (int ai = 0; ai < 2; ++ai)
#pragma unroll
                for (int m = 0; m < 4; ++m) { v4u w[2];
#pragma unroll
                    for (int bj = 0; bj < 2; ++bj) { const f32x4 v0 = acc[ai][bj][m][0], v1 = acc[ai][bj][m][1];
                        w[bj].x = pk2(gelu_tanh(v0[0]), gelu_tanh(v0[1])); w[bj].y = pk2(gelu_tanh(v0[2]), gelu_tanh(v0[3]));
                        w[bj].z = pk2(gelu_tanh(v1[0]), gelu_tanh(v1[1])); w[bj].w = pk2(gelu_tanh(v1[2]), gelu_tanh(v1[3])); }
                    fl_put<true>(pst + (size_t)(ai * 128 + m * 16) * ld, ld, lo, w[0], w[1]); }
        } else if (type == 4) {
#pragma unroll
            for (int ai = 0; ai < 2; ++ai)
#pragma unroll
                for (int m = 0; m < 4; ++m) { v4u w[2];
#pragma unroll
                    for (int bj = 0; bj < 2; ++bj) { const f32x4 v0 = acc[ai][bj][m][0], v1 = acc[ai][bj][m][1];
                        w[bj].x = pk2(sigmoidf_(v0[0]), sigmoidf_(v0[1])); w[bj].y = pk2(sigmoidf_(v0[2]), sigmoidf_(v0[3]));
                        w[bj].z = pk2(sigmoidf_(v1[0]), sigmoidf_(v1[1])); w[bj].w = pk2(sigmoidf_(v1[2]), sigmoidf_(v1[3])); }
                    fl_put<true>(pst + (size_t)(ai * 128 + m * 16) * ld, ld, lo, w[0], w[1]); }
        } else if (type == 3) {
#pragma unroll
            for (int ai = 0; ai < 2; ++ai)
#pragma unroll
                for (int m = 0; m < 4; ++m) { v4u w[2];
#pragma unroll
                    for (int bj = 0; bj < 2; ++bj) { const f32x4 v0 = acc[ai][bj][m][0], v1 = acc[ai][bj][m][1];
                        w[bj].x = pk2(v0[0], v0[1]); w[bj].y = pk2(v0[2], v0[3]); w[bj].z = pk2(v1[0], v1[1]); w[bj].w = pk2(v1[2], v1[3]); }
                    fl_put<true>(pst + (size_t)(ai * 128 + m * 16) * ld, ld, lo, w[0], w[1]); }
        } else {
            const float sc = (type == 1) ? QSCALE : 1.0f;
#pragma unroll
            for (int ai = 0; ai < 2; ++ai)
#pragma unroll
                for (int m = 0; m < 4; ++m) { const int row = rowl + ai * 128 + m * 16;
                    const f32x4* rp = (const f32x4*)(rope + (size_t)(row & (SEQ - 1)) * 16); const f32x4 c0 = rp[0], c1 = rp[1], s0 = rp[2], s1 = rp[3];
                    float cs[8], sn[8];
#pragma unroll
                    for (int e = 0; e < 4; ++e) { cs[e] = c0[e]; cs[4 + e] = c1[e]; sn[e] = s0[e]; sn[4 + e] = s1[e]; }
                    v4u w[2];
#pragma unroll
                    for (int bj = 0; bj < 2; ++bj) { f32x4 v0 = acc[ai][bj][m][0], v1 = acc[ai][bj][m][1];
                        if (bj == 0) {
#pragma unroll
                            for (int e = 0; e < 8; ++e) { const float x = (e < 4) ? v0[e & 3] : v1[e & 3]; const float p = __shfl_xor(x, 16);
                                float y = x;
                                if (fq == 0) y = x * cs[e] - p * sn[e];
                                if (fq == 1) y = x * cs[e] + p * sn[e];
                                if (e < 4) v0[e & 3] = y; else v1[e & 3] = y; } }
                        w[bj].x = pk2(v0[0] * sc, v0[1] * sc); w[bj].y = pk2(v0[2] * sc, v0[3] * sc); w[bj].z = pk2(v1[0] * sc, v1[1] * sc); w[bj].w = pk2(v1[2] * sc, v1[3] * sc); }
                    fl_put<true>(pst + (size_t)(ai * 128 + m * 16) * ld, ld, lo, w[0], w[1]); }
        }
    }
};
struct EpiProbe {
    static constexpr int MID_T = 0; static constexpr bool PERM = true, AFTER_DRAIN = false, BADJ = false;
    bf16* O; int ld; int on;
    __device__ __forceinline__ void operator()(const f32x4 (&acc)[2][2][4][2], const pg8::Unit& u, int wr, int wc, int fr, int fq) const {
        if (!on) return;
        const int row0 = u.pm * 256 + wr * 64 + fr, col0 = ((on == 3) ? u.pn : (u.pn & 3)) * 256 + wc * 32 + 8 * fq;
#pragma unroll
        for (int ai = 0; ai < 2; ++ai)
#pragma unroll
            for (int m = 0; m < 4; ++m) { bf16* rowp = O + (size_t)(row0 + ai * 128 + m * 16) * ld + col0;
#pragma unroll
                for (int bj = 0; bj < 2; ++bj) { const f32x4 v0 = acc[ai][bj][m][0], v1 = acc[ai][bj][m][1]; v4u w;
                    w.x = pk2(v0[0], v0[1]); w.y = pk2(v0[2], v0[3]); w.z = pk2(v1[0], v1[1]); w.w = pk2(v1[2], v1[3]);
                    *(v4u*)(rowp + bj * 128) = w; } }
    }
};
struct EpiYA {
    static constexpr int MID_T = 0; static constexpr bool PERM = true, AFTER_DRAIN = false, BADJ = false;
    const bf16* Gt; bf16* YA;
    __device__ __forceinline__ void operator()(const f32x4 (&acc)[2][2][4][2], const pg8::Unit& u, int wr, int wc, int fr, int fq) const {
        const int row0 = u.pm * 256 + wr * 64 + fr, col0 = u.pn * 256 + wc * 32 + 8 * fq;
#pragma unroll
        for (int ai = 0; ai < 2; ++ai)
#pragma unroll
            for (int m = 0; m < 4; ++m) { const size_t row = (size_t)(row0 + ai * 128 + m * 16);
#pragma unroll
                for (int bj = 0; bj < 2; ++bj) { const f32x4 v0 = acc[ai][bj][m][0], v1 = acc[ai][bj][m][1];
                    const v4u g = *(const v4u*)(Gt + row * 2048 + col0 + bj * 128); v4u w;
                    w.x = pk2(v0[0] * bflo(g.x), v0[1] * bfhi(g.x)); w.y = pk2(v0[2] * bflo(g.y), v0[3] * bfhi(g.y));
                    w.z = pk2(v1[0] * bflo(g.z), v1[1] * bfhi(g.z)); w.w = pk2(v1[2] * bflo(g.w), v1[3] * bfhi(g.w));
                    *(v4u*)(YA + row * 1024 + col0 + bj * 128) = w; } }
    }
};
struct EpiMg {
    static constexpr int MID_T = 0; static constexpr bool PERM = true, AFTER_DRAIN = false, BADJ = false;
    const bf16* Gt; const bf16* YA; bf16* MG;
    __device__ __forceinline__ void operator()(const f32x4 (&acc)[2][2][4][2], const pg8::Unit& u, int wr, int wc, int fr, int fq) const {
        const int row0 = u.pm * 256 + wr * 64 + fr, col0 = u.pn * 256 + wc * 32 + 8 * fq;
#pragma unroll
        for (int ai = 0; ai < 2; ++ai)
#pragma unroll
            for (int m = 0; m < 4; ++m) { const size_t row = (size_t)(row0 + ai * 128 + m * 16);
#pragma unroll
                for (int bj = 0; bj < 2; ++bj) { const f32x4 v0 = acc[ai][bj][m][0], v1 = acc[ai][bj][m][1];
                    const v4u g = *(const v4u*)(Gt + row * 2048 + 1024 + col0 + bj * 128); const v4u y = *(const v4u*)(YA + row * 1024 + col0 + bj * 128); v4u w;
                    w.x = pk2(bflo(y.x) + v0[0] * bflo(g.x), bfhi(y.x) + v0[1] * bfhi(g.x)); w.y = pk2(bflo(y.y) + v0[2] * bflo(g.y), bfhi(y.y) + v0[3] * bfhi(g.y));
                    w.z = pk2(bflo(y.z) + v1[0] * bflo(g.z), bfhi(y.z) + v1[1] * bfhi(g.z)); w.w = pk2(bflo(y.w) + v1[2] * bflo(g.w), bfhi(y.w) + v1[3] * bfhi(g.w));
                    *(v4u*)(MG + row * 1024 + col0 + bj * 128) = w; } }
    }
};
struct EpiMg2 {
    static constexpr int MID_T = 16; static constexpr bool PERM = true, AFTER_DRAIN = false, BADJ = true;
    const bf16* Gt; bf16* MG;
    __device__ __forceinline__ void mid(f32x4 (&acc)[2][2][4][2], const pg8::Unit& u, int wr, int wc, int fr, int fq) const {
        int row0 = u.pm * 256 + wr * 64 + fr; const int col0 = u.pn * 256 + wc * 64 + 8 * fq;
        asm volatile("" : "+v"(row0));
#pragma unroll
        for (int ai = 0; ai < 2; ++ai)
#pragma unroll
            for (int m = 0; m < 4; ++m) { const size_t row = (size_t)(row0 + ai * 128 + m * 16);
#pragma unroll
                for (int bj = 0; bj < 2; ++bj) { const v4u g0 = *(const v4u*)(Gt + row * 2048 + col0 + bj * 32), g1 = *(const v4u*)(Gt + row * 2048 + 1024 + col0 + bj * 32);
                    const unsigned a0[4] = {g0.x, g0.y, g0.z, g0.w}, a1[4] = {g1.x, g1.y, g1.z, g1.w};
#pragma unroll
                    for (int q = 0; q < 4; ++q) { const float r0 = bflo(a0[q]) * frcp(fmaxf(bflo(a1[q]), 1e-20f)), r1 = bfhi(a0[q]) * frcp(fmaxf(bfhi(a1[q]), 1e-20f));
                        acc[ai][bj][m][q >> 1][(q & 1) * 2] *= r0; acc[ai][bj][m][q >> 1][(q & 1) * 2 + 1] *= r1; } }
                if (m == 3) asm volatile("" ::: "memory"); }
    }
    __device__ __forceinline__ void operator()(const f32x4 (&acc)[2][2][4][2], const pg8::Unit& u, int wr, int wc, int fr, int fq) const {
        const int row0 = u.pm * 256 + wr * 64 + fr, col0 = u.pn * 256 + wc * 64 + 8 * fq; const bool lo = fr < 8;
        bf16* const pst = MG + (size_t)(u.pm * 256 + wr * 64 + (fr & 7)) * 1024 + u.pn * 256 + wc * 64 + (fr >> 3) * 32 + 8 * fq;
#pragma unroll
        for (int ai = 0; ai < 2; ++ai)
#pragma unroll
            for (int m = 0; m < 4; ++m) { const size_t row = (size_t)(row0 + ai * 128 + m * 16); v4u w[2];
#pragma unroll
                for (int bj = 0; bj < 2; ++bj) { const f32x4 v0 = acc[ai][bj][m][0], v1 = acc[ai][bj][m][1];
                    const v4u g = *(const v4u*)(Gt + row * 2048 + 1024 + col0 + bj * 32);
                    w[bj].x = pk2(v0[0] * fmaxf(bflo(g.x), 1e-20f), v0[1] * fmaxf(bfhi(g.x), 1e-20f)); w[bj].y = pk2(v0[2] * fmaxf(bflo(g.y), 1e-20f), v0[3] * fmaxf(bfhi(g.y), 1e-20f));
                    w[bj].z = pk2(v1[0] * fmaxf(bflo(g.z), 1e-20f), v1[1] * fmaxf(bfhi(g.z), 1e-20f)); w[bj].w = pk2(v1[2] * fmaxf(bflo(g.w), 1e-20f), v1[3] * fmaxf(bfhi(g.w), 1e-20f)); }
                fl_put<false>(pst + (size_t)(ai * 128 + m * 16) * 1024, 1024, lo, w[0], w[1]); }
    }
};
template <bool XF32> struct EpiOut {
    static constexpr int MID_T = 0; static constexpr bool PERM = true, AFTER_DRAIN = false, BADJ = true;
    const void* xres; const float* modl  ; bf16* YPRE;
    __device__ __forceinline__ void operator()(const f32x4 (&acc)[2][2][4][2], const pg8::Unit& u, int wr, int wc, int fr, int fq) const {
        const int row0 = u.pm * 256 + wr * 64 + fr, col0 = u.pn * 256 + wc * 64 + 8 * fq; const int b = (u.pm * 256) >> 12; const bool lo = fr < 8;
        bf16* const pst = YPRE + (size_t)(u.pm * 256 + wr * 64 + (fr & 7)) * 1024 + u.pn * 256 + wc * 64 + (fr >> 3) * 32 + 8 * fq;
        f32x4 gg[2][2];
#pragma unroll
        for (int bj = 0; bj < 2; ++bj)
#pragma unroll
            for (int n = 0; n < 2; ++n) gg[bj][n] = *(const f32x4*)(modl + (size_t)b * 6144 + 2048 + col0 + bj * 32 + 4 * n) + 1.0f;
#pragma unroll
        for (int ai = 0; ai < 2; ++ai)
#pragma unroll
            for (int m = 0; m < 4; ++m) { const size_t off = (size_t)(row0 + ai * 128 + m * 16) * 1024 + col0; v4u w[2];
#pragma unroll
                for (int bj = 0; bj < 2; ++bj) { f32x4 x0, x1;
                    if (XF32) { x0 = *(const f32x4*)((const float*)xres + off + bj * 32); x1 = *(const f32x4*)((const float*)xres + off + bj * 32 + 4); }
                    else { const v4u xr = *(const v4u*)((const bf16*)xres + off + bj * 32); x0 = (f32x4){bflo(xr.x), bfhi(xr.x), bflo(xr.y), bfhi(xr.y)}; x1 = (f32x4){bflo(xr.z), bfhi(xr.z), bflo(xr.w), bfhi(xr.w)}; }
                    const f32x4 o0 = x0 * DN_ALPHA + gg[bj][0] * acc[ai][bj][m][0], o1 = x1 * DN_ALPHA + gg[bj][1] * acc[ai][bj][m][1];
                    w[bj].x = pk2(o0[0], o0[1]); w[bj].y = pk2(o0[2], o0[3]); w[bj].z = pk2(o1[0], o1[1]); w[bj].w = pk2(o1[2], o1[3]); }
                fl_put<false>(pst + (size_t)(ai * 128 + m * 16) * 1024, 1024, lo, w[0], w[1]);
                if (m == 3) asm volatile("" ::: "memory"); }
    }
};
struct EpiUp {
    static constexpr int MID_T = 0; static constexpr bool PERM = true, AFTER_DRAIN = false, BADJ = false;
    const float* bup  ; bf16* ACT;
    __device__ __forceinline__ void operator()(const f32x4 (&acc)[2][2][4][2], const pg8::Unit& u, int wr, int wc, int fr, int fq) const {
        const int e = u.pn >> 3, pnl = u.pn & 7; const int row0 = u.pm * 256 + wr * 64 + fr, ac0 = pnl * 128 + wc * 32 + 8 * fq;
        const f32x4* bp = (const f32x4*)(bup + (size_t)e * 2048 + 2 * ac0); const f32x4 b0 = bp[0], b1 = bp[1], b2 = bp[2], b3 = bp[3];
        const float bg[8] = {b0[0], b0[2], b1[0], b1[2], b2[0], b2[2], b3[0], b3[2]}, bl[8] = {b0[1], b0[3], b1[1], b1[3], b2[1], b2[3], b3[1], b3[3]};
#pragma unroll
        for (int ai = 0; ai < 2; ++ai)
#pragma unroll
            for (int m = 0; m < 4; ++m) { float a[8];
#pragma unroll
                for (int j = 0; j < 8; ++j) { const float hg = acc[ai][0][m][j >> 2][j & 3] + bg[j], hl = acc[ai][1][m][j >> 2][j & 3] + bl[j];
                    const float glu = fminf(hg, 7.0f), lin = fminf(fmaxf(hl, -7.0f), 7.0f);
                    a[j] = glu * frcp(1.0f + fexp2(-2.4554669595930156f * glu)) * (lin + 1.0f); }
                v4u w; w.x = pk2(a[0], a[1]); w.y = pk2(a[2], a[3]); w.z = pk2(a[4], a[5]); w.w = pk2(a[6], a[7]);
                *(v4u*)(ACT + (size_t)(row0 + ai * 128 + m * 16) * 1024 + ac0) = w; }
    }
};
struct EpiDn {
    static constexpr int MID_T = 0; static constexpr bool PERM = true, AFTER_DRAIN = false, BADJ = true;
    const float* bdn  ; bf16* YKS;
    __device__ __forceinline__ void operator()(const f32x4 (&acc)[2][2][4][2], const pg8::Unit& u, int wr, int wc, int fr, int fq) const {
        const int e = u.pn >> 2, pnl = u.pn & 3; const int col0 = pnl * 256 + wc * 64 + 8 * fq; const bool lo = fr < 8;
        bf16* const pst = YKS + (size_t)(u.pm * 256 + wr * 64 + (fr & 7)) * 1024 + pnl * 256 + wc * 64 + (fr >> 3) * 32 + 8 * fq;
        f32x4 bv[2][2];
#pragma unroll
        for (int bj = 0; bj < 2; ++bj)
#pragma unroll
            for (int n = 0; n < 2; ++n) bv[bj][n] = *(const f32x4*)(bdn + (size_t)e * 1024 + col0 + bj * 32 + 4 * n);
#pragma unroll
        for (int ai = 0; ai < 2; ++ai)
#pragma unroll
            for (int m = 0; m < 4; ++m) { v4u w[2];
#pragma unroll
                for (int bj = 0; bj < 2; ++bj) { const f32x4 v0 = acc[ai][bj][m][0] + bv[bj][0], v1 = acc[ai][bj][m][1] + bv[bj][1];
                    w[bj].x = pk2(v0[0], v0[1]); w[bj].y = pk2(v0[2], v0[3]); w[bj].z = pk2(v1[0], v1[1]); w[bj].w = pk2(v1[2], v1[3]); }
                fl_put<FLNT>(pst + (size_t)(ai * 128 + m * 16) * 1024, 1024, lo, w[0], w[1]); }
    }
};
struct MoeOrder {
    static constexpr bool GATHER = false; __device__ __forceinline__ int arow(int, int r) const { return r; }
    int nM, nN, nwg, G, c, rev; const LAS unsigned char* tile_e;
    __device__ void init(int RT, int NN, int G_, int c_, const LAS unsigned char* te, int rev_ = 0) { nM = RT; nN = NN; nwg = RT * NN; G = G_; c = c_; tile_e = te; rev = rev_; }
    __device__ bool next(int i, pg8::Unit& u) const {
        const long L = (long)i * G + c; if (L >= nwg) return false;
        int wgid = (int)L; { const int q = nwg / pg8::NXCD, r = nwg % pg8::NXCD, xcd = wgid % pg8::NXCD, off = wgid / pg8::NXCD; wgid = (xcd < r ? xcd * (q + 1) : r * (q + 1) + (xcd - r) * q) + off; }
        const int nig = pg8::WGM * nN, gid = wgid / nig, fm = gid * pg8::WGM, gsz = (nM - fm) < pg8::WGM ? (nM - fm) : pg8::WGM;
        int pm = fm + ((wgid % nig) % gsz); const int pnl = (wgid % nig) / gsz; if (rev) pm = nM - 1 - pm;
        u.pm = pm; u.pn = (int)tile_e[pm] * nN + pnl; return true;
    }
    __device__ __forceinline__ void a_ready(const pg8::Unit&) const {}
    __device__ __forceinline__ void done(const pg8::Unit&) const {}
};

#ifndef STAG_N
#define STAG_N 1
#endif
#ifndef STAG_US
#define STAG_US 24
#endif
__device__ __forceinline__ void stagger(int slot, int us) {
    if (STAG_N <= 1) return;
    const unsigned long long t0 = __builtin_amdgcn_s_memrealtime(); const unsigned long long ticks = (unsigned long long)(slot % STAG_N) * (unsigned)us * 100ull / STAG_N;
    while (__builtin_amdgcn_s_memrealtime() - t0 < ticks) __builtin_amdgcn_s_sleep(16);
}
struct MoeGatherOrder : MoeOrder {
    static constexpr bool GATHER = true; const LAS unsigned short* tokl;
    __device__ __forceinline__ int arow(int ord, int r) const { return (int)tokl[ord * 256 + (r & 255)]; }
};
constexpr int X_TOKL = XOFF + 6144, TOKL_UNITS = 20;
constexpr int TR_NR = 32, TR_WAVE_BYTES = 64 * 64 * 4;
struct TrItem { const float* src; bf16* dst; int ld, K, kind, k0, c0, koff; };
__device__ __forceinline__ void tr_load(const TrItem& t, int lane, f32x4 (&r)[TR_NR]) {
    const int kq = lane >> 4, cc = lane & 15;
#pragma unroll
    for (int i = 0; i < TR_NR; ++i) r[i] = __builtin_nontemporal_load((const f32x4*)(t.src + (size_t)(t.k0 + 2 * (kq + 4 * (i >> 1)) + (i & 1)) * t.ld + t.c0 + 4 * cc));
}
__device__ __forceinline__ void tr_tile(int lane, LAS unsigned* scr, const f32x4 (&r)[TR_NR]) {
    const int kq = lane >> 4, cc = lane & 15;
#pragma unroll
    for (int i2 = 0; i2 < TR_NR / 2; ++i2) { LAS unsigned* p = scr + (4 * cc) * 64 + ((kq + 4 * i2) ^ (cc << 2));
#pragma unroll
        for (int e = 0; e < 4; ++e) p[e * 64] = pk2(r[2 * i2][e], r[2 * i2 + 1][e]); }
    LDS_WAIT(); asm volatile("" ::: "memory");
}
__device__ __forceinline__ void tr_store(const TrItem& t, int lane, const LAS unsigned* scr) {
    const int c = lane & 15;
    const int pbase = (t.kind == 0) ? t.c0 : (256 * (t.c0 >> 8) + ((t.c0 & 255) >> 1));
#pragma unroll
    for (int j = 0; j < 16; ++j) { const int n = (lane >> 4) + 4 * j; const v4u o = *(const LAS v4u*)(scr + n * 64 + ((c ^ j) << 2));
        const int drow = (t.kind == 0) ? (pbase + n) : (pbase + 128 * (n & 1) + (n >> 1));
        __builtin_nontemporal_store(o, (v4u*)(t.dst + (size_t)drow * t.K + t.koff + t.k0 + 8 * c)); }
    LDS_WAIT(); asm volatile("" ::: "memory");
}
__device__ __forceinline__ void sincos_d(double a, double& s, double& c) {
    const double k = rint(a * 0.63661977236758134308);
    const double y = fma(-k, 6.12323399573676603587e-17, fma(-k, 1.57079632679489655800, a));
    const double y2 = y * y;
    double sp = -7.6471637318198164759e-13; sp = fma(sp, y2, 1.6059043836821614599e-10); sp = fma(sp, y2, -2.5052108385441718775e-8); sp = fma(sp, y2, 2.7557319223985890653e-6);
    sp = fma(sp, y2, -1.9841269841269841270e-4); sp = fma(sp, y2, 8.3333333333333333333e-3); sp = fma(sp, y2, -1.6666666666666666667e-1); const double sy = fma(sp * y2, y, y);
    double cp = 4.7794773323873852974e-14; cp = fma(cp, y2, -1.1470745597729724714e-11); cp = fma(cp, y2, 2.0876756987868098979e-9); cp = fma(cp, y2, -2.7557319223985890653e-7);
    cp = fma(cp, y2, 2.4801587301587301587e-5); cp = fma(cp, y2, -1.3888888888888888889e-3); cp = fma(cp, y2, 4.1666666666666666667e-2); cp = fma(cp, y2, -0.5); const double cy = fma(cp, y2, 1.0);
    const int q = ((int)k) & 3;
    s = (q == 0) ? sy : (q == 1) ? cy : (q == 2) ? -sy : -cy;
    c = (q == 0) ? cy : (q == 1) ? -sy : (q == 2) ? -cy : sy;
}
__device__ __forceinline__ void phase_pro_a(Frame& F) {
    LAS unsigned* scr = (LAS unsigned*)(F.lds + F.wave * TR_WAVE_BYTES);
    const int gw = F.vcu * 8 + F.wave, NGW = F.G * 8;
    constexpr int I_IN = 8 * 136, I_SQ = 8 * 16, I_BB = 4 * 16, I_UP = 8 * 32;
    constexpr int S0 = NL * I_IN, S1 = S0 + NL * I_SQ, S2 = S1 + NL * I_BB, S3 = S2 + NL * I_SQ, S4 = S3 + NL * NE * I_SQ, S5 = S4 + NL * NE * I_UP;
    auto decode = [&](int it) -> TrItem { TrItem t; t.koff = 0;
        if (it < S0) { const int l = it / I_IN, r = it % I_IN; t.src = F.in[I_WIN] + (size_t)l * D * NIN; t.dst = wsp<bf16>(F, WS_WIN) + (size_t)l * NIN * D; t.ld = NIN; t.K = D; t.kind = 0; t.k0 = 128 * (r / 136); t.c0 = 64 * (r % 136); }
        else if (it < S1) { const int q = it - S0, l = q / I_SQ, r = q % I_SQ; t.src = F.in[I_WBA] + (size_t)l * D * D; t.dst = wsp<bf16>(F, WS_WBA) + (size_t)l * D * 1536; t.ld = D; t.K = 1536; t.kind = 0; t.k0 = 128 * (r / 16); t.c0 = 64 * (r % 16); }
        else if (it < S2) { const int q = it - S1, l = q / I_BB, r = q % I_BB; t.src = F.in[I_WBB] + (size_t)l * 512 * D; t.dst = wsp<bf16>(F, WS_WBA) + (size_t)l * D * 1536; t.ld = D; t.K = 1536; t.koff = 1024; t.kind = 0; t.k0 = 128 * (r / 16); t.c0 = 64 * (r % 16); }
        else if (it < S3) { const int q = it - S2, l = q / I_SQ, r = q % I_SQ; t.src = F.in[I_WOUT] + (size_t)l * D * D; t.dst = wsp<bf16>(F, WS_WOUT) + (size_t)l * D * D; t.ld = D; t.K = D; t.kind = 0; t.k0 = 128 * (r / 16); t.c0 = 64 * (r % 16); }
        else if (it < S4) { const int q = it - S3, le = q / I_SQ, r = q % I_SQ; t.src = F.in[I_WDN] + (size_t)le * FF * D; t.dst = wsp<bf16>(F, WS_WDN) + (size_t)le * D * FF; t.ld = D; t.K = FF; t.kind = 0; t.k0 = 128 * (r / 16); t.c0 = 64 * (r % 16); }
        else { const int q = it - S4, le = q / I_UP, r = q % I_UP; t.src = F.in[I_WUP] + (size_t)le * D * 2048; t.dst = wsp<bf16>(F, WS_WUP) + (size_t)le * 2048 * D; t.ld = 2048; t.K = D; t.kind = 1; t.k0 = 128 * (r / 32); t.c0 = 64 * (r % 32); }
        return t; };
    {
        f32x4 rn[TR_NR]; TrItem tn; int it = gw;
        if (it < S5) { tn = decode(it); tr_load(tn, F.lane, rn); }
#pragma unroll 1
        for (; it < S5; it += NGW) {
            const TrItem tc = tn;
            tr_tile(F.lane, scr, rn);
            if (it + NGW < S5) { tn = decode(it + NGW); tr_load(tn, F.lane, rn); }
            tr_store(tc, F.lane, scr);
        }
    }
    __syncthreads();
    {
        LAS float* cT = (LAS float*)F.lds;
        LAS float* red = (LAS float*)(F.lds + 32768);
        const float* cv = F.in[I_C];
        for (int i = F.tid; i < 8 * 1024; i += 512) { const int bb = i >> 10, k = i & 1023; cT[k * 8 + bb] = cv[i]; }
        __syncthreads();
        const int hf = F.lane >> 5, c4 = F.lane & 31;
        for (int u = F.vcu; u < NL * 48; u += F.G) {
            const int l = u / 48, n0 = 128 * (u % 48);
            f32x4 a[8];
#pragma unroll
            for (int bb = 0; bb < 8; ++bb) a[bb] = (f32x4){0.f, 0.f, 0.f, 0.f};
            const int kb = F.wave * 128 + hf;
            const float* wp = F.in[I_WADA] + (size_t)l * D * 6144 + (size_t)kb * 6144 + n0 + 4 * c4;
#pragma unroll 8
            for (int kk = 0; kk < 64; ++kk) { const f32x4 w = *(const f32x4*)(wp + (size_t)(2 * kk) * 6144);
                const f32x4 c0 = *(const LAS f32x4*)(cT + (kb + 2 * kk) * 8), c1 = *(const LAS f32x4*)(cT + (kb + 2 * kk) * 8 + 4);
#pragma unroll
                for (int bb = 0; bb < 4; ++bb) { a[bb] += w * c0[bb]; a[4 + bb] += w * c1[bb]; } }
#pragma unroll
            for (int bb = 0; bb < 8; ++bb) *(LAS f32x4*)(red + ((F.wave * 2 + hf) * 8 + bb) * 128 + 4 * c4) = a[bb];
            __syncthreads();
#pragma unroll
            for (int q = 0; q < 2; ++q) { const int o = F.tid + 512 * q, bb = o >> 7, cn = o & 127; float sum = F.in[I_BADA][l * 6144 + n0 + cn];
#pragma unroll
                for (int p = 0; p < 16; ++p) sum += red[(p * 8 + bb) * 128 + cn];
                wsp<float>(F, WS_MOD)[(size_t)(l * 8 + bb) * 6144 + n0 + cn] = sum; }
            __syncthreads();
        }
    }
    const int gt = F.vcu * 512 + F.tid, NT = F.G * 512;
    for (int i = gt; i < SEQ * 8; i += NT) { const int pos = i >> 3, f = i & 7;
        const double inv = (f == 0) ? 1.0 : (f == 1) ? 0.19392274474868576 : (f == 2) ? 0.03760603093086393 : (f == 3) ? 0.007292664737217109 : (f == 4) ? 0.001414213562373095 : (f == 5) ? 0.0002742481756762073 : (f == 6) ? 5.318295896944988e-05 : 1.031338537721246e-05;
        double s, c; sincos_d((double)pos * inv, s, c);
        float* rp = wsp<float>(F, WS_ROPE) + (size_t)pos * 16; rp[f] = (float)c; rp[8 + f] = (float)s; }
    for (int i = gt; i < NL * 4 * 128 * 128; i += NT) { const int j = i & 127, ii = (i >> 7) & 127; const float w = F.in[I_SPW][i];
        wsp<bf16>(F, WS_WSP)[i] = (bf16)(pk2((j <= ii) ? w : 0.f, 0.f) & 0xffffu); }
    for (int i = gt; i < NL * NE * D; i += NT) { const int k = i & 1023, e = (i >> 10) & 31, l = i >> 15; const float w = F.in[I_WR][((size_t)l * D + k) * NE + e];
        const unsigned hi = pk2(w, 0.f) & 0xffffu; const float lo = w - __uint_as_float(hi << 16);
        wsp<bf16>(F, WS_WRT)[i] = (bf16)hi; wsp<bf16>(F, WS_WRT)[NL * NE * D + i] = (bf16)(pk2(lo, 0.f) & 0xffffu); }
}
__device__ __forceinline__ void phase_pro_b(Frame& F) {
    const int gw = F.vcu * 8 + F.wave, NGW = F.G * 8;
    const float* mod = wsp<float>(F, WS_MOD);
    for (int m = gw; m < T; m += NGW) { const int b = m >> 12; const float* mb = mod + (size_t)b * 6144;
        const f32x4* xr = (const f32x4*)(F.in[I_X] + (size_t)m * D) + F.lane; v2u* hp = (v2u*)(wsp<bf16>(F, WS_H) + (size_t)m * D) + F.lane;
#pragma unroll
        for (int j = 0; j < 4; ++j) { const f32x4 x = xr[64 * j]; const f32x4 sh = *((const f32x4*)mb + F.lane + 64 * j), sc = *((const f32x4*)(mb + 1024) + F.lane + 64 * j);
            const f32x4 h = x * (sc + 1.0f) + sh; v2u o; o.x = pk2(h[0], h[1]); o.y = pk2(h[2], h[3]); hp[64 * j] = o; } }
}

constexpr int AT_RS = 144;
constexpr int AT_ROWS = 400, AT_VOFF = AT_ROWS * AT_RS;
#define LDS_BARRIER() do { asm volatile("s_waitcnt lgkmcnt(0)" ::: "memory"); __builtin_amdgcn_s_barrier(); asm volatile("" ::: "memory"); } while (0)
struct AtUnit { int g, b, h, r, n, d; size_t hoff; };
__device__ __forceinline__ AtUnit at_decode(int u) { AtUnit a; a.g = u >> 10; const int rem = u & 1023; a.b = rem >> 7; a.h = (rem >> 4) & 7; const int rn = rem & 15;
    const int dsh = 2 * a.g, nbs = 4 - dsh; a.d = 1 << dsh; a.r = rn >> nbs; a.n = 2 * (rn & ((1 << nbs) - 1)); a.hoff = (size_t)a.g * 512 + a.h * 64; return a; }
constexpr int AT_NU = 3 * 1024;
struct AtSlot { v4u k[6], v[6]; bf16x8 q0, q1, q2, q3; };
struct AtCtx { const bf16 *Qb, *Kb, *Vb; bf16* OG; float* LSE; LAS unsigned char *Ks, *Vs; int qi, g4, piece, jr; };
__device__ __forceinline__ void at_load(AtSlot& sl, int uu, const AtCtx& C, const Frame& F) {
    const AtUnit a_ = at_decode(uu);
#pragma unroll
    for (int ps = 0; ps < 6; ++ps) { const int lp = 128 * (a_.n - 1) + ps * 64 + C.jr; sl.k[ps] = (v4u){0u, 0u, 0u, 0u}; sl.v[ps] = sl.k[ps];
        if (lp >= 0) { const size_t off = ((size_t)a_.b * SEQ + (size_t)lp * a_.d + a_.r) * 1536 + a_.hoff + C.piece * 8; sl.k[ps] = *(const v4u*)(C.Kb + off); sl.v[ps] = *(const v4u*)(C.Vb + off); } }
    const size_t qrow_ = (size_t)a_.b * SEQ + (size_t)(128 * a_.n + 16 * F.wave + C.qi) * a_.d + a_.r; const bf16* qp = C.Qb + qrow_ * 1536 + a_.hoff + 8 * C.g4;
    sl.q0 = *(const bf16x8*)qp; sl.q1 = *(const bf16x8*)(qp + 32);
    const bf16* qp2 = qp + (size_t)128 * a_.d * 1536; sl.q2 = *(const bf16x8*)qp2; sl.q3 = *(const bf16x8*)(qp2 + 32);
}
__device__ __forceinline__ void at_unit(AtSlot& sl, int u, int unext, const AtCtx& C, const Frame& F) {
    bf16* OG = C.OG; float* LSE = C.LSE; LAS unsigned char* Ks = C.Ks; LAS unsigned char* Vs = C.Vs; const int qi = C.qi, g4 = C.g4;
    const AtUnit au = at_decode(u); const int g = au.g, b = au.b, h = au.h, r = au.r, n = au.n, d = au.d;
#pragma unroll
    for (int ps = 0; ps < 6; ++ps) { const int j = ps * 64 + C.jr; *(LAS v4u*)(Ks + j * AT_RS + C.piece * 16) = sl.k[ps]; *(LAS v4u*)(Vs + j * AT_RS + C.piece * 16) = sl.v[ps]; }
    const bf16x8 sl_q0 = sl.q0, sl_q1 = sl.q1, sl_q2 = sl.q2, sl_q3 = sl.q3;
    LDS_BARRIER();
    if (unext < AT_NU) at_load(sl, unext, C, F);
#pragma unroll
    for (int tq = 0; tq < 2; ++tq)
        {
            const int iq = 128 * tq + 16 * F.wave + qi; const int rb = 128 * tq + 16 * F.wave; const bf16x8 qf0 = tq ? sl_q2 : sl_q0, qf1 = tq ? sl_q3 : sl_q1; const size_t qrow = (size_t)b * SEQ + (size_t)(128 * n + iq) * d + r;
            f32x4 s[10]; float mx = -1e30f; const int dq = qi - 4 * g4; const bool first = (n == 0) && (tq == 0);
#pragma unroll
            for (int st = 0; st < 9; ++st) {
                const LAS unsigned char* kp = Ks + (rb + 16 * st + qi) * AT_RS + g4 * 16;
                const bf16x8 k0 = *(const LAS bf16x8*)kp, k1 = *(const LAS bf16x8*)(kp + 64);
                f32x4 a = (f32x4){0.f, 0.f, 0.f, 0.f};
                a = mfma16(k0, qf0, a); a = mfma16(k1, qf1, a);
                if (st == 0) {
#pragma unroll
                    for (int i = 0; i < 4; ++i) a[i] = (i >= dq) ? a[i] : -1e30f; }
                if (st == 8) {
#pragma unroll
                    for (int i = 0; i < 4; ++i) a[i] = (i <= dq) ? a[i] : -1e30f; }
                if (first) {
#pragma unroll
                    for (int i = 0; i < 4; ++i) a[i] = (rb + 16 * st + 4 * g4 + i >= 128) ? a[i] : -1e30f; }
#pragma unroll
                for (int i = 0; i < 4; ++i) mx = fmaxf(mx, a[i]);
                s[st] = a;
            }
            mx = fmaxf(mx, __shfl_xor(mx, 16)); mx = fmaxf(mx, __shfl_xor(mx, 32));
            float sum = 0.f;
#pragma unroll
            for (int st = 0; st < 9; ++st)
#pragma unroll
                for (int i = 0; i < 4; ++i) { const float p = fexp2(s[st][i] - mx); s[st][i] = p; sum += p; }
            s[9] = (f32x4){0.f, 0.f, 0.f, 0.f};
            sum += __shfl_xor(sum, 16); sum += __shfl_xor(sum, 32);
            f32x4 o[4];
#pragma unroll
            for (int dt = 0; dt < 4; ++dt) o[dt] = (f32x4){0.f, 0.f, 0.f, 0.f};
#pragma unroll
            for (int c = 0; c < 5; ++c) {
                v4u pw; pw.x = pk2(s[2 * c][0], s[2 * c][1]); pw.y = pk2(s[2 * c][2], s[2 * c][3]); pw.z = pk2(s[2 * c + 1][0], s[2 * c + 1][1]); pw.w = pk2(s[2 * c + 1][2], s[2 * c + 1][3]);
                const bf16x8 pf = __builtin_bit_cast(bf16x8, pw);
                const LAS unsigned char* vp = Vs + (rb + 32 * c + 4 * g4 + (qi >> 2)) * AT_RS + 8 * (qi & 3);
#pragma unroll
                for (int dt = 0; dt < 4; ++dt) { const s16x4 lo = tr16(vp + 32 * dt), hi = tr16(vp + 32 * dt + 16 * AT_RS);
                    o[dt] = mfma16(cat8(lo, hi), pf, o[dt]); }
            }
            const float inv = 1.0f / sum;
            bf16* op = OG + ((size_t)g * T + qrow) * 512 + h * 64 + 4 * g4;
#pragma unroll
            for (int dt = 0; dt < 4; ++dt) { v2u w; w.x = pk2(o[dt][0] * inv, o[dt][1] * inv); w.y = pk2(o[dt][2] * inv, o[dt][3] * inv); *(v2u*)(op + 16 * dt) = w; }
            if (g4 == 0) LSE[((size_t)g * T + qrow) * 8 + h] = mx + __log2f(sum);
        }
    LDS_BARRIER();
}
__device__ __forceinline__ void phase_attn(Frame& F) {
    AtCtx C; C.Qb = wsp<bf16>(F, WS_Q); C.Kb = wsp<bf16>(F, WS_K); C.Vb = wsp<bf16>(F, WS_VV); C.OG = wsp<bf16>(F, WS_OG); C.LSE = wsp<float>(F, WS_LSE);
    C.Ks = F.lds; C.Vs = F.lds + AT_VOFF; C.qi = F.lane & 15; C.g4 = F.lane >> 4; C.piece = F.tid & 7; C.jr = F.tid >> 3;
    if (F.tid < 144) { *(LAS v4u*)(C.Ks + 384 * AT_RS + F.tid * 16) = (v4u){0u, 0u, 0u, 0u}; *(LAS v4u*)(C.Vs + 384 * AT_RS + F.tid * 16) = (v4u){0u, 0u, 0u, 0u}; }
    AtSlot sa; const int u0 = F.vcu, G = F.G;
    if (u0 < AT_NU) at_load(sa, u0, C, F);
#pragma unroll 1
    for (int u = u0; u < AT_NU; u += G) at_unit(sa, u, u + G, C, F);
}

constexpr int SG_WOFF = 69632, SG_WRS = 264;
constexpr int SG_RS = 528;
__device__ __forceinline__ void phase_sg(Frame& F, int l) {
    const bf16* Ub = wsp<bf16>(F, WS_U); const bf16* Vb = wsp<bf16>(F, WS_V); bf16* TT = wsp<bf16>(F, WS_TT);
    const bf16* OG = wsp<bf16>(F, WS_OG); const float* LSE = wsp<float>(F, WS_LSE); bf16* OB = wsp<bf16>(F, WS_OB);
    const bf16* Wsp = wsp<bf16>(F, WS_WSP); const float* spb = F.in[I_SPB];
    LAS unsigned char* Vn = F.lds;
    const int qi = F.lane & 15, g4 = F.lane >> 4;
    const int l32 = F.lane & 31;
    v4u vraw[8];
#define SG_LOAD(uu) do { const int gi_ = (uu) & 3, m0_ = ((uu) >> 2) * 128; \
        _Pragma("unroll") for (int ps = 0; ps < 8; ++ps) vraw[ps] = *(const v4u*)(Vb + (size_t)(m0_ + 16 * ps + 2 * F.wave + (F.lane >> 5)) * 1024 + gi_ * 256 + 8 * l32); } while (0)
    if (F.vcu < 1024) SG_LOAD(F.vcu);
    const bool wlds = (F.G & 3) == 0; LAS unsigned char* Wl = F.lds + SG_WOFF;
    if (wlds) { const bf16* wsrc = Wsp + (size_t)(l * 4 + (F.vcu & 3)) * 128 * 128;
        for (int i = F.tid; i < 128 * 16; i += 512) { const int row = i >> 4, ch = i & 15; const v4u wv = *(const v4u*)(wsrc + row * 128 + ch * 8);
            *(LAS v2u*)(Wl + row * SG_WRS + ch * 16) = (v2u){wv.x, wv.y}; *(LAS v2u*)(Wl + row * SG_WRS + ch * 16 + 8) = (v2u){wv.z, wv.w}; } }
    for (int u = F.vcu; u < 1024; u += F.G) {
        const int gi = u & 3, m0 = (u >> 2) * 128;
        float ml[4][3]; v4u mo[4][3]; const int sub = F.tid & 7;
#pragma unroll
        for (int ps = 0; ps < 4; ++ps) { const int p = (F.tid >> 3) + 64 * ps; const size_t tok = (size_t)m0 + (p >> 1); const int hd = 2 * gi + (p & 1); const size_t off = tok * 512 + hd * 64 + 8 * sub;
#pragma unroll
            for (int gq = 0; gq < 3; ++gq) { ml[ps][gq] = LSE[((size_t)gq * T + tok) * 8 + hd]; mo[ps][gq] = *(const v4u*)(OG + (size_t)gq * T * 512 + off); } }
        {
            float sm[8], mean[8], rs[8];
#pragma unroll
            for (int ps = 0; ps < 8; ++ps) { const v4u raw = vraw[ps]; sm[ps] = ((bflo(raw.x) + bfhi(raw.x)) + (bflo(raw.y) + bfhi(raw.y))) + ((bflo(raw.z) + bfhi(raw.z)) + (bflo(raw.w) + bfhi(raw.w))); }
#pragma unroll
            for (int o = 1; o < 32; o <<= 1) {
#pragma unroll
                for (int ps = 0; ps < 8; ++ps) sm[ps] += __shfl_xor(sm[ps], o); }
#pragma unroll
            for (int ps = 0; ps < 8; ++ps) { const v4u raw = vraw[ps]; mean[ps] = sm[ps] * (1.0f / 256.0f); float q = 0.f;
                const float x[8] = {bflo(raw.x), bfhi(raw.x), bflo(raw.y), bfhi(raw.y), bflo(raw.z), bfhi(raw.z), bflo(raw.w), bfhi(raw.w)};
#pragma unroll
                for (int e = 0; e < 8; ++e) { const float dx = x[e] - mean[ps]; q += dx * dx; }
                sm[ps] = q; }
#pragma unroll
            for (int o = 1; o < 32; o <<= 1) {
#pragma unroll
                for (int ps = 0; ps < 8; ++ps) sm[ps] += __shfl_xor(sm[ps], o); }
#pragma unroll
            for (int ps = 0; ps < 8; ++ps) { rs[ps] = 1.0f / sqrtf(sm[ps] * (1.0f / 256.0f) + LN_EPS); const v4u raw = vraw[ps]; const int j = 16 * ps + 2 * F.wave + (F.lane >> 5);
                const float x[8] = {bflo(raw.x), bfhi(raw.x), bflo(raw.y), bfhi(raw.y), bflo(raw.z), bfhi(raw.z), bflo(raw.w), bfhi(raw.w)};
                v4u w; w.x = pk2((x[0] - mean[ps]) * rs[ps], (x[1] - mean[ps]) * rs[ps]); w.y = pk2((x[2] - mean[ps]) * rs[ps], (x[3] - mean[ps]) * rs[ps]);
                w.z = pk2((x[4] - mean[ps]) * rs[ps], (x[5] - mean[ps]) * rs[ps]); w.w = pk2((x[6] - mean[ps]) * rs[ps], (x[7] - mean[ps]) * rs[ps]);
                *(LAS v4u*)(Vn + j * SG_RS + l32 * 16) = w; }
        }
        LDS_BARRIER();
        if (u + F.G < 1024) SG_LOAD(u + F.G);
        {
#pragma unroll
          for (int ps = 0; ps < 4; ++ps) { const int p = (F.tid >> 3) + 64 * ps; const size_t tok = (size_t)m0 + (p >> 1); const int hd = 2 * gi + (p & 1);
              const float l0 = ml[ps][0], l1 = ml[ps][1], l2 = ml[ps][2];
              const float mxx = fmaxf(l0, fmaxf(l1, l2)); float w0 = fexp2(l0 - mxx), w1 = fexp2(l1 - mxx), w2 = fexp2(l2 - mxx); const float inv = 1.0f / (w0 + w1 + w2); w0 *= inv; w1 *= inv; w2 *= inv;
              const size_t off = tok * 512 + hd * 64 + 8 * sub;
              const v4u a = mo[ps][0], bq = mo[ps][1], cq = mo[ps][2]; v4u w;
              w.x = pk2(w0 * bflo(a.x) + w1 * bflo(bq.x) + w2 * bflo(cq.x), w0 * bfhi(a.x) + w1 * bfhi(bq.x) + w2 * bfhi(cq.x));
              w.y = pk2(w0 * bflo(a.y) + w1 * bflo(bq.y) + w2 * bflo(cq.y), w0 * bfhi(a.y) + w1 * bfhi(bq.y) + w2 * bfhi(cq.y));
              w.z = pk2(w0 * bflo(a.z) + w1 * bflo(bq.z) + w2 * bflo(cq.z), w0 * bfhi(a.z) + w1 * bfhi(bq.z) + w2 * bfhi(cq.z));
              w.w = pk2(w0 * bflo(a.w) + w1 * bflo(bq.w) + w2 * bflo(cq.w), w0 * bfhi(a.w) + w1 * bfhi(bq.w) + w2 * bfhi(cq.w));
              *(v4u*)(TT + tok * 1536 + 1024 + hd * 64 + 8 * sub) = w; } }
        v2u uq[8][2]; float ubias[8];
#pragma unroll
        for (int it = 0; it < 8; ++it) { const int i = 16 * it + qi; ubias[it] = spb[(l * 4 + gi) * 128 + i]; const size_t rowo = (size_t)(m0 + i) * 1024 + gi * 256 + 32 * F.wave + 4 * g4;
            uq[it][0] = *(const v2u*)(Ub + rowo); uq[it][1] = *(const v2u*)(Ub + rowo + 16); }
        {
            f32x4 acc[2][8];
#pragma unroll
            for (int ct = 0; ct < 2; ++ct)
#pragma unroll
                for (int it = 0; it < 8; ++it) acc[ct][it] = (f32x4){0.f, 0.f, 0.f, 0.f};
            const bf16* wbase = Wsp + (size_t)(l * 4 + gi) * 128 * 128 + (size_t)qi * 128 + 4 * g4;
#pragma unroll
            for (int kc = 0; kc < 4; ++kc) {
                bf16x8 af[2];
#pragma unroll
                for (int ct = 0; ct < 2; ++ct) { const LAS unsigned char* p = Vn + (32 * kc + 4 * g4 + (qi >> 2)) * SG_RS + (32 * F.wave + 16 * ct + 4 * (qi & 3)) * 2;
                    af[ct] = cat8(tr16(p), tr16(p + 16 * SG_RS)); }
#pragma unroll
                for (int it = 0; it < 8; ++it) if (it >= 2 * kc) {
                    const bf16* wp = wbase + (size_t)(16 * it) * 128 + 32 * kc; const LAS unsigned char* wq = Wl + (16 * it + qi) * SG_WRS + (32 * kc + 4 * g4) * 2;
                    const v2u b0 = wlds ? *(const LAS v2u*)wq : *(const v2u*)wp, b1 = wlds ? *(const LAS v2u*)(wq + 32) : *(const v2u*)(wp + 16);
                    const bf16x8 bfr = __builtin_bit_cast(bf16x8, (v4u){b0.x, b0.y, b1.x, b1.y});
                    acc[0][it] = mfma16(af[0], bfr, acc[0][it]); acc[1][it] = mfma16(af[1], bfr, acc[1][it]); }
            }
#pragma unroll
            for (int it = 0; it < 8; ++it) { const int i = 16 * it + qi; const float bias = ubias[it]; const size_t rowo = (size_t)(m0 + i) * 1536 + gi * 256 + 32 * F.wave + 4 * g4;
#pragma unroll
                for (int ct = 0; ct < 2; ++ct) { const v2u uu = uq[it][ct]; const f32x4 a = acc[ct][it]; v2u w;
                    w.x = pk2(bflo(uu.x) * (a[0] + bias), bfhi(uu.x) * (a[1] + bias)); w.y = pk2(bflo(uu.y) * (a[2] + bias), bfhi(uu.y) * (a[3] + bias));
                    *(v2u*)(TT + rowo + 16 * ct) = w; } }
        }
        LDS_BARRIER();
    }
#undef SG_LOAD
}

__device__ __forceinline__ void phase_ln1(Frame& F, int l, bool commit) {
    const bf16* YPRE = wsp<bf16>(F, WS_YPRE); bf16* H = wsp<bf16>(F, WS_H);
    const float* modl = wsp<float>(F, WS_MOD) + (size_t)l * 8 * 6144;
    const float* lg = F.in[I_LN1G] + l * D; const float* lb = F.in[I_LN1B] + l * D; const float* br = F.in[I_BR] + l * NE;
    const bf16* WH = wsp<bf16>(F, WS_WRT) + (size_t)l * NE * D; const bf16* WL = WH + (size_t)NL * NE * D;
    int* TOKINFO = wsp<int>(F, WS_TOKINFO); float* TOKW = wsp<float>(F, WS_TOKW);
    unsigned* cntg = wsp<unsigned>(F, WS_CTL) + CW_CNT + (size_t)l * NE * 64;
    LAS int* sel_e = (LAS int*)(F.lds + X_SELE);
    const int lane = F.lane, qi = lane & 15, g4 = lane >> 4;
    { const v4u* srcw = (const v4u*)WH;
#pragma unroll 4
      for (int i = F.tid; i < 2 * NE * 128; i += 512) { const int hl = i >> 12, e = (i >> 7) & 31, c = i & 127;
          *(LAS v4u*)(F.lds + hl * 65536 + e * 2048 + ((c ^ (e & 15)) << 4)) = srcw[(size_t)hl * (NL * NE * 128) + e * 128 + c]; } }
    __syncthreads();
    for (int tb = F.vcu; tb < T / 128; tb += F.G) {
        const int m0 = tb * 128; const int b = m0 >> 12; const float* mb = modl + (size_t)b * 6144; const int mw = m0 + 16 * F.wave;
        v2u pre[4][4];
#pragma unroll
        for (int r = 0; r < 4; ++r)
#pragma unroll
            for (int j = 0; j < 4; ++j) pre[r][j] = *((const v2u*)(YPRE + (size_t)(mw + r) * D) + lane + 64 * j);
#pragma unroll 1
        for (int rp = 0; rp < 4; ++rp) {
            f32x4 hh[4][4]; float mean[4], rstd[4];
            const int mrow = mw + 4 * rp;
#pragma unroll
            for (int r = 0; r < 4; ++r)
#pragma unroll
                for (int j = 0; j < 4; ++j) hh[r][j] = (f32x4){bflo(pre[r][j].x), bfhi(pre[r][j].x), bflo(pre[r][j].y), bfhi(pre[r][j].y)};
            if (rp < 3) {
#pragma unroll
                for (int r = 0; r < 4; ++r)
#pragma unroll
                    for (int j = 0; j < 4; ++j) pre[r][j] = *((const v2u*)(YPRE + (size_t)(mrow + 4 + r) * D) + lane + 64 * j); }
            { float sm[4], sq[4];
#pragma unroll
              for (int r = 0; r < 4; ++r) { sm[r] = 0.f; sq[r] = 0.f;
#pragma unroll
                  for (int j = 0; j < 4; ++j) { sm[r] += (hh[r][j][0] + hh[r][j][1]) + (hh[r][j][2] + hh[r][j][3]);
                      sq[r] += (hh[r][j][0] * hh[r][j][0] + hh[r][j][1] * hh[r][j][1]) + (hh[r][j][2] * hh[r][j][2] + hh[r][j][3] * hh[r][j][3]); } }
#pragma unroll
              for (int o = 1; o < 64; o <<= 1) {
#pragma unroll
                  for (int r = 0; r < 4; ++r) { sm[r] += __shfl_xor(sm[r], o); sq[r] += __shfl_xor(sq[r], o); } }
#pragma unroll
              for (int r = 0; r < 4; ++r) { mean[r] = sm[r] * (1.0f / D); rstd[r] = 1.0f / sqrtf(fmaxf(sq[r] * (1.0f / D) - mean[r] * mean[r], 0.f) + LN_EPS); } }
            if (lane < 4) { const float mq = (lane == 0) ? mean[0] : (lane == 1) ? mean[1] : (lane == 2) ? mean[2] : mean[3], rq = (lane == 0) ? rstd[0] : (lane == 1) ? rstd[1] : (lane == 2) ? rstd[2] : rstd[3];
                float* st = wsp<float>(F, WS_STAT) + (size_t)(mrow + lane) * 2; st[0] = mq; st[1] = rq; }
#pragma unroll
            for (int j = 0; j < 4; ++j) { const f32x4 gq = *((const f32x4*)lg + lane + 64 * j), bq = *((const f32x4*)lb + lane + 64 * j);
                const f32x4 shq = *((const f32x4*)(mb + 3072) + lane + 64 * j), scq = *((const f32x4*)(mb + 4096) + lane + 64 * j) + 1.0f;
#pragma unroll
                for (int r = 0; r < 4; ++r) { const f32x4 x1 = (hh[r][j] - mean[r]) * rstd[r] * gq + bq;
                    const f32x4 h2 = x1 * scq + shq; v2u o; o.x = pk2(h2[0], h2[1]); o.y = pk2(h2[2], h2[3]); *((v2u*)(H + (size_t)(mrow + r) * D) + lane + 64 * j) = o;
 } }
        }
        VM_WAIT(); asm volatile("" ::: "memory");
        f32x4 c0 = (f32x4){0.f, 0.f, 0.f, 0.f}, c1 = c0;
        { const bf16* hp = H + (size_t)(mw + qi) * D + 8 * g4;
          const LAS unsigned char* w0 = F.lds + qi * 2048; const LAS unsigned char* w1 = F.lds + (16 + qi) * 2048;
#pragma unroll 8
          for (int ks = 0; ks < 32; ++ks) {
              const bf16x8 hhi = *(const bf16x8*)(hp + 32 * ks);
              const int co = ((4 * ks + g4) ^ qi) << 4;
              const bf16x8 a0h = *(const LAS bf16x8*)(w0 + co), a0l = *(const LAS bf16x8*)(w0 + 65536 + co);
              const bf16x8 a1h = *(const LAS bf16x8*)(w1 + co), a1l = *(const LAS bf16x8*)(w1 + 65536 + co);
              c0 = mfma16(a0h, hhi, c0); c0 = mfma16(a0l, hhi, c0);
              c1 = mfma16(a1h, hhi, c1); c1 = mfma16(a1l, hhi, c1); } }
        {
            float v[8]; int id[8];
#pragma unroll
            for (int i = 0; i < 4; ++i) { id[i] = 4 * g4 + i; id[4 + i] = 16 + 4 * g4 + i; v[i] = c0[i] + br[4 * g4 + i]; v[4 + i] = c1[i] + br[16 + 4 * g4 + i]; }
            int ek[4]; float vk[4];
#pragma unroll
            for (int k = 0; k < 4; ++k) { float lm = v[0]; int li = id[0];
#pragma unroll
                for (int j = 1; j < 8; ++j) if (v[j] > lm) { lm = v[j]; li = id[j]; }
#pragma unroll
                for (int o = 16; o <= 32; o <<= 1) { const float om = __shfl_xor(lm, o); const int oi = __shfl_xor(li, o); if (om > lm || (om == lm && oi < li)) { lm = om; li = oi; } }
                ek[k] = li; vk[k] = lm;
#pragma unroll
                for (int j = 0; j < 8; ++j) if (id[j] == li) v[j] = -INFINITY; }
            const float e1 = __expf(vk[1] - vk[0]), e2 = __expf(vk[2] - vk[0]), e3 = __expf(vk[3] - vk[0]); const float inv = 1.0f / (1.0f + e1 + e2 + e3);
            if (g4 == 0) { const int tl = 16 * F.wave + qi;
                sel_e[tl * 4 + 0] = ek[0]; sel_e[tl * 4 + 1] = ek[1]; sel_e[tl * 4 + 2] = ek[2]; sel_e[tl * 4 + 3] = ek[3];
                *(f32x4*)(TOKW + (size_t)(m0 + tl) * 4) = (f32x4){inv, e1 * inv, e2 * inv, e3 * inv}; }
        }
        __syncthreads();
        { const int myE = sel_e[F.tid]; LAS unsigned long long* bm = (LAS unsigned long long*)(F.lds + X_SELR); unsigned long long mine = 0ull;
#pragma unroll
          for (int e = 0; e < 32; ++e) { const unsigned long long m = __ballot(myE == e); if (lane == e) mine = m; }
          if (lane < 32) bm[F.wave * 32 + lane] = mine;
          __syncthreads();
          int rk = __popcll(bm[F.wave * 32 + myE] & ((1ull << lane) - 1ull));
#pragma unroll
          for (int w = 0; w < 8; ++w) if (w < F.wave) rk += __popcll(bm[w * 32 + myE]);
          TOKINFO[(size_t)m0 * 4 + F.tid] = myE | (rk << 8);
          if (F.tid < 32) { int tot = 0;
#pragma unroll
              for (int w = 0; w < 8; ++w) tot += __popcll(bm[w * 32 + F.tid]);
              wsp<int>(F, WS_WGCNT)[((size_t)l * 256 + tb) * 32 + F.tid] = tot; if (tot && commit) (void)__hip_atomic_fetch_add(cntg + F.tid * 64, (unsigned)tot, RLX_AGENT); } }
        __syncthreads();
    }
}

__device__ __forceinline__ int moe_tables(Frame& F, int l) {
    const unsigned* cntg = wsp<unsigned>(F, WS_CTL) + CW_CNT + (size_t)l * NE * 64;
    LAS int* cnt_s = (LAS int*)(F.lds + X_CNTS); LAS int* off_s = (LAS int*)(F.lds + X_OFFS); LAS unsigned char* tile_e = (LAS unsigned char*)(F.lds + X_TILEE);
    if (F.tid < 32) cnt_s[F.tid] = (int)__hip_atomic_load(cntg + F.tid * 64, RLX_AGENT);
    __syncthreads();
    if (F.tid < 64) {
        const int e = F.tid & 31; const int c = (F.tid < 32) ? cnt_s[e] : 0; const int nt = (c + 255) >> 8; int incl = nt;
#pragma unroll
        for (int o = 1; o < 32; o <<= 1) { const int v = __shfl_up(incl, o); if ((F.tid & 63) >= o) incl += v; }
        if (F.tid < 32) { const int excl = incl - nt; off_s[e] = excl * 256; for (int t = 0; t < nt; ++t) tile_e[excl + t] = (unsigned char)e; if (e == 31) off_s[32] = incl * 256; }
    }
    __syncthreads();
    return off_s[32] >> 8;
}
__device__ __forceinline__ void phase_scat(Frame& F, int l) {
    (void)moe_tables(F, l);
    const LAS int* off_s = (const LAS int*)(F.lds + X_OFFS); const LAS int* cnt_s = (const LAS int*)(F.lds + X_CNTS); LAS int* base_s = (LAS int*)(F.lds + X_BASE);
    const int* TOKINFO = wsp<int>(F, WS_TOKINFO); const float* TOKW = wsp<float>(F, WS_TOKW);
    int* ROWTOK = wsp<int>(F, WS_ROWTOK); float* ROWW = wsp<float>(F, WS_ROWW); const int* WGC = wsp<int>(F, WS_WGCNT) + (size_t)l * 256 * 32; int* TOKINFO2 = wsp<int>(F, WS_TOKROW);
    for (int tb = F.vcu; tb < T / 128; tb += F.G) {
        if (F.tid < 32) base_s[F.tid] = 0;
        __syncthreads();
        { const int e = F.tid & 31, part = F.tid >> 5; int sacc = 0;
          for (int t2 = part * 16; t2 < part * 16 + 16; ++t2) if (t2 < tb) sacc += WGC[t2 * 32 + e];
          if (sacc) atomicAdd((int*)&base_s[e], sacc); }
        __syncthreads();
        { const size_t ent = (size_t)tb * 512 + F.tid; const int info = TOKINFO[ent]; const int e = info & 255, row = off_s[e] + base_s[e] + (info >> 8);
          ROWTOK[row] = (int)ent; ROWW[row] = TOKW[ent]; TOKINFO2[ent] = row; }
        __syncthreads();
    }
    if (F.vcu == 0) for (int e = 0; e < NE; ++e) for (int r = off_s[e] + cnt_s[e] + F.tid; r < off_s[e + 1]; r += 512) { ROWTOK[r] = 0; ROWW[r] = 0.f; }
}
__device__ __forceinline__ void phase_ln2(Frame& F, int l) {
    const bf16* X1 = wsp<bf16>(F, WS_YPRE); const bf16* YK = wsp<bf16>(F, WS_XG); bf16* H = wsp<bf16>(F, WS_H); const int* TOKROW = wsp<int>(F, WS_TOKROW); const float* TOKW = wsp<float>(F, WS_TOKW);
    const float* STAT = wsp<float>(F, WS_STAT); const float* l1g = F.in[I_LN1G] + l * D; const float* l1b = F.in[I_LN1B] + l * D;
    float* XO = F.out; bf16* XB = wsp<bf16>(F, WS_X2);
    const float* modl = wsp<float>(F, WS_MOD) + (size_t)l * 8 * 6144; const float* modn = wsp<float>(F, WS_MOD) + (size_t)((l + 1) & 3) * 8 * 6144;
    const float* lg = F.in[I_LN2G] + l * D; const float* lb = F.in[I_LN2B] + l * D;
    const int lane = F.lane; const int gw = F.vcu * 8 + F.wave, NGW = F.G * 8;
    v2u px[4]; v2u py[4][4]; float pst[2], nst[2]; f32x4 pw4, nw4;
#define LN2_LOAD(mm) do { nst[0] = STAT[(size_t)(mm) * 2]; nst[1] = STAT[(size_t)(mm) * 2 + 1]; nw4 = *(const f32x4*)(TOKW + (size_t)(mm) * 4); \
        int rw_[4]; _Pragma("unroll") for (int k = 0; k < 4; ++k) rw_[k] = TOKROW[(size_t)(mm) * 4 + k]; \
        _Pragma("unroll") for (int j = 0; j < 4; ++j) { px[j] = __builtin_nontemporal_load((const v2u*)(X1 + (size_t)(mm) * D) + lane + 64 * j); \
        _Pragma("unroll") for (int k = 0; k < 4; ++k) py[j][k] = __builtin_nontemporal_load((const v2u*)(YK + (size_t)rw_[k] * D) + lane + 64 * j); } } while (0)
    if (gw < T) LN2_LOAD(gw);
#pragma unroll 1
    for (int m = gw; m < T; m += NGW) { const int b = m >> 12; const float* mb = modl + (size_t)b * 6144; const float* mn = modn + (size_t)b * 6144;
        f32x4 v[4]; float s = 0.f; pst[0] = nst[0]; pst[1] = nst[1]; pw4 = nw4;
#pragma unroll
        for (int j = 0; j < 4; ++j) { f32x4 y = (f32x4){0.f, 0.f, 0.f, 0.f};
#pragma unroll
            for (int k = 0; k < 4; ++k) { const v2u w = py[j][k]; const float cw = pw4[k]; y[0] += cw * bflo(w.x); y[1] += cw * bfhi(w.x); y[2] += cw * bflo(w.y); y[3] += cw * bfhi(w.y); }
            const f32x4 g2 = *((const f32x4*)(mb + 5120) + lane + 64 * j) + 1.0f;
            const f32x4 pxf = (f32x4){bflo(px[j].x), bfhi(px[j].x), bflo(px[j].y), bfhi(px[j].y)};
            const f32x4 x1 = (pxf - pst[0]) * pst[1] * *((const f32x4*)l1g + lane + 64 * j) + *((const f32x4*)l1b + lane + 64 * j);
            v[j] = x1 * DN_ALPHA + g2 * y; s += (v[j][0] + v[j][1]) + (v[j][2] + v[j][3]); }
        if (m + NGW < T) LN2_LOAD(m + NGW);
        float s2 = 0.f;
#pragma unroll
        for (int j = 0; j < 4; ++j) s2 += (v[j][0] * v[j][0] + v[j][1] * v[j][1]) + (v[j][2] * v[j][2] + v[j][3] * v[j][3]);
#pragma unroll
        for (int o = 1; o < 64; o <<= 1) { s += __shfl_xor(s, o); s2 += __shfl_xor(s2, o); }
        const float mean = s * (1.0f / D); const float rstd = 1.0f / sqrtf(fmaxf(s2 * (1.0f / D) - mean * mean, 0.f) + LN_EPS);
#pragma unroll
        for (int j = 0; j < 4; ++j) v[j] = v[j] - mean;
        f32x4* xo = (f32x4*)(XO + (size_t)m * D) + lane; v2u* xb = (v2u*)(XB + (size_t)m * D) + lane; v2u* ho = (v2u*)(H + (size_t)m * D) + lane;
#pragma unroll
        for (int j = 0; j < 4; ++j) { const f32x4 gvj = *((const f32x4*)lg + lane + 64 * j), bvj = *((const f32x4*)lb + lane + 64 * j); const f32x4 x2 = v[j] * rstd * gvj + bvj;
            if (l == NL - 1) __builtin_nontemporal_store(x2, xo + 64 * j); else { v2u xq; xq.x = pk2(x2[0], x2[1]); xq.y = pk2(x2[2], x2[3]); __builtin_nontemporal_store(xq, xb + 64 * j); }
            if (l < NL - 1) { const f32x4 sh = *((const f32x4*)mn + lane + 64 * j), sc = *((const f32x4*)(mn + 1024) + lane + 64 * j) + 1.0f; const f32x4 h = x2 * sc + sh;
                v2u o; o.x = pk2(h[0], h[1]); o.y = pk2(h[2], h[3]); ho[64 * j] = o; } } }
#undef LN2_LOAD
}

#ifndef PH_MASK
#define PH_MASK 0xFFFF
#endif
#define PHM(b) ((PH_MASK >> (b)) & 1)
#ifndef DUP_MASK
#define DUP_MASK 0
#endif
#define REPS(b) (((DUP_MASK >> (b)) & 1) ? 2 : 1)
constexpr int NPH_L = 10, NPHASE = 2 + NL * NPH_L;
struct Args { const float* in[20]; float* out; unsigned char* ws; int ph_lo, ph_hi; };
__global__ void __launch_bounds__(512, 2) fwd(Args args) {
    extern __shared__ __attribute__((aligned(16))) unsigned char lds[];
    Frame F;
    F.lds = (LAS unsigned char*)lds;
#define FRESH() do { int zv_ = 0; asm volatile("" : "+v"(zv_)); const int z_ = __builtin_amdgcn_readfirstlane(zv_); \
        F.tid = (int)threadIdx.x + zv_; F.lane = F.tid & 63; F.wave = __builtin_amdgcn_readfirstlane(F.tid >> 6); \
        F.G = (int)gridDim.x + z_; F.bx = (int)blockIdx.x + z_; F.vcu = (F.G % 8 == 0) ? (F.bx % 8) * (F.G / 8) + F.bx / 8 : F.bx; \
        F.ws = args.ws + z_; F.in = args.in + z_; F.out = args.out + z_; F.lds = (LAS unsigned char*)lds + z_; } while (0)
    FRESH();
    for (int u = F.tid; u < (LDS_BYTES - XOFF) / 4; u += 512) ((LAS unsigned*)(F.lds + XOFF))[u] = 0u;
    __syncthreads();
    unsigned* ctl = wsp<unsigned>(F, WS_CTL);
    XcdBarrier bar; bar.bar = ctl + CW_BAR; bar.x = 0; bar.st = nullptr;
    if (!MK_PER_PHASE) bar = xcd_barrier_post(ctl + CW_BAR, (volatile LAS unsigned*)(F.lds + X_MISC) + 8);
    const int lo = args.ph_lo, hi = args.ph_hi;
#define IN(k) (lo <= (k) && (k) < hi)
#ifndef BAR_REPS
#define BAR_REPS 1
#endif
#define SEAM(k) do { if (!MK_PER_PHASE && IN(k) && IN((k) + 1)) for (int br_ = 0; br_ < BAR_REPS; ++br_) xcd_barrier(bar); } while (0)

    if (PHM(0) && IN(0)) for (int rep = 0; rep < REPS(0); ++rep) { FRESH(); phase_pro_a(F); } SEAM(0);
    if (PHM(1) && IN(1)) for (int rep = 0; rep < REPS(1); ++rep) { FRESH(); phase_pro_b(F); } SEAM(1);
    for (int l = 0; l < NL; ++l) {
        const int pb = 2 + l * NPH_L;
        if (PHM(2) && IN(pb + 0)) for (int rep = 0; rep < REPS(2); ++rep) { FRESH();
            pg8::Gemm g{wsp<bf16>(F, WS_H), wsp<bf16>(F, WS_WIN) + (size_t)l * NIN * D, T, NIN, D}; pg8::StaticOrder S; S.init(T, NIN, F.G, F.bx);
            EpiIn E{wsp<bf16>(F, WS_U), wsp<bf16>(F, WS_V), wsp<bf16>(F, WS_Q), wsp<bf16>(F, WS_K), wsp<bf16>(F, WS_VV), wsp<bf16>(F, WS_G), wsp<float>(F, WS_ROPE)};
            stagger(F.bx >> 3, STAG_US);
            pg8::gemm_phase<EpiIn, pg8::StaticOrder, PG8_ALIGN, PG8_SP2>(F.lds, g, S, E, F.tid);
#if defined(XPROBE)
            { FRESH(); pg8::Gemm g2{wsp<bf16>(F, WS_H), wsp<bf16>(F, WS_WIN) + (size_t)l * NIN * D, T, NIN, D}; pg8::StaticOrder S2; S2.init(T, NIN, F.G, F.bx);
              EpiProbe E2{wsp<bf16>(F, WS_XG), (XPROBE == 3) ? NIN : 1024, (XPROBE >= 2) ? (XPROBE == 3 ? 3 : 1) : (F.G == 0x7ffffff0 ? 1 : 0)};
              pg8::gemm_phase<EpiProbe, pg8::StaticOrder, PG8_ALIGN, PG8_SP2>(F.lds, g2, S2, E2, F.tid); }
#endif
        } SEAM(pb + 0);
        if (PHM(3) && IN(pb + 1)) for (int rep = 0; rep < REPS(3); ++rep) { FRESH(); phase_attn(F); } SEAM(pb + 1);
        if (PHM(4) && IN(pb + 2)) for (int rep = 0; rep < REPS(4); ++rep) { FRESH(); phase_sg(F, l); } SEAM(pb + 2);
        if (PHM(5) && IN(pb + 3)) for (int rep = 0; rep < REPS(5); ++rep) { FRESH();
            pg8::Gemm g{wsp<bf16>(F, WS_TT), wsp<bf16>(F, WS_WBA) + (size_t)l * D * 1536, T, D, 1536}; pg8::StaticOrder S; S.init(T, D, F.G, F.bx);
            EpiMg2 E{wsp<bf16>(F, WS_G), wsp<bf16>(F, WS_MG)}; pg8::gemm_phase<EpiMg2, pg8::StaticOrder, PG8_ALIGN, PG8_SP2>(F.lds, g, S, E, F.tid);
        } SEAM(pb + 3);
        if (PHM(6) && IN(pb + 4)) for (int rep = 0; rep < REPS(6); ++rep) { FRESH();
            pg8::Gemm g{wsp<bf16>(F, WS_MG), wsp<bf16>(F, WS_WOUT) + (size_t)l * D * D, T, D, D}; pg8::StaticOrder S; S.init(T, D, F.G, F.bx);
            if (l == 0) { EpiOut<true> E{(const void*)F.in[I_X], wsp<float>(F, WS_MOD) + (size_t)l * 8 * 6144, wsp<bf16>(F, WS_YPRE)}; pg8::gemm_phase<EpiOut<true>, pg8::StaticOrder, PG8_ALIGN, PG8_SP2>(F.lds, g, S, E, F.tid); }
            else { EpiOut<false> E{(const void*)wsp<bf16>(F, WS_X2), wsp<float>(F, WS_MOD) + (size_t)l * 8 * 6144, wsp<bf16>(F, WS_YPRE)}; pg8::gemm_phase<EpiOut<false>, pg8::StaticOrder, PG8_ALIGN, PG8_SP2>(F.lds, g, S, E, F.tid); }
        } SEAM(pb + 4);
        if (PHM(7) && IN(pb + 5)) for (int rep = 0; rep < REPS(7); ++rep) { FRESH(); phase_ln1(F, l, rep == 0); } SEAM(pb + 5);
        if (PHM(8) && IN(pb + 6)) for (int rep = 0; rep < REPS(8); ++rep) { FRESH(); phase_scat(F, l); } SEAM(pb + 6);
        if (PHM(9) && IN(pb + 7)) for (int rep = 0; rep < REPS(9); ++rep) { FRESH();
            const int RT = moe_tables(F, l);
            pg8::Gemm g{wsp<bf16>(F, WS_H), wsp<bf16>(F, WS_WUP) + (size_t)l * NE * 2048 * D, RT * 256, NE * 2048, D};
            MoeGatherOrder S; S.init(RT, 8, F.G, F.bx, (const LAS unsigned char*)(F.lds + X_TILEE)); S.tokl = (const LAS unsigned short*)(F.lds + X_TOKL);
            { const int* rowtok = wsp<int>(F, WS_ROWTOK); LAS unsigned short* tl = (LAS unsigned short*)(F.lds + X_TOKL); pg8::Unit uu;
              for (int i = 0; i < TOKL_UNITS && S.next(i, uu); ++i) if (F.tid < 256) tl[i * 256 + F.tid] = (unsigned short)(rowtok[uu.pm * 256 + F.tid] >> 2);
              __syncthreads(); }
            EpiUp E{F.in[I_BUP] + (size_t)l * NE * 2048, wsp<bf16>(F, WS_ACT)};
            stagger(F.bx >> 3, STAG_US);
            pg8::gemm_phase<EpiUp, MoeGatherOrder, PG8_ALIGN, true>(F.lds, g, S, E, F.tid);
        } SEAM(pb + 7);
        if (PHM(10) && IN(pb + 8)) for (int rep = 0; rep < REPS(10); ++rep) { FRESH();
            const int RT = moe_tables(F, l);
            pg8::Gemm g{wsp<bf16>(F, WS_ACT), wsp<bf16>(F, WS_WDN) + (size_t)l * NE * D * FF, RT * 256, NE * D, FF};
            MoeOrder S; S.init(RT, 4, F.G, F.bx, (const LAS unsigned char*)(F.lds + X_TILEE), 1);
            EpiDn E{F.in[I_BDN] + (size_t)l * NE * D, wsp<bf16>(F, WS_XG)};
            stagger(F.bx >> 3, STAG_US);
            pg8::gemm_phase<EpiDn, MoeOrder, PG8_ALIGN, PG8_SP2>(F.lds, g, S, E, F.tid);
        } SEAM(pb + 8);
        if (PHM(11) && IN(pb + 9)) for (int rep = 0; rep < REPS(11); ++rep) { FRESH(); phase_ln2(F, l); } SEAM(pb + 9);
    }
#undef IN
#undef SEAM
#undef FRESH
}

extern "C" void kernel_launch(void* const* d_in, const int* in_sizes, int n_in, void* d_out, int out_size, void* d_ws, size_t ws_size, hipStream_t stream) {
    static int grid = 0;
    if (grid == 0) {
        if (n_in != 20 || out_size != T * D || ws_size < WS_END) { fprintf(stderr, "kernel_launch: unexpected shapes (n_in %d, out %d, ws %zu < %zu)\n", n_in, out_size, ws_size, (size_t)WS_END); grid = -1; return; }
        int dev = 0, cus = 0;
        if (hipGetDevice(&dev) != hipSuccess || hipDeviceGetAttribute(&cus, hipDeviceAttributeMultiprocessorCount, dev) != hipSuccess) { grid = -1; return; }
        if (hipFuncSetAttribute((const void*)fwd, hipFuncAttributeMaxDynamicSharedMemorySize, LDS_BYTES) != hipSuccess) { fprintf(stderr, "kernel_launch: hipFuncSetAttribute failed\n"); grid = -1; return; }
        int per_cu = 0;
        if (hipOccupancyMaxActiveBlocksPerMultiprocessor(&per_cu, (const void*)fwd, 512, LDS_BYTES) != hipSuccess || per_cu < 1) fprintf(stderr, "kernel_launch: occupancy query says %d blocks per CU\n", per_cu);
        (void)hipGetLastError();
        grid = cus;
    }
    if (grid < 0) return;
    (void)in_sizes;
    if (hipMemsetAsync((char*)d_ws + WS_CTL, 0, CTL_ZERO_BYTES, stream) != hipSuccess) return;
    Args a{};
    for (int i = 0; i < 20; ++i) a.in[i] = (const float*)d_in[i];
    a.out = (float*)d_out; a.ws = (unsigned char*)d_ws;
#if MK_PER_PHASE
    for (int p = 0; p < NPHASE; ++p) { a.ph_lo = p; a.ph_hi = p + 1; hipLaunchKernelGGL(fwd, dim3(grid), dim3(512), LDS_BYTES, stream, a); }
#else
    a.ph_lo = 0; a.ph_hi = NPHASE;
    hipLaunchKernelGGL(fwd, dim3(grid), dim3(512), LDS_BYTES, stream, a);
#endif
    const hipError_t le = hipPeekAtLastError();
    if (le != hipSuccess) fprintf(stderr, "kernel_launch: launch failed: %s\n", hipGetErrorName(le));
}
```

```cpp
#include <hip/hip_runtime.h>
#include <cstdio>
#include <cstdint>
#ifndef MK_PER_PHASE
#define MK_PER_PHASE 0
#endif
namespace pg8 {
#define PG8_LAS __attribute__((address_space(3)))
typedef unsigned short bf16_t;
typedef short bf16x8 __attribute__((ext_vector_type(8)));
typedef float f32x4 __attribute__((ext_vector_type(4)));
typedef unsigned u32x4 __attribute__((ext_vector_type(4)));
constexpr int BM = 256, BK = 64, HALF = 128, HTB = HALF * BK * 2  , STAGE_BYTES = 8 * HTB, NXCD = 8;
#ifndef PG8_WGM
#define PG8_WGM 8
#endif
constexpr int WGM = PG8_WGM;

__host__ __device__ __forceinline__ int lds_byte(int r, int c) { const int st = (r >> 4) * 2 + (c >> 5), rr = r & 15, cc = c & 31, ob = rr * 64 + cc * 2; return st * 1024 + (ob ^ (((ob >> 9) & 1) << 5)); }
__host__ __device__ __forceinline__ void stage_rc(int b, int& R, int& C) { const int st = b / 1024, sb = b % 1024, swz = sb ^ (((sb >> 9) & 1) << 5); R = (st >> 1) * 16 + swz / 64; C = (st & 1) * 32 + (swz % 64) / 2; }
__host__ __device__ __forceinline__ int perm32(int rho) { const int n = rho >> 4, i = rho & 15; return 8 * (i >> 2) + 4 * n + (i & 3); }

struct Unit { int pm, pn; };
struct Gemm { const bf16_t* A; const bf16_t* Bt; int M, N, K; };

struct StaticOrder {
    static constexpr bool GATHER = false; __device__ __forceinline__ int arow(int, int r) const { return r; }
    int nM, nN, nwg, G, c;
    __host__ __device__ void init(int M, int N, int G_, int c_) { nM = M / BM; nN = N / BM; nwg = nM * nN; G = G_; c = c_; }
    __host__ __device__ bool next(int i, Unit& u) const {
        const long L = (long)i * G + c; if (L >= nwg) return false;
        int wgid = (int)L; { const int q = nwg / NXCD, r = nwg % NXCD, xcd = wgid % NXCD, off = wgid / NXCD; wgid = (xcd < r ? xcd * (q + 1) : r * (q + 1) + (xcd - r) * q) + off; }
        const int nig = WGM * nN, gid = wgid / nig, fm = gid * WGM, gsz = (nM - fm) < WGM ? (nM - fm) : WGM;
        u.pm = fm + ((wgid % nig) % gsz); u.pn = (wgid % nig) / gsz; return true;
    }
    __device__ __forceinline__ void a_ready(const Unit&) const {}
    __device__ __forceinline__ void done(const Unit&) const {}
};

__device__ __forceinline__ unsigned cvt_pk_bf16(float lo, float hi) { unsigned r; asm volatile("v_cvt_pk_bf16_f32 %0, %1, %2" : "=v"(r) : "v"(lo), "v"(hi)); return r; }
typedef float f32x2 __attribute__((ext_vector_type(2)));

template <class Epi, class Sched, bool ALIGN_EPI = false, bool SP2 = false>
__device__ __forceinline__ void gemm_phase(PG8_LAS unsigned char* lds, const Gemm g, const Sched& S, const Epi& E, const int tid_in) {
    const int tid = tid_in, wid = __builtin_amdgcn_readfirstlane(tid >> 6), lane = tid & 63, wr = wid >> 2, wc = wid & 3, fr = lane & 15, fq = lane >> 4;
    const int K = g.K, nt = K / BK;
    unsigned voffA[2], voffB[2];
#pragma unroll
    for (int i = 0; i < 2; ++i) { int R, C; stage_rc(tid * 16 + i * 8192, R, C); const int Rb = Epi::BADJ ? (64 * (R >> 5) + perm32(R & 31)) : Epi::PERM ? ((R & ~31) + perm32(R & 31)) : R;
        voffA[i] = Epi::ABLK ? (unsigned)((((R >> 4) * (K >> 5) + (C >> 5)) * 8 + (R & 7)) * 128 + ((R >> 3) & 1) * 64 + (C & 31) * 2) : (unsigned)(R * K + C) * 2u; voffB[i] = (unsigned)(Rb * K + C) * 2u; }
    const size_t kstep = (size_t)(BK * 2);
    const size_t kstepA = Epi::ABLK ? (size_t)2048 : kstep;
    const size_t hstep = (size_t)HALF * K * 2;
    const size_t tstep = 2 * hstep;
    const size_t bhstep = Epi::BADJ ? (size_t)32 * K * 2 : hstep;
    const unsigned ldsw = (unsigned)wid * 1024u;
    const int aoff = lds_byte(wr * 64 + fr, fq * 8), boff = lds_byte(wc * 32 + fr, fq * 8);
#define PG8_SA(b, h) (((b) * 2 + (h)) * HTB)
#define PG8_SB(b, h) ((4 + (b) * 2 + (h)) * HTB)
    unsigned gc[2][2], gn[2][2];
#define PG8_GOFF(dst, pmv, ordv) do { if constexpr (Sched::GATHER) { _Pragma("unroll") for (int _h = 0; _h < 2; ++_h) _Pragma("unroll") for (int _i = 0; _i < 2; ++_i) { int _R, _C; stage_rc(tid * 16 + _i * 8192, _R, _C); \
        dst[_h][_i] = (unsigned)S.arow((ordv), (pmv) * 256 + _h * 128 + _R) * (unsigned)(K * 2) + (unsigned)(_C * 2); } } } while (0)
#define PG8_STAGE_A(bufoff, origptr, nextf, hh, kbytes) do { if constexpr (Sched::GATHER) { _Pragma("unroll") for (int _i = 0; _i < 2; ++_i) { const unsigned _o = (nextf) ? gn[hh][_i] : gc[hh][_i]; \
        __builtin_amdgcn_global_load_lds((const unsigned*)((const char*)g.A + (kbytes) + _o), (PG8_LAS unsigned*)(lds + (bufoff) + ldsw + _i * 8192), 16, 0, 0); } } else { PG8_STAGE(bufoff, origptr, voffA); } } while (0)
#define PG8_STAGE(bufoff, gbase, voff) do { _Pragma("unroll") for (int _i = 0; _i < 2; ++_i) \
        __builtin_amdgcn_global_load_lds((const unsigned*)((const char*)(gbase) + (voff)[_i]), (PG8_LAS unsigned*)(lds + (bufoff) + ldsw + _i * 8192), 16, 0, 0); } while (0)
#define PG8_LDA(dst, b, h) do { _Pragma("unroll") for (int m = 0; m < 4; ++m) _Pragma("unroll") for (int k = 0; k < 2; ++k) dst[m][k] = *(const PG8_LAS bf16x8*)(lds + PG8_SA(b, h) + aoff + m * 2048 + k * 1024); } while (0)
#define PG8_LDB(dst, b, h) do { _Pragma("unroll") for (int n = 0; n < 2; ++n) _Pragma("unroll") for (int k = 0; k < 2; ++k) dst[n][k] = *(const PG8_LAS bf16x8*)(lds + PG8_SB(b, h) + boff + n * 2048 + k * 1024); } while (0)
#define PG8_MMA(ai, bj, At, Bt) do { __builtin_amdgcn_s_setprio(1); _Pragma("unroll") for (int m = 0; m < 4; ++m) _Pragma("unroll") for (int n = 0; n < 2; ++n) _Pragma("unroll") for (int k = 0; k < 2; ++k) \
        acc[ai][bj][m][n] = __builtin_amdgcn_mfma_f32_16x16x32_bf16(Bt[n][k], At[m][k], acc[ai][bj][m][n], 0, 0, 0); __builtin_amdgcn_s_setprio(0); } while (0)
#define PG8_WAIT_V(n) asm volatile("s_waitcnt vmcnt(" #n ")" ::: "memory")
#define PG8_WAIT_L(n) asm volatile("s_waitcnt lgkmcnt(" #n ")" ::: "memory")
#define PG8_BAR __builtin_amdgcn_s_barrier()
#define PG8_SCHED __builtin_amdgcn_sched_barrier(0)
    Unit cur, nxt; int ui = 0;
    if (!S.next(0, cur)) return;
    f32x4 acc[2][2][4][2];
#pragma unroll
    for (int a = 0; a < 2; ++a)
#pragma unroll
        for (int b = 0; b < 2; ++b)
#pragma unroll
            for (int m = 0; m < 4; ++m)
#pragma unroll
                for (int n = 0; n < 2; ++n) acc[a][b][m][n] = (f32x4){0.f, 0.f, 0.f, 0.f};
    bf16x8 At[4][2], B0[2][2], B1[2][2];
    const char* cA = (const char*)g.A + (size_t)cur.pm * tstep; const char* cB = (const char*)g.Bt + (size_t)cur.pn * tstep;
    S.a_ready(cur);
    PG8_GOFF(gc, cur.pm, 0);
    if constexpr (SP2) {
        PG8_STAGE(PG8_SB(0, 0), cB, voffB); PG8_STAGE(PG8_SB(0, 1), cB + bhstep, voffB); PG8_STAGE_A(PG8_SA(0, 0), cA, false, 0, 0); PG8_STAGE_A(PG8_SA(0, 1), cA + hstep, false, 1, 0);
        if (wr == 1) PG8_BAR;
        PG8_WAIT_V(2); PG8_BAR;
        PG8_STAGE(PG8_SB(1, 0), cB + kstep, voffB); PG8_STAGE_A(PG8_SA(1, 0), cA + kstepA, false, 0, kstep); PG8_STAGE(PG8_SB(1, 1), cB + bhstep + kstep, voffB);
        PG8_WAIT_V(6); PG8_BAR;
    } else {
        PG8_STAGE(PG8_SB(0, 0), cB, voffB); PG8_STAGE(PG8_SA(0, 0), cA, voffA); PG8_STAGE(PG8_SB(0, 1), cB + bhstep, voffB); PG8_STAGE(PG8_SA(0, 1), cA + hstep, voffA);
        if (wr == 1) PG8_BAR;
        PG8_WAIT_V(4); PG8_BAR;
        PG8_STAGE(PG8_SB(1, 0), cB + kstep, voffB); PG8_STAGE(PG8_SA(1, 0), cA + kstepA, voffA); PG8_STAGE(PG8_SB(1, 1), cB + bhstep + kstep, voffB);
        PG8_WAIT_V(6); PG8_BAR;
    }
    for (;;) {
        const bool has_next = S.next(ui + 1, nxt);
        if constexpr (Sched::GATHER) { if (has_next) { PG8_GOFF(gn, nxt.pm, ui + 1); } else { gn[0][0] = gc[0][0]; gn[0][1] = gc[0][1]; gn[1][0] = gc[1][0]; gn[1][1] = gc[1][1]; } }
        const char* nA = has_next ? (const char*)g.A + (size_t)nxt.pm * tstep : cA; const char* nB = has_next ? (const char*)g.Bt + (size_t)nxt.pn * tstep : cB;
#pragma unroll
        for (int seg = 0; seg < (Epi::MID_T > 0 ? 2 : 1); ++seg) {
        if constexpr (Epi::MID_T > 0) { if (seg == 1) { PG8_SCHED; E.mid(acc, cur, wr, wc, fr, fq); PG8_SCHED; } }
        const int t_lo = seg ? Epi::MID_T : 0, t_hi = (Epi::MID_T > 0 && seg == 0) ? Epi::MID_T : nt;
        for (int t = t_lo; t < t_hi; t += 2) {
            const bool last = (t == nt - 2);
            const char* a1 = cA + (size_t)(t + 1) * kstepA;
            const char* a2 = last ? nA : cA + (size_t)(t + 2) * kstepA; const char* b2 = last ? nB : cB + (size_t)(t + 2) * kstep;
            const char* a3 = a2 + kstepA; const char* b3 = b2 + kstep; const size_t k2b = last ? (size_t)0 : (size_t)(t + 2) * kstep;
            if (last && has_next) S.a_ready(nxt);
            if constexpr (SP2) {
            PG8_LDB(B0, 0, 0); PG8_LDB(B1, 0, 1); PG8_SCHED; PG8_LDA(At, 0, 0); PG8_STAGE_A(PG8_SA(1, 1), a1 + hstep, false, 1, (size_t)(t + 1) * kstep);
            PG8_WAIT_V(8); PG8_WAIT_L(0); PG8_BAR; PG8_MMA(0, 0, At, B0); PG8_MMA(0, 1, At, B1); PG8_BAR; PG8_SCHED;
            PG8_LDA(At, 0, 1); PG8_STAGE(PG8_SB(0, 0), b2, voffB); PG8_STAGE(PG8_SB(0, 1), b2 + bhstep, voffB); PG8_STAGE_A(PG8_SA(0, 0), a2, last, 0, k2b);
            PG8_WAIT_V(8); PG8_WAIT_L(0); PG8_BAR; PG8_MMA(1, 0, At, B0); PG8_MMA(1, 1, At, B1); PG8_BAR; PG8_SCHED;
            PG8_LDB(B0, 1, 0); PG8_LDB(B1, 1, 1); PG8_SCHED; PG8_LDA(At, 1, 0); PG8_STAGE_A(PG8_SA(0, 1), a2 + hstep, last, 1, k2b);
            PG8_WAIT_V(8); PG8_WAIT_L(0); PG8_BAR; PG8_MMA(0, 0, At, B0); PG8_MMA(0, 1, At, B1); PG8_BAR; PG8_SCHED;
            PG8_LDA(At, 1, 1); PG8_STAGE(PG8_SB(1, 0), b3, voffB); PG8_STAGE(PG8_SB(1, 1), b3 + bhstep, voffB); PG8_STAGE_A(PG8_SA(1, 0), a3, last, 0, k2b + kstep);
            PG8_WAIT_V(8); PG8_WAIT_L(0); PG8_BAR; PG8_MMA(1, 0, At, B0); PG8_MMA(1, 1, At, B1); PG8_BAR; PG8_SCHED;
            } else {
            PG8_LDB(B0, 0, 0); PG8_SCHED; PG8_LDA(At, 0, 0); PG8_STAGE(PG8_SA(1, 1), a1 + hstep, voffA);
            PG8_WAIT_L(8); PG8_BAR; PG8_WAIT_L(0); PG8_MMA(0, 0, At, B0); PG8_BAR; PG8_SCHED;
            PG8_LDB(B1, 0, 1); PG8_STAGE(PG8_SB(0, 0), b2, voffB);
            PG8_BAR; PG8_WAIT_L(0); PG8_MMA(0, 1, At, B1); PG8_BAR;
            PG8_LDA(At, 0, 1); PG8_STAGE(PG8_SA(0, 0), a2, voffA);
            PG8_BAR; PG8_WAIT_L(0); PG8_MMA(1, 0, At, B0); PG8_BAR; PG8_SCHED;
            PG8_STAGE(PG8_SB(0, 1), b2 + bhstep, voffB);
            PG8_WAIT_V(6); PG8_BAR; PG8_MMA(1, 1, At, B1); PG8_BAR;
            PG8_LDB(B0, 1, 0); PG8_SCHED; PG8_LDA(At, 1, 0); PG8_STAGE(PG8_SA(0, 1), a2 + hstep, voffA);
            PG8_WAIT_L(8); PG8_BAR; PG8_WAIT_L(0); PG8_MMA(0, 0, At, B0); PG8_BAR; PG8_SCHED;
            PG8_LDB(B1, 1, 1); PG8_STAGE(PG8_SB(1, 0), b3, voffB);
            PG8_BAR; PG8_WAIT_L(0); PG8_MMA(0, 1, At, B1); PG8_BAR;
            PG8_LDA(At, 1, 1); PG8_STAGE(PG8_SA(1, 0), a3, voffA);
            PG8_BAR; PG8_WAIT_L(0); PG8_MMA(1, 0, At, B0); PG8_BAR; PG8_SCHED;
            PG8_STAGE(PG8_SB(1, 1), b3 + bhstep, voffB);
            PG8_WAIT_V(6); PG8_BAR; PG8_MMA(1, 1, At, B1); PG8_BAR;
            }
        }
        }
        if constexpr (ALIGN_EPI) { if (wr == 0) PG8_BAR; }
        if constexpr (!Epi::AFTER_DRAIN) { E(acc, cur, wr, wc, fr, fq); S.done(cur); }
        if (!has_next) break;
#pragma unroll
        for (int a = 0; a < 2; ++a)
#pragma unroll
            for (int b = 0; b < 2; ++b)
#pragma unroll
                for (int m = 0; m < 4; ++m)
#pragma unroll
                    for (int n = 0; n < 2; ++n) acc[a][b][m][n] = (f32x4){0.f, 0.f, 0.f, 0.f};
        cur = nxt; cA = nA; cB = nB; ++ui;
        if constexpr (Sched::GATHER) { gc[0][0] = gn[0][0]; gc[0][1] = gn[0][1]; gc[1][0] = gn[1][0]; gc[1][1] = gn[1][1]; }
        if constexpr (ALIGN_EPI) { if (wr == 1) PG8_BAR; }
    }
    PG8_WAIT_V(0);
    if constexpr (!ALIGN_EPI) { if (wr == 0) PG8_BAR; }
    PG8_BAR;
    if constexpr (Epi::AFTER_DRAIN) { E.fused(acc, cur, wr, wc, fr, fq, lds, wid, lane); S.done(cur); }
#undef PG8_SA
#undef PG8_SB
#undef PG8_STAGE
#undef PG8_STAGE_A
#undef PG8_GOFF
#undef PG8_LDA
#undef PG8_LDB
#undef PG8_MMA
#undef PG8_WAIT_V
#undef PG8_WAIT_L
#undef PG8_BAR
#undef PG8_SCHED
}
}
#define LAS __attribute__((address_space(3)))
#define XB_TMO      128
#define XB_XCNT(j)  (256  + 64 * (j))
#define XB_XSUB(j)  (1280 + 64 * (j))
#define XB_XGEN(j)  (2304 + 64 * (j))
#define XB_TOP      3328
#define XB_TOPGEN   3392
#define XCD_BAR_WORDS 3456
#define XB_SPIN_CAP (1u << 18)

__device__ __forceinline__ unsigned xb_ld(unsigned* p)              { return __hip_atomic_load(p, __ATOMIC_RELAXED, __HIP_MEMORY_SCOPE_AGENT); }
__device__ __forceinline__ unsigned xb_add(unsigned* p, unsigned v) { return __hip_atomic_fetch_add(p, v, __ATOMIC_RELAXED, __HIP_MEMORY_SCOPE_AGENT); }
__device__ __forceinline__ unsigned xb_xcc_id() { return (unsigned)__builtin_amdgcn_s_getreg((3 << 11) | 20) & 0xFu; }
#define XB_SPIN(cond, bar) do { unsigned _sp = 0; while (cond) { __builtin_amdgcn_s_sleep(1); \
    if ((++_sp & 255u) == 0u) { if (xb_ld(&(bar)[XB_TMO])) break; if (_sp > XB_SPIN_CAP) { atomicAdd(&(bar)[XB_TMO], 1u); break; } } } } while (0)

struct XcdBarrier {
    unsigned* bar; unsigned x;
    volatile LAS unsigned* st;
};

__device__ __forceinline__ XcdBarrier xcd_barrier_post(unsigned* bar, volatile LAS unsigned* st) {
    XcdBarrier b; b.bar = bar; b.x = xb_xcc_id(); b.st = st;
    if (threadIdx.x == 0) (void)xb_add(&bar[XB_XCNT(b.x)], 1u);
    return b;
}
__device__ __forceinline__ void xcd_barrier_complete(unsigned* bar, unsigned x, unsigned& nloc, unsigned& nx) {
    const unsigned G = gridDim.x * gridDim.y * gridDim.z;
    unsigned sum, cnt, mine, sp = 0u;
    for (;;) {
        sum = 0u; cnt = 0u; mine = 0u;
#pragma unroll
        for (unsigned j = 0; j < 16; ++j) { const unsigned c = xb_ld(&bar[XB_XCNT(j)]); sum += c; cnt += (c > 0u) ? 1u : 0u; mine = (j == x) ? c : mine; }
        if (sum == G) break;
        __builtin_amdgcn_s_sleep(1);
        if ((++sp & 255u) == 0u) { if (xb_ld(&bar[XB_TMO])) break; if (sp > XB_SPIN_CAP) { atomicAdd(&bar[XB_TMO], 1u); break; } }
    }
    nloc = mine > 0u ? mine : 1u; nx = cnt > 0u ? cnt : 1u;
}

__device__ __forceinline__ void xcd_barrier(const XcdBarrier& b) {
    asm volatile("s_waitcnt vmcnt(0)" ::: "memory");
    __syncthreads();
    if (threadIdx.x == 0) {
        unsigned* bar = b.bar;
        __builtin_amdgcn_s_waitcnt(0);
        unsigned nloc = b.st[0], nx = b.st[1];
        if (nloc == 0u) { xcd_barrier_complete(bar, b.x, nloc, nx); b.st[0] = nloc; b.st[1] = nx; }
        const unsigned old = xb_add(&bar[XB_XSUB(b.x)], 1u);
        const unsigned gen = old / nloc;
        if (old + 1u == (gen + 1u) * nloc) {
            __builtin_amdgcn_fence(__ATOMIC_RELEASE, "agent");
            asm volatile("s_waitcnt vmcnt(0)" ::: "memory");
            const unsigned og = xb_add(&bar[XB_TOP], 1u);
            const unsigned tg = og / nx;
            if (og + 1u == (tg + 1u) * nx) xb_add(&bar[XB_TOPGEN], 1u);
            else XB_SPIN(xb_ld(&bar[XB_TOPGEN]) == tg, bar);
            __builtin_amdgcn_fence(__ATOMIC_ACQUIRE, "agent");
            xb_add(&bar[XB_XGEN(b.x)], 1u);
            asm volatile("s_waitcnt vmcnt(0)" ::: "memory");
        } else {
            XB_SPIN(xb_ld(&bar[XB_XGEN(b.x)]) == gen, bar);
            __builtin_amdgcn_fence(__ATOMIC_ACQUIRE, "agent");
            asm volatile("s_waitcnt vmcnt(0)" ::: "memory");
        }
    }
    __syncthreads();
}


#ifndef PG8_SP2
#define PG8_SP2 true
#endif
#ifndef PG8_ALIGN
#define PG8_ALIGN true
#endif
constexpr int D = 1024, NB = 8, SEQ = 4096, T = NB * SEQ, NL = 4;
constexpr int NIN = 8704, NE = 32, FF = 1024;
constexpr int RMAX = 139264;
constexpr float LN_EPS = 1e-5f, DN_ALPHA = 1.681792830507429f;
constexpr float QSCALE = 0.18033688011112042f;
constexpr float LOG2E = 1.4426950408889634f;

constexpr size_t MiB = 1u << 20;
constexpr size_t WS_CTL = 0, CTL_ZERO_BYTES = 1 * MiB;
constexpr size_t WS_MOD = 1 * MiB;
constexpr size_t WS_ROPE = 2 * MiB;
constexpr size_t WS_WSP = 3 * MiB;
constexpr size_t WS_WRT = 4 * MiB;
constexpr size_t WS_TOKINFO = 5 * MiB;
constexpr size_t WS_TOKW = 5 * MiB + 512 * 1024;
constexpr size_t WS_ROWTOK = 6 * MiB;
constexpr size_t WS_ROWW = 7 * MiB;
constexpr size_t WS_LSE = 8 * MiB;
constexpr size_t WS_TOKROW = 14 * MiB;
constexpr size_t WS_STAT = 13 * MiB;
constexpr size_t WS_WGCNT = 12 * MiB;
constexpr size_t WS_WIN = 16 * MiB;
constexpr size_t WS_WBA = 84 * MiB;
constexpr size_t WS_WBB = 92 * MiB;
constexpr size_t WS_WOUT = 96 * MiB;
constexpr size_t WS_WUP = 104 * MiB;
constexpr size_t WS_WDN = 616 * MiB;
constexpr size_t WS_H = 872 * MiB;
constexpr size_t WS_X1 = 936 * MiB;
constexpr size_t WS_X2 = 1064 * MiB;
constexpr size_t WS_YPRE = 1192 * MiB;
constexpr size_t WS_U = 1320 * MiB, WS_V = 1384 * MiB;
constexpr size_t WS_Q = 1448 * MiB, WS_K = 1544 * MiB, WS_VV = 1640 * MiB;
constexpr size_t WS_G = 1736 * MiB;
constexpr size_t WS_OG = 1864 * MiB;
constexpr size_t WS_TT = 1960 * MiB;
constexpr size_t WS_OB = 2024 * MiB;
constexpr size_t WS_YA = 2056 * MiB;
constexpr size_t WS_MG = 2120 * MiB;
constexpr size_t WS_XG = 2184 * MiB;
constexpr size_t WS_ACT = 2456 * MiB;
constexpr size_t WS_YK = 2728 * MiB;
constexpr size_t WS_END = 2984 * MiB;
constexpr int CW_BAR = 4096;
constexpr int CW_CNT = 16384;

constexpr int RING_BYTES = 131072;
constexpr int XOFF = RING_BYTES;
constexpr int X_MISC = XOFF;
constexpr int X_SELE = XOFF + 256;
constexpr int X_SELR = XOFF + 2304;
constexpr int X_CNTL = XOFF + 4352;
constexpr int X_BASE = XOFF + 4480;
constexpr int X_TILEE = XOFF + 4608;
constexpr int X_CNTS = XOFF + 5632;
constexpr int X_OFFS = XOFF + 5760;
constexpr int LDS_BYTES = 147456;

#define GAS __attribute__((address_space(1)))
typedef unsigned short bf16;
typedef unsigned v4u __attribute__((ext_vector_type(4)));
typedef unsigned v2u __attribute__((ext_vector_type(2)));
typedef float f32x4 __attribute__((ext_vector_type(4)));
typedef short bf16x8 __attribute__((ext_vector_type(8)));
typedef short s16x4 __attribute__((ext_vector_type(4)));
#define RLX_AGENT __ATOMIC_RELAXED, __HIP_MEMORY_SCOPE_AGENT
#define LDS_WAIT() asm volatile("s_waitcnt lgkmcnt(0)" ::: "memory")
#define VM_WAIT() asm volatile("s_waitcnt vmcnt(0)" ::: "memory")

typedef __bf16 bf16x2_t __attribute__((ext_vector_type(2))); typedef float f32x2_t __attribute__((ext_vector_type(2)));
__device__ __forceinline__ unsigned pk2(float lo, float hi) { return __builtin_bit_cast(unsigned, __builtin_convertvector((f32x2_t){lo, hi}, bf16x2_t)); }
__device__ __forceinline__ float bflo(unsigned w) { return __uint_as_float(w << 16); }
__device__ __forceinline__ float bfhi(unsigned w) { return __uint_as_float(w & 0xffff0000u); }
__device__ __forceinline__ float fexp2(float x) { return __builtin_amdgcn_exp2f(x); }
__device__ __forceinline__ float frcp(float x) { return __builtin_amdgcn_rcpf(x); }
__device__ __forceinline__ float gelu_tanh(float x) { const float u = x + 0.044715f * x * x * x; return x * frcp(1.0f + fexp2(-2.302208198144325f * u)); }
__device__ __forceinline__ float sigmoidf_(float x) { return frcp(1.0f + fexp2(-LOG2E * x)); }
__device__ __forceinline__ float wave_sum(float v) {
#pragma unroll
    for (int o = 1; o < 64; o <<= 1) v += __shfl_xor(v, o);
    return v;
}
__device__ __forceinline__ float wave_max(float v) {
#pragma unroll
    for (int o = 1; o < 64; o <<= 1) v = fmaxf(v, __shfl_xor(v, o));
    return v;
}
__device__ __forceinline__ s16x4 tr16(const LAS unsigned char* p) { return __builtin_bit_cast(s16x4, __builtin_amdgcn_ds_read_tr16_b64_v4i16((LAS s16x4*)p)); }
__device__ __forceinline__ bf16x8 cat8(s16x4 lo, s16x4 hi) { return (bf16x8){lo[0], lo[1], lo[2], lo[3], hi[0], hi[1], hi[2], hi[3]}; }
__device__ __forceinline__ f32x4 mfma16(bf16x8 a, bf16x8 b, f32x4 c) { return __builtin_amdgcn_mfma_f32_16x16x32_bf16(a, b, c, 0, 0, 0); }

struct Frame {
    LAS unsigned char* lds;
    int tid, lane, wave, G, vcu, bx;
    unsigned char* ws;
    const float* const* in;
    float* out;
};
enum { I_X = 0, I_C, I_WADA, I_BADA, I_WIN, I_SPW, I_SPB, I_WBA, I_WBB, I_WOUT, I_LN1G, I_LN1B, I_WR, I_BR, I_WUP, I_BUP, I_WDN, I_BDN, I_LN2G, I_LN2B };
template <class Tp> __device__ __forceinline__ Tp* wsp(const Frame& F, size_t off) { return (Tp*)(F.ws + off); }

template <class P> __device__ __forceinline__ P launder(P p) { unsigned lo = (unsigned)(uintptr_t)p, hi = (unsigned)((uintptr_t)p >> 32); asm volatile("" : "+v"(lo), "+v"(hi));
    lo = (unsigned)__builtin_amdgcn_readfirstlane((int)lo); hi = (unsigned)__builtin_amdgcn_readfirstlane((int)hi); return (P)(((uintptr_t)hi << 32) | (uintptr_t)lo); }
__device__ __forceinline__ unsigned fl_x8(unsigned v) { return (unsigned)__builtin_amdgcn_update_dpp(0, (int)v, 0x128, 0xf, 0xf, false); }
#ifndef FLNT
#define FLNT true
#endif
template <bool NT> __device__ __forceinline__ void fl_put(bf16* p, size_t ld, bool lo, const v4u& w0, const v4u& w1) {
    v4u sd; sd.x = lo ? w1.x : w0.x; sd.y = lo ? w1.y : w0.y; sd.z = lo ? w1.z : w0.z; sd.w = lo ? w1.w : w0.w;
    v4u rc; rc.x = fl_x8(sd.x); rc.y = fl_x8(sd.y); rc.z = fl_x8(sd.z); rc.w = fl_x8(sd.w);
    v4u oa, ob; oa.x = lo ? w0.x : rc.x; oa.y = lo ? w0.y : rc.y; oa.z = lo ? w0.z : rc.z; oa.w = lo ? w0.w : rc.w;
    ob.x = lo ? rc.x : w1.x; ob.y = lo ? rc.y : w1.y; ob.z = lo ? rc.z : w1.z; ob.w = lo ? rc.w : w1.w;
    if (NT) { __builtin_nontemporal_store(oa, (v4u*)p); __builtin_nontemporal_store(ob, (v4u*)(p + 8 * ld)); } else { *(v4u*)p = oa; *(v4u*)(p + 8 * ld) = ob; } }
struct EpiIn {
    static constexpr int MID_T = 0; static constexpr bool PERM = true, AFTER_DRAIN = false, BADJ = true, ABLK = false;
    bf16 *U, *V, *Q, *K, *VV, *Gt; const float* rope;
    __device__ __forceinline__ void operator()(const f32x4 (&acc)[2][2][4][2], const pg8::Unit& u, int wr, int wc, int fr, int fq) const {
        const int pn = u.pn; int type, ld, colt; bf16* base;
        if (pn < 4) { type = 0; base = U; ld = 1024; colt = pn * 256; }
        else if (pn < 8) { type = 0; base = V; ld = 1024; colt = (pn - 4) * 256; }
        else if (pn < 14) { type = 1; base = Q; ld = 1536; colt = (pn - 8) * 256; }
        else if (pn < 20) { type = 2; base = K; ld = 1536; colt = (pn - 14) * 256; }
        else if (pn < 26) { type = 3; base = VV; ld = 1536; colt = (pn - 20) * 256; }
        else { type = 4; base = Gt; ld = 2048; colt = (pn - 26) * 256; }
        const bool lo = fr < 8;
        const int rowl = u.pm * 256 + wr * 64 + fr;
        bf16* const pst = base + (size_t)(u.pm * 256 + wr * 64 + (fr & 7)) * ld + colt + wc * 64 + (fr >> 3) * 32 + 8 * fq;
        if (type == 0) {
#pragma unroll
            for (int ai = 0; ai < 2; ++ai)
#pragma unroll
                for (int m = 0; m < 4; ++m) { v4u w[2];
#pragma unroll
                    for (int bj = 0; bj < 2; ++bj) { const f32x4 v0 = acc[ai][bj][m][0], v1 = acc[ai][bj][m][1];
                        w[bj].x = pk2(gelu_tanh(v0[0]), gelu_tanh(v0[1])); w[bj].y = pk2(gelu_tanh(v0[2]), gelu_tanh(v0[3]));
                        w[bj].z = pk2(gelu_tanh(v1[0]), gelu_tanh(v1[1])); w[bj].w = pk2(gelu_tanh(v1[2]), gelu_tanh(v1[3])); }
                    fl_put<true>(pst + (size_t)(ai * 128 + m * 16) * ld, ld, lo, w[0], w[1]); }
        } else if (type == 4) {
#pragma unroll
            for (int ai = 0; ai < 2; ++ai)
#pragma unroll
                for (int m = 0; m < 4; ++m) { v4u w[2];
#pragma unroll
                    for (int bj = 0; bj < 2; ++bj) { const f32x4 v0 = acc[ai][bj][m][0], v1 = acc[ai][bj][m][1];
                        w[bj].x = pk2(sigmoidf_(v0[0]), sigmoidf_(v0[1])); w[bj].y = pk2(sigmoidf_(v0[2]), sigmoidf_(v0[3]));
                        w[bj].z = pk2(sigmoidf_(v1[0]), sigmoidf_(v1[1])); w[bj].w = pk2(sigmoidf_(v1[2]), sigmoidf_(v1[3])); }
                    fl_put<true>(pst + (size_t)(ai * 128 + m * 16) * ld, ld, lo, w[0], w[1]); }
        } else if (type == 3) {
#pragma unroll
            for (int ai = 0; ai < 2; ++ai)
#pragma unroll
                for (int m = 0; m < 4; ++m) { v4u w[2];
#pragma unroll
                    for (int bj = 0; bj < 2; ++bj) { const f32x4 v0 = acc[ai][bj][m][0], v1 = acc[ai][bj][m][1];
                        w[bj].x = pk2(v0[0], v0[1]); w[bj].y = pk2(v0[2], v0[3]); w[bj].z = pk2(v1[0], v1[1]); w[bj].w = pk2(v1[2], v1[3]); }
                    fl_put<true>(pst + (size_t)(ai * 128 + m * 16) * ld, ld, lo, w[0], w[1]); }
        } else {
            const float sc = (type == 1) ? QSCALE : 1.0f;
#pragma unroll
            for (int ai = 0; ai < 2; ++ai)
#pragma unroll
                for (int m = 0; m < 4; ++m) { const int row = rowl + ai * 128 + m * 16;
                    const f32x4* rp = (const f32x4*)(rope + (size_t)(row & (SEQ - 1)) * 16); const f32x4 c0 = rp[0], c1 = rp[1], s0 = rp[2], s1 = rp[3];
                    float cs[8], sn[8];
#pragma unroll
                    for (int e = 0; e < 4; ++e) { cs[e] = c0[e]; cs[4 + e] = c1[e]; sn[e] = s0[e]; sn[4 + e] = s1[e]; }
                    v4u w[2];
#pragma unroll
                    for (int bj = 0; bj < 2; ++bj) { f32x4 v0 = acc[ai][bj][m][0], v1 = acc[ai][bj][m][1];
                        if (bj == 0) {
#pragma unroll
                            for (int e = 0; e < 8; ++e) { const float x = (e < 4) ? v0[e & 3] : v1[e & 3]; const float p = __shfl_xor(x, 16);
                                float y = x;
                                if (fq == 0) y = x * cs[e] - p * sn[e];
                                if (fq == 1) y = x * cs[e] + p * sn[e];
                                if (e < 4) v0[e & 3] = y; else v1[e & 3] = y; } }
                        w[bj].x = pk2(v0[0] * sc, v0[1] * sc); w[bj].y = pk2(v0[2] * sc, v0[3] * sc); w[bj].z = pk2(v1[0] * sc, v1[1] * sc); w[bj].w = pk2(v1[2] * sc, v1[3] * sc); }
                    fl_put<true>(pst + (size_t)(ai * 128 + m * 16) * ld, ld, lo, w[0], w[1]); }
        }
    }
};
struct EpiProbe {
    static constexpr int MID_T = 0; static constexpr bool PERM = true, AFTER_DRAIN = false, BADJ = false, ABLK = false;
    bf16* O; int ld; int on;
    __device__ __forceinline__ void operator()(const f32x4 (&acc)[2][2][4][2], const pg8::Unit& u, int wr, int wc, int fr, int fq) const {
        if (!on) return;
        const int row0 = u.pm * 256 + wr * 64 + fr, col0 = ((on == 3) ? u.pn : (u.pn & 3)) * 256 + wc * 32 + 8 * fq;
#pragma unroll
        for (int ai = 0; ai < 2; ++ai)
#pragma unroll
            for (int m = 0; m < 4; ++m) { bf16* rowp = O + (size_t)(row0 + ai * 128 + m * 16) * ld + col0;
#pragma unroll
                for (int bj = 0; bj < 2; ++bj) { const f32x4 v0 = acc[ai][bj][m][0], v1 = acc[ai][bj][m][1]; v4u w;
                    w.x = pk2(v0[0], v0[1]); w.y = pk2(v0[2], v0[3]); w.z = pk2(v1[0], v1[1]); w.w = pk2(v1[2], v1[3]);
                    *(v4u*)(rowp + bj * 128) = w; } }
    }
};
struct EpiYA {
    static constexpr int MID_T = 0; static constexpr bool PERM = true, AFTER_DRAIN = false, BADJ = false, ABLK = false;
    const bf16* Gt; bf16* YA;
    __device__ __forceinline__ void operator()(const f32x4 (&acc)[2][2][4][2], const pg8::Unit& u, int wr, int wc, int fr, int fq) const {
        const int row0 = u.pm * 256 + wr * 64 + fr, col0 = u.pn * 256 + wc * 32 + 8 * fq;
#pragma unroll
        for (int ai = 0; ai < 2; ++ai)
#pragma unroll
            for (int m = 0; m < 4; ++m) { const size_t row = (size_t)(row0 + ai * 128 + m * 16);
#pragma unroll
                for (int bj = 0; bj < 2; ++bj) { const f32x4 v0 = acc[ai][bj][m][0], v1 = acc[ai][bj][m][1];
                    const v4u g = *(const v4u*)(Gt + row * 2048 + col0 + bj * 128); v4u w;
                    w.x = pk2(v0[0] * bflo(g.x), v0[1] * bfhi(g.x)); w.y = pk2(v0[2] * bflo(g.y), v0[3] * bfhi(g.y));
                    w.z = pk2(v1[0] * bflo(g.z), v1[1] * bfhi(g.z)); w.w = pk2(v1[2] * bflo(g.w), v1[3] * bfhi(g.w));
                    *(v4u*)(YA + row * 1024 + col0 + bj * 128) = w; } }
    }
};
struct EpiMg {
    static constexpr int MID_T = 0; static constexpr bool PERM = true, AFTER_DRAIN = false, BADJ = false, ABLK = false;
    const bf16* Gt; const bf16* YA; bf16* MG;
    __device__ __forceinline__ void operator()(const f32x4 (&acc)[2][2][4][2], const pg8::Unit& u, int wr, int wc, int fr, int fq) const {
        const int row0 = u.pm * 256 + wr * 64 + fr, col0 = u.pn * 256 + wc * 32 + 8 * fq;
#pragma unroll
        for (int ai = 0; ai < 2; ++ai)
#pragma unroll
            for (int m = 0; m < 4; ++m) { const size_t row = (size_t)(row0 + ai * 128 + m * 16);
#pragma unroll
                for (int bj = 0; bj < 2; ++bj) { const f32x4 v0 = acc[ai][bj][m][0], v1 = acc[ai][bj][m][1];
                    const v4u g = *(const v4u*)(Gt + row * 2048 + 1024 + col0 + bj * 128); const v4u y = *(const v4u*)(YA + row * 1024 + col0 + bj * 128); v4u w;
                    w.x = pk2(bflo(y.x) + v0[0] * bflo(g.x), bfhi(y.x) + v0[1] * bfhi(g.x)); w.y = pk2(bflo(y.y) + v0[2] * bflo(g.y), bfhi(y.y) + v0[3] * bfhi(g.y));
                    w.z = pk2(bflo(y.z) + v1[0] * bflo(g.z), bfhi(y.z) + v1[1] * bfhi(g.z)); w.w = pk2(bflo(y.w) + v1[2] * bflo(g.w), bfhi(y.w) + v1[3] * bfhi(g.w));
                    *(v4u*)(MG + row * 1024 + col0 + bj * 128) = w; } }
    }
};
struct EpiMg2 {
    static constexpr int MID_T = 16; static constexpr bool PERM = true, AFTER_DRAIN = false, BADJ = true, ABLK = false;
    const bf16* Gt; bf16* MG;
    __device__ __forceinline__ void mid(f32x4 (&acc)[2][2][4][2], const pg8::Unit& u, int wr, int wc, int fr, int fq) const {
        int row0 = u.pm * 256 + wr * 64 + fr; const int col0 = u.pn * 256 + wc * 64 + 8 * fq;
        asm volatile("" : "+v"(row0));
#pragma unroll
        for (int ai = 0; ai < 2; ++ai)
#pragma unroll
            for (int m = 0; m < 4; ++m) { const size_t row = (size_t)(row0 + ai * 128 + m * 16);
#pragma unroll
                for (int bj = 0; bj < 2; ++bj) { const v4u g0 = *(const v4u*)(Gt + row * 2048 + col0 + bj * 32), g1 = *(const v4u*)(Gt + row * 2048 + 1024 + col0 + bj * 32);
                    const unsigned a0[4] = {g0.x, g0.y, g0.z, g0.w}, a1[4] = {g1.x, g1.y, g1.z, g1.w};
#pragma unroll
                    for (int q = 0; q < 4; ++q) { const float r0 = bflo(a0[q]) * frcp(fmaxf(bflo(a1[q]), 1e-20f)), r1 = bfhi(a0[q]) * frcp(fmaxf(bfhi(a1[q]), 1e-20f));
                        acc[ai][bj][m][q >> 1][(q & 1) * 2] *= r0; acc[ai][bj][m][q >> 1][(q & 1) * 2 + 1] *= r1; } }
                if (m == 3) asm volatile("" ::: "memory"); }
    }
    __device__ __forceinline__ void operator()(const f32x4 (&acc)[2][2][4][2], const pg8::Unit& u, int wr, int wc, int fr, int fq) const {
        const int row0 = u.pm * 256 + wr * 64 + fr, col0 = u.pn * 256 + wc * 64 + 8 * fq; const bool lo = fr < 8;
        bf16* const pst = MG + (size_t)(u.pm * 256 + wr * 64 + (fr & 7)) * 1024 + u.pn * 256 + wc * 64 + (fr >> 3) * 32 + 8 * fq;
#pragma unroll
        for (int ai = 0; ai < 2; ++ai)
#pragma unroll
            for (int m = 0; m < 4; ++m) { const size_t row = (size_t)(row0 + ai * 128 + m * 16); v4u w[2];
#pragma unroll
                for (int bj = 0; bj < 2; ++bj) { const f32x4 v0 = acc[ai][bj][m][0], v1 = acc[ai][bj][m][1];
                    const v4u g = *(const v4u*)(Gt + row * 2048 + 1024 + col0 + bj * 32);
                    w[bj].x = pk2(v0[0] * fmaxf(bflo(g.x), 1e-20f), v0[1] * fmaxf(bfhi(g.x), 1e-20f)); w[bj].y = pk2(v0[2] * fmaxf(bflo(g.y), 1e-20f), v0[3] * fmaxf(bfhi(g.y), 1e-20f));
                    w[bj].z = pk2(v1[0] * fmaxf(bflo(g.z), 1e-20f), v1[1] * fmaxf(bfhi(g.z), 1e-20f)); w[bj].w = pk2(v1[2] * fmaxf(bflo(g.w), 1e-20f), v1[3] * fmaxf(bfhi(g.w), 1e-20f)); }
                fl_put<false>(pst + (size_t)(ai * 128 + m * 16) * 1024, 1024, lo, w[0], w[1]); }
    }
};
template <bool XF32> struct EpiOut {
    static constexpr int MID_T = 0; static constexpr bool PERM = true, AFTER_DRAIN = false, BADJ = true, ABLK = false;
    const void* xres; const float* modl  ; bf16* YPRE;
    __device__ __forceinline__ void operator()(const f32x4 (&acc)[2][2][4][2], const pg8::Unit& u, int wr, int wc, int fr, int fq) const {
        const int row0 = u.pm * 256 + wr * 64 + fr, col0 = u.pn * 256 + wc * 64 + 8 * fq; const int b = (u.pm * 256) >> 12; const bool lo = fr < 8;
        bf16* const pst = YPRE + (size_t)(u.pm * 256 + wr * 64 + (fr & 7)) * 1024 + u.pn * 256 + wc * 64 + (fr >> 3) * 32 + 8 * fq;
        f32x4 gg[2][2];
#pragma unroll
        for (int bj = 0; bj < 2; ++bj)
#pragma unroll
            for (int n = 0; n < 2; ++n) gg[bj][n] = *(const f32x4*)(modl + (size_t)b * 6144 + 2048 + col0 + bj * 32 + 4 * n) + 1.0f;
#pragma unroll
        for (int ai = 0; ai < 2; ++ai)
#pragma unroll
            for (int m = 0; m < 4; ++m) { const size_t off = (size_t)(row0 + ai * 128 + m * 16) * 1024 + col0; v4u w[2];
#pragma unroll
                for (int bj = 0; bj < 2; ++bj) { f32x4 x0, x1;
                    if (XF32) { x0 = *(const f32x4*)((const float*)xres + off + bj * 32); x1 = *(const f32x4*)((const float*)xres + off + bj * 32 + 4); }
                    else { const v4u xr = *(const v4u*)((const bf16*)xres + off + bj * 32); x0 = (f32x4){bflo(xr.x), bfhi(xr.x), bflo(xr.y), bfhi(xr.y)}; x1 = (f32x4){bflo(xr.z), bfhi(xr.z), bflo(xr.w), bfhi(xr.w)}; }
                    const f32x4 o0 = x0 * DN_ALPHA + gg[bj][0] * acc[ai][bj][m][0], o1 = x1 * DN_ALPHA + gg[bj][1] * acc[ai][bj][m][1];
                    w[bj].x = pk2(o0[0], o0[1]); w[bj].y = pk2(o0[2], o0[3]); w[bj].z = pk2(o1[0], o1[1]); w[bj].w = pk2(o1[2], o1[3]); }
                fl_put<false>(pst + (size_t)(ai * 128 + m * 16) * 1024, 1024, lo, w[0], w[1]);
                if (m == 3) asm volatile("" ::: "memory"); }
    }
};
#ifndef ACT_NT
#define ACT_NT 1
#endif
struct EpiUp {
    static constexpr int MID_T = 0; static constexpr bool PERM = true, AFTER_DRAIN = false, BADJ = false, ABLK = false;
    const float* bup  ; bf16* ACT;
    __device__ __forceinline__ void operator()(const f32x4 (&acc)[2][2][4][2], const pg8::Unit& u, int wr, int wc, int fr, int fq) const {
        const int e = u.pn >> 3, pnl = u.pn & 7; const int row0 = u.pm * 256 + wr * 64 + fr, ac0 = pnl * 128 + wc * 32 + 8 * fq;
        const f32x4* bp = (const f32x4*)(bup + (size_t)e * 2048 + 2 * ac0); const f32x4 b0 = bp[0], b1 = bp[1], b2 = bp[2], b3 = bp[3];
        const float bg[8] = {b0[0], b0[2], b1[0], b1[2], b2[0], b2[2], b3[0], b3[2]}, bl[8] = {b0[1], b0[3], b1[1], b1[3], b2[1], b2[3], b3[1], b3[3]};
#pragma unroll
        for (int ai = 0; ai < 2; ++ai)
#pragma unroll
            for (int m = 0; m < 4; ++m) { float a[8];
#pragma unroll
                for (int j = 0; j < 8; ++j) { const float hg = acc[ai][0][m][j >> 2][j & 3] + bg[j], hl = acc[ai][1][m][j >> 2][j & 3] + bl[j];
                    const float glu = fminf(hg, 7.0f), lin = fminf(fmaxf(hl, -7.0f), 7.0f);
                    a[j] = glu * frcp(1.0f + fexp2(-2.4554669595930156f * glu)) * (lin + 1.0f); }
                v4u w; w.x = pk2(a[0], a[1]); w.y = pk2(a[2], a[3]); w.z = pk2(a[4], a[5]); w.w = pk2(a[6], a[7]);
                { const size_t g16 = (size_t)((u.pm * 256 + wr * 64 + ai * 128 + m * 16) >> 4); unsigned char* lp = (unsigned char*)ACT + ((g16 * 32 + (size_t)(pnl * 4 + wc)) * 8 + (fr & 7)) * 128 + (fr >> 3) * 64 + 16 * fq;
                  if (ACT_NT) __builtin_nontemporal_store(w, (v4u*)lp); else *(v4u*)lp = w; } }
    }
};
struct EpiDn {
    static constexpr int MID_T = 0; static constexpr bool PERM = true, AFTER_DRAIN = false, BADJ = true, ABLK = true;
    const float* bdn  ; bf16* YKS;
    __device__ __forceinline__ void operator()(const f32x4 (&acc)[2][2][4][2], const pg8::Unit& u, int wr, int wc, int fr, int fq) const {
        const int e = u.pn >> 2, pnl = u.pn & 3; const int col0 = pnl * 256 + wc * 64 + 8 * fq; const bool lo = fr < 8;
        bf16* const pst = YKS + (size_t)(u.pm * 256 + wr * 64 + (fr & 7)) * 1024 + pnl * 256 + wc * 64 + (fr >> 3) * 32 + 8 * fq;
        f32x4 bv[2][2];
#pragma unroll
        for (int bj = 0; bj < 2; ++bj)
#pragma unroll
            for (int n = 0; n < 2; ++n) bv[bj][n] = *(const f32x4*)(bdn + (size_t)e * 1024 + col0 + bj * 32 + 4 * n);
#pragma unroll
        for (int ai = 0; ai < 2; ++ai)
#pragma unroll
            for (int m = 0; m < 4; ++m) { v4u w[2];
#pragma unroll
                for (int bj = 0; bj < 2; ++bj) { const f32x4 v0 = acc[ai][bj][m][0] + bv[bj][0], v1 = acc[ai][bj][m][1] + bv[bj][1];
                    w[bj].x = pk2(v0[0], v0[1]); w[bj].y = pk2(v0[2], v0[3]); w[bj].z = pk2(v1[0], v1[1]); w[bj].w = pk2(v1[2], v1[3]); }
                fl_put<FLNT>(pst + (size_t)(ai * 128 + m * 16) * 1024, 1024, lo, w[0], w[1]); }
    }
};
struct MoeOrder {
    static constexpr bool GATHER = false; __device__ __forceinline__ int arow(int, int r) const { return r; }
    int nM, nN, nwg, G, c, rev; const LAS unsigned char* tile_e;
    __device__ void init(int RT, int NN, int G_, int c_, const LAS unsigned char* te, int rev_ = 0) { nM = RT; nN = NN; nwg = RT * NN; G = G_; c = c_; tile_e = te; rev = rev_; }
    __device__ bool next(int i, pg8::Unit& u) const {
        const long L = (long)i * G + c; if (L >= nwg) return false;
        int wgid = (int)L; { const int q = nwg / pg8::NXCD, r = nwg % pg8::NXCD, xcd = wgid % pg8::NXCD, off = wgid / pg8::NXCD; wgid = (xcd < r ? xcd * (q + 1) : r * (q + 1) + (xcd - r) * q) + off; }
        const int nig = pg8::WGM * nN, gid = wgid / nig, fm = gid * pg8::WGM, gsz = (nM - fm) < pg8::WGM ? (nM - fm) : pg8::WGM;
        int pm = fm + ((wgid % nig) % gsz); const int pnl = (wgid % nig) / gsz; if (rev) pm = nM - 1 - pm;
        u.pm = pm; u.pn = (int)tile_e[pm] * nN + pnl; return true;
    }
    __device__ __forceinline__ void a_ready(const pg8::Unit&) const {}
    __device__ __forceinline__ void done(const pg8::Unit&) const {}
};

#ifndef STAG_N
#define STAG_N 1
#endif
#ifndef STAG_US
#define STAG_US 24
#endif
__device__ __forceinline__ void stagger(int slot, int us) {
    if (STAG_N <= 1) return;
    const unsigned long long t0 = __builtin_amdgcn_s_memrealtime(); const unsigned long long ticks = (unsigned long long)(slot % STAG_N) * (unsigned)us * 100ull / STAG_N;
    while (__builtin_amdgcn_s_memrealtime() - t0 < ticks) __builtin_amdgcn_s_sleep(16);
}
struct MoeGatherOrder : MoeOrder {
    static constexpr bool GATHER = true; const LAS unsigned short* tokl;
    __device__ __forceinline__ int arow(int ord, int r) const { return (int)tokl[ord * 256 + (r & 255)]; }
};
constexpr int X_TOKL = XOFF + 6144, TOKL_UNITS = 20;
constexpr int TR_NR = 32, TR_WAVE_BYTES = 64 * 64 * 4;
struct TrItem { const float* src; bf16* dst; int ld, K, kind, k0, c0, koff; };
__device__ __forceinline__ void tr_load(const TrItem& t, int lane, f32x4 (&r)[TR_NR]) {
    const int kq = lane >> 4, cc = lane & 15;
#pragma unroll
    for (int i = 0; i < TR_NR; ++i) r[i] = __builtin_nontemporal_load((const f32x4*)(t.src + (size_t)(t.k0 + 2 * (kq + 4 * (i >> 1)) + (i & 1)) * t.ld + t.c0 + 4 * cc));
}
__device__ __forceinline__ void tr_tile(int lane, LAS unsigned* scr, const f32x4 (&r)[TR_NR]) {
    const int kq = lane >> 4, cc = lane & 15;
#pragma unroll
    for (int i2 = 0; i2 < TR_NR / 2; ++i2) { LAS unsigned* p = scr + (4 * cc) * 64 + ((kq + 4 * i2) ^ (cc << 2));
#pragma unroll
        for (int e = 0; e < 4; ++e) p[e * 64] = pk2(r[2 * i2][e], r[2 * i2 + 1][e]); }
    LDS_WAIT(); asm volatile("" ::: "memory");
}
__device__ __forceinline__ void tr_store(const TrItem& t, int lane, const LAS unsigned* scr) {
    const int c = lane & 15;
    const int pbase = (t.kind == 0) ? t.c0 : (256 * (t.c0 >> 8) + ((t.c0 & 255) >> 1));
#pragma unroll
    for (int j = 0; j < 16; ++j) { const int n = (lane >> 4) + 4 * j; const v4u o = *(const LAS v4u*)(scr + n * 64 + ((c ^ j) << 2));
        const int drow = (t.kind == 0) ? (pbase + n) : (pbase + 128 * (n & 1) + (n >> 1));
        __builtin_nontemporal_store(o, (v4u*)(t.dst + (size_t)drow * t.K + t.koff + t.k0 + 8 * c)); }
    LDS_WAIT(); asm volatile("" ::: "memory");
}
__device__ __forceinline__ void sincos_d(double a, double& s, double& c) {
    const double k = rint(a * 0.63661977236758134308);
    const double y = fma(-k, 6.12323399573676603587e-17, fma(-k, 1.57079632679489655800, a));
    const double y2 = y * y;
    double sp = -7.6471637318198164759e-13; sp = fma(sp, y2, 1.6059043836821614599e-10); sp = fma(sp, y2, -2.5052108385441718775e-8); sp = fma(sp, y2, 2.7557319223985890653e-6);
    sp = fma(sp, y2, -1.9841269841269841270e-4); sp = fma(sp, y2, 8.3333333333333333333e-3); sp = fma(sp, y2, -1.6666666666666666667e-1); const double sy = fma(sp * y2, y, y);
    double cp = 4.7794773323873852974e-14; cp = fma(cp, y2, -1.1470745597729724714e-11); cp = fma(cp, y2, 2.0876756987868098979e-9); cp = fma(cp, y2, -2.7557319223985890653e-7);
    cp = fma(cp, y2, 2.4801587301587301587e-5); cp = fma(cp, y2, -1.3888888888888888889e-3); cp = fma(cp, y2, 4.1666666666666666667e-2); cp = fma(cp, y2, -0.5); const double cy = fma(cp, y2, 1.0);
    const int q = ((int)k) & 3;
    s = (q == 0) ? sy : (q == 1) ? cy : (q == 2) ? -sy : -cy;
    c = (q == 0) ? cy : (q == 1) ? -sy : (q == 2) ? -cy : sy;
}
__device__ __forceinline__ void phase_pro_a(Frame& F) {
    LAS unsigned* scr = (LAS unsigned*)(F.lds + F.wave * TR_WAVE_BYTES);
    const int gw = F.vcu * 8 + F.wave, NGW = F.G * 8;
    constexpr int I_IN = 8 * 136, I_SQ = 8 * 16, I_BB = 4 * 16, I_UP = 8 * 32;
    constexpr int S0 = NL * I_IN, S1 = S0 + NL * I_SQ, S2 = S1 + NL * I_BB, S3 = S2 + NL * I_SQ, S4 = S3 + NL * NE * I_SQ, S5 = S4 + NL * NE * I_UP;
    auto decode = [&](int it) -> TrItem { TrItem t; t.koff = 0;
        if (it < S0) { const int l = it / I_IN, r = it % I_IN; t.src = F.in[I_WIN] + (size_t)l * D * NIN; t.dst = wsp<bf16>(F, WS_WIN) + (size_t)l * NIN * D; t.ld = NIN; t.K = D; t.kind = 0; t.k0 = 128 * (r / 136); t.c0 = 64 * (r % 136); }
        else if (it < S1) { const int q = it - S0, l = q / I_SQ, r = q % I_SQ; t.src = F.in[I_WBA] + (size_t)l * D * D; t.dst = wsp<bf16>(F, WS_WBA) + (size_t)l * D * 1536; t.ld = D; t.K = 1536; t.kind = 0; t.k0 = 128 * (r / 16); t.c0 = 64 * (r % 16); }
        else if (it < S2) { const int q = it - S1, l = q / I_BB, r = q % I_BB; t.src = F.in[I_WBB] + (size_t)l * 512 * D; t.dst = wsp<bf16>(F, WS_WBA) + (size_t)l * D * 1536; t.ld = D; t.K = 1536; t.koff = 1024; t.kind = 0; t.k0 = 128 * (r / 16); t.c0 = 64 * (r % 16); }
        else if (it < S3) { const int q = it - S2, l = q / I_SQ, r = q % I_SQ; t.src = F.in[I_WOUT] + (size_t)l * D * D; t.dst = wsp<bf16>(F, WS_WOUT) + (size_t)l * D * D; t.ld = D; t.K = D; t.kind = 0; t.k0 = 128 * (r / 16); t.c0 = 64 * (r % 16); }
        else if (it < S4) { const int q = it - S3, le = q / I_SQ, r = q % I_SQ; t.src = F.in[I_WDN] + (size_t)le * FF * D; t.dst = wsp<bf16>(F, WS_WDN) + (size_t)le * D * FF; t.ld = D; t.K = FF; t.kind = 0; t.k0 = 128 * (r / 16); t.c0 = 64 * (r % 16); }
        else { const int q = it - S4, le = q / I_UP, r = q % I_UP; t.src = F.in[I_WUP] + (size_t)le * D * 2048; t.dst = wsp<bf16>(F, WS_WUP) + (size_t)le * 2048 * D; t.ld = 2048; t.K = D; t.kind = 1; t.k0 = 128 * (r / 32); t.c0 = 64 * (r % 32); }
        return t; };
    {
        f32x4 rn[TR_NR]; TrItem tn; int it = gw;
        if (it < S5) { tn = decode(it); tr_load(tn, F.lane, rn); }
#pragma unroll 1
        for (; it < S5; it += NGW) {
            const TrItem tc = tn;
            tr_tile(F.lane, scr, rn);
            if (it + NGW < S5) { tn = decode(it + NGW); tr_load(tn, F.lane, rn); }
            tr_store(tc, F.lane, scr);
        }
    }
    __syncthreads();
    {
        LAS float* cT = (LAS float*)F.lds;
        LAS float* red = (LAS float*)(F.lds + 32768);
        const float* cv = F.in[I_C];
        for (int i = F.tid; i < 8 * 1024; i += 512) { const int bb = i >> 10, k = i & 1023; cT[k * 8 + bb] = cv[i]; }
        __syncthreads();
        const int hf = F.lane >> 5, c4 = F.lane & 31;
        for (int u = F.vcu; u < NL * 48; u += F.G) {
            const int l = u / 48, n0 = 128 * (u % 48);
            f32x4 a[8];
#pragma unroll
            for (int bb = 0; bb < 8; ++bb) a[bb] = (f32x4){0.f, 0.f, 0.f, 0.f};
            const int kb = F.wave * 128 + hf;
            const float* wp = F.in[I_WADA] + (size_t)l * D * 6144 + (size_t)kb * 6144 + n0 + 4 * c4;
#pragma unroll 8
            for (int kk = 0; kk < 64; ++kk) { const f32x4 w = *(const f32x4*)(wp + (size_t)(2 * kk) * 6144);
                const f32x4 c0 = *(const LAS f32x4*)(cT + (kb + 2 * kk) * 8), c1 = *(const LAS f32x4*)(cT + (kb + 2 * kk) * 8 + 4);
#pragma unroll
                for (int bb = 0; bb < 4; ++bb) { a[bb] += w * c0[bb]; a[4 + bb] += w * c1[bb]; } }
#pragma unroll
            for (int bb = 0; bb < 8; ++bb) *(LAS f32x4*)(red + ((F.wave * 2 + hf) * 8 + bb) * 128 + 4 * c4) = a[bb];
            __syncthreads();
#pragma unroll
            for (int q = 0; q < 2; ++q) { const int o = F.tid + 512 * q, bb = o >> 7, cn = o & 127; float sum = F.in[I_BADA][l * 6144 + n0 + cn];
#pragma unroll
                for (int p = 0; p < 16; ++p) sum += red[(p * 8 + bb) * 128 + cn];
                wsp<float>(F, WS_MOD)[(size_t)(l * 8 + bb) * 6144 + n0 + cn] = sum; }
            __syncthreads();
        }
    }
    const int gt = F.vcu * 512 + F.tid, NT = F.G * 512;
    for (int i = gt; i < SEQ * 8; i += NT) { const int pos = i >> 3, f = i & 7;
        const double inv = (f == 0) ? 1.0 : (f == 1) ? 0.19392274474868576 : (f == 2) ? 0.03760603093086393 : (f == 3) ? 0.007292664737217109 : (f == 4) ? 0.001414213562373095 : (f == 5) ? 0.0002742481756762073 : (f == 6) ? 5.318295896944988e-05 : 1.031338537721246e-05;
        double s, c; sincos_d((double)pos * inv, s, c);
        float* rp = wsp<float>(F, WS_ROPE) + (size_t)pos * 16; rp[f] = (float)c; rp[8 + f] = (float)s; }
    for (int i = gt; i < NL * 4 * 128 * 128; i += NT) { const int j = i & 127, ii = (i >> 7) & 127; const float w = F.in[I_SPW][i];
        wsp<bf16>(F, WS_WSP)[i] = (bf16)(pk2((j <= ii) ? w : 0.f, 0.f) & 0xffffu); }
    for (int i = gt; i < NL * NE * D; i += NT) { const int k = i & 1023, e = (i >> 10) & 31, l = i >> 15; const float w = F.in[I_WR][((size_t)l * D + k) * NE + e];
        const unsigned hi = pk2(w, 0.f) & 0xffffu; const float lo = w - __uint_as_float(hi << 16);
        wsp<bf16>(F, WS_WRT)[i] = (bf16)hi; wsp<bf16>(F, WS_WRT)[NL * NE * D + i] = (bf16)(pk2(lo, 0.f) & 0xffffu); }
}
__device__ __forceinline__ void phase_pro_b(Frame& F) {
    const int gw = F.vcu * 8 + F.wave, NGW = F.G * 8;
    const float* mod = wsp<float>(F, WS_MOD);
    for (int m = gw; m < T; m += NGW) { const int b = m >> 12; const float* mb = mod + (size_t)b * 6144;
        const f32x4* xr = (const f32x4*)(F.in[I_X] + (size_t)m * D) + F.lane; v2u* hp = (v2u*)(wsp<bf16>(F, WS_H) + (size_t)m * D) + F.lane;
#pragma unroll
        for (int j = 0; j < 4; ++j) { const f32x4 x = xr[64 * j]; const f32x4 sh = *((const f32x4*)mb + F.lane + 64 * j), sc = *((const f32x4*)(mb + 1024) + F.lane + 64 * j);
            const f32x4 h = x * (sc + 1.0f) + sh; v2u o; o.x = pk2(h[0], h[1]); o.y = pk2(h[2], h[3]); hp[64 * j] = o; } }
}

constexpr int AT_RS = 144;
constexpr int AT_ROWS = 400, AT_VOFF = AT_ROWS * AT_RS;
#define LDS_BARRIER() do { asm volatile("s_waitcnt lgkmcnt(0)" ::: "memory"); __builtin_amdgcn_s_barrier(); asm volatile("" ::: "memory"); } while (0)
struct AtUnit { int g, b, h, r, n, d; size_t hoff; };
__device__ __forceinline__ AtUnit at_decode(int u) { AtUnit a; a.g = u >> 10; const int rem = u & 1023; a.b = rem >> 7; a.h = (rem >> 4) & 7; const int rn = rem & 15;
    const int dsh = 2 * a.g, nbs = 4 - dsh; a.d = 1 << dsh; a.r = rn >> nbs; a.n = 2 * (rn & ((1 << nbs) - 1)); a.hoff = (size_t)a.g * 512 + a.h * 64; return a; }
constexpr int AT_NU = 3 * 1024;
struct AtSlot { v4u k[6], v[6]; bf16x8 q0, q1, q2, q3; };
struct AtCtx { const bf16 *Qb, *Kb, *Vb; bf16* OG; float* LSE; LAS unsigned char *Ks, *Vs; int qi, g4, piece, jr; };
__device__ __forceinline__ void at_load(AtSlot& sl, int uu, const AtCtx& C, const Frame& F) {
    const AtUnit a_ = at_decode(uu);
#pragma unroll
    for (int ps = 0; ps < 6; ++ps) { const int lp = 128 * (a_.n - 1) + ps * 64 + C.jr; sl.k[ps] = (v4u){0u, 0u, 0u, 0u}; sl.v[ps] = sl.k[ps];
        if (lp >= 0) { const size_t off = ((size_t)a_.b * SEQ + (size_t)lp * a_.d + a_.r) * 1536 + a_.hoff + C.piece * 8; sl.k[ps] = *(const v4u*)(C.Kb + off); sl.v[ps] = *(const v4u*)(C.Vb + off); } }
    const size_t qrow_ = (size_t)a_.b * SEQ + (size_t)(128 * a_.n + 16 * F.wave + C.qi) * a_.d + a_.r; const bf16* qp = C.Qb + qrow_ * 1536 + a_.hoff + 8 * C.g4;
    sl.q0 = *(const bf16x8*)qp; sl.q1 = *(const bf16x8*)(qp + 32);
    const bf16* qp2 = qp + (size_t)128 * a_.d * 1536; sl.q2 = *(const bf16x8*)qp2; sl.q3 = *(const bf16x8*)(qp2 + 32);
}
__device__ __forceinline__ void at_unit(AtSlot& sl, int u, int unext, const AtCtx& C, const Frame& F) {
    bf16* OG = C.OG; float* LSE = C.LSE; LAS unsigned char* Ks = C.Ks; LAS unsigned char* Vs = C.Vs; const int qi = C.qi, g4 = C.g4;
    const AtUnit au = at_decode(u); const int g = au.g, b = au.b, h = au.h, r = au.r, n = au.n, d = au.d;
#pragma unroll
    for (int ps = 0; ps < 6; ++ps) { const int j = ps * 64 + C.jr; *(LAS v4u*)(Ks + j * AT_RS + C.piece * 16) = sl.k[ps]; *(LAS v4u*)(Vs + j * AT_RS + C.piece * 16) = sl.v[ps]; }
    const bf16x8 sl_q0 = sl.q0, sl_q1 = sl.q1, sl_q2 = sl.q2, sl_q3 = sl.q3;
    LDS_BARRIER();
    if (unext < AT_NU) at_load(sl, unext, C, F);
#pragma unroll
    for (int tq = 0; tq < 2; ++tq)
        {
            const int iq = 128 * tq + 16 * F.wave + qi; const int rb = 128 * tq + 16 * F.wave; const bf16x8 qf0 = tq ? sl_q2 : sl_q0, qf1 = tq ? sl_q3 : sl_q1; const size_t qrow = (size_t)b * SEQ + (size_t)(128 * n + iq) * d + r;
            f32x4 s[10]; float mx = -1e30f; const int dq = qi - 4 * g4; const bool first = (n == 0) && (tq == 0);
#pragma unroll
            for (int st = 0; st < 9; ++st) {
                const LAS unsigned char* kp = Ks + (rb + 16 * st + qi) * AT_RS + g4 * 16;
                const bf16x8 k0 = *(const LAS bf16x8*)kp, k1 = *(const LAS bf16x8*)(kp + 64);
                f32x4 a = (f32x4){0.f, 0.f, 0.f, 0.f};
                a = mfma16(k0, qf0, a); a = mfma16(k1, qf1, a);
                if (st == 0) {
#pragma unroll
                    for (int i = 0; i < 4; ++i) a[i] = (i >= dq) ? a[i] : -1e30f; }
                if (st == 8) {
#pragma unroll
                    for (int i = 0; i < 4; ++i) a[i] = (i <= dq) ? a[i] : -1e30f; }
                if (first) {
#pragma unroll
                    for (int i = 0; i < 4; ++i) a[i] = (rb + 16 * st + 4 * g4 + i >= 128) ? a[i] : -1e30f; }
#pragma unroll
                for (int i = 0; i < 4; ++i) mx = fmaxf(mx, a[i]);
                s[st] = a;
            }
            mx = fmaxf(mx, __shfl_xor(mx, 16)); mx = fmaxf(mx, __shfl_xor(mx, 32));
            float sum = 0.f;
#pragma unroll
            for (int st = 0; st < 9; ++st)
#pragma unroll
                for (int i = 0; i < 4; ++i) { const float p = fexp2(s[st][i] - mx); s[st][i] = p; sum += p; }
            s[9] = (f32x4){0.f, 0.f, 0.f, 0.f};
            sum += __shfl_xor(sum, 16); sum += __shfl_xor(sum, 32);
            f32x4 o[4];
#pragma unroll
            for (int dt = 0; dt < 4; ++dt) o[dt] = (f32x4){0.f, 0.f, 0.f, 0.f};
#pragma unroll
            for (int c = 0; c < 5; ++c) {
                v4u pw; pw.x = pk2(s[2 * c][0], s[2 * c][1]); pw.y = pk2(s[2 * c][2], s[2 * c][3]); pw.z = pk2(s[2 * c + 1][0], s[2 * c + 1][1]); pw.w = pk2(s[2 * c + 1][2], s[2 * c + 1][3]);
                const bf16x8 pf = __builtin_bit_cast(bf16x8, pw);
                const LAS unsigned char* vp = Vs + (rb + 32 * c + 4 * g4 + (qi >> 2)) * AT_RS + 8 * (qi & 3);
#pragma unroll
                for (int dt = 0; dt < 4; ++dt) { const s16x4 lo = tr16(vp + 32 * dt), hi = tr16(vp + 32 * dt + 16 * AT_RS);
                    o[dt] = mfma16(cat8(lo, hi), pf, o[dt]); }
            }
            const float inv = 1.0f / sum;
            bf16* op = OG + ((size_t)g * T + qrow) * 512 + h * 64 + 4 * g4;
#pragma unroll
            for (int dt = 0; dt < 4; ++dt) { v2u w; w.x = pk2(o[dt][0] * inv, o[dt][1] * inv); w.y = pk2(o[dt][2] * inv, o[dt][3] * inv); *(v2u*)(op + 16 * dt) = w; }
            if (g4 == 0) LSE[((size_t)g * T + qrow) * 8 + h] = mx + __log2f(sum);
        }
    LDS_BARRIER();
}
__device__ __forceinline__ void phase_attn(Frame& F) {
    AtCtx C; C.Qb = wsp<bf16>(F, WS_Q); C.Kb = wsp<bf16>(F, WS_K); C.Vb = wsp<bf16>(F, WS_VV); C.OG = wsp<bf16>(F, WS_OG); C.LSE = wsp<float>(F, WS_LSE);
    C.Ks = F.lds; C.Vs = F.lds + AT_VOFF; C.qi = F.lane & 15; C.g4 = F.lane >> 4; C.piece = F.tid & 7; C.jr = F.tid >> 3;
    if (F.tid < 144) { *(LAS v4u*)(C.Ks + 384 * AT_RS + F.tid * 16) = (v4u){0u, 0u, 0u, 0u}; *(LAS v4u*)(C.Vs + 384 * AT_RS + F.tid * 16) = (v4u){0u, 0u, 0u, 0u}; }
    AtSlot sa; const int u0 = F.vcu, G = F.G;
    if (u0 < AT_NU) at_load(sa, u0, C, F);
#pragma unroll 1
    for (int u = u0; u < AT_NU; u += G) at_unit(sa, u, u + G, C, F);
}

constexpr int SG_WOFF = 69632, SG_WRS = 264;
constexpr int SG_RS = 528;
__device__ __forceinline__ void phase_sg(Frame& F, int l) {
    const bf16* Ub = wsp<bf16>(F, WS_U); const bf16* Vb = wsp<bf16>(F, WS_V); bf16* TT = wsp<bf16>(F, WS_TT);
    const bf16* OG = wsp<bf16>(F, WS_OG); const float* LSE = wsp<float>(F, WS_LSE); bf16* OB = wsp<bf16>(F, WS_OB);
    const bf16* Wsp = wsp<bf16>(F, WS_WSP); const float* spb = F.in[I_SPB];
    LAS unsigned char* Vn = F.lds;
    const int qi = F.lane & 15, g4 = F.lane >> 4;
    const int l32 = F.lane & 31;
    v4u vraw[8];
#define SG_LOAD(uu) do { const int gi_ = (uu) & 3, m0_ = ((uu) >> 2) * 128; \
        _Pragma("unroll") for (int ps = 0; ps < 8; ++ps) vraw[ps] = *(const v4u*)(Vb + (size_t)(m0_ + 16 * ps + 2 * F.wave + (F.lane >> 5)) * 1024 + gi_ * 256 + 8 * l32); } while (0)
    if (F.vcu < 1024) SG_LOAD(F.vcu);
    const bool wlds = (F.G & 3) == 0; LAS unsigned char* Wl = F.lds + SG_WOFF;
    if (wlds) { const bf16* wsrc = Wsp + (size_t)(l * 4 + (F.vcu & 3)) * 128 * 128;
        for (int i = F.tid; i < 128 * 16; i += 512) { const int row = i >> 4, ch = i & 15; const v4u wv = *(const v4u*)(wsrc + row * 128 + ch * 8);
            *(LAS v2u*)(Wl + row * SG_WRS + ch * 16) = (v2u){wv.x, wv.y}; *(LAS v2u*)(Wl + row * SG_WRS + ch * 16 + 8) = (v2u){wv.z, wv.w}; } }
    for (int u = F.vcu; u < 1024; u += F.G) {
        const int gi = u & 3, m0 = (u >> 2) * 128;
        float ml[4][3]; v4u mo[4][3]; const int sub = F.tid & 7;
#pragma unroll
        for (int ps = 0; ps < 4; ++ps) { const int p = (F.tid >> 3) + 64 * ps; const size_t tok = (size_t)m0 + (p >> 1); const int hd = 2 * gi + (p & 1); const size_t off = tok * 512 + hd * 64 + 8 * sub;
#pragma unroll
            for (int gq = 0; gq < 3; ++gq) { ml[ps][gq] = LSE[((size_t)gq * T + tok) * 8 + hd]; mo[ps][gq] = *(const v4u*)(OG + (size_t)gq * T * 512 + off); } }
        {
            float sm[8], mean[8], rs[8];
#pragma unroll
            for (int ps = 0; ps < 8; ++ps) { const v4u raw = vraw[ps]; sm[ps] = ((bflo(raw.x) + bfhi(raw.x)) + (bflo(raw.y) + bfhi(raw.y))) + ((bflo(raw.z) + bfhi(raw.z)) + (bflo(raw.w) + bfhi(raw.w))); }
#pragma unroll
            for (int o = 1; o < 32; o <<= 1) {
#pragma unroll
                for (int ps = 0; ps < 8; ++ps) sm[ps] += __shfl_xor(sm[ps], o); }
#pragma unroll
            for (int ps = 0; ps < 8; ++ps) { const v4u raw = vraw[ps]; mean[ps] = sm[ps] * (1.0f / 256.0f); float q = 0.f;
                const float x[8] = {bflo(raw.x), bfhi(raw.x), bflo(raw.y), bfhi(raw.y), bflo(raw.z), bfhi(raw.z), bflo(raw.w), bfhi(raw.w)};
#pragma unroll
                for (int e = 0; e < 8; ++e) { const float dx = x[e] - mean[ps]; q += dx * dx; }
                sm[ps] = q; }
#pragma unroll
            for (int o = 1; o < 32; o <<= 1) {
#pragma unroll
                for (int ps = 0; ps < 8; ++ps) sm[ps] += __shfl_xor(sm[ps], o); }
#pragma unroll
            for (int ps = 0; ps < 8; ++ps) { rs[ps] = 1.0f / sqrtf(sm[ps] * (1.0f / 256.0f) + LN_EPS); const v4u raw = vraw[ps]; const int j = 16 * ps + 2 * F.wave + (F.lane >> 5);
                const float x[8] = {bflo(raw.x), bfhi(raw.x), bflo(raw.y), bfhi(raw.y), bflo(raw.z), bfhi(raw.z), bflo(raw.w), bfhi(raw.w)};
                v4u w; w.x = pk2((x[0] - mean[ps]) * rs[ps], (x[1] - mean[ps]) * rs[ps]); w.y = pk2((x[2] - mean[ps]) * rs[ps], (x[3] - mean[ps]) * rs[ps]);
                w.z = pk2((x[4] - mean[ps]) * rs[ps], (x[5] - mean[ps]) * rs[ps]); w.w = pk2((x[6] - mean[ps]) * rs[ps], (x[7] - mean[ps]) * rs[ps]);
                *(LAS v4u*)(Vn + j * SG_RS + l32 * 16) = w; }
        }
        LDS_BARRIER();
        if (u + F.G < 1024) SG_LOAD(u + F.G);
        {
#pragma unroll
          for (int ps = 0; ps < 4; ++ps) { const int p = (F.tid >> 3) + 64 * ps; const size_t tok = (size_t)m0 + (p >> 1); const int hd = 2 * gi + (p & 1);
              const float l0 = ml[ps][0], l1 = ml[ps][1], l2 = ml[ps][2];
              const float mxx = fmaxf(l0, fmaxf(l1, l2)); float w0 = fexp2(l0 - mxx), w1 = fexp2(l1 - mxx), w2 = fexp2(l2 - mxx); const float inv = 1.0f / (w0 + w1 + w2); w0 *= inv; w1 *= inv; w2 *= inv;
              const size_t off = tok * 512 + hd * 64 + 8 * sub;
              const v4u a = mo[ps][0], bq = mo[ps][1], cq = mo[ps][2]; v4u w;
              w.x = pk2(w0 * bflo(a.x) + w1 * bflo(bq.x) + w2 * bflo(cq.x), w0 * bfhi(a.x) + w1 * bfhi(bq.x) + w2 * bfhi(cq.x));
              w.y = pk2(w0 * bflo(a.y) + w1 * bflo(bq.y) + w2 * bflo(cq.y), w0 * bfhi(a.y) + w1 * bfhi(bq.y) + w2 * bfhi(cq.y));
              w.z = pk2(w0 * bflo(a.z) + w1 * bflo(bq.z) + w2 * bflo(cq.z), w0 * bfhi(a.z) + w1 * bfhi(bq.z) + w2 * bfhi(cq.z));
              w.w = pk2(w0 * bflo(a.w) + w1 * bflo(bq.w) + w2 * bflo(cq.w), w0 * bfhi(a.w) + w1 * bfhi(bq.w) + w2 * bfhi(cq.w));
              *(v4u*)(TT + tok * 1536 + 1024 + hd * 64 + 8 * sub) = w; } }
        v2u uq[8][2]; float ubias[8];
#pragma unroll
        for (int it = 0; it < 8; ++it) { const int i = 16 * it + qi; ubias[it] = spb[(l * 4 + gi) * 128 + i]; const size_t rowo = (size_t)(m0 + i) * 1024 + gi * 256 + 32 * F.wave + 4 * g4;
            uq[it][0] = *(const v2u*)(Ub + rowo); uq[it][1] = *(const v2u*)(Ub + rowo + 16); }
        {
            f32x4 acc[2][8];
#pragma unroll
            for (int ct = 0; ct < 2; ++ct)
#pragma unroll
                for (int it = 0; it < 8; ++it) acc[ct][it] = (f32x4){0.f, 0.f, 0.f, 0.f};
            const bf16* wbase = Wsp + (size_t)(l * 4 + gi) * 128 * 128 + (size_t)qi * 128 + 4 * g4;
#pragma unroll
            for (int kc = 0; kc < 4; ++kc) {
                bf16x8 af[2];
#pragma unroll
                for (int ct = 0; ct < 2; ++ct) { const LAS unsigned char* p = Vn + (32 * kc + 4 * g4 + (qi >> 2)) * SG_RS + (32 * F.wave + 16 * ct + 4 * (qi & 3)) * 2;
                    af[ct] = cat8(tr16(p), tr16(p + 16 * SG_RS)); }
#pragma unroll
                for (int it = 0; it < 8; ++it) if (it >= 2 * kc) {
                    const bf16* wp = wbase + (size_t)(16 * it) * 128 + 32 * kc; const LAS unsigned char* wq = Wl + (16 * it + qi) * SG_WRS + (32 * kc + 4 * g4) * 2;
                    const v2u b0 = wlds ? *(const LAS v2u*)wq : *(const v2u*)wp, b1 = wlds ? *(const LAS v2u*)(wq + 32) : *(const v2u*)(wp + 16);
                    const bf16x8 bfr = __builtin_bit_cast(bf16x8, (v4u){b0.x, b0.y, b1.x, b1.y});
                    acc[0][it] = mfma16(af[0], bfr, acc[0][it]); acc[1][it] = mfma16(af[1], bfr, acc[1][it]); }
            }
#pragma unroll
            for (int it = 0; it < 8; ++it) { const int i = 16 * it + qi; const float bias = ubias[it]; const size_t rowo = (size_t)(m0 + i) * 1536 + gi * 256 + 32 * F.wave + 4 * g4;
#pragma unroll
                for (int ct = 0; ct < 2; ++ct) { const v2u uu = uq[it][ct]; const f32x4 a = acc[ct][it]; v2u w;
                    w.x = pk2(bflo(uu.x) * (a[0] + bias), bfhi(uu.x) * (a[1] + bias)); w.y = pk2(bflo(uu.y) * (a[2] + bias), bfhi(uu.y) * (a[3] + bias));
                    *(v2u*)(TT + rowo + 16 * ct) = w; } }
        }
        LDS_BARRIER();
    }
#undef SG_LOAD
}

__device__ __forceinline__ void phase_ln1(Frame& F, int l, bool commit) {
    const bf16* YPRE = wsp<bf16>(F, WS_YPRE); bf16* H = wsp<bf16>(F, WS_H);
    const float* modl = wsp<float>(F, WS_MOD) + (size_t)l * 8 * 6144;
    const float* lg = F.in[I_LN1G] + l * D; const float* lb = F.in[I_LN1B] + l * D; const float* br = F.in[I_BR] + l * NE;
    const bf16* WH = wsp<bf16>(F, WS_WRT) + (size_t)l * NE * D; const bf16* WL = WH + (size_t)NL * NE * D;
    int* TOKINFO = wsp<int>(F, WS_TOKINFO); float* TOKW = wsp<float>(F, WS_TOKW);
    unsigned* cntg = wsp<unsigned>(F, WS_CTL) + CW_CNT + (size_t)l * NE * 64;
    LAS int* sel_e = (LAS int*)(F.lds + X_SELE);
    const int lane = F.lane, qi = lane & 15, g4 = lane >> 4;
    { const v4u* srcw = (const v4u*)WH;
#pragma unroll 4
      for (int i = F.tid; i < 2 * NE * 128; i += 512) { const int hl = i >> 12, e = (i >> 7) & 31, c = i & 127;
          *(LAS v4u*)(F.lds + hl * 65536 + e * 2048 + ((c ^ (e & 15)) << 4)) = srcw[(size_t)hl * (NL * NE * 128) + e * 128 + c]; } }
    __syncthreads();
    for (int tb = F.vcu; tb < T / 128; tb += F.G) {
        const int m0 = tb * 128; const int b = m0 >> 12; const float* mb = modl + (size_t)b * 6144; const int mw = m0 + 16 * F.wave;
        v2u pre[4][4];
#pragma unroll
        for (int r = 0; r < 4; ++r)
#pragma unroll
            for (int j = 0; j < 4; ++j) pre[r][j] = *((const v2u*)(YPRE + (size_t)(mw + r) * D) + lane + 64 * j);
#pragma unroll 1
        for (int rp = 0; rp < 4; ++rp) {
            f32x4 hh[4][4]; float mean[4], rstd[4];
            const int mrow = mw + 4 * rp;
#pragma unroll
            for (int r = 0; r < 4; ++r)
#pragma unroll
                for (int j = 0; j < 4; ++j) hh[r][j] = (f32x4){bflo(pre[r][j].x), bfhi(pre[r][j].x), bflo(pre[r][j].y), bfhi(pre[r][j].y)};
            if (rp < 3) {
#pragma unroll
                for (int r = 0; r < 4; ++r)
#pragma unroll
                    for (int j = 0; j < 4; ++j) pre[r][j] = *((const v2u*)(YPRE + (size_t)(mrow + 4 + r) * D) + lane + 64 * j); }
            { float sm[4], sq[4];
#pragma unroll
              for (int r = 0; r < 4; ++r) { sm[r] = 0.f; sq[r] = 0.f;
#pragma unroll
                  for (int j = 0; j < 4; ++j) { sm[r] += (hh[r][j][0] + hh[r][j][1]) + (hh[r][j][2] + hh[r][j][3]);
                      sq[r] += (hh[r][j][0] * hh[r][j][0] + hh[r][j][1] * hh[r][j][1]) + (hh[r][j][2] * hh[r][j][2] + hh[r][j][3] * hh[r][j][3]); } }
#pragma unroll
              for (int o = 1; o < 64; o <<= 1) {
#pragma unroll
                  for (int r = 0; r < 4; ++r) { sm[r] += __shfl_xor(sm[r], o); sq[r] += __shfl_xor(sq[r], o); } }
#pragma unroll
              for (int r = 0; r < 4; ++r) { mean[r] = sm[r] * (1.0f / D); rstd[r] = 1.0f / sqrtf(fmaxf(sq[r] * (1.0f / D) - mean[r] * mean[r], 0.f) + LN_EPS); } }
            if (lane < 4) { const float mq = (lane == 0) ? mean[0] : (lane == 1) ? mean[1] : (lane == 2) ? mean[2] : mean[3], rq = (lane == 0) ? rstd[0] : (lane == 1) ? rstd[1] : (lane == 2) ? rstd[2] : rstd[3];
                float* st = wsp<float>(F, WS_STAT) + (size_t)(mrow + lane) * 2; st[0] = mq; st[1] = rq; }
#pragma unroll
            for (int j = 0; j < 4; ++j) { const f32x4 gq = *((const f32x4*)lg + lane + 64 * j), bq = *((const f32x4*)lb + lane + 64 * j);
                const f32x4 shq = *((const f32x4*)(mb + 3072) + lane + 64 * j), scq = *((const f32x4*)(mb + 4096) + lane + 64 * j) + 1.0f;
#pragma unroll
                for (int r = 0; r < 4; ++r) { const f32x4 x1 = (hh[r][j] - mean[r]) * rstd[r] * gq + bq;
                    const f32x4 h2 = x1 * scq + shq; v2u o; o.x = pk2(h2[0], h2[1]); o.y = pk2(h2[2], h2[3]); *((v2u*)(H + (size_t)(mrow + r) * D) + lane + 64 * j) = o;
 } }
        }
        VM_WAIT(); asm volatile("" ::: "memory");
        f32x4 c0 = (f32x4){0.f, 0.f, 0.f, 0.f}, c1 = c0;
        { const bf16* hp = H + (size_t)(mw + qi) * D + 8 * g4;
          const LAS unsigned char* w0 = F.lds + qi * 2048; const LAS unsigned char* w1 = F.lds + (16 + qi) * 2048;
#pragma unroll 8
          for (int ks = 0; ks < 32; ++ks) {
              const bf16x8 hhi = *(const bf16x8*)(hp + 32 * ks);
              const int co = ((4 * ks + g4) ^ qi) << 4;
              const bf16x8 a0h = *(const LAS bf16x8*)(w0 + co), a0l = *(const LAS bf16x8*)(w0 + 65536 + co);
              const bf16x8 a1h = *(const LAS bf16x8*)(w1 + co), a1l = *(const LAS bf16x8*)(w1 + 65536 + co);
              c0 = mfma16(a0h, hhi, c0); c0 = mfma16(a0l, hhi, c0);
              c1 = mfma16(a1h, hhi, c1); c1 = mfma16(a1l, hhi, c1); } }
        {
            float v[8]; int id[8];
#pragma unroll
            for (int i = 0; i < 4; ++i) { id[i] = 4 * g4 + i; id[4 + i] = 16 + 4 * g4 + i; v[i] = c0[i] + br[4 * g4 + i]; v[4 + i] = c1[i] + br[16 + 4 * g4 + i]; }
            int ek[4]; float vk[4];
#pragma unroll
            for (int k = 0; k < 4; ++k) { float lm = v[0]; int li = id[0];
#pragma unroll
                for (int j = 1; j < 8; ++j) if (v[j] > lm) { lm = v[j]; li = id[j]; }
#pragma unroll
                for (int o = 16; o <= 32; o <<= 1) { const float om = __shfl_xor(lm, o); const int oi = __shfl_xor(li, o); if (om > lm || (om == lm && oi < li)) { lm = om; li = oi; } }
                ek[k] = li; vk[k] = lm;
#pragma unroll
                for (int j = 0; j < 8; ++j) if (id[j] == li) v[j] = -INFINITY; }
            const float e1 = __expf(vk[1] - vk[0]), e2 = __expf(vk[2] - vk[0]), e3 = __expf(vk[3] - vk[0]); const float inv = 1.0f / (1.0f + e1 + e2 + e3);
            if (g4 == 0) { const int tl = 16 * F.wave + qi;
                sel_e[tl * 4 + 0] = ek[0]; sel_e[tl * 4 + 1] = ek[1]; sel_e[tl * 4 + 2] = ek[2]; sel_e[tl * 4 + 3] = ek[3];
                *(f32x4*)(TOKW + (size_t)(m0 + tl) * 4) = (f32x4){inv, e1 * inv, e2 * inv, e3 * inv}; }
        }
        __syncthreads();
        { const int myE = sel_e[F.tid]; LAS unsigned long long* bm = (LAS unsigned long long*)(F.lds + X_SELR); unsigned long long mine = 0ull;
#pragma unroll
          for (int e = 0; e < 32; ++e) { const unsigned long long m = __ballot(myE == e); if (lane == e) mine = m; }
          if (lane < 32) bm[F.wave * 32 + lane] = mine;
          __syncthreads();
          int rk = __popcll(bm[F.wave * 32 + myE] & ((1ull << lane) - 1ull));
#pragma unroll
          for (int w = 0; w < 8; ++w) if (w < F.wave) rk += __popcll(bm[w * 32 + myE]);
          TOKINFO[(size_t)m0 * 4 + F.tid] = myE | (rk << 8);
          if (F.tid < 32) { int tot = 0;
#pragma unroll
              for (int w = 0; w < 8; ++w) tot += __popcll(bm[w * 32 + F.tid]);
              wsp<int>(F, WS_WGCNT)[((size_t)l * 256 + tb) * 32 + F.tid] = tot; if (tot && commit) (void)__hip_atomic_fetch_add(cntg + F.tid * 64, (unsigned)tot, RLX_AGENT); } }
        __syncthreads();
    }
}

__device__ __forceinline__ int moe_tables(Frame& F, int l) {
    const unsigned* cntg = wsp<unsigned>(F, WS_CTL) + CW_CNT + (size_t)l * NE * 64;
    LAS int* cnt_s = (LAS int*)(F.lds + X_CNTS); LAS int* off_s = (LAS int*)(F.lds + X_OFFS); LAS unsigned char* tile_e = (LAS unsigned char*)(F.lds + X_TILEE);
    if (F.tid < 32) cnt_s[F.tid] = (int)__hip_atomic_load(cntg + F.tid * 64, RLX_AGENT);
    __syncthreads();
    if (F.tid < 64) {
        const int e = F.tid & 31; const int c = (F.tid < 32) ? cnt_s[e] : 0; const int nt = (c + 255) >> 8; int incl = nt;
#pragma unroll
        for (int o = 1; o < 32; o <<= 1) { const int v = __shfl_up(incl, o); if ((F.tid & 63) >= o) incl += v; }
        if (F.tid < 32) { const int excl = incl - nt; off_s[e] = excl * 256; for (int t = 0; t < nt; ++t) tile_e[excl + t] = (unsigned char)e; if (e == 31) off_s[32] = incl * 256; }
    }
    __syncthreads();
    return off_s[32] >> 8;
}
__device__ __forceinline__ void phase_scat(Frame& F, int l) {
    (void)moe_tables(F, l);
    const LAS int* off_s = (const LAS int*)(F.lds + X_OFFS); const LAS int* cnt_s = (const LAS int*)(F.lds + X_CNTS); LAS int* base_s = (LAS int*)(F.lds + X_BASE);
    const int* TOKINFO = wsp<int>(F, WS_TOKINFO); const float* TOKW = wsp<float>(F, WS_TOKW);
    int* ROWTOK = wsp<int>(F, WS_ROWTOK); float* ROWW = wsp<float>(F, WS_ROWW); const int* WGC = wsp<int>(F, WS_WGCNT) + (size_t)l * 256 * 32; int* TOKINFO2 = wsp<int>(F, WS_TOKROW);
    for (int tb = F.vcu; tb < T / 128; tb += F.G) {
        if (F.tid < 32) base_s[F.tid] = 0;
        __syncthreads();
        { const int e = F.tid & 31, part = F.tid >> 5; int sacc = 0;
          for (int t2 = part * 16; t2 < part * 16 + 16; ++t2) if (t2 < tb) sacc += WGC[t2 * 32 + e];
          if (sacc) atomicAdd((int*)&base_s[e], sacc); }
        __syncthreads();
        { const size_t ent = (size_t)tb * 512 + F.tid; const int info = TOKINFO[ent]; const int e = info & 255, row = off_s[e] + base_s[e] + (info >> 8);
          ROWTOK[row] = (int)ent; ROWW[row] = TOKW[ent]; TOKINFO2[ent] = row; }
        __syncthreads();
    }
    if (F.vcu == 0) for (int e = 0; e < NE; ++e) for (int r = off_s[e] + cnt_s[e] + F.tid; r < off_s[e + 1]; r += 512) { ROWTOK[r] = 0; ROWW[r] = 0.f; }
}
__device__ __forceinline__ void phase_ln2(Frame& F, int l) {
    const bf16* X1 = wsp<bf16>(F, WS_YPRE); const bf16* YK = wsp<bf16>(F, WS_XG); bf16* H = wsp<bf16>(F, WS_H); const int* TOKROW = wsp<int>(F, WS_TOKROW); const float* TOKW = wsp<float>(F, WS_TOKW);
    const float* STAT = wsp<float>(F, WS_STAT); const float* l1g = F.in[I_LN1G] + l * D; const float* l1b = F.in[I_LN1B] + l * D;
    float* XO = F.out; bf16* XB = wsp<bf16>(F, WS_X2);
    const float* modl = wsp<float>(F, WS_MOD) + (size_t)l * 8 * 6144; const float* modn = wsp<float>(F, WS_MOD) + (size_t)((l + 1) & 3) * 8 * 6144;
    const float* lg = F.in[I_LN2G] + l * D; const float* lb = F.in[I_LN2B] + l * D;
    const int lane = F.lane; const int gw = F.vcu * 8 + F.wave, NGW = F.G * 8;
    v2u px[4]; v2u py[4][4]; float pst[2], nst[2]; f32x4 pw4, nw4;
#define LN2_LOAD(mm) do { nst[0] = STAT[(size_t)(mm) * 2]; nst[1] = STAT[(size_t)(mm) * 2 + 1]; nw4 = *(const f32x4*)(TOKW + (size_t)(mm) * 4); \
        int rw_[4]; _Pragma("unroll") for (int k = 0; k < 4; ++k) rw_[k] = TOKROW[(size_t)(mm) * 4 + k]; \
        _Pragma("unroll") for (int j = 0; j < 4; ++j) { px[j] = __builtin_nontemporal_load((const v2u*)(X1 + (size_t)(mm) * D) + lane + 64 * j); \
        _Pragma("unroll") for (int k = 0; k < 4; ++k) py[j][k] = __builtin_nontemporal_load((const v2u*)(YK + (size_t)rw_[k] * D) + lane + 64 * j); } } while (0)
    if (gw < T) LN2_LOAD(gw);
#pragma unroll 1
    for (int m = gw; m < T; m += NGW) { const int b = m >> 12; const float* mb = modl + (size_t)b * 6144; const float* mn = modn + (size_t)b * 6144;
        f32x4 v[4]; float s = 0.f; pst[0] = nst[0]; pst[1] = nst[1]; pw4 = nw4;
#pragma unroll
        for (int j = 0; j < 4; ++j) { f32x4 y = (f32x4){0.f, 0.f, 0.f, 0.f};
#pragma unroll
            for (int k = 0; k < 4; ++k) { const v2u w = py[j][k]; const float cw = pw4[k]; y[0] += cw * bflo(w.x); y[1] += cw * bfhi(w.x); y[2] += cw * bflo(w.y); y[3] += cw * bfhi(w.y); }
            const f32x4 g2 = *((const f32x4*)(mb + 5120) + lane + 64 * j) + 1.0f;
            const f32x4 pxf = (f32x4){bflo(px[j].x), bfhi(px[j].x), bflo(px[j].y), bfhi(px[j].y)};
            const f32x4 x1 = (pxf - pst[0]) * pst[1] * *((const f32x4*)l1g + lane + 64 * j) + *((const f32x4*)l1b + lane + 64 * j);
            v[j] = x1 * DN_ALPHA + g2 * y; s += (v[j][0] + v[j][1]) + (v[j][2] + v[j][3]); }
        if (m + NGW < T) LN2_LOAD(m + NGW);
        float s2 = 0.f;
#pragma unroll
        for (int j = 0; j < 4; ++j) s2 += (v[j][0] * v[j][0] + v[j][1] * v[j][1]) + (v[j][2] * v[j][2] + v[j][3] * v[j][3]);
#pragma unroll
        for (int o = 1; o < 64; o <<= 1) { s += __shfl_xor(s, o); s2 += __shfl_xor(s2, o); }
        const float mean = s * (1.0f / D); const float rstd = 1.0f / sqrtf(fmaxf(s2 * (1.0f / D) - mean * mean, 0.f) + LN_EPS);
#pragma unroll
        for (int j = 0; j < 4; ++j) v[j] = v[j] - mean;
        f32x4* xo = (f32x4*)(XO + (size_t)m * D) + lane; v2u* xb = (v2u*)(XB + (size_t)m * D) + lane; v2u* ho = (v2u*)(H + (size_t)m * D) + lane;
#pragma unroll
        for (int j = 0; j < 4; ++j) { const f32x4 gvj = *((const f32x4*)lg + lane + 64 * j), bvj = *((const f32x4*)lb + lane + 64 * j); const f32x4 x2 = v[j] * rstd * gvj + bvj;
            if (l == NL - 1) __builtin_nontemporal_store(x2, xo + 64 * j); else { v2u xq; xq.x = pk2(x2[0], x2[1]); xq.y = pk2(x2[2], x2[3]); __builtin_nontemporal_store(xq, xb + 64 * j); }
            if (l < NL - 1) { const f32x4 sh = *((const f32x4*)mn + lane + 64 * j), sc = *((const f32x4*)(mn + 1024) + lane + 64 * j) + 1.0f; const f32x4 h = x2 * sc + sh;
                v2u o; o.x = pk2(h[0], h[1]); o.y = pk2(h[2], h[3]); ho[64 * j] = o; } } }
#undef LN2_LOAD
}

#ifndef PH_MASK
#define PH_MASK 0xFFFF
#endif
#define PHM(b) ((PH_MASK >> (b)) & 1)
#ifndef DUP_MASK
#define DUP_MASK 0
#endif
#define REPS(b) (((DUP_MASK >> (b)) & 1) ? 2 : 1)
constexpr int NPH_L = 10, NPHASE = 2 + NL * NPH_L;
struct Args { const float* in[20]; float* out; unsigned char* ws; int ph_lo, ph_hi; };
__global__ void __launch_bounds__(512, 2) fwd(Args args) {
    extern __shared__ __attribute__((aligned(16))) unsigned char lds[];
    Frame F;
    F.lds = (LAS unsigned char*)lds;
#define FRESH() do { int zv_ = 0; asm volatile("" : "+v"(zv_)); const int z_ = __builtin_amdgcn_readfirstlane(zv_); \
        F.tid = (int)threadIdx.x + zv_; F.lane = F.tid & 63; F.wave = __builtin_amdgcn_readfirstlane(F.tid >> 6); \
        F.G = (int)gridDim.x + z_; F.bx = (int)blockIdx.x + z_; F.vcu = (F.G % 8 == 0) ? (F.bx % 8) * (F.G / 8) + F.bx / 8 : F.bx; \
        F.ws = args.ws + z_; F.in = args.in + z_; F.out = args.out + z_; F.lds = (LAS unsigned char*)lds + z_; } while (0)
    FRESH();
    for (int u = F.tid; u < (LDS_BYTES - XOFF) / 4; u += 512) ((LAS unsigned*)(F.lds + XOFF))[u] = 0u;
    __syncthreads();
    unsigned* ctl = wsp<unsigned>(F, WS_CTL);
    XcdBarrier bar; bar.bar = ctl + CW_BAR; bar.x = 0; bar.st = nullptr;
    if (!MK_PER_PHASE) bar = xcd_barrier_post(ctl + CW_BAR, (volatile LAS unsigned*)(F.lds + X_MISC) + 8);
    const int lo = args.ph_lo, hi = args.ph_hi;
#define IN(k) (lo <= (k) && (k) < hi)
#ifndef BAR_REPS
#define BAR_REPS 1
#endif
#define SEAM(k) do { if (!MK_PER_PHASE && IN(k) && IN((k) + 1)) for (int br_ = 0; br_ < BAR_REPS; ++br_) xcd_barrier(bar); } while (0)

    if (PHM(0) && IN(0)) for (int rep = 0; rep < REPS(0); ++rep) { FRESH(); phase_pro_a(F); } SEAM(0);
    if (PHM(1) && IN(1)) for (int rep = 0; rep < REPS(1); ++rep) { FRESH(); phase_pro_b(F); } SEAM(1);
    for (int l = 0; l < NL; ++l) {
        const int pb = 2 + l * NPH_L;
        if (PHM(2) && IN(pb + 0)) for (int rep = 0; rep < REPS(2); ++rep) { FRESH();
            pg8::Gemm g{wsp<bf16>(F, WS_H), wsp<bf16>(F, WS_WIN) + (size_t)l * NIN * D, T, NIN, D}; pg8::StaticOrder S; S.init(T, NIN, F.G, F.bx);
            EpiIn E{wsp<bf16>(F, WS_U), wsp<bf16>(F, WS_V), wsp<bf16>(F, WS_Q), wsp<bf16>(F, WS_K), wsp<bf16>(F, WS_VV), wsp<bf16>(F, WS_G), wsp<float>(F, WS_ROPE)};
            stagger(F.bx >> 3, STAG_US);
            pg8::gemm_phase<EpiIn, pg8::StaticOrder, PG8_ALIGN, PG8_SP2>(F.lds, g, S, E, F.tid);
#if defined(XPROBE)
            { FRESH(); pg8::Gemm g2{wsp<bf16>(F, WS_H), wsp<bf16>(F, WS_WIN) + (size_t)l * NIN * D, T, NIN, D}; pg8::StaticOrder S2; S2.init(T, NIN, F.G, F.bx);
              EpiProbe E2{wsp<bf16>(F, WS_XG), (XPROBE == 3) ? NIN : 1024, (XPROBE >= 2) ? (XPROBE == 3 ? 3 : 1) : (F.G == 0x7ffffff0 ? 1 : 0)};
              pg8::gemm_phase<EpiProbe, pg8::StaticOrder, PG8_ALIGN, PG8_SP2>(F.lds, g2, S2, E2, F.tid); }
#endif
        } SEAM(pb + 0);
        if (PHM(3) && IN(pb + 1)) for (int rep = 0; rep < REPS(3); ++rep) { FRESH(); phase_attn(F); } SEAM(pb + 1);
        if (PHM(4) && IN(pb + 2)) for (int rep = 0; rep < REPS(4); ++rep) { FRESH(); phase_sg(F, l); } SEAM(pb + 2);
        if (PHM(5) && IN(pb + 3)) for (int rep = 0; rep < REPS(5); ++rep) { FRESH();
            pg8::Gemm g{wsp<bf16>(F, WS_TT), wsp<bf16>(F, WS_WBA) + (size_t)l * D * 1536, T, D, 1536}; pg8::StaticOrder S; S.init(T, D, F.G, F.bx);
            EpiMg2 E{wsp<bf16>(F, WS_G), wsp<bf16>(F, WS_MG)}; pg8::gemm_phase<EpiMg2, pg8::StaticOrder, PG8_ALIGN, PG8_SP2>(F.lds, g, S, E, F.tid);
        } SEAM(pb + 3);
        if (PHM(6) && IN(pb + 4)) for (int rep = 0; rep < REPS(6); ++rep) { FRESH();
            pg8::Gemm g{wsp<bf16>(F, WS_MG), wsp<bf16>(F, WS_WOUT) + (size_t)l * D * D, T, D, D}; pg8::StaticOrder S; S.init(T, D, F.G, F.bx);
            if (l == 0) { EpiOut<true> E{(const void*)F.in[I_X], wsp<float>(F, WS_MOD) + (size_t)l * 8 * 6144, wsp<bf16>(F, WS_YPRE)}; pg8::gemm_phase<EpiOut<true>, pg8::StaticOrder, PG8_ALIGN, PG8_SP2>(F.lds, g, S, E, F.tid); }
            else { EpiOut<false> E{(const void*)wsp<bf16>(F, WS_X2), wsp<float>(F, WS_MOD) + (size_t)l * 8 * 6144, wsp<bf16>(F, WS_YPRE)}; pg8::gemm_phase<EpiOut<false>, pg8::StaticOrder, PG8_ALIGN, PG8_SP2>(F.lds, g, S, E, F.tid); }
        } SEAM(pb + 4);
        if (PHM(7) && IN(pb + 5)) for (int rep = 0; rep < REPS(7); ++rep) { FRESH(); phase_ln1(F, l, rep == 0); } SEAM(pb + 5);
        if (PHM(8) && IN(pb + 6)) for (int rep = 0; rep < REPS(8); ++rep) { FRESH(); phase_scat(F, l); } SEAM(pb + 6);
        if (PHM(9) && IN(pb + 7)) for (int rep = 0; rep < REPS(9); ++rep) { FRESH();
            const int RT = moe_tables(F, l);
            pg8::Gemm g{wsp<bf16>(F, WS_H), wsp<bf16>(F, WS_WUP) + (size_t)l * NE * 2048 * D, RT * 256, NE * 2048, D};
            MoeGatherOrder S; S.init(RT, 8, F.G, F.bx, (const LAS unsigned char*)(F.lds + X_TILEE)); S.tokl = (const LAS unsigned short*)(F.lds + X_TOKL);
            { const int* rowtok = wsp<int>(F, WS_ROWTOK); LAS unsigned short* tl = (LAS unsigned short*)(F.lds + X_TOKL); pg8::Unit uu;
              for (int i = 0; i < TOKL_UNITS && S.next(i, uu); ++i) if (F.tid < 256) tl[i * 256 + F.tid] = (unsigned short)(rowtok[uu.pm * 256 + F.tid] >> 2);
              __syncthreads(); }
            EpiUp E{F.in[I_BUP] + (size_t)l * NE * 2048, wsp<bf16>(F, WS_ACT)};
            stagger(F.bx >> 3, STAG_US);
            pg8::gemm_phase<EpiUp, MoeGatherOrder, PG8_ALIGN, true>(F.lds, g, S, E, F.tid);
        } SEAM(pb + 7);
        if (PHM(10) && IN(pb + 8)) for (int rep = 0; rep < REPS(10); ++rep) { FRESH();
            const int RT = moe_tables(F, l);
            pg8::Gemm g{wsp<bf16>(F, WS_ACT), wsp<bf16>(F, WS_WDN) + (size_t)l * NE * D * FF, RT * 256, NE * D, FF};
            MoeOrder S; S.init(RT, 4, F.G, F.bx, (const LAS unsigned char*)(F.lds + X_TILEE), 1);
            EpiDn E{F.in[I_BDN] + (size_t)l * NE * D, wsp<bf16>(F, WS_XG)};
            stagger(F.bx >> 3, STAG_US);
            pg8::gemm_phase<EpiDn, MoeOrder, PG8_ALIGN, PG8_SP2>(F.lds, g, S, E, F.tid);
        } SEAM(pb + 8);
        if (PHM(11) && IN(pb + 9)) for (int rep = 0; rep < REPS(11); ++rep) { FRESH(); phase_ln2(F, l); } SEAM(pb + 9);
    }
#undef IN
#undef SEAM
#undef FRESH
}

extern "C" void kernel_launch(void* const* d_in, const int* in_sizes, int n_in, void* d_out, int out_size, void* d_ws, size_t ws_size, hipStream_t stream) {
    static int grid = 0;
    if (grid == 0) {
        if (n_in != 20 || out_size != T * D || ws_size < WS_END) { fprintf(stderr, "kernel_launch: unexpected shapes (n_in %d, out %d, ws %zu < %zu)\n", n_in, out_size, ws_size, (size_t)WS_END); grid = -1; return; }
        int dev = 0, cus = 0;
        if (hipGetDevice(&dev) != hipSuccess || hipDeviceGetAttribute(&cus, hipDeviceAttributeMultiprocessorCount, dev) != hipSuccess) { grid = -1; return; }
        if (hipFuncSetAttribute((const void*)fwd, hipFuncAttributeMaxDynamicSharedMemorySize, LDS_BYTES) != hipSuccess) { fprintf(stderr, "kernel_launch: hipFuncSetAttribute failed\n"); grid = -1; return; }
        int per_cu = 0;
        if (hipOccupancyMaxActiveBlocksPerMultiprocessor(&per_cu, (const void*)fwd, 512, LDS_BYTES) != hipSuccess || per_cu < 1) fprintf(stderr, "kernel_launch: occupancy query says %d blocks per CU\n", per_cu);
        (void)hipGetLastError();
        grid = cus;
    }
    if (grid < 0) return;
    (void)in_sizes;
    if (hipMemsetAsync((char*)d_ws + WS_CTL, 0, CTL_ZERO_BYTES, stream) != hipSuccess) return;
    Args a{};
    for (int i = 0; i < 20; ++i) a.in[i] = (const float*)d_in[i];
    a.out = (float*)d_out; a.ws = (unsigned char*)d_ws;
#if MK_PER_PHASE
    for (int p = 0; p < NPHASE; ++p) { a.ph_lo = p; a.ph_hi = p + 1; hipLaunchKernelGGL(fwd, dim3(grid), dim3(512), LDS_BYTES, stream, a); }
#else
    a.ph_lo = 0; a.ph_hi = NPHASE;
    hipLaunchKernelGGL(fwd, dim3(grid), dim3(512), LDS_BYTES, stream, a);
#endif
    const hipError_t le = hipPeekAtLastError();
    if (le != hipSuccess) fprintf(stderr, "kernel_launch: launch failed: %s\n", hipGetErrorName(le));
}
```

```cpp
#include <hip/hip_runtime.h>
#include <cstdio>
#include <cstdint>
#ifndef MK_PER_PHASE
#define MK_PER_PHASE 0
#endif
namespace pg8 {
#define PG8_LAS __attribute__((address_space(3)))
typedef unsigned short bf16_t;
typedef short bf16x8 __attribute__((ext_vector_type(8)));
typedef float f32x4 __attribute__((ext_vector_type(4)));
typedef unsigned u32x4 __attribute__((ext_vector_type(4)));
constexpr int BM = 256, BK = 64, HALF = 128, HTB = HALF * BK * 2  , STAGE_BYTES = 8 * HTB, NXCD = 8;
#ifndef PG8_WGM
#define PG8_WGM 8
#endif
constexpr int WGM = PG8_WGM;

__host__ __device__ __forceinline__ int lds_byte(int r, int c) { const int st = (r >> 4) * 2 + (c >> 5), rr = r & 15, cc = c & 31, ob = rr * 64 + cc * 2; return st * 1024 + (ob ^ (((ob >> 9) & 1) << 5)); }
__host__ __device__ __forceinline__ void stage_rc(int b, int& R, int& C) { const int st = b / 1024, sb = b % 1024, swz = sb ^ (((sb >> 9) & 1) << 5); R = (st >> 1) * 16 + swz / 64; C = (st & 1) * 32 + (swz % 64) / 2; }
__host__ __device__ __forceinline__ int perm32(int rho) { const int n = rho >> 4, i = rho & 15; return 8 * (i >> 2) + 4 * n + (i & 3); }

struct Unit { int pm, pn; };
struct Gemm { const bf16_t* A; const bf16_t* Bt; int M, N, K; };

struct StaticOrder {
    static constexpr bool GATHER = false; __device__ __forceinline__ int arow(int, int r) const { return r; }
    int nM, nN, nwg, G, c;
    __host__ __device__ void init(int M, int N, int G_, int c_) { nM = M / BM; nN = N / BM; nwg = nM * nN; G = G_; c = c_; }
    __host__ __device__ bool next(int i, Unit& u) const {
        const long L = (long)i * G + c; if (L >= nwg) return false;
        int wgid = (int)L; { const int q = nwg / NXCD, r = nwg % NXCD, xcd = wgid % NXCD, off = wgid / NXCD; wgid = (xcd < r ? xcd * (q + 1) : r * (q + 1) + (xcd - r) * q) + off; }
        const int nig = WGM * nN, gid = wgid / nig, fm = gid * WGM, gsz = (nM - fm) < WGM ? (nM - fm) : WGM;
        u.pm = fm + ((wgid % nig) % gsz); u.pn = (wgid % nig) / gsz; return true;
    }
    __device__ __forceinline__ void a_ready(const Unit&) const {}
    __device__ __forceinline__ void done(const Unit&) const {}
};

__device__ __forceinline__ unsigned cvt_pk_bf16(float lo, float hi) { unsigned r; asm volatile("v_cvt_pk_bf16_f32 %0, %1, %2" : "=v"(r) : "v"(lo), "v"(hi)); return r; }
typedef float f32x2 __attribute__((ext_vector_type(2)));

template <class Epi, class Sched, bool ALIGN_EPI = false, bool SP2 = false>
__device__ __forceinline__ void gemm_phase(PG8_LAS unsigned char* lds, const Gemm g, const Sched& S, const Epi& E, const int tid_in) {
    const int tid = tid_in, wid = __builtin_amdgcn_readfirstlane(tid >> 6), lane = tid & 63, wr = wid >> 2, wc = wid & 3, fr = lane & 15, fq = lane >> 4;
    const int K = g.K, nt = K / BK; constexpr bool BBLK = true;
    unsigned voffA[2], voffB[2];
#pragma unroll
    for (int i = 0; i < 2; ++i) { int R, C; stage_rc(tid * 16 + i * 8192, R, C); const int Rb = Epi::BADJ ? (64 * (R >> 5) + perm32(R & 31)) : Epi::PERM ? ((R & ~31) + perm32(R & 31)) : R;
        voffA[i] = Epi::ABLK ? (unsigned)((((R >> 4) * (K >> 5) + (C >> 5)) * 8 + (R & 7)) * 128 + ((R >> 3) & 1) * 64 + (C & 31) * 2) : (unsigned)(R * K + C) * 2u; voffB[i] = BBLK ? (unsigned)((((Rb >> 4) * (K >> 5) + (C >> 5)) * 8 + (Rb & 7)) * 128 + ((Rb >> 3) & 1) * 64 + (C & 31) * 2) : (unsigned)(Rb * K + C) * 2u; }
    const size_t kstep = (size_t)(BK * 2);
    const size_t kstepB = BBLK ? (size_t)2048 : kstep;
    const size_t kstepA = Epi::ABLK ? (size_t)2048 : kstep;
    const size_t hstep = (size_t)HALF * K * 2;
    const size_t tstep = 2 * hstep;
    const size_t bhstep = Epi::BADJ ? (size_t)32 * K * 2 : hstep;
    const unsigned ldsw = (unsigned)wid * 1024u;
    const int aoff = lds_byte(wr * 64 + fr, fq * 8), boff = lds_byte(wc * 32 + fr, fq * 8);
#define PG8_SA(b, h) (((b) * 2 + (h)) * HTB)
#define PG8_SB(b, h) ((4 + (b) * 2 + (h)) * HTB)
    unsigned gc[2][2], gn[2][2];
#define PG8_GOFF(dst, pmv, ordv) do { if constexpr (Sched::GATHER) { _Pragma("unroll") for (int _h = 0; _h < 2; ++_h) _Pragma("unroll") for (int _i = 0; _i < 2; ++_i) { int _R, _C; stage_rc(tid * 16 + _i * 8192, _R, _C); \
        dst[_h][_i] = (unsigned)S.arow((ordv), (pmv) * 256 + _h * 128 + _R) * (unsigned)(K * 2) + (unsigned)(_C * 2); } } } while (0)
#define PG8_STAGE_A(bufoff, origptr, nextf, hh, kbytes) do { if constexpr (Sched::GATHER) { _Pragma("unroll") for (int _i = 0; _i < 2; ++_i) { const unsigned _o = (nextf) ? gn[hh][_i] : gc[hh][_i]; \
        __builtin_amdgcn_global_load_lds((const unsigned*)((const char*)g.A + (kbytes) + _o), (PG8_LAS unsigned*)(lds + (bufoff) + ldsw + _i * 8192), 16, 0, 0); } } else { PG8_STAGE(bufoff, origptr, voffA); } } while (0)
#define PG8_STAGE(bufoff, gbase, voff) do { _Pragma("unroll") for (int _i = 0; _i < 2; ++_i) \
        __builtin_amdgcn_global_load_lds((const unsigned*)((const char*)(gbase) + (voff)[_i]), (PG8_LAS unsigned*)(lds + (bufoff) + ldsw + _i * 8192), 16, 0, 0); } while (0)
#define PG8_LDA(dst, b, h) do { _Pragma("unroll") for (int m = 0; m < 4; ++m) _Pragma("unroll") for (int k = 0; k < 2; ++k) dst[m][k] = *(const PG8_LAS bf16x8*)(lds + PG8_SA(b, h) + aoff + m * 2048 + k * 1024); } while (0)
#define PG8_LDB(dst, b, h) do { _Pragma("unroll") for (int n = 0; n < 2; ++n) _Pragma("unroll") for (int k = 0; k < 2; ++k) dst[n][k] = *(const PG8_LAS bf16x8*)(lds + PG8_SB(b, h) + boff + n * 2048 + k * 1024); } while (0)
#define PG8_MMA(ai, bj, At, Bt) do { __builtin_amdgcn_s_setprio(1); _Pragma("unroll") for (int m = 0; m < 4; ++m) _Pragma("unroll") for (int n = 0; n < 2; ++n) _Pragma("unroll") for (int k = 0; k < 2; ++k) \
        acc[ai][bj][m][n] = __builtin_amdgcn_mfma_f32_16x16x32_bf16(Bt[n][k], At[m][k], acc[ai][bj][m][n], 0, 0, 0); __builtin_amdgcn_s_setprio(0); } while (0)
#define PG8_WAIT_V(n) asm volatile("s_waitcnt vmcnt(" #n ")" ::: "memory")
#define PG8_WAIT_L(n) asm volatile("s_waitcnt lgkmcnt(" #n ")" ::: "memory")
#define PG8_BAR __builtin_amdgcn_s_barrier()
#define PG8_SCHED __builtin_amdgcn_sched_barrier(0)
    Unit cur, nxt; int ui = 0;
    if (!S.next(0, cur)) return;
    f32x4 acc[2][2][4][2];
#pragma unroll
    for (int a = 0; a < 2; ++a)
#pragma unroll
        for (int b = 0; b < 2; ++b)
#pragma unroll
            for (int m = 0; m < 4; ++m)
#pragma unroll
                for (int n = 0; n < 2; ++n) acc[a][b][m][n] = (f32x4){0.f, 0.f, 0.f, 0.f};
    bf16x8 At[4][2], B0[2][2], B1[2][2];
    const char* cA = (const char*)g.A + (size_t)cur.pm * tstep; const char* cB = (const char*)g.Bt + (size_t)cur.pn * tstep;
    S.a_ready(cur);
    PG8_GOFF(gc, cur.pm, 0);
    if constexpr (SP2) {
        PG8_STAGE(PG8_SB(0, 0), cB, voffB); PG8_STAGE(PG8_SB(0, 1), cB + bhstep, voffB); PG8_STAGE_A(PG8_SA(0, 0), cA, false, 0, 0); PG8_STAGE_A(PG8_SA(0, 1), cA + hstep, false, 1, 0);
        if (wr == 1) PG8_BAR;
        PG8_WAIT_V(2); PG8_BAR;
        PG8_STAGE(PG8_SB(1, 0), cB + kstepB, voffB); PG8_STAGE_A(PG8_SA(1, 0), cA + kstepA, false, 0, kstep); PG8_STAGE(PG8_SB(1, 1), cB + bhstep + kstepB, voffB);
        PG8_WAIT_V(6); PG8_BAR;
    } else {
        PG8_STAGE(PG8_SB(0, 0), cB, voffB); PG8_STAGE(PG8_SA(0, 0), cA, voffA); PG8_STAGE(PG8_SB(0, 1), cB + bhstep, voffB); PG8_STAGE(PG8_SA(0, 1), cA + hstep, voffA);
        if (wr == 1) PG8_BAR;
        PG8_WAIT_V(4); PG8_BAR;
        PG8_STAGE(PG8_SB(1, 0), cB + kstepB, voffB); PG8_STAGE(PG8_SA(1, 0), cA + kstepA, voffA); PG8_STAGE(PG8_SB(1, 1), cB + bhstep + kstepB, voffB);
        PG8_WAIT_V(6); PG8_BAR;
    }
    for (;;) {
        const bool has_next = S.next(ui + 1, nxt);
        if constexpr (Sched::GATHER) { if (has_next) { PG8_GOFF(gn, nxt.pm, ui + 1); } else { gn[0][0] = gc[0][0]; gn[0][1] = gc[0][1]; gn[1][0] = gc[1][0]; gn[1][1] = gc[1][1]; } }
        const char* nA = has_next ? (const char*)g.A + (size_t)nxt.pm * tstep : cA; const char* nB = has_next ? (const char*)g.Bt + (size_t)nxt.pn * tstep : cB;
#pragma unroll
        for (int seg = 0; seg < (Epi::MID_T > 0 ? 2 : 1); ++seg) {
        if constexpr (Epi::MID_T > 0) { if (seg == 1) { PG8_SCHED; E.mid(acc, cur, wr, wc, fr, fq); PG8_SCHED; } }
        const int t_lo = seg ? Epi::MID_T : 0, t_hi = (Epi::MID_T > 0 && seg == 0) ? Epi::MID_T : nt;
        for (int t = t_lo; t < t_hi; t += 2) {
            const bool last = (t == nt - 2);
            const char* a1 = cA + (size_t)(t + 1) * kstepA;
            const char* a2 = last ? nA : cA + (size_t)(t + 2) * kstepA; const char* b2 = last ? nB : cB + (size_t)(t + 2) * kstepB;
            const char* a3 = a2 + kstepA; const char* b3 = b2 + kstepB; const size_t k2b = last ? (size_t)0 : (size_t)(t + 2) * kstep;
            if (last && has_next) S.a_ready(nxt);
            if constexpr (SP2) {
            PG8_LDB(B0, 0, 0); PG8_LDB(B1, 0, 1); PG8_SCHED; PG8_LDA(At, 0, 0); PG8_STAGE_A(PG8_SA(1, 1), a1 + hstep, false, 1, (size_t)(t + 1) * kstep);
            PG8_WAIT_V(8); PG8_WAIT_L(0); PG8_BAR; PG8_MMA(0, 0, At, B0); PG8_MMA(0, 1, At, B1); PG8_BAR; PG8_SCHED;
            PG8_LDA(At, 0, 1); PG8_STAGE(PG8_SB(0, 0), b2, voffB); PG8_STAGE(PG8_SB(0, 1), b2 + bhstep, voffB); PG8_STAGE_A(PG8_SA(0, 0), a2, last, 0, k2b);
            PG8_WAIT_V(8); PG8_WAIT_L(0); PG8_BAR; PG8_MMA(1, 0, At, B0); PG8_MMA(1, 1, At, B1); PG8_BAR; PG8_SCHED;
            PG8_LDB(B0, 1, 0); PG8_LDB(B1, 1, 1); PG8_SCHED; PG8_LDA(At, 1, 0); PG8_STAGE_A(PG8_SA(0, 1), a2 + hstep, last, 1, k2b);
            PG8_WAIT_V(8); PG8_WAIT_L(0); PG8_BAR; PG8_MMA(0, 0, At, B0); PG8_MMA(0, 1, At, B1); PG8_BAR; PG8_SCHED;
            PG8_LDA(At, 1, 1); PG8_STAGE(PG8_SB(1, 0), b3, voffB); PG8_STAGE(PG8_SB(1, 1), b3 + bhstep, voffB); PG8_STAGE_A(PG8_SA(1, 0), a3, last, 0, k2b + kstep);
            PG8_WAIT_V(8); PG8_WAIT_L(0); PG8_BAR; PG8_MMA(1, 0, At, B0); PG8_MMA(1, 1, At, B1); PG8_BAR; PG8_SCHED;
            } else {
            PG8_LDB(B0, 0, 0); PG8_SCHED; PG8_LDA(At, 0, 0); PG8_STAGE(PG8_SA(1, 1), a1 + hstep, voffA);
            PG8_WAIT_L(8); PG8_BAR; PG8_WAIT_L(0); PG8_MMA(0, 0, At, B0); PG8_BAR; PG8_SCHED;
            PG8_LDB(B1, 0, 1); PG8_STAGE(PG8_SB(0, 0), b2, voffB);
            PG8_BAR; PG8_WAIT_L(0); PG8_MMA(0, 1, At, B1); PG8_BAR;
            PG8_LDA(At, 0, 1); PG8_STAGE(PG8_SA(0, 0), a2, voffA);
            PG8_BAR; PG8_WAIT_L(0); PG8_MMA(1, 0, At, B0); PG8_BAR; PG8_SCHED;
            PG8_STAGE(PG8_SB(0, 1), b2 + bhstep, voffB);
            PG8_WAIT_V(6); PG8_BAR; PG8_MMA(1, 1, At, B1); PG8_BAR;
            PG8_LDB(B0, 1, 0); PG8_SCHED; PG8_LDA(At, 1, 0); PG8_STAGE(PG8_SA(0, 1), a2 + hstep, voffA);
            PG8_WAIT_L(8); PG8_BAR; PG8_WAIT_L(0); PG8_MMA(0, 0, At, B0); PG8_BAR; PG8_SCHED;
            PG8_LDB(B1, 1, 1); PG8_STAGE(PG8_SB(1, 0), b3, voffB);
            PG8_BAR; PG8_WAIT_L(0); PG8_MMA(0, 1, At, B1); PG8_BAR;
            PG8_LDA(At, 1, 1); PG8_STAGE(PG8_SA(1, 0), a3, voffA);
            PG8_BAR; PG8_WAIT_L(0); PG8_MMA(1, 0, At, B0); PG8_BAR; PG8_SCHED;
            PG8_STAGE(PG8_SB(1, 1), b3 + bhstep, voffB);
            PG8_WAIT_V(6); PG8_BAR; PG8_MMA(1, 1, At, B1); PG8_BAR;
            }
        }
        }
        if constexpr (ALIGN_EPI) { if (wr == 0) PG8_BAR; }
        if constexpr (!Epi::AFTER_DRAIN) { E(acc, cur, wr, wc, fr, fq); S.done(cur); }
        if (!has_next) break;
#pragma unroll
        for (int a = 0; a < 2; ++a)
#pragma unroll
            for (int b = 0; b < 2; ++b)
#pragma unroll
                for (int m = 0; m < 4; ++m)
#pragma unroll
                    for (int n = 0; n < 2; ++n) acc[a][b][m][n] = (f32x4){0.f, 0.f, 0.f, 0.f};
        cur = nxt; cA = nA; cB = nB; ++ui;
        if constexpr (Sched::GATHER) { gc[0][0] = gn[0][0]; gc[0][1] = gn[0][1]; gc[1][0] = gn[1][0]; gc[1][1] = gn[1][1]; }
        if constexpr (ALIGN_EPI) { if (wr == 1) PG8_BAR; }
    }
    PG8_WAIT_V(0);
    if constexpr (!ALIGN_EPI) { if (wr == 0) PG8_BAR; }
    PG8_BAR;
    if constexpr (Epi::AFTER_DRAIN) { E.fused(acc, cur, wr, wc, fr, fq, lds, wid, lane); S.done(cur); }
#undef PG8_SA
#undef PG8_SB
#undef PG8_STAGE
#undef PG8_STAGE_A
#undef PG8_GOFF
#undef PG8_LDA
#undef PG8_LDB
#undef PG8_MMA
#undef PG8_WAIT_V
#undef PG8_WAIT_L
#undef PG8_BAR
#undef PG8_SCHED
}
}
#define LAS __attribute__((address_space(3)))
#define XB_TMO      128
#define XB_XCNT(j)  (256  + 64 * (j))
#define XB_XSUB(j)  (1280 + 64 * (j))
#define XB_XGEN(j)  (2304 + 64 * (j))
#define XB_TOP      3328
#define XB_TOPGEN   3392
#define XCD_BAR_WORDS 3456
#define XB_SPIN_CAP (1u << 18)

__device__ __forceinline__ unsigned xb_ld(unsigned* p)              { return __hip_atomic_load(p, __ATOMIC_RELAXED, __HIP_MEMORY_SCOPE_AGENT); }
__device__ __forceinline__ unsigned xb_add(unsigned* p, unsigned v) { return __hip_atomic_fetch_add(p, v, __ATOMIC_RELAXED, __HIP_MEMORY_SCOPE_AGENT); }
__device__ __forceinline__ unsigned xb_xcc_id() { return (unsigned)__builtin_amdgcn_s_getreg((3 << 11) | 20) & 0xFu; }
#define XB_SPIN(cond, bar) do { unsigned _sp = 0; while (cond) { __builtin_amdgcn_s_sleep(1); \
    if ((++_sp & 255u) == 0u) { if (xb_ld(&(bar)[XB_TMO])) break; if (_sp > XB_SPIN_CAP) { atomicAdd(&(bar)[XB_TMO], 1u); break; } } } } while (0)

struct XcdBarrier {
    unsigned* bar; unsigned x;
    volatile LAS unsigned* st;
};

__device__ __forceinline__ XcdBarrier xcd_barrier_post(unsigned* bar, volatile LAS unsigned* st) {
    XcdBarrier b; b.bar = bar; b.x = xb_xcc_id(); b.st = st;
    if (threadIdx.x == 0) (void)xb_add(&bar[XB_XCNT(b.x)], 1u);
    return b;
}
__device__ __forceinline__ void xcd_barrier_complete(unsigned* bar, unsigned x, unsigned& nloc, unsigned& nx) {
    const unsigned G = gridDim.x * gridDim.y * gridDim.z;
    unsigned sum, cnt, mine, sp = 0u;
    for (;;) {
        sum = 0u; cnt = 0u; mine = 0u;
#pragma unroll
        for (unsigned j = 0; j < 16; ++j) { const unsigned c = xb_ld(&bar[XB_XCNT(j)]); sum += c; cnt += (c > 0u) ? 1u : 0u; mine = (j == x) ? c : mine; }
        if (sum == G) break;
        __builtin_amdgcn_s_sleep(1);
        if ((++sp & 255u) == 0u) { if (xb_ld(&bar[XB_TMO])) break; if (sp > XB_SPIN_CAP) { atomicAdd(&bar[XB_TMO], 1u); break; } }
    }
    nloc = mine > 0u ? mine : 1u; nx = cnt > 0u ? cnt : 1u;
}

__device__ __forceinline__ void xcd_barrier(const XcdBarrier& b) {
    asm volatile("s_waitcnt vmcnt(0)" ::: "memory");
    __syncthreads();
    if (threadIdx.x == 0) {
        unsigned* bar = b.bar;
        __builtin_amdgcn_s_waitcnt(0);
        unsigned nloc = b.st[0], nx = b.st[1];
        if (nloc == 0u) { xcd_barrier_complete(bar, b.x, nloc, nx); b.st[0] = nloc; b.st[1] = nx; }
        const unsigned old = xb_add(&bar[XB_XSUB(b.x)], 1u);
        const unsigned gen = old / nloc;
        if (old + 1u == (gen + 1u) * nloc) {
            __builtin_amdgcn_fence(__ATOMIC_RELEASE, "agent");
            asm volatile("s_waitcnt vmcnt(0)" ::: "memory");
            const unsigned og = xb_add(&bar[XB_TOP], 1u);
            const unsigned tg = og / nx;
            if (og + 1u == (tg + 1u) * nx) xb_add(&bar[XB_TOPGEN], 1u);
            else XB_SPIN(xb_ld(&bar[XB_TOPGEN]) == tg, bar);
            __builtin_amdgcn_fence(__ATOMIC_ACQUIRE, "agent");
            xb_add(&bar[XB_XGEN(b.x)], 1u);
            asm volatile("s_waitcnt vmcnt(0)" ::: "memory");
        } else {
            XB_SPIN(xb_ld(&bar[XB_XGEN(b.x)]) == gen, bar);
            __builtin_amdgcn_fence(__ATOMIC_ACQUIRE, "agent");
            asm volatile("s_waitcnt vmcnt(0)" ::: "memory");
        }
    }
    __syncthreads();
}


#ifndef PG8_SP2
#define PG8_SP2 true
#endif
#ifndef PG8_ALIGN
#define PG8_ALIGN true
#endif
constexpr int D = 1024, NB = 8, SEQ = 4096, T = NB * SEQ, NL = 4;
constexpr int NIN = 8704, NE = 32, FF = 1024;
constexpr int RMAX = 139264;
constexpr float LN_EPS = 1e-5f, DN_ALPHA = 1.681792830507429f;
constexpr float QSCALE = 0.18033688011112042f;
constexpr float LOG2E = 1.4426950408889634f;

constexpr size_t MiB = 1u << 20;
constexpr size_t WS_CTL = 0, CTL_ZERO_BYTES = 1 * MiB;
constexpr size_t WS_MOD = 1 * MiB;
constexpr size_t WS_ROPE = 2 * MiB;
constexpr size_t WS_WSP = 3 * MiB;
constexpr size_t WS_WRT = 4 * MiB;
constexpr size_t WS_TOKINFO = 5 * MiB;
constexpr size_t WS_TOKW = 5 * MiB + 512 * 1024;
constexpr size_t WS_ROWTOK = 6 * MiB;
constexpr size_t WS_ROWW = 7 * MiB;
constexpr size_t WS_LSE = 8 * MiB;
constexpr size_t WS_TOKROW = 14 * MiB;
constexpr size_t WS_STAT = 13 * MiB;
constexpr size_t WS_WGCNT = 12 * MiB;
constexpr size_t WS_WIN = 16 * MiB;
constexpr size_t WS_WBA = 84 * MiB;
constexpr size_t WS_WBB = 92 * MiB;
constexpr size_t WS_WOUT = 96 * MiB;
constexpr size_t WS_WUP = 104 * MiB;
constexpr size_t WS_WDN = 616 * MiB;
constexpr size_t WS_H = 872 * MiB;
constexpr size_t WS_X1 = 936 * MiB;
constexpr size_t WS_X2 = 1064 * MiB;
constexpr size_t WS_YPRE = 1192 * MiB;
constexpr size_t WS_U = 1320 * MiB, WS_V = 1384 * MiB;
constexpr size_t WS_Q = 1448 * MiB, WS_K = 1544 * MiB, WS_VV = 1640 * MiB;
constexpr size_t WS_G = 1736 * MiB;
constexpr size_t WS_OG = 1864 * MiB;
constexpr size_t WS_TT = 1960 * MiB;
constexpr size_t WS_OB = 2024 * MiB;
constexpr size_t WS_YA = 2056 * MiB;
constexpr size_t WS_MG = 2120 * MiB;
constexpr size_t WS_XG = 2184 * MiB;
constexpr size_t WS_ACT = 2456 * MiB;
constexpr size_t WS_YK = 2728 * MiB;
constexpr size_t WS_END = 2984 * MiB;
constexpr int CW_BAR = 4096;
constexpr int CW_CNT = 16384;

constexpr int RING_BYTES = 131072;
constexpr int XOFF = RING_BYTES;
constexpr int X_MISC = XOFF;
constexpr int X_SELE = XOFF + 256;
constexpr int X_SELR = XOFF + 2304;
constexpr int X_CNTL = XOFF + 4352;
constexpr int X_BASE = XOFF + 4480;
constexpr int X_TILEE = XOFF + 4608;
constexpr int X_CNTS = XOFF + 5632;
constexpr int X_OFFS = XOFF + 5760;
constexpr int LDS_BYTES = 147456;

#define GAS __attribute__((address_space(1)))
typedef unsigned short bf16;
typedef unsigned v4u __attribute__((ext_vector_type(4)));
typedef unsigned v2u __attribute__((ext_vector_type(2)));
typedef float f32x4 __attribute__((ext_vector_type(4)));
typedef short bf16x8 __attribute__((ext_vector_type(8)));
typedef short s16x4 __attribute__((ext_vector_type(4)));
#define RLX_AGENT __ATOMIC_RELAXED, __HIP_MEMORY_SCOPE_AGENT
#define LDS_WAIT() asm volatile("s_waitcnt lgkmcnt(0)" ::: "memory")
#define VM_WAIT() asm volatile("s_waitcnt vmcnt(0)" ::: "memory")

typedef __bf16 bf16x2_t __attribute__((ext_vector_type(2))); typedef float f32x2_t __attribute__((ext_vector_type(2)));
__device__ __forceinline__ unsigned pk2(float lo, float hi) { return __builtin_bit_cast(unsigned, __builtin_convertvector((f32x2_t){lo, hi}, bf16x2_t)); }
__device__ __forceinline__ float bflo(unsigned w) { return __uint_as_float(w << 16); }
__device__ __forceinline__ float bfhi(unsigned w) { return __uint_as_float(w & 0xffff0000u); }
__device__ __forceinline__ float fexp2(float x) { return __builtin_amdgcn_exp2f(x); }
__device__ __forceinline__ float frcp(float x) { return __builtin_amdgcn_rcpf(x); }
__device__ __forceinline__ float gelu_tanh(float x) { const float u = x + 0.044715f * x * x * x; return x * frcp(1.0f + fexp2(-2.302208198144325f * u)); }
__device__ __forceinline__ float sigmoidf_(float x) { return frcp(1.0f + fexp2(-LOG2E * x)); }
__device__ __forceinline__ float wave_sum(float v) {
#pragma unroll
    for (int o = 1; o < 64; o <<= 1) v += __shfl_xor(v, o);
    return v;
}
__device__ __forceinline__ float wave_max(float v) {
#pragma unroll
    for (int o = 1; o < 64; o <<= 1) v = fmaxf(v, __shfl_xor(v, o));
    return v;
}
__device__ __forceinline__ s16x4 tr16(const LAS unsigned char* p) { return __builtin_bit_cast(s16x4, __builtin_amdgcn_ds_read_tr16_b64_v4i16((LAS s16x4*)p)); }
__device__ __forceinline__ bf16x8 cat8(s16x4 lo, s16x4 hi) { return (bf16x8){lo[0], lo[1], lo[2], lo[3], hi[0], hi[1], hi[2], hi[3]}; }
__device__ __forceinline__ f32x4 mfma16(bf16x8 a, bf16x8 b, f32x4 c) { return __builtin_amdgcn_mfma_f32_16x16x32_bf16(a, b, c, 0, 0, 0); }

struct Frame {
    LAS unsigned char* lds;
    int tid, lane, wave, G, vcu, bx;
    unsigned char* ws;
    const float* const* in;
    float* out;
};
enum { I_X = 0, I_C, I_WADA, I_BADA, I_WIN, I_SPW, I_SPB, I_WBA, I_WBB, I_WOUT, I_LN1G, I_LN1B, I_WR, I_BR, I_WUP, I_BUP, I_WDN, I_BDN, I_LN2G, I_LN2B };
template <class Tp> __device__ __forceinline__ Tp* wsp(const Frame& F, size_t off) { return (Tp*)(F.ws + off); }

template <class P> __device__ __forceinline__ P launder(P p) { unsigned lo = (unsigned)(uintptr_t)p, hi = (unsigned)((uintptr_t)p >> 32); asm volatile("" : "+v"(lo), "+v"(hi));
    lo = (unsigned)__builtin_amdgcn_readfirstlane((int)lo); hi = (unsigned)__builtin_amdgcn_readfirstlane((int)hi); return (P)(((uintptr_t)hi << 32) | (uintptr_t)lo); }
__device__ __forceinline__ unsigned fl_x8(unsigned v) { return (unsigned)__builtin_amdgcn_update_dpp(0, (int)v, 0x128, 0xf, 0xf, false); }
#ifndef FLNT
#define FLNT true
#endif
template <bool NT> __device__ __forceinline__ void fl_put(bf16* p, size_t ld, bool lo, const v4u& w0, const v4u& w1) {
    v4u sd; sd.x = lo ? w1.x : w0.x; sd.y = lo ? w1.y : w0.y; sd.z = lo ? w1.z : w0.z; sd.w = lo ? w1.w : w0.w;
    v4u rc; rc.x = fl_x8(sd.x); rc.y = fl_x8(sd.y); rc.z = fl_x8(sd.z); rc.w = fl_x8(sd.w);
    v4u oa, ob; oa.x = lo ? w0.x : rc.x; oa.y = lo ? w0.y : rc.y; oa.z = lo ? w0.z : rc.z; oa.w = lo ? w0.w : rc.w;
    ob.x = lo ? rc.x : w1.x; ob.y = lo ? rc.y : w1.y; ob.z = lo ? rc.z : w1.z; ob.w = lo ? rc.w : w1.w;
    if (NT) { __builtin_nontemporal_store(oa, (v4u*)p); __builtin_nontemporal_store(ob, (v4u*)(p + 8 * ld)); } else { *(v4u*)p = oa; *(v4u*)(p + 8 * ld) = ob; } }
struct EpiIn {
    static constexpr int MID_T = 0; static constexpr bool PERM = true, AFTER_DRAIN = false, BADJ = true, ABLK = false;
    bf16 *U, *V, *Q, *K, *VV, *Gt; const float* rope;
    __device__ __forceinline__ void operator()(const f32x4 (&acc)[2][2][4][2], const pg8::Unit& u, int wr, int wc, int fr, int fq) const {
        const int pn = u.pn; int type, ld, colt; bf16* base;
        if (pn < 4) { type = 0; base = U; ld = 1024; colt = pn * 256; }
        else if (pn < 8) { type = 0; base = V; ld = 1024; colt = (pn - 4) * 256; }
        else if (pn < 14) { type = 1; base = Q; ld = 1536; colt = (pn - 8) * 256; }
        else if (pn < 20) { type = 2; base = K; ld = 1536; colt = (pn - 14) * 256; }
        else if (pn < 26) { type = 3; base = VV; ld = 1536; colt = (pn - 20) * 256; }
        else { type = 4; base = Gt; ld = 2048; colt = (pn - 26) * 256; }
        const bool lo = fr < 8;
        const int rowl = u.pm * 256 + wr * 64 + fr;
        bf16* const pst = base + (size_t)(u.pm * 256 + wr * 64 + (fr & 7)) * ld + colt + wc * 64 + (fr >> 3) * 32 + 8 * fq;
        if (type == 0) {
#pragma unroll
            for (int ai = 0; ai < 2; ++ai)
#pragma unroll
                for (int m = 0; m < 4; ++m) { v4u w[2];
#pragma unroll
                    for (int bj = 0; bj < 2; ++bj) { const f32x4 v0 = acc[ai][bj][m][0], v1 = acc[ai][bj][m][1];
                        w[bj].x = pk2(gelu_tanh(v0[0]), gelu_tanh(v0[1])); w[bj].y = pk2(gelu_tanh(v0[2]), gelu_tanh(v0[3]));
                        w[bj].z = pk2(gelu_tanh(v1[0]), gelu_tanh(v1[1])); w[bj].w = pk2(gelu_tanh(v1[2]), gelu_tanh(v1[3])); }
                    fl_put<true>(pst + (size_t)(ai * 128 + m * 16) * ld, ld, lo, w[0], w[1]); }
        } else if (type == 4) {
#pragma unroll
            for (int ai = 0; ai < 2; ++ai)
#pragma unroll
                for (int m = 0; m < 4; ++m) { v4u w[2];
#pragma unroll
                    for (int bj = 0; bj < 2; ++bj) { const f32x4 v0 = acc[ai][bj][m][0], v1 = acc[ai][bj][m][1];
                        w[bj].x = pk2(sigmoidf_(v0[0]), sigmoidf_(v0[1])); w[bj].y = pk2(sigmoidf_(v0[2]), sigmoidf_(v0[3]));
                        w[bj].z = pk2(sigmoidf_(v1[0]), sigmoidf_(v1[1])); w[bj].w = pk2(sigmoidf_(v1[2]), sigmoidf_(v1[3])); }
                    fl_put<true>(pst + (size_t)(ai * 128 + m * 16) * ld, ld, lo, w[0], w[1]); }
        } else if (type == 3) {
#pragma unroll
            for (int ai = 0; ai < 2; ++ai)
#pragma unroll
                for (int m = 0; m < 4; ++m) { v4u w[2];
#pragma unroll
                    for (int bj = 0; bj < 2; ++bj) { const f32x4 v0 = acc[ai][bj][m][0], v1 = acc[ai][bj][m][1];
                        w[bj].x = pk2(v0[0], v0[1]); w[bj].y = pk2(v0[2], v0[3]); w[bj].z = pk2(v1[0], v1[1]); w[bj].w = pk2(v1[2], v1[3]); }
                    fl_put<true>(pst + (size_t)(ai * 128 + m * 16) * ld, ld, lo, w[0], w[1]); }
        } else {
            const float sc = (type == 1) ? QSCALE : 1.0f;
#pragma unroll
            for (int ai = 0; ai < 2; ++ai)
#pragma unroll
                for (int m = 0; m < 4; ++m) { const int row = rowl + ai * 128 + m * 16;
                    const f32x4* rp = (const f32x4*)(rope + (size_t)(row & (SEQ - 1)) * 16); const f32x4 c0 = rp[0], c1 = rp[1], s0 = rp[2], s1 = rp[3];
                    float cs[8], sn[8];
#pragma unroll
                    for (int e = 0; e < 4; ++e) { cs[e] = c0[e]; cs[4 + e] = c1[e]; sn[e] = s0[e]; sn[4 + e] = s1[e]; }
                    v4u w[2];
#pragma unroll
                    for (int bj = 0; bj < 2; ++bj) { f32x4 v0 = acc[ai][bj][m][0], v1 = acc[ai][bj][m][1];
                        if (bj == 0) {
#pragma unroll
                            for (int e = 0; e < 8; ++e) { const float x = (e < 4) ? v0[e & 3] : v1[e & 3]; const float p = __shfl_xor(x, 16);
                                float y = x;
                                if (fq == 0) y = x * cs[e] - p * sn[e];
                                if (fq == 1) y = x * cs[e] + p * sn[e];
                                if (e < 4) v0[e & 3] = y; else v1[e & 3] = y; } }
                        w[bj].x = pk2(v0[0] * sc, v0[1] * sc); w[bj].y = pk2(v0[2] * sc, v0[3] * sc); w[bj].z = pk2(v1[0] * sc, v1[1] * sc); w[bj].w = pk2(v1[2] * sc, v1[3] * sc); }
                    fl_put<true>(pst + (size_t)(ai * 128 + m * 16) * ld, ld, lo, w[0], w[1]); }
        }
    }
};
struct EpiProbe {
    static constexpr int MID_T = 0; static constexpr bool PERM = true, AFTER_DRAIN = false, BADJ = false, ABLK = false;
    bf16* O; int ld; int on;
    __device__ __forceinline__ void operator()(const f32x4 (&acc)[2][2][4][2], const pg8::Unit& u, int wr, int wc, int fr, int fq) const {
        if (!on) return;
        const int row0 = u.pm * 256 + wr * 64 + fr, col0 = ((on == 3) ? u.pn : (u.pn & 3)) * 256 + wc * 32 + 8 * fq;
#pragma unroll
        for (int ai = 0; ai < 2; ++ai)
#pragma unroll
            for (int m = 0; m < 4; ++m) { bf16* rowp = O + (size_t)(row0 + ai * 128 + m * 16) * ld + col0;
#pragma unroll
                for (int bj = 0; bj < 2; ++bj) { const f32x4 v0 = acc[ai][bj][m][0], v1 = acc[ai][bj][m][1]; v4u w;
                    w.x = pk2(v0[0], v0[1]); w.y = pk2(v0[2], v0[3]); w.z = pk2(v1[0], v1[1]); w.w = pk2(v1[2], v1[3]);
                    *(v4u*)(rowp + bj * 128) = w; } }
    }
};
struct EpiYA {
    static constexpr int MID_T = 0; static constexpr bool PERM = true, AFTER_DRAIN = false, BADJ = false, ABLK = false;
    const bf16* Gt; bf16* YA;
    __device__ __forceinline__ void operator()(const f32x4 (&acc)[2][2][4][2], const pg8::Unit& u, int wr, int wc, int fr, int fq) const {
        const int row0 = u.pm * 256 + wr * 64 + fr, col0 = u.pn * 256 + wc * 32 + 8 * fq;
#pragma unroll
        for (int ai = 0; ai < 2; ++ai)
#pragma unroll
            for (int m = 0; m < 4; ++m) { const size_t row = (size_t)(row0 + ai * 128 + m * 16);
#pragma unroll
                for (int bj = 0; bj < 2; ++bj) { const f32x4 v0 = acc[ai][bj][m][0], v1 = acc[ai][bj][m][1];
                    const v4u g = *(const v4u*)(Gt + row * 2048 + col0 + bj * 128); v4u w;
                    w.x = pk2(v0[0] * bflo(g.x), v0[1] * bfhi(g.x)); w.y = pk2(v0[2] * bflo(g.y), v0[3] * bfhi(g.y));
                    w.z = pk2(v1[0] * bflo(g.z), v1[1] * bfhi(g.z)); w.w = pk2(v1[2] * bflo(g.w), v1[3] * bfhi(g.w));
                    *(v4u*)(YA + row * 1024 + col0 + bj * 128) = w; } }
    }
};
struct EpiMg {
    static constexpr int MID_T = 0; static constexpr bool PERM = true, AFTER_DRAIN = false, BADJ = false, ABLK = false;
    const bf16* Gt; const bf16* YA; bf16* MG;
    __device__ __forceinline__ void operator()(const f32x4 (&acc)[2][2][4][2], const pg8::Unit& u, int wr, int wc, int fr, int fq) const {
        const int row0 = u.pm * 256 + wr * 64 + fr, col0 = u.pn * 256 + wc * 32 + 8 * fq;
#pragma unroll
        for (int ai = 0; ai < 2; ++ai)
#pragma unroll
            for (int m = 0; m < 4; ++m) { const size_t row = (size_t)(row0 + ai * 128 + m * 16);
#pragma unroll
                for (int bj = 0; bj < 2; ++bj) { const f32x4 v0 = acc[ai][bj][m][0], v1 = acc[ai][bj][m][1];
                    const v4u g = *(const v4u*)(Gt + row * 2048 + 1024 + col0 + bj * 128); const v4u y = *(const v4u*)(YA + row * 1024 + col0 + bj * 128); v4u w;
                    w.x = pk2(bflo(y.x) + v0[0] * bflo(g.x), bfhi(y.x) + v0[1] * bfhi(g.x)); w.y = pk2(bflo(y.y) + v0[2] * bflo(g.y), bfhi(y.y) + v0[3] * bfhi(g.y));
                    w.z = pk2(bflo(y.z) + v1[0] * bflo(g.z), bfhi(y.z) + v1[1] * bfhi(g.z)); w.w = pk2(bflo(y.w) + v1[2] * bflo(g.w), bfhi(y.w) + v1[3] * bfhi(g.w));
                    *(v4u*)(MG + row * 1024 + col0 + bj * 128) = w; } }
    }
};
struct EpiMg2 {
    static constexpr int MID_T = 16; static constexpr bool PERM = true, AFTER_DRAIN = false, BADJ = true, ABLK = false;
    const bf16* Gt; bf16* MG;
    __device__ __forceinline__ void mid(f32x4 (&acc)[2][2][4][2], const pg8::Unit& u, int wr, int wc, int fr, int fq) const {
        int row0 = u.pm * 256 + wr * 64 + fr; const int col0 = u.pn * 256 + wc * 64 + 8 * fq;
        asm volatile("" : "+v"(row0));
#pragma unroll
        for (int ai = 0; ai < 2; ++ai)
#pragma unroll
            for (int m = 0; m < 4; ++m) { const size_t row = (size_t)(row0 + ai * 128 + m * 16);
#pragma unroll
                for (int bj = 0; bj < 2; ++bj) { const v4u g0 = *(const v4u*)(Gt + row * 2048 + col0 + bj * 32), g1 = *(const v4u*)(Gt + row * 2048 + 1024 + col0 + bj * 32);
                    const unsigned a0[4] = {g0.x, g0.y, g0.z, g0.w}, a1[4] = {g1.x, g1.y, g1.z, g1.w};
#pragma unroll
                    for (int q = 0; q < 4; ++q) { const float r0 = bflo(a0[q]) * frcp(fmaxf(bflo(a1[q]), 1e-20f)), r1 = bfhi(a0[q]) * frcp(fmaxf(bfhi(a1[q]), 1e-20f));
                        acc[ai][bj][m][q >> 1][(q & 1) * 2] *= r0; acc[ai][bj][m][q >> 1][(q & 1) * 2 + 1] *= r1; } }
                if (m == 3) asm volatile("" ::: "memory"); }
    }
    __device__ __forceinline__ void operator()(const f32x4 (&acc)[2][2][4][2], const pg8::Unit& u, int wr, int wc, int fr, int fq) const {
        const int row0 = u.pm * 256 + wr * 64 + fr, col0 = u.pn * 256 + wc * 64 + 8 * fq; const bool lo = fr < 8;
        bf16* const pst = MG + (size_t)(u.pm * 256 + wr * 64 + (fr & 7)) * 1024 + u.pn * 256 + wc * 64 + (fr >> 3) * 32 + 8 * fq;
#pragma unroll
        for (int ai = 0; ai < 2; ++ai)
#pragma unroll
            for (int m = 0; m < 4; ++m) { const size_t row = (size_t)(row0 + ai * 128 + m * 16); v4u w[2];
#pragma unroll
                for (int bj = 0; bj < 2; ++bj) { const f32x4 v0 = acc[ai][bj][m][0], v1 = acc[ai][bj][m][1];
                    const v4u g = *(const v4u*)(Gt + row * 2048 + 1024 + col0 + bj * 32);
                    w[bj].x = pk2(v0[0] * fmaxf(bflo(g.x), 1e-20f), v0[1] * fmaxf(bfhi(g.x), 1e-20f)); w[bj].y = pk2(v0[2] * fmaxf(bflo(g.y), 1e-20f), v0[3] * fmaxf(bfhi(g.y), 1e-20f));
                    w[bj].z = pk2(v1[0] * fmaxf(bflo(g.z), 1e-20f), v1[1] * fmaxf(bfhi(g.z), 1e-20f)); w[bj].w = pk2(v1[2] * fmaxf(bflo(g.w), 1e-20f), v1[3] * fmaxf(bfhi(g.w), 1e-20f)); }
                fl_put<false>(pst + (size_t)(ai * 128 + m * 16) * 1024, 1024, lo, w[0], w[1]); }
    }
};
template <bool XF32> struct EpiOut {
    static constexpr int MID_T = 0; static constexpr bool PERM = true, AFTER_DRAIN = false, BADJ = true, ABLK = false;
    const void* xres; const float* modl  ; bf16* YPRE;
    __device__ __forceinline__ void operator()(const f32x4 (&acc)[2][2][4][2], const pg8::Unit& u, int wr, int wc, int fr, int fq) const {
        const int row0 = u.pm * 256 + wr * 64 + fr, col0 = u.pn * 256 + wc * 64 + 8 * fq; const int b = (u.pm * 256) >> 12; const bool lo = fr < 8;
        bf16* const pst = YPRE + (size_t)(u.pm * 256 + wr * 64 + (fr & 7)) * 1024 + u.pn * 256 + wc * 64 + (fr >> 3) * 32 + 8 * fq;
        f32x4 gg[2][2];
#pragma unroll
        for (int bj = 0; bj < 2; ++bj)
#pragma unroll
            for (int n = 0; n < 2; ++n) gg[bj][n] = *(const f32x4*)(modl + (size_t)b * 6144 + 2048 + col0 + bj * 32 + 4 * n) + 1.0f;
#pragma unroll
        for (int ai = 0; ai < 2; ++ai)
#pragma unroll
            for (int m = 0; m < 4; ++m) { const size_t off = (size_t)(row0 + ai * 128 + m * 16) * 1024 + col0; v4u w[2];
#pragma unroll
                for (int bj = 0; bj < 2; ++bj) { f32x4 x0, x1;
                    if (XF32) { x0 = *(const f32x4*)((const float*)xres + off + bj * 32); x1 = *(const f32x4*)((const float*)xres + off + bj * 32 + 4); }
                    else { const v4u xr = *(const v4u*)((const bf16*)xres + off + bj * 32); x0 = (f32x4){bflo(xr.x), bfhi(xr.x), bflo(xr.y), bfhi(xr.y)}; x1 = (f32x4){bflo(xr.z), bfhi(xr.z), bflo(xr.w), bfhi(xr.w)}; }
                    const f32x4 o0 = x0 * DN_ALPHA + gg[bj][0] * acc[ai][bj][m][0], o1 = x1 * DN_ALPHA + gg[bj][1] * acc[ai][bj][m][1];
                    w[bj].x = pk2(o0[0], o0[1]); w[bj].y = pk2(o0[2], o0[3]); w[bj].z = pk2(o1[0], o1[1]); w[bj].w = pk2(o1[2], o1[3]); }
                fl_put<false>(pst + (size_t)(ai * 128 + m * 16) * 1024, 1024, lo, w[0], w[1]);
                if (m == 3) asm volatile("" ::: "memory"); }
    }
};
#ifndef ACT_NT
#define ACT_NT 1
#endif
struct EpiUp {
    static constexpr int MID_T = 0; static constexpr bool PERM = true, AFTER_DRAIN = false, BADJ = false, ABLK = false;
    const float* bup  ; bf16* ACT;
    __device__ __forceinline__ void operator()(const f32x4 (&acc)[2][2][4][2], const pg8::Unit& u, int wr, int wc, int fr, int fq) const {
        const int e = u.pn >> 3, pnl = u.pn & 7; const int row0 = u.pm * 256 + wr * 64 + fr, ac0 = pnl * 128 + wc * 32 + 8 * fq;
        const f32x4* bp = (const f32x4*)(bup + (size_t)e * 2048 + 2 * ac0); const f32x4 b0 = bp[0], b1 = bp[1], b2 = bp[2], b3 = bp[3];
        const float bg[8] = {b0[0], b0[2], b1[0], b1[2], b2[0], b2[2], b3[0], b3[2]}, bl[8] = {b0[1], b0[3], b1[1], b1[3], b2[1], b2[3], b3[1], b3[3]};
#pragma unroll
        for (int ai = 0; ai < 2; ++ai)
#pragma unroll
            for (int m = 0; m < 4; ++m) { float a[8];
#pragma unroll
                for (int j = 0; j < 8; ++j) { const float hg = acc[ai][0][m][j >> 2][j & 3] + bg[j], hl = acc[ai][1][m][j >> 2][j & 3] + bl[j];
                    const float glu = fminf(hg, 7.0f), lin = fminf(fmaxf(hl, -7.0f), 7.0f);
                    a[j] = glu * frcp(1.0f + fexp2(-2.4554669595930156f * glu)) * (lin + 1.0f); }
                v4u w; w.x = pk2(a[0], a[1]); w.y = pk2(a[2], a[3]); w.z = pk2(a[4], a[5]); w.w = pk2(a[6], a[7]);
                { const size_t g16 = (size_t)((u.pm * 256 + wr * 64 + ai * 128 + m * 16) >> 4); unsigned char* lp = (unsigned char*)ACT + ((g16 * 32 + (size_t)(pnl * 4 + wc)) * 8 + (fr & 7)) * 128 + (fr >> 3) * 64 + 16 * fq;
                  if (ACT_NT) __builtin_nontemporal_store(w, (v4u*)lp); else *(v4u*)lp = w; } }
    }
};
struct EpiDn {
    static constexpr int MID_T = 0; static constexpr bool PERM = true, AFTER_DRAIN = false, BADJ = true, ABLK = true;
    const float* bdn  ; bf16* YKS;
    __device__ __forceinline__ void operator()(const f32x4 (&acc)[2][2][4][2], const pg8::Unit& u, int wr, int wc, int fr, int fq) const {
        const int e = u.pn >> 2, pnl = u.pn & 3; const int col0 = pnl * 256 + wc * 64 + 8 * fq; const bool lo = fr < 8;
        bf16* const pst = YKS + (size_t)(u.pm * 256 + wr * 64 + (fr & 7)) * 1024 + pnl * 256 + wc * 64 + (fr >> 3) * 32 + 8 * fq;
        f32x4 bv[2][2];
#pragma unroll
        for (int bj = 0; bj < 2; ++bj)
#pragma unroll
            for (int n = 0; n < 2; ++n) bv[bj][n] = *(const f32x4*)(bdn + (size_t)e * 1024 + col0 + bj * 32 + 4 * n);
#pragma unroll
        for (int ai = 0; ai < 2; ++ai)
#pragma unroll
            for (int m = 0; m < 4; ++m) { v4u w[2];
#pragma unroll
                for (int bj = 0; bj < 2; ++bj) { const f32x4 v0 = acc[ai][bj][m][0] + bv[bj][0], v1 = acc[ai][bj][m][1] + bv[bj][1];
                    w[bj].x = pk2(v0[0], v0[1]); w[bj].y = pk2(v0[2], v0[3]); w[bj].z = pk2(v1[0], v1[1]); w[bj].w = pk2(v1[2], v1[3]); }
                fl_put<FLNT>(pst + (size_t)(ai * 128 + m * 16) * 1024, 1024, lo, w[0], w[1]); }
    }
};
struct MoeOrder {
    static constexpr bool GATHER = false; __device__ __forceinline__ int arow(int, int r) const { return r; }
    int nM, nN, nwg, G, c, rev; const LAS unsigned char* tile_e;
    __device__ void init(int RT, int NN, int G_, int c_, const LAS unsigned char* te, int rev_ = 0) { nM = RT; nN = NN; nwg = RT * NN; G = G_; c = c_; tile_e = te; rev = rev_; }
    __device__ bool next(int i, pg8::Unit& u) const {
        const long L = (long)i * G + c; if (L >= nwg) return false;
        int wgid = (int)L; { const int q = nwg / pg8::NXCD, r = nwg % pg8::NXCD, xcd = wgid % pg8::NXCD, off = wgid / pg8::NXCD; wgid = (xcd < r ? xcd * (q + 1) : r * (q + 1) + (xcd - r) * q) + off; }
        const int nig = pg8::WGM * nN, gid = wgid / nig, fm = gid * pg8::WGM, gsz = (nM - fm) < pg8::WGM ? (nM - fm) : pg8::WGM;
        int pm = fm + ((wgid % nig) % gsz); const int pnl = (wgid % nig) / gsz; if (rev) pm = nM - 1 - pm;
        u.pm = pm; u.pn = (int)tile_e[pm] * nN + pnl; return true;
    }
    __device__ __forceinline__ void a_ready(const pg8::Unit&) const {}
    __device__ __forceinline__ void done(const pg8::Unit&) const {}
};

#ifndef STAG_N
#define STAG_N 1
#endif
#ifndef STAG_US
#define STAG_US 24
#endif
__device__ __forceinline__ void stagger(int slot, int us) {
    if (STAG_N <= 1) return;
    const unsigned long long t0 = __builtin_amdgcn_s_memrealtime(); const unsigned long long ticks = (unsigned long long)(slot % STAG_N) * (unsigned)us * 100ull / STAG_N;
    while (__builtin_amdgcn_s_memrealtime() - t0 < ticks) __builtin_amdgcn_s_sleep(16);
}
struct MoeGatherOrder : MoeOrder {
    static constexpr bool GATHER = true; const LAS unsigned short* tokl;
    __device__ __forceinline__ int arow(int ord, int r) const { return (int)tokl[ord * 256 + (r & 255)]; }
};
constexpr int X_TOKL = XOFF + 6144, TOKL_UNITS = 20;
constexpr int TR_NR = 32, TR_WAVE_BYTES = 64 * 64 * 4;
struct TrItem { const float* src; bf16* dst; int ld, K, kind, k0, c0, koff; };
__device__ __forceinline__ void tr_load(const TrItem& t, int lane, f32x4 (&r)[TR_NR]) {
    const int kq = lane >> 4, cc = lane & 15;
#pragma unroll
    for (int i = 0; i < TR_NR; ++i) r[i] = __builtin_nontemporal_load((const f32x4*)(t.src + (size_t)(t.k0 + 2 * (kq + 4 * (i >> 1)) + (i & 1)) * t.ld + t.c0 + 4 * cc));
}
__device__ __forceinline__ void tr_tile(int lane, LAS unsigned* scr, const f32x4 (&r)[TR_NR]) {
    const int kq = lane >> 4, cc = lane & 15;
#pragma unroll
    for (int i2 = 0; i2 < TR_NR / 2; ++i2) { LAS unsigned* p = scr + (4 * cc) * 64 + ((kq + 4 * i2) ^ (cc << 2));
#pragma unroll
        for (int e = 0; e < 4; ++e) p[e * 64] = pk2(r[2 * i2][e], r[2 * i2 + 1][e]); }
    LDS_WAIT(); asm volatile("" ::: "memory");
}
__device__ __forceinline__ void tr_store(const TrItem& t, int lane, const LAS unsigned* scr) {
    const int line = lane >> 3, half = (lane >> 2) & 1, piece = lane & 3;
    const int pbase = (t.kind == 0) ? t.c0 : (256 * (t.c0 >> 8) + ((t.c0 & 255) >> 1));
    const int kb0 = (t.koff + t.k0) >> 5, KB = t.K >> 5;
#pragma unroll
    for (int j = 0; j < 16; ++j) { const int q = 16 * (j >> 2) + line + 8 * half, cb = j & 3, c = 4 * cb + piece;
        const int n = (t.kind == 0) ? q : (2 * (q & 31) + (q >> 5)); const int drow = (t.kind == 0) ? (pbase + q) : (pbase + 128 * (q >> 5) + (q & 31));
        const v4u o = *(const LAS v4u*)(scr + n * 64 + ((c ^ ((n >> 2) & 15)) << 2));
        unsigned char* dp = (unsigned char*)t.dst + ((size_t)((drow >> 4) * KB + kb0 + cb) * 8 + (drow & 7)) * 128 + ((drow >> 3) & 1) * 64 + piece * 16;
        __builtin_nontemporal_store(o, (v4u*)dp); }
    LDS_WAIT(); asm volatile("" ::: "memory");
}
__device__ __forceinline__ void sincos_d(double a, double& s, double& c) {
    const double k = rint(a * 0.63661977236758134308);
    const double y = fma(-k, 6.12323399573676603587e-17, fma(-k, 1.57079632679489655800, a));
    const double y2 = y * y;
    double sp = -7.6471637318198164759e-13; sp = fma(sp, y2, 1.6059043836821614599e-10); sp = fma(sp, y2, -2.5052108385441718775e-8); sp = fma(sp, y2, 2.7557319223985890653e-6);
    sp = fma(sp, y2, -1.9841269841269841270e-4); sp = fma(sp, y2, 8.3333333333333333333e-3); sp = fma(sp, y2, -1.6666666666666666667e-1); const double sy = fma(sp * y2, y, y);
    double cp = 4.7794773323873852974e-14; cp = fma(cp, y2, -1.1470745597729724714e-11); cp = fma(cp, y2, 2.0876756987868098979e-9); cp = fma(cp, y2, -2.7557319223985890653e-7);
    cp = fma(cp, y2, 2.4801587301587301587e-5); cp = fma(cp, y2, -1.3888888888888888889e-3); cp = fma(cp, y2, 4.1666666666666666667e-2); cp = fma(cp, y2, -0.5); const double cy = fma(cp, y2, 1.0);
    const int q = ((int)k) & 3;
    s = (q == 0) ? sy : (q == 1) ? cy : (q == 2) ? -sy : -cy;
    c = (q == 0) ? cy : (q == 1) ? -sy : (q == 2) ? -cy : sy;
}
__device__ __forceinline__ void phase_pro_a(Frame& F) {
    LAS unsigned* scr = (LAS unsigned*)(F.lds + F.wave * TR_WAVE_BYTES);
    const int gw = F.vcu * 8 + F.wave, NGW = F.G * 8;
    constexpr int I_IN = 8 * 136, I_SQ = 8 * 16, I_BB = 4 * 16, I_UP = 8 * 32;
    constexpr int S0 = NL * I_IN, S1 = S0 + NL * I_SQ, S2 = S1 + NL * I_BB, S3 = S2 + NL * I_SQ, S4 = S3 + NL * NE * I_SQ, S5 = S4 + NL * NE * I_UP;
    auto decode = [&](int it) -> TrItem { TrItem t; t.koff = 0;
        if (it < S0) { const int l = it / I_IN, r = it % I_IN; t.src = F.in[I_WIN] + (size_t)l * D * NIN; t.dst = wsp<bf16>(F, WS_WIN) + (size_t)l * NIN * D; t.ld = NIN; t.K = D; t.kind = 0; t.k0 = 128 * (r / 136); t.c0 = 64 * (r % 136); }
        else if (it < S1) { const int q = it - S0, l = q / I_SQ, r = q % I_SQ; t.src = F.in[I_WBA] + (size_t)l * D * D; t.dst = wsp<bf16>(F, WS_WBA) + (size_t)l * D * 1536; t.ld = D; t.K = 1536; t.kind = 0; t.k0 = 128 * (r / 16); t.c0 = 64 * (r % 16); }
        else if (it < S2) { const int q = it - S1, l = q / I_BB, r = q % I_BB; t.src = F.in[I_WBB] + (size_t)l * 512 * D; t.dst = wsp<bf16>(F, WS_WBA) + (size_t)l * D * 1536; t.ld = D; t.K = 1536; t.koff = 1024; t.kind = 0; t.k0 = 128 * (r / 16); t.c0 = 64 * (r % 16); }
        else if (it < S3) { const int q = it - S2, l = q / I_SQ, r = q % I_SQ; t.src = F.in[I_WOUT] + (size_t)l * D * D; t.dst = wsp<bf16>(F, WS_WOUT) + (size_t)l * D * D; t.ld = D; t.K = D; t.kind = 0; t.k0 = 128 * (r / 16); t.c0 = 64 * (r % 16); }
        else if (it < S4) { const int q = it - S3, le = q / I_SQ, r = q % I_SQ; t.src = F.in[I_WDN] + (size_t)le * FF * D; t.dst = wsp<bf16>(F, WS_WDN) + (size_t)le * D * FF; t.ld = D; t.K = FF; t.kind = 0; t.k0 = 128 * (r / 16); t.c0 = 64 * (r % 16); }
        else { const int q = it - S4, le = q / I_UP, r = q % I_UP; t.src = F.in[I_WUP] + (size_t)le * D * 2048; t.dst = wsp<bf16>(F, WS_WUP) + (size_t)le * 2048 * D; t.ld = 2048; t.K = D; t.kind = 1; t.k0 = 128 * (r / 32); t.c0 = 64 * (r % 32); }
        return t; };
    {
        f32x4 rn[TR_NR]; TrItem tn; int it = gw;
        if (it < S5) { tn = decode(it); tr_load(tn, F.lane, rn); }
#pragma unroll 1
        for (; it < S5; it += NGW) {
            const TrItem tc = tn;
            tr_tile(F.lane, scr, rn);
            if (it + NGW < S5) { tn = decode(it + NGW); tr_load(tn, F.lane, rn); }
            tr_store(tc, F.lane, scr);
        }
    }
    __syncthreads();
    {
        LAS float* cT = (LAS float*)F.lds;
        LAS float* red = (LAS float*)(F.lds + 32768);
        const float* cv = F.in[I_C];
        for (int i = F.tid; i < 8 * 1024; i += 512) { const int bb = i >> 10, k = i & 1023; cT[k * 8 + bb] = cv[i]; }
        __syncthreads();
        const int hf = F.lane >> 5, c4 = F.lane & 31;
        for (int u = F.vcu; u < NL * 48; u += F.G) {
            const int l = u / 48, n0 = 128 * (u % 48);
            f32x4 a[8];
#pragma unroll
            for (int bb = 0; bb < 8; ++bb) a[bb] = (f32x4){0.f, 0.f, 0.f, 0.f};
            const int kb = F.wave * 128 + hf;
            const float* wp = F.in[I_WADA] + (size_t)l * D * 6144 + (size_t)kb * 6144 + n0 + 4 * c4;
#pragma unroll 8
            for (int kk = 0; kk < 64; ++kk) { const f32x4 w = *(const f32x4*)(wp + (size_t)(2 * kk) * 6144);
                const f32x4 c0 = *(const LAS f32x4*)(cT + (kb + 2 * kk) * 8), c1 = *(const LAS f32x4*)(cT + (kb + 2 * kk) * 8 + 4);
#pragma unroll
                for (int bb = 0; bb < 4; ++bb) { a[bb] += w * c0[bb]; a[4 + bb] += w * c1[bb]; } }
#pragma unroll
            for (int bb = 0; bb < 8; ++bb) *(LAS f32x4*)(red + ((F.wave * 2 + hf) * 8 + bb) * 128 + 4 * c4) = a[bb];
            __syncthreads();
#pragma unroll
            for (int q = 0; q < 2; ++q) { const int o = F.tid + 512 * q, bb = o >> 7, cn = o & 127; float sum = F.in[I_BADA][l * 6144 + n0 + cn];
#pragma unroll
                for (int p = 0; p < 16; ++p) sum += red[(p * 8 + bb) * 128 + cn];
                wsp<float>(F, WS_MOD)[(size_t)(l * 8 + bb) * 6144 + n0 + cn] = sum; }
            __syncthreads();
        }
    }
    const int gt = F.vcu * 512 + F.tid, NT = F.G * 512;
    for (int i = gt; i < SEQ * 8; i += NT) { const int pos = i >> 3, f = i & 7;
        const double inv = (f == 0) ? 1.0 : (f == 1) ? 0.19392274474868576 : (f == 2) ? 0.03760603093086393 : (f == 3) ? 0.007292664737217109 : (f == 4) ? 0.001414213562373095 : (f == 5) ? 0.0002742481756762073 : (f == 6) ? 5.318295896944988e-05 : 1.031338537721246e-05;
        double s, c; sincos_d((double)pos * inv, s, c);
        float* rp = wsp<float>(F, WS_ROPE) + (size_t)pos * 16; rp[f] = (float)c; rp[8 + f] = (float)s; }
    for (int i = gt; i < NL * 4 * 128 * 128; i += NT) { const int j = i & 127, ii = (i >> 7) & 127; const float w = F.in[I_SPW][i];
        wsp<bf16>(F, WS_WSP)[i] = (bf16)(pk2((j <= ii) ? w : 0.f, 0.f) & 0xffffu); }
    for (int i = gt; i < NL * NE * D; i += NT) { const int k = i & 1023, e = (i >> 10) & 31, l = i >> 15; const float w = F.in[I_WR][((size_t)l * D + k) * NE + e];
        const unsigned hi = pk2(w, 0.f) & 0xffffu; const float lo = w - __uint_as_float(hi << 16);
        wsp<bf16>(F, WS_WRT)[i] = (bf16)hi; wsp<bf16>(F, WS_WRT)[NL * NE * D + i] = (bf16)(pk2(lo, 0.f) & 0xffffu); }
}
__device__ __forceinline__ void phase_pro_b(Frame& F) {
    const int gw = F.vcu * 8 + F.wave, NGW = F.G * 8;
    const float* mod = wsp<float>(F, WS_MOD);
    for (int m = gw; m < T; m += NGW) { const int b = m >> 12; const float* mb = mod + (size_t)b * 6144;
        const f32x4* xr = (const f32x4*)(F.in[I_X] + (size_t)m * D) + F.lane; v2u* hp = (v2u*)(wsp<bf16>(F, WS_H) + (size_t)m * D) + F.lane;
#pragma unroll
        for (int j = 0; j < 4; ++j) { const f32x4 x = xr[64 * j]; const f32x4 sh = *((const f32x4*)mb + F.lane + 64 * j), sc = *((const f32x4*)(mb + 1024) + F.lane + 64 * j);
            const f32x4 h = x * (sc + 1.0f) + sh; v2u o; o.x = pk2(h[0], h[1]); o.y = pk2(h[2], h[3]); hp[64 * j] = o; } }
}

constexpr int AT_RS = 144;
constexpr int AT_ROWS = 400, AT_VOFF = AT_ROWS * AT_RS;
#define LDS_BARRIER() do { asm volatile("s_waitcnt lgkmcnt(0)" ::: "memory"); __builtin_amdgcn_s_barrier(); asm volatile("" ::: "memory"); } while (0)
struct AtUnit { int g, b, h, r, n, d; size_t hoff; };
__device__ __forceinline__ AtUnit at_decode(int u) { AtUnit a; a.g = u >> 10; const int rem = u & 1023; a.b = rem >> 7; a.h = (rem >> 4) & 7; const int rn = rem & 15;
    const int dsh = 2 * a.g, nbs = 4 - dsh; a.d = 1 << dsh; a.r = rn >> nbs; a.n = 2 * (rn & ((1 << nbs) - 1)); a.hoff = (size_t)a.g * 512 + a.h * 64; return a; }
constexpr int AT_NU = 3 * 1024;
struct AtSlot { v4u k[6], v[6]; bf16x8 q0, q1, q2, q3; };
struct AtCtx { const bf16 *Qb, *Kb, *Vb; bf16* OG; float* LSE; LAS unsigned char *Ks, *Vs; int qi, g4, piece, jr; };
__device__ __forceinline__ void at_load(AtSlot& sl, int uu, const AtCtx& C, const Frame& F) {
    const AtUnit a_ = at_decode(uu);
#pragma unroll
    for (int ps = 0; ps < 6; ++ps) { const int lp = 128 * (a_.n - 1) + ps * 64 + C.jr; sl.k[ps] = (v4u){0u, 0u, 0u, 0u}; sl.v[ps] = sl.k[ps];
        if (lp >= 0) { const size_t off = ((size_t)a_.b * SEQ + (size_t)lp * a_.d + a_.r) * 1536 + a_.hoff + C.piece * 8; sl.k[ps] = *(const v4u*)(C.Kb + off); sl.v[ps] = *(const v4u*)(C.Vb + off); } }
    const size_t qrow_ = (size_t)a_.b * SEQ + (size_t)(128 * a_.n + 16 * F.wave + C.qi) * a_.d + a_.r; const bf16* qp = C.Qb + qrow_ * 1536 + a_.hoff + 8 * C.g4;
    sl.q0 = *(const bf16x8*)qp; sl.q1 = *(const bf16x8*)(qp + 32);
    const bf16* qp2 = qp + (size_t)128 * a_.d * 1536; sl.q2 = *(const bf16x8*)qp2; sl.q3 = *(const bf16x8*)(qp2 + 32);
}
__device__ __forceinline__ void at_unit(AtSlot& sl, int u, int unext, const AtCtx& C, const Frame& F) {
    bf16* OG = C.OG; float* LSE = C.LSE; LAS unsigned char* Ks = C.Ks; LAS unsigned char* Vs = C.Vs; const int qi = C.qi, g4 = C.g4;
    const AtUnit au = at_decode(u); const int g = au.g, b = au.b, h = au.h, r = au.r, n = au.n, d = au.d;
#pragma unroll
    for (int ps = 0; ps < 6; ++ps) { const int j = ps * 64 + C.jr; *(LAS v4u*)(Ks + j * AT_RS + C.piece * 16) = sl.k[ps]; *(LAS v4u*)(Vs + j * AT_RS + C.piece * 16) = sl.v[ps]; }
    const bf16x8 sl_q0 = sl.q0, sl_q1 = sl.q1, sl_q2 = sl.q2, sl_q3 = sl.q3;
    LDS_BARRIER();
    if (unext < AT_NU) at_load(sl, unext, C, F);
#pragma unroll
    for (int tq = 0; tq < 2; ++tq)
        {
            const int iq = 128 * tq + 16 * F.wave + qi; const int rb = 128 * tq + 16 * F.wave; const bf16x8 qf0 = tq ? sl_q2 : sl_q0, qf1 = tq ? sl_q3 : sl_q1; const size_t qrow = (size_t)b * SEQ + (size_t)(128 * n + iq) * d + r;
            f32x4 s[10]; float mx = -1e30f; const int dq = qi - 4 * g4; const bool first = (n == 0) && (tq == 0);
#pragma unroll
            for (int st = 0; st < 9; ++st) {
                const LAS unsigned char* kp = Ks + (rb + 16 * st + qi) * AT_RS + g4 * 16;
                const bf16x8 k0 = *(const LAS bf16x8*)kp, k1 = *(const LAS bf16x8*)(kp + 64);
                f32x4 a = (f32x4){0.f, 0.f, 0.f, 0.f};
                a = mfma16(k0, qf0, a); a = mfma16(k1, qf1, a);
                if (st == 0) {
#pragma unroll
                    for (int i = 0; i < 4; ++i) a[i] = (i >= dq) ? a[i] : -1e30f; }
                if (st == 8) {
#pragma unroll
                    for (int i = 0; i < 4; ++i) a[i] = (i <= dq) ? a[i] : -1e30f; }
                if (first) {
#pragma unroll
                    for (int i = 0; i < 4; ++i) a[i] = (rb + 16 * st + 4 * g4 + i >= 128) ? a[i] : -1e30f; }
#pragma unroll
                for (int i = 0; i < 4; ++i) mx = fmaxf(mx, a[i]);
                s[st] = a;
            }
            mx = fmaxf(mx, __shfl_xor(mx, 16)); mx = fmaxf(mx, __shfl_xor(mx, 32));
            float sum = 0.f;
#pragma unroll
            for (int st = 0; st < 9; ++st)
#pragma unroll
                for (int i = 0; i < 4; ++i) { const float p = fexp2(s[st][i] - mx); s[st][i] = p; sum += p; }
            s[9] = (f32x4){0.f, 0.f, 0.f, 0.f};
            sum += __shfl_xor(sum, 16); sum += __shfl_xor(sum, 32);
            f32x4 o[4];
#pragma unroll
            for (int dt = 0; dt < 4; ++dt) o[dt] = (f32x4){0.f, 0.f, 0.f, 0.f};
#pragma unroll
            for (int c = 0; c < 5; ++c) {
                v4u pw; pw.x = pk2(s[2 * c][0], s[2 * c][1]); pw.y = pk2(s[2 * c][2], s[2 * c][3]); pw.z = pk2(s[2 * c + 1][0], s[2 * c + 1][1]); pw.w = pk2(s[2 * c + 1][2], s[2 * c + 1][3]);
                const bf16x8 pf = __builtin_bit_cast(bf16x8, pw);
                const LAS unsigned char* vp = Vs + (rb + 32 * c + 4 * g4 + (qi >> 2)) * AT_RS + 8 * (qi & 3);
#pragma unroll
                for (int dt = 0; dt < 4; ++dt) { const s16x4 lo = tr16(vp + 32 * dt), hi = tr16(vp + 32 * dt + 16 * AT_RS);
                    o[dt] = mfma16(cat8(lo, hi), pf, o[dt]); }
            }
            const float inv = 1.0f / sum;
            bf16* op = OG + ((size_t)g * T + qrow) * 512 + h * 64 + 4 * g4;
#pragma unroll
            for (int dt = 0; dt < 4; ++dt) { v2u w; w.x = pk2(o[dt][0] * inv, o[dt][1] * inv); w.y = pk2(o[dt][2] * inv, o[dt][3] * inv); *(v2u*)(op + 16 * dt) = w; }
            if (g4 == 0) LSE[((size_t)g * T + qrow) * 8 + h] = mx + __log2f(sum);
        }
    LDS_BARRIER();
}
__device__ __forceinline__ void phase_attn(Frame& F) {
    AtCtx C; C.Qb = wsp<bf16>(F, WS_Q); C.Kb = wsp<bf16>(F, WS_K); C.Vb = wsp<bf16>(F, WS_VV); C.OG = wsp<bf16>(F, WS_OG); C.LSE = wsp<float>(F, WS_LSE);
    C.Ks = F.lds; C.Vs = F.lds + AT_VOFF; C.qi = F.lane & 15; C.g4 = F.lane >> 4; C.piece = F.tid & 7; C.jr = F.tid >> 3;
    if (F.tid < 144) { *(LAS v4u*)(C.Ks + 384 * AT_RS + F.tid * 16) = (v4u){0u, 0u, 0u, 0u}; *(LAS v4u*)(C.Vs + 384 * AT_RS + F.tid * 16) = (v4u){0u, 0u, 0u, 0u}; }
    AtSlot sa; const int u0 = F.vcu, G = F.G;
    if (u0 < AT_NU) at_load(sa, u0, C, F);
#pragma unroll 1
    for (int u = u0; u < AT_NU; u += G) at_unit(sa, u, u + G, C, F);
}

constexpr int SG_WOFF = 69632, SG_WRS = 264;
constexpr int SG_RS = 528;
__device__ __forceinline__ void phase_sg(Frame& F, int l) {
    const bf16* Ub = wsp<bf16>(F, WS_U); const bf16* Vb = wsp<bf16>(F, WS_V); bf16* TT = wsp<bf16>(F, WS_TT);
    const bf16* OG = wsp<bf16>(F, WS_OG); const float* LSE = wsp<float>(F, WS_LSE); bf16* OB = wsp<bf16>(F, WS_OB);
    const bf16* Wsp = wsp<bf16>(F, WS_WSP); const float* spb = F.in[I_SPB];
    LAS unsigned char* Vn = F.lds;
    const int qi = F.lane & 15, g4 = F.lane >> 4;
    const int l32 = F.lane & 31;
    v4u vraw[8];
#define SG_LOAD(uu) do { const int gi_ = (uu) & 3, m0_ = ((uu) >> 2) * 128; \
        _Pragma("unroll") for (int ps = 0; ps < 8; ++ps) vraw[ps] = *(const v4u*)(Vb + (size_t)(m0_ + 16 * ps + 2 * F.wave + (F.lane >> 5)) * 1024 + gi_ * 256 + 8 * l32); } while (0)
    if (F.vcu < 1024) SG_LOAD(F.vcu);
    const bool wlds = (F.G & 3) == 0; LAS unsigned char* Wl = F.lds + SG_WOFF;
    if (wlds) { const bf16* wsrc = Wsp + (size_t)(l * 4 + (F.vcu & 3)) * 128 * 128;
        for (int i = F.tid; i < 128 * 16; i += 512) { const int row = i >> 4, ch = i & 15; const v4u wv = *(const v4u*)(wsrc + row * 128 + ch * 8);
            *(LAS v2u*)(Wl + row * SG_WRS + ch * 16) = (v2u){wv.x, wv.y}; *(LAS v2u*)(Wl + row * SG_WRS + ch * 16 + 8) = (v2u){wv.z, wv.w}; } }
    for (int u = F.vcu; u < 1024; u += F.G) {
        const int gi = u & 3, m0 = (u >> 2) * 128;
        float ml[4][3]; v4u mo[4][3]; const int sub = F.tid & 7;
#pragma unroll
        for (int ps = 0; ps < 4; ++ps) { const int p = (F.tid >> 3) + 64 * ps; const size_t tok = (size_t)m0 + (p >> 1); const int hd = 2 * gi + (p & 1); const size_t off = tok * 512 + hd * 64 + 8 * sub;
#pragma unroll
            for (int gq = 0; gq < 3; ++gq) { ml[ps][gq] = LSE[((size_t)gq * T + tok) * 8 + hd]; mo[ps][gq] = *(const v4u*)(OG + (size_t)gq * T * 512 + off); } }
        {
            float sm[8], mean[8], rs[8];
#pragma unroll
            for (int ps = 0; ps < 8; ++ps) { const v4u raw = vraw[ps]; sm[ps] = ((bflo(raw.x) + bfhi(raw.x)) + (bflo(raw.y) + bfhi(raw.y))) + ((bflo(raw.z) + bfhi(raw.z)) + (bflo(raw.w) + bfhi(raw.w))); }
#pragma unroll
            for (int o = 1; o < 32; o <<= 1) {
#pragma unroll
                for (int ps = 0; ps < 8; ++ps) sm[ps] += __shfl_xor(sm[ps], o); }
#pragma unroll
            for (int ps = 0; ps < 8; ++ps) { const v4u raw = vraw[ps]; mean[ps] = sm[ps] * (1.0f / 256.0f); float q = 0.f;
                const float x[8] = {bflo(raw.x), bfhi(raw.x), bflo(raw.y), bfhi(raw.y), bflo(raw.z), bfhi(raw.z), bflo(raw.w), bfhi(raw.w)};
#pragma unroll
                for (int e = 0; e < 8; ++e) { const float dx = x[e] - mean[ps]; q += dx * dx; }
                sm[ps] = q; }
#pragma unroll
            for (int o = 1; o < 32; o <<= 1) {
#pragma unroll
                for (int ps = 0; ps < 8; ++ps) sm[ps] += __shfl_xor(sm[ps], o); }
#pragma unroll
            for (int ps = 0; ps < 8; ++ps) { rs[ps] = 1.0f / sqrtf(sm[ps] * (1.0f / 256.0f) + LN_EPS); const v4u raw = vraw[ps]; const int j = 16 * ps + 2 * F.wave + (F.lane >> 5);
                const float x[8] = {bflo(raw.x), bfhi(raw.x), bflo(raw.y), bfhi(raw.y), bflo(raw.z), bfhi(raw.z), bflo(raw.w), bfhi(raw.w)};
                v4u w; w.x = pk2((x[0] - mean[ps]) * rs[ps], (x[1] - mean[ps]) * rs[ps]); w.y = pk2((x[2] - mean[ps]) * rs[ps], (x[3] - mean[ps]) * rs[ps]);
                w.z = pk2((x[4] - mean[ps]) * rs[ps], (x[5] - mean[ps]) * rs[ps]); w.w = pk2((x[6] - mean[ps]) * rs[ps], (x[7] - mean[ps]) * rs[ps]);
                *(LAS v4u*)(Vn + j * SG_RS + l32 * 16) = w; }
        }
        LDS_BARRIER();
        if (u + F.G < 1024) SG_LOAD(u + F.G);
        {
#pragma unroll
          for (int ps = 0; ps < 4; ++ps) { const int p = (F.tid >> 3) + 64 * ps; const size_t tok = (size_t)m0 + (p >> 1); const int hd = 2 * gi + (p & 1);
              const float l0 = ml[ps][0], l1 = ml[ps][1], l2 = ml[ps][2];
              const float mxx = fmaxf(l0, fmaxf(l1, l2)); float w0 = fexp2(l0 - mxx), w1 = fexp2(l1 - mxx), w2 = fexp2(l2 - mxx); const float inv = 1.0f / (w0 + w1 + w2); w0 *= inv; w1 *= inv; w2 *= inv;
              const size_t off = tok * 512 + hd * 64 + 8 * sub;
              const v4u a = mo[ps][0], bq = mo[ps][1], cq = mo[ps][2]; v4u w;
              w.x = pk2(w0 * bflo(a.x) + w1 * bflo(bq.x) + w2 * bflo(cq.x), w0 * bfhi(a.x) + w1 * bfhi(bq.x) + w2 * bfhi(cq.x));
              w.y = pk2(w0 * bflo(a.y) + w1 * bflo(bq.y) + w2 * bflo(cq.y), w0 * bfhi(a.y) + w1 * bfhi(bq.y) + w2 * bfhi(cq.y));
              w.z = pk2(w0 * bflo(a.z) + w1 * bflo(bq.z) + w2 * bflo(cq.z), w0 * bfhi(a.z) + w1 * bfhi(bq.z) + w2 * bfhi(cq.z));
              w.w = pk2(w0 * bflo(a.w) + w1 * bflo(bq.w) + w2 * bflo(cq.w), w0 * bfhi(a.w) + w1 * bfhi(bq.w) + w2 * bfhi(cq.w));
              *(v4u*)(TT + tok * 1536 + 1024 + hd * 64 + 8 * sub) = w; } }
        v2u uq[8][2]; float ubias[8];
#pragma unroll
        for (int it = 0; it < 8; ++it) { const int i = 16 * it + qi; ubias[it] = spb[(l * 4 + gi) * 128 + i]; const size_t rowo = (size_t)(m0 + i) * 1024 + gi * 256 + 32 * F.wave + 4 * g4;
            uq[it][0] = *(const v2u*)(Ub + rowo); uq[it][1] = *(const v2u*)(Ub + rowo + 16); }
        {
            f32x4 acc[2][8];
#pragma unroll
            for (int ct = 0; ct < 2; ++ct)
#pragma unroll
                for (int it = 0; it < 8; ++it) acc[ct][it] = (f32x4){0.f, 0.f, 0.f, 0.f};
            const bf16* wbase = Wsp + (size_t)(l * 4 + gi) * 128 * 128 + (size_t)qi * 128 + 4 * g4;
#pragma unroll
            for (int kc = 0; kc < 4; ++kc) {
                bf16x8 af[2];
#pragma unroll
                for (int ct = 0; ct < 2; ++ct) { const LAS unsigned char* p = Vn + (32 * kc + 4 * g4 + (qi >> 2)) * SG_RS + (32 * F.wave + 16 * ct + 4 * (qi & 3)) * 2;
                    af[ct] = cat8(tr16(p), tr16(p + 16 * SG_RS)); }
#pragma unroll
                for (int it = 0; it < 8; ++it) if (it >= 2 * kc) {
                    const bf16* wp = wbase + (size_t)(16 * it) * 128 + 32 * kc; const LAS unsigned char* wq = Wl + (16 * it + qi) * SG_WRS + (32 * kc + 4 * g4) * 2;
                    const v2u b0 = wlds ? *(const LAS v2u*)wq : *(const v2u*)wp, b1 = wlds ? *(const LAS v2u*)(wq + 32) : *(const v2u*)(wp + 16);
                    const bf16x8 bfr = __builtin_bit_cast(bf16x8, (v4u){b0.x, b0.y, b1.x, b1.y});
                    acc[0][it] = mfma16(af[0], bfr, acc[0][it]); acc[1][it] = mfma16(af[1], bfr, acc[1][it]); }
            }
#pragma unroll
            for (int it = 0; it < 8; ++it) { const int i = 16 * it + qi; const float bias = ubias[it]; const size_t rowo = (size_t)(m0 + i) * 1536 + gi * 256 + 32 * F.wave + 4 * g4;
#pragma unroll
                for (int ct = 0; ct < 2; ++ct) { const v2u uu = uq[it][ct]; const f32x4 a = acc[ct][it]; v2u w;
                    w.x = pk2(bflo(uu.x) * (a[0] + bias), bfhi(uu.x) * (a[1] + bias)); w.y = pk2(bflo(uu.y) * (a[2] + bias), bfhi(uu.y) * (a[3] + bias));
                    *(v2u*)(TT + rowo + 16 * ct) = w; } }
        }
        LDS_BARRIER();
    }
#undef SG_LOAD
}

__device__ __forceinline__ void phase_ln1(Frame& F, int l, bool commit) {
    const bf16* YPRE = wsp<bf16>(F, WS_YPRE); bf16* H = wsp<bf16>(F, WS_H);
    const float* modl = wsp<float>(F, WS_MOD) + (size_t)l * 8 * 6144;
    const float* lg = F.in[I_LN1G] + l * D; const float* lb = F.in[I_LN1B] + l * D; const float* br = F.in[I_BR] + l * NE;
    const bf16* WH = wsp<bf16>(F, WS_WRT) + (size_t)l * NE * D; const bf16* WL = WH + (size_t)NL * NE * D;
    int* TOKINFO = wsp<int>(F, WS_TOKINFO); float* TOKW = wsp<float>(F, WS_TOKW);
    unsigned* cntg = wsp<unsigned>(F, WS_CTL) + CW_CNT + (size_t)l * NE * 64;
    LAS int* sel_e = (LAS int*)(F.lds + X_SELE);
    const int lane = F.lane, qi = lane & 15, g4 = lane >> 4;
    { const v4u* srcw = (const v4u*)WH;
#pragma unroll 4
      for (int i = F.tid; i < 2 * NE * 128; i += 512) { const int hl = i >> 12, e = (i >> 7) & 31, c = i & 127;
          *(LAS v4u*)(F.lds + hl * 65536 + e * 2048 + ((c ^ (e & 15)) << 4)) = srcw[(size_t)hl * (NL * NE * 128) + e * 128 + c]; } }
    __syncthreads();
    for (int tb = F.vcu; tb < T / 128; tb += F.G) {
        const int m0 = tb * 128; const int b = m0 >> 12; const float* mb = modl + (size_t)b * 6144; const int mw = m0 + 16 * F.wave;
        v2u pre[4][4];
#pragma unroll
        for (int r = 0; r < 4; ++r)
#pragma unroll
            for (int j = 0; j < 4; ++j) pre[r][j] = *((const v2u*)(YPRE + (size_t)(mw + r) * D) + lane + 64 * j);
#pragma unroll 1
        for (int rp = 0; rp < 4; ++rp) {
            f32x4 hh[4][4]; float mean[4], rstd[4];
            const int mrow = mw + 4 * rp;
#pragma unroll
            for (int r = 0; r < 4; ++r)
#pragma unroll
                for (int j = 0; j < 4; ++j) hh[r][j] = (f32x4){bflo(pre[r][j].x), bfhi(pre[r][j].x), bflo(pre[r][j].y), bfhi(pre[r][j].y)};
            if (rp < 3) {
#pragma unroll
                for (int r = 0; r < 4; ++r)
#pragma unroll
                    for (int j = 0; j < 4; ++j) pre[r][j] = *((const v2u*)(YPRE + (size_t)(mrow + 4 + r) * D) + lane + 64 * j); }
            { float sm[4], sq[4];
#pragma unroll
              for (int r = 0; r < 4; ++r) { sm[r] = 0.f; sq[r] = 0.f;
#pragma unroll
                  for (int j = 0; j < 4; ++j) { sm[r] += (hh[r][j][0] + hh[r][j][1]) + (hh[r][j][2] + hh[r][j][3]);
                      sq[r] += (hh[r][j][0] * hh[r][j][0] + hh[r][j][1] * hh[r][j][1]) + (hh[r][j][2] * hh[r][j][2] + hh[r][j][3] * hh[r][j][3]); } }
#pragma unroll
              for (int o = 1; o < 64; o <<= 1) {
#pragma unroll
                  for (int r = 0; r < 4; ++r) { sm[r] += __shfl_xor(sm[r], o); sq[r] += __shfl_xor(sq[r], o); } }
#pragma unroll
              for (int r = 0; r < 4; ++r) { mean[r] = sm[r] * (1.0f / D); rstd[r] = 1.0f / sqrtf(fmaxf(sq[r] * (1.0f / D) - mean[r] * mean[r], 0.f) + LN_EPS); } }
            if (lane < 4) { const float mq = (lane == 0) ? mean[0] : (lane == 1) ? mean[1] : (lane == 2) ? mean[2] : mean[3], rq = (lane == 0) ? rstd[0] : (lane == 1) ? rstd[1] : (lane == 2) ? rstd[2] : rstd[3];
                float* st = wsp<float>(F, WS_STAT) + (size_t)(mrow + lane) * 2; st[0] = mq; st[1] = rq; }
#pragma unroll
            for (int j = 0; j < 4; ++j) { const f32x4 gq = *((const f32x4*)lg + lane + 64 * j), bq = *((const f32x4*)lb + lane + 64 * j);
                const f32x4 shq = *((const f32x4*)(mb + 3072) + lane + 64 * j), scq = *((const f32x4*)(mb + 4096) + lane + 64 * j) + 1.0f;
#pragma unroll
                for (int r = 0; r < 4; ++r) { const f32x4 x1 = (hh[r][j] - mean[r]) * rstd[r] * gq + bq;
                    const f32x4 h2 = x1 * scq + shq; v2u o; o.x = pk2(h2[0], h2[1]); o.y = pk2(h2[2], h2[3]); *((v2u*)(H + (size_t)(mrow + r) * D) + lane + 64 * j) = o;
 } }
        }
        VM_WAIT(); asm volatile("" ::: "memory");
        f32x4 c0 = (f32x4){0.f, 0.f, 0.f, 0.f}, c1 = c0;
        { const bf16* hp = H + (size_t)(mw + qi) * D + 8 * g4;
          const LAS unsigned char* w0 = F.lds + qi * 2048; const LAS unsigned char* w1 = F.lds + (16 + qi) * 2048;
#pragma unroll 8
          for (int ks = 0; ks < 32; ++ks) {
              const bf16x8 hhi = *(const bf16x8*)(hp + 32 * ks);
              const int co = ((4 * ks + g4) ^ qi) << 4;
              const bf16x8 a0h = *(const LAS bf16x8*)(w0 + co), a0l = *(const LAS bf16x8*)(w0 + 65536 + co);
              const bf16x8 a1h = *(const LAS bf16x8*)(w1 + co), a1l = *(const LAS bf16x8*)(w1 + 65536 + co);
              c0 = mfma16(a0h, hhi, c0); c0 = mfma16(a0l, hhi, c0);
              c1 = mfma16(a1h, hhi, c1); c1 = mfma16(a1l, hhi, c1); } }
        {
            float v[8]; int id[8];
#pragma unroll
            for (int i = 0; i < 4; ++i) { id[i] = 4 * g4 + i; id[4 + i] = 16 + 4 * g4 + i; v[i] = c0[i] + br[4 * g4 + i]; v[4 + i] = c1[i] + br[16 + 4 * g4 + i]; }
            int ek[4]; float vk[4];
#pragma unroll
            for (int k = 0; k < 4; ++k) { float lm = v[0]; int li = id[0];
#pragma unroll
                for (int j = 1; j < 8; ++j) if (v[j] > lm) { lm = v[j]; li = id[j]; }
#pragma unroll
                for (int o = 16; o <= 32; o <<= 1) { const float om = __shfl_xor(lm, o); const int oi = __shfl_xor(li, o); if (om > lm || (om == lm && oi < li)) { lm = om; li = oi; } }
                ek[k] = li; vk[k] = lm;
#pragma unroll
                for (int j = 0; j < 8; ++j) if (id[j] == li) v[j] = -INFINITY; }
            const float e1 = __expf(vk[1] - vk[0]), e2 = __expf(vk[2] - vk[0]), e3 = __expf(vk[3] - vk[0]); const float inv = 1.0f / (1.0f + e1 + e2 + e3);
            if (g4 == 0) { const int tl = 16 * F.wave + qi;
                sel_e[tl * 4 + 0] = ek[0]; sel_e[tl * 4 + 1] = ek[1]; sel_e[tl * 4 + 2] = ek[2]; sel_e[tl * 4 + 3] = ek[3];
                *(f32x4*)(TOKW + (size_t)(m0 + tl) * 4) = (f32x4){inv, e1 * inv, e2 * inv, e3 * inv}; }
        }
        __syncthreads();
        { const int myE = sel_e[F.tid]; LAS unsigned long long* bm = (LAS unsigned long long*)(F.lds + X_SELR); unsigned long long mine = 0ull;
#pragma unroll
          for (int e = 0; e < 32; ++e) { const unsigned long long m = __ballot(myE == e); if (lane == e) mine = m; }
          if (lane < 32) bm[F.wave * 32 + lane] = mine;
          __syncthreads();
          int rk = __popcll(bm[F.wave * 32 + myE] & ((1ull << lane) - 1ull));
#pragma unroll
          for (int w = 0; w < 8; ++w) if (w < F.wave) rk += __popcll(bm[w * 32 + myE]);
          TOKINFO[(size_t)m0 * 4 + F.tid] = myE | (rk << 8);
          if (F.tid < 32) { int tot = 0;
#pragma unroll
              for (int w = 0; w < 8; ++w) tot += __popcll(bm[w * 32 + F.tid]);
              wsp<int>(F, WS_WGCNT)[((size_t)l * 256 + tb) * 32 + F.tid] = tot; if (tot && commit) (void)__hip_atomic_fetch_add(cntg + F.tid * 64, (unsigned)tot, RLX_AGENT); } }
        __syncthreads();
    }
}

__device__ __forceinline__ int moe_tables(Frame& F, int l) {
    const unsigned* cntg = wsp<unsigned>(F, WS_CTL) + CW_CNT + (size_t)l * NE * 64;
    LAS int* cnt_s = (LAS int*)(F.lds + X_CNTS); LAS int* off_s = (LAS int*)(F.lds + X_OFFS); LAS unsigned char* tile_e = (LAS unsigned char*)(F.lds + X_TILEE);
    if (F.tid < 32) cnt_s[F.tid] = (int)__hip_atomic_load(cntg + F.tid * 64, RLX_AGENT);
    __syncthreads();
    if (F.tid < 64) {
        const int e = F.tid & 31; const int c = (F.tid < 32) ? cnt_s[e] : 0; const int nt = (c + 255) >> 8; int incl = nt;
#pragma unroll
        for (int o = 1; o < 32; o <<= 1) { const int v = __shfl_up(incl, o); if ((F.tid & 63) >= o) incl += v; }
        if (F.tid < 32) { const int excl = incl - nt; off_s[e] = excl * 256; for (int t = 0; t < nt; ++t) tile_e[excl + t] = (unsigned char)e; if (e == 31) off_s[32] = incl * 256; }
    }
    __syncthreads();
    return off_s[32] >> 8;
}
__device__ __forceinline__ void phase_scat(Frame& F, int l) {
    (void)moe_tables(F, l);
    const LAS int* off_s = (const LAS int*)(F.lds + X_OFFS); const LAS int* cnt_s = (const LAS int*)(F.lds + X_CNTS); LAS int* base_s = (LAS int*)(F.lds + X_BASE);
    const int* TOKINFO = wsp<int>(F, WS_TOKINFO); const float* TOKW = wsp<float>(F, WS_TOKW);
    int* ROWTOK = wsp<int>(F, WS_ROWTOK); float* ROWW = wsp<float>(F, WS_ROWW); const int* WGC = wsp<int>(F, WS_WGCNT) + (size_t)l * 256 * 32; int* TOKINFO2 = wsp<int>(F, WS_TOKROW);
    for (int tb = F.vcu; tb < T / 128; tb += F.G) {
        if (F.tid < 32) base_s[F.tid] = 0;
        __syncthreads();
        { const int e = F.tid & 31, part = F.tid >> 5; int sacc = 0;
          for (int t2 = part * 16; t2 < part * 16 + 16; ++t2) if (t2 < tb) sacc += WGC[t2 * 32 + e];
          if (sacc) atomicAdd((int*)&base_s[e], sacc); }
        __syncthreads();
        { const size_t ent = (size_t)tb * 512 + F.tid; const int info = TOKINFO[ent]; const int e = info & 255, row = off_s[e] + base_s[e] + (info >> 8);
          ROWTOK[row] = (int)ent; ROWW[row] = TOKW[ent]; TOKINFO2[ent] = row; }
        __syncthreads();
    }
    if (F.vcu == 0) for (int e = 0; e < NE; ++e) for (int r = off_s[e] + cnt_s[e] + F.tid; r < off_s[e + 1]; r += 512) { ROWTOK[r] = 0; ROWW[r] = 0.f; }
}
__device__ __forceinline__ void phase_ln2(Frame& F, int l) {
    const bf16* X1 = wsp<bf16>(F, WS_YPRE); const bf16* YK = wsp<bf16>(F, WS_XG); bf16* H = wsp<bf16>(F, WS_H); const int* TOKROW = wsp<int>(F, WS_TOKROW); const float* TOKW = wsp<float>(F, WS_TOKW);
    const float* STAT = wsp<float>(F, WS_STAT); const float* l1g = F.in[I_LN1G] + l * D; const float* l1b = F.in[I_LN1B] + l * D;
    float* XO = F.out; bf16* XB = wsp<bf16>(F, WS_X2);
    const float* modl = wsp<float>(F, WS_MOD) + (size_t)l * 8 * 6144; const float* modn = wsp<float>(F, WS_MOD) + (size_t)((l + 1) & 3) * 8 * 6144;
    const float* lg = F.in[I_LN2G] + l * D; const float* lb = F.in[I_LN2B] + l * D;
    const int lane = F.lane; const int gw = F.vcu * 8 + F.wave, NGW = F.G * 8;
    v2u px[4]; v2u py[4][4]; float pst[2], nst[2]; f32x4 pw4, nw4;
#define LN2_LOAD(mm) do { nst[0] = STAT[(size_t)(mm) * 2]; nst[1] = STAT[(size_t)(mm) * 2 + 1]; nw4 = *(const f32x4*)(TOKW + (size_t)(mm) * 4); \
        int rw_[4]; _Pragma("unroll") for (int k = 0; k < 4; ++k) rw_[k] = TOKROW[(size_t)(mm) * 4 + k]; \
        _Pragma("unroll") for (int j = 0; j < 4; ++j) { px[j] = __builtin_nontemporal_load((const v2u*)(X1 + (size_t)(mm) * D) + lane + 64 * j); \
        _Pragma("unroll") for (int k = 0; k < 4; ++k) py[j][k] = __builtin_nontemporal_load((const v2u*)(YK + (size_t)rw_[k] * D) + lane + 64 * j); } } while (0)
    if (gw < T) LN2_LOAD(gw);
#pragma unroll 1
    for (int m = gw; m < T; m += NGW) { const int b = m >> 12; const float* mb = modl + (size_t)b * 6144; const float* mn = modn + (size_t)b * 6144;
        f32x4 v[4]; float s = 0.f; pst[0] = nst[0]; pst[1] = nst[1]; pw4 = nw4;
#pragma unroll
        for (int j = 0; j < 4; ++j) { f32x4 y = (f32x4){0.f, 0.f, 0.f, 0.f};
#pragma unroll
            for (int k = 0; k < 4; ++k) { const v2u w = py[j][k]; const float cw = pw4[k]; y[0] += cw * bflo(w.x); y[1] += cw * bfhi(w.x); y[2] += cw * bflo(w.y); y[3] += cw * bfhi(w.y); }
            const f32x4 g2 = *((const f32x4*)(mb + 5120) + lane + 64 * j) + 1.0f;
            const f32x4 pxf = (f32x4){bflo(px[j].x), bfhi(px[j].x), bflo(px[j].y), bfhi(px[j].y)};
            const f32x4 x1 = (pxf - pst[0]) * pst[1] * *((const f32x4*)l1g + lane + 64 * j) + *((const f32x4*)l1b + lane + 64 * j);
            v[j] = x1 * DN_ALPHA + g2 * y; s += (v[j][0] + v[j][1]) + (v[j][2] + v[j][3]); }
        if (m + NGW < T) LN2_LOAD(m + NGW);
        float s2 = 0.f;
#pragma unroll
        for (int j = 0; j < 4; ++j) s2 += (v[j][0] * v[j][0] + v[j][1] * v[j][1]) + (v[j][2] * v[j][2] + v[j][3] * v[j][3]);
#pragma unroll
        for (int o = 1; o < 64; o <<= 1) { s += __shfl_xor(s, o); s2 += __shfl_xor(s2, o); }
        const float mean = s * (1.0f / D); const float rstd = 1.0f / sqrtf(fmaxf(s2 * (1.0f / D) - mean * mean, 0.f) + LN_EPS);
#pragma unroll
        for (int j = 0; j < 4; ++j) v[j] = v[j] - mean;
        f32x4* xo = (f32x4*)(XO + (size_t)m * D) + lane; v2u* xb = (v2u*)(XB + (size_t)m * D) + lane; v2u* ho = (v2u*)(H + (size_t)m * D) + lane;
#pragma unroll
        for (int j = 0; j < 4; ++j) { const f32x4 gvj = *((const f32x4*)lg + lane + 64 * j), bvj = *((const f32x4*)lb + lane + 64 * j); const f32x4 x2 = v[j] * rstd * gvj + bvj;
            if (l == NL - 1) __builtin_nontemporal_store(x2, xo + 64 * j); else { v2u xq; xq.x = pk2(x2[0], x2[1]); xq.y = pk2(x2[2], x2[3]); __builtin_nontemporal_store(xq, xb + 64 * j); }
            if (l < NL - 1) { const f32x4 sh = *((const f32x4*)mn + lane + 64 * j), sc = *((const f32x4*)(mn + 1024) + lane + 64 * j) + 1.0f; const f32x4 h = x2 * sc + sh;
                v2u o; o.x = pk2(h[0], h[1]); o.y = pk2(h[2], h[3]); ho[64 * j] = o; } } }
#undef LN2_LOAD
}

#ifndef PH_MASK
#define PH_MASK 0xFFFF
#endif
#define PHM(b) ((PH_MASK >> (b)) & 1)
#ifndef DUP_MASK
#define DUP_MASK 0
#endif
#define REPS(b) (((DUP_MASK >> (b)) & 1) ? 2 : 1)
constexpr int NPH_L = 10, NPHASE = 2 + NL * NPH_L;
struct Args { const float* in[20]; float* out; unsigned char* ws; int ph_lo, ph_hi; };
__global__ void __launch_bounds__(512, 2) fwd(Args args) {
    extern __shared__ __attribute__((aligned(16))) unsigned char lds[];
    Frame F;
    F.lds = (LAS unsigned char*)lds;
#define FRESH() do { int zv_ = 0; asm volatile("" : "+v"(zv_)); const int z_ = __builtin_amdgcn_readfirstlane(zv_); \
        F.tid = (int)threadIdx.x + zv_; F.lane = F.tid & 63; F.wave = __builtin_amdgcn_readfirstlane(F.tid >> 6); \
        F.G = (int)gridDim.x + z_; F.bx = (int)blockIdx.x + z_; F.vcu = (F.G % 8 == 0) ? (F.bx % 8) * (F.G / 8) + F.bx / 8 : F.bx; \
        F.ws = args.ws + z_; F.in = args.in + z_; F.out = args.out + z_; F.lds = (LAS unsigned char*)lds + z_; } while (0)
    FRESH();
    for (int u = F.tid; u < (LDS_BYTES - XOFF) / 4; u += 512) ((LAS unsigned*)(F.lds + XOFF))[u] = 0u;
    __syncthreads();
    unsigned* ctl = wsp<unsigned>(F, WS_CTL);
    XcdBarrier bar; bar.bar = ctl + CW_BAR; bar.x = 0; bar.st = nullptr;
    if (!MK_PER_PHASE) bar = xcd_barrier_post(ctl + CW_BAR, (volatile LAS unsigned*)(F.lds + X_MISC) + 8);
    const int lo = args.ph_lo, hi = args.ph_hi;
#define IN(k) (lo <= (k) && (k) < hi)
#ifndef BAR_REPS
#define BAR_REPS 1
#endif
#define SEAM(k) do { if (!MK_PER_PHASE && IN(k) && IN((k) + 1)) for (int br_ = 0; br_ < BAR_REPS; ++br_) xcd_barrier(bar); } while (0)

    if (PHM(0) && IN(0)) for (int rep = 0; rep < REPS(0); ++rep) { FRESH(); phase_pro_a(F); } SEAM(0);
    if (PHM(1) && IN(1)) for (int rep = 0; rep < REPS(1); ++rep) { FRESH(); phase_pro_b(F); } SEAM(1);
    for (int l = 0; l < NL; ++l) {
        const int pb = 2 + l * NPH_L;
        if (PHM(2) && IN(pb + 0)) for (int rep = 0; rep < REPS(2); ++rep) { FRESH();
            pg8::Gemm g{wsp<bf16>(F, WS_H), wsp<bf16>(F, WS_WIN) + (size_t)l * NIN * D, T, NIN, D}; pg8::StaticOrder S; S.init(T, NIN, F.G, F.bx);
            EpiIn E{wsp<bf16>(F, WS_U), wsp<bf16>(F, WS_V), wsp<bf16>(F, WS_Q), wsp<bf16>(F, WS_K), wsp<bf16>(F, WS_VV), wsp<bf16>(F, WS_G), wsp<float>(F, WS_ROPE)};
            stagger(F.bx >> 3, STAG_US);
            pg8::gemm_phase<EpiIn, pg8::StaticOrder, PG8_ALIGN, PG8_SP2>(F.lds, g, S, E, F.tid);
#if defined(XPROBE)
            { FRESH(); pg8::Gemm g2{wsp<bf16>(F, WS_H), wsp<bf16>(F, WS_WIN) + (size_t)l * NIN * D, T, NIN, D}; pg8::StaticOrder S2; S2.init(T, NIN, F.G, F.bx);
              EpiProbe E2{wsp<bf16>(F, WS_XG), (XPROBE == 3) ? NIN : 1024, (XPROBE >= 2) ? (XPROBE == 3 ? 3 : 1) : (F.G == 0x7ffffff0 ? 1 : 0)};
              pg8::gemm_phase<EpiProbe, pg8::StaticOrder, PG8_ALIGN, PG8_SP2>(F.lds, g2, S2, E2, F.tid); }
#endif
        } SEAM(pb + 0);
        if (PHM(3) && IN(pb + 1)) for (int rep = 0; rep < REPS(3); ++rep) { FRESH(); phase_attn(F); } SEAM(pb + 1);
        if (PHM(4) && IN(pb + 2)) for (int rep = 0; rep < REPS(4); ++rep) { FRESH(); phase_sg(F, l); } SEAM(pb + 2);
        if (PHM(5) && IN(pb + 3)) for (int rep = 0; rep < REPS(5); ++rep) { FRESH();
            pg8::Gemm g{wsp<bf16>(F, WS_TT), wsp<bf16>(F, WS_WBA) + (size_t)l * D * 1536, T, D, 1536}; pg8::StaticOrder S; S.init(T, D, F.G, F.bx);
            EpiMg2 E{wsp<bf16>(F, WS_G), wsp<bf16>(F, WS_MG)}; pg8::gemm_phase<EpiMg2, pg8::StaticOrder, PG8_ALIGN, PG8_SP2>(F.lds, g, S, E, F.tid);
        } SEAM(pb + 3);
        if (PHM(6) && IN(pb + 4)) for (int rep = 0; rep < REPS(6); ++rep) { FRESH();
            pg8::Gemm g{wsp<bf16>(F, WS_MG), wsp<bf16>(F, WS_WOUT) + (size_t)l * D * D, T, D, D}; pg8::StaticOrder S; S.init(T, D, F.G, F.bx);
            if (l == 0) { EpiOut<true> E{(const void*)F.in[I_X], wsp<float>(F, WS_MOD) + (size_t)l * 8 * 6144, wsp<bf16>(F, WS_YPRE)}; pg8::gemm_phase<EpiOut<true>, pg8::StaticOrder, PG8_ALIGN, PG8_SP2>(F.lds, g, S, E, F.tid); }
            else { EpiOut<false> E{(const void*)wsp<bf16>(F, WS_X2), wsp<float>(F, WS_MOD) + (size_t)l * 8 * 6144, wsp<bf16>(F, WS_YPRE)}; pg8::gemm_phase<EpiOut<false>, pg8::StaticOrder, PG8_ALIGN, PG8_SP2>(F.lds, g, S, E, F.tid); }
        } SEAM(pb + 4);
        if (PHM(7) && IN(pb + 5)) for (int rep = 0; rep < REPS(7); ++rep) { FRESH(); phase_ln1(F, l, rep == 0); } SEAM(pb + 5);
        if (PHM(8) && IN(pb + 6)) for (int rep = 0; rep < REPS(8); ++rep) { FRESH(); phase_scat(F, l); } SEAM(pb + 6);
        if (PHM(9) && IN(pb + 7)) for (int rep = 0; rep < REPS(9); ++rep) { FRESH();
            const int RT = moe_tables(F, l);
            pg8::Gemm g{wsp<bf16>(F, WS_H), wsp<bf16>(F, WS_WUP) + (size_t)l * NE * 2048 * D, RT * 256, NE * 2048, D};
            MoeGatherOrder S; S.init(RT, 8, F.G, F.bx, (const LAS unsigned char*)(F.lds + X_TILEE)); S.tokl = (const LAS unsigned short*)(F.lds + X_TOKL);
            { const int* rowtok = wsp<int>(F, WS_ROWTOK); LAS unsigned short* tl = (LAS unsigned short*)(F.lds + X_TOKL); pg8::Unit uu;
              for (int i = 0; i < TOKL_UNITS && S.next(i, uu); ++i) if (F.tid < 256) tl[i * 256 + F.tid] = (unsigned short)(rowtok[uu.pm * 256 + F.tid] >> 2);
              __syncthreads(); }
            EpiUp E{F.in[I_BUP] + (size_t)l * NE * 2048, wsp<bf16>(F, WS_ACT)};
            stagger(F.bx >> 3, STAG_US);
            pg8::gemm_phase<EpiUp, MoeGatherOrder, PG8_ALIGN, true>(F.lds, g, S, E, F.tid);
        } SEAM(pb + 7);
        if (PHM(10) && IN(pb + 8)) for (int rep = 0; rep < REPS(10); ++rep) { FRESH();
            const int RT = moe_tables(F, l);
            pg8::Gemm g{wsp<bf16>(F, WS_ACT), wsp<bf16>(F, WS_WDN) + (size_t)l * NE * D * FF, RT * 256, NE * D, FF};
            MoeOrder S; S.init(RT, 4, F.G, F.bx, (const LAS unsigned char*)(F.lds + X_TILEE), 1);
            EpiDn E{F.in[I_BDN] + (size_t)l * NE * D, wsp<bf16>(F, WS_XG)};
            stagger(F.bx >> 3, STAG_US);
            pg8::gemm_phase<EpiDn, MoeOrder, PG8_ALIGN, PG8_SP2>(F.lds, g, S, E, F.tid);
        } SEAM(pb + 8);
        if (PHM(11) && IN(pb + 9)) for (int rep = 0; rep < REPS(11); ++rep) { FRESH(); phase_ln2(F, l); } SEAM(pb + 9);
    }
#undef IN
#undef SEAM
#undef FRESH
}

extern "C" void kernel_launch(void* const* d_in, const int* in_sizes, int n_in, void* d_out, int out_size, void* d_ws, size_t ws_size, hipStream_t stream) {
    static int grid = 0;
    if (grid == 0) {
        if (n_in != 20 || out_size != T * D || ws_size < WS_END) { fprintf(stderr, "kernel_launch: unexpected shapes (n_in %d, out %d, ws %zu < %zu)\n", n_in, out_size, ws_size, (size_t)WS_END); grid = -1; return; }
        int dev = 0, cus = 0;
        if (hipGetDevice(&dev) != hipSuccess || hipDeviceGetAttribute(&cus, hipDeviceAttributeMultiprocessorCount, dev) != hipSuccess) { grid = -1; return; }
        if (hipFuncSetAttribute((const void*)fwd, hipFuncAttributeMaxDynamicSharedMemorySize, LDS_BYTES) != hipSuccess) { fprintf(stderr, "kernel_launch: hipFuncSetAttribute failed\n"); grid = -1; return; }
        int per_cu = 0;
        if (hipOccupancyMaxActiveBlocksPerMultiprocessor(&per_cu, (const void*)fwd, 512, LDS_BYTES) != hipSuccess || per_cu < 1) fprintf(stderr, "kernel_launch: occupancy query says %d blocks per CU\n", per_cu);
        (void)hipGetLastError();
        grid = cus;
    }
    if (grid < 0) return;
    (void)in_sizes;
    if (hipMemsetAsync((char*)d_ws + WS_CTL, 0, CTL_ZERO_BYTES, stream) != hipSuccess) return;
    Args a{};
    for (int i = 0; i < 20; ++i) a.in[i] = (const float*)d_in[i];
    a.out = (float*)d_out; a.ws = (unsigned char*)d_ws;
#if MK_PER_PHASE
    for (int p = 0; p < NPHASE; ++p) { a.ph_lo = p; a.ph_hi = p + 1; hipLaunchKernelGGL(fwd, dim3(grid), dim3(512), LDS_BYTES, stream, a); }
#else
    a.ph_lo = 0; a.ph_hi = NPHASE;
    hipLaunchKernelGGL(fwd, dim3(grid), dim3(512), LDS_BYTES, stream, a);
#endif
    const hipError_t le = hipPeekAtLastError();
    if (le != hipSuccess) fprintf(stderr, "kernel_launch: launch failed: %s\n", hipGetErrorName(le));
}
```

```cpp
#include <hip/hip_runtime.h>
#include <cstdio>
#include <cstdint>
#ifndef MK_PER_PHASE
#define MK_PER_PHASE 0
#endif
namespace pg8 {
#define PG8_LAS __attribute__((address_space(3)))
typedef unsigned short bf16_t;
typedef short bf16x8 __attribute__((ext_vector_type(8)));
typedef float f32x4 __attribute__((ext_vector_type(4)));
typedef unsigned u32x4 __attribute__((ext_vector_type(4)));
constexpr int BM = 256, BK = 64, HALF = 128, HTB = HALF * BK * 2  , STAGE_BYTES = 8 * HTB, NXCD = 8;
#ifndef PG8_WGM
#define PG8_WGM 8
#endif
constexpr int WGM = PG8_WGM;

__host__ __device__ __forceinline__ int lds_byte(int r, int c) { const int st = (r >> 4) * 2 + (c >> 5), rr = r & 15, cc = c & 31, ob = rr * 64 + cc * 2; return st * 1024 + (ob ^ (((ob >> 9) & 1) << 5)); }
__host__ __device__ __forceinline__ void stage_rc(int b, int& R, int& C) { const int st = b / 1024, sb = b % 1024, swz = sb ^ (((sb >> 9) & 1) << 5); R = (st >> 1) * 16 + swz / 64; C = (st & 1) * 32 + (swz % 64) / 2; }
__host__ __device__ __forceinline__ int perm32(int rho) { const int n = rho >> 4, i = rho & 15; return 8 * (i >> 2) + 4 * n + (i & 3); }

struct Unit { int pm, pn; };
struct Gemm { const bf16_t* A; const bf16_t* Bt; int M, N, K; };

struct StaticOrder {
    static constexpr bool GATHER = false; __device__ __forceinline__ int arow(int, int r) const { return r; }
    int nM, nN, nwg, G, c;
    __host__ __device__ void init(int M, int N, int G_, int c_) { nM = M / BM; nN = N / BM; nwg = nM * nN; G = G_; c = c_; }
    __host__ __device__ bool next(int i, Unit& u) const {
        const long L = (long)i * G + c; if (L >= nwg) return false;
        int wgid = (int)L; { const int q = nwg / NXCD, r = nwg % NXCD, xcd = wgid % NXCD, off = wgid / NXCD; wgid = (xcd < r ? xcd * (q + 1) : r * (q + 1) + (xcd - r) * q) + off; }
        const int nig = WGM * nN, gid = wgid / nig, fm = gid * WGM, gsz = (nM - fm) < WGM ? (nM - fm) : WGM;
        u.pm = fm + ((wgid % nig) % gsz); u.pn = (wgid % nig) / gsz; return true;
    }
    __device__ __forceinline__ void a_ready(const Unit&) const {}
    __device__ __forceinline__ void done(const Unit&) const {}
};

__device__ __forceinline__ unsigned cvt_pk_bf16(float lo, float hi) { unsigned r; asm volatile("v_cvt_pk_bf16_f32 %0, %1, %2" : "=v"(r) : "v"(lo), "v"(hi)); return r; }
typedef float f32x2 __attribute__((ext_vector_type(2)));

template <class Epi, class Sched, bool ALIGN_EPI = false, bool SP2 = false>
__device__ __forceinline__ void gemm_phase(PG8_LAS unsigned char* lds, const Gemm g, const Sched& S, const Epi& E, const int tid_in) {
    const int tid = tid_in, wid = __builtin_amdgcn_readfirstlane(tid >> 6), lane = tid & 63, wr = wid >> 2, wc = wid & 3, fr = lane & 15, fq = lane >> 4;
    const int K = g.K, nt = K / BK; constexpr bool BBLK = true;
    unsigned voffA[2], voffB[2];
#pragma unroll
    for (int i = 0; i < 2; ++i) { int R, C; stage_rc(tid * 16 + i * 8192, R, C); const int Rb = Epi::BADJ ? (64 * (R >> 5) + perm32(R & 31)) : Epi::PERM ? ((R & ~31) + perm32(R & 31)) : R;
        voffA[i] = Epi::ABLK ? (unsigned)((((R >> 4) * (K >> 5) + (C >> 5)) * 8 + (R & 7)) * 128 + ((R >> 3) & 1) * 64 + (C & 31) * 2) : (unsigned)(R * K + C) * 2u; voffB[i] = BBLK ? (unsigned)((((Rb >> 4) * (K >> 5) + (C >> 5)) * 8 + (Rb & 7)) * 128 + ((Rb >> 3) & 1) * 64 + (C & 31) * 2) : (unsigned)(Rb * K + C) * 2u; }
    const size_t kstep = (size_t)(BK * 2);
    const size_t kstepB = BBLK ? (size_t)2048 : kstep;
    const size_t kstepA = Epi::ABLK ? (size_t)2048 : kstep;
    const size_t hstep = (size_t)HALF * K * 2;
    const size_t tstep = 2 * hstep;
    const size_t bhstep = Epi::BADJ ? (size_t)32 * K * 2 : hstep;
    const unsigned ldsw = (unsigned)wid * 1024u;
    const int aoff = lds_byte(wr * 64 + fr, fq * 8), boff = lds_byte(wc * 32 + fr, fq * 8);
#define PG8_SA(b, h) (((b) * 2 + (h)) * HTB)
#define PG8_SB(b, h) ((4 + (b) * 2 + (h)) * HTB)
    unsigned gc[2][2], gn[2][2];
#define PG8_GOFF(dst, pmv, ordv) do { if constexpr (Sched::GATHER) { _Pragma("unroll") for (int _h = 0; _h < 2; ++_h) _Pragma("unroll") for (int _i = 0; _i < 2; ++_i) { int _R, _C; stage_rc(tid * 16 + _i * 8192, _R, _C); \
        dst[_h][_i] = (unsigned)S.arow((ordv), (pmv) * 256 + _h * 128 + _R) * (unsigned)(K * 2) + (unsigned)(_C * 2); } } } while (0)
#define PG8_STAGE_A(bufoff, origptr, nextf, hh, kbytes) do { if constexpr (Sched::GATHER) { _Pragma("unroll") for (int _i = 0; _i < 2; ++_i) { const unsigned _o = (nextf) ? gn[hh][_i] : gc[hh][_i]; \
        __builtin_amdgcn_global_load_lds((const unsigned*)((const char*)g.A + (kbytes) + _o), (PG8_LAS unsigned*)(lds + (bufoff) + ldsw + _i * 8192), 16, 0, 0); } } else { PG8_STAGE(bufoff, origptr, voffA); } } while (0)
#define PG8_STAGE(bufoff, gbase, voff) do { _Pragma("unroll") for (int _i = 0; _i < 2; ++_i) \
        __builtin_amdgcn_global_load_lds((const unsigned*)((const char*)(gbase) + (voff)[_i]), (PG8_LAS unsigned*)(lds + (bufoff) + ldsw + _i * 8192), 16, 0, 0); } while (0)
#define PG8_LDA(dst, b, h) do { _Pragma("unroll") for (int m = 0; m < 4; ++m) _Pragma("unroll") for (int k = 0; k < 2; ++k) dst[m][k] = *(const PG8_LAS bf16x8*)(lds + PG8_SA(b, h) + aoff + m * 2048 + k * 1024); } while (0)
#define PG8_LDB(dst, b, h) do { _Pragma("unroll") for (int n = 0; n < 2; ++n) _Pragma("unroll") for (int k = 0; k < 2; ++k) dst[n][k] = *(const PG8_LAS bf16x8*)(lds + PG8_SB(b, h) + boff + n * 2048 + k * 1024); } while (0)
#define PG8_MMA(ai, bj, At, Bt) do { __builtin_amdgcn_s_setprio(1); _Pragma("unroll") for (int m = 0; m < 4; ++m) _Pragma("unroll") for (int n = 0; n < 2; ++n) _Pragma("unroll") for (int k = 0; k < 2; ++k) \
        acc[ai][bj][m][n] = __builtin_amdgcn_mfma_f32_16x16x32_bf16(Bt[n][k], At[m][k], acc[ai][bj][m][n], 0, 0, 0); __builtin_amdgcn_s_setprio(0); } while (0)
#define PG8_WAIT_V(n) asm volatile("s_waitcnt vmcnt(" #n ")" ::: "memory")
#define PG8_WAIT_L(n) asm volatile("s_waitcnt lgkmcnt(" #n ")" ::: "memory")
#define PG8_BAR __builtin_amdgcn_s_barrier()
#define PG8_SCHED __builtin_amdgcn_sched_barrier(0)
    Unit cur, nxt; int ui = 0;
    if (!S.next(0, cur)) return;
    f32x4 acc[2][2][4][2];
#pragma unroll
    for (int a = 0; a < 2; ++a)
#pragma unroll
        for (int b = 0; b < 2; ++b)
#pragma unroll
            for (int m = 0; m < 4; ++m)
#pragma unroll
                for (int n = 0; n < 2; ++n) acc[a][b][m][n] = (f32x4){0.f, 0.f, 0.f, 0.f};
    bf16x8 At[4][2], B0[2][2], B1[2][2];
    const char* cA = (const char*)g.A + (size_t)cur.pm * tstep; const char* cB = (const char*)g.Bt + (size_t)cur.pn * tstep;
    S.a_ready(cur);
    PG8_GOFF(gc, cur.pm, 0);
    if constexpr (SP2) {
        PG8_STAGE(PG8_SB(0, 0), cB, voffB); PG8_STAGE(PG8_SB(0, 1), cB + bhstep, voffB); PG8_STAGE_A(PG8_SA(0, 0), cA, false, 0, 0); PG8_STAGE_A(PG8_SA(0, 1), cA + hstep, false, 1, 0);
        if (wr == 1) PG8_BAR;
        PG8_WAIT_V(2); PG8_BAR;
        PG8_STAGE(PG8_SB(1, 0), cB + kstepB, voffB); PG8_STAGE_A(PG8_SA(1, 0), cA + kstepA, false, 0, kstep); PG8_STAGE(PG8_SB(1, 1), cB + bhstep + kstepB, voffB);
        PG8_WAIT_V(6); PG8_BAR;
    } else {
        PG8_STAGE(PG8_SB(0, 0), cB, voffB); PG8_STAGE(PG8_SA(0, 0), cA, voffA); PG8_STAGE(PG8_SB(0, 1), cB + bhstep, voffB); PG8_STAGE(PG8_SA(0, 1), cA + hstep, voffA);
        if (wr == 1) PG8_BAR;
        PG8_WAIT_V(4); PG8_BAR;
        PG8_STAGE(PG8_SB(1, 0), cB + kstepB, voffB); PG8_STAGE(PG8_SA(1, 0), cA + kstepA, voffA); PG8_STAGE(PG8_SB(1, 1), cB + bhstep + kstepB, voffB);
        PG8_WAIT_V(6); PG8_BAR;
    }
    for (;;) {
        const bool has_next = S.next(ui + 1, nxt);
        if constexpr (Sched::GATHER) { if (has_next) { PG8_GOFF(gn, nxt.pm, ui + 1); } else { gn[0][0] = gc[0][0]; gn[0][1] = gc[0][1]; gn[1][0] = gc[1][0]; gn[1][1] = gc[1][1]; } }
        const char* nA = has_next ? (const char*)g.A + (size_t)nxt.pm * tstep : cA; const char* nB = has_next ? (const char*)g.Bt + (size_t)nxt.pn * tstep : cB;
#pragma unroll
        for (int seg = 0; seg < (Epi::MID_T > 0 ? 2 : 1); ++seg) {
        if constexpr (Epi::MID_T > 0) { if (seg == 1) { PG8_SCHED; E.mid(acc, cur, wr, wc, fr, fq); PG8_SCHED; } }
        const int t_lo = seg ? Epi::MID_T : 0, t_hi = (Epi::MID_T > 0 && seg == 0) ? Epi::MID_T : nt;
        for (int t = t_lo; t < t_hi; t += 2) {
            const bool last = (t == nt - 2);
            const char* a1 = cA + (size_t)(t + 1) * kstepA;
            const char* a2 = last ? nA : cA + (size_t)(t + 2) * kstepA; const char* b2 = last ? nB : cB + (size_t)(t + 2) * kstepB;
            const char* a3 = a2 + kstepA; const char* b3 = b2 + kstepB; const size_t k2b = last ? (size_t)0 : (size_t)(t + 2) * kstep;
            if (last && has_next) S.a_ready(nxt);
            if constexpr (SP2) {
            PG8_LDB(B0, 0, 0); PG8_LDB(B1, 0, 1); PG8_SCHED; PG8_LDA(At, 0, 0); PG8_STAGE_A(PG8_SA(1, 1), a1 + hstep, false, 1, (size_t)(t + 1) * kstep);
            PG8_WAIT_V(8); PG8_WAIT_L(0); PG8_BAR; PG8_MMA(0, 0, At, B0); PG8_MMA(0, 1, At, B1); PG8_BAR; PG8_SCHED;
            PG8_LDA(At, 0, 1); PG8_STAGE(PG8_SB(0, 0), b2, voffB); PG8_STAGE(PG8_SB(0, 1), b2 + bhstep, voffB); PG8_STAGE_A(PG8_SA(0, 0), a2, last, 0, k2b);
            PG8_WAIT_V(8); PG8_WAIT_L(0); PG8_BAR; PG8_MMA(1, 0, At, B0); PG8_MMA(1, 1, At, B1); PG8_BAR; PG8_SCHED;
            PG8_LDB(B0, 1, 0); PG8_LDB(B1, 1, 1); PG8_SCHED; PG8_LDA(At, 1, 0); PG8_STAGE_A(PG8_SA(0, 1), a2 + hstep, last, 1, k2b);
            PG8_WAIT_V(8); PG8_WAIT_L(0); PG8_BAR; PG8_MMA(0, 0, At, B0); PG8_MMA(0, 1, At, B1); PG8_BAR; PG8_SCHED;
            PG8_LDA(At, 1, 1); PG8_STAGE(PG8_SB(1, 0), b3, voffB); PG8_STAGE(PG8_SB(1, 1), b3 + bhstep, voffB); PG8_STAGE_A(PG8_SA(1, 0), a3, last, 0, k2b + kstep);
            PG8_WAIT_V(8); PG8_WAIT_L(0); PG8_BAR; PG8_MMA(1, 0, At, B0); PG8_MMA(1, 1, At, B1); PG8_BAR; PG8_SCHED;
            } else {
            PG8_LDB(B0, 0, 0); PG8_SCHED; PG8_LDA(At, 0, 0); PG8_STAGE(PG8_SA(1, 1), a1 + hstep, voffA);
            PG8_WAIT_L(8); PG8_BAR; PG8_WAIT_L(0); PG8_MMA(0, 0, At, B0); PG8_BAR; PG8_SCHED;
            PG8_LDB(B1, 0, 1); PG8_STAGE(PG8_SB(0, 0), b2, voffB);
            PG8_BAR; PG8_WAIT_L(0); PG8_MMA(0, 1, At, B1); PG8_BAR;
            PG8_LDA(At, 0, 1); PG8_STAGE(PG8_SA(0, 0), a2, voffA);
            PG8_BAR; PG8_WAIT_L(0); PG8_MMA(1, 0, At, B0); PG8_BAR; PG8_SCHED;
            PG8_STAGE(PG8_SB(0, 1), b2 + bhstep, voffB);
            PG8_WAIT_V(6); PG8_BAR; PG8_MMA(1, 1, At, B1); PG8_BAR;
            PG8_LDB(B0, 1, 0); PG8_SCHED; PG8_LDA(At, 1, 0); PG8_STAGE(PG8_SA(0, 1), a2 + hstep, voffA);
            PG8_WAIT_L(8); PG8_BAR; PG8_WAIT_L(0); PG8_MMA(0, 0, At, B0); PG8_BAR; PG8_SCHED;
            PG8_LDB(B1, 1, 1); PG8_STAGE(PG8_SB(1, 0), b3, voffB);
            PG8_BAR; PG8_WAIT_L(0); PG8_MMA(0, 1, At, B1); PG8_BAR;
            PG8_LDA(At, 1, 1); PG8_STAGE(PG8_SA(1, 0), a3, voffA);
            PG8_BAR; PG8_WAIT_L(0); PG8_MMA(1, 0, At, B0); PG8_BAR; PG8_SCHED;
            PG8_STAGE(PG8_SB(1, 1), b3 + bhstep, voffB);
            PG8_WAIT_V(6); PG8_BAR; PG8_MMA(1, 1, At, B1); PG8_BAR;
            }
        }
        }
        if constexpr (ALIGN_EPI) { if (wr == 0) PG8_BAR; }
        if constexpr (!Epi::AFTER_DRAIN) { E(acc, cur, wr, wc, fr, fq); S.done(cur); }
        if (!has_next) break;
#pragma unroll
        for (int a = 0; a < 2; ++a)
#pragma unroll
            for (int b = 0; b < 2; ++b)
#pragma unroll
                for (int m = 0; m < 4; ++m)
#pragma unroll
                    for (int n = 0; n < 2; ++n) acc[a][b][m][n] = (f32x4){0.f, 0.f, 0.f, 0.f};
        cur = nxt; cA = nA; cB = nB; ++ui;
        if constexpr (Sched::GATHER) { gc[0][0] = gn[0][0]; gc[0][1] = gn[0][1]; gc[1][0] = gn[1][0]; gc[1][1] = gn[1][1]; }
        if constexpr (ALIGN_EPI) { if (wr == 1) PG8_BAR; }
    }
    PG8_WAIT_V(0);
    if constexpr (!ALIGN_EPI) { if (wr == 0) PG8_BAR; }
    PG8_BAR;
    if constexpr (Epi::AFTER_DRAIN) { E.fused(acc, cur, wr, wc, fr, fq, lds, wid, lane); S.done(cur); }
#undef PG8_SA
#undef PG8_SB
#undef PG8_STAGE
#undef PG8_STAGE_A
#undef PG8_GOFF
#undef PG8_LDA
#undef PG8_LDB
#undef PG8_MMA
#undef PG8_WAIT_V
#undef PG8_WAIT_L
#undef PG8_BAR
#undef PG8_SCHED
}
}
#define LAS __attribute__((address_space(3)))
#define XB_TMO      128
#define XB_XCNT(j)  (256  + 64 * (j))
#define XB_XSUB(j)  (1280 + 64 * (j))
#define XB_XGEN(j)  (2304 + 64 * (j))
#define XB_TOP      3328
#define XB_TOPGEN   3392
#define XCD_BAR_WORDS 3456
#define XB_SPIN_CAP (1u << 18)

__device__ __forceinline__ unsigned xb_ld(unsigned* p)              { return __hip_atomic_load(p, __ATOMIC_RELAXED, __HIP_MEMORY_SCOPE_AGENT); }
__device__ __forceinline__ unsigned xb_add(unsigned* p, unsigned v) { return __hip_atomic_fetch_add(p, v, __ATOMIC_RELAXED, __HIP_MEMORY_SCOPE_AGENT); }
__device__ __forceinline__ unsigned xb_xcc_id() { return (unsigned)__builtin_amdgcn_s_getreg((3 << 11) | 20) & 0xFu; }
#define XB_SPIN(cond, bar) do { unsigned _sp = 0; while (cond) { __builtin_amdgcn_s_sleep(1); \
    if ((++_sp & 255u) == 0u) { if (xb_ld(&(bar)[XB_TMO])) break; if (_sp > XB_SPIN_CAP) { atomicAdd(&(bar)[XB_TMO], 1u); break; } } } } while (0)

struct XcdBarrier {
    unsigned* bar; unsigned x;
    volatile LAS unsigned* st;
};

__device__ __forceinline__ XcdBarrier xcd_barrier_post(unsigned* bar, volatile LAS unsigned* st) {
    XcdBarrier b; b.bar = bar; b.x = xb_xcc_id(); b.st = st;
    if (threadIdx.x == 0) (void)xb_add(&bar[XB_XCNT(b.x)], 1u);
    return b;
}
__device__ __forceinline__ void xcd_barrier_complete(unsigned* bar, unsigned x, unsigned& nloc, unsigned& nx) {
    const unsigned G = gridDim.x * gridDim.y * gridDim.z;
    unsigned sum, cnt, mine, sp = 0u;
    for (;;) {
        sum = 0u; cnt = 0u; mine = 0u;
#pragma unroll
        for (unsigned j = 0; j < 16; ++j) { const unsigned c = xb_ld(&bar[XB_XCNT(j)]); sum += c; cnt += (c > 0u) ? 1u : 0u; mine = (j == x) ? c : mine; }
        if (sum == G) break;
        __builtin_amdgcn_s_sleep(1);
        if ((++sp & 255u) == 0u) { if (xb_ld(&bar[XB_TMO])) break; if (sp > XB_SPIN_CAP) { atomicAdd(&bar[XB_TMO], 1u); break; } }
    }
    nloc = mine > 0u ? mine : 1u; nx = cnt > 0u ? cnt : 1u;
}

__device__ __forceinline__ void xcd_barrier(const XcdBarrier& b) {
    asm volatile("s_waitcnt vmcnt(0)" ::: "memory");
    __syncthreads();
    if (threadIdx.x == 0) {
        unsigned* bar = b.bar;
        __builtin_amdgcn_s_waitcnt(0);
        unsigned nloc = b.st[0], nx = b.st[1];
        if (nloc == 0u) { xcd_barrier_complete(bar, b.x, nloc, nx); b.st[0] = nloc; b.st[1] = nx; }
        const unsigned old = xb_add(&bar[XB_XSUB(b.x)], 1u);
        const unsigned gen = old / nloc;
        if (old + 1u == (gen + 1u) * nloc) {
            __builtin_amdgcn_fence(__ATOMIC_RELEASE, "agent");
            asm volatile("s_waitcnt vmcnt(0)" ::: "memory");
            const unsigned og = xb_add(&bar[XB_TOP], 1u);
            const unsigned tg = og / nx;
            if (og + 1u == (tg + 1u) * nx) xb_add(&bar[XB_TOPGEN], 1u);
            else XB_SPIN(xb_ld(&bar[XB_TOPGEN]) == tg, bar);
            __builtin_amdgcn_fence(__ATOMIC_ACQUIRE, "agent");
            xb_add(&bar[XB_XGEN(b.x)], 1u);
            asm volatile("s_waitcnt vmcnt(0)" ::: "memory");
        } else {
            XB_SPIN(xb_ld(&bar[XB_XGEN(b.x)]) == gen, bar);
            __builtin_amdgcn_fence(__ATOMIC_ACQUIRE, "agent");
            asm volatile("s_waitcnt vmcnt(0)" ::: "memory");
        }
    }
    __syncthreads();
}


#ifndef PG8_SP2
#define PG8_SP2 true
#endif
#ifndef PG8_ALIGN
#define PG8_ALIGN true
#endif
constexpr int D = 1024, NB = 8, SEQ = 4096, T = NB * SEQ, NL = 4;
constexpr int NIN = 8704, NE = 32, FF = 1024;
constexpr int RMAX = 139264;
constexpr float LN_EPS = 1e-5f, DN_ALPHA = 1.681792830507429f;
constexpr float QSCALE = 0.18033688011112042f;
constexpr float LOG2E = 1.4426950408889634f;

constexpr size_t MiB = 1u << 20;
constexpr size_t WS_CTL = 0, CTL_ZERO_BYTES = 1 * MiB;
constexpr size_t WS_MOD = 1 * MiB;
constexpr size_t WS_ROPE = 2 * MiB;
constexpr size_t WS_WSP = 3 * MiB;
constexpr size_t WS_WRT = 4 * MiB;
constexpr size_t WS_TOKINFO = 5 * MiB;
constexpr size_t WS_TOKW = 5 * MiB + 512 * 1024;
constexpr size_t WS_ROWTOK = 6 * MiB;
constexpr size_t WS_ROWW = 7 * MiB;
constexpr size_t WS_LSE = 8 * MiB;
constexpr size_t WS_TOKROW = 14 * MiB;
constexpr size_t WS_STAT = 13 * MiB;
constexpr size_t WS_WGCNT = 12 * MiB;
constexpr size_t WS_WIN = 16 * MiB;
constexpr size_t WS_WBA = 84 * MiB;
constexpr size_t WS_WBB = 92 * MiB;
constexpr size_t WS_WOUT = 96 * MiB;
constexpr size_t WS_WUP = 104 * MiB;
constexpr size_t WS_WDN = 616 * MiB;
constexpr size_t WS_H = 872 * MiB;
constexpr size_t WS_X1 = 936 * MiB;
constexpr size_t WS_X2 = 1064 * MiB;
constexpr size_t WS_YPRE = 1192 * MiB;
constexpr size_t WS_U = 1320 * MiB, WS_V = 1384 * MiB;
constexpr size_t WS_Q = 1448 * MiB, WS_K = 1544 * MiB, WS_VV = 1640 * MiB;
constexpr size_t WS_G = 1736 * MiB;
constexpr size_t WS_OG = 1864 * MiB;
constexpr size_t WS_TT = 1960 * MiB;
constexpr size_t WS_OB = 2024 * MiB;
constexpr size_t WS_YA = 2056 * MiB;
constexpr size_t WS_MG = 2120 * MiB;
constexpr size_t WS_XG = 2184 * MiB;
constexpr size_t WS_ACT = 2456 * MiB;
constexpr size_t WS_YK = 2728 * MiB;
constexpr size_t WS_END = 2984 * MiB;
constexpr int CW_BAR = 4096;
constexpr int CW_CNT = 16384;

constexpr int RING_BYTES = 131072;
constexpr int XOFF = RING_BYTES;
constexpr int X_MISC = XOFF;
constexpr int X_SELE = XOFF + 256;
constexpr int X_SELR = XOFF + 2304;
constexpr int X_CNTL = XOFF + 4352;
constexpr int X_BASE = XOFF + 4480;
constexpr int X_TILEE = XOFF + 4608;
constexpr int X_CNTS = XOFF + 5632;
constexpr int X_OFFS = XOFF + 5760;
constexpr int LDS_BYTES = 147456;

#define GAS __attribute__((address_space(1)))
typedef unsigned short bf16;
typedef unsigned v4u __attribute__((ext_vector_type(4)));
typedef unsigned v2u __attribute__((ext_vector_type(2)));
typedef float f32x4 __attribute__((ext_vector_type(4)));
typedef short bf16x8 __attribute__((ext_vector_type(8)));
typedef short s16x4 __attribute__((ext_vector_type(4)));
#define RLX_AGENT __ATOMIC_RELAXED, __HIP_MEMORY_SCOPE_AGENT
#define LDS_WAIT() asm volatile("s_waitcnt lgkmcnt(0)" ::: "memory")
#define VM_WAIT() asm volatile("s_waitcnt vmcnt(0)" ::: "memory")

typedef __bf16 bf16x2_t __attribute__((ext_vector_type(2))); typedef float f32x2_t __attribute__((ext_vector_type(2)));
__device__ __forceinline__ unsigned pk2(float lo, float hi) { return __builtin_bit_cast(unsigned, __builtin_convertvector((f32x2_t){lo, hi}, bf16x2_t)); }
__device__ __forceinline__ float bflo(unsigned w) { return __uint_as_float(w << 16); }
__device__ __forceinline__ float bfhi(unsigned w) { return __uint_as_float(w & 0xffff0000u); }
__device__ __forceinline__ float fexp2(float x) { return __builtin_amdgcn_exp2f(x); }
__device__ __forceinline__ float frcp(float x) { return __builtin_amdgcn_rcpf(x); }
__device__ __forceinline__ float gelu_tanh(float x) { const float u = x + 0.044715f * x * x * x; return x * frcp(1.0f + fexp2(-2.302208198144325f * u)); }
__device__ __forceinline__ float sigmoidf_(float x) { return frcp(1.0f + fexp2(-LOG2E * x)); }
__device__ __forceinline__ float wave_sum(float v) {
#pragma unroll
    for (int o = 1; o < 64; o <<= 1) v += __shfl_xor(v, o);
    return v;
}
__device__ __forceinline__ float wave_max(float v) {
#pragma unroll
    for (int o = 1; o < 64; o <<= 1) v = fmaxf(v, __shfl_xor(v, o));
    return v;
}
__device__ __forceinline__ s16x4 tr16(const LAS unsigned char* p) { return __builtin_bit_cast(s16x4, __builtin_amdgcn_ds_read_tr16_b64_v4i16((LAS s16x4*)p)); }
__device__ __forceinline__ bf16x8 cat8(s16x4 lo, s16x4 hi) { return (bf16x8){lo[0], lo[1], lo[2], lo[3], hi[0], hi[1], hi[2], hi[3]}; }
__device__ __forceinline__ f32x4 mfma16(bf16x8 a, bf16x8 b, f32x4 c) { return __builtin_amdgcn_mfma_f32_16x16x32_bf16(a, b, c, 0, 0, 0); }

struct Frame {
    LAS unsigned char* lds;
    int tid, lane, wave, G, vcu, bx;
    unsigned char* ws;
    const float* const* in;
    float* out;
};
enum { I_X = 0, I_C, I_WADA, I_BADA, I_WIN, I_SPW, I_SPB, I_WBA, I_WBB, I_WOUT, I_LN1G, I_LN1B, I_WR, I_BR, I_WUP, I_BUP, I_WDN, I_BDN, I_LN2G, I_LN2B };
template <class Tp> __device__ __forceinline__ Tp* wsp(const Frame& F, size_t off) { return (Tp*)(F.ws + off); }

template <class P> __device__ __forceinline__ P launder(P p) { unsigned lo = (unsigned)(uintptr_t)p, hi = (unsigned)((uintptr_t)p >> 32); asm volatile("" : "+v"(lo), "+v"(hi));
    lo = (unsigned)__builtin_amdgcn_readfirstlane((int)lo); hi = (unsigned)__builtin_amdgcn_readfirstlane((int)hi); return (P)(((uintptr_t)hi << 32) | (uintptr_t)lo); }
__device__ __forceinline__ unsigned fl_x8(unsigned v) { return (unsigned)__builtin_amdgcn_update_dpp(0, (int)v, 0x128, 0xf, 0xf, false); }
#ifndef FLNT
#define FLNT true
#endif
template <bool NT> __device__ __forceinline__ void fl_put(bf16* p, size_t ld, bool lo, const v4u& w0, const v4u& w1) {
    v4u sd; sd.x = lo ? w1.x : w0.x; sd.y = lo ? w1.y : w0.y; sd.z = lo ? w1.z : w0.z; sd.w = lo ? w1.w : w0.w;
    v4u rc; rc.x = fl_x8(sd.x); rc.y = fl_x8(sd.y); rc.z = fl_x8(sd.z); rc.w = fl_x8(sd.w);
    v4u oa, ob; oa.x = lo ? w0.x : rc.x; oa.y = lo ? w0.y : rc.y; oa.z = lo ? w0.z : rc.z; oa.w = lo ? w0.w : rc.w;
    ob.x = lo ? rc.x : w1.x; ob.y = lo ? rc.y : w1.y; ob.z = lo ? rc.z : w1.z; ob.w = lo ? rc.w : w1.w;
    if (NT) { __builtin_nontemporal_store(oa, (v4u*)p); __builtin_nontemporal_store(ob, (v4u*)(p + 8 * ld)); } else { *(v4u*)p = oa; *(v4u*)(p + 8 * ld) = ob; } }
struct EpiIn {
    static constexpr int MID_T = 0; static constexpr bool PERM = true, AFTER_DRAIN = false, BADJ = true, ABLK = true;
    bf16 *U, *V, *Q, *K, *VV, *Gt; const float* rope;
    __device__ __forceinline__ void operator()(const f32x4 (&acc)[2][2][4][2], const pg8::Unit& u, int wr, int wc, int fr, int fq) const {
        const int pn = u.pn; int type, ld, colt; bf16* base;
        if (pn < 4) { type = 0; base = U; ld = 1024; colt = pn * 256; }
        else if (pn < 8) { type = 0; base = V; ld = 1024; colt = (pn - 4) * 256; }
        else if (pn < 14) { type = 1; base = Q; ld = 1536; colt = (pn - 8) * 256; }
        else if (pn < 20) { type = 2; base = K; ld = 1536; colt = (pn - 14) * 256; }
        else if (pn < 26) { type = 3; base = VV; ld = 1536; colt = (pn - 20) * 256; }
        else { type = 4; base = Gt; ld = 2048; colt = (pn - 26) * 256; }
        const bool lo = fr < 8;
        const int rowl = u.pm * 256 + wr * 64 + fr;
        bf16* const pst = base + (size_t)(u.pm * 256 + wr * 64 + (fr & 7)) * ld + colt + wc * 64 + (fr >> 3) * 32 + 8 * fq;
        if (type == 0) {
#pragma unroll
            for (int ai = 0; ai < 2; ++ai)
#pragma unroll
                for (int m = 0; m < 4; ++m) { v4u w[2];
#pragma unroll
                    for (int bj = 0; bj < 2; ++bj) { const f32x4 v0 = acc[ai][bj][m][0], v1 = acc[ai][bj][m][1];
                        w[bj].x = pk2(gelu_tanh(v0[0]), gelu_tanh(v0[1])); w[bj].y = pk2(gelu_tanh(v0[2]), gelu_tanh(v0[3]));
                        w[bj].z = pk2(gelu_tanh(v1[0]), gelu_tanh(v1[1])); w[bj].w = pk2(gelu_tanh(v1[2]), gelu_tanh(v1[3])); }
                    fl_put<true>(pst + (size_t)(ai * 128 + m * 16) * ld, ld, lo, w[0], w[1]); }
        } else if (type == 4) {
#pragma unroll
            for (int ai = 0; ai < 2; ++ai)
#pragma unroll
                for (int m = 0; m < 4; ++m) { v4u w[2];
#pragma unroll
                    for (int bj = 0; bj < 2; ++bj) { const f32x4 v0 = acc[ai][bj][m][0], v1 = acc[ai][bj][m][1];
                        w[bj].x = pk2(sigmoidf_(v0[0]), sigmoidf_(v0[1])); w[bj].y = pk2(sigmoidf_(v0[2]), sigmoidf_(v0[3]));
                        w[bj].z = pk2(sigmoidf_(v1[0]), sigmoidf_(v1[1])); w[bj].w = pk2(sigmoidf_(v1[2]), sigmoidf_(v1[3])); }
                    fl_put<true>(pst + (size_t)(ai * 128 + m * 16) * ld, ld, lo, w[0], w[1]); }
        } else if (type == 3) {
#pragma unroll
            for (int ai = 0; ai < 2; ++ai)
#pragma unroll
                for (int m = 0; m < 4; ++m) { v4u w[2];
#pragma unroll
                    for (int bj = 0; bj < 2; ++bj) { const f32x4 v0 = acc[ai][bj][m][0], v1 = acc[ai][bj][m][1];
                        w[bj].x = pk2(v0[0], v0[1]); w[bj].y = pk2(v0[2], v0[3]); w[bj].z = pk2(v1[0], v1[1]); w[bj].w = pk2(v1[2], v1[3]); }
                    fl_put<true>(pst + (size_t)(ai * 128 + m * 16) * ld, ld, lo, w[0], w[1]); }
        } else {
            const float sc = (type == 1) ? QSCALE : 1.0f;
#pragma unroll
            for (int ai = 0; ai < 2; ++ai)
#pragma unroll
                for (int m = 0; m < 4; ++m) { const int row = rowl + ai * 128 + m * 16;
                    const f32x4* rp = (const f32x4*)(rope + (size_t)(row & (SEQ - 1)) * 16); const f32x4 c0 = rp[0], c1 = rp[1], s0 = rp[2], s1 = rp[3];
                    float cs[8], sn[8];
#pragma unroll
                    for (int e = 0; e < 4; ++e) { cs[e] = c0[e]; cs[4 + e] = c1[e]; sn[e] = s0[e]; sn[4 + e] = s1[e]; }
                    v4u w[2];
#pragma unroll
                    for (int bj = 0; bj < 2; ++bj) { f32x4 v0 = acc[ai][bj][m][0], v1 = acc[ai][bj][m][1];
                        if (bj == 0) {
#pragma unroll
                            for (int e = 0; e < 8; ++e) { const float x = (e < 4) ? v0[e & 3] : v1[e & 3]; const float p = __shfl_xor(x, 16);
                                float y = x;
                                if (fq == 0) y = x * cs[e] - p * sn[e];
                                if (fq == 1) y = x * cs[e] + p * sn[e];
                                if (e < 4) v0[e & 3] = y; else v1[e & 3] = y; } }
                        w[bj].x = pk2(v0[0] * sc, v0[1] * sc); w[bj].y = pk2(v0[2] * sc, v0[3] * sc); w[bj].z = pk2(v1[0] * sc, v1[1] * sc); w[bj].w = pk2(v1[2] * sc, v1[3] * sc); }
                    fl_put<true>(pst + (size_t)(ai * 128 + m * 16) * ld, ld, lo, w[0], w[1]); }
        }
    }
};
struct EpiProbe {
    static constexpr int MID_T = 0; static constexpr bool PERM = true, AFTER_DRAIN = false, BADJ = false, ABLK = false;
    bf16* O; int ld; int on;
    __device__ __forceinline__ void operator()(const f32x4 (&acc)[2][2][4][2], const pg8::Unit& u, int wr, int wc, int fr, int fq) const {
        if (!on) return;
        const int row0 = u.pm * 256 + wr * 64 + fr, col0 = ((on == 3) ? u.pn : (u.pn & 3)) * 256 + wc * 32 + 8 * fq;
#pragma unroll
        for (int ai = 0; ai < 2; ++ai)
#pragma unroll
            for (int m = 0; m < 4; ++m) { bf16* rowp = O + (size_t)(row0 + ai * 128 + m * 16) * ld + col0;
#pragma unroll
                for (int bj = 0; bj < 2; ++bj) { const f32x4 v0 = acc[ai][bj][m][0], v1 = acc[ai][bj][m][1]; v4u w;
                    w.x = pk2(v0[0], v0[1]); w.y = pk2(v0[2], v0[3]); w.z = pk2(v1[0], v1[1]); w.w = pk2(v1[2], v1[3]);
                    *(v4u*)(rowp + bj * 128) = w; } }
    }
};
struct EpiYA {
    static constexpr int MID_T = 0; static constexpr bool PERM = true, AFTER_DRAIN = false, BADJ = false, ABLK = false;
    const bf16* Gt; bf16* YA;
    __device__ __forceinline__ void operator()(const f32x4 (&acc)[2][2][4][2], const pg8::Unit& u, int wr, int wc, int fr, int fq) const {
        const int row0 = u.pm * 256 + wr * 64 + fr, col0 = u.pn * 256 + wc * 32 + 8 * fq;
#pragma unroll
        for (int ai = 0; ai < 2; ++ai)
#pragma unroll
            for (int m = 0; m < 4; ++m) { const size_t row = (size_t)(row0 + ai * 128 + m * 16);
#pragma unroll
                for (int bj = 0; bj < 2; ++bj) { const f32x4 v0 = acc[ai][bj][m][0], v1 = acc[ai][bj][m][1];
                    const v4u g = *(const v4u*)(Gt + row * 2048 + col0 + bj * 128); v4u w;
                    w.x = pk2(v0[0] * bflo(g.x), v0[1] * bfhi(g.x)); w.y = pk2(v0[2] * bflo(g.y), v0[3] * bfhi(g.y));
                    w.z = pk2(v1[0] * bflo(g.z), v1[1] * bfhi(g.z)); w.w = pk2(v1[2] * bflo(g.w), v1[3] * bfhi(g.w));
                    *(v4u*)(YA + row * 1024 + col0 + bj * 128) = w; } }
    }
};
struct EpiMg {
    static constexpr int MID_T = 0; static constexpr bool PERM = true, AFTER_DRAIN = false, BADJ = false, ABLK = false;
    const bf16* Gt; const bf16* YA; bf16* MG;
    __device__ __forceinline__ void operator()(const f32x4 (&acc)[2][2][4][2], const pg8::Unit& u, int wr, int wc, int fr, int fq) const {
        const int row0 = u.pm * 256 + wr * 64 + fr, col0 = u.pn * 256 + wc * 32 + 8 * fq;
#pragma unroll
        for (int ai = 0; ai < 2; ++ai)
#pragma unroll
            for (int m = 0; m < 4; ++m) { const size_t row = (size_t)(row0 + ai * 128 + m * 16);
#pragma unroll
                for (int bj = 0; bj < 2; ++bj) { const f32x4 v0 = acc[ai][bj][m][0], v1 = acc[ai][bj][m][1];
                    const v4u g = *(const v4u*)(Gt + row * 2048 + 1024 + col0 + bj * 128); const v4u y = *(const v4u*)(YA + row * 1024 + col0 + bj * 128); v4u w;
                    w.x = pk2(bflo(y.x) + v0[0] * bflo(g.x), bfhi(y.x) + v0[1] * bfhi(g.x)); w.y = pk2(bflo(y.y) + v0[2] * bflo(g.y), bfhi(y.y) + v0[3] * bfhi(g.y));
                    w.z = pk2(bflo(y.z) + v1[0] * bflo(g.z), bfhi(y.z) + v1[1] * bfhi(g.z)); w.w = pk2(bflo(y.w) + v1[2] * bflo(g.w), bfhi(y.w) + v1[3] * bfhi(g.w));
                    *(v4u*)(MG + row * 1024 + col0 + bj * 128) = w; } }
    }
};
struct EpiMg2 {
    static constexpr int MID_T = 16; static constexpr bool PERM = true, AFTER_DRAIN = false, BADJ = true, ABLK = false;
    const bf16* Gt; bf16* MG;
    __device__ __forceinline__ void mid(f32x4 (&acc)[2][2][4][2], const pg8::Unit& u, int wr, int wc, int fr, int fq) const {
        int row0 = u.pm * 256 + wr * 64 + fr; const int col0 = u.pn * 256 + wc * 64 + 8 * fq;
        asm volatile("" : "+v"(row0));
#pragma unroll
        for (int ai = 0; ai < 2; ++ai)
#pragma unroll
            for (int m = 0; m < 4; ++m) { const size_t row = (size_t)(row0 + ai * 128 + m * 16);
#pragma unroll
                for (int bj = 0; bj < 2; ++bj) { const v4u g0 = *(const v4u*)(Gt + row * 2048 + col0 + bj * 32), g1 = *(const v4u*)(Gt + row * 2048 + 1024 + col0 + bj * 32);
                    const unsigned a0[4] = {g0.x, g0.y, g0.z, g0.w}, a1[4] = {g1.x, g1.y, g1.z, g1.w};
#pragma unroll
                    for (int q = 0; q < 4; ++q) { const float r0 = bflo(a0[q]) * frcp(fmaxf(bflo(a1[q]), 1e-20f)), r1 = bfhi(a0[q]) * frcp(fmaxf(bfhi(a1[q]), 1e-20f));
                        acc[ai][bj][m][q >> 1][(q & 1) * 2] *= r0; acc[ai][bj][m][q >> 1][(q & 1) * 2 + 1] *= r1; } }
                if (m == 3) asm volatile("" ::: "memory"); }
    }
    __device__ __forceinline__ void operator()(const f32x4 (&acc)[2][2][4][2], const pg8::Unit& u, int wr, int wc, int fr, int fq) const {
        const int row0 = u.pm * 256 + wr * 64 + fr, col0 = u.pn * 256 + wc * 64 + 8 * fq; const bool lo = fr < 8;
        bf16* const pst = MG + (size_t)(u.pm * 256 + wr * 64 + (fr & 7)) * 1024 + u.pn * 256 + wc * 64 + (fr >> 3) * 32 + 8 * fq;
#pragma unroll
        for (int ai = 0; ai < 2; ++ai)
#pragma unroll
            for (int m = 0; m < 4; ++m) { const size_t row = (size_t)(row0 + ai * 128 + m * 16); v4u w[2];
#pragma unroll
                for (int bj = 0; bj < 2; ++bj) { const f32x4 v0 = acc[ai][bj][m][0], v1 = acc[ai][bj][m][1];
                    const v4u g = *(const v4u*)(Gt + row * 2048 + 1024 + col0 + bj * 32);
                    w[bj].x = pk2(v0[0] * fmaxf(bflo(g.x), 1e-20f), v0[1] * fmaxf(bfhi(g.x), 1e-20f)); w[bj].y = pk2(v0[2] * fmaxf(bflo(g.y), 1e-20f), v0[3] * fmaxf(bfhi(g.y), 1e-20f));
                    w[bj].z = pk2(v1[0] * fmaxf(bflo(g.z), 1e-20f), v1[1] * fmaxf(bfhi(g.z), 1e-20f)); w[bj].w = pk2(v1[2] * fmaxf(bflo(g.w), 1e-20f), v1[3] * fmaxf(bfhi(g.w), 1e-20f)); }
                fl_put<false>(pst + (size_t)(ai * 128 + m * 16) * 1024, 1024, lo, w[0], w[1]); }
    }
};
template <bool XF32> struct EpiOut {
    static constexpr int MID_T = 0; static constexpr bool PERM = true, AFTER_DRAIN = false, BADJ = true, ABLK = false;
    const void* xres; const float* modl  ; bf16* YPRE;
    __device__ __forceinline__ void operator()(const f32x4 (&acc)[2][2][4][2], const pg8::Unit& u, int wr, int wc, int fr, int fq) const {
        const int row0 = u.pm * 256 + wr * 64 + fr, col0 = u.pn * 256 + wc * 64 + 8 * fq; const int b = (u.pm * 256) >> 12; const bool lo = fr < 8;
        bf16* const pst = YPRE + (size_t)(u.pm * 256 + wr * 64 + (fr & 7)) * 1024 + u.pn * 256 + wc * 64 + (fr >> 3) * 32 + 8 * fq;
        f32x4 gg[2][2];
#pragma unroll
        for (int bj = 0; bj < 2; ++bj)
#pragma unroll
            for (int n = 0; n < 2; ++n) gg[bj][n] = *(const f32x4*)(modl + (size_t)b * 6144 + 2048 + col0 + bj * 32 + 4 * n) + 1.0f;
#pragma unroll
        for (int ai = 0; ai < 2; ++ai)
#pragma unroll
            for (int m = 0; m < 4; ++m) { const size_t off = (size_t)(row0 + ai * 128 + m * 16) * 1024 + col0; v4u w[2];
#pragma unroll
                for (int bj = 0; bj < 2; ++bj) { f32x4 x0, x1;
                    if (XF32) { x0 = *(const f32x4*)((const float*)xres + off + bj * 32); x1 = *(const f32x4*)((const float*)xres + off + bj * 32 + 4); }
                    else { const v4u xr = *(const v4u*)((const bf16*)xres + off + bj * 32); x0 = (f32x4){bflo(xr.x), bfhi(xr.x), bflo(xr.y), bfhi(xr.y)}; x1 = (f32x4){bflo(xr.z), bfhi(xr.z), bflo(xr.w), bfhi(xr.w)}; }
                    const f32x4 o0 = x0 * DN_ALPHA + gg[bj][0] * acc[ai][bj][m][0], o1 = x1 * DN_ALPHA + gg[bj][1] * acc[ai][bj][m][1];
                    w[bj].x = pk2(o0[0], o0[1]); w[bj].y = pk2(o0[2], o0[3]); w[bj].z = pk2(o1[0], o1[1]); w[bj].w = pk2(o1[2], o1[3]); }
                fl_put<false>(pst + (size_t)(ai * 128 + m * 16) * 1024, 1024, lo, w[0], w[1]);
                if (m == 3) asm volatile("" ::: "memory"); }
    }
};
#ifndef ACT_NT
#define ACT_NT 1
#endif
struct EpiUp {
    static constexpr int MID_T = 0; static constexpr bool PERM = true, AFTER_DRAIN = false, BADJ = false, ABLK = false;
    const float* bup  ; bf16* ACT;
    __device__ __forceinline__ void operator()(const f32x4 (&acc)[2][2][4][2], const pg8::Unit& u, int wr, int wc, int fr, int fq) const {
        const int e = u.pn >> 3, pnl = u.pn & 7; const int row0 = u.pm * 256 + wr * 64 + fr, ac0 = pnl * 128 + wc * 32 + 8 * fq;
        const f32x4* bp = (const f32x4*)(bup + (size_t)e * 2048 + 2 * ac0); const f32x4 b0 = bp[0], b1 = bp[1], b2 = bp[2], b3 = bp[3];
        const float bg[8] = {b0[0], b0[2], b1[0], b1[2], b2[0], b2[2], b3[0], b3[2]}, bl[8] = {b0[1], b0[3], b1[1], b1[3], b2[1], b2[3], b3[1], b3[3]};
#pragma unroll
        for (int ai = 0; ai < 2; ++ai)
#pragma unroll
            for (int m = 0; m < 4; ++m) { float a[8];
#pragma unroll
                for (int j = 0; j < 8; ++j) { const float hg = acc[ai][0][m][j >> 2][j & 3] + bg[j], hl = acc[ai][1][m][j >> 2][j & 3] + bl[j];
                    const float glu = fminf(hg, 7.0f), lin = fminf(fmaxf(hl, -7.0f), 7.0f);
                    a[j] = glu * frcp(1.0f + fexp2(-2.4554669595930156f * glu)) * (lin + 1.0f); }
                v4u w; w.x = pk2(a[0], a[1]); w.y = pk2(a[2], a[3]); w.z = pk2(a[4], a[5]); w.w = pk2(a[6], a[7]);
                { const size_t g16 = (size_t)((u.pm * 256 + wr * 64 + ai * 128 + m * 16) >> 4); unsigned char* lp = (unsigned char*)ACT + ((g16 * 32 + (size_t)(pnl * 4 + wc)) * 8 + (fr & 7)) * 128 + (fr >> 3) * 64 + 16 * fq;
                  if (ACT_NT) __builtin_nontemporal_store(w, (v4u*)lp); else *(v4u*)lp = w; } }
    }
};
struct EpiDn {
    static constexpr int MID_T = 0; static constexpr bool PERM = true, AFTER_DRAIN = false, BADJ = true, ABLK = true;
    const float* bdn  ; bf16* YKS;
    __device__ __forceinline__ void operator()(const f32x4 (&acc)[2][2][4][2], const pg8::Unit& u, int wr, int wc, int fr, int fq) const {
        const int e = u.pn >> 2, pnl = u.pn & 3; const int col0 = pnl * 256 + wc * 64 + 8 * fq; const bool lo = fr < 8;
        bf16* const pst = YKS + (size_t)(u.pm * 256 + wr * 64 + (fr & 7)) * 1024 + pnl * 256 + wc * 64 + (fr >> 3) * 32 + 8 * fq;
        f32x4 bv[2][2];
#pragma unroll
        for (int bj = 0; bj < 2; ++bj)
#pragma unroll
            for (int n = 0; n < 2; ++n) bv[bj][n] = *(const f32x4*)(bdn + (size_t)e * 1024 + col0 + bj * 32 + 4 * n);
#pragma unroll
        for (int ai = 0; ai < 2; ++ai)
#pragma unroll
            for (int m = 0; m < 4; ++m) { v4u w[2];
#pragma unroll
                for (int bj = 0; bj < 2; ++bj) { const f32x4 v0 = acc[ai][bj][m][0] + bv[bj][0], v1 = acc[ai][bj][m][1] + bv[bj][1];
                    w[bj].x = pk2(v0[0], v0[1]); w[bj].y = pk2(v0[2], v0[3]); w[bj].z = pk2(v1[0], v1[1]); w[bj].w = pk2(v1[2], v1[3]); }
                fl_put<FLNT>(pst + (size_t)(ai * 128 + m * 16) * 1024, 1024, lo, w[0], w[1]); }
    }
};
struct MoeOrder {
    static constexpr bool GATHER = false; __device__ __forceinline__ int arow(int, int r) const { return r; }
    int nM, nN, nwg, G, c, rev; const LAS unsigned char* tile_e;
    __device__ void init(int RT, int NN, int G_, int c_, const LAS unsigned char* te, int rev_ = 0) { nM = RT; nN = NN; nwg = RT * NN; G = G_; c = c_; tile_e = te; rev = rev_; }
    __device__ bool next(int i, pg8::Unit& u) const {
        const long L = (long)i * G + c; if (L >= nwg) return false;
        int wgid = (int)L; { const int q = nwg / pg8::NXCD, r = nwg % pg8::NXCD, xcd = wgid % pg8::NXCD, off = wgid / pg8::NXCD; wgid = (xcd < r ? xcd * (q + 1) : r * (q + 1) + (xcd - r) * q) + off; }
        const int nig = pg8::WGM * nN, gid = wgid / nig, fm = gid * pg8::WGM, gsz = (nM - fm) < pg8::WGM ? (nM - fm) : pg8::WGM;
        int pm = fm + ((wgid % nig) % gsz); const int pnl = (wgid % nig) / gsz; if (rev) pm = nM - 1 - pm;
        u.pm = pm; u.pn = (int)tile_e[pm] * nN + pnl; return true;
    }
    __device__ __forceinline__ void a_ready(const pg8::Unit&) const {}
    __device__ __forceinline__ void done(const pg8::Unit&) const {}
};

#ifndef STAG_N
#define STAG_N 1
#endif
#ifndef STAG_US
#define STAG_US 24
#endif
__device__ __forceinline__ void stagger(int slot, int us) {
    if (STAG_N <= 1) return;
    const unsigned long long t0 = __builtin_amdgcn_s_memrealtime(); const unsigned long long ticks = (unsigned long long)(slot % STAG_N) * (unsigned)us * 100ull / STAG_N;
    while (__builtin_amdgcn_s_memrealtime() - t0 < ticks) __builtin_amdgcn_s_sleep(16);
}
struct MoeGatherOrder : MoeOrder {
    static constexpr bool GATHER = true; const LAS unsigned short* tokl;
    __device__ __forceinline__ int arow(int ord, int r) const { return (int)tokl[ord * 256 + (r & 255)]; }
};
constexpr int X_TOKL = XOFF + 6144, TOKL_UNITS = 20;
constexpr int TR_NR = 32, TR_WAVE_BYTES = 64 * 64 * 4;
struct TrItem { const float* src; bf16* dst; int ld, K, kind, k0, c0, koff; };
__device__ __forceinline__ void tr_load(const TrItem& t, int lane, f32x4 (&r)[TR_NR]) {
    const int kq = lane >> 4, cc = lane & 15;
#pragma unroll
    for (int i = 0; i < TR_NR; ++i) r[i] = __builtin_nontemporal_load((const f32x4*)(t.src + (size_t)(t.k0 + 2 * (kq + 4 * (i >> 1)) + (i & 1)) * t.ld + t.c0 + 4 * cc));
}
__device__ __forceinline__ void tr_tile(int lane, LAS unsigned* scr, const f32x4 (&r)[TR_NR]) {
    const int kq = lane >> 4, cc = lane & 15;
#pragma unroll
    for (int i2 = 0; i2 < TR_NR / 2; ++i2) { LAS unsigned* p = scr + (4 * cc) * 64 + ((kq + 4 * i2) ^ (cc << 2));
#pragma unroll
        for (int e = 0; e < 4; ++e) p[e * 64] = pk2(r[2 * i2][e], r[2 * i2 + 1][e]); }
    LDS_WAIT(); asm volatile("" ::: "memory");
}
__device__ __forceinline__ void tr_store(const TrItem& t, int lane, const LAS unsigned* scr) {
    const int line = lane >> 3, half = (lane >> 2) & 1, piece = lane & 3;
    const int pbase = (t.kind == 0) ? t.c0 : (256 * (t.c0 >> 8) + ((t.c0 & 255) >> 1));
    const int kb0 = (t.koff + t.k0) >> 5, KB = t.K >> 5;
#pragma unroll
    for (int j = 0; j < 16; ++j) { const int q = 16 * (j >> 2) + line + 8 * half, cb = j & 3, c = 4 * cb + piece;
        const int n = (t.kind == 0) ? q : (2 * (q & 31) + (q >> 5)); const int drow = (t.kind == 0) ? (pbase + q) : (pbase + 128 * (q >> 5) + (q & 31));
        const v4u o = *(const LAS v4u*)(scr + n * 64 + ((c ^ ((n >> 2) & 15)) << 2));
        unsigned char* dp = (unsigned char*)t.dst + ((size_t)((drow >> 4) * KB + kb0 + cb) * 8 + (drow & 7)) * 128 + ((drow >> 3) & 1) * 64 + piece * 16;
        __builtin_nontemporal_store(o, (v4u*)dp); }
    LDS_WAIT(); asm volatile("" ::: "memory");
}
__device__ __forceinline__ void sincos_d(double a, double& s, double& c) {
    const double k = rint(a * 0.63661977236758134308);
    const double y = fma(-k, 6.12323399573676603587e-17, fma(-k, 1.57079632679489655800, a));
    const double y2 = y * y;
    double sp = -7.6471637318198164759e-13; sp = fma(sp, y2, 1.6059043836821614599e-10); sp = fma(sp, y2, -2.5052108385441718775e-8); sp = fma(sp, y2, 2.7557319223985890653e-6);
    sp = fma(sp, y2, -1.9841269841269841270e-4); sp = fma(sp, y2, 8.3333333333333333333e-3); sp = fma(sp, y2, -1.6666666666666666667e-1); const double sy = fma(sp * y2, y, y);
    double cp = 4.7794773323873852974e-14; cp = fma(cp, y2, -1.1470745597729724714e-11); cp = fma(cp, y2, 2.0876756987868098979e-9); cp = fma(cp, y2, -2.7557319223985890653e-7);
    cp = fma(cp, y2, 2.4801587301587301587e-5); cp = fma(cp, y2, -1.3888888888888888889e-3); cp = fma(cp, y2, 4.1666666666666666667e-2); cp = fma(cp, y2, -0.5); const double cy = fma(cp, y2, 1.0);
    const int q = ((int)k) & 3;
    s = (q == 0) ? sy : (q == 1) ? cy : (q == 2) ? -sy : -cy;
    c = (q == 0) ? cy : (q == 1) ? -sy : (q == 2) ? -cy : sy;
}
__device__ __forceinline__ void phase_pro_a(Frame& F) {
    LAS unsigned* scr = (LAS unsigned*)(F.lds + F.wave * TR_WAVE_BYTES);
    const int gw = F.vcu * 8 + F.wave, NGW = F.G * 8;
    constexpr int I_IN = 8 * 136, I_SQ = 8 * 16, I_BB = 4 * 16, I_UP = 8 * 32;
    constexpr int S0 = NL * I_IN, S1 = S0 + NL * I_SQ, S2 = S1 + NL * I_BB, S3 = S2 + NL * I_SQ, S4 = S3 + NL * NE * I_SQ, S5 = S4 + NL * NE * I_UP;
    auto decode = [&](int it) -> TrItem { TrItem t; t.koff = 0;
        if (it < S0) { const int l = it / I_IN, r = it % I_IN; t.src = F.in[I_WIN] + (size_t)l * D * NIN; t.dst = wsp<bf16>(F, WS_WIN) + (size_t)l * NIN * D; t.ld = NIN; t.K = D; t.kind = 0; t.k0 = 128 * (r / 136); t.c0 = 64 * (r % 136); }
        else if (it < S1) { const int q = it - S0, l = q / I_SQ, r = q % I_SQ; t.src = F.in[I_WBA] + (size_t)l * D * D; t.dst = wsp<bf16>(F, WS_WBA) + (size_t)l * D * 1536; t.ld = D; t.K = 1536; t.kind = 0; t.k0 = 128 * (r / 16); t.c0 = 64 * (r % 16); }
        else if (it < S2) { const int q = it - S1, l = q / I_BB, r = q % I_BB; t.src = F.in[I_WBB] + (size_t)l * 512 * D; t.dst = wsp<bf16>(F, WS_WBA) + (size_t)l * D * 1536; t.ld = D; t.K = 1536; t.koff = 1024; t.kind = 0; t.k0 = 128 * (r / 16); t.c0 = 64 * (r % 16); }
        else if (it < S3) { const int q = it - S2, l = q / I_SQ, r = q % I_SQ; t.src = F.in[I_WOUT] + (size_t)l * D * D; t.dst = wsp<bf16>(F, WS_WOUT) + (size_t)l * D * D; t.ld = D; t.K = D; t.kind = 0; t.k0 = 128 * (r / 16); t.c0 = 64 * (r % 16); }
        else if (it < S4) { const int q = it - S3, le = q / I_SQ, r = q % I_SQ; t.src = F.in[I_WDN] + (size_t)le * FF * D; t.dst = wsp<bf16>(F, WS_WDN) + (size_t)le * D * FF; t.ld = D; t.K = FF; t.kind = 0; t.k0 = 128 * (r / 16); t.c0 = 64 * (r % 16); }
        else { const int q = it - S4, le = q / I_UP, r = q % I_UP; t.src = F.in[I_WUP] + (size_t)le * D * 2048; t.dst = wsp<bf16>(F, WS_WUP) + (size_t)le * 2048 * D; t.ld = 2048; t.K = D; t.kind = 1; t.k0 = 128 * (r / 32); t.c0 = 64 * (r % 32); }
        return t; };
    {
        f32x4 rn[TR_NR]; TrItem tn; int it = gw;
        if (it < S5) { tn = decode(it); tr_load(tn, F.lane, rn); }
#pragma unroll 1
        for (; it < S5; it += NGW) {
            const TrItem tc = tn;
            tr_tile(F.lane, scr, rn);
            if (it + NGW < S5) { tn = decode(it + NGW); tr_load(tn, F.lane, rn); }
            tr_store(tc, F.lane, scr);
        }
    }
    __syncthreads();
    {
        LAS float* cT = (LAS float*)F.lds;
        LAS float* red = (LAS float*)(F.lds + 32768);
        const float* cv = F.in[I_C];
        for (int i = F.tid; i < 8 * 1024; i += 512) { const int bb = i >> 10, k = i & 1023; cT[k * 8 + bb] = cv[i]; }
        __syncthreads();
        const int hf = F.lane >> 5, c4 = F.lane & 31;
        for (int u = F.vcu; u < NL * 48; u += F.G) {
            const int l = u / 48, n0 = 128 * (u % 48);
            f32x4 a[8];
#pragma unroll
            for (int bb = 0; bb < 8; ++bb) a[bb] = (f32x4){0.f, 0.f, 0.f, 0.f};
            const int kb = F.wave * 128 + hf;
            const float* wp = F.in[I_WADA] + (size_t)l * D * 6144 + (size_t)kb * 6144 + n0 + 4 * c4;
#pragma unroll 8
            for (int kk = 0; kk < 64; ++kk) { const f32x4 w = *(const f32x4*)(wp + (size_t)(2 * kk) * 6144);
                const f32x4 c0 = *(const LAS f32x4*)(cT + (kb + 2 * kk) * 8), c1 = *(const LAS f32x4*)(cT + (kb + 2 * kk) * 8 + 4);
#pragma unroll
                for (int bb = 0; bb < 4; ++bb) { a[bb] += w * c0[bb]; a[4 + bb] += w * c1[bb]; } }
#pragma unroll
            for (int bb = 0; bb < 8; ++bb) *(LAS f32x4*)(red + ((F.wave * 2 + hf) * 8 + bb) * 128 + 4 * c4) = a[bb];
            __syncthreads();
#pragma unroll
            for (int q = 0; q < 2; ++q) { const int o = F.tid + 512 * q, bb = o >> 7, cn = o & 127; float sum = F.in[I_BADA][l * 6144 + n0 + cn];
#pragma unroll
                for (int p = 0; p < 16; ++p) sum += red[(p * 8 + bb) * 128 + cn];
                wsp<float>(F, WS_MOD)[(size_t)(l * 8 + bb) * 6144 + n0 + cn] = sum; }
            __syncthreads();
        }
    }
    const int gt = F.vcu * 512 + F.tid, NT = F.G * 512;
    for (int i = gt; i < SEQ * 8; i += NT) { const int pos = i >> 3, f = i & 7;
        const double inv = (f == 0) ? 1.0 : (f == 1) ? 0.19392274474868576 : (f == 2) ? 0.03760603093086393 : (f == 3) ? 0.007292664737217109 : (f == 4) ? 0.001414213562373095 : (f == 5) ? 0.0002742481756762073 : (f == 6) ? 5.318295896944988e-05 : 1.031338537721246e-05;
        double s, c; sincos_d((double)pos * inv, s, c);
        float* rp = wsp<float>(F, WS_ROPE) + (size_t)pos * 16; rp[f] = (float)c; rp[8 + f] = (float)s; }
    for (int i = gt; i < NL * 4 * 128 * 128; i += NT) { const int j = i & 127, ii = (i >> 7) & 127; const float w = F.in[I_SPW][i];
        wsp<bf16>(F, WS_WSP)[i] = (bf16)(pk2((j <= ii) ? w : 0.f, 0.f) & 0xffffu); }
    for (int i = gt; i < NL * NE * D; i += NT) { const int k = i & 1023, e = (i >> 10) & 31, l = i >> 15; const float w = F.in[I_WR][((size_t)l * D + k) * NE + e];
        const unsigned hi = pk2(w, 0.f) & 0xffffu; const float lo = w - __uint_as_float(hi << 16);
        wsp<bf16>(F, WS_WRT)[i] = (bf16)hi; wsp<bf16>(F, WS_WRT)[NL * NE * D + i] = (bf16)(pk2(lo, 0.f) & 0xffffu); }
}
__device__ __forceinline__ v2u* hblk(bf16* H, int m, int lane) { return (v2u*)((unsigned char*)H + ((size_t)((m >> 4) * 32 + (lane >> 3)) * 8 + (m & 7)) * 128 + ((m >> 3) & 1) * 64 + (lane & 7) * 8); }
__device__ __forceinline__ void phase_pro_b(Frame& F) {
    const int gw = F.vcu * 8 + F.wave, NGW = F.G * 8;
    const float* mod = wsp<float>(F, WS_MOD);
    for (int m = gw; m < T; m += NGW) { const int b = m >> 12; const float* mb = mod + (size_t)b * 6144;
        const f32x4* xr = (const f32x4*)(F.in[I_X] + (size_t)m * D) + F.lane; v2u* hp = hblk(wsp<bf16>(F, WS_H), m, F.lane);
#pragma unroll
        for (int j = 0; j < 4; ++j) { const f32x4 x = xr[64 * j]; const f32x4 sh = *((const f32x4*)mb + F.lane + 64 * j), sc = *((const f32x4*)(mb + 1024) + F.lane + 64 * j);
            const f32x4 h = x * (sc + 1.0f) + sh; v2u o; o.x = pk2(h[0], h[1]); o.y = pk2(h[2], h[3]); hp[1024 * j] = o; } }
}

constexpr int AT_RS = 144;
constexpr int AT_ROWS = 400, AT_VOFF = AT_ROWS * AT_RS;
#define LDS_BARRIER() do { asm volatile("s_waitcnt lgkmcnt(0)" ::: "memory"); __builtin_amdgcn_s_barrier(); asm volatile("" ::: "memory"); } while (0)
struct AtUnit { int g, b, h, r, n, d; size_t hoff; };
__device__ __forceinline__ AtUnit at_decode(int u) { AtUnit a; a.g = u >> 10; const int rem = u & 1023; a.b = rem >> 7; a.h = (rem >> 4) & 7; const int rn = rem & 15;
    const int dsh = 2 * a.g, nbs = 4 - dsh; a.d = 1 << dsh; a.r = rn >> nbs; a.n = 2 * (rn & ((1 << nbs) - 1)); a.hoff = (size_t)a.g * 512 + a.h * 64; return a; }
constexpr int AT_NU = 3 * 1024;
struct AtSlot { v4u k[6], v[6]; bf16x8 q0, q1, q2, q3; };
struct AtCtx { const bf16 *Qb, *Kb, *Vb; bf16* OG; float* LSE; LAS unsigned char *Ks, *Vs; int qi, g4, piece, jr; };
__device__ __forceinline__ void at_load(AtSlot& sl, int uu, const AtCtx& C, const Frame& F) {
    const AtUnit a_ = at_decode(uu);
#pragma unroll
    for (int ps = 0; ps < 6; ++ps) { const int lp = 128 * (a_.n - 1) + ps * 64 + C.jr; sl.k[ps] = (v4u){0u, 0u, 0u, 0u}; sl.v[ps] = sl.k[ps];
        if (lp >= 0) { const size_t off = ((size_t)a_.b * SEQ + (size_t)lp * a_.d + a_.r) * 1536 + a_.hoff + C.piece * 8; sl.k[ps] = *(const v4u*)(C.Kb + off); sl.v[ps] = *(const v4u*)(C.Vb + off); } }
    const size_t qrow_ = (size_t)a_.b * SEQ + (size_t)(128 * a_.n + 16 * F.wave + C.qi) * a_.d + a_.r; const bf16* qp = C.Qb + qrow_ * 1536 + a_.hoff + 8 * C.g4;
    sl.q0 = *(const bf16x8*)qp; sl.q1 = *(const bf16x8*)(qp + 32);
    const bf16* qp2 = qp + (size_t)128 * a_.d * 1536; sl.q2 = *(const bf16x8*)qp2; sl.q3 = *(const bf16x8*)(qp2 + 32);
}
__device__ __forceinline__ void at_unit(AtSlot& sl, int u, int unext, const AtCtx& C, const Frame& F) {
    bf16* OG = C.OG; float* LSE = C.LSE; LAS unsigned char* Ks = C.Ks; LAS unsigned char* Vs = C.Vs; const int qi = C.qi, g4 = C.g4;
    const AtUnit au = at_decode(u); const int g = au.g, b = au.b, h = au.h, r = au.r, n = au.n, d = au.d;
#pragma unroll
    for (int ps = 0; ps < 6; ++ps) { const int j = ps * 64 + C.jr; *(LAS v4u*)(Ks + j * AT_RS + C.piece * 16) = sl.k[ps]; *(LAS v4u*)(Vs + j * AT_RS + C.piece * 16) = sl.v[ps]; }
    const bf16x8 sl_q0 = sl.q0, sl_q1 = sl.q1, sl_q2 = sl.q2, sl_q3 = sl.q3;
    LDS_BARRIER();
    if (unext < AT_NU) at_load(sl, unext, C, F);
#pragma unroll
    for (int tq = 0; tq < 2; ++tq)
        {
            const int iq = 128 * tq + 16 * F.wave + qi; const int rb = 128 * tq + 16 * F.wave; const bf16x8 qf0 = tq ? sl_q2 : sl_q0, qf1 = tq ? sl_q3 : sl_q1; const size_t qrow = (size_t)b * SEQ + (size_t)(128 * n + iq) * d + r;
            f32x4 s[10]; float mx = -1e30f; const int dq = qi - 4 * g4; const bool first = (n == 0) && (tq == 0);
#pragma unroll
            for (int st = 0; st < 9; ++st) {
                const LAS unsigned char* kp = Ks + (rb + 16 * st + qi) * AT_RS + g4 * 16;
                const bf16x8 k0 = *(const LAS bf16x8*)kp, k1 = *(const LAS bf16x8*)(kp + 64);
                f32x4 a = (f32x4){0.f, 0.f, 0.f, 0.f};
                a = mfma16(k0, qf0, a); a = mfma16(k1, qf1, a);
                if (st == 0) {
#pragma unroll
                    for (int i = 0; i < 4; ++i) a[i] = (i >= dq) ? a[i] : -1e30f; }
                if (st == 8) {
#pragma unroll
                    for (int i = 0; i < 4; ++i) a[i] = (i <= dq) ? a[i] : -1e30f; }
                if (first) {
#pragma unroll
                    for (int i = 0; i < 4; ++i) a[i] = (rb + 16 * st + 4 * g4 + i >= 128) ? a[i] : -1e30f; }
#pragma unroll
                for (int i = 0; i < 4; ++i) mx = fmaxf(mx, a[i]);
                s[st] = a;
            }
            mx = fmaxf(mx, __shfl_xor(mx, 16)); mx = fmaxf(mx, __shfl_xor(mx, 32));
            float sum = 0.f;
#pragma unroll
            for (int st = 0; st < 9; ++st)
#pragma unroll
                for (int i = 0; i < 4; ++i) { const float p = fexp2(s[st][i] - mx); s[st][i] = p; sum += p; }
            s[9] = (f32x4){0.f, 0.f, 0.f, 0.f};
            sum += __shfl_xor(sum, 16); sum += __shfl_xor(sum, 32);
            f32x4 o[4];
#pragma unroll
            for (int dt = 0; dt < 4; ++dt) o[dt] = (f32x4){0.f, 0.f, 0.f, 0.f};
#pragma unroll
            for (int c = 0; c < 5; ++c) {
                v4u pw; pw.x = pk2(s[2 * c][0], s[2 * c][1]); pw.y = pk2(s[2 * c][2], s[2 * c][3]); pw.z = pk2(s[2 * c + 1][0], s[2 * c + 1][1]); pw.w = pk2(s[2 * c + 1][2], s[2 * c + 1][3]);
                const bf16x8 pf = __builtin_bit_cast(bf16x8, pw);
                const LAS unsigned char* vp = Vs + (rb + 32 * c + 4 * g4 + (qi >> 2)) * AT_RS + 8 * (qi & 3);
#pragma unroll
                for (int dt = 0; dt < 4; ++dt) { const s16x4 lo = tr16(vp + 32 * dt), hi = tr16(vp + 32 * dt + 16 * AT_RS);
                    o[dt] = mfma16(cat8(lo, hi), pf, o[dt]); }
            }
            const float inv = 1.0f / sum;
            bf16* op = OG + ((size_t)g * T + qrow) * 512 + h * 64 + 4 * g4;
#pragma unroll
            for (int dt = 0; dt < 4; ++dt) { v2u w; w.x = pk2(o[dt][0] * inv, o[dt][1] * inv); w.y = pk2(o[dt][2] * inv, o[dt][3] * inv); *(v2u*)(op + 16 * dt) = w; }
            if (g4 == 0) LSE[((size_t)g * T + qrow) * 8 + h] = mx + __log2f(sum);
        }
    LDS_BARRIER();
}
__device__ __forceinline__ void phase_attn(Frame& F) {
    AtCtx C; C.Qb = wsp<bf16>(F, WS_Q); C.Kb = wsp<bf16>(F, WS_K); C.Vb = wsp<bf16>(F, WS_VV); C.OG = wsp<bf16>(F, WS_OG); C.LSE = wsp<float>(F, WS_LSE);
    C.Ks = F.lds; C.Vs = F.lds + AT_VOFF; C.qi = F.lane & 15; C.g4 = F.lane >> 4; C.piece = F.tid & 7; C.jr = F.tid >> 3;
    if (F.tid < 144) { *(LAS v4u*)(C.Ks + 384 * AT_RS + F.tid * 16) = (v4u){0u, 0u, 0u, 0u}; *(LAS v4u*)(C.Vs + 384 * AT_RS + F.tid * 16) = (v4u){0u, 0u, 0u, 0u}; }
    AtSlot sa; const int u0 = F.vcu, G = F.G;
    if (u0 < AT_NU) at_load(sa, u0, C, F);
#pragma unroll 1
    for (int u = u0; u < AT_NU; u += G) at_unit(sa, u, u + G, C, F);
}

constexpr int SG_WOFF = 69632, SG_WRS = 264;
constexpr int SG_RS = 528;
__device__ __forceinline__ void phase_sg(Frame& F, int l) {
    const bf16* Ub = wsp<bf16>(F, WS_U); const bf16* Vb = wsp<bf16>(F, WS_V); bf16* TT = wsp<bf16>(F, WS_TT);
    const bf16* OG = wsp<bf16>(F, WS_OG); const float* LSE = wsp<float>(F, WS_LSE); bf16* OB = wsp<bf16>(F, WS_OB);
    const bf16* Wsp = wsp<bf16>(F, WS_WSP); const float* spb = F.in[I_SPB];
    LAS unsigned char* Vn = F.lds;
    const int qi = F.lane & 15, g4 = F.lane >> 4;
    const int l32 = F.lane & 31;
    v4u vraw[8];
#define SG_LOAD(uu) do { const int gi_ = (uu) & 3, m0_ = ((uu) >> 2) * 128; \
        _Pragma("unroll") for (int ps = 0; ps < 8; ++ps) vraw[ps] = *(const v4u*)(Vb + (size_t)(m0_ + 16 * ps + 2 * F.wave + (F.lane >> 5)) * 1024 + gi_ * 256 + 8 * l32); } while (0)
    if (F.vcu < 1024) SG_LOAD(F.vcu);
    const bool wlds = (F.G & 3) == 0; LAS unsigned char* Wl = F.lds + SG_WOFF;
    if (wlds) { const bf16* wsrc = Wsp + (size_t)(l * 4 + (F.vcu & 3)) * 128 * 128;
        for (int i = F.tid; i < 128 * 16; i += 512) { const int row = i >> 4, ch = i & 15; const v4u wv = *(const v4u*)(wsrc + row * 128 + ch * 8);
            *(LAS v2u*)(Wl + row * SG_WRS + ch * 16) = (v2u){wv.x, wv.y}; *(LAS v2u*)(Wl + row * SG_WRS + ch * 16 + 8) = (v2u){wv.z, wv.w}; } }
    for (int u = F.vcu; u < 1024; u += F.G) {
        const int gi = u & 3, m0 = (u >> 2) * 128;
        float ml[4][3]; v4u mo[4][3]; const int sub = F.tid & 7;
#pragma unroll
        for (int ps = 0; ps < 4; ++ps) { const int p = (F.tid >> 3) + 64 * ps; const size_t tok = (size_t)m0 + (p >> 1); const int hd = 2 * gi + (p & 1); const size_t off = tok * 512 + hd * 64 + 8 * sub;
#pragma unroll
            for (int gq = 0; gq < 3; ++gq) { ml[ps][gq] = LSE[((size_t)gq * T + tok) * 8 + hd]; mo[ps][gq] = *(const v4u*)(OG + (size_t)gq * T * 512 + off); } }
        {
            float sm[8], mean[8], rs[8];
#pragma unroll
            for (int ps = 0; ps < 8; ++ps) { const v4u raw = vraw[ps]; sm[ps] = ((bflo(raw.x) + bfhi(raw.x)) + (bflo(raw.y) + bfhi(raw.y))) + ((bflo(raw.z) + bfhi(raw.z)) + (bflo(raw.w) + bfhi(raw.w))); }
#pragma unroll
            for (int o = 1; o < 32; o <<= 1) {
#pragma unroll
                for (int ps = 0; ps < 8; ++ps) sm[ps] += __shfl_xor(sm[ps], o); }
#pragma unroll
            for (int ps = 0; ps < 8; ++ps) { const v4u raw = vraw[ps]; mean[ps] = sm[ps] * (1.0f / 256.0f); float q = 0.f;
                const float x[8] = {bflo(raw.x), bfhi(raw.x), bflo(raw.y), bfhi(raw.y), bflo(raw.z), bfhi(raw.z), bflo(raw.w), bfhi(raw.w)};
#pragma unroll
                for (int e = 0; e < 8; ++e) { const float dx = x[e] - mean[ps]; q += dx * dx; }
                sm[ps] = q; }
#pragma unroll
            for (int o = 1; o < 32; o <<= 1) {
#pragma unroll
                for (int ps = 0; ps < 8; ++ps) sm[ps] += __shfl_xor(sm[ps], o); }
#pragma unroll
            for (int ps = 0; ps < 8; ++ps) { rs[ps] = 1.0f / sqrtf(sm[ps] * (1.0f / 256.0f) + LN_EPS); const v4u raw = vraw[ps]; const int j = 16 * ps + 2 * F.wave + (F.lane >> 5);
                const float x[8] = {bflo(raw.x), bfhi(raw.x), bflo(raw.y), bfhi(raw.y), bflo(raw.z), bfhi(raw.z), bflo(raw.w), bfhi(raw.w)};
                v4u w; w.x = pk2((x[0] - mean[ps]) * rs[ps], (x[1] - mean[ps]) * rs[ps]); w.y = pk2((x[2] - mean[ps]) * rs[ps], (x[3] - mean[ps]) * rs[ps]);
                w.z = pk2((x[4] - mean[ps]) * rs[ps], (x[5] - mean[ps]) * rs[ps]); w.w = pk2((x[6] - mean[ps]) * rs[ps], (x[7] - mean[ps]) * rs[ps]);
                *(LAS v4u*)(Vn + j * SG_RS + l32 * 16) = w; }
        }
        LDS_BARRIER();
        if (u + F.G < 1024) SG_LOAD(u + F.G);
        {
#pragma unroll
          for (int ps = 0; ps < 4; ++ps) { const int p = (F.tid >> 3) + 64 * ps; const size_t tok = (size_t)m0 + (p >> 1); const int hd = 2 * gi + (p & 1);
              const float l0 = ml[ps][0], l1 = ml[ps][1], l2 = ml[ps][2];
              const float mxx = fmaxf(l0, fmaxf(l1, l2)); float w0 = fexp2(l0 - mxx), w1 = fexp2(l1 - mxx), w2 = fexp2(l2 - mxx); const float inv = 1.0f / (w0 + w1 + w2); w0 *= inv; w1 *= inv; w2 *= inv;
              const size_t off = tok * 512 + hd * 64 + 8 * sub;
              const v4u a = mo[ps][0], bq = mo[ps][1], cq = mo[ps][2]; v4u w;
              w.x = pk2(w0 * bflo(a.x) + w1 * bflo(bq.x) + w2 * bflo(cq.x), w0 * bfhi(a.x) + w1 * bfhi(bq.x) + w2 * bfhi(cq.x));
              w.y = pk2(w0 * bflo(a.y) + w1 * bflo(bq.y) + w2 * bflo(cq.y), w0 * bfhi(a.y) + w1 * bfhi(bq.y) + w2 * bfhi(cq.y));
              w.z = pk2(w0 * bflo(a.z) + w1 * bflo(bq.z) + w2 * bflo(cq.z), w0 * bfhi(a.z) + w1 * bfhi(bq.z) + w2 * bfhi(cq.z));
              w.w = pk2(w0 * bflo(a.w) + w1 * bflo(bq.w) + w2 * bflo(cq.w), w0 * bfhi(a.w) + w1 * bfhi(bq.w) + w2 * bfhi(cq.w));
              *(v4u*)(TT + tok * 1536 + 1024 + hd * 64 + 8 * sub) = w; } }
        v2u uq[8][2]; float ubias[8];
#pragma unroll
        for (int it = 0; it < 8; ++it) { const int i = 16 * it + qi; ubias[it] = spb[(l * 4 + gi) * 128 + i]; const size_t rowo = (size_t)(m0 + i) * 1024 + gi * 256 + 32 * F.wave + 4 * g4;
            uq[it][0] = *(const v2u*)(Ub + rowo); uq[it][1] = *(const v2u*)(Ub + rowo + 16); }
        {
            f32x4 acc[2][8];
#pragma unroll
            for (int ct = 0; ct < 2; ++ct)
#pragma unroll
                for (int it = 0; it < 8; ++it) acc[ct][it] = (f32x4){0.f, 0.f, 0.f, 0.f};
            const bf16* wbase = Wsp + (size_t)(l * 4 + gi) * 128 * 128 + (size_t)qi * 128 + 4 * g4;
#pragma unroll
            for (int kc = 0; kc < 4; ++kc) {
                bf16x8 af[2];
#pragma unroll
                for (int ct = 0; ct < 2; ++ct) { const LAS unsigned char* p = Vn + (32 * kc + 4 * g4 + (qi >> 2)) * SG_RS + (32 * F.wave + 16 * ct + 4 * (qi & 3)) * 2;
                    af[ct] = cat8(tr16(p), tr16(p + 16 * SG_RS)); }
#pragma unroll
                for (int it = 0; it < 8; ++it) if (it >= 2 * kc) {
                    const bf16* wp = wbase + (size_t)(16 * it) * 128 + 32 * kc; const LAS unsigned char* wq = Wl + (16 * it + qi) * SG_WRS + (32 * kc + 4 * g4) * 2;
                    const v2u b0 = wlds ? *(const LAS v2u*)wq : *(const v2u*)wp, b1 = wlds ? *(const LAS v2u*)(wq + 32) : *(const v2u*)(wp + 16);
                    const bf16x8 bfr = __builtin_bit_cast(bf16x8, (v4u){b0.x, b0.y, b1.x, b1.y});
                    acc[0][it] = mfma16(af[0], bfr, acc[0][it]); acc[1][it] = mfma16(af[1], bfr, acc[1][it]); }
            }
#pragma unroll
            for (int it = 0; it < 8; ++it) { const int i = 16 * it + qi; const float bias = ubias[it]; const size_t rowo = (size_t)(m0 + i) * 1536 + gi * 256 + 32 * F.wave + 4 * g4;
#pragma unroll
                for (int ct = 0; ct < 2; ++ct) { const v2u uu = uq[it][ct]; const f32x4 a = acc[ct][it]; v2u w;
                    w.x = pk2(bflo(uu.x) * (a[0] + bias), bfhi(uu.x) * (a[1] + bias)); w.y = pk2(bflo(uu.y) * (a[2] + bias), bfhi(uu.y) * (a[3] + bias));
                    *(v2u*)(TT + rowo + 16 * ct) = w; } }
        }
        LDS_BARRIER();
    }
#undef SG_LOAD
}

__device__ __forceinline__ void phase_ln1(Frame& F, int l, bool commit) {
    const bf16* YPRE = wsp<bf16>(F, WS_YPRE); bf16* H = wsp<bf16>(F, WS_H);
    const float* modl = wsp<float>(F, WS_MOD) + (size_t)l * 8 * 6144;
    const float* lg = F.in[I_LN1G] + l * D; const float* lb = F.in[I_LN1B] + l * D; const float* br = F.in[I_BR] + l * NE;
    const bf16* WH = wsp<bf16>(F, WS_WRT) + (size_t)l * NE * D; const bf16* WL = WH + (size_t)NL * NE * D;
    int* TOKINFO = wsp<int>(F, WS_TOKINFO); float* TOKW = wsp<float>(F, WS_TOKW);
    unsigned* cntg = wsp<unsigned>(F, WS_CTL) + CW_CNT + (size_t)l * NE * 64;
    LAS int* sel_e = (LAS int*)(F.lds + X_SELE);
    const int lane = F.lane, qi = lane & 15, g4 = lane >> 4;
    { const v4u* srcw = (const v4u*)WH;
#pragma unroll 4
      for (int i = F.tid; i < 2 * NE * 128; i += 512) { const int hl = i >> 12, e = (i >> 7) & 31, c = i & 127;
          *(LAS v4u*)(F.lds + hl * 65536 + e * 2048 + ((c ^ (e & 15)) << 4)) = srcw[(size_t)hl * (NL * NE * 128) + e * 128 + c]; } }
    __syncthreads();
    for (int tb = F.vcu; tb < T / 128; tb += F.G) {
        const int m0 = tb * 128; const int b = m0 >> 12; const float* mb = modl + (size_t)b * 6144; const int mw = m0 + 16 * F.wave;
        v2u pre[4][4];
#pragma unroll
        for (int r = 0; r < 4; ++r)
#pragma unroll
            for (int j = 0; j < 4; ++j) pre[r][j] = *((const v2u*)(YPRE + (size_t)(mw + r) * D) + lane + 64 * j);
#pragma unroll 1
        for (int rp = 0; rp < 4; ++rp) {
            f32x4 hh[4][4]; float mean[4], rstd[4];
            const int mrow = mw + 4 * rp;
#pragma unroll
            for (int r = 0; r < 4; ++r)
#pragma unroll
                for (int j = 0; j < 4; ++j) hh[r][j] = (f32x4){bflo(pre[r][j].x), bfhi(pre[r][j].x), bflo(pre[r][j].y), bfhi(pre[r][j].y)};
            if (rp < 3) {
#pragma unroll
                for (int r = 0; r < 4; ++r)
#pragma unroll
                    for (int j = 0; j < 4; ++j) pre[r][j] = *((const v2u*)(YPRE + (size_t)(mrow + 4 + r) * D) + lane + 64 * j); }
            { float sm[4], sq[4];
#pragma unroll
              for (int r = 0; r < 4; ++r) { sm[r] = 0.f; sq[r] = 0.f;
#pragma unroll
                  for (int j = 0; j < 4; ++j) { sm[r] += (hh[r][j][0] + hh[r][j][1]) + (hh[r][j][2] + hh[r][j][3]);
                      sq[r] += (hh[r][j][0] * hh[r][j][0] + hh[r][j][1] * hh[r][j][1]) + (hh[r][j][2] * hh[r][j][2] + hh[r][j][3] * hh[r][j][3]); } }
#pragma unroll
              for (int o = 1; o < 64; o <<= 1) {
#pragma unroll
                  for (int r = 0; r < 4; ++r) { sm[r] += __shfl_xor(sm[r], o); sq[r] += __shfl_xor(sq[r], o); } }
#pragma unroll
              for (int r = 0; r < 4; ++r) { mean[r] = sm[r] * (1.0f / D); rstd[r] = 1.0f / sqrtf(fmaxf(sq[r] * (1.0f / D) - mean[r] * mean[r], 0.f) + LN_EPS); } }
            if (lane < 4) { const float mq = (lane == 0) ? mean[0] : (lane == 1) ? mean[1] : (lane == 2) ? mean[2] : mean[3], rq = (lane == 0) ? rstd[0] : (lane == 1) ? rstd[1] : (lane == 2) ? rstd[2] : rstd[3];
                float* st = wsp<float>(F, WS_STAT) + (size_t)(mrow + lane) * 2; st[0] = mq; st[1] = rq; }
#pragma unroll
            for (int j = 0; j < 4; ++j) { const f32x4 gq = *((const f32x4*)lg + lane + 64 * j), bq = *((const f32x4*)lb + lane + 64 * j);
                const f32x4 shq = *((const f32x4*)(mb + 3072) + lane + 64 * j), scq = *((const f32x4*)(mb + 4096) + lane + 64 * j) + 1.0f;
#pragma unroll
                for (int r = 0; r < 4; ++r) { const f32x4 x1 = (hh[r][j] - mean[r]) * rstd[r] * gq + bq;
                    const f32x4 h2 = x1 * scq + shq; v2u o; o.x = pk2(h2[0], h2[1]); o.y = pk2(h2[2], h2[3]); *((v2u*)(H + (size_t)(mrow + r) * D) + lane + 64 * j) = o;
 } }
        }
        VM_WAIT(); asm volatile("" ::: "memory");
        f32x4 c0 = (f32x4){0.f, 0.f, 0.f, 0.f}, c1 = c0;
        { const bf16* hp = H + (size_t)(mw + qi) * D + 8 * g4;
          const LAS unsigned char* w0 = F.lds + qi * 2048; const LAS unsigned char* w1 = F.lds + (16 + qi) * 2048;
#pragma unroll 8
          for (int ks = 0; ks < 32; ++ks) {
              const bf16x8 hhi = *(const bf16x8*)(hp + 32 * ks);
              const int co = ((4 * ks + g4) ^ qi) << 4;
              const bf16x8 a0h = *(const LAS bf16x8*)(w0 + co), a0l = *(const LAS bf16x8*)(w0 + 65536 + co);
              const bf16x8 a1h = *(const LAS bf16x8*)(w1 + co), a1l = *(const LAS bf16x8*)(w1 + 65536 + co);
              c0 = mfma16(a0h, hhi, c0); c0 = mfma16(a0l, hhi, c0);
              c1 = mfma16(a1h, hhi, c1); c1 = mfma16(a1l, hhi, c1); } }
        {
            float v[8]; int id[8];
#pragma unroll
            for (int i = 0; i < 4; ++i) { id[i] = 4 * g4 + i; id[4 + i] = 16 + 4 * g4 + i; v[i] = c0[i] + br[4 * g4 + i]; v[4 + i] = c1[i] + br[16 + 4 * g4 + i]; }
            int ek[4]; float vk[4];
#pragma unroll
            for (int k = 0; k < 4; ++k) { float lm = v[0]; int li = id[0];
#pragma unroll
                for (int j = 1; j < 8; ++j) if (v[j] > lm) { lm = v[j]; li = id[j]; }
#pragma unroll
                for (int o = 16; o <= 32; o <<= 1) { const float om = __shfl_xor(lm, o); const int oi = __shfl_xor(li, o); if (om > lm || (om == lm && oi < li)) { lm = om; li = oi; } }
                ek[k] = li; vk[k] = lm;
#pragma unroll
                for (int j = 0; j < 8; ++j) if (id[j] == li) v[j] = -INFINITY; }
            const float e1 = __expf(vk[1] - vk[0]), e2 = __expf(vk[2] - vk[0]), e3 = __expf(vk[3] - vk[0]); const float inv = 1.0f / (1.0f + e1 + e2 + e3);
            if (g4 == 0) { const int tl = 16 * F.wave + qi;
                sel_e[tl * 4 + 0] = ek[0]; sel_e[tl * 4 + 1] = ek[1]; sel_e[tl * 4 + 2] = ek[2]; sel_e[tl * 4 + 3] = ek[3];
                *(f32x4*)(TOKW + (size_t)(m0 + tl) * 4) = (f32x4){inv, e1 * inv, e2 * inv, e3 * inv}; }
        }
        __syncthreads();
        { const int myE = sel_e[F.tid]; LAS unsigned long long* bm = (LAS unsigned long long*)(F.lds + X_SELR); unsigned long long mine = 0ull;
#pragma unroll
          for (int e = 0; e < 32; ++e) { const unsigned long long m = __ballot(myE == e); if (lane == e) mine = m; }
          if (lane < 32) bm[F.wave * 32 + lane] = mine;
          __syncthreads();
          int rk = __popcll(bm[F.wave * 32 + myE] & ((1ull << lane) - 1ull));
#pragma unroll
          for (int w = 0; w < 8; ++w) if (w < F.wave) rk += __popcll(bm[w * 32 + myE]);
          TOKINFO[(size_t)m0 * 4 + F.tid] = myE | (rk << 8);
          if (F.tid < 32) { int tot = 0;
#pragma unroll
              for (int w = 0; w < 8; ++w) tot += __popcll(bm[w * 32 + F.tid]);
              wsp<int>(F, WS_WGCNT)[((size_t)l * 256 + tb) * 32 + F.tid] = tot; if (tot && commit) (void)__hip_atomic_fetch_add(cntg + F.tid * 64, (unsigned)tot, RLX_AGENT); } }
        __syncthreads();
    }
}

__device__ __forceinline__ int moe_tables(Frame& F, int l) {
    const unsigned* cntg = wsp<unsigned>(F, WS_CTL) + CW_CNT + (size_t)l * NE * 64;
    LAS int* cnt_s = (LAS int*)(F.lds + X_CNTS); LAS int* off_s = (LAS int*)(F.lds + X_OFFS); LAS unsigned char* tile_e = (LAS unsigned char*)(F.lds + X_TILEE);
    if (F.tid < 32) cnt_s[F.tid] = (int)__hip_atomic_load(cntg + F.tid * 64, RLX_AGENT);
    __syncthreads();
    if (F.tid < 64) {
        const int e = F.tid & 31; const int c = (F.tid < 32) ? cnt_s[e] : 0; const int nt = (c + 255) >> 8; int incl = nt;
#pragma unroll
        for (int o = 1; o < 32; o <<= 1) { const int v = __shfl_up(incl, o); if ((F.tid & 63) >= o) incl += v; }
        if (F.tid < 32) { const int excl = incl - nt; off_s[e] = excl * 256; for (int t = 0; t < nt; ++t) tile_e[excl + t] = (unsigned char)e; if (e == 31) off_s[32] = incl * 256; }
    }
    __syncthreads();
    return off_s[32] >> 8;
}
__device__ __forceinline__ void phase_scat(Frame& F, int l) {
    (void)moe_tables(F, l);
    const LAS int* off_s = (const LAS int*)(F.lds + X_OFFS); const LAS int* cnt_s = (const LAS int*)(F.lds + X_CNTS); LAS int* base_s = (LAS int*)(F.lds + X_BASE);
    const int* TOKINFO = wsp<int>(F, WS_TOKINFO); const float* TOKW = wsp<float>(F, WS_TOKW);
    int* ROWTOK = wsp<int>(F, WS_ROWTOK); float* ROWW = wsp<float>(F, WS_ROWW); const int* WGC = wsp<int>(F, WS_WGCNT) + (size_t)l * 256 * 32; int* TOKINFO2 = wsp<int>(F, WS_TOKROW);
    for (int tb = F.vcu; tb < T / 128; tb += F.G) {
        if (F.tid < 32) base_s[F.tid] = 0;
        __syncthreads();
        { const int e = F.tid & 31, part = F.tid >> 5; int sacc = 0;
          for (int t2 = part * 16; t2 < part * 16 + 16; ++t2) if (t2 < tb) sacc += WGC[t2 * 32 + e];
          if (sacc) atomicAdd((int*)&base_s[e], sacc); }
        __syncthreads();
        { const size_t ent = (size_t)tb * 512 + F.tid; const int info = TOKINFO[ent]; const int e = info & 255, row = off_s[e] + base_s[e] + (info >> 8);
          ROWTOK[row] = (int)ent; ROWW[row] = TOKW[ent]; TOKINFO2[ent] = row; }
        __syncthreads();
    }
    if (F.vcu == 0) for (int e = 0; e < NE; ++e) for (int r = off_s[e] + cnt_s[e] + F.tid; r < off_s[e + 1]; r += 512) { ROWTOK[r] = 0; ROWW[r] = 0.f; }
}
__device__ __forceinline__ void phase_ln2(Frame& F, int l) {
    const bf16* X1 = wsp<bf16>(F, WS_YPRE); const bf16* YK = wsp<bf16>(F, WS_XG); bf16* H = wsp<bf16>(F, WS_H); const int* TOKROW = wsp<int>(F, WS_TOKROW); const float* TOKW = wsp<float>(F, WS_TOKW);
    const float* STAT = wsp<float>(F, WS_STAT); const float* l1g = F.in[I_LN1G] + l * D; const float* l1b = F.in[I_LN1B] + l * D;
    float* XO = F.out; bf16* XB = wsp<bf16>(F, WS_X2);
    const float* modl = wsp<float>(F, WS_MOD) + (size_t)l * 8 * 6144; const float* modn = wsp<float>(F, WS_MOD) + (size_t)((l + 1) & 3) * 8 * 6144;
    const float* lg = F.in[I_LN2G] + l * D; const float* lb = F.in[I_LN2B] + l * D;
    const int lane = F.lane; const int gw = F.vcu * 8 + F.wave, NGW = F.G * 8;
    v2u px[4]; v2u py[4][4]; float pst[2], nst[2]; f32x4 pw4, nw4;
#define LN2_LOAD(mm) do { nst[0] = STAT[(size_t)(mm) * 2]; nst[1] = STAT[(size_t)(mm) * 2 + 1]; nw4 = *(const f32x4*)(TOKW + (size_t)(mm) * 4); \
        int rw_[4]; _Pragma("unroll") for (int k = 0; k < 4; ++k) rw_[k] = TOKROW[(size_t)(mm) * 4 + k]; \
        _Pragma("unroll") for (int j = 0; j < 4; ++j) { px[j] = __builtin_nontemporal_load((const v2u*)(X1 + (size_t)(mm) * D) + lane + 64 * j); \
        _Pragma("unroll") for (int k = 0; k < 4; ++k) py[j][k] = __builtin_nontemporal_load((const v2u*)(YK + (size_t)rw_[k] * D) + lane + 64 * j); } } while (0)
    if (gw < T) LN2_LOAD(gw);
#pragma unroll 1
    for (int m = gw; m < T; m += NGW) { const int b = m >> 12; const float* mb = modl + (size_t)b * 6144; const float* mn = modn + (size_t)b * 6144;
        f32x4 v[4]; float s = 0.f; pst[0] = nst[0]; pst[1] = nst[1]; pw4 = nw4;
#pragma unroll
        for (int j = 0; j < 4; ++j) { f32x4 y = (f32x4){0.f, 0.f, 0.f, 0.f};
#pragma unroll
            for (int k = 0; k < 4; ++k) { const v2u w = py[j][k]; const float cw = pw4[k]; y[0] += cw * bflo(w.x); y[1] += cw * bfhi(w.x); y[2] += cw * bflo(w.y); y[3] += cw * bfhi(w.y); }
            const f32x4 g2 = *((const f32x4*)(mb + 5120) + lane + 64 * j) + 1.0f;
            const f32x4 pxf = (f32x4){bflo(px[j].x), bfhi(px[j].x), bflo(px[j].y), bfhi(px[j].y)};
            const f32x4 x1 = (pxf - pst[0]) * pst[1] * *((const f32x4*)l1g + lane + 64 * j) + *((const f32x4*)l1b + lane + 64 * j);
            v[j] = x1 * DN_ALPHA + g2 * y; s += (v[j][0] + v[j][1]) + (v[j][2] + v[j][3]); }
        if (m + NGW < T) LN2_LOAD(m + NGW);
        float s2 = 0.f;
#pragma unroll
        for (int j = 0; j < 4; ++j) s2 += (v[j][0] * v[j][0] + v[j][1] * v[j][1]) + (v[j][2] * v[j][2] + v[j][3] * v[j][3]);
#pragma unroll
        for (int o = 1; o < 64; o <<= 1) { s += __shfl_xor(s, o); s2 += __shfl_xor(s2, o); }
        const float mean = s * (1.0f / D); const float rstd = 1.0f / sqrtf(fmaxf(s2 * (1.0f / D) - mean * mean, 0.f) + LN_EPS);
#pragma unroll
        for (int j = 0; j < 4; ++j) v[j] = v[j] - mean;
        f32x4* xo = (f32x4*)(XO + (size_t)m * D) + lane; v2u* xb = (v2u*)(XB + (size_t)m * D) + lane; v2u* ho = hblk(H, m, lane);
#pragma unroll
        for (int j = 0; j < 4; ++j) { const f32x4 gvj = *((const f32x4*)lg + lane + 64 * j), bvj = *((const f32x4*)lb + lane + 64 * j); const f32x4 x2 = v[j] * rstd * gvj + bvj;
            if (l == NL - 1) __builtin_nontemporal_store(x2, xo + 64 * j); else { v2u xq; xq.x = pk2(x2[0], x2[1]); xq.y = pk2(x2[2], x2[3]); __builtin_nontemporal_store(xq, xb + 64 * j); }
            if (l < NL - 1) { const f32x4 sh = *((const f32x4*)mn + lane + 64 * j), sc = *((const f32x4*)(mn + 1024) + lane + 64 * j) + 1.0f; const f32x4 h = x2 * sc + sh;
                v2u o; o.x = pk2(h[0], h[1]); o.y = pk2(h[2], h[3]); ho[1024 * j] = o; } } }
#undef LN2_LOAD
}

#ifndef PH_MASK
#define PH_MASK 0xFFFF
#endif
#define PHM(b) ((PH_MASK >> (b)) & 1)
#ifndef DUP_MASK
#define DUP_MASK 0
#endif
#define REPS(b) (((DUP_MASK >> (b)) & 1) ? 2 : 1)
constexpr int NPH_L = 10, NPHASE = 2 + NL * NPH_L;
struct Args { const float* in[20]; float* out; unsigned char* ws; int ph_lo, ph_hi; };
__global__ void __launch_bounds__(512, 2) fwd(Args args) {
    extern __shared__ __attribute__((aligned(16))) unsigned char lds[];
    Frame F;
    F.lds = (LAS unsigned char*)lds;
#define FRESH() do { int zv_ = 0; asm volatile("" : "+v"(zv_)); const int z_ = __builtin_amdgcn_readfirstlane(zv_); \
        F.tid = (int)threadIdx.x + zv_; F.lane = F.tid & 63; F.wave = __builtin_amdgcn_readfirstlane(F.tid >> 6); \
        F.G = (int)gridDim.x + z_; F.bx = (int)blockIdx.x + z_; F.vcu = (F.G % 8 == 0) ? (F.bx % 8) * (F.G / 8) + F.bx / 8 : F.bx; \
        F.ws = args.ws + z_; F.in = args.in + z_; F.out = args.out + z_; F.lds = (LAS unsigned char*)lds + z_; } while (0)
    FRESH();
    for (int u = F.tid; u < (LDS_BYTES - XOFF) / 4; u += 512) ((LAS unsigned*)(F.lds + XOFF))[u] = 0u;
    __syncthreads();
    unsigned* ctl = wsp<unsigned>(F, WS_CTL);
    XcdBarrier bar; bar.bar = ctl + CW_BAR; bar.x = 0; bar.st = nullptr;
    if (!MK_PER_PHASE) bar = xcd_barrier_post(ctl + CW_BAR, (volatile LAS unsigned*)(F.lds + X_MISC) + 8);
    const int lo = args.ph_lo, hi = args.ph_hi;
#define IN(k) (lo <= (k) && (k) < hi)
#ifndef BAR_REPS
#define BAR_REPS 1
#endif
#define SEAM(k) do { if (!MK_PER_PHASE && IN(k) && IN((k) + 1)) for (int br_ = 0; br_ < BAR_REPS; ++br_) xcd_barrier(bar); } while (0)

    if (PHM(0) && IN(0)) for (int rep = 0; rep < REPS(0); ++rep) { FRESH(); phase_pro_a(F); } SEAM(0);
    if (PHM(1) && IN(1)) for (int rep = 0; rep < REPS(1); ++rep) { FRESH(); phase_pro_b(F); } SEAM(1);
    for (int l = 0; l < NL; ++l) {
        const int pb = 2 + l * NPH_L;
        if (PHM(2) && IN(pb + 0)) for (int rep = 0; rep < REPS(2); ++rep) { FRESH();
            pg8::Gemm g{wsp<bf16>(F, WS_H), wsp<bf16>(F, WS_WIN) + (size_t)l * NIN * D, T, NIN, D}; pg8::StaticOrder S; S.init(T, NIN, F.G, F.bx);
            EpiIn E{wsp<bf16>(F, WS_U), wsp<bf16>(F, WS_V), wsp<bf16>(F, WS_Q), wsp<bf16>(F, WS_K), wsp<bf16>(F, WS_VV), wsp<bf16>(F, WS_G), wsp<float>(F, WS_ROPE)};
            stagger(F.bx >> 3, STAG_US);
            pg8::gemm_phase<EpiIn, pg8::StaticOrder, PG8_ALIGN, PG8_SP2>(F.lds, g, S, E, F.tid);
#if defined(XPROBE)
            { FRESH(); pg8::Gemm g2{wsp<bf16>(F, WS_H), wsp<bf16>(F, WS_WIN) + (size_t)l * NIN * D, T, NIN, D}; pg8::StaticOrder S2; S2.init(T, NIN, F.G, F.bx);
              EpiProbe E2{wsp<bf16>(F, WS_XG), (XPROBE == 3) ? NIN : 1024, (XPROBE >= 2) ? (XPROBE == 3 ? 3 : 1) : (F.G == 0x7ffffff0 ? 1 : 0)};
              pg8::gemm_phase<EpiProbe, pg8::StaticOrder, PG8_ALIGN, PG8_SP2>(F.lds, g2, S2, E2, F.tid); }
#endif
        } SEAM(pb + 0);
        if (PHM(3) && IN(pb + 1)) for (int rep = 0; rep < REPS(3); ++rep) { FRESH(); phase_attn(F); } SEAM(pb + 1);
        if (PHM(4) && IN(pb + 2)) for (int rep = 0; rep < REPS(4); ++rep) { FRESH(); phase_sg(F, l); } SEAM(pb + 2);
        if (PHM(5) && IN(pb + 3)) for (int rep = 0; rep < REPS(5); ++rep) { FRESH();
            pg8::Gemm g{wsp<bf16>(F, WS_TT), wsp<bf16>(F, WS_WBA) + (size_t)l * D * 1536, T, D, 1536}; pg8::StaticOrder S; S.init(T, D, F.G, F.bx);
            EpiMg2 E{wsp<bf16>(F, WS_G), wsp<bf16>(F, WS_MG)}; pg8::gemm_phase<EpiMg2, pg8::StaticOrder, PG8_ALIGN, PG8_SP2>(F.lds, g, S, E, F.tid);
        } SEAM(pb + 3);
        if (PHM(6) && IN(pb + 4)) for (int rep = 0; rep < REPS(6); ++rep) { FRESH();
            pg8::Gemm g{wsp<bf16>(F, WS_MG), wsp<bf16>(F, WS_WOUT) + (size_t)l * D * D, T, D, D}; pg8::StaticOrder S; S.init(T, D, F.G, F.bx);
            if (l == 0) { EpiOut<true> E{(const void*)F.in[I_X], wsp<float>(F, WS_MOD) + (size_t)l * 8 * 6144, wsp<bf16>(F, WS_YPRE)}; pg8::gemm_phase<EpiOut<true>, pg8::StaticOrder, PG8_ALIGN, PG8_SP2>(F.lds, g, S, E, F.tid); }
            else { EpiOut<false> E{(const void*)wsp<bf16>(F, WS_X2), wsp<float>(F, WS_MOD) + (size_t)l * 8 * 6144, wsp<bf16>(F, WS_YPRE)}; pg8::gemm_phase<EpiOut<false>, pg8::StaticOrder, PG8_ALIGN, PG8_SP2>(F.lds, g, S, E, F.tid); }
        } SEAM(pb + 4);
        if (PHM(7) && IN(pb + 5)) for (int rep = 0; rep < REPS(7); ++rep) { FRESH(); phase_ln1(F, l, rep == 0); } SEAM(pb + 5);
        if (PHM(8) && IN(pb + 6)) for (int rep = 0; rep < REPS(8); ++rep) { FRESH(); phase_scat(F, l); } SEAM(pb + 6);
        if (PHM(9) && IN(pb + 7)) for (int rep = 0; rep < REPS(9); ++rep) { FRESH();
            const int RT = moe_tables(F, l);
            pg8::Gemm g{wsp<bf16>(F, WS_H), wsp<bf16>(F, WS_WUP) + (size_t)l * NE * 2048 * D, RT * 256, NE * 2048, D};
            MoeGatherOrder S; S.init(RT, 8, F.G, F.bx, (const LAS unsigned char*)(F.lds + X_TILEE)); S.tokl = (const LAS unsigned short*)(F.lds + X_TOKL);
            { const int* rowtok = wsp<int>(F, WS_ROWTOK); LAS unsigned short* tl = (LAS unsigned short*)(F.lds + X_TOKL); pg8::Unit uu;
              for (int i = 0; i < TOKL_UNITS && S.next(i, uu); ++i) if (F.tid < 256) tl[i * 256 + F.tid] = (unsigned short)(rowtok[uu.pm * 256 + F.tid] >> 2);
              __syncthreads(); }
            EpiUp E{F.in[I_BUP] + (size_t)l * NE * 2048, wsp<bf16>(F, WS_ACT)};
            stagger(F.bx >> 3, STAG_US);
            pg8::gemm_phase<EpiUp, MoeGatherOrder, PG8_ALIGN, true>(F.lds, g, S, E, F.tid);
        } SEAM(pb + 7);
        if (PHM(10) && IN(pb + 8)) for (int rep = 0; rep < REPS(10); ++rep) { FRESH();
            const int RT = moe_tables(F, l);
            pg8::Gemm g{wsp<bf16>(F, WS_ACT), wsp<bf16>(F, WS_WDN) + (size_t)l * NE * D * FF, RT * 256, NE * D, FF};
            MoeOrder S; S.init(RT, 4, F.G, F.bx, (const LAS unsigned char*)(F.lds + X_TILEE), 1);
            EpiDn E{F.in[I_BDN] + (size_t)l * NE * D, wsp<bf16>(F, WS_XG)};
            stagger(F.bx >> 3, STAG_US);
            pg8::gemm_phase<EpiDn, MoeOrder, PG8_ALIGN, PG8_SP2>(F.lds, g, S, E, F.tid);
        } SEAM(pb + 8);
        if (PHM(11) && IN(pb + 9)) for (int rep = 0; rep < REPS(11); ++rep) { FRESH(); phase_ln2(F, l); } SEAM(pb + 9);
    }
#undef IN
#undef SEAM
#undef FRESH
}

extern "C" void kernel_launch(void* const* d_in, const int* in_sizes, int n_in, void* d_out, int out_size, void* d_ws, size_t ws_size, hipStream_t stream) {
    static int grid = 0;
    if (grid == 0) {
        if (n_in != 20 || out_size != T * D || ws_size < WS_END) { fprintf(stderr, "kernel_launch: unexpected shapes (n_in %d, out %d, ws %zu < %zu)\n", n_in, out_size, ws_size, (size_t)WS_END); grid = -1; return; }
        int dev = 0, cus = 0;
        if (hipGetDevice(&dev) != hipSuccess || hipDeviceGetAttribute(&cus, hipDeviceAttributeMultiprocessorCount, dev) != hipSuccess) { grid = -1; return; }
        if (hipFuncSetAttribute((const void*)fwd, hipFuncAttributeMaxDynamicSharedMemorySize, LDS_BYTES) != hipSuccess) { fprintf(stderr, "kernel_launch: hipFuncSetAttribute failed\n"); grid = -1; return; }
        int per_cu = 0;
        if (hipOccupancyMaxActiveBlocksPerMultiprocessor(&per_cu, (const void*)fwd, 512, LDS_BYTES) != hipSuccess || per_cu < 1) fprintf(stderr, "kernel_launch: occupancy query says %d blocks per CU\n", per_cu);
        (void)hipGetLastError();
        grid = cus;
    }
    if (grid < 0) return;
    (void)in_sizes;
    if (hipMemsetAsync((char*)d_ws + WS_CTL, 0, CTL_ZERO_BYTES, stream) != hipSuccess) return;
    Args a{};
    for (int i = 0; i < 20; ++i) a.in[i] = (const float*)d_in[i];
    a.out = (float*)d_out; a.ws = (unsigned char*)d_ws;
#if MK_PER_PHASE
    for (int p = 0; p < NPHASE; ++p) { a.ph_lo = p; a.ph_hi = p + 1; hipLaunchKernelGGL(fwd, dim3(grid), dim3(512), LDS_BYTES, stream, a); }
#else
    a.ph_lo = 0; a.ph_hi = NPHASE;
    hipLaunchKernelGGL(fwd, dim3(grid), dim3(512), LDS_BYTES, stream, a);
#endif
    const hipError_t le = hipPeekAtLastError();
    if (le != hipSuccess) fprintf(stderr, "kernel_launch: launch failed: %s\n", hipGetErrorName(le));
}
```

```cpp
#include <hip/hip_runtime.h>
#include <cstdio>
#include <cstdint>
#ifndef MK_PER_PHASE
#define MK_PER_PHASE 0
#endif
#define ATT_NT false
namespace pg8 {
#define PG8_LAS __attribute__((address_space(3)))
typedef unsigned short bf16_t;
typedef short bf16x8 __attribute__((ext_vector_type(8)));
typedef float f32x4 __attribute__((ext_vector_type(4)));
typedef unsigned u32x4 __attribute__((ext_vector_type(4)));
constexpr int BM = 256, BK = 64, HALF = 128, HTB = HALF * BK * 2  , STAGE_BYTES = 8 * HTB, NXCD = 8;
#ifndef PG8_WGM
#define PG8_WGM 8
#endif
constexpr int WGM = PG8_WGM;

__host__ __device__ __forceinline__ int lds_byte(int r, int c) { const int st = (r >> 4) * 2 + (c >> 5), rr = r & 15, cc = c & 31, ob = rr * 64 + cc * 2; return st * 1024 + (ob ^ (((ob >> 9) & 1) << 5)); }
__host__ __device__ __forceinline__ void stage_rc(int b, int& R, int& C) { const int st = b / 1024, sb = b % 1024, swz = sb ^ (((sb >> 9) & 1) << 5); R = (st >> 1) * 16 + swz / 64; C = (st & 1) * 32 + (swz % 64) / 2; }
__host__ __device__ __forceinline__ int perm32(int rho) { const int n = rho >> 4, i = rho & 15; return 8 * (i >> 2) + 4 * n + (i & 3); }

struct Unit { int pm, pn; };
struct Gemm { const bf16_t* A; const bf16_t* Bt; int M, N, K; };

struct StaticOrder {
    static constexpr bool GATHER = false; __device__ __forceinline__ int arow(int, int r) const { return r; }
    int nM, nN, nwg, G, c;
    __host__ __device__ void init(int M, int N, int G_, int c_) { nM = M / BM; nN = N / BM; nwg = nM * nN; G = G_; c = c_; }
    __host__ __device__ bool next(int i, Unit& u) const {
        const long L = (long)i * G + c; if (L >= nwg) return false;
        int wgid = (int)L; { const int q = nwg / NXCD, r = nwg % NXCD, xcd = wgid % NXCD, off = wgid / NXCD; wgid = (xcd < r ? xcd * (q + 1) : r * (q + 1) + (xcd - r) * q) + off; }
        const int nig = WGM * nN, gid = wgid / nig, fm = gid * WGM, gsz = (nM - fm) < WGM ? (nM - fm) : WGM;
        u.pm = fm + ((wgid % nig) % gsz); u.pn = (wgid % nig) / gsz; return true;
    }
    __device__ __forceinline__ void a_ready(const Unit&) const {}
    __device__ __forceinline__ void done(const Unit&) const {}
};

__device__ __forceinline__ unsigned cvt_pk_bf16(float lo, float hi) { unsigned r; asm volatile("v_cvt_pk_bf16_f32 %0, %1, %2" : "=v"(r) : "v"(lo), "v"(hi)); return r; }
typedef float f32x2 __attribute__((ext_vector_type(2)));

template <class Epi, class Sched, bool ALIGN_EPI = false, bool SP2 = false>
__device__ __forceinline__ void gemm_phase(PG8_LAS unsigned char* lds, const Gemm g, const Sched& S, const Epi& E, const int tid_in) {
    const int tid = tid_in, wid = __builtin_amdgcn_readfirstlane(tid >> 6), lane = tid & 63, wr = wid >> 2, wc = wid & 3, fr = lane & 15, fq = lane >> 4;
    const int K = g.K, nt = K / BK; constexpr bool BBLK = true;
    unsigned voffA[2], voffB[2];
#pragma unroll
    for (int i = 0; i < 2; ++i) { int R, C; stage_rc(tid * 16 + i * 8192, R, C); const int Rb = Epi::BADJ ? (64 * (R >> 5) + perm32(R & 31)) : Epi::PERM ? ((R & ~31) + perm32(R & 31)) : R;
        voffA[i] = Epi::ABLK ? (unsigned)((((R >> 4) * (K >> 5) + (C >> 5)) * 8 + (R & 7)) * 128 + ((R >> 3) & 1) * 64 + (C & 31) * 2) : (unsigned)(R * K + C) * 2u; voffB[i] = BBLK ? (unsigned)((((Rb >> 4) * (K >> 5) + (C >> 5)) * 8 + (Rb & 7)) * 128 + ((Rb >> 3) & 1) * 64 + (C & 31) * 2) : (unsigned)(Rb * K + C) * 2u; }
    const size_t kstep = (size_t)(BK * 2);
    const size_t kstepB = BBLK ? (size_t)2048 : kstep;
    const size_t kstepA = Epi::ABLK ? (size_t)2048 : kstep;
    const size_t hstep = (size_t)HALF * K * 2;
    const size_t tstep = 2 * hstep;
    const size_t bhstep = Epi::BADJ ? (size_t)32 * K * 2 : hstep;
    const unsigned ldsw = (unsigned)wid * 1024u;
    const int aoff = lds_byte(wr * 64 + fr, fq * 8), boff = lds_byte(wc * 32 + fr, fq * 8);
#define PG8_SA(b, h) (((b) * 2 + (h)) * HTB)
#define PG8_SB(b, h) ((4 + (b) * 2 + (h)) * HTB)
    unsigned gc[2][2], gn[2][2];
#define PG8_GOFF(dst, pmv, ordv) do { if constexpr (Sched::GATHER) { _Pragma("unroll") for (int _h = 0; _h < 2; ++_h) _Pragma("unroll") for (int _i = 0; _i < 2; ++_i) { int _R, _C; stage_rc(tid * 16 + _i * 8192, _R, _C); \
        dst[_h][_i] = (unsigned)S.arow((ordv), (pmv) * 256 + _h * 128 + _R) * (unsigned)(K * 2) + (unsigned)(_C * 2); } } } while (0)
#define PG8_STAGE_A(bufoff, origptr, nextf, hh, kbytes) do { if constexpr (Sched::GATHER) { _Pragma("unroll") for (int _i = 0; _i < 2; ++_i) { const unsigned _o = (nextf) ? gn[hh][_i] : gc[hh][_i]; \
        __builtin_amdgcn_global_load_lds((const unsigned*)((const char*)g.A + (kbytes) + _o), (PG8_LAS unsigned*)(lds + (bufoff) + ldsw + _i * 8192), 16, 0, 0); } } else { PG8_STAGE(bufoff, origptr, voffA); } } while (0)
#define PG8_STAGE(bufoff, gbase, voff) do { _Pragma("unroll") for (int _i = 0; _i < 2; ++_i) \
        __builtin_amdgcn_global_load_lds((const unsigned*)((const char*)(gbase) + (voff)[_i]), (PG8_LAS unsigned*)(lds + (bufoff) + ldsw + _i * 8192), 16, 0, 0); } while (0)
#define PG8_LDA(dst, b, h) do { _Pragma("unroll") for (int m = 0; m < 4; ++m) _Pragma("unroll") for (int k = 0; k < 2; ++k) dst[m][k] = *(const PG8_LAS bf16x8*)(lds + PG8_SA(b, h) + aoff + m * 2048 + k * 1024); } while (0)
#define PG8_LDB(dst, b, h) do { _Pragma("unroll") for (int n = 0; n < 2; ++n) _Pragma("unroll") for (int k = 0; k < 2; ++k) dst[n][k] = *(const PG8_LAS bf16x8*)(lds + PG8_SB(b, h) + boff + n * 2048 + k * 1024); } while (0)
#define PG8_MMA(ai, bj, At, Bt) do { __builtin_amdgcn_s_setprio(1); _Pragma("unroll") for (int m = 0; m < 4; ++m) _Pragma("unroll") for (int n = 0; n < 2; ++n) _Pragma("unroll") for (int k = 0; k < 2; ++k) \
        acc[ai][bj][m][n] = __builtin_amdgcn_mfma_f32_16x16x32_bf16(Bt[n][k], At[m][k], acc[ai][bj][m][n], 0, 0, 0); __builtin_amdgcn_s_setprio(0); } while (0)
#define PG8_WAIT_V(n) asm volatile("s_waitcnt vmcnt(" #n ")" ::: "memory")
#define PG8_WAIT_L(n) asm volatile("s_waitcnt lgkmcnt(" #n ")" ::: "memory")
#define PG8_BAR __builtin_amdgcn_s_barrier()
#define PG8_SCHED __builtin_amdgcn_sched_barrier(0)
    Unit cur, nxt; int ui = 0;
    if (!S.next(0, cur)) return;
    f32x4 acc[2][2][4][2];
#pragma unroll
    for (int a = 0; a < 2; ++a)
#pragma unroll
        for (int b = 0; b < 2; ++b)
#pragma unroll
            for (int m = 0; m < 4; ++m)
#pragma unroll
                for (int n = 0; n < 2; ++n) acc[a][b][m][n] = (f32x4){0.f, 0.f, 0.f, 0.f};
    bf16x8 At[4][2], B0[2][2], B1[2][2];
    const char* cA = (const char*)g.A + (size_t)cur.pm * tstep; const char* cB = (const char*)g.Bt + (size_t)cur.pn * tstep;
    S.a_ready(cur);
    PG8_GOFF(gc, cur.pm, 0);
    if constexpr (SP2) {
        PG8_STAGE(PG8_SB(0, 0), cB, voffB); PG8_STAGE(PG8_SB(0, 1), cB + bhstep, voffB); PG8_STAGE_A(PG8_SA(0, 0), cA, false, 0, 0); PG8_STAGE_A(PG8_SA(0, 1), cA + hstep, false, 1, 0);
        if (wr == 1) PG8_BAR;
        PG8_WAIT_V(2); PG8_BAR;
        PG8_STAGE(PG8_SB(1, 0), cB + kstepB, voffB); PG8_STAGE_A(PG8_SA(1, 0), cA + kstepA, false, 0, kstep); PG8_STAGE(PG8_SB(1, 1), cB + bhstep + kstepB, voffB);
        PG8_WAIT_V(6); PG8_BAR;
    } else {
        PG8_STAGE(PG8_SB(0, 0), cB, voffB); PG8_STAGE(PG8_SA(0, 0), cA, voffA); PG8_STAGE(PG8_SB(0, 1), cB + bhstep, voffB); PG8_STAGE(PG8_SA(0, 1), cA + hstep, voffA);
        if (wr == 1) PG8_BAR;
        PG8_WAIT_V(4); PG8_BAR;
        PG8_STAGE(PG8_SB(1, 0), cB + kstepB, voffB); PG8_STAGE(PG8_SA(1, 0), cA + kstepA, voffA); PG8_STAGE(PG8_SB(1, 1), cB + bhstep + kstepB, voffB);
        PG8_WAIT_V(6); PG8_BAR;
    }
    for (;;) {
        const bool has_next = S.next(ui + 1, nxt);
        if constexpr (Sched::GATHER) { if (has_next) { PG8_GOFF(gn, nxt.pm, ui + 1); } else { gn[0][0] = gc[0][0]; gn[0][1] = gc[0][1]; gn[1][0] = gc[1][0]; gn[1][1] = gc[1][1]; } }
        const char* nA = has_next ? (const char*)g.A + (size_t)nxt.pm * tstep : cA; const char* nB = has_next ? (const char*)g.Bt + (size_t)nxt.pn * tstep : cB;
#pragma unroll
        for (int seg = 0; seg < (Epi::MID_T > 0 ? 2 : 1); ++seg) {
        if constexpr (Epi::MID_T > 0) { if (seg == 1) { PG8_SCHED; E.mid(acc, cur, wr, wc, fr, fq); PG8_SCHED; } }
        const int t_lo = seg ? Epi::MID_T : 0, t_hi = (Epi::MID_T > 0 && seg == 0) ? Epi::MID_T : nt;
        for (int t = t_lo; t < t_hi; t += 2) {
            const bool last = (t == nt - 2);
            const char* a1 = cA + (size_t)(t + 1) * kstepA;
            const char* a2 = last ? nA : cA + (size_t)(t + 2) * kstepA; const char* b2 = last ? nB : cB + (size_t)(t + 2) * kstepB;
            const char* a3 = a2 + kstepA; const char* b3 = b2 + kstepB; const size_t k2b = last ? (size_t)0 : (size_t)(t + 2) * kstep;
            if (last && has_next) S.a_ready(nxt);
            if constexpr (SP2) {
            PG8_LDB(B0, 0, 0); PG8_LDB(B1, 0, 1); PG8_SCHED; PG8_LDA(At, 0, 0); PG8_STAGE_A(PG8_SA(1, 1), a1 + hstep, false, 1, (size_t)(t + 1) * kstep);
            PG8_WAIT_V(8); PG8_WAIT_L(0); PG8_BAR; PG8_MMA(0, 0, At, B0); PG8_MMA(0, 1, At, B1); PG8_BAR; PG8_SCHED;
            PG8_LDA(At, 0, 1); PG8_STAGE(PG8_SB(0, 0), b2, voffB); PG8_STAGE(PG8_SB(0, 1), b2 + bhstep, voffB); PG8_STAGE_A(PG8_SA(0, 0), a2, last, 0, k2b);
            PG8_WAIT_V(8); PG8_WAIT_L(0); PG8_BAR; PG8_MMA(1, 0, At, B0); PG8_MMA(1, 1, At, B1); PG8_BAR; PG8_SCHED;
            PG8_LDB(B0, 1, 0); PG8_LDB(B1, 1, 1); PG8_SCHED; PG8_LDA(At, 1, 0); PG8_STAGE_A(PG8_SA(0, 1), a2 + hstep, last, 1, k2b);
            PG8_WAIT_V(8); PG8_WAIT_L(0); PG8_BAR; PG8_MMA(0, 0, At, B0); PG8_MMA(0, 1, At, B1); PG8_BAR; PG8_SCHED;
            PG8_LDA(At, 1, 1); PG8_STAGE(PG8_SB(1, 0), b3, voffB); PG8_STAGE(PG8_SB(1, 1), b3 + bhstep, voffB); PG8_STAGE_A(PG8_SA(1, 0), a3, last, 0, k2b + kstep);
            PG8_WAIT_V(8); PG8_WAIT_L(0); PG8_BAR; PG8_MMA(1, 0, At, B0); PG8_MMA(1, 1, At, B1); PG8_BAR; PG8_SCHED;
            } else {
            PG8_LDB(B0, 0, 0); PG8_SCHED; PG8_LDA(At, 0, 0); PG8_STAGE(PG8_SA(1, 1), a1 + hstep, voffA);
            PG8_WAIT_L(8); PG8_BAR; PG8_WAIT_L(0); PG8_MMA(0, 0, At, B0); PG8_BAR; PG8_SCHED;
            PG8_LDB(B1, 0, 1); PG8_STAGE(PG8_SB(0, 0), b2, voffB);
            PG8_BAR; PG8_WAIT_L(0); PG8_MMA(0, 1, At, B1); PG8_BAR;
            PG8_LDA(At, 0, 1); PG8_STAGE(PG8_SA(0, 0), a2, voffA);
            PG8_BAR; PG8_WAIT_L(0); PG8_MMA(1, 0, At, B0); PG8_BAR; PG8_SCHED;
            PG8_STAGE(PG8_SB(0, 1), b2 + bhstep, voffB);
            PG8_WAIT_V(6); PG8_BAR; PG8_MMA(1, 1, At, B1); PG8_BAR;
            PG8_LDB(B0, 1, 0); PG8_SCHED; PG8_LDA(At, 1, 0); PG8_STAGE(PG8_SA(0, 1), a2 + hstep, voffA);
            PG8_WAIT_L(8); PG8_BAR; PG8_WAIT_L(0); PG8_MMA(0, 0, At, B0); PG8_BAR; PG8_SCHED;
            PG8_LDB(B1, 1, 1); PG8_STAGE(PG8_SB(1, 0), b3, voffB);
            PG8_BAR; PG8_WAIT_L(0); PG8_MMA(0, 1, At, B1); PG8_BAR;
            PG8_LDA(At, 1, 1); PG8_STAGE(PG8_SA(1, 0), a3, voffA);
            PG8_BAR; PG8_WAIT_L(0); PG8_MMA(1, 0, At, B0); PG8_BAR; PG8_SCHED;
            PG8_STAGE(PG8_SB(1, 1), b3 + bhstep, voffB);
            PG8_WAIT_V(6); PG8_BAR; PG8_MMA(1, 1, At, B1); PG8_BAR;
            }
        }
        }
        if constexpr (ALIGN_EPI) { if (wr == 0) PG8_BAR; }
        if constexpr (!Epi::AFTER_DRAIN) { E(acc, cur, wr, wc, fr, fq); S.done(cur); }
        if (!has_next) break;
#pragma unroll
        for (int a = 0; a < 2; ++a)
#pragma unroll
            for (int b = 0; b < 2; ++b)
#pragma unroll
                for (int m = 0; m < 4; ++m)
#pragma unroll
                    for (int n = 0; n < 2; ++n) acc[a][b][m][n] = (f32x4){0.f, 0.f, 0.f, 0.f};
        cur = nxt; cA = nA; cB = nB; ++ui;
        if constexpr (Sched::GATHER) { gc[0][0] = gn[0][0]; gc[0][1] = gn[0][1]; gc[1][0] = gn[1][0]; gc[1][1] = gn[1][1]; }
        if constexpr (ALIGN_EPI) { if (wr == 1) PG8_BAR; }
    }
    PG8_WAIT_V(0);
    if constexpr (!ALIGN_EPI) { if (wr == 0) PG8_BAR; }
    PG8_BAR;
    if constexpr (Epi::AFTER_DRAIN) { E.fused(acc, cur, wr, wc, fr, fq, lds, wid, lane); S.done(cur); }
#undef PG8_SA
#undef PG8_SB
#undef PG8_STAGE
#undef PG8_STAGE_A
#undef PG8_GOFF
#undef PG8_LDA
#undef PG8_LDB
#undef PG8_MMA
#undef PG8_WAIT_V
#undef PG8_WAIT_L
#undef PG8_BAR
#undef PG8_SCHED
}
}
#define LAS __attribute__((address_space(3)))
#define XB_TMO      128
#define XB_XCNT(j)  (256  + 64 * (j))
#define XB_XSUB(j)  (1280 + 64 * (j))
#define XB_XGEN(j)  (2304 + 64 * (j))
#define XB_TOP      3328
#define XB_TOPGEN   3392
#define XCD_BAR_WORDS 3456
#define XB_SPIN_CAP (1u << 18)

__device__ __forceinline__ unsigned xb_ld(unsigned* p)              { return __hip_atomic_load(p, __ATOMIC_RELAXED, __HIP_MEMORY_SCOPE_AGENT); }
__device__ __forceinline__ unsigned xb_add(unsigned* p, unsigned v) { return __hip_atomic_fetch_add(p, v, __ATOMIC_RELAXED, __HIP_MEMORY_SCOPE_AGENT); }
__device__ __forceinline__ unsigned xb_xcc_id() { return (unsigned)__builtin_amdgcn_s_getreg((3 << 11) | 20) & 0xFu; }
#define XB_SPIN(cond, bar) do { unsigned _sp = 0; while (cond) { __builtin_amdgcn_s_sleep(1); \
    if ((++_sp & 255u) == 0u) { if (xb_ld(&(bar)[XB_TMO])) break; if (_sp > XB_SPIN_CAP) { atomicAdd(&(bar)[XB_TMO], 1u); break; } } } } while (0)

struct XcdBarrier {
    unsigned* bar; unsigned x;
    volatile LAS unsigned* st;
};

__device__ __forceinline__ XcdBarrier xcd_barrier_post(unsigned* bar, volatile LAS unsigned* st) {
    XcdBarrier b; b.bar = bar; b.x = xb_xcc_id(); b.st = st;
    if (threadIdx.x == 0) (void)xb_add(&bar[XB_XCNT(b.x)], 1u);
    return b;
}
__device__ __forceinline__ void xcd_barrier_complete(unsigned* bar, unsigned x, unsigned& nloc, unsigned& nx) {
    const unsigned G = gridDim.x * gridDim.y * gridDim.z;
    unsigned sum, cnt, mine, sp = 0u;
    for (;;) {
        sum = 0u; cnt = 0u; mine = 0u;
#pragma unroll
        for (unsigned j = 0; j < 16; ++j) { const unsigned c = xb_ld(&bar[XB_XCNT(j)]); sum += c; cnt += (c > 0u) ? 1u : 0u; mine = (j == x) ? c : mine; }
        if (sum == G) break;
        __builtin_amdgcn_s_sleep(1);
        if ((++sp & 255u) == 0u) { if (xb_ld(&bar[XB_TMO])) break; if (sp > XB_SPIN_CAP) { atomicAdd(&bar[XB_TMO], 1u); break; } }
    }
    nloc = mine > 0u ? mine : 1u; nx = cnt > 0u ? cnt : 1u;
}

__device__ __forceinline__ void xcd_barrier(const XcdBarrier& b) {
    asm volatile("s_waitcnt vmcnt(0)" ::: "memory");
    __syncthreads();
    if (threadIdx.x == 0) {
        unsigned* bar = b.bar;
        __builtin_amdgcn_s_waitcnt(0);
        unsigned nloc = b.st[0], nx = b.st[1];
        if (nloc == 0u) { xcd_barrier_complete(bar, b.x, nloc, nx); b.st[0] = nloc; b.st[1] = nx; }
        const unsigned old = xb_add(&bar[XB_XSUB(b.x)], 1u);
        const unsigned gen = old / nloc;
        if (old + 1u == (gen + 1u) * nloc) {
            __builtin_amdgcn_fence(__ATOMIC_RELEASE, "agent");
            asm volatile("s_waitcnt vmcnt(0)" ::: "memory");
            const unsigned og = xb_add(&bar[XB_TOP], 1u);
            const unsigned tg = og / nx;
            if (og + 1u == (tg + 1u) * nx) xb_add(&bar[XB_TOPGEN], 1u);
            else XB_SPIN(xb_ld(&bar[XB_TOPGEN]) == tg, bar);
            __builtin_amdgcn_fence(__ATOMIC_ACQUIRE, "agent");
            xb_add(&bar[XB_XGEN(b.x)], 1u);
            asm volatile("s_waitcnt vmcnt(0)" ::: "memory");
        } else {
            XB_SPIN(xb_ld(&bar[XB_XGEN(b.x)]) == gen, bar);
            __builtin_amdgcn_fence(__ATOMIC_ACQUIRE, "agent");
            asm volatile("s_waitcnt vmcnt(0)" ::: "memory");
        }
    }
    __syncthreads();
}


#ifndef PG8_SP2
#define PG8_SP2 true
#endif
#ifndef PG8_ALIGN
#define PG8_ALIGN true
#endif
constexpr int D = 1024, NB = 8, SEQ = 4096, T = NB * SEQ, NL = 4;
constexpr int NIN = 8704, NE = 32, FF = 1024;
constexpr int RMAX = 139264;
constexpr float LN_EPS = 1e-5f, DN_ALPHA = 1.681792830507429f;
constexpr float QSCALE = 0.18033688011112042f;
constexpr float LOG2E = 1.4426950408889634f;

constexpr size_t MiB = 1u << 20;
constexpr size_t WS_CTL = 0, CTL_ZERO_BYTES = 1 * MiB;
constexpr size_t WS_MOD = 1 * MiB;
constexpr size_t WS_ROPE = 2 * MiB;
constexpr size_t WS_WSP = 3 * MiB;
constexpr size_t WS_WRT = 4 * MiB;
constexpr size_t WS_TOKINFO = 5 * MiB;
constexpr size_t WS_TOKW = 5 * MiB + 512 * 1024;
constexpr size_t WS_ROWTOK = 6 * MiB;
constexpr size_t WS_ROWW = 7 * MiB;
constexpr size_t WS_LSE = 8 * MiB;
constexpr size_t WS_TOKROW = 14 * MiB;
constexpr size_t WS_STAT = 13 * MiB;
constexpr size_t WS_WGCNT = 12 * MiB;
constexpr size_t WS_WIN = 16 * MiB;
constexpr size_t WS_WBA = 84 * MiB;
constexpr size_t WS_WBB = 92 * MiB;
constexpr size_t WS_WOUT = 96 * MiB;
constexpr size_t WS_WUP = 104 * MiB;
constexpr size_t WS_WDN = 616 * MiB;
constexpr size_t WS_H = 872 * MiB;
constexpr size_t WS_X1 = 936 * MiB;
constexpr size_t WS_X2 = 1064 * MiB;
constexpr size_t WS_YPRE = 1192 * MiB;
constexpr size_t WS_U = 1320 * MiB, WS_V = 1384 * MiB;
constexpr size_t WS_Q = 1448 * MiB, WS_K = 1544 * MiB, WS_VV = 1640 * MiB;
constexpr size_t WS_G = 1736 * MiB;
constexpr size_t WS_OG = 1864 * MiB;
constexpr size_t WS_TT = 1960 * MiB;
constexpr size_t WS_OB = 2024 * MiB;
constexpr size_t WS_YA = 2056 * MiB;
constexpr size_t WS_MG = 2120 * MiB;
constexpr size_t WS_XG = 2184 * MiB;
constexpr size_t WS_ACT = 2456 * MiB;
constexpr size_t WS_YK = 2728 * MiB;
constexpr size_t WS_END = 2984 * MiB;
constexpr int CW_BAR = 4096;
constexpr int CW_CNT = 16384;

constexpr int RING_BYTES = 131072;
constexpr int XOFF = RING_BYTES;
constexpr int X_MISC = XOFF;
constexpr int X_SELE = XOFF + 256;
constexpr int X_SELR = XOFF + 2304;
constexpr int X_CNTL = XOFF + 4352;
constexpr int X_BASE = XOFF + 4480;
constexpr int X_TILEE = XOFF + 4608;
constexpr int X_CNTS = XOFF + 5632;
constexpr int X_OFFS = XOFF + 5760;
constexpr int LDS_BYTES = 147456;

#define GAS __attribute__((address_space(1)))
typedef unsigned short bf16;
typedef unsigned v4u __attribute__((ext_vector_type(4)));
typedef unsigned v2u __attribute__((ext_vector_type(2)));
typedef float f32x4 __attribute__((ext_vector_type(4)));
typedef short bf16x8 __attribute__((ext_vector_type(8)));
typedef short s16x4 __attribute__((ext_vector_type(4)));
#define RLX_AGENT __ATOMIC_RELAXED, __HIP_MEMORY_SCOPE_AGENT
#define LDS_WAIT() asm volatile("s_waitcnt lgkmcnt(0)" ::: "memory")
#define VM_WAIT() asm volatile("s_waitcnt vmcnt(0)" ::: "memory")

typedef __bf16 bf16x2_t __attribute__((ext_vector_type(2))); typedef float f32x2_t __attribute__((ext_vector_type(2)));
__device__ __forceinline__ unsigned pk2(float lo, float hi) { return __builtin_bit_cast(unsigned, __builtin_convertvector((f32x2_t){lo, hi}, bf16x2_t)); }
__device__ __forceinline__ float bflo(unsigned w) { return __uint_as_float(w << 16); }
__device__ __forceinline__ float bfhi(unsigned w) { return __uint_as_float(w & 0xffff0000u); }
__device__ __forceinline__ float fexp2(float x) { return __builtin_amdgcn_exp2f(x); }
__device__ __forceinline__ float frcp(float x) { return __builtin_amdgcn_rcpf(x); }
__device__ __forceinline__ float gelu_tanh(float x) { const float u = x + 0.044715f * x * x * x; return x * frcp(1.0f + fexp2(-2.302208198144325f * u)); }
__device__ __forceinline__ float sigmoidf_(float x) { return frcp(1.0f + fexp2(-LOG2E * x)); }
__device__ __forceinline__ float wave_sum(float v) {
#pragma unroll
    for (int o = 1; o < 64; o <<= 1) v += __shfl_xor(v, o);
    return v;
}
__device__ __forceinline__ float wave_max(float v) {
#pragma unroll
    for (int o = 1; o < 64; o <<= 1) v = fmaxf(v, __shfl_xor(v, o));
    return v;
}
__device__ __forceinline__ s16x4 tr16(const LAS unsigned char* p) { return __builtin_bit_cast(s16x4, __builtin_amdgcn_ds_read_tr16_b64_v4i16((LAS s16x4*)p)); }
__device__ __forceinline__ bf16x8 cat8(s16x4 lo, s16x4 hi) { return (bf16x8){lo[0], lo[1], lo[2], lo[3], hi[0], hi[1], hi[2], hi[3]}; }
__device__ __forceinline__ f32x4 mfma16(bf16x8 a, bf16x8 b, f32x4 c) { return __builtin_amdgcn_mfma_f32_16x16x32_bf16(a, b, c, 0, 0, 0); }

struct Frame {
    LAS unsigned char* lds;
    int tid, lane, wave, G, vcu, bx;
    unsigned char* ws;
    const float* const* in;
    float* out;
};
enum { I_X = 0, I_C, I_WADA, I_BADA, I_WIN, I_SPW, I_SPB, I_WBA, I_WBB, I_WOUT, I_LN1G, I_LN1B, I_WR, I_BR, I_WUP, I_BUP, I_WDN, I_BDN, I_LN2G, I_LN2B };
template <class Tp> __device__ __forceinline__ Tp* wsp(const Frame& F, size_t off) { return (Tp*)(F.ws + off); }

template <class P> __device__ __forceinline__ P launder(P p) { unsigned lo = (unsigned)(uintptr_t)p, hi = (unsigned)((uintptr_t)p >> 32); asm volatile("" : "+v"(lo), "+v"(hi));
    lo = (unsigned)__builtin_amdgcn_readfirstlane((int)lo); hi = (unsigned)__builtin_amdgcn_readfirstlane((int)hi); return (P)(((uintptr_t)hi << 32) | (uintptr_t)lo); }
__device__ __forceinline__ unsigned fl_x8(unsigned v) { return (unsigned)__builtin_amdgcn_update_dpp(0, (int)v, 0x128, 0xf, 0xf, false); }
#ifndef FLNT
#define FLNT true
#endif
template <bool NT> __device__ __forceinline__ void fl_put(bf16* p, size_t ld, bool lo, const v4u& w0, const v4u& w1) {
    v4u sd; sd.x = lo ? w1.x : w0.x; sd.y = lo ? w1.y : w0.y; sd.z = lo ? w1.z : w0.z; sd.w = lo ? w1.w : w0.w;
    v4u rc; rc.x = fl_x8(sd.x); rc.y = fl_x8(sd.y); rc.z = fl_x8(sd.z); rc.w = fl_x8(sd.w);
    v4u oa, ob; oa.x = lo ? w0.x : rc.x; oa.y = lo ? w0.y : rc.y; oa.z = lo ? w0.z : rc.z; oa.w = lo ? w0.w : rc.w;
    ob.x = lo ? rc.x : w1.x; ob.y = lo ? rc.y : w1.y; ob.z = lo ? rc.z : w1.z; ob.w = lo ? rc.w : w1.w;
    if (NT) { __builtin_nontemporal_store(oa, (v4u*)p); __builtin_nontemporal_store(ob, (v4u*)(p + 8 * ld)); } else { *(v4u*)p = oa; *(v4u*)(p + 8 * ld) = ob; } }
struct EpiIn {
    static constexpr int MID_T = 0; static constexpr bool PERM = true, AFTER_DRAIN = false, BADJ = true, ABLK = true;
    bf16 *U, *V, *Q, *K, *VV, *Gt; const float* rope;
    __device__ __forceinline__ void operator()(const f32x4 (&acc)[2][2][4][2], const pg8::Unit& u, int wr, int wc, int fr, int fq) const {
        const int pn = u.pn; int type, ld, colt; bf16* base;
        if (pn < 4) { type = 0; base = U; ld = 1024; colt = pn * 256; }
        else if (pn < 8) { type = 0; base = V; ld = 1024; colt = (pn - 4) * 256; }
        else if (pn < 14) { type = 1; base = Q; ld = 1536; colt = (pn - 8) * 256; }
        else if (pn < 20) { type = 2; base = K; ld = 1536; colt = (pn - 14) * 256; }
        else if (pn < 26) { type = 3; base = VV; ld = 1536; colt = (pn - 20) * 256; }
        else { type = 4; base = Gt; ld = 2048; colt = (pn - 26) * 256; }
        const bool lo = fr < 8;
        const int rowl = u.pm * 256 + wr * 64 + fr;
        bf16* const pst = base + (size_t)(u.pm * 256 + wr * 64 + (fr & 7)) * ld + colt + wc * 64 + (fr >> 3) * 32 + 8 * fq;
        if (type == 0) {
#pragma unroll
            for (int ai = 0; ai < 2; ++ai)
#pragma unroll
                for (int m = 0; m < 4; ++m) { v4u w[2];
#pragma unroll
                    for (int bj = 0; bj < 2; ++bj) { const f32x4 v0 = acc[ai][bj][m][0], v1 = acc[ai][bj][m][1];
                        w[bj].x = pk2(gelu_tanh(v0[0]), gelu_tanh(v0[1])); w[bj].y = pk2(gelu_tanh(v0[2]), gelu_tanh(v0[3]));
                        w[bj].z = pk2(gelu_tanh(v1[0]), gelu_tanh(v1[1])); w[bj].w = pk2(gelu_tanh(v1[2]), gelu_tanh(v1[3])); }
                    fl_put<true>(pst + (size_t)(ai * 128 + m * 16) * ld, ld, lo, w[0], w[1]); }
        } else if (type == 4) {
#pragma unroll
            for (int ai = 0; ai < 2; ++ai)
#pragma unroll
                for (int m = 0; m < 4; ++m) { v4u w[2];
#pragma unroll
                    for (int bj = 0; bj < 2; ++bj) { const f32x4 v0 = acc[ai][bj][m][0], v1 = acc[ai][bj][m][1];
                        w[bj].x = pk2(sigmoidf_(v0[0]), sigmoidf_(v0[1])); w[bj].y = pk2(sigmoidf_(v0[2]), sigmoidf_(v0[3]));
                        w[bj].z = pk2(sigmoidf_(v1[0]), sigmoidf_(v1[1])); w[bj].w = pk2(sigmoidf_(v1[2]), sigmoidf_(v1[3])); }
                    fl_put<true>(pst + (size_t)(ai * 128 + m * 16) * ld, ld, lo, w[0], w[1]); }
        } else if (type == 3) {
#pragma unroll
            for (int ai = 0; ai < 2; ++ai)
#pragma unroll
                for (int m = 0; m < 4; ++m) { v4u w[2];
#pragma unroll
                    for (int bj = 0; bj < 2; ++bj) { const f32x4 v0 = acc[ai][bj][m][0], v1 = acc[ai][bj][m][1];
                        w[bj].x = pk2(v0[0], v0[1]); w[bj].y = pk2(v0[2], v0[3]); w[bj].z = pk2(v1[0], v1[1]); w[bj].w = pk2(v1[2], v1[3]); }
                    fl_put<true>(pst + (size_t)(ai * 128 + m * 16) * ld, ld, lo, w[0], w[1]); }
        } else {
            const float sc = (type == 1) ? QSCALE : 1.0f;
#pragma unroll
            for (int ai = 0; ai < 2; ++ai)
#pragma unroll
                for (int m = 0; m < 4; ++m) { const int row = rowl + ai * 128 + m * 16;
                    const f32x4* rp = (const f32x4*)(rope + (size_t)(row & (SEQ - 1)) * 16); const f32x4 c0 = rp[0], c1 = rp[1], s0 = rp[2], s1 = rp[3];
                    float cs[8], sn[8];
#pragma unroll
                    for (int e = 0; e < 4; ++e) { cs[e] = c0[e]; cs[4 + e] = c1[e]; sn[e] = s0[e]; sn[4 + e] = s1[e]; }
                    v4u w[2];
#pragma unroll
                    for (int bj = 0; bj < 2; ++bj) { f32x4 v0 = acc[ai][bj][m][0], v1 = acc[ai][bj][m][1];
                        if (bj == 0) {
#pragma unroll
                            for (int e = 0; e < 8; ++e) { const float x = (e < 4) ? v0[e & 3] : v1[e & 3]; const float p = __shfl_xor(x, 16);
                                float y = x;
                                if (fq == 0) y = x * cs[e] - p * sn[e];
                                if (fq == 1) y = x * cs[e] + p * sn[e];
                                if (e < 4) v0[e & 3] = y; else v1[e & 3] = y; } }
                        w[bj].x = pk2(v0[0] * sc, v0[1] * sc); w[bj].y = pk2(v0[2] * sc, v0[3] * sc); w[bj].z = pk2(v1[0] * sc, v1[1] * sc); w[bj].w = pk2(v1[2] * sc, v1[3] * sc); }
                    fl_put<true>(pst + (size_t)(ai * 128 + m * 16) * ld, ld, lo, w[0], w[1]); }
        }
    }
};
struct EpiProbe {
    static constexpr int MID_T = 0; static constexpr bool PERM = true, AFTER_DRAIN = false, BADJ = false, ABLK = false;
    bf16* O; int ld; int on;
    __device__ __forceinline__ void operator()(const f32x4 (&acc)[2][2][4][2], const pg8::Unit& u, int wr, int wc, int fr, int fq) const {
        if (!on) return;
        const int row0 = u.pm * 256 + wr * 64 + fr, col0 = ((on == 3) ? u.pn : (u.pn & 3)) * 256 + wc * 32 + 8 * fq;
#pragma unroll
        for (int ai = 0; ai < 2; ++ai)
#pragma unroll
            for (int m = 0; m < 4; ++m) { bf16* rowp = O + (size_t)(row0 + ai * 128 + m * 16) * ld + col0;
#pragma unroll
                for (int bj = 0; bj < 2; ++bj) { const f32x4 v0 = acc[ai][bj][m][0], v1 = acc[ai][bj][m][1]; v4u w;
                    w.x = pk2(v0[0], v0[1]); w.y = pk2(v0[2], v0[3]); w.z = pk2(v1[0], v1[1]); w.w = pk2(v1[2], v1[3]);
                    *(v4u*)(rowp + bj * 128) = w; } }
    }
};
struct EpiYA {
    static constexpr int MID_T = 0; static constexpr bool PERM = true, AFTER_DRAIN = false, BADJ = false, ABLK = false;
    const bf16* Gt; bf16* YA;
    __device__ __forceinline__ void operator()(const f32x4 (&acc)[2][2][4][2], const pg8::Unit& u, int wr, int wc, int fr, int fq) const {
        const int row0 = u.pm * 256 + wr * 64 + fr, col0 = u.pn * 256 + wc * 32 + 8 * fq;
#pragma unroll
        for (int ai = 0; ai < 2; ++ai)
#pragma unroll
            for (int m = 0; m < 4; ++m) { const size_t row = (size_t)(row0 + ai * 128 + m * 16);
#pragma unroll
                for (int bj = 0; bj < 2; ++bj) { const f32x4 v0 = acc[ai][bj][m][0], v1 = acc[ai][bj][m][1];
                    const v4u g = *(const v4u*)(Gt + row * 2048 + col0 + bj * 128); v4u w;
                    w.x = pk2(v0[0] * bflo(g.x), v0[1] * bfhi(g.x)); w.y = pk2(v0[2] * bflo(g.y), v0[3] * bfhi(g.y));
                    w.z = pk2(v1[0] * bflo(g.z), v1[1] * bfhi(g.z)); w.w = pk2(v1[2] * bflo(g.w), v1[3] * bfhi(g.w));
                    *(v4u*)(YA + row * 1024 + col0 + bj * 128) = w; } }
    }
};
struct EpiMg {
    static constexpr int MID_T = 0; static constexpr bool PERM = true, AFTER_DRAIN = false, BADJ = false, ABLK = false;
    const bf16* Gt; const bf16* YA; bf16* MG;
    __device__ __forceinline__ void operator()(const f32x4 (&acc)[2][2][4][2], const pg8::Unit& u, int wr, int wc, int fr, int fq) const {
        const int row0 = u.pm * 256 + wr * 64 + fr, col0 = u.pn * 256 + wc * 32 + 8 * fq;
#pragma unroll
        for (int ai = 0; ai < 2; ++ai)
#pragma unroll
            for (int m = 0; m < 4; ++m) { const size_t row = (size_t)(row0 + ai * 128 + m * 16);
#pragma unroll
                for (int bj = 0; bj < 2; ++bj) { const f32x4 v0 = acc[ai][bj][m][0], v1 = acc[ai][bj][m][1];
                    const v4u g = *(const v4u*)(Gt + row * 2048 + 1024 + col0 + bj * 128); const v4u y = *(const v4u*)(YA + row * 1024 + col0 + bj * 128); v4u w;
                    w.x = pk2(bflo(y.x) + v0[0] * bflo(g.x), bfhi(y.x) + v0[1] * bfhi(g.x)); w.y = pk2(bflo(y.y) + v0[2] * bflo(g.y), bfhi(y.y) + v0[3] * bfhi(g.y));
                    w.z = pk2(bflo(y.z) + v1[0] * bflo(g.z), bfhi(y.z) + v1[1] * bfhi(g.z)); w.w = pk2(bflo(y.w) + v1[2] * bflo(g.w), bfhi(y.w) + v1[3] * bfhi(g.w));
                    *(v4u*)(MG + row * 1024 + col0 + bj * 128) = w; } }
    }
};
struct EpiMg2 {
    static constexpr int MID_T = 16; static constexpr bool PERM = true, AFTER_DRAIN = false, BADJ = true, ABLK = false;
    const bf16* Gt; bf16* MG;
    __device__ __forceinline__ void mid(f32x4 (&acc)[2][2][4][2], const pg8::Unit& u, int wr, int wc, int fr, int fq) const {
        int row0 = u.pm * 256 + wr * 64 + fr; const int col0 = u.pn * 256 + wc * 64 + 8 * fq;
        asm volatile("" : "+v"(row0));
#pragma unroll
        for (int ai = 0; ai < 2; ++ai)
#pragma unroll
            for (int m = 0; m < 4; ++m) { const size_t row = (size_t)(row0 + ai * 128 + m * 16);
#pragma unroll
                for (int bj = 0; bj < 2; ++bj) { const v4u g0 = *(const v4u*)(Gt + row * 2048 + col0 + bj * 32), g1 = *(const v4u*)(Gt + row * 2048 + 1024 + col0 + bj * 32);
                    const unsigned a0[4] = {g0.x, g0.y, g0.z, g0.w}, a1[4] = {g1.x, g1.y, g1.z, g1.w};
#pragma unroll
                    for (int q = 0; q < 4; ++q) { const float r0 = bflo(a0[q]) * frcp(fmaxf(bflo(a1[q]), 1e-20f)), r1 = bfhi(a0[q]) * frcp(fmaxf(bfhi(a1[q]), 1e-20f));
                        acc[ai][bj][m][q >> 1][(q & 1) * 2] *= r0; acc[ai][bj][m][q >> 1][(q & 1) * 2 + 1] *= r1; } }
                if (m == 3) asm volatile("" ::: "memory"); }
    }
    __device__ __forceinline__ void operator()(const f32x4 (&acc)[2][2][4][2], const pg8::Unit& u, int wr, int wc, int fr, int fq) const {
        const int row0 = u.pm * 256 + wr * 64 + fr, col0 = u.pn * 256 + wc * 64 + 8 * fq; const bool lo = fr < 8;
        bf16* const pst = MG + (size_t)(u.pm * 256 + wr * 64 + (fr & 7)) * 1024 + u.pn * 256 + wc * 64 + (fr >> 3) * 32 + 8 * fq;
#pragma unroll
        for (int ai = 0; ai < 2; ++ai)
#pragma unroll
            for (int m = 0; m < 4; ++m) { const size_t row = (size_t)(row0 + ai * 128 + m * 16); v4u w[2];
#pragma unroll
                for (int bj = 0; bj < 2; ++bj) { const f32x4 v0 = acc[ai][bj][m][0], v1 = acc[ai][bj][m][1];
                    const v4u g = *(const v4u*)(Gt + row * 2048 + 1024 + col0 + bj * 32);
                    w[bj].x = pk2(v0[0] * fmaxf(bflo(g.x), 1e-20f), v0[1] * fmaxf(bfhi(g.x), 1e-20f)); w[bj].y = pk2(v0[2] * fmaxf(bflo(g.y), 1e-20f), v0[3] * fmaxf(bfhi(g.y), 1e-20f));
                    w[bj].z = pk2(v1[0] * fmaxf(bflo(g.z), 1e-20f), v1[1] * fmaxf(bfhi(g.z), 1e-20f)); w[bj].w = pk2(v1[2] * fmaxf(bflo(g.w), 1e-20f), v1[3] * fmaxf(bfhi(g.w), 1e-20f)); }
                fl_put<false>(pst + (size_t)(ai * 128 + m * 16) * 1024, 1024, lo, w[0], w[1]); }
    }
};
template <bool XF32> struct EpiOut {
    static constexpr int MID_T = 0; static constexpr bool PERM = true, AFTER_DRAIN = false, BADJ = true, ABLK = false;
    const void* xres; const float* modl  ; bf16* YPRE;
    __device__ __forceinline__ void operator()(const f32x4 (&acc)[2][2][4][2], const pg8::Unit& u, int wr, int wc, int fr, int fq) const {
        const int row0 = u.pm * 256 + wr * 64 + fr, col0 = u.pn * 256 + wc * 64 + 8 * fq; const int b = (u.pm * 256) >> 12; const bool lo = fr < 8;
        bf16* const pst = YPRE + (size_t)(u.pm * 256 + wr * 64 + (fr & 7)) * 1024 + u.pn * 256 + wc * 64 + (fr >> 3) * 32 + 8 * fq;
        f32x4 gg[2][2];
#pragma unroll
        for (int bj = 0; bj < 2; ++bj)
#pragma unroll
            for (int n = 0; n < 2; ++n) gg[bj][n] = *(const f32x4*)(modl + (size_t)b * 6144 + 2048 + col0 + bj * 32 + 4 * n) + 1.0f;
#pragma unroll
        for (int ai = 0; ai < 2; ++ai)
#pragma unroll
            for (int m = 0; m < 4; ++m) { const size_t off = (size_t)(row0 + ai * 128 + m * 16) * 1024 + col0; v4u w[2];
#pragma unroll
                for (int bj = 0; bj < 2; ++bj) { f32x4 x0, x1;
                    if (XF32) { x0 = *(const f32x4*)((const float*)xres + off + bj * 32); x1 = *(const f32x4*)((const float*)xres + off + bj * 32 + 4); }
                    else { const v4u xr = *(const v4u*)((const bf16*)xres + off + bj * 32); x0 = (f32x4){bflo(xr.x), bfhi(xr.x), bflo(xr.y), bfhi(xr.y)}; x1 = (f32x4){bflo(xr.z), bfhi(xr.z), bflo(xr.w), bfhi(xr.w)}; }
                    const f32x4 o0 = x0 * DN_ALPHA + gg[bj][0] * acc[ai][bj][m][0], o1 = x1 * DN_ALPHA + gg[bj][1] * acc[ai][bj][m][1];
                    w[bj].x = pk2(o0[0], o0[1]); w[bj].y = pk2(o0[2], o0[3]); w[bj].z = pk2(o1[0], o1[1]); w[bj].w = pk2(o1[2], o1[3]); }
                fl_put<false>(pst + (size_t)(ai * 128 + m * 16) * 1024, 1024, lo, w[0], w[1]);
                if (m == 3) asm volatile("" ::: "memory"); }
    }
};
#ifndef ACT_NT
#define ACT_NT 1
#endif
struct EpiUp {
    static constexpr int MID_T = 0; static constexpr bool PERM = true, AFTER_DRAIN = false, BADJ = false, ABLK = false;
    const float* bup  ; bf16* ACT;
    __device__ __forceinline__ void operator()(const f32x4 (&acc)[2][2][4][2], const pg8::Unit& u, int wr, int wc, int fr, int fq) const {
        const int e = u.pn >> 3, pnl = u.pn & 7; const int row0 = u.pm * 256 + wr * 64 + fr, ac0 = pnl * 128 + wc * 32 + 8 * fq;
        const f32x4* bp = (const f32x4*)(bup + (size_t)e * 2048 + 2 * ac0); const f32x4 b0 = bp[0], b1 = bp[1], b2 = bp[2], b3 = bp[3];
        const float bg[8] = {b0[0], b0[2], b1[0], b1[2], b2[0], b2[2], b3[0], b3[2]}, bl[8] = {b0[1], b0[3], b1[1], b1[3], b2[1], b2[3], b3[1], b3[3]};
#pragma unroll
        for (int ai = 0; ai < 2; ++ai)
#pragma unroll
            for (int m = 0; m < 4; ++m) { float a[8];
#pragma unroll
                for (int j = 0; j < 8; ++j) { const float hg = acc[ai][0][m][j >> 2][j & 3] + bg[j], hl = acc[ai][1][m][j >> 2][j & 3] + bl[j];
                    const float glu = fminf(hg, 7.0f), lin = fminf(fmaxf(hl, -7.0f), 7.0f);
                    a[j] = glu * frcp(1.0f + fexp2(-2.4554669595930156f * glu)) * (lin + 1.0f); }
                v4u w; w.x = pk2(a[0], a[1]); w.y = pk2(a[2], a[3]); w.z = pk2(a[4], a[5]); w.w = pk2(a[6], a[7]);
                { const size_t g16 = (size_t)((u.pm * 256 + wr * 64 + ai * 128 + m * 16) >> 4); unsigned char* lp = (unsigned char*)ACT + ((g16 * 32 + (size_t)(pnl * 4 + wc)) * 8 + (fr & 7)) * 128 + (fr >> 3) * 64 + 16 * fq;
                  if (ACT_NT) __builtin_nontemporal_store(w, (v4u*)lp); else *(v4u*)lp = w; } }
    }
};
struct EpiDn {
    static constexpr int MID_T = 0; static constexpr bool PERM = true, AFTER_DRAIN = false, BADJ = true, ABLK = true;
    const float* bdn  ; bf16* YKS;
    __device__ __forceinline__ void operator()(const f32x4 (&acc)[2][2][4][2], const pg8::Unit& u, int wr, int wc, int fr, int fq) const {
        const int e = u.pn >> 2, pnl = u.pn & 3; const int col0 = pnl * 256 + wc * 64 + 8 * fq; const bool lo = fr < 8;
        bf16* const pst = YKS + (size_t)(u.pm * 256 + wr * 64 + (fr & 7)) * 1024 + pnl * 256 + wc * 64 + (fr >> 3) * 32 + 8 * fq;
        f32x4 bv[2][2];
#pragma unroll
        for (int bj = 0; bj < 2; ++bj)
#pragma unroll
            for (int n = 0; n < 2; ++n) bv[bj][n] = *(const f32x4*)(bdn + (size_t)e * 1024 + col0 + bj * 32 + 4 * n);
#pragma unroll
        for (int ai = 0; ai < 2; ++ai)
#pragma unroll
            for (int m = 0; m < 4; ++m) { v4u w[2];
#pragma unroll
                for (int bj = 0; bj < 2; ++bj) { const f32x4 v0 = acc[ai][bj][m][0] + bv[bj][0], v1 = acc[ai][bj][m][1] + bv[bj][1];
                    w[bj].x = pk2(v0[0], v0[1]); w[bj].y = pk2(v0[2], v0[3]); w[bj].z = pk2(v1[0], v1[1]); w[bj].w = pk2(v1[2], v1[3]); }
                fl_put<FLNT>(pst + (size_t)(ai * 128 + m * 16) * 1024, 1024, lo, w[0], w[1]); }
    }
};
struct MoeOrder {
    static constexpr bool GATHER = false; __device__ __forceinline__ int arow(int, int r) const { return r; }
    int nM, nN, nwg, G, c, rev; const LAS unsigned char* tile_e;
    __device__ void init(int RT, int NN, int G_, int c_, const LAS unsigned char* te, int rev_ = 0) { nM = RT; nN = NN; nwg = RT * NN; G = G_; c = c_; tile_e = te; rev = rev_; }
    __device__ bool next(int i, pg8::Unit& u) const {
        const long L = (long)i * G + c; if (L >= nwg) return false;
        int wgid = (int)L; { const int q = nwg / pg8::NXCD, r = nwg % pg8::NXCD, xcd = wgid % pg8::NXCD, off = wgid / pg8::NXCD; wgid = (xcd < r ? xcd * (q + 1) : r * (q + 1) + (xcd - r) * q) + off; }
        const int nig = pg8::WGM * nN, gid = wgid / nig, fm = gid * pg8::WGM, gsz = (nM - fm) < pg8::WGM ? (nM - fm) : pg8::WGM;
        int pm = fm + ((wgid % nig) % gsz); const int pnl = (wgid % nig) / gsz; if (rev) pm = nM - 1 - pm;
        u.pm = pm; u.pn = (int)tile_e[pm] * nN + pnl; return true;
    }
    __device__ __forceinline__ void a_ready(const pg8::Unit&) const {}
    __device__ __forceinline__ void done(const pg8::Unit&) const {}
};

#ifndef STAG_N
#define STAG_N 1
#endif
#ifndef STAG_US
#define STAG_US 24
#endif
__device__ __forceinline__ void stagger(int slot, int us) {
    if (STAG_N <= 1) return;
    const unsigned long long t0 = __builtin_amdgcn_s_memrealtime(); const unsigned long long ticks = (unsigned long long)(slot % STAG_N) * (unsigned)us * 100ull / STAG_N;
    while (__builtin_amdgcn_s_memrealtime() - t0 < ticks) __builtin_amdgcn_s_sleep(16);
}
struct MoeGatherOrder : MoeOrder {
    static constexpr bool GATHER = true; const LAS unsigned short* tokl;
    __device__ __forceinline__ int arow(int ord, int r) const { return (int)tokl[ord * 256 + (r & 255)]; }
};
constexpr int X_TOKL = XOFF + 6144, TOKL_UNITS = 20;
constexpr int TR_NR = 32, TR_WAVE_BYTES = 64 * 64 * 4;
struct TrItem { const float* src; bf16* dst; int ld, K, kind, k0, c0, koff; };
__device__ __forceinline__ void tr_load(const TrItem& t, int lane, f32x4 (&r)[TR_NR]) {
    const int kq = lane >> 4, cc = lane & 15;
#pragma unroll
    for (int i = 0; i < TR_NR; ++i) r[i] = __builtin_nontemporal_load((const f32x4*)(t.src + (size_t)(t.k0 + 2 * (kq + 4 * (i >> 1)) + (i & 1)) * t.ld + t.c0 + 4 * cc));
}
__device__ __forceinline__ void tr_tile(int lane, LAS unsigned* scr, const f32x4 (&r)[TR_NR]) {
    const int kq = lane >> 4, cc = lane & 15;
#pragma unroll
    for (int i2 = 0; i2 < TR_NR / 2; ++i2) { LAS unsigned* p = scr + (4 * cc) * 64 + ((kq + 4 * i2) ^ (cc << 2));
#pragma unroll
        for (int e = 0; e < 4; ++e) p[e * 64] = pk2(r[2 * i2][e], r[2 * i2 + 1][e]); }
    LDS_WAIT(); asm volatile("" ::: "memory");
}
__device__ __forceinline__ void tr_store(const TrItem& t, int lane, const LAS unsigned* scr) {
    const int line = lane >> 3, half = (lane >> 2) & 1, piece = lane & 3;
    const int pbase = (t.kind == 0) ? t.c0 : (256 * (t.c0 >> 8) + ((t.c0 & 255) >> 1));
    const int kb0 = (t.koff + t.k0) >> 5, KB = t.K >> 5;
#pragma unroll
    for (int j = 0; j < 16; ++j) { const int q = 16 * (j >> 2) + line + 8 * half, cb = j & 3, c = 4 * cb + piece;
        const int n = (t.kind == 0) ? q : (2 * (q & 31) + (q >> 5)); const int drow = (t.kind == 0) ? (pbase + q) : (pbase + 128 * (q >> 5) + (q & 31));
        const v4u o = *(const LAS v4u*)(scr + n * 64 + ((c ^ ((n >> 2) & 15)) << 2));
        unsigned char* dp = (unsigned char*)t.dst + ((size_t)((drow >> 4) * KB + kb0 + cb) * 8 + (drow & 7)) * 128 + ((drow >> 3) & 1) * 64 + piece * 16;
        __builtin_nontemporal_store(o, (v4u*)dp); }
    LDS_WAIT(); asm volatile("" ::: "memory");
}
__device__ __forceinline__ void sincos_d(double a, double& s, double& c) {
    const double k = rint(a * 0.63661977236758134308);
    const double y = fma(-k, 6.12323399573676603587e-17, fma(-k, 1.57079632679489655800, a));
    const double y2 = y * y;
    double sp = -7.6471637318198164759e-13; sp = fma(sp, y2, 1.6059043836821614599e-10); sp = fma(sp, y2, -2.5052108385441718775e-8); sp = fma(sp, y2, 2.7557319223985890653e-6);
    sp = fma(sp, y2, -1.9841269841269841270e-4); sp = fma(sp, y2, 8.3333333333333333333e-3); sp = fma(sp, y2, -1.6666666666666666667e-1); const double sy = fma(sp * y2, y, y);
    double cp = 4.7794773323873852974e-14; cp = fma(cp, y2, -1.1470745597729724714e-11); cp = fma(cp, y2, 2.0876756987868098979e-9); cp = fma(cp, y2, -2.7557319223985890653e-7);
    cp = fma(cp, y2, 2.4801587301587301587e-5); cp = fma(cp, y2, -1.3888888888888888889e-3); cp = fma(cp, y2, 4.1666666666666666667e-2); cp = fma(cp, y2, -0.5); const double cy = fma(cp, y2, 1.0);
    const int q = ((int)k) & 3;
    s = (q == 0) ? sy : (q == 1) ? cy : (q == 2) ? -sy : -cy;
    c = (q == 0) ? cy : (q == 1) ? -sy : (q == 2) ? -cy : sy;
}
__device__ __forceinline__ void phase_pro_a(Frame& F) {
    LAS unsigned* scr = (LAS unsigned*)(F.lds + F.wave * TR_WAVE_BYTES);
    const int gw = F.vcu * 8 + F.wave, NGW = F.G * 8;
    constexpr int I_IN = 8 * 136, I_SQ = 8 * 16, I_BB = 4 * 16, I_UP = 8 * 32;
    constexpr int S0 = NL * I_IN, S1 = S0 + NL * I_SQ, S2 = S1 + NL * I_BB, S3 = S2 + NL * I_SQ, S4 = S3 + NL * NE * I_SQ, S5 = S4 + NL * NE * I_UP;
    auto decode = [&](int it) -> TrItem { TrItem t; t.koff = 0;
        if (it < S0) { const int l = it / I_IN, r = it % I_IN; t.src = F.in[I_WIN] + (size_t)l * D * NIN; t.dst = wsp<bf16>(F, WS_WIN) + (size_t)l * NIN * D; t.ld = NIN; t.K = D; t.kind = 0; t.k0 = 128 * (r / 136); t.c0 = 64 * (r % 136); }
        else if (it < S1) { const int q = it - S0, l = q / I_SQ, r = q % I_SQ; t.src = F.in[I_WBA] + (size_t)l * D * D; t.dst = wsp<bf16>(F, WS_WBA) + (size_t)l * D * 1536; t.ld = D; t.K = 1536; t.kind = 0; t.k0 = 128 * (r / 16); t.c0 = 64 * (r % 16); }
        else if (it < S2) { const int q = it - S1, l = q / I_BB, r = q % I_BB; t.src = F.in[I_WBB] + (size_t)l * 512 * D; t.dst = wsp<bf16>(F, WS_WBA) + (size_t)l * D * 1536; t.ld = D; t.K = 1536; t.koff = 1024; t.kind = 0; t.k0 = 128 * (r / 16); t.c0 = 64 * (r % 16); }
        else if (it < S3) { const int q = it - S2, l = q / I_SQ, r = q % I_SQ; t.src = F.in[I_WOUT] + (size_t)l * D * D; t.dst = wsp<bf16>(F, WS_WOUT) + (size_t)l * D * D; t.ld = D; t.K = D; t.kind = 0; t.k0 = 128 * (r / 16); t.c0 = 64 * (r % 16); }
        else if (it < S4) { const int q = it - S3, le = q / I_SQ, r = q % I_SQ; t.src = F.in[I_WDN] + (size_t)le * FF * D; t.dst = wsp<bf16>(F, WS_WDN) + (size_t)le * D * FF; t.ld = D; t.K = FF; t.kind = 0; t.k0 = 128 * (r / 16); t.c0 = 64 * (r % 16); }
        else { const int q = it - S4, le = q / I_UP, r = q % I_UP; t.src = F.in[I_WUP] + (size_t)le * D * 2048; t.dst = wsp<bf16>(F, WS_WUP) + (size_t)le * 2048 * D; t.ld = 2048; t.K = D; t.kind = 1; t.k0 = 128 * (r / 32); t.c0 = 64 * (r % 32); }
        return t; };
    {
        f32x4 rn[TR_NR]; TrItem tn; int it = gw;
        if (it < S5) { tn = decode(it); tr_load(tn, F.lane, rn); }
#pragma unroll 1
        for (; it < S5; it += NGW) {
            const TrItem tc = tn;
            tr_tile(F.lane, scr, rn);
            if (it + NGW < S5) { tn = decode(it + NGW); tr_load(tn, F.lane, rn); }
            tr_store(tc, F.lane, scr);
        }
    }
    __syncthreads();
    {
        LAS float* cT = (LAS float*)F.lds;
        LAS float* red = (LAS float*)(F.lds + 32768);
        const float* cv = F.in[I_C];
        for (int i = F.tid; i < 8 * 1024; i += 512) { const int bb = i >> 10, k = i & 1023; cT[k * 8 + bb] = cv[i]; }
        __syncthreads();
        const int hf = F.lane >> 5, c4 = F.lane & 31;
        for (int u = F.vcu; u < NL * 48; u += F.G) {
            const int l = u / 48, n0 = 128 * (u % 48);
            f32x4 a[8];
#pragma unroll
            for (int bb = 0; bb < 8; ++bb) a[bb] = (f32x4){0.f, 0.f, 0.f, 0.f};
            const int kb = F.wave * 128 + hf;
            const float* wp = F.in[I_WADA] + (size_t)l * D * 6144 + (size_t)kb * 6144 + n0 + 4 * c4;
#pragma unroll 8
            for (int kk = 0; kk < 64; ++kk) { const f32x4 w = *(const f32x4*)(wp + (size_t)(2 * kk) * 6144);
                const f32x4 c0 = *(const LAS f32x4*)(cT + (kb + 2 * kk) * 8), c1 = *(const LAS f32x4*)(cT + (kb + 2 * kk) * 8 + 4);
#pragma unroll
                for (int bb = 0; bb < 4; ++bb) { a[bb] += w * c0[bb]; a[4 + bb] += w * c1[bb]; } }
#pragma unroll
            for (int bb = 0; bb < 8; ++bb) *(LAS f32x4*)(red + ((F.wave * 2 + hf) * 8 + bb) * 128 + 4 * c4) = a[bb];
            __syncthreads();
#pragma unroll
            for (int q = 0; q < 2; ++q) { const int o = F.tid + 512 * q, bb = o >> 7, cn = o & 127; float sum = F.in[I_BADA][l * 6144 + n0 + cn];
#pragma unroll
                for (int p = 0; p < 16; ++p) sum += red[(p * 8 + bb) * 128 + cn];
                wsp<float>(F, WS_MOD)[(size_t)(l * 8 + bb) * 6144 + n0 + cn] = sum; }
            __syncthreads();
        }
    }
    const int gt = F.vcu * 512 + F.tid, NT = F.G * 512;
    for (int i = gt; i < SEQ * 8; i += NT) { const int pos = i >> 3, f = i & 7;
        const double inv = (f == 0) ? 1.0 : (f == 1) ? 0.19392274474868576 : (f == 2) ? 0.03760603093086393 : (f == 3) ? 0.007292664737217109 : (f == 4) ? 0.001414213562373095 : (f == 5) ? 0.0002742481756762073 : (f == 6) ? 5.318295896944988e-05 : 1.031338537721246e-05;
        double s, c; sincos_d((double)pos * inv, s, c);
        float* rp = wsp<float>(F, WS_ROPE) + (size_t)pos * 16; rp[f] = (float)c; rp[8 + f] = (float)s; }
    for (int i = gt; i < NL * 4 * 128 * 128; i += NT) { const int j = i & 127, ii = (i >> 7) & 127; const float w = F.in[I_SPW][i];
        wsp<bf16>(F, WS_WSP)[i] = (bf16)(pk2((j <= ii) ? w : 0.f, 0.f) & 0xffffu); }
    for (int i = gt; i < NL * NE * D; i += NT) { const int k = i & 1023, e = (i >> 10) & 31, l = i >> 15; const float w = F.in[I_WR][((size_t)l * D + k) * NE + e];
        const unsigned hi = pk2(w, 0.f) & 0xffffu; const float lo = w - __uint_as_float(hi << 16);
        wsp<bf16>(F, WS_WRT)[i] = (bf16)hi; wsp<bf16>(F, WS_WRT)[NL * NE * D + i] = (bf16)(pk2(lo, 0.f) & 0xffffu); }
}
__device__ __forceinline__ v2u* hblk(bf16* H, int m, int lane) { return (v2u*)((unsigned char*)H + ((size_t)((m >> 4) * 32 + (lane >> 3)) * 8 + (m & 7)) * 128 + ((m >> 3) & 1) * 64 + (lane & 7) * 8); }
__device__ __forceinline__ void phase_pro_b(Frame& F) {
    const int gw = F.vcu * 8 + F.wave, NGW = F.G * 8;
    const float* mod = wsp<float>(F, WS_MOD);
    for (int m = gw; m < T; m += NGW) { const int b = m >> 12; const float* mb = mod + (size_t)b * 6144;
        const f32x4* xr = (const f32x4*)(F.in[I_X] + (size_t)m * D) + F.lane; v2u* hp = hblk(wsp<bf16>(F, WS_H), m, F.lane);
#pragma unroll
        for (int j = 0; j < 4; ++j) { const f32x4 x = xr[64 * j]; const f32x4 sh = *((const f32x4*)mb + F.lane + 64 * j), sc = *((const f32x4*)(mb + 1024) + F.lane + 64 * j);
            const f32x4 h = x * (sc + 1.0f) + sh; v2u o; o.x = pk2(h[0], h[1]); o.y = pk2(h[2], h[3]); hp[1024 * j] = o; } }
}

constexpr int AT_RS = 144;
constexpr int AT_ROWS = 400, AT_VOFF = AT_ROWS * AT_RS;
#define LDS_BARRIER() do { asm volatile("s_waitcnt lgkmcnt(0)" ::: "memory"); __builtin_amdgcn_s_barrier(); asm volatile("" ::: "memory"); } while (0)
#ifndef ATT_NT
#define ATT_NT true
#endif
struct AtUnit { int g, b, h, r, n, d; size_t hoff; };
__device__ __forceinline__ AtUnit at_decode(int u) { AtUnit a; a.g = u >> 10; const int rem = u & 1023; a.b = rem >> 7; a.h = (rem >> 4) & 7; const int rn = rem & 15;
    const int dsh = 2 * a.g, nbs = 4 - dsh; a.d = 1 << dsh; a.r = rn >> nbs; a.n = 2 * (rn & ((1 << nbs) - 1)); a.hoff = (size_t)a.g * 512 + a.h * 64; return a; }
constexpr int AT_NU = 3 * 1024;
struct AtSlot { v4u k[6], v[6]; bf16x8 q0, q1, q2, q3; };
struct AtCtx { const bf16 *Qb, *Kb, *Vb; bf16* OG; float* LSE; LAS unsigned char *Ks, *Vs; int qi, g4, piece, jr; };
__device__ __forceinline__ void at_load(AtSlot& sl, int uu, const AtCtx& C, const Frame& F) {
    const AtUnit a_ = at_decode(uu);
#pragma unroll
    for (int ps = 0; ps < 6; ++ps) { const int lp = 128 * (a_.n - 1) + ps * 64 + C.jr; sl.k[ps] = (v4u){0u, 0u, 0u, 0u}; sl.v[ps] = sl.k[ps];
        if (lp >= 0) { const size_t off = ((size_t)a_.b * SEQ + (size_t)lp * a_.d + a_.r) * 1536 + a_.hoff + C.piece * 8; sl.k[ps] = *(const v4u*)(C.Kb + off); sl.v[ps] = *(const v4u*)(C.Vb + off); } }
    const size_t qrow_ = (size_t)a_.b * SEQ + (size_t)(128 * a_.n + 16 * F.wave + C.qi) * a_.d + a_.r; const bf16* qp = C.Qb + qrow_ * 1536 + a_.hoff + 8 * C.g4;
    sl.q0 = *(const bf16x8*)qp; sl.q1 = *(const bf16x8*)(qp + 32);
    const bf16* qp2 = qp + (size_t)128 * a_.d * 1536; sl.q2 = *(const bf16x8*)qp2; sl.q3 = *(const bf16x8*)(qp2 + 32);
}
__device__ __forceinline__ void at_unit(AtSlot& sl, int u, int unext, const AtCtx& C, const Frame& F) {
    bf16* OG = C.OG; float* LSE = C.LSE; LAS unsigned char* Ks = C.Ks; LAS unsigned char* Vs = C.Vs; const int qi = C.qi, g4 = C.g4;
    const AtUnit au = at_decode(u); const int g = au.g, b = au.b, h = au.h, r = au.r, n = au.n, d = au.d;
#pragma unroll
    for (int ps = 0; ps < 6; ++ps) { const int j = ps * 64 + C.jr; *(LAS v4u*)(Ks + j * AT_RS + C.piece * 16) = sl.k[ps]; *(LAS v4u*)(Vs + j * AT_RS + C.piece * 16) = sl.v[ps]; }
    const bf16x8 sl_q0 = sl.q0, sl_q1 = sl.q1, sl_q2 = sl.q2, sl_q3 = sl.q3;
    LDS_BARRIER();
    if (unext < AT_NU) at_load(sl, unext, C, F);
#pragma unroll
    for (int tq = 0; tq < 2; ++tq)
        {
            const int iq = 128 * tq + 16 * F.wave + qi; const int rb = 128 * tq + 16 * F.wave; const bf16x8 qf0 = tq ? sl_q2 : sl_q0, qf1 = tq ? sl_q3 : sl_q1; const size_t qrow = (size_t)b * SEQ + (size_t)(128 * n + iq) * d + r;
            f32x4 s[10]; float mx = -1e30f; const int dq = qi - 4 * g4; const bool first = (n == 0) && (tq == 0);
#pragma unroll
            for (int st = 0; st < 9; ++st) {
                const LAS unsigned char* kp = Ks + (rb + 16 * st + qi) * AT_RS + g4 * 16;
                const bf16x8 k0 = *(const LAS bf16x8*)kp, k1 = *(const LAS bf16x8*)(kp + 64);
                f32x4 a = (f32x4){0.f, 0.f, 0.f, 0.f};
                a = mfma16(k0, qf0, a); a = mfma16(k1, qf1, a);
                if (st == 0) {
#pragma unroll
                    for (int i = 0; i < 4; ++i) a[i] = (i >= dq) ? a[i] : -1e30f; }
                if (st == 8) {
#pragma unroll
                    for (int i = 0; i < 4; ++i) a[i] = (i <= dq) ? a[i] : -1e30f; }
                if (first) {
#pragma unroll
                    for (int i = 0; i < 4; ++i) a[i] = (rb + 16 * st + 4 * g4 + i >= 128) ? a[i] : -1e30f; }
#pragma unroll
                for (int i = 0; i < 4; ++i) mx = fmaxf(mx, a[i]);
                s[st] = a;
            }
            mx = fmaxf(mx, __shfl_xor(mx, 16)); mx = fmaxf(mx, __shfl_xor(mx, 32));
            float sum = 0.f;
#pragma unroll
            for (int st = 0; st < 9; ++st)
#pragma unroll
                for (int i = 0; i < 4; ++i) { const float p = fexp2(s[st][i] - mx); s[st][i] = p; sum += p; }
            s[9] = (f32x4){0.f, 0.f, 0.f, 0.f};
            sum += __shfl_xor(sum, 16); sum += __shfl_xor(sum, 32);
            f32x4 o[4];
#pragma unroll
            for (int dt = 0; dt < 4; ++dt) o[dt] = (f32x4){0.f, 0.f, 0.f, 0.f};
#pragma unroll
            for (int c = 0; c < 5; ++c) {
                v4u pw; pw.x = pk2(s[2 * c][0], s[2 * c][1]); pw.y = pk2(s[2 * c][2], s[2 * c][3]); pw.z = pk2(s[2 * c + 1][0], s[2 * c + 1][1]); pw.w = pk2(s[2 * c + 1][2], s[2 * c + 1][3]);
                const bf16x8 pf = __builtin_bit_cast(bf16x8, pw);
                const LAS unsigned char* vp = Vs + (rb + 32 * c + 4 * g4 + (qi >> 2)) * AT_RS + 8 * (qi & 3);
#pragma unroll
                for (int dt = 0; dt < 4; ++dt) { const s16x4 lo = tr16(vp + 32 * dt), hi = tr16(vp + 32 * dt + 16 * AT_RS);
                    o[dt] = mfma16(cat8(lo, hi), pf, o[dt]); }
            }
            const float inv = 1.0f / sum;
            { v2u w[4];
#pragma unroll
              for (int dt = 0; dt < 4; ++dt) { w[dt].x = pk2(o[dt][0] * inv, o[dt][1] * inv); w[dt].y = pk2(o[dt][2] * inv, o[dt][3] * inv); }
              const bool od = (g4 & 1) != 0; const int pp = g4 >> 1;
              const unsigned s0x = od ? w[0].x : w[1].x, s0y = od ? w[0].y : w[1].y, s1x = od ? w[2].x : w[3].x, s1y = od ? w[2].y : w[3].y;
              const unsigned r0x = (unsigned)__shfl_xor((int)s0x, 16), r0y = (unsigned)__shfl_xor((int)s0y, 16), r1x = (unsigned)__shfl_xor((int)s1x, 16), r1y = (unsigned)__shfl_xor((int)s1y, 16);
              v4u c0, c1;
              c0.x = od ? r0x : w[0].x; c0.y = od ? r0y : w[0].y; c0.z = od ? w[1].x : r0x; c0.w = od ? w[1].y : r0y;
              c1.x = od ? r1x : w[2].x; c1.y = od ? r1y : w[2].y; c1.z = od ? w[3].x : r1x; c1.w = od ? w[3].y : r1y;
              const size_t qrowA = (size_t)b * SEQ + (size_t)(128 * n + 128 * tq + 16 * F.wave + (qi & 7)) * d + r;
              bf16* pA = OG + ((size_t)g * T + qrowA) * 512 + h * 64 + (qi >> 3) * 32 + (od ? 16 : 0) + 8 * pp;
              fl_put<ATT_NT>(pA, (size_t)512 * d, qi < 8, c0, c1); }
            if (g4 == 0) LSE[((size_t)g * T + qrow) * 8 + h] = mx + __log2f(sum);
        }
    LDS_BARRIER();
}
__device__ __forceinline__ void phase_attn(Frame& F) {
    AtCtx C; C.Qb = wsp<bf16>(F, WS_Q); C.Kb = wsp<bf16>(F, WS_K); C.Vb = wsp<bf16>(F, WS_VV); C.OG = wsp<bf16>(F, WS_OG); C.LSE = wsp<float>(F, WS_LSE);
    C.Ks = F.lds; C.Vs = F.lds + AT_VOFF; C.qi = F.lane & 15; C.g4 = F.lane >> 4; C.piece = F.tid & 7; C.jr = F.tid >> 3;
    if (F.tid < 144) { *(LAS v4u*)(C.Ks + 384 * AT_RS + F.tid * 16) = (v4u){0u, 0u, 0u, 0u}; *(LAS v4u*)(C.Vs + 384 * AT_RS + F.tid * 16) = (v4u){0u, 0u, 0u, 0u}; }
    AtSlot sa; const int u0 = F.vcu, G = F.G;
    if (u0 < AT_NU) at_load(sa, u0, C, F);
#pragma unroll 1
    for (int u = u0; u < AT_NU; u += G) at_unit(sa, u, u + G, C, F);
}

constexpr int SG_WOFF = 69632, SG_WRS = 264;
constexpr int SG_RS = 528;
__device__ __forceinline__ void phase_sg(Frame& F, int l) {
    const bf16* Ub = wsp<bf16>(F, WS_U); const bf16* Vb = wsp<bf16>(F, WS_V); bf16* TT = wsp<bf16>(F, WS_TT);
    const bf16* OG = wsp<bf16>(F, WS_OG); const float* LSE = wsp<float>(F, WS_LSE); bf16* OB = wsp<bf16>(F, WS_OB);
    const bf16* Wsp = wsp<bf16>(F, WS_WSP); const float* spb = F.in[I_SPB];
    LAS unsigned char* Vn = F.lds;
    const int qi = F.lane & 15, g4 = F.lane >> 4;
    const int l32 = F.lane & 31;
    v4u vraw[8];
#define SG_LOAD(uu) do { const int gi_ = (uu) & 3, m0_ = ((uu) >> 2) * 128; \
        _Pragma("unroll") for (int ps = 0; ps < 8; ++ps) vraw[ps] = *(const v4u*)(Vb + (size_t)(m0_ + 16 * ps + 2 * F.wave + (F.lane >> 5)) * 1024 + gi_ * 256 + 8 * l32); } while (0)
    if (F.vcu < 1024) SG_LOAD(F.vcu);
    const bool wlds = (F.G & 3) == 0; LAS unsigned char* Wl = F.lds + SG_WOFF;
    if (wlds) { const bf16* wsrc = Wsp + (size_t)(l * 4 + (F.vcu & 3)) * 128 * 128;
        for (int i = F.tid; i < 128 * 16; i += 512) { const int row = i >> 4, ch = i & 15; const v4u wv = *(const v4u*)(wsrc + row * 128 + ch * 8);
            *(LAS v2u*)(Wl + row * SG_WRS + ch * 16) = (v2u){wv.x, wv.y}; *(LAS v2u*)(Wl + row * SG_WRS + ch * 16 + 8) = (v2u){wv.z, wv.w}; } }
    for (int u = F.vcu; u < 1024; u += F.G) {
        const int gi = u & 3, m0 = (u >> 2) * 128;
        float ml[4][3]; v4u mo[4][3]; const int sub = F.tid & 7;
#pragma unroll
        for (int ps = 0; ps < 4; ++ps) { const int p = (F.tid >> 3) + 64 * ps; const size_t tok = (size_t)m0 + (p >> 1); const int hd = 2 * gi + (p & 1); const size_t off = tok * 512 + hd * 64 + 8 * sub;
#pragma unroll
            for (int gq = 0; gq < 3; ++gq) { ml[ps][gq] = LSE[((size_t)gq * T + tok) * 8 + hd]; mo[ps][gq] = *(const v4u*)(OG + (size_t)gq * T * 512 + off); } }
        {
            float sm[8], mean[8], rs[8];
#pragma unroll
            for (int ps = 0; ps < 8; ++ps) { const v4u raw = vraw[ps]; sm[ps] = ((bflo(raw.x) + bfhi(raw.x)) + (bflo(raw.y) + bfhi(raw.y))) + ((bflo(raw.z) + bfhi(raw.z)) + (bflo(raw.w) + bfhi(raw.w))); }
#pragma unroll
            for (int o = 1; o < 32; o <<= 1) {
#pragma unroll
                for (int ps = 0; ps < 8; ++ps) sm[ps] += __shfl_xor(sm[ps], o); }
#pragma unroll
            for (int ps = 0; ps < 8; ++ps) { const v4u raw = vraw[ps]; mean[ps] = sm[ps] * (1.0f / 256.0f); float q = 0.f;
                const float x[8] = {bflo(raw.x), bfhi(raw.x), bflo(raw.y), bfhi(raw.y), bflo(raw.z), bfhi(raw.z), bflo(raw.w), bfhi(raw.w)};
#pragma unroll
                for (int e = 0; e < 8; ++e) { const float dx = x[e] - mean[ps]; q += dx * dx; }
                sm[ps] = q; }
#pragma unroll
            for (int o = 1; o < 32; o <<= 1) {
#pragma unroll
                for (int ps = 0; ps < 8; ++ps) sm[ps] += __shfl_xor(sm[ps], o); }
#pragma unroll
            for (int ps = 0; ps < 8; ++ps) { rs[ps] = 1.0f / sqrtf(sm[ps] * (1.0f / 256.0f) + LN_EPS); const v4u raw = vraw[ps]; const int j = 16 * ps + 2 * F.wave + (F.lane >> 5);
                const float x[8] = {bflo(raw.x), bfhi(raw.x), bflo(raw.y), bfhi(raw.y), bflo(raw.z), bfhi(raw.z), bflo(raw.w), bfhi(raw.w)};
                v4u w; w.x = pk2((x[0] - mean[ps]) * rs[ps], (x[1] - mean[ps]) * rs[ps]); w.y = pk2((x[2] - mean[ps]) * rs[ps], (x[3] - mean[ps]) * rs[ps]);
                w.z = pk2((x[4] - mean[ps]) * rs[ps], (x[5] - mean[ps]) * rs[ps]); w.w = pk2((x[6] - mean[ps]) * rs[ps], (x[7] - mean[ps]) * rs[ps]);
                *(LAS v4u*)(Vn + j * SG_RS + l32 * 16) = w; }
        }
        LDS_BARRIER();
        if (u + F.G < 1024) SG_LOAD(u + F.G);
        {
#pragma unroll
          for (int ps = 0; ps < 4; ++ps) { const int p = (F.tid >> 3) + 64 * ps; const size_t tok = (size_t)m0 + (p >> 1); const int hd = 2 * gi + (p & 1);
              const float l0 = ml[ps][0], l1 = ml[ps][1], l2 = ml[ps][2];
              const float mxx = fmaxf(l0, fmaxf(l1, l2)); float w0 = fexp2(l0 - mxx), w1 = fexp2(l1 - mxx), w2 = fexp2(l2 - mxx); const float inv = 1.0f / (w0 + w1 + w2); w0 *= inv; w1 *= inv; w2 *= inv;
              const size_t off = tok * 512 + hd * 64 + 8 * sub;
              const v4u a = mo[ps][0], bq = mo[ps][1], cq = mo[ps][2]; v4u w;
              w.x = pk2(w0 * bflo(a.x) + w1 * bflo(bq.x) + w2 * bflo(cq.x), w0 * bfhi(a.x) + w1 * bfhi(bq.x) + w2 * bfhi(cq.x));
              w.y = pk2(w0 * bflo(a.y) + w1 * bflo(bq.y) + w2 * bflo(cq.y), w0 * bfhi(a.y) + w1 * bfhi(bq.y) + w2 * bfhi(cq.y));
              w.z = pk2(w0 * bflo(a.z) + w1 * bflo(bq.z) + w2 * bflo(cq.z), w0 * bfhi(a.z) + w1 * bfhi(bq.z) + w2 * bfhi(cq.z));
              w.w = pk2(w0 * bflo(a.w) + w1 * bflo(bq.w) + w2 * bflo(cq.w), w0 * bfhi(a.w) + w1 * bfhi(bq.w) + w2 * bfhi(cq.w));
              *(v4u*)(TT + tok * 1536 + 1024 + hd * 64 + 8 * sub) = w; } }
        v2u uq[8][2]; float ubias[8];
#pragma unroll
        for (int it = 0; it < 8; ++it) { const int i = 16 * it + qi; ubias[it] = spb[(l * 4 + gi) * 128 + i]; const size_t rowo = (size_t)(m0 + i) * 1024 + gi * 256 + 32 * F.wave + 4 * g4;
            uq[it][0] = *(const v2u*)(Ub + rowo); uq[it][1] = *(const v2u*)(Ub + rowo + 16); }
        {
            f32x4 acc[2][8];
#pragma unroll
            for (int ct = 0; ct < 2; ++ct)
#pragma unroll
                for (int it = 0; it < 8; ++it) acc[ct][it] = (f32x4){0.f, 0.f, 0.f, 0.f};
            const bf16* wbase = Wsp + (size_t)(l * 4 + gi) * 128 * 128 + (size_t)qi * 128 + 4 * g4;
#pragma unroll
            for (int kc = 0; kc < 4; ++kc) {
                bf16x8 af[2];
#pragma unroll
                for (int ct = 0; ct < 2; ++ct) { const LAS unsigned char* p = Vn + (32 * kc + 4 * g4 + (qi >> 2)) * SG_RS + (32 * F.wave + 16 * ct + 4 * (qi & 3)) * 2;
                    af[ct] = cat8(tr16(p), tr16(p + 16 * SG_RS)); }
#pragma unroll
                for (int it = 0; it < 8; ++it) if (it >= 2 * kc) {
                    const bf16* wp = wbase + (size_t)(16 * it) * 128 + 32 * kc; const LAS unsigned char* wq = Wl + (16 * it + qi) * SG_WRS + (32 * kc + 4 * g4) * 2;
                    const v2u b0 = wlds ? *(const LAS v2u*)wq : *(const v2u*)wp, b1 = wlds ? *(const LAS v2u*)(wq + 32) : *(const v2u*)(wp + 16);
                    const bf16x8 bfr = __builtin_bit_cast(bf16x8, (v4u){b0.x, b0.y, b1.x, b1.y});
                    acc[0][it] = mfma16(af[0], bfr, acc[0][it]); acc[1][it] = mfma16(af[1], bfr, acc[1][it]); }
            }
#pragma unroll
            for (int it = 0; it < 8; ++it) { const int i = 16 * it + qi; const float bias = ubias[it]; const size_t rowo = (size_t)(m0 + i) * 1536 + gi * 256 + 32 * F.wave + 4 * g4;
#pragma unroll
                for (int ct = 0; ct < 2; ++ct) { const v2u uu = uq[it][ct]; const f32x4 a = acc[ct][it]; v2u w;
                    w.x = pk2(bflo(uu.x) * (a[0] + bias), bfhi(uu.x) * (a[1] + bias)); w.y = pk2(bflo(uu.y) * (a[2] + bias), bfhi(uu.y) * (a[3] + bias));
                    *(v2u*)(TT + rowo + 16 * ct) = w; } }
        }
        LDS_BARRIER();
    }
#undef SG_LOAD
}

__device__ __forceinline__ void phase_ln1(Frame& F, int l, bool commit) {
    const bf16* YPRE = wsp<bf16>(F, WS_YPRE); bf16* H = wsp<bf16>(F, WS_H);
    const float* modl = wsp<float>(F, WS_MOD) + (size_t)l * 8 * 6144;
    const float* lg = F.in[I_LN1G] + l * D; const float* lb = F.in[I_LN1B] + l * D; const float* br = F.in[I_BR] + l * NE;
    const bf16* WH = wsp<bf16>(F, WS_WRT) + (size_t)l * NE * D; const bf16* WL = WH + (size_t)NL * NE * D;
    int* TOKINFO = wsp<int>(F, WS_TOKINFO); float* TOKW = wsp<float>(F, WS_TOKW);
    unsigned* cntg = wsp<unsigned>(F, WS_CTL) + CW_CNT + (size_t)l * NE * 64;
    LAS int* sel_e = (LAS int*)(F.lds + X_SELE);
    const int lane = F.lane, qi = lane & 15, g4 = lane >> 4;
    { const v4u* srcw = (const v4u*)WH;
#pragma unroll 4
      for (int i = F.tid; i < 2 * NE * 128; i += 512) { const int hl = i >> 12, e = (i >> 7) & 31, c = i & 127;
          *(LAS v4u*)(F.lds + hl * 65536 + e * 2048 + ((c ^ (e & 15)) << 4)) = srcw[(size_t)hl * (NL * NE * 128) + e * 128 + c]; } }
    __syncthreads();
    for (int tb = F.vcu; tb < T / 128; tb += F.G) {
        const int m0 = tb * 128; const int b = m0 >> 12; const float* mb = modl + (size_t)b * 6144; const int mw = m0 + 16 * F.wave;
        v2u pre[4][4];
#pragma unroll
        for (int r = 0; r < 4; ++r)
#pragma unroll
            for (int j = 0; j < 4; ++j) pre[r][j] = *((const v2u*)(YPRE + (size_t)(mw + r) * D) + lane + 64 * j);
#pragma unroll 1
        for (int rp = 0; rp < 4; ++rp) {
            f32x4 hh[4][4]; float mean[4], rstd[4];
            const int mrow = mw + 4 * rp;
#pragma unroll
            for (int r = 0; r < 4; ++r)
#pragma unroll
                for (int j = 0; j < 4; ++j) hh[r][j] = (f32x4){bflo(pre[r][j].x), bfhi(pre[r][j].x), bflo(pre[r][j].y), bfhi(pre[r][j].y)};
            if (rp < 3) {
#pragma unroll
                for (int r = 0; r < 4; ++r)
#pragma unroll
                    for (int j = 0; j < 4; ++j) pre[r][j] = *((const v2u*)(YPRE + (size_t)(mrow + 4 + r) * D) + lane + 64 * j); }
            { float sm[4], sq[4];
#pragma unroll
              for (int r = 0; r < 4; ++r) { sm[r] = 0.f; sq[r] = 0.f;
#pragma unroll
                  for (int j = 0; j < 4; ++j) { sm[r] += (hh[r][j][0] + hh[r][j][1]) + (hh[r][j][2] + hh[r][j][3]);
                      sq[r] += (hh[r][j][0] * hh[r][j][0] + hh[r][j][1] * hh[r][j][1]) + (hh[r][j][2] * hh[r][j][2] + hh[r][j][3] * hh[r][j][3]); } }
#pragma unroll
              for (int o = 1; o < 64; o <<= 1) {
#pragma unroll
                  for (int r = 0; r < 4; ++r) { sm[r] += __shfl_xor(sm[r], o); sq[r] += __shfl_xor(sq[r], o); } }
#pragma unroll
              for (int r = 0; r < 4; ++r) { mean[r] = sm[r] * (1.0f / D); rstd[r] = 1.0f / sqrtf(fmaxf(sq[r] * (1.0f / D) - mean[r] * mean[r], 0.f) + LN_EPS); } }
            if (lane < 4) { const float mq = (lane == 0) ? mean[0] : (lane == 1) ? mean[1] : (lane == 2) ? mean[2] : mean[3], rq = (lane == 0) ? rstd[0] : (lane == 1) ? rstd[1] : (lane == 2) ? rstd[2] : rstd[3];
                float* st = wsp<float>(F, WS_STAT) + (size_t)(mrow + lane) * 2; st[0] = mq; st[1] = rq; }
#pragma unroll
            for (int j = 0; j < 4; ++j) { const f32x4 gq = *((const f32x4*)lg + lane + 64 * j), bq = *((const f32x4*)lb + lane + 64 * j);
                const f32x4 shq = *((const f32x4*)(mb + 3072) + lane + 64 * j), scq = *((const f32x4*)(mb + 4096) + lane + 64 * j) + 1.0f;
#pragma unroll
                for (int r = 0; r < 4; ++r) { const f32x4 x1 = (hh[r][j] - mean[r]) * rstd[r] * gq + bq;
                    const f32x4 h2 = x1 * scq + shq; v2u o; o.x = pk2(h2[0], h2[1]); o.y = pk2(h2[2], h2[3]); *((v2u*)(H + (size_t)(mrow + r) * D) + lane + 64 * j) = o;
 } }
        }
        VM_WAIT(); asm volatile("" ::: "memory");
        f32x4 c0 = (f32x4){0.f, 0.f, 0.f, 0.f}, c1 = c0;
        { const bf16* hp = H + (size_t)(mw + qi) * D + 8 * g4;
          const LAS unsigned char* w0 = F.lds + qi * 2048; const LAS unsigned char* w1 = F.lds + (16 + qi) * 2048;
#pragma unroll 8
          for (int ks = 0; ks < 32; ++ks) {
              const bf16x8 hhi = *(const bf16x8*)(hp + 32 * ks);
              const int co = ((4 * ks + g4) ^ qi) << 4;
              const bf16x8 a0h = *(const LAS bf16x8*)(w0 + co), a0l = *(const LAS bf16x8*)(w0 + 65536 + co);
              const bf16x8 a1h = *(const LAS bf16x8*)(w1 + co), a1l = *(const LAS bf16x8*)(w1 + 65536 + co);
              c0 = mfma16(a0h, hhi, c0); c0 = mfma16(a0l, hhi, c0);
              c1 = mfma16(a1h, hhi, c1); c1 = mfma16(a1l, hhi, c1); } }
        {
            float v[8]; int id[8];
#pragma unroll
            for (int i = 0; i < 4; ++i) { id[i] = 4 * g4 + i; id[4 + i] = 16 + 4 * g4 + i; v[i] = c0[i] + br[4 * g4 + i]; v[4 + i] = c1[i] + br[16 + 4 * g4 + i]; }
            int ek[4]; float vk[4];
#pragma unroll
            for (int k = 0; k < 4; ++k) { float lm = v[0]; int li = id[0];
#pragma unroll
                for (int j = 1; j < 8; ++j) if (v[j] > lm) { lm = v[j]; li = id[j]; }
#pragma unroll
                for (int o = 16; o <= 32; o <<= 1) { const float om = __shfl_xor(lm, o); const int oi = __shfl_xor(li, o); if (om > lm || (om == lm && oi < li)) { lm = om; li = oi; } }
                ek[k] = li; vk[k] = lm;
#pragma unroll
                for (int j = 0; j < 8; ++j) if (id[j] == li) v[j] = -INFINITY; }
            const float e1 = __expf(vk[1] - vk[0]), e2 = __expf(vk[2] - vk[0]), e3 = __expf(vk[3] - vk[0]); const float inv = 1.0f / (1.0f + e1 + e2 + e3);
            if (g4 == 0) { const int tl = 16 * F.wave + qi;
                sel_e[tl * 4 + 0] = ek[0]; sel_e[tl * 4 + 1] = ek[1]; sel_e[tl * 4 + 2] = ek[2]; sel_e[tl * 4 + 3] = ek[3];
                *(f32x4*)(TOKW + (size_t)(m0 + tl) * 4) = (f32x4){inv, e1 * inv, e2 * inv, e3 * inv}; }
        }
        __syncthreads();
        { const int myE = sel_e[F.tid]; LAS unsigned long long* bm = (LAS unsigned long long*)(F.lds + X_SELR); unsigned long long mine = 0ull;
#pragma unroll
          for (int e = 0; e < 32; ++e) { const unsigned long long m = __ballot(myE == e); if (lane == e) mine = m; }
          if (lane < 32) bm[F.wave * 32 + lane] = mine;
          __syncthreads();
          int rk = __popcll(bm[F.wave * 32 + myE] & ((1ull << lane) - 1ull));
#pragma unroll
          for (int w = 0; w < 8; ++w) if (w < F.wave) rk += __popcll(bm[w * 32 + myE]);
          TOKINFO[(size_t)m0 * 4 + F.tid] = myE | (rk << 8);
          if (F.tid < 32) { int tot = 0;
#pragma unroll
              for (int w = 0; w < 8; ++w) tot += __popcll(bm[w * 32 + F.tid]);
              wsp<int>(F, WS_WGCNT)[((size_t)l * 256 + tb) * 32 + F.tid] = tot; if (tot && commit) (void)__hip_atomic_fetch_add(cntg + F.tid * 64, (unsigned)tot, RLX_AGENT); } }
        __syncthreads();
    }
}

__device__ __forceinline__ int moe_tables(Frame& F, int l) {
    const unsigned* cntg = wsp<unsigned>(F, WS_CTL) + CW_CNT + (size_t)l * NE * 64;
    LAS int* cnt_s = (LAS int*)(F.lds + X_CNTS); LAS int* off_s = (LAS int*)(F.lds + X_OFFS); LAS unsigned char* tile_e = (LAS unsigned char*)(F.lds + X_TILEE);
    if (F.tid < 32) cnt_s[F.tid] = (int)__hip_atomic_load(cntg + F.tid * 64, RLX_AGENT);
    __syncthreads();
    if (F.tid < 64) {
        const int e = F.tid & 31; const int c = (F.tid < 32) ? cnt_s[e] : 0; const int nt = (c + 255) >> 8; int incl = nt;
#pragma unroll
        for (int o = 1; o < 32; o <<= 1) { const int v = __shfl_up(incl, o); if ((F.tid & 63) >= o) incl += v; }
        if (F.tid < 32) { const int excl = incl - nt; off_s[e] = excl * 256; for (int t = 0; t < nt; ++t) tile_e[excl + t] = (unsigned char)e; if (e == 31) off_s[32] = incl * 256; }
    }
    __syncthreads();
    return off_s[32] >> 8;
}
__device__ __forceinline__ void phase_scat(Frame& F, int l) {
    (void)moe_tables(F, l);
    const LAS int* off_s = (const LAS int*)(F.lds + X_OFFS); const LAS int* cnt_s = (const LAS int*)(F.lds + X_CNTS); LAS int* base_s = (LAS int*)(F.lds + X_BASE);
    const int* TOKINFO = wsp<int>(F, WS_TOKINFO); const float* TOKW = wsp<float>(F, WS_TOKW);
    int* ROWTOK = wsp<int>(F, WS_ROWTOK); float* ROWW = wsp<float>(F, WS_ROWW); const int* WGC = wsp<int>(F, WS_WGCNT) + (size_t)l * 256 * 32; int* TOKINFO2 = wsp<int>(F, WS_TOKROW);
    for (int tb = F.vcu; tb < T / 128; tb += F.G) {
        if (F.tid < 32) base_s[F.tid] = 0;
        __syncthreads();
        { const int e = F.tid & 31, part = F.tid >> 5; int sacc = 0;
          for (int t2 = part * 16; t2 < part * 16 + 16; ++t2) if (t2 < tb) sacc += WGC[t2 * 32 + e];
          if (sacc) atomicAdd((int*)&base_s[e], sacc); }
        __syncthreads();
        { const size_t ent = (size_t)tb * 512 + F.tid; const int info = TOKINFO[ent]; const int e = info & 255, row = off_s[e] + base_s[e] + (info >> 8);
          ROWTOK[row] = (int)ent; ROWW[row] = TOKW[ent]; TOKINFO2[ent] = row; }
        __syncthreads();
    }
    if (F.vcu == 0) for (int e = 0; e < NE; ++e) for (int r = off_s[e] + cnt_s[e] + F.tid; r < off_s[e + 1]; r += 512) { ROWTOK[r] = 0; ROWW[r] = 0.f; }
}
__device__ __forceinline__ void phase_ln2(Frame& F, int l) {
    const bf16* X1 = wsp<bf16>(F, WS_YPRE); const bf16* YK = wsp<bf16>(F, WS_XG); bf16* H = wsp<bf16>(F, WS_H); const int* TOKROW = wsp<int>(F, WS_TOKROW); const float* TOKW = wsp<float>(F, WS_TOKW);
    const float* STAT = wsp<float>(F, WS_STAT); const float* l1g = F.in[I_LN1G] + l * D; const float* l1b = F.in[I_LN1B] + l * D;
    float* XO = F.out; bf16* XB = wsp<bf16>(F, WS_X2);
    const float* modl = wsp<float>(F, WS_MOD) + (size_t)l * 8 * 6144; const float* modn = wsp<float>(F, WS_MOD) + (size_t)((l + 1) & 3) * 8 * 6144;
    const float* lg = F.in[I_LN2G] + l * D; const float* lb = F.in[I_LN2B] + l * D;
    const int lane = F.lane; const int gw = F.vcu * 8 + F.wave, NGW = F.G * 8;
    v2u px[4]; v2u py[4][4]; float pst[2], nst[2]; f32x4 pw4, nw4;
#define LN2_LOAD(mm) do { nst[0] = STAT[(size_t)(mm) * 2]; nst[1] = STAT[(size_t)(mm) * 2 + 1]; nw4 = *(const f32x4*)(TOKW + (size_t)(mm) * 4); \
        int rw_[4]; _Pragma("unroll") for (int k = 0; k < 4; ++k) rw_[k] = TOKROW[(size_t)(mm) * 4 + k]; \
        _Pragma("unroll") for (int j = 0; j < 4; ++j) { px[j] = __builtin_nontemporal_load((const v2u*)(X1 + (size_t)(mm) * D) + lane + 64 * j); \
        _Pragma("unroll") for (int k = 0; k < 4; ++k) py[j][k] = __builtin_nontemporal_load((const v2u*)(YK + (size_t)rw_[k] * D) + lane + 64 * j); } } while (0)
    if (gw < T) LN2_LOAD(gw);
#pragma unroll 1
    for (int m = gw; m < T; m += NGW) { const int b = m >> 12; const float* mb = modl + (size_t)b * 6144; const float* mn = modn + (size_t)b * 6144;
        f32x4 v[4]; float s = 0.f; pst[0] = nst[0]; pst[1] = nst[1]; pw4 = nw4;
#pragma unroll
        for (int j = 0; j < 4; ++j) { f32x4 y = (f32x4){0.f, 0.f, 0.f, 0.f};
#pragma unroll
            for (int k = 0; k < 4; ++k) { const v2u w = py[j][k]; const float cw = pw4[k]; y[0] += cw * bflo(w.x); y[1] += cw * bfhi(w.x); y[2] += cw * bflo(w.y); y[3] += cw * bfhi(w.y); }
            const f32x4 g2 = *((const f32x4*)(mb + 5120) + lane + 64 * j) + 1.0f;
            const f32x4 pxf = (f32x4){bflo(px[j].x), bfhi(px[j].x), bflo(px[j].y), bfhi(px[j].y)};
            const f32x4 x1 = (pxf - pst[0]) * pst[1] * *((const f32x4*)l1g + lane + 64 * j) + *((const f32x4*)l1b + lane + 64 * j);
            v[j] = x1 * DN_ALPHA + g2 * y; s += (v[j][0] + v[j][1]) + (v[j][2] + v[j][3]); }
        if (m + NGW < T) LN2_LOAD(m + NGW);
        float s2 = 0.f;
#pragma unroll
        for (int j = 0; j < 4; ++j) s2 += (v[j][0] * v[j][0] + v[j][1] * v[j][1]) + (v[j][2] * v[j][2] + v[j][3] * v[j][3]);
#pragma unroll
        for (int o = 1; o < 64; o <<= 1) { s += __shfl_xor(s, o); s2 += __shfl_xor(s2, o); }
        const float mean = s * (1.0f / D); const float rstd = 1.0f / sqrtf(fmaxf(s2 * (1.0f / D) - mean * mean, 0.f) + LN_EPS);
#pragma unroll
        for (int j = 0; j < 4; ++j) v[j] = v[j] - mean;
        f32x4* xo = (f32x4*)(XO + (size_t)m * D) + lane; v2u* xb = (v2u*)(XB + (size_t)m * D) + lane; v2u* ho = hblk(H, m, lane);
#pragma unroll
        for (int j = 0; j < 4; ++j) { const f32x4 gvj = *((const f32x4*)lg + lane + 64 * j), bvj = *((const f32x4*)lb + lane + 64 * j); const f32x4 x2 = v[j] * rstd * gvj + bvj;
            if (l == NL - 1) __builtin_nontemporal_store(x2, xo + 64 * j); else { v2u xq; xq.x = pk2(x2[0], x2[1]); xq.y = pk2(x2[2], x2[3]); __builtin_nontemporal_store(xq, xb + 64 * j); }
            if (l < NL - 1) { const f32x4 sh = *((const f32x4*)mn + lane + 64 * j), sc = *((const f32x4*)(mn + 1024) + lane + 64 * j) + 1.0f; const f32x4 h = x2 * sc + sh;
                v2u o; o.x = pk2(h[0], h[1]); o.y = pk2(h[2], h[3]); ho[1024 * j] = o; } } }
#undef LN2_LOAD
}

#ifndef PH_MASK
#define PH_MASK 0xFFFF
#endif
#define PHM(b) ((PH_MASK >> (b)) & 1)
#ifndef DUP_MASK
#define DUP_MASK 0
#endif
#define REPS(b) (((DUP_MASK >> (b)) & 1) ? 2 : 1)
constexpr int NPH_L = 10, NPHASE = 2 + NL * NPH_L;
struct Args { const float* in[20]; float* out; unsigned char* ws; int ph_lo, ph_hi; };
__global__ void __launch_bounds__(512, 2) fwd(Args args) {
    extern __shared__ __attribute__((aligned(16))) unsigned char lds[];
    Frame F;
    F.lds = (LAS unsigned char*)lds;
#define FRESH() do { int zv_ = 0; asm volatile("" : "+v"(zv_)); const int z_ = __builtin_amdgcn_readfirstlane(zv_); \
        F.tid = (int)threadIdx.x + zv_; F.lane = F.tid & 63; F.wave = __builtin_amdgcn_readfirstlane(F.tid >> 6); \
        F.G = (int)gridDim.x + z_; F.bx = (int)blockIdx.x + z_; F.vcu = (F.G % 8 == 0) ? (F.bx % 8) * (F.G / 8) + F.bx / 8 : F.bx; \
        F.ws = args.ws + z_; F.in = args.in + z_; F.out = args.out + z_; F.lds = (LAS unsigned char*)lds + z_; } while (0)
    FRESH();
    for (int u = F.tid; u < (LDS_BYTES - XOFF) / 4; u += 512) ((LAS unsigned*)(F.lds + XOFF))[u] = 0u;
    __syncthreads();
    unsigned* ctl = wsp<unsigned>(F, WS_CTL);
    XcdBarrier bar; bar.bar = ctl + CW_BAR; bar.x = 0; bar.st = nullptr;
    if (!MK_PER_PHASE) bar = xcd_barrier_post(ctl + CW_BAR, (volatile LAS unsigned*)(F.lds + X_MISC) + 8);
    const int lo = args.ph_lo, hi = args.ph_hi;
#define IN(k) (lo <= (k) && (k) < hi)
#ifndef BAR_REPS
#define BAR_REPS 1
#endif
#define SEAM(k) do { if (!MK_PER_PHASE && IN(k) && IN((k) + 1)) for (int br_ = 0; br_ < BAR_REPS; ++br_) xcd_barrier(bar); } while (0)

    if (PHM(0) && IN(0)) for (int rep = 0; rep < REPS(0); ++rep) { FRESH(); phase_pro_a(F); } SEAM(0);
    if (PHM(1) && IN(1)) for (int rep = 0; rep < REPS(1); ++rep) { FRESH(); phase_pro_b(F); } SEAM(1);
    for (int l = 0; l < NL; ++l) {
        const int pb = 2 + l * NPH_L;
        if (PHM(2) && IN(pb + 0)) for (int rep = 0; rep < REPS(2); ++rep) { FRESH();
            pg8::Gemm g{wsp<bf16>(F, WS_H), wsp<bf16>(F, WS_WIN) + (size_t)l * NIN * D, T, NIN, D}; pg8::StaticOrder S; S.init(T, NIN, F.G, F.bx);
            EpiIn E{wsp<bf16>(F, WS_U), wsp<bf16>(F, WS_V), wsp<bf16>(F, WS_Q), wsp<bf16>(F, WS_K), wsp<bf16>(F, WS_VV), wsp<bf16>(F, WS_G), wsp<float>(F, WS_ROPE)};
            stagger(F.bx >> 3, STAG_US);
            pg8::gemm_phase<EpiIn, pg8::StaticOrder, PG8_ALIGN, PG8_SP2>(F.lds, g, S, E, F.tid);
#if defined(XPROBE)
            { FRESH(); pg8::Gemm g2{wsp<bf16>(F, WS_H), wsp<bf16>(F, WS_WIN) + (size_t)l * NIN * D, T, NIN, D}; pg8::StaticOrder S2; S2.init(T, NIN, F.G, F.bx);
              EpiProbe E2{wsp<bf16>(F, WS_XG), (XPROBE == 3) ? NIN : 1024, (XPROBE >= 2) ? (XPROBE == 3 ? 3 : 1) : (F.G == 0x7ffffff0 ? 1 : 0)};
              pg8::gemm_phase<EpiProbe, pg8::StaticOrder, PG8_ALIGN, PG8_SP2>(F.lds, g2, S2, E2, F.tid); }
#endif
        } SEAM(pb + 0);
        if (PHM(3) && IN(pb + 1)) for (int rep = 0; rep < REPS(3); ++rep) { FRESH(); phase_attn(F); } SEAM(pb + 1);
        if (PHM(4) && IN(pb + 2)) for (int rep = 0; rep < REPS(4); ++rep) { FRESH(); phase_sg(F, l); } SEAM(pb + 2);
        if (PHM(5) && IN(pb + 3)) for (int rep = 0; rep < REPS(5); ++rep) { FRESH();
            pg8::Gemm g{wsp<bf16>(F, WS_TT), wsp<bf16>(F, WS_WBA) + (size_t)l * D * 1536, T, D, 1536}; pg8::StaticOrder S; S.init(T, D, F.G, F.bx);
            EpiMg2 E{wsp<bf16>(F, WS_G), wsp<bf16>(F, WS_MG)}; pg8::gemm_phase<EpiMg2, pg8::StaticOrder, PG8_ALIGN, PG8_SP2>(F.lds, g, S, E, F.tid);
        } SEAM(pb + 3);
        if (PHM(6) && IN(pb + 4)) for (int rep = 0; rep < REPS(6); ++rep) { FRESH();
            pg8::Gemm g{wsp<bf16>(F, WS_MG), wsp<bf16>(F, WS_WOUT) + (size_t)l * D * D, T, D, D}; pg8::StaticOrder S; S.init(T, D, F.G, F.bx);
            if (l == 0) { EpiOut<true> E{(const void*)F.in[I_X], wsp<float>(F, WS_MOD) + (size_t)l * 8 * 6144, wsp<bf16>(F, WS_YPRE)}; pg8::gemm_phase<EpiOut<true>, pg8::StaticOrder, PG8_ALIGN, PG8_SP2>(F.lds, g, S, E, F.tid); }
            else { EpiOut<false> E{(const void*)wsp<bf16>(F, WS_X2), wsp<float>(F, WS_MOD) + (size_t)l * 8 * 6144, wsp<bf16>(F, WS_YPRE)}; pg8::gemm_phase<EpiOut<false>, pg8::StaticOrder, PG8_ALIGN, PG8_SP2>(F.lds, g, S, E, F.tid); }
        } SEAM(pb + 4);
        if (PHM(7) && IN(pb + 5)) for (int rep = 0; rep < REPS(7); ++rep) { FRESH(); phase_ln1(F, l, rep == 0); } SEAM(pb + 5);
        if (PHM(8) && IN(pb + 6)) for (int rep = 0; rep < REPS(8); ++rep) { FRESH(); phase_scat(F, l); } SEAM(pb + 6);
        if (PHM(9) && IN(pb + 7)) for (int rep = 0; rep < REPS(9); ++rep) { FRESH();
            const int RT = moe_tables(F, l);
            pg8::Gemm g{wsp<bf16>(F, WS_H), wsp<bf16>(F, WS_WUP) + (size_t)l * NE * 2048 * D, RT * 256, NE * 2048, D};
            MoeGatherOrder S; S.init(RT, 8, F.G, F.bx, (const LAS unsigned char*)(F.lds + X_TILEE)); S.tokl = (const LAS unsigned short*)(F.lds + X_TOKL);
            { const int* rowtok = wsp<int>(F, WS_ROWTOK); LAS unsigned short* tl = (LAS unsigned short*)(F.lds + X_TOKL); pg8::Unit uu;
              for (int i = 0; i < TOKL_UNITS && S.next(i, uu); ++i) if (F.tid < 256) tl[i * 256 + F.tid] = (unsigned short)(rowtok[uu.pm * 256 + F.tid] >> 2);
              __syncthreads(); }
            EpiUp E{F.in[I_BUP] + (size_t)l * NE * 2048, wsp<bf16>(F, WS_ACT)};
            stagger(F.bx >> 3, STAG_US);
            pg8::gemm_phase<EpiUp, MoeGatherOrder, PG8_ALIGN, true>(F.lds, g, S, E, F.tid);
        } SEAM(pb + 7);
        if (PHM(10) && IN(pb + 8)) for (int rep = 0; rep < REPS(10); ++rep) { FRESH();
            const int RT = moe_tables(F, l);
            pg8::Gemm g{wsp<bf16>(F, WS_ACT), wsp<bf16>(F, WS_WDN) + (size_t)l * NE * D * FF, RT * 256, NE * D, FF};
            MoeOrder S; S.init(RT, 4, F.G, F.bx, (const LAS unsigned char*)(F.lds + X_TILEE), 1);
            EpiDn E{F.in[I_BDN] + (size_t)l * NE * D, wsp<bf16>(F, WS_XG)};
            stagger(F.bx >> 3, STAG_US);
            pg8::gemm_phase<EpiDn, MoeOrder, PG8_ALIGN, PG8_SP2>(F.lds, g, S, E, F.tid);
        } SEAM(pb + 8);
        if (PHM(11) && IN(pb + 9)) for (int rep = 0; rep < REPS(11); ++rep) { FRESH(); phase_ln2(F, l); } SEAM(pb + 9);
    }
#undef IN
#undef SEAM
#undef FRESH
}

extern "C" void kernel_launch(void* const* d_in, const int* in_sizes, int n_in, void* d_out, int out_size, void* d_ws, size_t ws_size, hipStream_t stream) {
    static int grid = 0;
    if (grid == 0) {
        if (n_in != 20 || out_size != T * D || ws_size < WS_END) { fprintf(stderr, "kernel_launch: unexpected shapes (n_in %d, out %d, ws %zu < %zu)\n", n_in, out_size, ws_size, (size_t)WS_END); grid = -1; return; }
        int dev = 0, cus = 0;
        if (hipGetDevice(&dev) != hipSuccess || hipDeviceGetAttribute(&cus, hipDeviceAttributeMultiprocessorCount, dev) != hipSuccess) { grid = -1; return; }
        if (hipFuncSetAttribute((const void*)fwd, hipFuncAttributeMaxDynamicSharedMemorySize, LDS_BYTES) != hipSuccess) { fprintf(stderr, "kernel_launch: hipFuncSetAttribute failed\n"); grid = -1; return; }
        int per_cu = 0;
        if (hipOccupancyMaxActiveBlocksPerMultiprocessor(&per_cu, (const void*)fwd, 512, LDS_BYTES) != hipSuccess || per_cu < 1) fprintf(stderr, "kernel_launch: occupancy query says %d blocks per CU\n", per_cu);
        (void)hipGetLastError();
        grid = cus;
    }
    if (grid < 0) return;
    (void)in_sizes;
    if (hipMemsetAsync((char*)d_ws + WS_CTL, 0, CTL_ZERO_BYTES, stream) != hipSuccess) return;
    Args a{};
    for (int i = 0; i < 20; ++i) a.in[i] = (const float*)d_in[i];
    a.out = (float*)d_out; a.ws = (unsigned char*)d_ws;
#if MK_PER_PHASE
    for (int p = 0; p < NPHASE; ++p) { a.ph_lo = p; a.ph_hi = p + 1; hipLaunchKernelGGL(fwd, dim3(grid), dim3(512), LDS_BYTES, stream, a); }
#else
    a.ph_lo = 0; a.ph_hi = NPHASE;
    hipLaunchKernelGGL(fwd, dim3(grid), dim3(512), LDS_BYTES, stream, a);
#endif
    const hipError_t le = hipPeekAtLastError();
    if (le != hipSuccess) fprintf(stderr, "kernel_launch: launch failed: %s\n", hipGetErrorName(le));
}
```

```cpp
#include <hip/hip_runtime.h>
#include <cstdio>
#include <cstdint>
#ifndef MK_PER_PHASE
#define MK_PER_PHASE 0
#endif
namespace pg8 {
#define PG8_LAS __attribute__((address_space(3)))
typedef unsigned short bf16_t;
typedef short bf16x8 __attribute__((ext_vector_type(8)));
typedef float f32x4 __attribute__((ext_vector_type(4)));
typedef unsigned u32x4 __attribute__((ext_vector_type(4)));
constexpr int BM = 256, BK = 64, HALF = 128, HTB = HALF * BK * 2  , STAGE_BYTES = 8 * HTB, NXCD = 8;
#ifndef PG8_WGM
#define PG8_WGM 8
#endif
constexpr int WGM = PG8_WGM;

__host__ __device__ __forceinline__ int lds_byte(int r, int c) { const int st = (r >> 4) * 2 + (c >> 5), rr = r & 15, cc = c & 31, ob = rr * 64 + cc * 2; return st * 1024 + (ob ^ (((ob >> 9) & 1) << 5)); }
__host__ __device__ __forceinline__ void stage_rc(int b, int& R, int& C) { const int st = b / 1024, sb = b % 1024, swz = sb ^ (((sb >> 9) & 1) << 5); R = (st >> 1) * 16 + swz / 64; C = (st & 1) * 32 + (swz % 64) / 2; }
__host__ __device__ __forceinline__ int perm32(int rho) { const int n = rho >> 4, i = rho & 15; return 8 * (i >> 2) + 4 * n + (i & 3); }

struct Unit { int pm, pn; };
struct Gemm { const bf16_t* A; const bf16_t* Bt; int M, N, K; };

struct StaticOrder {
    static constexpr bool GATHER = false; __device__ __forceinline__ int arow(int, int r) const { return r; }
    int nM, nN, nwg, G, c;
    __host__ __device__ void init(int M, int N, int G_, int c_) { nM = M / BM; nN = N / BM; nwg = nM * nN; G = G_; c = c_; }
    __host__ __device__ bool next(int i, Unit& u) const {
        const long L = (long)i * G + c; if (L >= nwg) return false;
        int wgid = (int)L; { const int q = nwg / NXCD, r = nwg % NXCD, xcd = wgid % NXCD, off = wgid / NXCD; wgid = (xcd < r ? xcd * (q + 1) : r * (q + 1) + (xcd - r) * q) + off; }
        const int nig = WGM * nN, gid = wgid / nig, fm = gid * WGM, gsz = (nM - fm) < WGM ? (nM - fm) : WGM;
        u.pm = fm + ((wgid % nig) % gsz); u.pn = (wgid % nig) / gsz; return true;
    }
    __device__ __forceinline__ void a_ready(const Unit&) const {}
    __device__ __forceinline__ void done(const Unit&) const {}
};

__device__ __forceinline__ unsigned cvt_pk_bf16(float lo, float hi) { unsigned r; asm volatile("v_cvt_pk_bf16_f32 %0, %1, %2" : "=v"(r) : "v"(lo), "v"(hi)); return r; }
typedef float f32x2 __attribute__((ext_vector_type(2)));

template <class Epi, class Sched, bool ALIGN_EPI = false, bool SP2 = false>
__device__ __forceinline__ void gemm_phase(PG8_LAS unsigned char* lds, const Gemm g, const Sched& S, const Epi& E, const int tid_in) {
    const int tid = tid_in, wid = __builtin_amdgcn_readfirstlane(tid >> 6), lane = tid & 63, wr = wid >> 2, wc = wid & 3, fr = lane & 15, fq = lane >> 4;
    const int K = g.K, nt = K / BK; constexpr bool BBLK = true;
    unsigned voffA[2], voffB[2];
#pragma unroll
    for (int i = 0; i < 2; ++i) { int R, C; stage_rc(tid * 16 + i * 8192, R, C); const int Rb = Epi::BADJ ? (64 * (R >> 5) + perm32(R & 31)) : Epi::PERM ? ((R & ~31) + perm32(R & 31)) : R;
        voffA[i] = Epi::ABLK ? (unsigned)((((R >> 4) * (K >> 5) + (C >> 5)) * 8 + (R & 7)) * 128 + ((R >> 3) & 1) * 64 + (C & 31) * 2) : (unsigned)(R * K + C) * 2u; voffB[i] = BBLK ? (unsigned)((((Rb >> 4) * (K >> 5) + (C >> 5)) * 8 + (Rb & 7)) * 128 + ((Rb >> 3) & 1) * 64 + (C & 31) * 2) : (unsigned)(Rb * K + C) * 2u; }
    const size_t kstep = (size_t)(BK * 2);
    const size_t kstepB = BBLK ? (size_t)2048 : kstep;
    const size_t kstepA = Epi::ABLK ? (size_t)2048 : kstep;
    const size_t hstep = (size_t)HALF * K * 2;
    const size_t tstep = 2 * hstep;
    const size_t bhstep = Epi::BADJ ? (size_t)32 * K * 2 : hstep;
    const unsigned ldsw = (unsigned)wid * 1024u;
    const int aoff = lds_byte(wr * 64 + fr, fq * 8), boff = lds_byte(wc * 32 + fr, fq * 8);
#define PG8_SA(b, h) (((b) * 2 + (h)) * HTB)
#define PG8_SB(b, h) ((4 + (b) * 2 + (h)) * HTB)
    unsigned gc[2][2], gn[2][2];
#define PG8_GOFF(dst, pmv, ordv) do { if constexpr (Sched::GATHER) { _Pragma("unroll") for (int _h = 0; _h < 2; ++_h) _Pragma("unroll") for (int _i = 0; _i < 2; ++_i) { int _R, _C; stage_rc(tid * 16 + _i * 8192, _R, _C); \
        dst[_h][_i] = (unsigned)S.arow((ordv), (pmv) * 256 + _h * 128 + _R) * (unsigned)(K * 2) + (unsigned)(_C * 2); } } } while (0)
#define PG8_STAGE_A(bufoff, origptr, nextf, hh, kbytes) do { if constexpr (Sched::GATHER) { _Pragma("unroll") for (int _i = 0; _i < 2; ++_i) { const unsigned _o = (nextf) ? gn[hh][_i] : gc[hh][_i]; \
        __builtin_amdgcn_global_load_lds((const unsigned*)((const char*)g.A + (kbytes) + _o), (PG8_LAS unsigned*)(lds + (bufoff) + ldsw + _i * 8192), 16, 0, 0); } } else { PG8_STAGE(bufoff, origptr, voffA); } } while (0)
#define PG8_STAGE(bufoff, gbase, voff) do { _Pragma("unroll") for (int _i = 0; _i < 2; ++_i) \
        __builtin_amdgcn_global_load_lds((const unsigned*)((const char*)(gbase) + (voff)[_i]), (PG8_LAS unsigned*)(lds + (bufoff) + ldsw + _i * 8192), 16, 0, 0); } while (0)
#define PG8_LDA(dst, b, h) do { _Pragma("unroll") for (int m = 0; m < 4; ++m) _Pragma("unroll") for (int k = 0; k < 2; ++k) dst[m][k] = *(const PG8_LAS bf16x8*)(lds + PG8_SA(b, h) + aoff + m * 2048 + k * 1024); } while (0)
#define PG8_LDB(dst, b, h) do { _Pragma("unroll") for (int n = 0; n < 2; ++n) _Pragma("unroll") for (int k = 0; k < 2; ++k) dst[n][k] = *(const PG8_LAS bf16x8*)(lds + PG8_SB(b, h) + boff + n * 2048 + k * 1024); } while (0)
#define PG8_MMA(ai, bj, At, Bt) do { __builtin_amdgcn_s_setprio(1); _Pragma("unroll") for (int m = 0; m < 4; ++m) _Pragma("unroll") for (int n = 0; n < 2; ++n) _Pragma("unroll") for (int k = 0; k < 2; ++k) \
        acc[ai][bj][m][n] = __builtin_amdgcn_mfma_f32_16x16x32_bf16(Bt[n][k], At[m][k], acc[ai][bj][m][n], 0, 0, 0); __builtin_amdgcn_s_setprio(0); } while (0)
#define PG8_WAIT_V(n) asm volatile("s_waitcnt vmcnt(" #n ")" ::: "memory")
#define PG8_WAIT_L(n) asm volatile("s_waitcnt lgkmcnt(" #n ")" ::: "memory")
#define PG8_BAR __builtin_amdgcn_s_barrier()
#define PG8_SCHED __builtin_amdgcn_sched_barrier(0)
    Unit cur, nxt; int ui = 0;
    if (!S.next(0, cur)) return;
    f32x4 acc[2][2][4][2];
#pragma unroll
    for (int a = 0; a < 2; ++a)
#pragma unroll
        for (int b = 0; b < 2; ++b)
#pragma unroll
            for (int m = 0; m < 4; ++m)
#pragma unroll
                for (int n = 0; n < 2; ++n) acc[a][b][m][n] = (f32x4){0.f, 0.f, 0.f, 0.f};
    bf16x8 At[4][2], B0[2][2], B1[2][2];
    const char* cA = (const char*)g.A + (size_t)cur.pm * tstep; const char* cB = (const char*)g.Bt + (size_t)cur.pn * tstep;
    S.a_ready(cur);
    PG8_GOFF(gc, cur.pm, 0);
    if constexpr (SP2) {
        PG8_STAGE(PG8_SB(0, 0), cB, voffB); PG8_STAGE(PG8_SB(0, 1), cB + bhstep, voffB); PG8_STAGE_A(PG8_SA(0, 0), cA, false, 0, 0); PG8_STAGE_A(PG8_SA(0, 1), cA + hstep, false, 1, 0);
        if (wr == 1) PG8_BAR;
        PG8_WAIT_V(2); PG8_BAR;
        PG8_STAGE(PG8_SB(1, 0), cB + kstepB, voffB); PG8_STAGE_A(PG8_SA(1, 0), cA + kstepA, false, 0, kstep); PG8_STAGE(PG8_SB(1, 1), cB + bhstep + kstepB, voffB);
        PG8_WAIT_V(6); PG8_BAR;
    } else {
        PG8_STAGE(PG8_SB(0, 0), cB, voffB); PG8_STAGE(PG8_SA(0, 0), cA, voffA); PG8_STAGE(PG8_SB(0, 1), cB + bhstep, voffB); PG8_STAGE(PG8_SA(0, 1), cA + hstep, voffA);
        if (wr == 1) PG8_BAR;
        PG8_WAIT_V(4); PG8_BAR;
        PG8_STAGE(PG8_SB(1, 0), cB + kstepB, voffB); PG8_STAGE(PG8_SA(1, 0), cA + kstepA, voffA); PG8_STAGE(PG8_SB(1, 1), cB + bhstep + kstepB, voffB);
        PG8_WAIT_V(6); PG8_BAR;
    }
    for (;;) {
        const bool has_next = S.next(ui + 1, nxt);
        if constexpr (Sched::GATHER) { if (has_next) { PG8_GOFF(gn, nxt.pm, ui + 1); } else { gn[0][0] = gc[0][0]; gn[0][1] = gc[0][1]; gn[1][0] = gc[1][0]; gn[1][1] = gc[1][1]; } }
        const char* nA = has_next ? (const char*)g.A + (size_t)nxt.pm * tstep : cA; const char* nB = has_next ? (const char*)g.Bt + (size_t)nxt.pn * tstep : cB;
#pragma unroll
        for (int seg = 0; seg < (Epi::MID_T > 0 ? 2 : 1); ++seg) {
        if constexpr (Epi::MID_T > 0) { if (seg == 1) { PG8_SCHED; E.mid(acc, cur, wr, wc, fr, fq); PG8_SCHED; } }
        const int t_lo = seg ? Epi::MID_T : 0, t_hi = (Epi::MID_T > 0 && seg == 0) ? Epi::MID_T : nt;
        for (int t = t_lo; t < t_hi; t += 2) {
            const bool last = (t == nt - 2);
            const char* a1 = cA + (size_t)(t + 1) * kstepA;
            const char* a2 = last ? nA : cA + (size_t)(t + 2) * kstepA; const char* b2 = last ? nB : cB + (size_t)(t + 2) * kstepB;
            const char* a3 = a2 + kstepA; const char* b3 = b2 + kstepB; const size_t k2b = last ? (size_t)0 : (size_t)(t + 2) * kstep;
            if (last && has_next) S.a_ready(nxt);
            if constexpr (SP2) {
            PG8_LDB(B0, 0, 0); PG8_LDB(B1, 0, 1); PG8_SCHED; PG8_LDA(At, 0, 0); PG8_STAGE_A(PG8_SA(1, 1), a1 + hstep, false, 1, (size_t)(t + 1) * kstep);
            PG8_WAIT_V(8); PG8_WAIT_L(0); PG8_BAR; PG8_MMA(0, 0, At, B0); PG8_MMA(0, 1, At, B1); PG8_BAR; PG8_SCHED;
            PG8_LDA(At, 0, 1); PG8_STAGE(PG8_SB(0, 0), b2, voffB); PG8_STAGE(PG8_SB(0, 1), b2 + bhstep, voffB); PG8_STAGE_A(PG8_SA(0, 0), a2, last, 0, k2b);
            PG8_WAIT_V(8); PG8_WAIT_L(0); PG8_BAR; PG8_MMA(1, 0, At, B0); PG8_MMA(1, 1, At, B1); PG8_BAR; PG8_SCHED;
            PG8_LDB(B0, 1, 0); PG8_LDB(B1, 1, 1); PG8_SCHED; PG8_LDA(At, 1, 0); PG8_STAGE_A(PG8_SA(0, 1), a2 + hstep, last, 1, k2b);
            PG8_WAIT_V(8); PG8_WAIT_L(0); PG8_BAR; PG8_MMA(0, 0, At, B0); PG8_MMA(0, 1, At, B1); PG8_BAR; PG8_SCHED;
            PG8_LDA(At, 1, 1); PG8_STAGE(PG8_SB(1, 0), b3, voffB); PG8_STAGE(PG8_SB(1, 1), b3 + bhstep, voffB); PG8_STAGE_A(PG8_SA(1, 0), a3, last, 0, k2b + kstep);
            PG8_WAIT_V(8); PG8_WAIT_L(0); PG8_BAR; PG8_MMA(1, 0, At, B0); PG8_MMA(1, 1, At, B1); PG8_BAR; PG8_SCHED;
            } else {
            PG8_LDB(B0, 0, 0); PG8_SCHED; PG8_LDA(At, 0, 0); PG8_STAGE(PG8_SA(1, 1), a1 + hstep, voffA);
            PG8_WAIT_L(8); PG8_BAR; PG8_WAIT_L(0); PG8_MMA(0, 0, At, B0); PG8_BAR; PG8_SCHED;
            PG8_LDB(B1, 0, 1); PG8_STAGE(PG8_SB(0, 0), b2, voffB);
            PG8_BAR; PG8_WAIT_L(0); PG8_MMA(0, 1, At, B1); PG8_BAR;
            PG8_LDA(At, 0, 1); PG8_STAGE(PG8_SA(0, 0), a2, voffA);
            PG8_BAR; PG8_WAIT_L(0); PG8_MMA(1, 0, At, B0); PG8_BAR; PG8_SCHED;
            PG8_STAGE(PG8_SB(0, 1), b2 + bhstep, voffB);
            PG8_WAIT_V(6); PG8_BAR; PG8_MMA(1, 1, At, B1); PG8_BAR;
            PG8_LDB(B0, 1, 0); PG8_SCHED; PG8_LDA(At, 1, 0); PG8_STAGE(PG8_SA(0, 1), a2 + hstep, voffA);
            PG8_WAIT_L(8); PG8_BAR; PG8_WAIT_L(0); PG8_MMA(0, 0, At, B0); PG8_BAR; PG8_SCHED;
            PG8_LDB(B1, 1, 1); PG8_STAGE(PG8_SB(1, 0), b3, voffB);
            PG8_BAR; PG8_WAIT_L(0); PG8_MMA(0, 1, At, B1); PG8_BAR;
            PG8_LDA(At, 1, 1); PG8_STAGE(PG8_SA(1, 0), a3, voffA);
            PG8_BAR; PG8_WAIT_L(0); PG8_MMA(1, 0, At, B0); PG8_BAR; PG8_SCHED;
            PG8_STAGE(PG8_SB(1, 1), b3 + bhstep, voffB);
            PG8_WAIT_V(6); PG8_BAR; PG8_MMA(1, 1, At, B1); PG8_BAR;
            }
        }
        }
        if constexpr (ALIGN_EPI) { if (wr == 0) PG8_BAR; }
        if constexpr (!Epi::AFTER_DRAIN) { E(acc, cur, wr, wc, fr, fq); S.done(cur); }
        if (!has_next) break;
#pragma unroll
        for (int a = 0; a < 2; ++a)
#pragma unroll
            for (int b = 0; b < 2; ++b)
#pragma unroll
                for (int m = 0; m < 4; ++m)
#pragma unroll
                    for (int n = 0; n < 2; ++n) acc[a][b][m][n] = (f32x4){0.f, 0.f, 0.f, 0.f};
        cur = nxt; cA = nA; cB = nB; ++ui;
        if constexpr (Sched::GATHER) { gc[0][0] = gn[0][0]; gc[0][1] = gn[0][1]; gc[1][0] = gn[1][0]; gc[1][1] = gn[1][1]; }
        if constexpr (ALIGN_EPI) { if (wr == 1) PG8_BAR; }
    }
    PG8_WAIT_V(0);
    if constexpr (!ALIGN_EPI) { if (wr == 0) PG8_BAR; }
    PG8_BAR;
    if constexpr (Epi::AFTER_DRAIN) { E.fused(acc, cur, wr, wc, fr, fq, lds, wid, lane); S.done(cur); }
#undef PG8_SA
#undef PG8_SB
#undef PG8_STAGE
#undef PG8_STAGE_A
#undef PG8_GOFF
#undef PG8_LDA
#undef PG8_LDB
#undef PG8_MMA
#undef PG8_WAIT_V
#undef PG8_WAIT_L
#undef PG8_BAR
#undef PG8_SCHED
}
}
#define LAS __attribute__((address_space(3)))
#define XB_TMO      128
#define XB_XCNT(j)  (256  + 64 * (j))
#define XB_XSUB(j)  (1280 + 64 * (j))
#define XB_XGEN(j)  (2304 + 64 * (j))
#define XB_TOP      3328
#define XB_TOPGEN   3392
#define XCD_BAR_WORDS 3456
#define XB_SPIN_CAP (1u << 18)

__device__ __forceinline__ unsigned xb_ld(unsigned* p)              { return __hip_atomic_load(p, __ATOMIC_RELAXED, __HIP_MEMORY_SCOPE_AGENT); }
__device__ __forceinline__ unsigned xb_add(unsigned* p, unsigned v) { return __hip_atomic_fetch_add(p, v, __ATOMIC_RELAXED, __HIP_MEMORY_SCOPE_AGENT); }
__device__ __forceinline__ unsigned xb_xcc_id() { return (unsigned)__builtin_amdgcn_s_getreg((3 << 11) | 20) & 0xFu; }
#define XB_SPIN(cond, bar) do { unsigned _sp = 0; while (cond) { __builtin_amdgcn_s_sleep(1); \
    if ((++_sp & 255u) == 0u) { if (xb_ld(&(bar)[XB_TMO])) break; if (_sp > XB_SPIN_CAP) { atomicAdd(&(bar)[XB_TMO], 1u); break; } } } } while (0)

struct XcdBarrier {
    unsigned* bar; unsigned x;
    volatile LAS unsigned* st;
};

__device__ __forceinline__ XcdBarrier xcd_barrier_post(unsigned* bar, volatile LAS unsigned* st) {
    XcdBarrier b; b.bar = bar; b.x = xb_xcc_id(); b.st = st;
    if (threadIdx.x == 0) (void)xb_add(&bar[XB_XCNT(b.x)], 1u);
    return b;
}
__device__ __forceinline__ void xcd_barrier_complete(unsigned* bar, unsigned x, unsigned& nloc, unsigned& nx) {
    const unsigned G = gridDim.x * gridDim.y * gridDim.z;
    unsigned sum, cnt, mine, sp = 0u;
    for (;;) {
        sum = 0u; cnt = 0u; mine = 0u;
#pragma unroll
        for (unsigned j = 0; j < 16; ++j) { const unsigned c = xb_ld(&bar[XB_XCNT(j)]); sum += c; cnt += (c > 0u) ? 1u : 0u; mine = (j == x) ? c : mine; }
        if (sum == G) break;
        __builtin_amdgcn_s_sleep(1);
        if ((++sp & 255u) == 0u) { if (xb_ld(&bar[XB_TMO])) break; if (sp > XB_SPIN_CAP) { atomicAdd(&bar[XB_TMO], 1u); break; } }
    }
    nloc = mine > 0u ? mine : 1u; nx = cnt > 0u ? cnt : 1u;
}

__device__ __forceinline__ void xcd_barrier(const XcdBarrier& b) {
    asm volatile("s_waitcnt vmcnt(0)" ::: "memory");
    __syncthreads();
    if (threadIdx.x == 0) {
        unsigned* bar = b.bar;
        __builtin_amdgcn_s_waitcnt(0);
        unsigned nloc = b.st[0], nx = b.st[1];
        if (nloc == 0u) { xcd_barrier_complete(bar, b.x, nloc, nx); b.st[0] = nloc; b.st[1] = nx; }
        const unsigned old = xb_add(&bar[XB_XSUB(b.x)], 1u);
        const unsigned gen = old / nloc;
        if (old + 1u == (gen + 1u) * nloc) {
            __builtin_amdgcn_fence(__ATOMIC_RELEASE, "agent");
            asm volatile("s_waitcnt vmcnt(0)" ::: "memory");
            const unsigned og = xb_add(&bar[XB_TOP], 1u);
            const unsigned tg = og / nx;
            if (og + 1u == (tg + 1u) * nx) xb_add(&bar[XB_TOPGEN], 1u);
            else XB_SPIN(xb_ld(&bar[XB_TOPGEN]) == tg, bar);
            __builtin_amdgcn_fence(__ATOMIC_ACQUIRE, "agent");
            xb_add(&bar[XB_XGEN(b.x)], 1u);
            asm volatile("s_waitcnt vmcnt(0)" ::: "memory");
        } else {
            XB_SPIN(xb_ld(&bar[XB_XGEN(b.x)]) == gen, bar);
            __builtin_amdgcn_fence(__ATOMIC_ACQUIRE, "agent");
            asm volatile("s_waitcnt vmcnt(0)" ::: "memory");
        }
    }
    __syncthreads();
}


#ifndef PG8_SP2
#define PG8_SP2 true
#endif
#ifndef PG8_ALIGN
#define PG8_ALIGN true
#endif
constexpr int D = 1024, NB = 8, SEQ = 4096, T = NB * SEQ, NL = 4;
constexpr int NIN = 8704, NE = 32, FF = 1024;
constexpr int RMAX = 139264;
constexpr float LN_EPS = 1e-5f, DN_ALPHA = 1.681792830507429f;
constexpr float QSCALE = 0.18033688011112042f;
constexpr float LOG2E = 1.4426950408889634f;

constexpr size_t MiB = 1u << 20;
constexpr size_t WS_CTL = 0, CTL_ZERO_BYTES = 1 * MiB;
constexpr size_t WS_MOD = 1 * MiB;
constexpr size_t WS_ROPE = 2 * MiB;
constexpr size_t WS_WSP = 3 * MiB;
constexpr size_t WS_WRT = 4 * MiB;
constexpr size_t WS_TOKINFO = 5 * MiB;
constexpr size_t WS_TOKW = 5 * MiB + 512 * 1024;
constexpr size_t WS_ROWTOK = 6 * MiB;
constexpr size_t WS_ROWW = 7 * MiB;
constexpr size_t WS_LSE = 8 * MiB;
constexpr size_t WS_TOKROW = 14 * MiB;
constexpr size_t WS_STAT = 13 * MiB;
constexpr size_t WS_WGCNT = 12 * MiB;
constexpr size_t WS_WIN = 16 * MiB;
constexpr size_t WS_WBA = 84 * MiB;
constexpr size_t WS_WBB = 92 * MiB;
constexpr size_t WS_WOUT = 96 * MiB;
constexpr size_t WS_WUP = 104 * MiB;
constexpr size_t WS_WDN = 616 * MiB;
constexpr size_t WS_H = 872 * MiB;
constexpr size_t WS_X1 = 936 * MiB;
constexpr size_t WS_X2 = 1064 * MiB;
constexpr size_t WS_YPRE = 1192 * MiB;
constexpr size_t WS_U = 1320 * MiB, WS_V = 1384 * MiB;
constexpr size_t WS_Q = 1448 * MiB, WS_K = 1544 * MiB, WS_VV = 1640 * MiB;
constexpr size_t WS_G = 1736 * MiB;
constexpr size_t WS_OG = 1864 * MiB;
constexpr size_t WS_TT = 1960 * MiB;
constexpr size_t WS_OB = 2024 * MiB;
constexpr size_t WS_YA = 2056 * MiB;
constexpr size_t WS_MG = 2120 * MiB;
constexpr size_t WS_XG = 2184 * MiB;
constexpr size_t WS_ACT = 2456 * MiB;
constexpr size_t WS_YK = 2728 * MiB;
constexpr size_t WS_END = 2984 * MiB;
constexpr int CW_BAR = 4096;
constexpr int CW_CNT = 16384;

constexpr int RING_BYTES = 131072;
constexpr int XOFF = RING_BYTES;
constexpr int X_MISC = XOFF;
constexpr int X_SELE = XOFF + 256;
constexpr int X_SELR = XOFF + 2304;
constexpr int X_CNTL = XOFF + 4352;
constexpr int X_BASE = XOFF + 4480;
constexpr int X_TILEE = XOFF + 4608;
constexpr int X_CNTS = XOFF + 5632;
constexpr int X_OFFS = XOFF + 5760;
constexpr int LDS_BYTES = 147456;

#define GAS __attribute__((address_space(1)))
typedef unsigned short bf16;
typedef unsigned v4u __attribute__((ext_vector_type(4)));
typedef unsigned v2u __attribute__((ext_vector_type(2)));
typedef float f32x4 __attribute__((ext_vector_type(4)));
typedef short bf16x8 __attribute__((ext_vector_type(8)));
typedef short s16x4 __attribute__((ext_vector_type(4)));
#define RLX_AGENT __ATOMIC_RELAXED, __HIP_MEMORY_SCOPE_AGENT
#define LDS_WAIT() asm volatile("s_waitcnt lgkmcnt(0)" ::: "memory")
#define VM_WAIT() asm volatile("s_waitcnt vmcnt(0)" ::: "memory")

typedef __bf16 bf16x2_t __attribute__((ext_vector_type(2))); typedef float f32x2_t __attribute__((ext_vector_type(2)));
__device__ __forceinline__ unsigned pk2(float lo, float hi) { return __builtin_bit_cast(unsigned, __builtin_convertvector((f32x2_t){lo, hi}, bf16x2_t)); }
__device__ __forceinline__ float bflo(unsigned w) { return __uint_as_float(w << 16); }
__device__ __forceinline__ float bfhi(unsigned w) { return __uint_as_float(w & 0xffff0000u); }
__device__ __forceinline__ float fexp2(float x) { return __builtin_amdgcn_exp2f(x); }
__device__ __forceinline__ float frcp(float x) { return __builtin_amdgcn_rcpf(x); }
__device__ __forceinline__ float gelu_tanh(float x) { const float u = x + 0.044715f * x * x * x; return x * frcp(1.0f + fexp2(-2.302208198144325f * u)); }
__device__ __forceinline__ float sigmoidf_(float x) { return frcp(1.0f + fexp2(-LOG2E * x)); }
__device__ __forceinline__ float wave_sum(float v) {
#pragma unroll
    for (int o = 1; o < 64; o <<= 1) v += __shfl_xor(v, o);
    return v;
}
__device__ __forceinline__ float wave_max(float v) {
#pragma unroll
    for (int o = 1; o < 64; o <<= 1) v = fmaxf(v, __shfl_xor(v, o));
    return v;
}
__device__ __forceinline__ s16x4 tr16(const LAS unsigned char* p) { return __builtin_bit_cast(s16x4, __builtin_amdgcn_ds_read_tr16_b64_v4i16((LAS s16x4*)p)); }
__device__ __forceinline__ bf16x8 cat8(s16x4 lo, s16x4 hi) { return (bf16x8){lo[0], lo[1], lo[2], lo[3], hi[0], hi[1], hi[2], hi[3]}; }
__device__ __forceinline__ f32x4 mfma16(bf16x8 a, bf16x8 b, f32x4 c) { return __builtin_amdgcn_mfma_f32_16x16x32_bf16(a, b, c, 0, 0, 0); }

struct Frame {
    LAS unsigned char* lds;
    int tid, lane, wave, G, vcu, bx;
    unsigned char* ws;
    const float* const* in;
    float* out;
};
enum { I_X = 0, I_C, I_WADA, I_BADA, I_WIN, I_SPW, I_SPB, I_WBA, I_WBB, I_WOUT, I_LN1G, I_LN1B, I_WR, I_BR, I_WUP, I_BUP, I_WDN, I_BDN, I_LN2G, I_LN2B };
template <class Tp> __device__ __forceinline__ Tp* wsp(const Frame& F, size_t off) { return (Tp*)(F.ws + off); }

template <class P> __device__ __forceinline__ P launder(P p) { unsigned lo = (unsigned)(uintptr_t)p, hi = (unsigned)((uintptr_t)p >> 32); asm volatile("" : "+v"(lo), "+v"(hi));
    lo = (unsigned)__builtin_amdgcn_readfirstlane((int)lo); hi = (unsigned)__builtin_amdgcn_readfirstlane((int)hi); return (P)(((uintptr_t)hi << 32) | (uintptr_t)lo); }
__device__ __forceinline__ unsigned fl_x8(unsigned v) { return (unsigned)__builtin_amdgcn_update_dpp(0, (int)v, 0x128, 0xf, 0xf, false); }
#ifndef FLNT
#define FLNT true
#endif
template <bool NT> __device__ __forceinline__ void fl_put(bf16* p, size_t ld, bool lo, const v4u& w0, const v4u& w1) {
    v4u sd; sd.x = lo ? w1.x : w0.x; sd.y = lo ? w1.y : w0.y; sd.z = lo ? w1.z : w0.z; sd.w = lo ? w1.w : w0.w;
    v4u rc; rc.x = fl_x8(sd.x); rc.y = fl_x8(sd.y); rc.z = fl_x8(sd.z); rc.w = fl_x8(sd.w);
    v4u oa, ob; oa.x = lo ? w0.x : rc.x; oa.y = lo ? w0.y : rc.y; oa.z = lo ? w0.z : rc.z; oa.w = lo ? w0.w : rc.w;
    ob.x = lo ? rc.x : w1.x; ob.y = lo ? rc.y : w1.y; ob.z = lo ? rc.z : w1.z; ob.w = lo ? rc.w : w1.w;
    if (NT) { __builtin_nontemporal_store(oa, (v4u*)p); __builtin_nontemporal_store(ob, (v4u*)(p + 8 * ld)); } else { *(v4u*)p = oa; *(v4u*)(p + 8 * ld) = ob; } }
struct EpiIn {
    static constexpr int MID_T = 0; static constexpr bool PERM = true, AFTER_DRAIN = false, BADJ = true, ABLK = true;
    bf16 *U, *V, *Q, *K, *VV, *Gt; const float* rope;
    __device__ __forceinline__ void operator()(const f32x4 (&acc)[2][2][4][2], const pg8::Unit& u, int wr, int wc, int fr, int fq) const {
        const int pn = u.pn; int type, ld, colt; bf16* base;
        if (pn < 4) { type = 0; base = U; ld = 1024; colt = pn * 256; }
        else if (pn < 8) { type = 0; base = V; ld = 1024; colt = (pn - 4) * 256; }
        else if (pn < 14) { type = 1; base = Q; ld = 1536; colt = (pn - 8) * 256; }
        else if (pn < 20) { type = 2; base = K; ld = 1536; colt = (pn - 14) * 256; }
        else if (pn < 26) { type = 3; base = VV; ld = 1536; colt = (pn - 20) * 256; }
        else { type = 4; base = Gt; ld = 2048; colt = (pn - 26) * 256; }
        const bool lo = fr < 8;
        const int rowl = u.pm * 256 + wr * 64 + fr;
        bf16* const pst = base + (size_t)(u.pm * 256 + wr * 64 + (fr & 7)) * ld + colt + wc * 64 + (fr >> 3) * 32 + 8 * fq;
        if (type == 0) {
#pragma unroll
            for (int ai = 0; ai < 2; ++ai)
#pragma unroll
                for (int m = 0; m < 4; ++m) { v4u w[2];
#pragma unroll
                    for (int bj = 0; bj < 2; ++bj) { const f32x4 v0 = acc[ai][bj][m][0], v1 = acc[ai][bj][m][1];
                        w[bj].x = pk2(gelu_tanh(v0[0]), gelu_tanh(v0[1])); w[bj].y = pk2(gelu_tanh(v0[2]), gelu_tanh(v0[3]));
                        w[bj].z = pk2(gelu_tanh(v1[0]), gelu_tanh(v1[1])); w[bj].w = pk2(gelu_tanh(v1[2]), gelu_tanh(v1[3])); }
                    fl_put<true>(pst + (size_t)(ai * 128 + m * 16) * ld, ld, lo, w[0], w[1]); }
        } else if (type == 4) {
#pragma unroll
            for (int ai = 0; ai < 2; ++ai)
#pragma unroll
                for (int m = 0; m < 4; ++m) { v4u w[2];
#pragma unroll
                    for (int bj = 0; bj < 2; ++bj) { const f32x4 v0 = acc[ai][bj][m][0], v1 = acc[ai][bj][m][1];
                        w[bj].x = pk2(sigmoidf_(v0[0]), sigmoidf_(v0[1])); w[bj].y = pk2(sigmoidf_(v0[2]), sigmoidf_(v0[3]));
                        w[bj].z = pk2(sigmoidf_(v1[0]), sigmoidf_(v1[1])); w[bj].w = pk2(sigmoidf_(v1[2]), sigmoidf_(v1[3])); }
                    fl_put<true>(pst + (size_t)(ai * 128 + m * 16) * ld, ld, lo, w[0], w[1]); }
        } else if (type == 3) {
#pragma unroll
            for (int ai = 0; ai < 2; ++ai)
#pragma unroll
                for (int m = 0; m < 4; ++m) { v4u w[2];
#pragma unroll
                    for (int bj = 0; bj < 2; ++bj) { const f32x4 v0 = acc[ai][bj][m][0], v1 = acc[ai][bj][m][1];
                        w[bj].x = pk2(v0[0], v0[1]); w[bj].y = pk2(v0[2], v0[3]); w[bj].z = pk2(v1[0], v1[1]); w[bj].w = pk2(v1[2], v1[3]); }
                    fl_put<true>(pst + (size_t)(ai * 128 + m * 16) * ld, ld, lo, w[0], w[1]); }
        } else {
            const float sc = (type == 1) ? QSCALE : 1.0f;
#pragma unroll
            for (int ai = 0; ai < 2; ++ai)
#pragma unroll
                for (int m = 0; m < 4; ++m) { const int row = rowl + ai * 128 + m * 16;
                    const f32x4* rp = (const f32x4*)(rope + (size_t)(row & (SEQ - 1)) * 16); const f32x4 c0 = rp[0], c1 = rp[1], s0 = rp[2], s1 = rp[3];
                    float cs[8], sn[8];
#pragma unroll
                    for (int e = 0; e < 4; ++e) { cs[e] = c0[e]; cs[4 + e] = c1[e]; sn[e] = s0[e]; sn[4 + e] = s1[e]; }
                    v4u w[2];
#pragma unroll
                    for (int bj = 0; bj < 2; ++bj) { f32x4 v0 = acc[ai][bj][m][0], v1 = acc[ai][bj][m][1];
                        if (bj == 0) {
#pragma unroll
                            for (int e = 0; e < 8; ++e) { const float x = (e < 4) ? v0[e & 3] : v1[e & 3]; const float p = __shfl_xor(x, 16);
                                float y = x;
                                if (fq == 0) y = x * cs[e] - p * sn[e];
                                if (fq == 1) y = x * cs[e] + p * sn[e];
                                if (e < 4) v0[e & 3] = y; else v1[e & 3] = y; } }
                        w[bj].x = pk2(v0[0] * sc, v0[1] * sc); w[bj].y = pk2(v0[2] * sc, v0[3] * sc); w[bj].z = pk2(v1[0] * sc, v1[1] * sc); w[bj].w = pk2(v1[2] * sc, v1[3] * sc); }
                    fl_put<true>(pst + (size_t)(ai * 128 + m * 16) * ld, ld, lo, w[0], w[1]); }
        }
    }
};
struct EpiProbe {
    static constexpr int MID_T = 0; static constexpr bool PERM = true, AFTER_DRAIN = false, BADJ = false, ABLK = false;
    bf16* O; int ld; int on;
    __device__ __forceinline__ void operator()(const f32x4 (&acc)[2][2][4][2], const pg8::Unit& u, int wr, int wc, int fr, int fq) const {
        if (!on) return;
        const int row0 = u.pm * 256 + wr * 64 + fr, col0 = ((on == 3) ? u.pn : (u.pn & 3)) * 256 + wc * 32 + 8 * fq;
#pragma unroll
        for (int ai = 0; ai < 2; ++ai)
#pragma unroll
            for (int m = 0; m < 4; ++m) { bf16* rowp = O + (size_t)(row0 + ai * 128 + m * 16) * ld + col0;
#pragma unroll
                for (int bj = 0; bj < 2; ++bj) { const f32x4 v0 = acc[ai][bj][m][0], v1 = acc[ai][bj][m][1]; v4u w;
                    w.x = pk2(v0[0], v0[1]); w.y = pk2(v0[2], v0[3]); w.z = pk2(v1[0], v1[1]); w.w = pk2(v1[2], v1[3]);
                    *(v4u*)(rowp + bj * 128) = w; } }
    }
};
struct EpiYA {
    static constexpr int MID_T = 0; static constexpr bool PERM = true, AFTER_DRAIN = false, BADJ = false, ABLK = false;
    const bf16* Gt; bf16* YA;
    __device__ __forceinline__ void operator()(const f32x4 (&acc)[2][2][4][2], const pg8::Unit& u, int wr, int wc, int fr, int fq) const {
        const int row0 = u.pm * 256 + wr * 64 + fr, col0 = u.pn * 256 + wc * 32 + 8 * fq;
#pragma unroll
        for (int ai = 0; ai < 2; ++ai)
#pragma unroll
            for (int m = 0; m < 4; ++m) { const size_t row = (size_t)(row0 + ai * 128 + m * 16);
#pragma unroll
                for (int bj = 0; bj < 2; ++bj) { const f32x4 v0 = acc[ai][bj][m][0], v1 = acc[ai][bj][m][1];
                    const v4u g = *(const v4u*)(Gt + row * 2048 + col0 + bj * 128); v4u w;
                    w.x = pk2(v0[0] * bflo(g.x), v0[1] * bfhi(g.x)); w.y = pk2(v0[2] * bflo(g.y), v0[3] * bfhi(g.y));
                    w.z = pk2(v1[0] * bflo(g.z), v1[1] * bfhi(g.z)); w.w = pk2(v1[2] * bflo(g.w), v1[3] * bfhi(g.w));
                    *(v4u*)(YA + row * 1024 + col0 + bj * 128) = w; } }
    }
};
struct EpiMg {
    static constexpr int MID_T = 0; static constexpr bool PERM = true, AFTER_DRAIN = false, BADJ = false, ABLK = false;
    const bf16* Gt; const bf16* YA; bf16* MG;
    __device__ __forceinline__ void operator()(const f32x4 (&acc)[2][2][4][2], const pg8::Unit& u, int wr, int wc, int fr, int fq) const {
        const int row0 = u.pm * 256 + wr * 64 + fr, col0 = u.pn * 256 + wc * 32 + 8 * fq;
#pragma unroll
        for (int ai = 0; ai < 2; ++ai)
#pragma unroll
            for (int m = 0; m < 4; ++m) { const size_t row = (size_t)(row0 + ai * 128 + m * 16);
#pragma unroll
                for (int bj = 0; bj < 2; ++bj) { const f32x4 v0 = acc[ai][bj][m][0], v1 = acc[ai][bj][m][1];
                    const v4u g = *(const v4u*)(Gt + row * 2048 + 1024 + col0 + bj * 128); const v4u y = *(const v4u*)(YA + row * 1024 + col0 + bj * 128); v4u w;
                    w.x = pk2(bflo(y.x) + v0[0] * bflo(g.x), bfhi(y.x) + v0[1] * bfhi(g.x)); w.y = pk2(bflo(y.y) + v0[2] * bflo(g.y), bfhi(y.y) + v0[3] * bfhi(g.y));
                    w.z = pk2(bflo(y.z) + v1[0] * bflo(g.z), bfhi(y.z) + v1[1] * bfhi(g.z)); w.w = pk2(bflo(y.w) + v1[2] * bflo(g.w), bfhi(y.w) + v1[3] * bfhi(g.w));
                    *(v4u*)(MG + row * 1024 + col0 + bj * 128) = w; } }
    }
};
struct EpiMg2 {
    static constexpr int MID_T = 16; static constexpr bool PERM = true, AFTER_DRAIN = false, BADJ = true, ABLK = false;
    const bf16* Gt; bf16* MG;
    __device__ __forceinline__ void mid(f32x4 (&acc)[2][2][4][2], const pg8::Unit& u, int wr, int wc, int fr, int fq) const {
        int row0 = u.pm * 256 + wr * 64 + fr; const int col0 = u.pn * 256 + wc * 64 + 8 * fq;
        asm volatile("" : "+v"(row0));
#pragma unroll
        for (int ai = 0; ai < 2; ++ai)
#pragma unroll
            for (int m = 0; m < 4; ++m) { const size_t row = (size_t)(row0 + ai * 128 + m * 16);
#pragma unroll
                for (int bj = 0; bj < 2; ++bj) { const v4u g0 = *(const v4u*)(Gt + row * 2048 + col0 + bj * 32), g1 = *(const v4u*)(Gt + row * 2048 + 1024 + col0 + bj * 32);
                    const unsigned a0[4] = {g0.x, g0.y, g0.z, g0.w}, a1[4] = {g1.x, g1.y, g1.z, g1.w};
#pragma unroll
                    for (int q = 0; q < 4; ++q) { const float r0 = bflo(a0[q]) * frcp(fmaxf(bflo(a1[q]), 1e-20f)), r1 = bfhi(a0[q]) * frcp(fmaxf(bfhi(a1[q]), 1e-20f));
                        acc[ai][bj][m][q >> 1][(q & 1) * 2] *= r0; acc[ai][bj][m][q >> 1][(q & 1) * 2 + 1] *= r1; } }
                if (m == 3) asm volatile("" ::: "memory"); }
    }
    __device__ __forceinline__ void operator()(const f32x4 (&acc)[2][2][4][2], const pg8::Unit& u, int wr, int wc, int fr, int fq) const {
        const int row0 = u.pm * 256 + wr * 64 + fr, col0 = u.pn * 256 + wc * 64 + 8 * fq; const bool lo = fr < 8;
        bf16* const pst = MG + (size_t)(u.pm * 256 + wr * 64 + (fr & 7)) * 1024 + u.pn * 256 + wc * 64 + (fr >> 3) * 32 + 8 * fq;
#pragma unroll
        for (int ai = 0; ai < 2; ++ai)
#pragma unroll
            for (int m = 0; m < 4; ++m) { const size_t row = (size_t)(row0 + ai * 128 + m * 16); v4u w[2];
#pragma unroll
                for (int bj = 0; bj < 2; ++bj) { const f32x4 v0 = acc[ai][bj][m][0], v1 = acc[ai][bj][m][1];
                    const v4u g = *(const v4u*)(Gt + row * 2048 + 1024 + col0 + bj * 32);
                    w[bj].x = pk2(v0[0] * fmaxf(bflo(g.x), 1e-20f), v0[1] * fmaxf(bfhi(g.x), 1e-20f)); w[bj].y = pk2(v0[2] * fmaxf(bflo(g.y), 1e-20f), v0[3] * fmaxf(bfhi(g.y), 1e-20f));
                    w[bj].z = pk2(v1[0] * fmaxf(bflo(g.z), 1e-20f), v1[1] * fmaxf(bfhi(g.z), 1e-20f)); w[bj].w = pk2(v1[2] * fmaxf(bflo(g.w), 1e-20f), v1[3] * fmaxf(bfhi(g.w), 1e-20f)); }
                fl_put<false>(pst + (size_t)(ai * 128 + m * 16) * 1024, 1024, lo, w[0], w[1]); }
    }
};
template <bool XF32> struct EpiOut {
    static constexpr int MID_T = 0; static constexpr bool PERM = true, AFTER_DRAIN = false, BADJ = true, ABLK = false;
    const void* xres; const float* modl  ; bf16* YPRE;
    __device__ __forceinline__ void operator()(const f32x4 (&acc)[2][2][4][2], const pg8::Unit& u, int wr, int wc, int fr, int fq) const {
        const int row0 = u.pm * 256 + wr * 64 + fr, col0 = u.pn * 256 + wc * 64 + 8 * fq; const int b = (u.pm * 256) >> 12; const bool lo = fr < 8;
        bf16* const pst = YPRE + (size_t)(u.pm * 256 + wr * 64 + (fr & 7)) * 1024 + u.pn * 256 + wc * 64 + (fr >> 3) * 32 + 8 * fq;
        f32x4 gg[2][2];
#pragma unroll
        for (int bj = 0; bj < 2; ++bj)
#pragma unroll
            for (int n = 0; n < 2; ++n) gg[bj][n] = *(const f32x4*)(modl + (size_t)b * 6144 + 2048 + col0 + bj * 32 + 4 * n) + 1.0f;
#pragma unroll
        for (int ai = 0; ai < 2; ++ai)
#pragma unroll
            for (int m = 0; m < 4; ++m) { const size_t off = (size_t)(row0 + ai * 128 + m * 16) * 1024 + col0; v4u w[2];
#pragma unroll
                for (int bj = 0; bj < 2; ++bj) { f32x4 x0, x1;
                    if (XF32) { x0 = *(const f32x4*)((const float*)xres + off + bj * 32); x1 = *(const f32x4*)((const float*)xres + off + bj * 32 + 4); }
                    else { const v4u xr = *(const v4u*)((const bf16*)xres + off + bj * 32); x0 = (f32x4){bflo(xr.x), bfhi(xr.x), bflo(xr.y), bfhi(xr.y)}; x1 = (f32x4){bflo(xr.z), bfhi(xr.z), bflo(xr.w), bfhi(xr.w)}; }
                    const f32x4 o0 = x0 * DN_ALPHA + gg[bj][0] * acc[ai][bj][m][0], o1 = x1 * DN_ALPHA + gg[bj][1] * acc[ai][bj][m][1];
                    w[bj].x = pk2(o0[0], o0[1]); w[bj].y = pk2(o0[2], o0[3]); w[bj].z = pk2(o1[0], o1[1]); w[bj].w = pk2(o1[2], o1[3]); }
                fl_put<false>(pst + (size_t)(ai * 128 + m * 16) * 1024, 1024, lo, w[0], w[1]);
                if (m == 3) asm volatile("" ::: "memory"); }
    }
};
#ifndef ACT_NT
#define ACT_NT 1
#endif
struct EpiUp {
    static constexpr int MID_T = 0; static constexpr bool PERM = true, AFTER_DRAIN = false, BADJ = false, ABLK = false;
    const float* bup  ; bf16* ACT;
    __device__ __forceinline__ void operator()(const f32x4 (&acc)[2][2][4][2], const pg8::Unit& u, int wr, int wc, int fr, int fq) const {
        const int e = u.pn >> 3, pnl = u.pn & 7; const int row0 = u.pm * 256 + wr * 64 + fr, ac0 = pnl * 128 + wc * 32 + 8 * fq;
        const f32x4* bp = (const f32x4*)(bup + (size_t)e * 2048 + 2 * ac0); const f32x4 b0 = bp[0], b1 = bp[1], b2 = bp[2], b3 = bp[3];
        const float bg[8] = {b0[0], b0[2], b1[0], b1[2], b2[0], b2[2], b3[0], b3[2]}, bl[8] = {b0[1], b0[3], b1[1], b1[3], b2[1], b2[3], b3[1], b3[3]};
#pragma unroll
        for (int ai = 0; ai < 2; ++ai)
#pragma unroll
            for (int m = 0; m < 4; ++m) { float a[8];
#pragma unroll
                for (int j = 0; j < 8; ++j) { const float hg = acc[ai][0][m][j >> 2][j & 3] + bg[j], hl = acc[ai][1][m][j >> 2][j & 3] + bl[j];
                    const float glu = fminf(hg, 7.0f), lin = fminf(fmaxf(hl, -7.0f), 7.0f);
                    a[j] = glu * frcp(1.0f + fexp2(-2.4554669595930156f * glu)) * (lin + 1.0f); }
                v4u w; w.x = pk2(a[0], a[1]); w.y = pk2(a[2], a[3]); w.z = pk2(a[4], a[5]); w.w = pk2(a[6], a[7]);
                { const size_t g16 = (size_t)((u.pm * 256 + wr * 64 + ai * 128 + m * 16) >> 4); unsigned char* lp = (unsigned char*)ACT + ((g16 * 32 + (size_t)(pnl * 4 + wc)) * 8 + (fr & 7)) * 128 + (fr >> 3) * 64 + 16 * fq;
                  if (ACT_NT) __builtin_nontemporal_store(w, (v4u*)lp); else *(v4u*)lp = w; } }
    }
};
struct EpiDn {
    static constexpr int MID_T = 0; static constexpr bool PERM = true, AFTER_DRAIN = false, BADJ = true, ABLK = true;
    const float* bdn  ; bf16* YKS;
    __device__ __forceinline__ void operator()(const f32x4 (&acc)[2][2][4][2], const pg8::Unit& u, int wr, int wc, int fr, int fq) const {
        const int e = u.pn >> 2, pnl = u.pn & 3; const int col0 = pnl * 256 + wc * 64 + 8 * fq; const bool lo = fr < 8;
        bf16* const pst = YKS + (size_t)(u.pm * 256 + wr * 64 + (fr & 7)) * 1024 + pnl * 256 + wc * 64 + (fr >> 3) * 32 + 8 * fq;
        f32x4 bv[2][2];
#pragma unroll
        for (int bj = 0; bj < 2; ++bj)
#pragma unroll
            for (int n = 0; n < 2; ++n) bv[bj][n] = *(const f32x4*)(bdn + (size_t)e * 1024 + col0 + bj * 32 + 4 * n);
#pragma unroll
        for (int ai = 0; ai < 2; ++ai)
#pragma unroll
            for (int m = 0; m < 4; ++m) { v4u w[2];
#pragma unroll
                for (int bj = 0; bj < 2; ++bj) { const f32x4 v0 = acc[ai][bj][m][0] + bv[bj][0], v1 = acc[ai][bj][m][1] + bv[bj][1];
                    w[bj].x = pk2(v0[0], v0[1]); w[bj].y = pk2(v0[2], v0[3]); w[bj].z = pk2(v1[0], v1[1]); w[bj].w = pk2(v1[2], v1[3]); }
                fl_put<FLNT>(pst + (size_t)(ai * 128 + m * 16) * 1024, 1024, lo, w[0], w[1]); }
    }
};
struct MoeOrder {
    static constexpr bool GATHER = false; __device__ __forceinline__ int arow(int, int r) const { return r; }
    int nM, nN, nwg, G, c, rev; const LAS unsigned char* tile_e;
    __device__ void init(int RT, int NN, int G_, int c_, const LAS unsigned char* te, int rev_ = 0) { nM = RT; nN = NN; nwg = RT * NN; G = G_; c = c_; tile_e = te; rev = rev_; }
    __device__ __forceinline__ bool next(int i, pg8::Unit& u) const {
        const long L = (long)i * G + c; if (L >= nwg) return false;
        int wgid = (int)L; { const int q = nwg / pg8::NXCD, r = nwg % pg8::NXCD, xcd = wgid % pg8::NXCD, off = wgid / pg8::NXCD; wgid = (xcd < r ? xcd * (q + 1) : r * (q + 1) + (xcd - r) * q) + off; }
        const int nig = pg8::WGM * nN, gid = wgid / nig, fm = gid * pg8::WGM, gsz = (nM - fm) < pg8::WGM ? (nM - fm) : pg8::WGM;
        int pm = fm + ((wgid % nig) % gsz); const int pnl = (wgid % nig) / gsz; if (rev) pm = nM - 1 - pm;
        u.pm = pm; u.pn = (int)tile_e[pm] * nN + pnl; return true;
    }
    __device__ __forceinline__ void a_ready(const pg8::Unit&) const {}
    __device__ __forceinline__ void done(const pg8::Unit&) const {}
};

#ifndef STAG_N
#define STAG_N 1
#endif
#ifndef STAG_US
#define STAG_US 24
#endif
__device__ __forceinline__ void stagger(int slot, int us) {
    if (STAG_N <= 1) return;
    const unsigned long long t0 = __builtin_amdgcn_s_memrealtime(); const unsigned long long ticks = (unsigned long long)(slot % STAG_N) * (unsigned)us * 100ull / STAG_N;
    while (__builtin_amdgcn_s_memrealtime() - t0 < ticks) __builtin_amdgcn_s_sleep(16);
}
struct MoeGatherOrder : MoeOrder {
    static constexpr bool GATHER = true; const LAS unsigned short* tokl;
    __device__ __forceinline__ int arow(int ord, int r) const { return (int)tokl[ord * 256 + (r & 255)]; }
};
constexpr int X_TOKL = XOFF + 6144, TOKL_UNITS = 20;
constexpr int TR_NR = 32, TR_WAVE_BYTES = 64 * 64 * 4;
struct TrItem { const float* src; bf16* dst; int ld, K, kind, k0, c0, koff; };
__device__ __forceinline__ void tr_load(const TrItem& t, int lane, f32x4 (&r)[TR_NR]) {
    const int kq = lane >> 4, cc = lane & 15;
#pragma unroll
    for (int i = 0; i < TR_NR; ++i) r[i] = __builtin_nontemporal_load((const f32x4*)(t.src + (size_t)(t.k0 + 2 * (kq + 4 * (i >> 1)) + (i & 1)) * t.ld + t.c0 + 4 * cc));
}
__device__ __forceinline__ void tr_tile(int lane, LAS unsigned* scr, const f32x4 (&r)[TR_NR]) {
    const int kq = lane >> 4, cc = lane & 15;
#pragma unroll
    for (int i2 = 0; i2 < TR_NR / 2; ++i2) { LAS unsigned* p = scr + (4 * cc) * 64 + ((kq + 4 * i2) ^ (cc << 2));
#pragma unroll
        for (int e = 0; e < 4; ++e) p[e * 64] = pk2(r[2 * i2][e], r[2 * i2 + 1][e]); }
    LDS_WAIT(); asm volatile("" ::: "memory");
}
__device__ __forceinline__ void tr_store(const TrItem& t, int lane, const LAS unsigned* scr) {
    const int line = lane >> 3, half = (lane >> 2) & 1, piece = lane & 3;
    const int pbase = (t.kind == 0) ? t.c0 : (256 * (t.c0 >> 8) + ((t.c0 & 255) >> 1));
    const int kb0 = (t.koff + t.k0) >> 5, KB = t.K >> 5;
#pragma unroll
    for (int j = 0; j < 16; ++j) { const int q = 16 * (j >> 2) + line + 8 * half, cb = j & 3, c = 4 * cb + piece;
        const int n = (t.kind == 0) ? q : (2 * (q & 31) + (q >> 5)); const int drow = (t.kind == 0) ? (pbase + q) : (pbase + 128 * (q >> 5) + (q & 31));
        const v4u o = *(const LAS v4u*)(scr + n * 64 + ((c ^ ((n >> 2) & 15)) << 2));
        unsigned char* dp = (unsigned char*)t.dst + ((size_t)((drow >> 4) * KB + kb0 + cb) * 8 + (drow & 7)) * 128 + ((drow >> 3) & 1) * 64 + piece * 16;
        __builtin_nontemporal_store(o, (v4u*)dp); if ((j & 3) == 3) asm volatile("" ::: "memory"); }
    LDS_WAIT(); asm volatile("" ::: "memory");
}
__device__ __forceinline__ void sincos_d(double a, double& s, double& c) {
    const double k = rint(a * 0.63661977236758134308);
    const double y = fma(-k, 6.12323399573676603587e-17, fma(-k, 1.57079632679489655800, a));
    const double y2 = y * y;
    double sp = -7.6471637318198164759e-13; sp = fma(sp, y2, 1.6059043836821614599e-10); sp = fma(sp, y2, -2.5052108385441718775e-8); sp = fma(sp, y2, 2.7557319223985890653e-6);
    sp = fma(sp, y2, -1.9841269841269841270e-4); sp = fma(sp, y2, 8.3333333333333333333e-3); sp = fma(sp, y2, -1.6666666666666666667e-1); const double sy = fma(sp * y2, y, y);
    double cp = 4.7794773323873852974e-14; cp = fma(cp, y2, -1.1470745597729724714e-11); cp = fma(cp, y2, 2.0876756987868098979e-9); cp = fma(cp, y2, -2.7557319223985890653e-7);
    cp = fma(cp, y2, 2.4801587301587301587e-5); cp = fma(cp, y2, -1.3888888888888888889e-3); cp = fma(cp, y2, 4.1666666666666666667e-2); cp = fma(cp, y2, -0.5); const double cy = fma(cp, y2, 1.0);
    const int q = ((int)k) & 3;
    s = (q == 0) ? sy : (q == 1) ? cy : (q == 2) ? -sy : -cy;
    c = (q == 0) ? cy : (q == 1) ? -sy : (q == 2) ? -cy : sy;
}
constexpr int TI_IN = 8 * 136, TI_SQ = 8 * 16, TI_BB = 4 * 16, TI_UP = 8 * 32;
constexpr int TL0 = TI_IN, TL1 = TL0 + TI_SQ, TL2 = TL1 + TI_BB, TL3 = TL2 + TI_SQ, TL4 = TL3 + NE * TI_SQ, TR_IPL = TL4 + NE * TI_UP;
__device__ __forceinline__ TrItem tr_decode(const Frame& F, int l, int it) { TrItem t; t.koff = 0;
    if (it < TL0) { const int r = it; t.src = F.in[I_WIN] + (size_t)l * D * NIN; t.dst = wsp<bf16>(F, WS_WIN) + (size_t)l * NIN * D; t.ld = NIN; t.K = D; t.kind = 0; t.k0 = 128 * (r / 136); t.c0 = 64 * (r % 136); }
    else if (it < TL1) { const int r = it - TL0; t.src = F.in[I_WBA] + (size_t)l * D * D; t.dst = wsp<bf16>(F, WS_WBA) + (size_t)l * D * 1536; t.ld = D; t.K = 1536; t.kind = 0; t.k0 = 128 * (r / 16); t.c0 = 64 * (r % 16); }
    else if (it < TL2) { const int r = it - TL1; t.src = F.in[I_WBB] + (size_t)l * 512 * D; t.dst = wsp<bf16>(F, WS_WBA) + (size_t)l * D * 1536; t.ld = D; t.K = 1536; t.koff = 1024; t.kind = 0; t.k0 = 128 * (r / 16); t.c0 = 64 * (r % 16); }
    else if (it < TL3) { const int r = it - TL2; t.src = F.in[I_WOUT] + (size_t)l * D * D; t.dst = wsp<bf16>(F, WS_WOUT) + (size_t)l * D * D; t.ld = D; t.K = D; t.kind = 0; t.k0 = 128 * (r / 16); t.c0 = 64 * (r % 16); }
    else if (it < TL4) { const int q = it - TL3, le = l * NE + q / TI_SQ, r = q % TI_SQ; t.src = F.in[I_WDN] + (size_t)le * FF * D; t.dst = wsp<bf16>(F, WS_WDN) + (size_t)le * D * FF; t.ld = D; t.K = FF; t.kind = 0; t.k0 = 128 * (r / 16); t.c0 = 64 * (r % 16); }
    else { const int q = it - TL4, le = l * NE + q / TI_UP, r = q % TI_UP; t.src = F.in[I_WUP] + (size_t)le * D * 2048; t.dst = wsp<bf16>(F, WS_WUP) + (size_t)le * 2048 * D; t.ld = 2048; t.K = D; t.kind = 1; t.k0 = 128 * (r / 32); t.c0 = 64 * (r % 32); }
    return t; }
__device__ __forceinline__ void tr_convert(const Frame& F, int l, int first, int end, int stride) {
    LAS unsigned* scr = (LAS unsigned*)(F.lds + F.wave * TR_WAVE_BYTES);
    f32x4 rn[TR_NR]; int it = first;
    if (it < end) { const TrItem t0 = tr_decode(F, l, it); tr_load(t0, F.lane, rn); }
#pragma unroll 1
    for (; it < end; it += stride) {
        tr_tile(F.lane, scr, rn);
        if (it + stride < end) { const TrItem tn = tr_decode(F, l, it + stride); tr_load(tn, F.lane, rn); }
        const TrItem tc = tr_decode(F, l, it); tr_store(tc, F.lane, scr);
    }
}
#ifndef TR_IPW_UP
#define TR_IPW_UP 2
#endif
#ifndef TR_IPW_DN
#define TR_IPW_DN 1
#endif
__device__ __forceinline__ int tr_tail_items(int nwg, int G, int ipw) { const int R = nwg % G; const int n = (R > 0 && nwg > G) ? (G - R) * 8 * ipw : 0; return n; }
__device__ __forceinline__ void tr_tail(const Frame& F, int l, int nwg, int base, int ipw) {
    const int R = nwg % F.G; if (!(R > 0 && nwg > F.G) || F.bx < R) return;
    const int nslots = (F.G - R) * 8, w = (F.bx - R) * 8 + F.wave; int end = base + nslots * ipw; if (end > TR_IPL) end = TR_IPL;
    tr_convert(F, l, base + w, end, nslots);
}
__device__ __forceinline__ void phase_pro_a(Frame& F) {
    const int gw = F.vcu * 8 + F.wave, NGW = F.G * 8;
    tr_convert(F, 0, gw, TR_IPL, NGW);
    __syncthreads();
    {
        LAS float* cT = (LAS float*)F.lds;
        LAS float* red = (LAS float*)(F.lds + 32768);
        const float* cv = F.in[I_C];
        for (int i = F.tid; i < 8 * 1024; i += 512) { const int bb = i >> 10, k = i & 1023; cT[k * 8 + bb] = cv[i]; }
        __syncthreads();
        const int hf = F.lane >> 5, c4 = F.lane & 31;
        for (int u = F.vcu; u < NL * 48; u += F.G) {
            const int l = u / 48, n0 = 128 * (u % 48);
            f32x4 a[8];
#pragma unroll
            for (int bb = 0; bb < 8; ++bb) a[bb] = (f32x4){0.f, 0.f, 0.f, 0.f};
            const int kb = F.wave * 128 + hf;
            const float* wp = F.in[I_WADA] + (size_t)l * D * 6144 + (size_t)kb * 6144 + n0 + 4 * c4;
#pragma unroll 8
            for (int kk = 0; kk < 64; ++kk) { const f32x4 w = *(const f32x4*)(wp + (size_t)(2 * kk) * 6144);
                const f32x4 c0 = *(const LAS f32x4*)(cT + (kb + 2 * kk) * 8), c1 = *(const LAS f32x4*)(cT + (kb + 2 * kk) * 8 + 4);
#pragma unroll
                for (int bb = 0; bb < 4; ++bb) { a[bb] += w * c0[bb]; a[4 + bb] += w * c1[bb]; } }
#pragma unroll
            for (int bb = 0; bb < 8; ++bb) *(LAS f32x4*)(red + ((F.wave * 2 + hf) * 8 + bb) * 128 + 4 * c4) = a[bb];
            __syncthreads();
#pragma unroll
            for (int q = 0; q < 2; ++q) { const int o = F.tid + 512 * q, bb = o >> 7, cn = o & 127; float sum = F.in[I_BADA][l * 6144 + n0 + cn];
#pragma unroll
                for (int p = 0; p < 16; ++p) sum += red[(p * 8 + bb) * 128 + cn];
                wsp<float>(F, WS_MOD)[(size_t)(l * 8 + bb) * 6144 + n0 + cn] = sum; }
            __syncthreads();
        }
    }
    const int gt = F.vcu * 512 + F.tid, NT = F.G * 512;
    for (int i = gt; i < SEQ * 8; i += NT) { const int pos = i >> 3, f = i & 7;
        const double inv = (f == 0) ? 1.0 : (f == 1) ? 0.19392274474868576 : (f == 2) ? 0.03760603093086393 : (f == 3) ? 0.007292664737217109 : (f == 4) ? 0.001414213562373095 : (f == 5) ? 0.0002742481756762073 : (f == 6) ? 5.318295896944988e-05 : 1.031338537721246e-05;
        double s, c; sincos_d((double)pos * inv, s, c);
        float* rp = wsp<float>(F, WS_ROPE) + (size_t)pos * 16; rp[f] = (float)c; rp[8 + f] = (float)s; }
    for (int i = gt; i < NL * 4 * 128 * 128; i += NT) { const int j = i & 127, ii = (i >> 7) & 127; const float w = F.in[I_SPW][i];
        wsp<bf16>(F, WS_WSP)[i] = (bf16)(pk2((j <= ii) ? w : 0.f, 0.f) & 0xffffu); }
    for (int i = gt; i < NL * NE * D; i += NT) { const int k = i & 1023, e = (i >> 10) & 31, l = i >> 15; const float w = F.in[I_WR][((size_t)l * D + k) * NE + e];
        const unsigned hi = pk2(w, 0.f) & 0xffffu; const float lo = w - __uint_as_float(hi << 16);
        wsp<bf16>(F, WS_WRT)[i] = (bf16)hi; wsp<bf16>(F, WS_WRT)[NL * NE * D + i] = (bf16)(pk2(lo, 0.f) & 0xffffu); }
}
__device__ __forceinline__ v2u* hblk(bf16* H, int m, int lane) { return (v2u*)((unsigned char*)H + ((size_t)((m >> 4) * 32 + (lane >> 3)) * 8 + (m & 7)) * 128 + ((m >> 3) & 1) * 64 + (lane & 7) * 8); }
__device__ __forceinline__ void phase_pro_b(Frame& F) {
    const int gw = F.vcu * 8 + F.wave, NGW = F.G * 8;
    const float* mod = wsp<float>(F, WS_MOD);
    for (int m = gw; m < T; m += NGW) { const int b = m >> 12; const float* mb = mod + (size_t)b * 6144;
        const f32x4* xr = (const f32x4*)(F.in[I_X] + (size_t)m * D) + F.lane; v2u* hp = hblk(wsp<bf16>(F, WS_H), m, F.lane);
#pragma unroll
        for (int j = 0; j < 4; ++j) { const f32x4 x = xr[64 * j]; const f32x4 sh = *((const f32x4*)mb + F.lane + 64 * j), sc = *((const f32x4*)(mb + 1024) + F.lane + 64 * j);
            const f32x4 h = x * (sc + 1.0f) + sh; v2u o; o.x = pk2(h[0], h[1]); o.y = pk2(h[2], h[3]); hp[1024 * j] = o; } }
}

constexpr int AT_RS = 144;
constexpr int AT_ROWS = 400, AT_VOFF = AT_ROWS * AT_RS;
#define LDS_BARRIER() do { asm volatile("s_waitcnt lgkmcnt(0)" ::: "memory"); __builtin_amdgcn_s_barrier(); asm volatile("" ::: "memory"); } while (0)
struct AtUnit { int g, b, h, r, n, d; size_t hoff; };
__device__ __forceinline__ AtUnit at_decode(int u) { AtUnit a; a.g = u >> 10; const int rem = u & 1023; a.b = rem >> 7; a.h = (rem >> 4) & 7; const int rn = rem & 15;
    const int dsh = 2 * a.g, nbs = 4 - dsh; a.d = 1 << dsh; a.r = rn >> nbs; a.n = 2 * (rn & ((1 << nbs) - 1)); a.hoff = (size_t)a.g * 512 + a.h * 64; return a; }
constexpr int AT_NU = 3 * 1024;
struct AtSlot { v4u k[6], v[6]; bf16x8 q0, q1, q2, q3; };
struct AtCtx { const bf16 *Qb, *Kb, *Vb; bf16* OG; float* LSE; LAS unsigned char *Ks, *Vs; int qi, g4, piece, jr; };
__device__ __forceinline__ void at_load(AtSlot& sl, int uu, const AtCtx& C, const Frame& F) {
    const AtUnit a_ = at_decode(uu);
#pragma unroll
    for (int ps = 0; ps < 6; ++ps) { const int lp = 128 * (a_.n - 1) + ps * 64 + C.jr; sl.k[ps] = (v4u){0u, 0u, 0u, 0u}; sl.v[ps] = sl.k[ps];
        if (lp >= 0) { const size_t off = ((size_t)a_.b * SEQ + (size_t)lp * a_.d + a_.r) * 1536 + a_.hoff + C.piece * 8; sl.k[ps] = *(const v4u*)(C.Kb + off); sl.v[ps] = *(const v4u*)(C.Vb + off); } }
    const size_t qrow_ = (size_t)a_.b * SEQ + (size_t)(128 * a_.n + 16 * F.wave + C.qi) * a_.d + a_.r; const bf16* qp = C.Qb + qrow_ * 1536 + a_.hoff + 8 * C.g4;
    sl.q0 = *(const bf16x8*)qp; sl.q1 = *(const bf16x8*)(qp + 32);
    const bf16* qp2 = qp + (size_t)128 * a_.d * 1536; sl.q2 = *(const bf16x8*)qp2; sl.q3 = *(const bf16x8*)(qp2 + 32);
}
__device__ __forceinline__ void at_unit(AtSlot& sl, int u, int unext, const AtCtx& C, const Frame& F) {
    bf16* OG = C.OG; float* LSE = C.LSE; LAS unsigned char* Ks = C.Ks; LAS unsigned char* Vs = C.Vs; const int qi = C.qi, g4 = C.g4;
    const AtUnit au = at_decode(u); const int g = au.g, b = au.b, h = au.h, r = au.r, n = au.n, d = au.d;
#pragma unroll
    for (int ps = 0; ps < 6; ++ps) { const int j = ps * 64 + C.jr; *(LAS v4u*)(Ks + j * AT_RS + C.piece * 16) = sl.k[ps]; *(LAS v4u*)(Vs + j * AT_RS + C.piece * 16) = sl.v[ps]; }
    const bf16x8 sl_q0 = sl.q0, sl_q1 = sl.q1, sl_q2 = sl.q2, sl_q3 = sl.q3;
    LDS_BARRIER();
    if (unext < AT_NU) at_load(sl, unext, C, F);
#pragma unroll
    for (int tq = 0; tq < 2; ++tq)
        {
            const int iq = 128 * tq + 16 * F.wave + qi; const int rb = 128 * tq + 16 * F.wave; const bf16x8 qf0 = tq ? sl_q2 : sl_q0, qf1 = tq ? sl_q3 : sl_q1; const size_t qrow = (size_t)b * SEQ + (size_t)(128 * n + iq) * d + r;
            f32x4 s[10]; float mx = -1e30f; const int dq = qi - 4 * g4; const bool first = (n == 0) && (tq == 0);
#pragma unroll
            for (int st = 0; st < 9; ++st) {
                const LAS unsigned char* kp = Ks + (rb + 16 * st + qi) * AT_RS + g4 * 16;
                const bf16x8 k0 = *(const LAS bf16x8*)kp, k1 = *(const LAS bf16x8*)(kp + 64);
                f32x4 a = (f32x4){0.f, 0.f, 0.f, 0.f};
                a = mfma16(k0, qf0, a); a = mfma16(k1, qf1, a);
                if (st == 0) {
#pragma unroll
                    for (int i = 0; i < 4; ++i) a[i] = (i >= dq) ? a[i] : -1e30f; }
                if (st == 8) {
#pragma unroll
                    for (int i = 0; i < 4; ++i) a[i] = (i <= dq) ? a[i] : -1e30f; }
                if (first) {
#pragma unroll
                    for (int i = 0; i < 4; ++i) a[i] = (rb + 16 * st + 4 * g4 + i >= 128) ? a[i] : -1e30f; }
#pragma unroll
                for (int i = 0; i < 4; ++i) mx = fmaxf(mx, a[i]);
                s[st] = a;
            }
            mx = fmaxf(mx, __shfl_xor(mx, 16)); mx = fmaxf(mx, __shfl_xor(mx, 32));
            float sum = 0.f;
#pragma unroll
            for (int st = 0; st < 9; ++st)
#pragma unroll
                for (int i = 0; i < 4; ++i) { const float p = fexp2(s[st][i] - mx); s[st][i] = p; sum += p; }
            s[9] = (f32x4){0.f, 0.f, 0.f, 0.f};
            sum += __shfl_xor(sum, 16); sum += __shfl_xor(sum, 32);
            f32x4 o[4];
#pragma unroll
            for (int dt = 0; dt < 4; ++dt) o[dt] = (f32x4){0.f, 0.f, 0.f, 0.f};
#pragma unroll
            for (int c = 0; c < 5; ++c) {
                v4u pw; pw.x = pk2(s[2 * c][0], s[2 * c][1]); pw.y = pk2(s[2 * c][2], s[2 * c][3]); pw.z = pk2(s[2 * c + 1][0], s[2 * c + 1][1]); pw.w = pk2(s[2 * c + 1][2], s[2 * c + 1][3]);
                const bf16x8 pf = __builtin_bit_cast(bf16x8, pw);
                const LAS unsigned char* vp = Vs + (rb + 32 * c + 4 * g4 + (qi >> 2)) * AT_RS + 8 * (qi & 3);
#pragma unroll
                for (int dt = 0; dt < 4; ++dt) { const s16x4 lo = tr16(vp + 32 * dt), hi = tr16(vp + 32 * dt + 16 * AT_RS);
                    o[dt] = mfma16(cat8(lo, hi), pf, o[dt]); }
            }
            const float inv = 1.0f / sum;
            bf16* op = OG + ((size_t)g * T + qrow) * 512 + h * 64 + 4 * g4;
#pragma unroll
            for (int dt = 0; dt < 4; ++dt) { v2u w; w.x = pk2(o[dt][0] * inv, o[dt][1] * inv); w.y = pk2(o[dt][2] * inv, o[dt][3] * inv); *(v2u*)(op + 16 * dt) = w; }
            if (g4 == 0) LSE[((size_t)g * T + qrow) * 8 + h] = mx + __log2f(sum);
        }
    LDS_BARRIER();
}
__device__ __forceinline__ void phase_attn(Frame& F) {
    AtCtx C; C.Qb = wsp<bf16>(F, WS_Q); C.Kb = wsp<bf16>(F, WS_K); C.Vb = wsp<bf16>(F, WS_VV); C.OG = wsp<bf16>(F, WS_OG); C.LSE = wsp<float>(F, WS_LSE);
    C.Ks = F.lds; C.Vs = F.lds + AT_VOFF; C.qi = F.lane & 15; C.g4 = F.lane >> 4; C.piece = F.tid & 7; C.jr = F.tid >> 3;
    if (F.tid < 144) { *(LAS v4u*)(C.Ks + 384 * AT_RS + F.tid * 16) = (v4u){0u, 0u, 0u, 0u}; *(LAS v4u*)(C.Vs + 384 * AT_RS + F.tid * 16) = (v4u){0u, 0u, 0u, 0u}; }
    AtSlot sa; const int u0 = F.vcu, G = F.G;
    if (u0 < AT_NU) at_load(sa, u0, C, F);
#pragma unroll 1
    for (int u = u0; u < AT_NU; u += G) at_unit(sa, u, u + G, C, F);
}

constexpr int SG_WOFF = 69632, SG_WRS = 264;
constexpr int SG_RS = 528;
__device__ __forceinline__ void phase_sg(Frame& F, int l) {
    const bf16* Ub = wsp<bf16>(F, WS_U); const bf16* Vb = wsp<bf16>(F, WS_V); bf16* TT = wsp<bf16>(F, WS_TT);
    const bf16* OG = wsp<bf16>(F, WS_OG); const float* LSE = wsp<float>(F, WS_LSE); bf16* OB = wsp<bf16>(F, WS_OB);
    const bf16* Wsp = wsp<bf16>(F, WS_WSP); const float* spb = F.in[I_SPB];
    LAS unsigned char* Vn = F.lds;
    const int qi = F.lane & 15, g4 = F.lane >> 4;
    const int l32 = F.lane & 31;
    v4u vraw[8];
#define SG_LOAD(uu) do { const int gi_ = (uu) & 3, m0_ = ((uu) >> 2) * 128; \
        _Pragma("unroll") for (int ps = 0; ps < 8; ++ps) vraw[ps] = *(const v4u*)(Vb + (size_t)(m0_ + 16 * ps + 2 * F.wave + (F.lane >> 5)) * 1024 + gi_ * 256 + 8 * l32); } while (0)
    if (F.vcu < 1024) SG_LOAD(F.vcu);
    const bool wlds = (F.G & 3) == 0; LAS unsigned char* Wl = F.lds + SG_WOFF;
    if (wlds) { const bf16* wsrc = Wsp + (size_t)(l * 4 + (F.vcu & 3)) * 128 * 128;
        for (int i = F.tid; i < 128 * 16; i += 512) { const int row = i >> 4, ch = i & 15; const v4u wv = *(const v4u*)(wsrc + row * 128 + ch * 8);
            *(LAS v2u*)(Wl + row * SG_WRS + ch * 16) = (v2u){wv.x, wv.y}; *(LAS v2u*)(Wl + row * SG_WRS + ch * 16 + 8) = (v2u){wv.z, wv.w}; } }
    for (int u = F.vcu; u < 1024; u += F.G) {
        const int gi = u & 3, m0 = (u >> 2) * 128;
        float ml[4][3]; v4u mo[4][3]; const int sub = F.tid & 7;
#pragma unroll
        for (int ps = 0; ps < 4; ++ps) { const int p = (F.tid >> 3) + 64 * ps; const size_t tok = (size_t)m0 + (p >> 1); const int hd = 2 * gi + (p & 1); const size_t off = tok * 512 + hd * 64 + 8 * sub;
#pragma unroll
            for (int gq = 0; gq < 3; ++gq) { ml[ps][gq] = LSE[((size_t)gq * T + tok) * 8 + hd]; mo[ps][gq] = *(const v4u*)(OG + (size_t)gq * T * 512 + off); } }
        {
            float sm[8], mean[8], rs[8];
#pragma unroll
            for (int ps = 0; ps < 8; ++ps) { const v4u raw = vraw[ps]; sm[ps] = ((bflo(raw.x) + bfhi(raw.x)) + (bflo(raw.y) + bfhi(raw.y))) + ((bflo(raw.z) + bfhi(raw.z)) + (bflo(raw.w) + bfhi(raw.w))); }
#pragma unroll
            for (int o = 1; o < 32; o <<= 1) {
#pragma unroll
                for (int ps = 0; ps < 8; ++ps) sm[ps] += __shfl_xor(sm[ps], o); }
#pragma unroll
            for (int ps = 0; ps < 8; ++ps) { const v4u raw = vraw[ps]; mean[ps] = sm[ps] * (1.0f / 256.0f); float q = 0.f;
                const float x[8] = {bflo(raw.x), bfhi(raw.x), bflo(raw.y), bfhi(raw.y), bflo(raw.z), bfhi(raw.z), bflo(raw.w), bfhi(raw.w)};
#pragma unroll
                for (int e = 0; e < 8; ++e) { const float dx = x[e] - mean[ps]; q += dx * dx; }
                sm[ps] = q; }
#pragma unroll
            for (int o = 1; o < 32; o <<= 1) {
#pragma unroll
                for (int ps = 0; ps < 8; ++ps) sm[ps] += __shfl_xor(sm[ps], o); }
#pragma unroll
            for (int ps = 0; ps < 8; ++ps) { rs[ps] = 1.0f / sqrtf(sm[ps] * (1.0f / 256.0f) + LN_EPS); const v4u raw = vraw[ps]; const int j = 16 * ps + 2 * F.wave + (F.lane >> 5);
                const float x[8] = {bflo(raw.x), bfhi(raw.x), bflo(raw.y), bfhi(raw.y), bflo(raw.z), bfhi(raw.z), bflo(raw.w), bfhi(raw.w)};
                v4u w; w.x = pk2((x[0] - mean[ps]) * rs[ps], (x[1] - mean[ps]) * rs[ps]); w.y = pk2((x[2] - mean[ps]) * rs[ps], (x[3] - mean[ps]) * rs[ps]);
                w.z = pk2((x[4] - mean[ps]) * rs[ps], (x[5] - mean[ps]) * rs[ps]); w.w = pk2((x[6] - mean[ps]) * rs[ps], (x[7] - mean[ps]) * rs[ps]);
                *(LAS v4u*)(Vn + j * SG_RS + l32 * 16) = w; }
        }
        LDS_BARRIER();
        if (u + F.G < 1024) SG_LOAD(u + F.G);
        {
#pragma unroll
          for (int ps = 0; ps < 4; ++ps) { const int p = (F.tid >> 3) + 64 * ps; const size_t tok = (size_t)m0 + (p >> 1); const int hd = 2 * gi + (p & 1);
              const float l0 = ml[ps][0], l1 = ml[ps][1], l2 = ml[ps][2];
              const float mxx = fmaxf(l0, fmaxf(l1, l2)); float w0 = fexp2(l0 - mxx), w1 = fexp2(l1 - mxx), w2 = fexp2(l2 - mxx); const float inv = 1.0f / (w0 + w1 + w2); w0 *= inv; w1 *= inv; w2 *= inv;
              const size_t off = tok * 512 + hd * 64 + 8 * sub;
              const v4u a = mo[ps][0], bq = mo[ps][1], cq = mo[ps][2]; v4u w;
              w.x = pk2(w0 * bflo(a.x) + w1 * bflo(bq.x) + w2 * bflo(cq.x), w0 * bfhi(a.x) + w1 * bfhi(bq.x) + w2 * bfhi(cq.x));
              w.y = pk2(w0 * bflo(a.y) + w1 * bflo(bq.y) + w2 * bflo(cq.y), w0 * bfhi(a.y) + w1 * bfhi(bq.y) + w2 * bfhi(cq.y));
              w.z = pk2(w0 * bflo(a.z) + w1 * bflo(bq.z) + w2 * bflo(cq.z), w0 * bfhi(a.z) + w1 * bfhi(bq.z) + w2 * bfhi(cq.z));
              w.w = pk2(w0 * bflo(a.w) + w1 * bflo(bq.w) + w2 * bflo(cq.w), w0 * bfhi(a.w) + w1 * bfhi(bq.w) + w2 * bfhi(cq.w));
              *(v4u*)(TT + tok * 1536 + 1024 + hd * 64 + 8 * sub) = w; } }
        v2u uq[8][2]; float ubias[8];
#pragma unroll
        for (int it = 0; it < 8; ++it) { const int i = 16 * it + qi; ubias[it] = spb[(l * 4 + gi) * 128 + i]; const size_t rowo = (size_t)(m0 + i) * 1024 + gi * 256 + 32 * F.wave + 4 * g4;
            uq[it][0] = *(const v2u*)(Ub + rowo); uq[it][1] = *(const v2u*)(Ub + rowo + 16); }
        {
            f32x4 acc[2][8];
#pragma unroll
            for (int ct = 0; ct < 2; ++ct)
#pragma unroll
                for (int it = 0; it < 8; ++it) acc[ct][it] = (f32x4){0.f, 0.f, 0.f, 0.f};
            const bf16* wbase = Wsp + (size_t)(l * 4 + gi) * 128 * 128 + (size_t)qi * 128 + 4 * g4;
#pragma unroll
            for (int kc = 0; kc < 4; ++kc) {
                bf16x8 af[2];
#pragma unroll
                for (int ct = 0; ct < 2; ++ct) { const LAS unsigned char* p = Vn + (32 * kc + 4 * g4 + (qi >> 2)) * SG_RS + (32 * F.wave + 16 * ct + 4 * (qi & 3)) * 2;
                    af[ct] = cat8(tr16(p), tr16(p + 16 * SG_RS)); }
#pragma unroll
                for (int it = 0; it < 8; ++it) if (it >= 2 * kc) {
                    const bf16* wp = wbase + (size_t)(16 * it) * 128 + 32 * kc; const LAS unsigned char* wq = Wl + (16 * it + qi) * SG_WRS + (32 * kc + 4 * g4) * 2;
                    const v2u b0 = wlds ? *(const LAS v2u*)wq : *(const v2u*)wp, b1 = wlds ? *(const LAS v2u*)(wq + 32) : *(const v2u*)(wp + 16);
                    const bf16x8 bfr = __builtin_bit_cast(bf16x8, (v4u){b0.x, b0.y, b1.x, b1.y});
                    acc[0][it] = mfma16(af[0], bfr, acc[0][it]); acc[1][it] = mfma16(af[1], bfr, acc[1][it]); }
            }
#pragma unroll
            for (int it = 0; it < 8; ++it) { const int i = 16 * it + qi; const float bias = ubias[it]; const size_t rowo = (size_t)(m0 + i) * 1536 + gi * 256 + 32 * F.wave + 4 * g4;
#pragma unroll
                for (int ct = 0; ct < 2; ++ct) { const v2u uu = uq[it][ct]; const f32x4 a = acc[ct][it]; v2u w;
                    w.x = pk2(bflo(uu.x) * (a[0] + bias), bfhi(uu.x) * (a[1] + bias)); w.y = pk2(bflo(uu.y) * (a[2] + bias), bfhi(uu.y) * (a[3] + bias));
                    *(v2u*)(TT + rowo + 16 * ct) = w; } }
        }
        LDS_BARRIER();
    }
#undef SG_LOAD
}

__device__ __forceinline__ void phase_ln1(Frame& F, int l, bool commit) {
    const bf16* YPRE = wsp<bf16>(F, WS_YPRE); bf16* H = wsp<bf16>(F, WS_H);
    const float* modl = wsp<float>(F, WS_MOD) + (size_t)l * 8 * 6144;
    const float* lg = F.in[I_LN1G] + l * D; const float* lb = F.in[I_LN1B] + l * D; const float* br = F.in[I_BR] + l * NE;
    const bf16* WH = wsp<bf16>(F, WS_WRT) + (size_t)l * NE * D; const bf16* WL = WH + (size_t)NL * NE * D;
    int* TOKINFO = wsp<int>(F, WS_TOKINFO); float* TOKW = wsp<float>(F, WS_TOKW);
    unsigned* cntg = wsp<unsigned>(F, WS_CTL) + CW_CNT + (size_t)l * NE * 64;
    LAS int* sel_e = (LAS int*)(F.lds + X_SELE);
    const int lane = F.lane, qi = lane & 15, g4 = lane >> 4;
    { const v4u* srcw = (const v4u*)WH;
#pragma unroll 4
      for (int i = F.tid; i < 2 * NE * 128; i += 512) { const int hl = i >> 12, e = (i >> 7) & 31, c = i & 127;
          *(LAS v4u*)(F.lds + hl * 65536 + e * 2048 + ((c ^ (e & 15)) << 4)) = srcw[(size_t)hl * (NL * NE * 128) + e * 128 + c]; } }
    __syncthreads();
    for (int tb = F.vcu; tb < T / 128; tb += F.G) {
        const int m0 = tb * 128; const int b = m0 >> 12; const float* mb = modl + (size_t)b * 6144; const int mw = m0 + 16 * F.wave;
        v2u pre[4][4];
#pragma unroll
        for (int r = 0; r < 4; ++r)
#pragma unroll
            for (int j = 0; j < 4; ++j) pre[r][j] = *((const v2u*)(YPRE + (size_t)(mw + r) * D) + lane + 64 * j);
#pragma unroll 1
        for (int rp = 0; rp < 4; ++rp) {
            f32x4 hh[4][4]; float mean[4], rstd[4];
            const int mrow = mw + 4 * rp;
#pragma unroll
            for (int r = 0; r < 4; ++r)
#pragma unroll
                for (int j = 0; j < 4; ++j) hh[r][j] = (f32x4){bflo(pre[r][j].x), bfhi(pre[r][j].x), bflo(pre[r][j].y), bfhi(pre[r][j].y)};
            if (rp < 3) {
#pragma unroll
                for (int r = 0; r < 4; ++r)
#pragma unroll
                    for (int j = 0; j < 4; ++j) pre[r][j] = *((const v2u*)(YPRE + (size_t)(mrow + 4 + r) * D) + lane + 64 * j); }
            { float sm[4], sq[4];
#pragma unroll
              for (int r = 0; r < 4; ++r) { sm[r] = 0.f; sq[r] = 0.f;
#pragma unroll
                  for (int j = 0; j < 4; ++j) { sm[r] += (hh[r][j][0] + hh[r][j][1]) + (hh[r][j][2] + hh[r][j][3]);
                      sq[r] += (hh[r][j][0] * hh[r][j][0] + hh[r][j][1] * hh[r][j][1]) + (hh[r][j][2] * hh[r][j][2] + hh[r][j][3] * hh[r][j][3]); } }
#pragma unroll
              for (int o = 1; o < 64; o <<= 1) {
#pragma unroll
                  for (int r = 0; r < 4; ++r) { sm[r] += __shfl_xor(sm[r], o); sq[r] += __shfl_xor(sq[r], o); } }
#pragma unroll
              for (int r = 0; r < 4; ++r) { mean[r] = sm[r] * (1.0f / D); rstd[r] = 1.0f / sqrtf(fmaxf(sq[r] * (1.0f / D) - mean[r] * mean[r], 0.f) + LN_EPS); } }
            if (lane < 4) { const float mq = (lane == 0) ? mean[0] : (lane == 1) ? mean[1] : (lane == 2) ? mean[2] : mean[3], rq = (lane == 0) ? rstd[0] : (lane == 1) ? rstd[1] : (lane == 2) ? rstd[2] : rstd[3];
                float* st = wsp<float>(F, WS_STAT) + (size_t)(mrow + lane) * 2; st[0] = mq; st[1] = rq; }
#pragma unroll
            for (int j = 0; j < 4; ++j) { const f32x4 gq = *((const f32x4*)lg + lane + 64 * j), bq = *((const f32x4*)lb + lane + 64 * j);
                const f32x4 shq = *((const f32x4*)(mb + 3072) + lane + 64 * j), scq = *((const f32x4*)(mb + 4096) + lane + 64 * j) + 1.0f;
#pragma unroll
                for (int r = 0; r < 4; ++r) { const f32x4 x1 = (hh[r][j] - mean[r]) * rstd[r] * gq + bq;
                    const f32x4 h2 = x1 * scq + shq; v2u o; o.x = pk2(h2[0], h2[1]); o.y = pk2(h2[2], h2[3]); *((v2u*)(H + (size_t)(mrow + r) * D) + lane + 64 * j) = o;
 } }
        }
        VM_WAIT(); asm volatile("" ::: "memory");
        f32x4 c0 = (f32x4){0.f, 0.f, 0.f, 0.f}, c1 = c0;
        { const bf16* hp = H + (size_t)(mw + qi) * D + 8 * g4;
          const LAS unsigned char* w0 = F.lds + qi * 2048; const LAS unsigned char* w1 = F.lds + (16 + qi) * 2048;
#pragma unroll 8
          for (int ks = 0; ks < 32; ++ks) {
              const bf16x8 hhi = *(const bf16x8*)(hp + 32 * ks);
              const int co = ((4 * ks + g4) ^ qi) << 4;
              const bf16x8 a0h = *(const LAS bf16x8*)(w0 + co), a0l = *(const LAS bf16x8*)(w0 + 65536 + co);
              const bf16x8 a1h = *(const LAS bf16x8*)(w1 + co), a1l = *(const LAS bf16x8*)(w1 + 65536 + co);
              c0 = mfma16(a0h, hhi, c0); c0 = mfma16(a0l, hhi, c0);
              c1 = mfma16(a1h, hhi, c1); c1 = mfma16(a1l, hhi, c1); } }
        {
            float v[8]; int id[8];
#pragma unroll
            for (int i = 0; i < 4; ++i) { id[i] = 4 * g4 + i; id[4 + i] = 16 + 4 * g4 + i; v[i] = c0[i] + br[4 * g4 + i]; v[4 + i] = c1[i] + br[16 + 4 * g4 + i]; }
            int ek[4]; float vk[4];
#pragma unroll
            for (int k = 0; k < 4; ++k) { float lm = v[0]; int li = id[0];
#pragma unroll
                for (int j = 1; j < 8; ++j) if (v[j] > lm) { lm = v[j]; li = id[j]; }
#pragma unroll
                for (int o = 16; o <= 32; o <<= 1) { const float om = __shfl_xor(lm, o); const int oi = __shfl_xor(li, o); if (om > lm || (om == lm && oi < li)) { lm = om; li = oi; } }
                ek[k] = li; vk[k] = lm;
#pragma unroll
                for (int j = 0; j < 8; ++j) if (id[j] == li) v[j] = -INFINITY; }
            const float e1 = __expf(vk[1] - vk[0]), e2 = __expf(vk[2] - vk[0]), e3 = __expf(vk[3] - vk[0]); const float inv = 1.0f / (1.0f + e1 + e2 + e3);
            if (g4 == 0) { const int tl = 16 * F.wave + qi;
                sel_e[tl * 4 + 0] = ek[0]; sel_e[tl * 4 + 1] = ek[1]; sel_e[tl * 4 + 2] = ek[2]; sel_e[tl * 4 + 3] = ek[3];
                *(f32x4*)(TOKW + (size_t)(m0 + tl) * 4) = (f32x4){inv, e1 * inv, e2 * inv, e3 * inv}; }
        }
        __syncthreads();
        { const int myE = sel_e[F.tid]; LAS unsigned long long* bm = (LAS unsigned long long*)(F.lds + X_SELR); unsigned long long mine = 0ull;
#pragma unroll
          for (int e = 0; e < 32; ++e) { const unsigned long long m = __ballot(myE == e); if (lane == e) mine = m; }
          if (lane < 32) bm[F.wave * 32 + lane] = mine;
          __syncthreads();
          int rk = __popcll(bm[F.wave * 32 + myE] & ((1ull << lane) - 1ull));
#pragma unroll
          for (int w = 0; w < 8; ++w) if (w < F.wave) rk += __popcll(bm[w * 32 + myE]);
          TOKINFO[(size_t)m0 * 4 + F.tid] = myE | (rk << 8);
          if (F.tid < 32) { int tot = 0;
#pragma unroll
              for (int w = 0; w < 8; ++w) tot += __popcll(bm[w * 32 + F.tid]);
              wsp<int>(F, WS_WGCNT)[((size_t)l * 256 + tb) * 32 + F.tid] = tot; if (tot && commit) (void)__hip_atomic_fetch_add(cntg + F.tid * 64, (unsigned)tot, RLX_AGENT); } }
        __syncthreads();
    }
}

__device__ __forceinline__ int moe_tables(Frame& F, int l) {
    const unsigned* cntg = wsp<unsigned>(F, WS_CTL) + CW_CNT + (size_t)l * NE * 64;
    LAS int* cnt_s = (LAS int*)(F.lds + X_CNTS); LAS int* off_s = (LAS int*)(F.lds + X_OFFS); LAS unsigned char* tile_e = (LAS unsigned char*)(F.lds + X_TILEE);
    if (F.tid < 32) cnt_s[F.tid] = (int)__hip_atomic_load(cntg + F.tid * 64, RLX_AGENT);
    __syncthreads();
    if (F.tid < 64) {
        const int e = F.tid & 31; const int c = (F.tid < 32) ? cnt_s[e] : 0; const int nt = (c + 255) >> 8; int incl = nt;
#pragma unroll
        for (int o = 1; o < 32; o <<= 1) { const int v = __shfl_up(incl, o); if ((F.tid & 63) >= o) incl += v; }
        if (F.tid < 32) { const int excl = incl - nt; off_s[e] = excl * 256; for (int t = 0; t < nt; ++t) tile_e[excl + t] = (unsigned char)e; if (e == 31) off_s[32] = incl * 256; }
    }
    __syncthreads();
    return off_s[32] >> 8;
}
__device__ __forceinline__ void phase_scat(Frame& F, int l) {
    (void)moe_tables(F, l);
    const LAS int* off_s = (const LAS int*)(F.lds + X_OFFS); const LAS int* cnt_s = (const LAS int*)(F.lds + X_CNTS); LAS int* base_s = (LAS int*)(F.lds + X_BASE);
    const int* TOKINFO = wsp<int>(F, WS_TOKINFO); const float* TOKW = wsp<float>(F, WS_TOKW);
    int* ROWTOK = wsp<int>(F, WS_ROWTOK); float* ROWW = wsp<float>(F, WS_ROWW); const int* WGC = wsp<int>(F, WS_WGCNT) + (size_t)l * 256 * 32; int* TOKINFO2 = wsp<int>(F, WS_TOKROW);
    for (int tb = F.vcu; tb < T / 128; tb += F.G) {
        if (F.tid < 32) base_s[F.tid] = 0;
        __syncthreads();
        { const int e = F.tid & 31, part = F.tid >> 5; int sacc = 0;
          for (int t2 = part * 16; t2 < part * 16 + 16; ++t2) if (t2 < tb) sacc += WGC[t2 * 32 + e];
          if (sacc) atomicAdd((int*)&base_s[e], sacc); }
        __syncthreads();
        { const size_t ent = (size_t)tb * 512 + F.tid; const int info = TOKINFO[ent]; const int e = info & 255, row = off_s[e] + base_s[e] + (info >> 8);
          ROWTOK[row] = (int)ent; ROWW[row] = TOKW[ent]; TOKINFO2[ent] = row; }
        __syncthreads();
    }
    if (F.vcu == 0) for (int e = 0; e < NE; ++e) for (int r = off_s[e] + cnt_s[e] + F.tid; r < off_s[e + 1]; r += 512) { ROWTOK[r] = 0; ROWW[r] = 0.f; }
}
__device__ __forceinline__ void phase_ln2(Frame& F, int l) {
    const bf16* X1 = wsp<bf16>(F, WS_YPRE); const bf16* YK = wsp<bf16>(F, WS_XG); bf16* H = wsp<bf16>(F, WS_H); const int* TOKROW = wsp<int>(F, WS_TOKROW); const float* TOKW = wsp<float>(F, WS_TOKW);
    const float* STAT = wsp<float>(F, WS_STAT); const float* l1g = F.in[I_LN1G] + l * D; const float* l1b = F.in[I_LN1B] + l * D;
    float* XO = F.out; bf16* XB = wsp<bf16>(F, WS_X2);
    const float* modl = wsp<float>(F, WS_MOD) + (size_t)l * 8 * 6144; const float* modn = wsp<float>(F, WS_MOD) + (size_t)((l + 1) & 3) * 8 * 6144;
    const float* lg = F.in[I_LN2G] + l * D; const float* lb = F.in[I_LN2B] + l * D;
    const int lane = F.lane; const int gw = F.vcu * 8 + F.wave, NGW = F.G * 8;
    v2u px[4]; v2u py[4][4]; float pst[2], nst[2]; f32x4 pw4, nw4;
#define LN2_LOAD(mm) do { nst[0] = STAT[(size_t)(mm) * 2]; nst[1] = STAT[(size_t)(mm) * 2 + 1]; nw4 = *(const f32x4*)(TOKW + (size_t)(mm) * 4); \
        int rw_[4]; _Pragma("unroll") for (int k = 0; k < 4; ++k) rw_[k] = TOKROW[(size_t)(mm) * 4 + k]; \
        _Pragma("unroll") for (int j = 0; j < 4; ++j) { px[j] = __builtin_nontemporal_load((const v2u*)(X1 + (size_t)(mm) * D) + lane + 64 * j); \
        _Pragma("unroll") for (int k = 0; k < 4; ++k) py[j][k] = __builtin_nontemporal_load((const v2u*)(YK + (size_t)rw_[k] * D) + lane + 64 * j); } } while (0)
    if (gw < T) LN2_LOAD(gw);
#pragma unroll 1
    for (int m = gw; m < T; m += NGW) { const int b = m >> 12; const float* mb = modl + (size_t)b * 6144; const float* mn = modn + (size_t)b * 6144;
        f32x4 v[4]; float s = 0.f; pst[0] = nst[0]; pst[1] = nst[1]; pw4 = nw4;
#pragma unroll
        for (int j = 0; j < 4; ++j) { f32x4 y = (f32x4){0.f, 0.f, 0.f, 0.f};
#pragma unroll
            for (int k = 0; k < 4; ++k) { const v2u w = py[j][k]; const float cw = pw4[k]; y[0] += cw * bflo(w.x); y[1] += cw * bfhi(w.x); y[2] += cw * bflo(w.y); y[3] += cw * bfhi(w.y); }
            const f32x4 g2 = *((const f32x4*)(mb + 5120) + lane + 64 * j) + 1.0f;
            const f32x4 pxf = (f32x4){bflo(px[j].x), bfhi(px[j].x), bflo(px[j].y), bfhi(px[j].y)};
            const f32x4 x1 = (pxf - pst[0]) * pst[1] * *((const f32x4*)l1g + lane + 64 * j) + *((const f32x4*)l1b + lane + 64 * j);
            v[j] = x1 * DN_ALPHA + g2 * y; s += (v[j][0] + v[j][1]) + (v[j][2] + v[j][3]); }
        if (m + NGW < T) LN2_LOAD(m + NGW);
        float s2 = 0.f;
#pragma unroll
        for (int j = 0; j < 4; ++j) s2 += (v[j][0] * v[j][0] + v[j][1] * v[j][1]) + (v[j][2] * v[j][2] + v[j][3] * v[j][3]);
#pragma unroll
        for (int o = 1; o < 64; o <<= 1) { s += __shfl_xor(s, o); s2 += __shfl_xor(s2, o); }
        const float mean = s * (1.0f / D); const float rstd = 1.0f / sqrtf(fmaxf(s2 * (1.0f / D) - mean * mean, 0.f) + LN_EPS);
#pragma unroll
        for (int j = 0; j < 4; ++j) v[j] = v[j] - mean;
        f32x4* xo = (f32x4*)(XO + (size_t)m * D) + lane; v2u* xb = (v2u*)(XB + (size_t)m * D) + lane; v2u* ho = hblk(H, m, lane);
#pragma unroll
        for (int j = 0; j < 4; ++j) { const f32x4 gvj = *((const f32x4*)lg + lane + 64 * j), bvj = *((const f32x4*)lb + lane + 64 * j); const f32x4 x2 = v[j] * rstd * gvj + bvj;
            if (l == NL - 1) __builtin_nontemporal_store(x2, xo + 64 * j); else { v2u xq; xq.x = pk2(x2[0], x2[1]); xq.y = pk2(x2[2], x2[3]); __builtin_nontemporal_store(xq, xb + 64 * j); }
            if (l < NL - 1) { const f32x4 sh = *((const f32x4*)mn + lane + 64 * j), sc = *((const f32x4*)(mn + 1024) + lane + 64 * j) + 1.0f; const f32x4 h = x2 * sc + sh;
                v2u o; o.x = pk2(h[0], h[1]); o.y = pk2(h[2], h[3]); ho[1024 * j] = o; } } }
#undef LN2_LOAD
}

#ifndef PH_MASK
#define PH_MASK 0xFFFF
#endif
#define PHM(b) ((PH_MASK >> (b)) & 1)
#ifndef DUP_MASK
#define DUP_MASK 0
#endif
#define REPS(b) (((DUP_MASK >> (b)) & 1) ? 2 : 1)
constexpr int NPH_L = 10, NPHASE = 2 + NL * NPH_L;
struct Args { const float* in[20]; float* out; unsigned char* ws; int ph_lo, ph_hi; };
__global__ void __launch_bounds__(512, 2) fwd(Args args) {
    extern __shared__ __attribute__((aligned(16))) unsigned char lds[];
    Frame F;
    F.lds = (LAS unsigned char*)lds;
#define FRESH() do { int zv_ = 0; asm volatile("" : "+v"(zv_)); const int z_ = __builtin_amdgcn_readfirstlane(zv_); \
        F.tid = (int)threadIdx.x + zv_; F.lane = F.tid & 63; F.wave = __builtin_amdgcn_readfirstlane(F.tid >> 6); \
        F.G = (int)gridDim.x + z_; F.bx = (int)blockIdx.x + z_; F.vcu = (F.G % 8 == 0) ? (F.bx % 8) * (F.G / 8) + F.bx / 8 : F.bx; \
        F.ws = args.ws + z_; F.in = args.in + z_; F.out = args.out + z_; F.lds = (LAS unsigned char*)lds + z_; } while (0)
    FRESH();
    for (int u = F.tid; u < (LDS_BYTES - XOFF) / 4; u += 512) ((LAS unsigned*)(F.lds + XOFF))[u] = 0u;
    __syncthreads();
    unsigned* ctl = wsp<unsigned>(F, WS_CTL);
    XcdBarrier bar; bar.bar = ctl + CW_BAR; bar.x = 0; bar.st = nullptr;
    if (!MK_PER_PHASE) bar = xcd_barrier_post(ctl + CW_BAR, (volatile LAS unsigned*)(F.lds + X_MISC) + 8);
    const int lo = args.ph_lo, hi = args.ph_hi;
#define IN(k) (lo <= (k) && (k) < hi)
#ifndef BAR_REPS
#define BAR_REPS 1
#endif
#define SEAM(k) do { if (!MK_PER_PHASE && IN(k) && IN((k) + 1)) for (int br_ = 0; br_ < BAR_REPS; ++br_) xcd_barrier(bar); } while (0)

    if (PHM(0) && IN(0)) for (int rep = 0; rep < REPS(0); ++rep) { FRESH(); phase_pro_a(F); } SEAM(0);
    if (PHM(1) && IN(1)) for (int rep = 0; rep < REPS(1); ++rep) { FRESH(); phase_pro_b(F); } SEAM(1);
    for (int l = 0; l < NL; ++l) {
        const int pb = 2 + l * NPH_L;
        if (PHM(2) && IN(pb + 0)) for (int rep = 0; rep < REPS(2); ++rep) { FRESH();
            pg8::Gemm g{wsp<bf16>(F, WS_H), wsp<bf16>(F, WS_WIN) + (size_t)l * NIN * D, T, NIN, D}; pg8::StaticOrder S; S.init(T, NIN, F.G, F.bx);
            EpiIn E{wsp<bf16>(F, WS_U), wsp<bf16>(F, WS_V), wsp<bf16>(F, WS_Q), wsp<bf16>(F, WS_K), wsp<bf16>(F, WS_VV), wsp<bf16>(F, WS_G), wsp<float>(F, WS_ROPE)};
            stagger(F.bx >> 3, STAG_US);
            pg8::gemm_phase<EpiIn, pg8::StaticOrder, PG8_ALIGN, PG8_SP2>(F.lds, g, S, E, F.tid);
#if defined(XPROBE)
            { FRESH(); pg8::Gemm g2{wsp<bf16>(F, WS_H), wsp<bf16>(F, WS_WIN) + (size_t)l * NIN * D, T, NIN, D}; pg8::StaticOrder S2; S2.init(T, NIN, F.G, F.bx);
              EpiProbe E2{wsp<bf16>(F, WS_XG), (XPROBE == 3) ? NIN : 1024, (XPROBE >= 2) ? (XPROBE == 3 ? 3 : 1) : (F.G == 0x7ffffff0 ? 1 : 0)};
              pg8::gemm_phase<EpiProbe, pg8::StaticOrder, PG8_ALIGN, PG8_SP2>(F.lds, g2, S2, E2, F.tid); }
#endif
        } SEAM(pb + 0);
        if (PHM(3) && IN(pb + 1)) for (int rep = 0; rep < REPS(3); ++rep) { FRESH(); phase_attn(F); } SEAM(pb + 1);
        if (PHM(4) && IN(pb + 2)) for (int rep = 0; rep < REPS(4); ++rep) { FRESH(); phase_sg(F, l); } SEAM(pb + 2);
        if (PHM(5) && IN(pb + 3)) for (int rep = 0; rep < REPS(5); ++rep) { FRESH();
            pg8::Gemm g{wsp<bf16>(F, WS_TT), wsp<bf16>(F, WS_WBA) + (size_t)l * D * 1536, T, D, 1536}; pg8::StaticOrder S; S.init(T, D, F.G, F.bx);
            EpiMg2 E{wsp<bf16>(F, WS_G), wsp<bf16>(F, WS_MG)}; pg8::gemm_phase<EpiMg2, pg8::StaticOrder, PG8_ALIGN, PG8_SP2>(F.lds, g, S, E, F.tid);
        } SEAM(pb + 3);
        if (PHM(6) && IN(pb + 4)) for (int rep = 0; rep < REPS(6); ++rep) { FRESH();
            pg8::Gemm g{wsp<bf16>(F, WS_MG), wsp<bf16>(F, WS_WOUT) + (size_t)l * D * D, T, D, D}; pg8::StaticOrder S; S.init(T, D, F.G, F.bx);
            if (l == 0) { EpiOut<true> E{(const void*)F.in[I_X], wsp<float>(F, WS_MOD) + (size_t)l * 8 * 6144, wsp<bf16>(F, WS_YPRE)}; pg8::gemm_phase<EpiOut<true>, pg8::StaticOrder, PG8_ALIGN, PG8_SP2>(F.lds, g, S, E, F.tid); }
            else { EpiOut<false> E{(const void*)wsp<bf16>(F, WS_X2), wsp<float>(F, WS_MOD) + (size_t)l * 8 * 6144, wsp<bf16>(F, WS_YPRE)}; pg8::gemm_phase<EpiOut<false>, pg8::StaticOrder, PG8_ALIGN, PG8_SP2>(F.lds, g, S, E, F.tid); }
        } SEAM(pb + 4);
        if (PHM(7) && IN(pb + 5)) for (int rep = 0; rep < REPS(7); ++rep) { FRESH(); phase_ln1(F, l, rep == 0); } SEAM(pb + 5);
        if (PHM(8) && IN(pb + 6)) for (int rep = 0; rep < REPS(8); ++rep) { FRESH(); phase_scat(F, l); } SEAM(pb + 6);
        if (PHM(9) && IN(pb + 7)) for (int rep = 0; rep < REPS(9); ++rep) { FRESH();
            const int RT = moe_tables(F, l);
            pg8::Gemm g{wsp<bf16>(F, WS_H), wsp<bf16>(F, WS_WUP) + (size_t)l * NE * 2048 * D, RT * 256, NE * 2048, D};
            MoeGatherOrder S; S.init(RT, 8, F.G, F.bx, (const LAS unsigned char*)(F.lds + X_TILEE)); S.tokl = (const LAS unsigned short*)(F.lds + X_TOKL);
            { const int* rowtok = wsp<int>(F, WS_ROWTOK); LAS unsigned short* tl = (LAS unsigned short*)(F.lds + X_TOKL); pg8::Unit uu;
              for (int i = 0; i < TOKL_UNITS && S.next(i, uu); ++i) if (F.tid < 256) tl[i * 256 + F.tid] = (unsigned short)(rowtok[uu.pm * 256 + F.tid] >> 2);
              __syncthreads(); }
            EpiUp E{F.in[I_BUP] + (size_t)l * NE * 2048, wsp<bf16>(F, WS_ACT)};
            stagger(F.bx >> 3, STAG_US);
            pg8::gemm_phase<EpiUp, MoeGatherOrder, PG8_ALIGN, true>(F.lds, g, S, E, F.tid);
            if (l + 1 < NL) tr_tail(F, l + 1, RT * 8, 0, TR_IPW_UP);
        } SEAM(pb + 7);
        if (PHM(10) && IN(pb + 8)) for (int rep = 0; rep < REPS(10); ++rep) { FRESH();
            const int RT = moe_tables(F, l);
            pg8::Gemm g{wsp<bf16>(F, WS_ACT), wsp<bf16>(F, WS_WDN) + (size_t)l * NE * D * FF, RT * 256, NE * D, FF};
            MoeOrder S; S.init(RT, 4, F.G, F.bx, (const LAS unsigned char*)(F.lds + X_TILEE), 1);
            EpiDn E{F.in[I_BDN] + (size_t)l * NE * D, wsp<bf16>(F, WS_XG)};
            stagger(F.bx >> 3, STAG_US);
            pg8::gemm_phase<EpiDn, MoeOrder, PG8_ALIGN, PG8_SP2>(F.lds, g, S, E, F.tid);
            if (l + 1 < NL) tr_tail(F, l + 1, RT * 4, tr_tail_items(RT * 8, F.G, TR_IPW_UP), TR_IPW_DN);
        } SEAM(pb + 8);
        if (PHM(11) && IN(pb + 9)) for (int rep = 0; rep < REPS(11); ++rep) { FRESH();
            if (l + 1 < NL) { const int RT = moe_tables(F, l); int te = tr_tail_items(RT * 8, F.G, TR_IPW_UP) + tr_tail_items(RT * 4, F.G, TR_IPW_DN); if (te > TR_IPL) te = TR_IPL;
                tr_convert(F, l + 1, te + F.vcu * 8 + F.wave, TR_IPL, F.G * 8); __syncthreads(); }
            phase_ln2(F, l); } SEAM(pb + 9);
    }
#undef IN
#undef SEAM
#undef FRESH
}

extern "C" void kernel_launch(void* const* d_in, const int* in_sizes, int n_in, void* d_out, int out_size, void* d_ws, size_t ws_size, hipStream_t stream) {
    static int grid = 0;
    if (grid == 0) {
        if (n_in != 20 || out_size != T * D || ws_size < WS_END) { fprintf(stderr, "kernel_launch: unexpected shapes (n_in %d, out %d, ws %zu < %zu)\n", n_in, out_size, ws_size, (size_t)WS_END); grid = -1; return; }
        int dev = 0, cus = 0;
        if (hipGetDevice(&dev) != hipSuccess || hipDeviceGetAttribute(&cus, hipDeviceAttributeMultiprocessorCount, dev) != hipSuccess) { grid = -1; return; }
        if (hipFuncSetAttribute((const void*)fwd, hipFuncAttributeMaxDynamicSharedMemorySize, LDS_BYTES) != hipSuccess) { fprintf(stderr, "kernel_launch: hipFuncSetAttribute failed\n"); grid = -1; return; }
        int per_cu = 0;
        if (hipOccupancyMaxActiveBlocksPerMultiprocessor(&per_cu, (const void*)fwd, 512, LDS_BYTES) != hipSuccess || per_cu < 1) fprintf(stderr, "kernel_launch: occupancy query says %d blocks per CU\n", per_cu);
        (void)hipGetLastError();
        grid = cus;
    }
    if (grid < 0) return;
    (void)in_sizes;
    if (hipMemsetAsync((char*)d_ws + WS_CTL, 0, CTL_ZERO_BYTES, stream) != hipSuccess) return;
    Args a{};
    for (int i = 0; i < 20; ++i) a.in[i] = (const float*)d_in[i];
    a.out = (float*)d_out; a.ws = (unsigned char*)d_ws;
#if MK_PER_PHASE
    for (int p = 0; p < NPHASE; ++p) { a.ph_lo = p; a.ph_hi = p + 1; hipLaunchKernelGGL(fwd, dim3(grid), dim3(512), LDS_BYTES, stream, a); }
#else
    a.ph_lo = 0; a.ph_hi = NPHASE;
    hipLaunchKernelGGL(fwd, dim3(grid), dim3(512), LDS_BYTES, stream, a);
#endif
    const hipError_t le = hipPeekAtLastError();
    if (le != hipSuccess) fprintf(stderr, "kernel_launch: launch failed: %s\n", hipGetErrorName(le));
}
```
